# Optimizing an MI355X kernel written in HIP

```python
import math
import jax, jax.numpy as jnp
from jax import lax
import numpy as np

D_MODEL = 2048
BATCH = 4
SEQ = 4096
DEPTH = 4

DN_ALPHA = (2 * DEPTH) ** 0.25
DN_BETA = (8 * DEPTH) ** -0.25
LN_EPS = 1e-5

A_HEADS = 8
A_HEAD_DIM = 128
A_WIDTH = A_HEADS * A_HEAD_DIM
MOBA_BLOCK = 256
MOBA_TOPK = 3
MOBA_QCHUNK = 16
ROPE_THETA = 500000.0
ROPE_DIM = A_HEAD_DIM // 4
NEG_INF = -1e30

B_HEADS = 4
B_HEAD_DIM = 256
B_WIDTH = B_HEADS * B_HEAD_DIM
MLSTM_CHUNK = 64
B_CONV = 4
HNORM_EPS = 1e-6

EVEN_IN = 3 * A_WIDTH + 4 * B_WIDTH + 2 * B_HEADS
EVEN_SPLITS = (A_WIDTH, 2 * A_WIDTH, 3 * A_WIDTH, 3 * A_WIDTH + 2 * B_WIDTH,
               3 * A_WIDTH + 3 * B_WIDTH, 3 * A_WIDTH + 4 * B_WIDTH)
EVEN_MIX = A_WIDTH + B_WIDTH

C_HEAD_DIM = 64
C_HEADS = D_MODEL // C_HEAD_DIM
LORA_W = 96
LORA_A = 96
LORA_V = 64
LORA_G = 256
LNX_EPS = 64e-5
KK_EPS = 1e-12

N_GROUPS = 4
EXPERTS_PER_GROUP = 8
N_EXPERTS = N_GROUPS * EXPERTS_PER_GROUP
MOE_TOPK = 2
EXPERT_FF = 512
MOE_BLOCK = 128

N_EVEN = (DEPTH + 1) // 2
N_ODD = DEPTH // 2
N_VRES = max(N_ODD - 1, 0)

kernel_name = "moba_mlstm_rwkv7_hmoe_deepnorm_trunk"

F32 = jnp.float32


def layer_norm(x, g, b):
    xf = x.astype(F32)
    mu = jnp.mean(xf, -1, keepdims=True)
    var = jnp.mean(jnp.square(xf - mu), -1, keepdims=True)
    return ((xf - mu) * lax.rsqrt(var + LN_EPS) * g.astype(F32) + b.astype(F32)).astype(x.dtype)


def split_heads(t, n_heads):
    bsz, s, w = t.shape
    return t.reshape(bsz, s, n_heads, w // n_heads).transpose(0, 2, 1, 3)


def merge_heads(t):
    bsz, h, s, d = t.shape
    return t.transpose(0, 2, 1, 3).reshape(bsz, s, h * d)


def partial_rotary(x, pos):
    half = ROPE_DIM // 2
    inv = jnp.power(jnp.float32(ROPE_THETA), -jnp.arange(half, dtype=F32) / half)
    ang = pos.astype(F32)[:, None] * inv[None, :]
    cos, sin = jnp.cos(ang), jnp.sin(ang)
    xr = x[..., :ROPE_DIM].astype(F32)
    x1, x2 = xr[..., :half], xr[..., half:]
    rot = jnp.concatenate([x1 * cos - x2 * sin, x2 * cos + x1 * sin], -1)
    return jnp.concatenate([rot.astype(x.dtype), x[..., ROPE_DIM:]], -1)


def moba_attention(q, k, v):
    bsz, h, s, dh = q.shape
    nblk = s // MOBA_BLOCK
    n_sel = min(MOBA_TOPK, nblk)
    kb = k.reshape(bsz, h, nblk, MOBA_BLOCK, dh)
    vb = v.reshape(bsz, h, nblk, MOBA_BLOCK, dh)
    kmean = jnp.mean(kb.astype(F32), axis=3)
    gate = jnp.einsum('bhsd,bhnd->bhsn', q.astype(F32), kmean)
    qblk = jnp.arange(s) // MOBA_BLOCK
    past = jnp.arange(nblk)[None, :] < qblk[:, None]
    gate = jnp.where(past, gate, -jnp.inf)
    _, sel = lax.top_k(gate, n_sel)
    sel_valid = sel < qblk[:, None]
    scale = A_HEAD_DIM ** -0.5
    nq = s // MOBA_QCHUNK

    def to_chunks(t):
        t = t.reshape(bsz, h, nq, MOBA_QCHUNK, *t.shape[3:])
        return jnp.moveaxis(t, 2, 0)

    bi = jnp.arange(bsz)[:, None, None, None]
    hi = jnp.arange(h)[None, :, None, None]

    def attend(args):
        qc, selc, validc, c = args
        q0 = c * MOBA_QCHUNK
        own = q0 // MOBA_BLOCK
        qpos = q0 + jnp.arange(MOBA_QCHUNK)
        kpos = own * MOBA_BLOCK + jnp.arange(MOBA_BLOCK)
        k_own = lax.dynamic_index_in_dim(kb, own, axis=2, keepdims=False)
        v_own = lax.dynamic_index_in_dim(vb, own, axis=2, keepdims=False)
        s_own = jnp.einsum('bhqd,bhkd->bhqk', qc, k_own).astype(F32) * scale
        s_own = jnp.where(kpos[None, :] <= qpos[:, None], s_own, NEG_INF)
        k_sel = kb[bi, hi, selc]
        v_sel = vb[bi, hi, selc]
        s_sel = jnp.einsum('bhqd,bhqnkd->bhqnk', qc, k_sel).astype(F32) * scale
        s_sel = jnp.where(validc[..., None], s_sel, NEG_INF)
        logits = jnp.concatenate(
            [s_own, s_sel.reshape(bsz, h, MOBA_QCHUNK, n_sel * MOBA_BLOCK)], -1)
        p = jax.nn.softmax(logits, axis=-1).astype(v.dtype)
        p_own = p[..., :MOBA_BLOCK]
        p_sel = p[..., MOBA_BLOCK:].reshape(bsz, h, MOBA_QCHUNK, n_sel, MOBA_BLOCK)
        return (jnp.einsum('bhqk,bhkd->bhqd', p_own, v_own)
                + jnp.einsum('bhqnk,bhqnkd->bhqd', p_sel, v_sel))

    out = lax.map(attend, (to_chunks(q), to_chunks(sel), to_chunks(sel_valid), jnp.arange(nq)))
    return jnp.moveaxis(out, 0, 2).reshape(bsz, h, s, dh)


def mlstm_chunkwise(q, k, v, i_pre, f_pre):
    bsz, h, s, dk = q.shape
    dv = v.shape[-1]
    L = MLSTM_CHUNK
    nc = s // L
    q = q.astype(F32)
    k = k.astype(F32) * (dk ** -0.5)
    v = v.astype(F32)
    log_f = jax.nn.log_sigmoid(f_pre.astype(F32))
    log_i = i_pre.astype(F32)

    def chunks(t):
        t = t.reshape(bsz, h, nc, L, *t.shape[3:])
        return jnp.moveaxis(t, 2, 0)

    tri = jnp.tril(jnp.ones((L, L), dtype=bool))

    def step(carry, xs):
        C, n, m = carry
        qc, kc, vc, ic, fc = xs
        b = jnp.cumsum(fc, axis=-1)
        log_inter = b + m[..., None]
        log_intra = b[..., :, None] - b[..., None, :] + ic[..., None, :]
        log_intra = jnp.where(tri, log_intra, -jnp.inf)
        m_t = jnp.maximum(log_inter, jnp.max(log_intra, -1))
        w_intra = jnp.exp(log_intra - m_t[..., None])
        w_inter = jnp.exp(log_inter - m_t)
        qk = jnp.einsum('bhtd,bhsd->bhts', qc, kc) * w_intra
        num = (w_inter[..., None] * jnp.einsum('bhtd,bhde->bhte', qc, C)
               + jnp.einsum('bhts,bhse->bhte', qk, vc))
        den = w_inter * jnp.einsum('bhtd,bhd->bht', qc, n) + jnp.sum(qk, -1)
        h_out = num / jnp.maximum(jnp.abs(den), jnp.exp(-m_t))[..., None]
        b_last = b[..., -1]
        log_s = b_last[..., None] - b + ic
        m_new = jnp.maximum(b_last + m, jnp.max(log_s, -1))
        carry_decay = jnp.exp(b_last + m - m_new)
        ws = jnp.exp(log_s - m_new[..., None])
        kw = kc * ws[..., None]
        C_new = carry_decay[..., None, None] * C + jnp.einsum('bhsd,bhse->bhde', kw, vc)
        n_new = carry_decay[..., None] * n + jnp.sum(kw, axis=2)
        return (C_new, n_new, m_new), h_out

    init = (jnp.zeros((bsz, h, dk, dv), F32), jnp.zeros((bsz, h, dk), F32),
            jnp.zeros((bsz, h), F32))
    _, hs = lax.scan(step, init, (chunks(q), chunks(k), chunks(v), chunks(log_i), chunks(log_f)))
    return jnp.moveaxis(hs, 0, 2).reshape(bsz, h, s, dv)


def causal_depthwise_conv(u, w, b):
    kw = w.shape[0]
    s = u.shape[1]
    up = jnp.pad(u, ((0, 0), (kw - 1, 0), (0, 0)))
    out = b
    for j in range(kw):
        out = out + up[:, j:j + s] * w[j]
    return out


def even_mixer(x, w_in, gate_bias, conv_w, conv_b, hnorm_g, w_out):
    bsz, s, _ = x.shape
    z = jnp.einsum('bsd,de->bse', x, w_in)
    q_a, k_a, v_a, qk_b, v_b, o_b, gates = jnp.split(z, list(EVEN_SPLITS), axis=-1)
    pos = jnp.arange(s)
    q_a = partial_rotary(split_heads(q_a, A_HEADS), pos)
    k_a = partial_rotary(split_heads(k_a, A_HEADS), pos)
    v_a = split_heads(v_a, A_HEADS)
    s_pad = -(-s // MOBA_BLOCK) * MOBA_BLOCK
    padw = ((0, 0), (0, 0), (0, s_pad - s), (0, 0))
    y_a = moba_attention(jnp.pad(q_a, padw), jnp.pad(k_a, padw), jnp.pad(v_a, padw))[:, :, :s]
    y_a = merge_heads(y_a).astype(x.dtype)
    qk_b = jax.nn.silu(causal_depthwise_conv(qk_b, conv_w, conv_b))
    q_b, k_b = jnp.split(qk_b, 2, axis=-1)
    gates = gates.astype(F32) + gate_bias.astype(F32).reshape(2 * B_HEADS)
    i_pre = gates[..., :B_HEADS].transpose(0, 2, 1)
    f_pre = gates[..., B_HEADS:].transpose(0, 2, 1)
    hb = mlstm_chunkwise(split_heads(q_b, B_HEADS), split_heads(k_b, B_HEADS),
                         split_heads(v_b, B_HEADS), i_pre, f_pre)
    hb = hb * lax.rsqrt(jnp.mean(hb * hb, -1, keepdims=True) + HNORM_EPS)
    y_b = merge_heads(hb).astype(x.dtype) * hnorm_g * jax.nn.sigmoid(o_b)
    y = jnp.concatenate([y_a, y_b], axis=-1)
    return jnp.einsum('bse,ed->bsd', y, w_out)


def rwkv7_mixer(x, v_first, mu, w_r, w_k, w_v, w_o, w0, w1, w2, a0, a1, a2, g1, g2,
                k_k, k_a, r_k, lnx_g, lnx_b, vres):
    bsz, s, d = x.shape
    dx = jnp.pad(x, ((0, 0), (1, 0), (0, 0)))[:, :s] - x
    xr, xw, xk, xv, xa, xg = (x + dx * mu[j] for j in range(6))
    r = xr @ w_r
    k = xk @ w_k
    v = xv @ w_v
    log_w = -jax.nn.softplus(-(w0 + jnp.tanh(xw @ w1) @ w2).astype(F32)) - 0.5
    decay = jnp.exp(-jnp.exp(log_w))
    a = jax.nn.sigmoid((a0 + (xa @ a1) @ a2).astype(F32))
    g = jax.nn.sigmoid(xg @ g1) @ g2
    if vres is None:
        v_first = v
    else:
        v0, v1, v2 = vres
        v = v + (v_first - v) * jax.nn.sigmoid(v0 + (xv @ v1) @ v2)

    def heads(t):
        return t.astype(F32).reshape(bsz, s, C_HEADS, C_HEAD_DIM)

    hd = (C_HEADS, C_HEAD_DIM)
    rh, vh, ah, wh = heads(r), heads(v), heads(a), heads(decay)
    kk = heads(k) * k_k.astype(F32).reshape(hd)
    kk = kk / jnp.maximum(jnp.sqrt(jnp.sum(kk * kk, -1, keepdims=True)), KK_EPS)
    kh = heads(k) * (1.0 + (ah - 1.0) * k_a.astype(F32).reshape(hd))

    def tm(t):
        return jnp.moveaxis(t, 1, 0)

    def step(state, xs):
        r_t, w_t, k_t, v_t, kk_t, a_t = xs
        u = jnp.einsum('bhvk,bhk->bhv', state, kk_t)
        state = (state * w_t[:, :, None, :] - u[..., None] * (kk_t * a_t)[:, :, None, :]
                 + v_t[..., None] * k_t[:, :, None, :])
        return state, jnp.einsum('bhvk,bhk->bhv', state, r_t)

    s0 = jnp.zeros((bsz, C_HEADS, C_HEAD_DIM, C_HEAD_DIM), F32)
    _, y = lax.scan(step, s0, (tm(rh), tm(wh), tm(kh), tm(vh), tm(kk), tm(ah)))
    y = jnp.moveaxis(y, 0, 1)
    ym = jnp.mean(y, -1, keepdims=True)
    yv = jnp.mean(jnp.square(y - ym), -1, keepdims=True)
    y = ((y - ym) * lax.rsqrt(yv + LNX_EPS)).reshape(bsz, s, d) * lnx_g.astype(F32) + lnx_b.astype(F32)
    bonus = jnp.sum(rh * kh * r_k.astype(F32).reshape(hd), -1, keepdims=True) * vh
    y = (y + bonus.reshape(bsz, s, d)).astype(x.dtype) * g
    return y @ w_o, v_first


def grouped_expert_mlp(xf, expert_idx, w_gate, w_up, w_down):
    t, kk = expert_idx.shape
    d = xf.shape[-1]
    m = t * kk
    e = w_gate.shape[0]
    flat_e = expert_idx.reshape(m)
    order = jnp.argsort(flat_e)
    sorted_e = flat_e[order]
    counts = jnp.bincount(flat_e, length=e)
    padded = (counts + MOE_BLOCK - 1) // MOE_BLOCK * MOE_BLOCK
    pad_end = jnp.cumsum(padded)
    pad_start = pad_end - padded
    start = jnp.cumsum(counts) - counts
    dest = pad_start[sorted_e] + jnp.arange(m) - start[sorted_e]
    n_blocks = (m + e * (MOE_BLOCK - 1) + MOE_BLOCK - 1) // MOE_BLOCK
    buf = jnp.zeros((n_blocks * MOE_BLOCK, d), xf.dtype).at[dest].set(xf[order // kk])
    block_e = jnp.minimum(
        jnp.searchsorted(pad_end, jnp.arange(n_blocks) * MOE_BLOCK, side='right'), e - 1)

    def expert_block(args):
        xb, ei = args
        hid = jax.nn.silu(xb @ w_gate[ei]) * (xb @ w_up[ei])
        return hid @ w_down[ei]

    yb = lax.map(expert_block, (buf.reshape(n_blocks, MOE_BLOCK, d), block_e))
    y_sorted = yb.reshape(-1, d)[dest]
    return jnp.zeros((m, d), yb.dtype).at[order].set(y_sorted).reshape(t, kk, d)


def hierarchical_moe(x, w_grp, b_grp, w_exp_r, b_exp_r, w_gate, w_up, w_down):
    bsz, s, d = x.shape
    xf = x.reshape(-1, d)
    t = xf.shape[0]
    g_prob = jax.nn.softmax((xf @ w_grp + b_grp).astype(F32), axis=-1)
    g_p, g_idx = lax.top_k(g_prob, 1)
    e_logits = (xf @ w_exp_r + b_exp_r).astype(F32).reshape(t, N_GROUPS, EXPERTS_PER_GROUP)
    e_logits = jnp.take_along_axis(e_logits, g_idx[:, :, None], axis=1)[:, 0]
    e_p, e_idx = lax.top_k(jax.nn.softmax(e_logits, axis=-1), MOE_TOPK)
    e_p = e_p / jnp.sum(e_p, -1, keepdims=True)
    gates = g_p * e_p
    expert = g_idx * EXPERTS_PER_GROUP + e_idx
    y = grouped_expert_mlp(xf, expert, w_gate, w_up, w_down)
    out = jnp.einsum('tk,tkd->td', gates.astype(y.dtype), y)
    return out.reshape(bsz, s, d)


def setup_inputs(seed: int = 0) -> dict:
    key = jax.random.key(seed)
    keys = iter(jax.random.split(key, 48))
    D = D_MODEL

    def nrm(shape, scale):
        return jax.random.normal(next(keys), shape, F32) * scale

    inp = {}
    inp['x'] = nrm((BATCH, SEQ, D), 1.0)
    inp['ev_w_in'] = nrm((N_EVEN, D, EVEN_IN), D ** -0.5)
    inp['ev_gate_bias'] = jnp.stack([nrm((N_EVEN, B_HEADS), 0.1),
                                     3.0 + nrm((N_EVEN, B_HEADS), 0.5)], axis=1)
    inp['ev_conv_w'] = nrm((N_EVEN, B_CONV, 2 * B_WIDTH), 0.5)
    inp['ev_conv_b'] = nrm((N_EVEN, 2 * B_WIDTH), 0.02)
    inp['ev_hnorm_g'] = 1.0 + nrm((N_EVEN, B_WIDTH), 0.05)
    inp['ev_w_out'] = nrm((N_EVEN, EVEN_MIX, D), EVEN_MIX ** -0.5 * DN_BETA)
    inp['od_mu'] = jax.random.uniform(next(keys), (N_ODD, 6, D), F32)
    inp['od_w_r'] = nrm((N_ODD, D, D), D ** -0.5)
    inp['od_w_k'] = nrm((N_ODD, D, D), D ** -0.5)
    inp['od_w_v'] = nrm((N_ODD, D, D), D ** -0.5)
    inp['od_w_o'] = nrm((N_ODD, D, D), D ** -0.5 * DN_BETA)
    inp['od_w0'] = -2.0 + nrm((N_ODD, D), 1.0)
    inp['od_w1'] = nrm((N_ODD, D, LORA_W), D ** -0.5)
    inp['od_w2'] = nrm((N_ODD, LORA_W, D), 0.1 * LORA_W ** -0.5)
    inp['od_a0'] = nrm((N_ODD, D), 0.1)
    inp['od_a1'] = nrm((N_ODD, D, LORA_A), D ** -0.5)
    inp['od_a2'] = nrm((N_ODD, LORA_A, D), 0.1 * LORA_A ** -0.5)
    inp['od_g1'] = nrm((N_ODD, D, LORA_G), D ** -0.5)
    inp['od_g2'] = nrm((N_ODD, LORA_G, D), LORA_G ** -0.5)
    inp['od_k_k'] = 0.85 + nrm((N_ODD, D), 0.05)
    inp['od_k_a'] = 1.0 + nrm((N_ODD, D), 0.05)
    inp['od_r_k'] = nrm((N_ODD, D), 0.1)
    inp['od_lnx_g'] = 1.0 + nrm((N_ODD, D), 0.05)
    inp['od_lnx_b'] = nrm((N_ODD, D), 0.02)
    inp['od_v0'] = 1.0 + nrm((N_VRES, D), 0.1)
    inp['od_v1'] = nrm((N_VRES, D, LORA_V), D ** -0.5)
    inp['od_v2'] = nrm((N_VRES, LORA_V, D), 0.1 * LORA_V ** -0.5)
    inp['ln_mix_g'] = 1.0 + nrm((DEPTH, D), 0.05)
    inp['ln_mix_b'] = nrm((DEPTH, D), 0.02)
    inp['ln_ffn_g'] = 1.0 + nrm((DEPTH, D), 0.05)
    inp['ln_ffn_b'] = nrm((DEPTH, D), 0.02)
    inp['moe_w_grp'] = nrm((DEPTH, D, N_GROUPS), D ** -0.5)
    inp['moe_b_grp'] = nrm((DEPTH, N_GROUPS), 0.01)
    inp['moe_w_exp_r'] = nrm((DEPTH, D, N_EXPERTS), D ** -0.5)
    inp['moe_b_exp_r'] = nrm((DEPTH, N_EXPERTS), 0.01)
    inp['moe_w_gate'] = nrm((DEPTH, N_EXPERTS, D, EXPERT_FF), D ** -0.5)
    inp['moe_w_up'] = nrm((DEPTH, N_EXPERTS, D, EXPERT_FF), D ** -0.5)
    inp['moe_w_down'] = nrm((DEPTH, N_EXPERTS, EXPERT_FF, D), EXPERT_FF ** -0.5 * DN_BETA)
    return inp


def reference(x, ev_w_in, ev_gate_bias, ev_conv_w, ev_conv_b, ev_hnorm_g, ev_w_out,
              od_mu, od_w_r, od_w_k, od_w_v, od_w_o, od_w0, od_w1, od_w2, od_a0, od_a1, od_a2,
              od_g1, od_g2, od_k_k, od_k_a, od_r_k, od_lnx_g, od_lnx_b, od_v0, od_v1, od_v2,
              ln_mix_g, ln_mix_b, ln_ffn_g, ln_ffn_b,
              moe_w_grp, moe_b_grp, moe_w_exp_r, moe_b_exp_r, moe_w_gate, moe_w_up, moe_w_down):
    v_first = None
    for layer in range(DEPTH):
        if layer % 2 == 0:
            e = layer // 2
            mix = even_mixer(x, ev_w_in[e], ev_gate_bias[e], ev_conv_w[e], ev_conv_b[e],
                             ev_hnorm_g[e], ev_w_out[e])
        else:
            o = layer // 2
            vres = None if o == 0 else (od_v0[o - 1], od_v1[o - 1], od_v2[o - 1])
            mix, v_first = rwkv7_mixer(x, v_first, od_mu[o], od_w_r[o], od_w_k[o], od_w_v[o],
                                       od_w_o[o], od_w0[o], od_w1[o], od_w2[o], od_a0[o],
                                       od_a1[o], od_a2[o], od_g1[o], od_g2[o], od_k_k[o],
                                       od_k_a[o], od_r_k[o], od_lnx_g[o], od_lnx_b[o], vres)
        x = layer_norm(DN_ALPHA * x + mix, ln_mix_g[layer], ln_mix_b[layer])
        ffn = hierarchical_moe(x, moe_w_grp[layer], moe_b_grp[layer], moe_w_exp_r[layer],
                               moe_b_exp_r[layer], moe_w_gate[layer], moe_w_up[layer],
                               moe_w_down[layer])
        x = layer_norm(DN_ALPHA * x + ffn, ln_ffn_g[layer], ln_ffn_b[layer])
    return x
```

```cpp
#include <hip/hip_runtime.h>
#include <cstdio>
#include <cstdint>
#include <type_traits>

#ifndef ONE_LAUNCH
#define ONE_LAUNCH 1
#endif

#define LAS __attribute__((address_space(3)))
typedef unsigned short bf16;
typedef unsigned v4u __attribute__((ext_vector_type(4)));
typedef unsigned v2u __attribute__((ext_vector_type(2)));
typedef float f32x4 __attribute__((ext_vector_type(4)));
typedef float f32x2 __attribute__((ext_vector_type(2)));
typedef short bf16x8 __attribute__((ext_vector_type(8)));

__device__ __forceinline__ unsigned f2bf(float f) { unsigned u = __builtin_bit_cast(unsigned, f); return (u + 0x7fffu + ((u >> 16) & 1u)) >> 16; }
__device__ __forceinline__ unsigned pk2(float lo, float hi) { return f2bf(lo) | (f2bf(hi) << 16); }
__device__ __forceinline__ float bflo(unsigned w) { return __builtin_bit_cast(float, w << 16); }
__device__ __forceinline__ float bfhi(unsigned w) { return __builtin_bit_cast(float, w & 0xffff0000u); }
__device__ __forceinline__ float bf2f(bf16 h) { return __builtin_bit_cast(float, (unsigned)h << 16); }
__device__ __forceinline__ float sigmoidf_(float x) { return 1.f / (1.f + __expf(-x)); }
__device__ __forceinline__ float wave_sum(float v) {
#pragma unroll
    for (int o = 1; o < 64; o <<= 1) v += __shfl_xor(v, o);
    return v;
}
template <int CTRL> __device__ __forceinline__ float dppf(float x) { return __builtin_bit_cast(float, __builtin_amdgcn_mov_dpp(__builtin_bit_cast(int, x), CTRL, 0xf, 0xf, true)); }
__device__ __forceinline__ float red16(float x) { x += dppf<0xB1>(x); x += dppf<0x4E>(x); x += dppf<0x141>(x); x += dppf<0x128>(x); return x; }
__device__ __forceinline__ float max16(float x) { x = fmaxf(x, dppf<0xB1>(x)); x = fmaxf(x, dppf<0x4E>(x)); x = fmaxf(x, dppf<0x141>(x)); x = fmaxf(x, dppf<0x128>(x)); return x; }

__device__ __forceinline__ int lane_id_asm() { int l; asm volatile("v_mbcnt_lo_u32_b32 %0, -1, 0\n\tv_mbcnt_hi_u32_b32 %0, -1, %0" : "=v"(l)); return l; }
#define OPAQUE_TID() const int tid = wv * 64 + lane_id_asm()
#define LDS_WAIT() asm volatile("s_waitcnt lgkmcnt(0)" ::: "memory")
#define VM_WAIT() asm volatile("s_waitcnt vmcnt(0)" ::: "memory")

namespace pg8 {
#define PG8_LAS __attribute__((address_space(3)))
typedef unsigned short bf16_t;
typedef short bf16x8 __attribute__((ext_vector_type(8)));
typedef float f32x4 __attribute__((ext_vector_type(4)));
typedef unsigned u32x4 __attribute__((ext_vector_type(4)));
constexpr int BM = 256, BK = 64, HALF = 128, HTB = HALF * BK * 2  , STAGE_BYTES = 8 * HTB, NXCD = 8, WGM = 8;

__host__ __device__ __forceinline__ int lds_byte(int r, int c) { const int st = (r >> 4) * 2 + (c >> 5), rr = r & 15, cc = c & 31, ob = rr * 64 + cc * 2; return st * 1024 + (ob ^ (((ob >> 9) & 1) << 5)); }
__host__ __device__ __forceinline__ void stage_rc(int b, int& R, int& C) { const int st = b / 1024, sb = b % 1024, swz = sb ^ (((sb >> 9) & 1) << 5); R = (st >> 1) * 16 + swz / 64; C = (st & 1) * 32 + (swz % 64) / 2; }
__host__ __device__ __forceinline__ int perm32(int rho) { const int n = rho >> 4, i = rho & 15; return 8 * (i >> 2) + 4 * n + (i & 3); }

struct Unit { int pm, pn, aoff; };
struct Gemm { const bf16_t* A; const bf16_t* Bt; int K, lda, ldb; };

struct StaticOrder {
    int nM, nN, nwg, G, c;
    __device__ void init(int M, int N, int G_, int c_) { nM = M / BM; nN = N / BM; nwg = nM * nN; G = G_; c = c_; }
    __device__ bool next(int i, Unit& u) const { return at((long)i * G + c, u); }
    __device__ bool at(long L, Unit& u) const {
        if (L >= nwg) return false;
        int wgid = (int)L; { const int q = nwg / NXCD, r = nwg % NXCD, xcd = wgid % NXCD, off = wgid / NXCD; wgid = (xcd < r ? xcd * (q + 1) : r * (q + 1) + (xcd - r) * q) + off; }
        const int nig = WGM * nN, gid = wgid / nig, fm = gid * WGM, gsz = (nM - fm) < WGM ? (nM - fm) : WGM;
        u.pm = fm + ((wgid % nig) % gsz); u.pn = (wgid % nig) / gsz; u.aoff = 0; return true;
    }
    __device__ __forceinline__ void a_ready(const Unit&) const {}
    __device__ __forceinline__ void done(const Unit&) const {}
};

__device__ __forceinline__ unsigned cvt_pk_bf16(float lo, float hi) { unsigned r; asm volatile("v_cvt_pk_bf16_f32 %0, %1, %2" : "=v"(r) : "v"(lo), "v"(hi)); return r; }

struct EpiBf16 {
    static constexpr bool PERM = true, AFTER_DRAIN = false;
    bf16_t* O; int ldc; int pm_mod, pn_mod; size_t gstride; bf16_t* O2;
    __device__ __forceinline__ void operator()(const f32x4 (&acc)[2][2][4][2], const Unit& u, int wr, int wc, int fr, int fq) const {
        const int g = pm_mod ? u.pm / pm_mod : 0;
        const int row0 = (u.pm - g * pm_mod) * BM + wr * 64 + fr;
        const int col0 = (pn_mod ? (u.pn % pn_mod) : u.pn) * BM + wc * 32 + 8 * fq;
        bf16_t* base = O + (size_t)g * gstride;
        bf16_t* base2 = (O2 && g == 2) ? O2 : nullptr;
#pragma unroll
        for (int ai = 0; ai < 2; ++ai)
#pragma unroll
            for (int m = 0; m < 4; ++m) { const size_t ro = (size_t)(row0 + ai * HALF + m * 16) * ldc + col0;
#pragma unroll
                for (int bj = 0; bj < 2; ++bj) { const f32x4 v0 = acc[ai][bj][m][0], v1 = acc[ai][bj][m][1];
                    u32x4 w; w.x = cvt_pk_bf16(v0[0], v0[1]); w.y = cvt_pk_bf16(v0[2], v0[3]); w.z = cvt_pk_bf16(v1[0], v1[1]); w.w = cvt_pk_bf16(v1[2], v1[3]);
                    *(u32x4*)(base + ro + bj * HALF) = w; if (base2) *(u32x4*)(base2 + ro + bj * HALF) = w; } }
    }
};
struct EpiResid {
    static constexpr bool PERM = true, AFTER_DRAIN = false;
    float* X; int ldc; float alpha;
    __device__ __forceinline__ void operator()(const f32x4 (&acc)[2][2][4][2], const Unit& u, int wr, int wc, int fr, int fq) const {
        const int row0 = u.pm * BM + wr * 64 + fr, col0 = u.pn * BM + wc * 32 + 8 * fq;
#pragma unroll
        for (int ai = 0; ai < 2; ++ai)
#pragma unroll
            for (int m = 0; m < 4; ++m) { float* rowp = X + (size_t)(row0 + ai * HALF + m * 16) * ldc + col0;
#pragma unroll
                for (int bj = 0; bj < 2; ++bj) { f32x4* p = (f32x4*)(rowp + bj * HALF); const f32x4 x0 = p[0], x1 = p[1];
                    p[0] = x0 * alpha + acc[ai][bj][m][0]; p[1] = x1 * alpha + acc[ai][bj][m][1]; } }
    }
};
struct EpiSilu {
    static constexpr bool PERM = true, AFTER_DRAIN = false;
    bf16_t* O;
    __device__ __forceinline__ void operator()(const f32x4 (&acc)[2][2][4][2], const Unit& u, int wr, int wc, int fr, int fq) const {
        const int row0 = u.pm * BM + wr * 64 + fr, col0 = (u.pn & 3) * 128 + wc * 32 + 8 * fq;
#pragma unroll
        for (int ai = 0; ai < 2; ++ai)
#pragma unroll
            for (int m = 0; m < 4; ++m) { bf16_t* rowp = O + (size_t)(row0 + ai * HALF + m * 16) * 512 + col0;
                float h[8];
#pragma unroll
                for (int n = 0; n < 2; ++n)
#pragma unroll
                    for (int e = 0; e < 4; ++e) { const float gt = acc[ai][0][m][n][e], up = acc[ai][1][m][n][e]; h[n * 4 + e] = gt / (1.f + __expf(-gt)) * up; }
                u32x4 w; w.x = cvt_pk_bf16(h[0], h[1]); w.y = cvt_pk_bf16(h[2], h[3]); w.z = cvt_pk_bf16(h[4], h[5]); w.w = cvt_pk_bf16(h[6], h[7]);
                *(u32x4*)rowp = w; }
    }
};
struct EpiL1 {
    static constexpr bool PERM = true, AFTER_DRAIN = false;
    bf16_t* O;
    __device__ __forceinline__ void operator()(const f32x4 (&acc)[2][2][4][2], const Unit& u, int wr, int wc, int fr, int fq) const {
        const int row0 = u.pm * BM + wr * 64 + fr, col0 = u.pn * BM + wc * 32 + 8 * fq;
#pragma unroll
        for (int ai = 0; ai < 2; ++ai)
#pragma unroll
            for (int m = 0; m < 4; ++m) { bf16_t* rowp = O + (size_t)(row0 + ai * HALF + m * 16) * 512 + col0;
#pragma unroll
                for (int bj = 0; bj < 2; ++bj) { const int c = col0 + bj * HALF; float h[8];
#pragma unroll
                    for (int n = 0; n < 2; ++n)
#pragma unroll
                        for (int e = 0; e < 4; ++e) { const float v = acc[ai][bj][m][n][e];
                            h[n * 4 + e] = (c < 256) ? 1.f / (1.f + __expf(-v)) : ((c < 352) ? (1.f - 2.f / (1.f + __expf(2.f * v))) : v); }
                    u32x4 w; w.x = cvt_pk_bf16(h[0], h[1]); w.y = cvt_pk_bf16(h[2], h[3]); w.z = cvt_pk_bf16(h[4], h[5]); w.w = cvt_pk_bf16(h[6], h[7]);
                    *(u32x4*)(rowp + bj * HALF) = w; } }
    }
};
template <int KIND> __device__ __forceinline__ void epi_l2(const f32x4 (&acc)[2][2][4][2], bf16_t* O, const bf16_t* VF, const float* pv, int row0, int col0) {
    float pr[2][8];
#pragma unroll
    for (int bj = 0; bj < 2; ++bj)
#pragma unroll
        for (int j = 0; j < 8; ++j) pr[bj][j] = (KIND == 0) ? 0.f : pv[col0 + bj * HALF + j];
#pragma unroll
    for (int ai = 0; ai < 2; ++ai)
#pragma unroll
        for (int m = 0; m < 4; ++m) { const size_t ro = (size_t)(row0 + ai * HALF + m * 16) * 2048 + col0;
#pragma unroll
            for (int bj = 0; bj < 2; ++bj) { float h[8];
#pragma unroll
                for (int n = 0; n < 2; ++n)
#pragma unroll
                    for (int e = 0; e < 4; ++e) h[n * 4 + e] = acc[ai][bj][m][n][e] + pr[bj][n * 4 + e];
                if (KIND == 1) {
#pragma unroll
                    for (int j = 0; j < 8; ++j) { const float x = -h[j]; const float sp = fmaxf(x, 0.f) + __logf(1.f + __expf(-fabsf(x))); h[j] = -__expf(-sp - 0.5f); }
                } else if (KIND == 2) {
#pragma unroll
                    for (int j = 0; j < 8; ++j) h[j] = 1.f / (1.f + __expf(-h[j]));
                } else if (KIND == 3) {
                    const u32x4 vv = *(const u32x4*)(O + ro + bj * HALF), vf = *(const u32x4*)(VF + ro + bj * HALF);
#pragma unroll
                    for (int j = 0; j < 4; ++j) { const unsigned a = vv[j], b = vf[j];
                        const float v0_ = __builtin_bit_cast(float, a << 16), v1_ = __builtin_bit_cast(float, a & 0xffff0000u);
                        const float f0_ = __builtin_bit_cast(float, b << 16), f1_ = __builtin_bit_cast(float, b & 0xffff0000u);
                        h[2 * j] = v0_ + (f0_ - v0_) / (1.f + __expf(-h[2 * j])); h[2 * j + 1] = v1_ + (f1_ - v1_) / (1.f + __expf(-h[2 * j + 1])); }
                }
                u32x4 w; w.x = cvt_pk_bf16(h[0], h[1]); w.y = cvt_pk_bf16(h[2], h[3]); w.z = cvt_pk_bf16(h[4], h[5]); w.w = cvt_pk_bf16(h[6], h[7]);
                *(u32x4*)(O + ro + bj * HALF) = w; } }
}
struct EpiL2 {
    static constexpr bool PERM = true, AFTER_DRAIN = false;
    bf16_t *G, *WD, *AA, *V; const bf16_t* VF; const float *w0, *a0, *v0;
    __device__ __forceinline__ void operator()(const f32x4 (&acc)[2][2][4][2], const Unit& u, int wr, int wc, int fr, int fq) const {
        const int kind = u.pn >> 3;
        const int row0 = u.pm * BM + wr * 64 + fr, col0 = (u.pn & 7) * BM + wc * 32 + 8 * fq;
        if (kind == 0) epi_l2<0>(acc, G, nullptr, nullptr, row0, col0);
        else if (kind == 1) epi_l2<1>(acc, WD, nullptr, w0, row0, col0);
        else if (kind == 2) epi_l2<2>(acc, AA, nullptr, a0, row0, col0);
        else epi_l2<3>(acc, V, VF, v0, row0, col0);
    }
};

template <class Epi, class Sched, bool ALIGN_EPI = false, bool SP2 = false>
__device__ __forceinline__ void gemm_phase(const int wv, PG8_LAS unsigned char* lds, const Gemm g, const Sched& S, const Epi& E) {
#ifdef NO_GEMM
    return;
#endif
    const int tid_o = wv * 64 + lane_id_asm();
    const int tid = tid_o, wid = __builtin_amdgcn_readfirstlane(tid >> 6), lane = tid & 63, wr = wid >> 2, wc = wid & 3, fr = lane & 15, fq = lane >> 4;
    const int K = g.K, nt = K / BK;
    unsigned voffA[2], voffB[2];
#pragma unroll
    for (int i = 0; i < 2; ++i) { int R, C; stage_rc(tid * 16 + i * 8192, R, C); const int Rb = Epi::PERM ? ((R & ~31) + perm32(R & 31)) : R;
        voffA[i] = (unsigned)(R * g.lda + C) * 2u; voffB[i] = (unsigned)(Rb * g.ldb + C) * 2u; }
    const size_t kstep = (size_t)(BK * 2);
    const size_t hstepA = (size_t)HALF * g.lda * 2, hstepB = (size_t)HALF * g.ldb * 2;
    const size_t tstepA = 2 * hstepA, tstepB = 2 * hstepB;
    const unsigned ldsw = (unsigned)wid * 1024u;
    const int aoff = lds_byte(wr * 64 + fr, fq * 8), boff = lds_byte(wc * 32 + fr, fq * 8);
#define PG8_SA(b, h) (((b) * 2 + (h)) * HTB)
#define PG8_SB(b, h) ((4 + (b) * 2 + (h)) * HTB)
#define PG8_STAGE(bufoff, gbase, voff) do { _Pragma("unroll") for (int _i = 0; _i < 2; ++_i) \
        __builtin_amdgcn_global_load_lds((const unsigned*)((const char*)(gbase) + (voff)[_i]), (PG8_LAS unsigned*)(lds + (bufoff) + ldsw + _i * 8192), 16, 0, 0); } while (0)
#define PG8_LDA(dst, b, h) do { _Pragma("unroll") for (int m = 0; m < 4; ++m) _Pragma("unroll") for (int k = 0; k < 2; ++k) dst[m][k] = *(const PG8_LAS bf16x8*)(lds + PG8_SA(b, h) + aoff + m * 2048 + k * 1024); } while (0)
#define PG8_LDB(dst, b, h) do { _Pragma("unroll") for (int n = 0; n < 2; ++n) _Pragma("unroll") for (int k = 0; k < 2; ++k) dst[n][k] = *(const PG8_LAS bf16x8*)(lds + PG8_SB(b, h) + boff + n * 2048 + k * 1024); } while (0)
#define PG8_MMA(ai, bj, At, Bt) do { __builtin_amdgcn_s_setprio(1); _Pragma("unroll") for (int m = 0; m < 4; ++m) _Pragma("unroll") for (int n = 0; n < 2; ++n) _Pragma("unroll") for (int k = 0; k < 2; ++k) \
        acc[ai][bj][m][n] = __builtin_amdgcn_mfma_f32_16x16x32_bf16(Bt[n][k], At[m][k], acc[ai][bj][m][n], 0, 0, 0); __builtin_amdgcn_s_setprio(0); } while (0)
#define PG8_WAIT_V(n) asm volatile("s_waitcnt vmcnt(" #n ")" ::: "memory")
#define PG8_WAIT_L(n) asm volatile("s_waitcnt lgkmcnt(" #n ")" ::: "memory")
#define PG8_BAR __builtin_amdgcn_s_barrier()
#define PG8_SCHED __builtin_amdgcn_sched_barrier(0)
    Unit cur, nxt; int ui = 0;
    if (!S.next(0, cur)) return;
    f32x4 acc[2][2][4][2];
#pragma unroll
    for (int a = 0; a < 2; ++a)
#pragma unroll
        for (int b = 0; b < 2; ++b)
#pragma unroll
            for (int m = 0; m < 4; ++m)
#pragma unroll
                for (int n = 0; n < 2; ++n) acc[a][b][m][n] = (f32x4){0.f, 0.f, 0.f, 0.f};
    bf16x8 At[4][2], B0[2][2], B1[2][2];
    const char* cA = (const char*)g.A + (size_t)cur.pm * tstepA + cur.aoff; const char* cB = (const char*)g.Bt + (size_t)cur.pn * tstepB;
    S.a_ready(cur);
    if constexpr (SP2) {
        PG8_STAGE(PG8_SB(0, 0), cB, voffB); PG8_STAGE(PG8_SB(0, 1), cB + hstepB, voffB); PG8_STAGE(PG8_SA(0, 0), cA, voffA); PG8_STAGE(PG8_SA(0, 1), cA + hstepA, voffA);
        if (wr == 1) PG8_BAR;
        PG8_WAIT_V(2); PG8_BAR;
        PG8_STAGE(PG8_SB(1, 0), cB + kstep, voffB); PG8_STAGE(PG8_SA(1, 0), cA + kstep, voffA); PG8_STAGE(PG8_SB(1, 1), cB + hstepB + kstep, voffB);
        PG8_WAIT_V(6); PG8_BAR;
    } else {
        PG8_STAGE(PG8_SB(0, 0), cB, voffB); PG8_STAGE(PG8_SA(0, 0), cA, voffA); PG8_STAGE(PG8_SB(0, 1), cB + hstepB, voffB); PG8_STAGE(PG8_SA(0, 1), cA + hstepA, voffA);
        if (wr == 1) PG8_BAR;
        PG8_WAIT_V(4); PG8_BAR;
        PG8_STAGE(PG8_SB(1, 0), cB + kstep, voffB); PG8_STAGE(PG8_SA(1, 0), cA + kstep, voffA); PG8_STAGE(PG8_SB(1, 1), cB + hstepB + kstep, voffB);
        PG8_WAIT_V(6); PG8_BAR;
    }
    for (;;) {
        const bool has_next = S.next(ui + 1, nxt);
        const char* nA = has_next ? (const char*)g.A + (size_t)nxt.pm * tstepA + nxt.aoff : cA; const char* nB = has_next ? (const char*)g.Bt + (size_t)nxt.pn * tstepB : cB;
        for (int t = 0; t < nt; t += 2) {
            const bool last = (t == nt - 2);
            const char* a1 = cA + (size_t)(t + 1) * kstep;
            const char* a2 = last ? nA : cA + (size_t)(t + 2) * kstep; const char* b2 = last ? nB : cB + (size_t)(t + 2) * kstep;
            const char* a3 = a2 + kstep; const char* b3 = b2 + kstep;
            if (last && has_next) S.a_ready(nxt);
            if constexpr (SP2) {
            PG8_LDB(B0, 0, 0); PG8_LDB(B1, 0, 1); PG8_SCHED; PG8_LDA(At, 0, 0); PG8_STAGE(PG8_SA(1, 1), a1 + hstepA, voffA);
            PG8_WAIT_V(8); PG8_WAIT_L(0); PG8_BAR; PG8_MMA(0, 0, At, B0); PG8_MMA(0, 1, At, B1); PG8_BAR; PG8_SCHED;
            PG8_LDA(At, 0, 1); PG8_STAGE(PG8_SB(0, 0), b2, voffB); PG8_STAGE(PG8_SB(0, 1), b2 + hstepB, voffB); PG8_STAGE(PG8_SA(0, 0), a2, voffA);
            PG8_WAIT_V(8); PG8_WAIT_L(0); PG8_BAR; PG8_MMA(1, 0, At, B0); PG8_MMA(1, 1, At, B1); PG8_BAR; PG8_SCHED;
            PG8_LDB(B0, 1, 0); PG8_LDB(B1, 1, 1); PG8_SCHED; PG8_LDA(At, 1, 0); PG8_STAGE(PG8_SA(0, 1), a2 + hstepA, voffA);
            PG8_WAIT_V(8); PG8_WAIT_L(0); PG8_BAR; PG8_MMA(0, 0, At, B0); PG8_MMA(0, 1, At, B1); PG8_BAR; PG8_SCHED;
            PG8_LDA(At, 1, 1); PG8_STAGE(PG8_SB(1, 0), b3, voffB); PG8_STAGE(PG8_SB(1, 1), b3 + hstepB, voffB); PG8_STAGE(PG8_SA(1, 0), a3, voffA);
            PG8_WAIT_V(8); PG8_WAIT_L(0); PG8_BAR; PG8_MMA(1, 0, At, B0); PG8_MMA(1, 1, At, B1); PG8_BAR; PG8_SCHED;
            } else {
            PG8_LDB(B0, 0, 0); PG8_SCHED; PG8_LDA(At, 0, 0); PG8_STAGE(PG8_SA(1, 1), a1 + hstepA, voffA);
            PG8_WAIT_L(8); PG8_BAR; PG8_WAIT_L(0); PG8_MMA(0, 0, At, B0); PG8_BAR; PG8_SCHED;
            PG8_LDB(B1, 0, 1); PG8_STAGE(PG8_SB(0, 0), b2, voffB);
            PG8_BAR; PG8_WAIT_L(0); PG8_MMA(0, 1, At, B1); PG8_BAR;
            PG8_LDA(At, 0, 1); PG8_STAGE(PG8_SA(0, 0), a2, voffA);
            PG8_BAR; PG8_WAIT_L(0); PG8_MMA(1, 0, At, B0); PG8_BAR; PG8_SCHED;
            PG8_STAGE(PG8_SB(0, 1), b2 + hstepB, voffB);
            PG8_WAIT_V(6); PG8_BAR; PG8_MMA(1, 1, At, B1); PG8_BAR;
            PG8_LDB(B0, 1, 0); PG8_SCHED; PG8_LDA(At, 1, 0); PG8_STAGE(PG8_SA(0, 1), a2 + hstepA, voffA);
            PG8_WAIT_L(8); PG8_BAR; PG8_WAIT_L(0); PG8_MMA(0, 0, At, B0); PG8_BAR; PG8_SCHED;
            PG8_LDB(B1, 1, 1); PG8_STAGE(PG8_SB(1, 0), b3, voffB);
            PG8_BAR; PG8_WAIT_L(0); PG8_MMA(0, 1, At, B1); PG8_BAR;
            PG8_LDA(At, 1, 1); PG8_STAGE(PG8_SA(1, 0), a3, voffA);
            PG8_BAR; PG8_WAIT_L(0); PG8_MMA(1, 0, At, B0); PG8_BAR; PG8_SCHED;
            PG8_STAGE(PG8_SB(1, 1), b3 + hstepB, voffB);
            PG8_WAIT_V(6); PG8_BAR; PG8_MMA(1, 1, At, B1); PG8_BAR;
            }
        }
        if constexpr (ALIGN_EPI) { if (wr == 0) PG8_BAR; }
        if constexpr (!Epi::AFTER_DRAIN) { E(acc, cur, wr, wc, fr, fq); S.done(cur); }
        if (!has_next) break;
#pragma unroll
        for (int a = 0; a < 2; ++a)
#pragma unroll
            for (int b = 0; b < 2; ++b)
#pragma unroll
                for (int m = 0; m < 4; ++m)
#pragma unroll
                    for (int n = 0; n < 2; ++n) acc[a][b][m][n] = (f32x4){0.f, 0.f, 0.f, 0.f};
        cur = nxt; cA = nA; cB = nB; ++ui;
        if constexpr (ALIGN_EPI) { if (wr == 1) PG8_BAR; }
    }
    PG8_WAIT_V(0);
    if constexpr (!ALIGN_EPI) { if (wr == 0) PG8_BAR; }
    PG8_BAR;
    if constexpr (Epi::AFTER_DRAIN) { E.fused(acc, cur, wr, wc, fr, fq, lds, wid, lane); S.done(cur); }
#undef PG8_SA
#undef PG8_SB
#undef PG8_STAGE
#undef PG8_LDA
#undef PG8_LDB
#undef PG8_MMA
#undef PG8_WAIT_V
#undef PG8_WAIT_L
#undef PG8_BAR
#undef PG8_SCHED
}
}

#define XB_TMO      128
#define XB_XCNT(j)  (256  + 64 * (j))
#define XB_XSUB(j)  (1280 + 64 * (j))
#define XB_XGEN(j)  (2304 + 64 * (j))
#define XB_TOP      3328
#define XB_TOPGEN   3392
#define XCD_BAR_WORDS 3456
#define XB_SPIN_CAP (1u << 18)

__device__ __forceinline__ unsigned xb_ld(unsigned* p)              { return __hip_atomic_load(p, __ATOMIC_RELAXED, __HIP_MEMORY_SCOPE_AGENT); }
__device__ __forceinline__ unsigned xb_add(unsigned* p, unsigned v) { return __hip_atomic_fetch_add(p, v, __ATOMIC_RELAXED, __HIP_MEMORY_SCOPE_AGENT); }
__device__ __forceinline__ unsigned xb_xcc_id() { return (unsigned)__builtin_amdgcn_s_getreg((3 << 11) | 20) & 0xFu; }
#define XB_SPIN(cond, bar) do { unsigned _sp = 0; while (cond) { __builtin_amdgcn_s_sleep(1); \
    if ((++_sp & 255u) == 0u) { if (xb_ld(&(bar)[XB_TMO])) break; if (_sp > XB_SPIN_CAP) { atomicAdd(&(bar)[XB_TMO], 1u); break; } } } } while (0)

struct XcdBarrier {
    unsigned* bar; unsigned x;
    volatile LAS unsigned* st;
};

__device__ __forceinline__ XcdBarrier xcd_barrier_post(unsigned* bar, volatile LAS unsigned* st, const bool t0) {
    XcdBarrier b; b.bar = bar; b.x = xb_xcc_id(); b.st = st;
    if (t0) (void)xb_add(&bar[XB_XCNT(b.x)], 1u);
    return b;
}
__device__ __forceinline__ void xcd_barrier_complete(unsigned* bar, unsigned x, unsigned& nloc, unsigned& nx) {
    const unsigned G = gridDim.x * gridDim.y * gridDim.z;
    unsigned sum, cnt, mine, sp = 0u;
    for (;;) {
        sum = 0u; cnt = 0u; mine = 0u;
#pragma unroll
        for (unsigned j = 0; j < 16; ++j) { const unsigned c = xb_ld(&bar[XB_XCNT(j)]); sum += c; cnt += (c > 0u) ? 1u : 0u; mine = (j == x) ? c : mine; }
        if (sum == G) break;
        __builtin_amdgcn_s_sleep(1);
        if ((++sp & 255u) == 0u) { if (xb_ld(&bar[XB_TMO])) break; if (sp > XB_SPIN_CAP) { atomicAdd(&bar[XB_TMO], 1u); break; } }
    }
    nloc = mine > 0u ? mine : 1u; nx = cnt > 0u ? cnt : 1u;
}

__device__ __forceinline__ void xcd_barrier(const XcdBarrier& b, const bool t0) {
    asm volatile("s_waitcnt vmcnt(0)" ::: "memory");
    __syncthreads();
    if (t0) {
        unsigned* bar = b.bar;
        __builtin_amdgcn_s_waitcnt(0);
        unsigned nloc = b.st[0], nx = b.st[1];
        if (nloc == 0u) { xcd_barrier_complete(bar, b.x, nloc, nx); b.st[0] = nloc; b.st[1] = nx; }
        const unsigned old = xb_add(&bar[XB_XSUB(b.x)], 1u);
        const unsigned gen = old / nloc;
        if (old + 1u == (gen + 1u) * nloc) {
            __builtin_amdgcn_fence(__ATOMIC_RELEASE, "agent");
            asm volatile("s_waitcnt vmcnt(0)" ::: "memory");
            const unsigned og = xb_add(&bar[XB_TOP], 1u);
            const unsigned tg = og / nx;
            if (og + 1u == (tg + 1u) * nx) xb_add(&bar[XB_TOPGEN], 1u);
            else XB_SPIN(xb_ld(&bar[XB_TOPGEN]) == tg, bar);
            __builtin_amdgcn_fence(__ATOMIC_ACQUIRE, "agent");
            xb_add(&bar[XB_XGEN(b.x)], 1u);
            asm volatile("s_waitcnt vmcnt(0)" ::: "memory");
        } else {
            XB_SPIN(xb_ld(&bar[XB_XGEN(b.x)]) == gen, bar);
            __builtin_amdgcn_fence(__ATOMIC_ACQUIRE, "agent");
            asm volatile("s_waitcnt vmcnt(0)" ::: "memory");
        }
    }
    __syncthreads();
}

constexpr int NWAVES = 8, NTHR = 512;
constexpr int NB = 4, SEQ = 4096, T_ = NB * SEQ, D_ = 2048;
constexpr int EVEN_IN = 7176, ZW = 7168;
constexpr float DN_ALPHA = 1.6817928305074290f;
constexpr float LN_EPS = 1e-5f;
constexpr int MOE_ROWS = 40960, MOE_TILES = MOE_ROWS / 256;

constexpr size_t MiB = 1u << 20;
constexpr size_t WS_CTL = 0, CTL_ZERO_BYTES = 1 * MiB;
constexpr size_t WS_IG = 1 * MiB, WS_FG = WS_IG + 256 * 1024, WS_KPART = 2 * MiB;
constexpr size_t WS_TOKE = 3 * MiB, WS_TOKR = WS_TOKE + 128 * 1024, WS_TOKG = WS_TOKR + 128 * 1024, WS_SLOT = WS_TOKG + 128 * 1024;
constexpr size_t WS_WIN = 16 * MiB;
constexpr size_t WS_WOUT = 72 * MiB;
constexpr size_t WS_WRKV = 88 * MiB;
constexpr size_t WS_WO = 136 * MiB;
constexpr size_t WS_WL1 = 152 * MiB;
constexpr size_t WS_WL2 = 160 * MiB;
constexpr size_t WS_WGU = 168 * MiB;
constexpr size_t WS_WDN = 680 * MiB;
constexpr size_t WS_XB = 936 * MiB;
constexpr size_t WS_VF = 1000 * MiB;
constexpr size_t WS_R = 1064 * MiB;
constexpr size_t WS_Z = WS_R;
constexpr size_t WS_QKB = WS_R + 224 * MiB;
constexpr size_t WS_VAT = WS_R + 288 * MiB;
constexpr size_t WS_YE = WS_R + 320 * MiB;
constexpr size_t WS_HB = WS_R + 384 * MiB;
constexpr size_t WS_XRKV = WS_R;
constexpr size_t WS_XC = WS_R + 192 * MiB;
constexpr size_t WS_RKV = WS_R + 320 * MiB;
constexpr size_t WS_L1 = WS_R + 512 * MiB;
constexpr size_t WS_G = WS_R + 528 * MiB;
constexpr size_t WS_WD = WS_R + 592 * MiB;
constexpr size_t WS_AA = WS_R + 656 * MiB;
constexpr size_t WS_YO = WS_R + 720 * MiB;
constexpr size_t WS_XS = WS_R;
constexpr size_t WS_HID = WS_R + 160 * MiB;
constexpr size_t WS_YS = WS_R + 200 * MiB;
constexpr size_t WS_END = WS_R + 784 * MiB;

constexpr int CW_BAR = 4096;
constexpr int CW_CNT = 16384;

constexpr int RING_BYTES = 131072;
constexpr int MISC_OFF = RING_BYTES;
constexpr int LDS_BYTES = 147456;

typedef unsigned gu32;

struct Args { const float* in[39]; float* out; unsigned char* ws; int ph_lo, ph_hi; };
#define CAS __attribute__((address_space(4)))
typedef const CAS Args* ArgsP;
__device__ __forceinline__ ArgsP get_args() { ArgsP p = (ArgsP)__builtin_amdgcn_kernarg_segment_ptr(); asm volatile("" : "+s"(p)); return p; }

__device__ __forceinline__ void tr_item(const float* W, int ldw, int k0, int n0, bf16* WT, int ldt, int drow0, int dcol0, LAS float* scr, int lane, const float* kscale) {
    const int r = lane >> 3, c4 = lane & 7;
    f32x4 v[8];
#pragma unroll
    for (int i = 0; i < 8; ++i) v[i] = __builtin_nontemporal_load((const f32x4*)(W + (size_t)(k0 + 8 * i + r) * ldw + n0 + 4 * c4));
    if (kscale) {
#pragma unroll
        for (int i = 0; i < 8; ++i) v[i] = v[i] * kscale[k0 + 8 * i + r]; }
#pragma unroll
    for (int i = 0; i < 8; ++i) { LAS float* d = scr + (8 * i + r) * 33 + 4 * c4; d[0] = v[i].x; d[1] = v[i].y; d[2] = v[i].z; d[3] = v[i].w; }
    LDS_WAIT(); asm volatile("" ::: "memory");
    const int c = lane & 7;
#pragma unroll
    for (int j = 0; j < 4; ++j) { const int n = (lane >> 3) + 8 * j; const LAS float* s = scr + (8 * c) * 33 + n;
        v4u o; o.x = pk2(s[0 * 33], s[1 * 33]); o.y = pk2(s[2 * 33], s[3 * 33]); o.z = pk2(s[4 * 33], s[5 * 33]); o.w = pk2(s[6 * 33], s[7 * 33]);
        *(v4u*)(WT + (size_t)(drow0 + n) * ldt + dcol0 + 8 * c) = o; }
    LDS_WAIT(); asm volatile("" ::: "memory");
}

__device__ __forceinline__ void prologue(const int wv, LAS unsigned char* lds) {
    const ArgsP a = get_args();
#ifdef NO_PROL
    return;
#endif
    OPAQUE_TID(); const int lane = tid & 63, wave = tid >> 6;
    unsigned char* ws = a->ws;
    LAS float* scr = (LAS float*)(lds + wave * 16384);
    const int gw = blockIdx.x * NWAVES + wave, NGW = gridDim.x * NWAVES;
    constexpr int I0 = 2 * 7168, I1 = 2 * 2048, I2 = 2 * 4 * 2048, I3 = 2 * 32 * 16, I4 = 4 * 32 * 1536;
    constexpr int NITEMS = I0 + I1 + I2 + I3 + I4;
    for (int it = gw; it < NITEMS; it += NGW) {
        int r = it;
        if (r < I0) { const int e = r / 7168, rr = r % 7168, kb = rr / 224, nb = rr % 224;
            tr_item(a->in[1] + (size_t)e * 2048 * EVEN_IN, EVEN_IN, 64 * kb, 32 * nb, (bf16*)(ws + WS_WIN) + (size_t)e * ZW * 2048, 2048, 32 * nb, 64 * kb, scr, lane, nullptr); continue; } r -= I0;
        if (r < I1) { const int e = r / 2048, rr = r % 2048, kb = rr / 64, nb = rr % 64;
            tr_item(a->in[6] + (size_t)e * 2048 * 2048, 2048, 64 * kb, 32 * nb, (bf16*)(ws + WS_WOUT) + (size_t)e * 2048 * 2048, 2048, 32 * nb, 64 * kb, scr, lane, nullptr); continue; } r -= I1;
        if (r < I2) { const int o = r / 8192, rr = r % 8192, mat = rr / 2048, q = rr % 2048, kb = q / 64, nb = q % 64;
            const float* src = (mat == 0 ? a->in[8] : mat == 1 ? a->in[9] : mat == 2 ? a->in[10] : a->in[11]) + (size_t)o * 2048 * 2048;
            bf16* dst = (mat < 3) ? (bf16*)(ws + WS_WRKV) + (size_t)o * 3 * 2048 * 2048 + (size_t)mat * 2048 * 2048 : (bf16*)(ws + WS_WO) + (size_t)o * 2048 * 2048;
            tr_item(src, 2048, 64 * kb, 32 * nb, dst, 2048, 32 * nb, 64 * kb, scr, lane, nullptr); continue; } r -= I2;
        if (r < I3) { const int o = r / 512, rr = r % 512, kb = rr / 16, nb = rr % 16;
            const float* src; int ldw, n0, drow0, mu;
            if (nb < 8) { src = a->in[18] + (size_t)o * 2048 * 256; ldw = 256; n0 = 32 * nb; drow0 = 32 * nb; mu = 5; }
            else if (nb < 11) { src = a->in[13] + (size_t)o * 2048 * 96; ldw = 96; n0 = 32 * (nb - 8); drow0 = 256 + n0; mu = 1; }
            else if (nb < 14) { src = a->in[16] + (size_t)o * 2048 * 96; ldw = 96; n0 = 32 * (nb - 11); drow0 = 352 + n0; mu = 4; }
            else { if (o == 0) continue; src = a->in[26]; ldw = 64; n0 = 32 * (nb - 14); drow0 = 448 + n0; mu = 3; }
            bf16* dst = (bf16*)(ws + WS_WL1) + (size_t)o * 512 * 4096;
            tr_item(src, ldw, 64 * kb, n0, dst, 4096, drow0, 64 * kb, scr, lane, nullptr);
            tr_item(src, ldw, 64 * kb, n0, dst, 4096, drow0, 2048 + 64 * kb, scr, lane, a->in[7] + (size_t)(o * 6 + mu) * 2048);
            continue; } r -= I3;
        { const int le = r / 1536, rr = r % 1536, mat = rr / 512, q = rr % 512;
            if (mat < 2) { const int kb = q / 16, nb = q % 16, n0 = 32 * nb;
                tr_item((mat == 0 ? a->in[36] : a->in[37]) + (size_t)le * 2048 * 512, 512, 64 * kb, n0, (bf16*)(ws + WS_WGU) + (size_t)le * 1024 * 2048, 2048,
                        (n0 / 128) * 256 + (n0 % 128) + (mat == 1 ? 128 : 0), 64 * kb, scr, lane, nullptr); }
            else { const int kb = q / 64, nb = q % 64;
                tr_item(a->in[38] + (size_t)le * 512 * 2048, 2048, 64 * kb, 32 * nb, (bf16*)(ws + WS_WDN) + (size_t)le * 2048 * 512, 512, 32 * nb, 64 * kb, scr, lane, nullptr); }
        }
    }
    const int gt = blockIdx.x * NTHR + tid, NGT = gridDim.x * NTHR;
    for (int idx = gt; idx < 2 * 32 * 8192; idx += NGT) {
        const int o = idx / (32 * 8192), rem = idx % (32 * 8192), kg = rem / 8192, n = rem % 8192, mat = n / 2048, nn = n % 2048;
        float v[8];
#pragma unroll
        for (int j = 0; j < 8; ++j) { const int k = 8 * kg + j; float x = 0.f;
            if (mat == 0) x = a->in[19][((size_t)o * 256 + k) * 2048 + nn];
            else if (mat == 1) { if (k < 96) x = a->in[14][((size_t)o * 96 + k) * 2048 + nn]; }
            else if (mat == 2) { if (k >= 96 && k < 192) x = a->in[17][((size_t)o * 96 + (k - 96)) * 2048 + nn]; }
            else { if (o == 1 && k >= 192) x = a->in[27][(size_t)(k - 192) * 2048 + nn]; }
            v[j] = x; }
        v4u w; w.x = pk2(v[0], v[1]); w.y = pk2(v[2], v[3]); w.z = pk2(v[4], v[5]); w.w = pk2(v[6], v[7]);
        *(v4u*)((bf16*)(ws + WS_WL2) + ((size_t)o * 8192 + n) * 256 + 8 * kg) = w;
    }
    for (int i = gt; i < T_ * D_ / 4; i += NGT) { const f32x4 v = ((const f32x4*)a->in[0])[i]; ((f32x4*)a->out)[i] = v;
        v2u w; w.x = pk2(v.x, v.y); w.y = pk2(v.z, v.w); ((v2u*)(ws + WS_XB))[i] = w; }
}

__device__ __forceinline__ void even_prep(const int wv, int e, LAS unsigned char* lds, int u) {
    const ArgsP a = get_args();
#ifdef NO_EPREP
    return;
#endif
    OPAQUE_TID(); const int lane = tid & 63, wave = tid >> 6;
    unsigned char* ws = a->ws;
    bf16* Z = (bf16*)(ws + WS_Z);
    const int m0 = 64 * u, b = u >> 6, ch = u & 63, t0 = ch * 64;
    { LAS float* cst = (LAS float*)lds; LAS float* snt = cst + 1024;
#pragma unroll 1
      for (int q = tid; q < 1024; q += NTHR) { const int r = q >> 4, i = q & 15; const float inv = exp2f(-(float)i * (18.931568569324174f / 16.f));
          float sn_, cs_; sincosf((float)(t0 + r) * inv, &sn_, &cs_); cst[q] = cs_; snt[q] = sn_; }
      __syncthreads();
      const int row = tid >> 3, head = tid & 7;
      float cs[16], sn[16];
#pragma unroll
      for (int i = 0; i < 4; ++i) { const f32x4 c4 = *(const LAS f32x4*)(cst + row * 16 + 4 * i), s4 = *(const LAS f32x4*)(snt + row * 16 + 4 * i);
          cs[4 * i] = c4.x; cs[4 * i + 1] = c4.y; cs[4 * i + 2] = c4.z; cs[4 * i + 3] = c4.w; sn[4 * i] = s4.x; sn[4 * i + 1] = s4.y; sn[4 * i + 2] = s4.z; sn[4 * i + 3] = s4.w; }
#pragma unroll 1
      for (int qk = 0; qk < 2; ++qk) { v4u* p = (v4u*)(Z + (size_t)(m0 + row) * ZW + qk * 1024 + head * 128);
        v4u w0 = p[0], w1 = p[1], w2 = p[2], w3 = p[3]; unsigned x1[8] = {w0.x, w0.y, w0.z, w0.w, w1.x, w1.y, w1.z, w1.w}, x2[8] = {w2.x, w2.y, w2.z, w2.w, w3.x, w3.y, w3.z, w3.w};
        unsigned o1[8], o2[8];
#pragma unroll
        for (int j = 0; j < 8; ++j) { const float a0 = bflo(x1[j]), a1 = bfhi(x1[j]), b0 = bflo(x2[j]), b1 = bfhi(x2[j]);
            o1[j] = pk2(a0 * cs[2 * j] - b0 * sn[2 * j], a1 * cs[2 * j + 1] - b1 * sn[2 * j + 1]);
            o2[j] = pk2(b0 * cs[2 * j] + a0 * sn[2 * j], b1 * cs[2 * j + 1] + a1 * sn[2 * j + 1]); }
        p[0] = (v4u){o1[0], o1[1], o1[2], o1[3]}; p[1] = (v4u){o1[4], o1[5], o1[6], o1[7]}; p[2] = (v4u){o2[0], o2[1], o2[2], o2[3]}; p[3] = (v4u){o2[4], o2[5], o2[6], o2[7]}; }
    }
    VM_WAIT(); __syncthreads();
    { LAS float* red = (LAS float*)lds;
      const int cg = tid & 127, rq = tid >> 7; float s[8] = {0, 0, 0, 0, 0, 0, 0, 0};
      for (int r = 0; r < 16; ++r) { const v4u w = *(const v4u*)(Z + (size_t)(m0 + rq * 16 + r) * ZW + 1024 + cg * 8);
          s[0] += bflo(w.x); s[1] += bfhi(w.x); s[2] += bflo(w.y); s[3] += bfhi(w.y); s[4] += bflo(w.z); s[5] += bfhi(w.z); s[6] += bflo(w.w); s[7] += bfhi(w.w); }
#pragma unroll
      for (int j = 0; j < 8; ++j) red[rq * 1024 + cg * 8 + j] = s[j];
      __syncthreads();
      if (tid < 256) { f32x4 t = {0, 0, 0, 0};
#pragma unroll
          for (int q = 0; q < 4; ++q) { const f32x4 v = *(const LAS f32x4*)(red + q * 1024 + tid * 4); t += v; }
          const int c = tid * 4, h = c >> 7, d = c & 127;
          *(f32x4*)((float*)(ws + WS_KPART) + ((size_t)((b * 8 + h) * 64 + ch)) * 128 + d) = t; }
      __syncthreads();
    }
    { LAS bf16* tile = (LAS bf16*)lds;
      bf16* VAT = (bf16*)(ws + WS_VAT);
      for (int p = 0; p < 4; ++p) {
          { const int r = tid >> 3, seg = tid & 7; const v4u* src = (const v4u*)(Z + (size_t)(m0 + r) * ZW + 2048 + 256 * p + 32 * seg);
#pragma unroll
            for (int j = 0; j < 4; ++j) *(LAS v4u*)(tile + r * 264 + 32 * seg + 8 * j) = src[j]; }
          __syncthreads();
          { const int c = tid & 255, rh = tid >> 8; unsigned w[16];
#pragma unroll
            for (int j = 0; j < 16; ++j) { const unsigned lo = tile[(32 * rh + 2 * j) * 264 + c], hi = tile[(32 * rh + 2 * j + 1) * 264 + c]; w[j] = lo | (hi << 16); }
            const int col = 256 * p + c, h = col >> 7, d = col & 127;
            v4u* dst = (v4u*)(VAT + ((size_t)((b * 8 + h) * 128 + d)) * SEQ + t0 + 32 * rh);
#pragma unroll
            for (int j = 0; j < 4; ++j) dst[j] = (v4u){w[4 * j], w[4 * j + 1], w[4 * j + 2], w[4 * j + 3]}; }
          __syncthreads();
      }
    }
    { const int cg = tid & 255, rh = tid >> 8; const int c0 = 8 * cg;
      const float* cw = a->in[3] + (size_t)e * 4 * 2048; const float* cb = a->in[4] + (size_t)e * 2048;
      float w[4][8], bias[8];
#pragma unroll
      for (int j = 0; j < 4; ++j)
#pragma unroll
          for (int i = 0; i < 8; ++i) w[j][i] = cw[j * 2048 + c0 + i];
#pragma unroll
      for (int i = 0; i < 8; ++i) bias[i] = cb[c0 + i];
      float win[3][8];
#pragma unroll
      for (int j = 0; j < 3; ++j) { const int tt = t0 + 32 * rh - 3 + j;
          v4u x = {0, 0, 0, 0}; if (tt >= 0) x = *(const v4u*)(Z + (size_t)(b * SEQ + tt) * ZW + 3072 + c0);
          win[j][0] = bflo(x.x); win[j][1] = bfhi(x.x); win[j][2] = bflo(x.y); win[j][3] = bfhi(x.y); win[j][4] = bflo(x.z); win[j][5] = bfhi(x.z); win[j][6] = bflo(x.w); win[j][7] = bfhi(x.w); }
      bf16* QKB = (bf16*)(ws + WS_QKB);
      for (int r = 0; r < 32; ++r) { const int m = m0 + 32 * rh + r;
          const v4u x = *(const v4u*)(Z + (size_t)m * ZW + 3072 + c0);
          float cur[8] = {bflo(x.x), bfhi(x.x), bflo(x.y), bfhi(x.y), bflo(x.z), bfhi(x.z), bflo(x.w), bfhi(x.w)}; float o[8];
#pragma unroll
          for (int i = 0; i < 8; ++i) { const float v = bias[i] + w[0][i] * win[0][i] + w[1][i] * win[1][i] + w[2][i] * win[2][i] + w[3][i] * cur[i]; o[i] = v / (1.f + __expf(-v));
              win[0][i] = win[1][i]; win[1][i] = win[2][i]; win[2][i] = cur[i]; }
          *(v4u*)(QKB + (size_t)m * 2048 + c0) = (v4u){pk2(o[0], o[1]), pk2(o[2], o[3]), pk2(o[4], o[5]), pk2(o[6], o[7])}; }
    }
    { LAS float* wg = (LAS float*)lds;
      const float* Win = a->in[1] + (size_t)e * 2048 * EVEN_IN;
      for (int i = tid; i < 2048 * 2; i += NTHR) { const int k = i >> 1, hf = i & 1; *(LAS f32x4*)(wg + k * 8 + hf * 4) = *(const f32x4*)(Win + (size_t)k * EVEN_IN + ZW + hf * 4); }
      __syncthreads();
      const float* gb = a->in[2] + e * 8;
      for (int rr = 0; rr < 8; ++rr) { const int row = wave * 8 + rr, m = m0 + row; const f32x4* xr = (const f32x4*)(a->out + (size_t)m * D_) + lane;
          float acc[8] = {0, 0, 0, 0, 0, 0, 0, 0};
#pragma unroll 2
          for (int j = 0; j < 8; ++j) { const f32x4 xv = xr[64 * j]; const int k0 = 4 * lane + 256 * j;
#pragma unroll
              for (int i = 0; i < 4; ++i) { const f32x4 wa = *(const LAS f32x4*)(wg + (k0 + i) * 8), wb = *(const LAS f32x4*)(wg + (k0 + i) * 8 + 4); const float xx = xv[i];
                  acc[0] += xx * wa.x; acc[1] += xx * wa.y; acc[2] += xx * wa.z; acc[3] += xx * wa.w; acc[4] += xx * wb.x; acc[5] += xx * wb.y; acc[6] += xx * wb.z; acc[7] += xx * wb.w; } }
#pragma unroll
          for (int j = 0; j < 8; ++j) acc[j] = wave_sum(acc[j]);
          if (lane < 4) { const int h = lane; float ip = 0.f, fp = 0.f;
#pragma unroll
              for (int j = 0; j < 4; ++j) { if (j == h) { ip = acc[j]; fp = acc[4 + j]; } }
              ip += gb[h]; fp += gb[4 + h];
              const float lf = -(fmaxf(-fp, 0.f) + __logf(1.f + __expf(-fabsf(fp))));
              ((float*)(ws + WS_IG))[(size_t)(b * 4 + h) * SEQ + t0 + row] = ip; ((float*)(ws + WS_FG))[(size_t)(b * 4 + h) * SEQ + t0 + row] = lf; } }
      __syncthreads();
    }
}

constexpr int AT_KSTR = 136, AT_VSTR = 72;
constexpr int AT_K_OFF = 0, AT_V_OFF = 64 * AT_KSTR * 2, AT_KM_OFF = AT_V_OFF + 128 * AT_VSTR * 2, AT_GATE_OFF = AT_KM_OFF + 16 * 128 * 4,
              AT_SEL_OFF = AT_GATE_OFF + 128 * 16 * 4, AT_TL_OFF = AT_SEL_OFF + 128 * 4, AT_END = AT_TL_OFF + 80 * 4;

__device__ __forceinline__ void attn_unit(const int wv, LAS unsigned char* lds, int b, int h, int qt) {
    const ArgsP a = get_args();
#ifdef NO_ATTN
    return;
#endif
    OPAQUE_TID(); const int lane = tid & 63, wave = __builtin_amdgcn_readfirstlane(tid >> 6), fr = lane & 15, fq = lane >> 4;
    unsigned char* ws = a->ws;
    const bf16* Z = (const bf16*)(ws + WS_Z);
    const bf16* VAT = (const bf16*)(ws + WS_VAT) + (size_t)(b * 8 + h) * 128 * SEQ;
    const int qb = qt >> 1, q0 = 128 * qt;
    LAS bf16* Kt = (LAS bf16*)(lds + AT_K_OFF); LAS bf16* Vt = (LAS bf16*)(lds + AT_V_OFF);
    LAS float* km = (LAS float*)(lds + AT_KM_OFF); LAS float* gate = (LAS float*)(lds + AT_GATE_OFF);
    LAS unsigned* sel = (LAS unsigned*)(lds + AT_SEL_OFF); LAS int* tl = (LAS int*)(lds + AT_TL_OFF);
    for (int i = tid; i < qb * 128; i += NTHR) { const int n = i >> 7, d = i & 127; const float* kp = (const float*)(ws + WS_KPART) + ((size_t)((b * 8 + h) * 64 + 4 * n)) * 128 + d;
        km[i] = (kp[0] + kp[128] + kp[256] + kp[384]) * (1.f / 256.f); }
    __syncthreads();
    { const int ql = tid >> 2, part = tid & 3; const v4u* qp = (const v4u*)(Z + (size_t)(b * SEQ + q0 + ql) * ZW + h * 128);
      if (part < qb) { float g[4] = {0, 0, 0, 0};
          for (int c = 0; c < 16; ++c) { const v4u w = qp[c]; const float qv[8] = {bflo(w.x), bfhi(w.x), bflo(w.y), bfhi(w.y), bflo(w.z), bfhi(w.z), bflo(w.w), bfhi(w.w)};
#pragma unroll
              for (int jj = 0; jj < 4; ++jj) { const int n = part + 4 * jj; if (n < qb) { const LAS float* kk = km + n * 128 + c * 8;
#pragma unroll
                  for (int i = 0; i < 8; ++i) g[jj] += qv[i] * kk[i]; } } }
#pragma unroll
          for (int jj = 0; jj < 4; ++jj) { const int n = part + 4 * jj; if (n < qb) gate[ql * 16 + n] = g[jj]; } }
    }
    __syncthreads();
    if (tid < 128) { unsigned m = 0;
        if (qb <= 3) m = (1u << qb) - 1u;
        else { for (int r = 0; r < 3; ++r) { float best = -3.0e38f; int bi = 0; for (int n = 0; n < qb; ++n) { const float g = gate[tid * 16 + n]; if (!((m >> n) & 1u) && g > best) { best = g; bi = n; } } m |= 1u << bi; } }
        sel[tid] = m; }
    __syncthreads();
    if (tid == 0) { unsigned um = 0; for (int i = 0; i < 128; ++i) um |= sel[i];
        int nt = 0; const int nown = (qt & 1) ? 4 : 2;
        for (int j = 0; j < nown; ++j) tl[1 + nt++] = (4 * qb + j) | (1 << 16);
        for (int n = 0; n < qb; ++n) if ((um >> n) & 1u) for (int j = 0; j < 4; ++j) tl[1 + nt++] = 4 * n + j;
        tl[0] = nt; }
    __syncthreads();
    const int ntile = tl[0];
    const unsigned mysel = sel[16 * wave + fr];
    unsigned wsel = mysel;
#pragma unroll
    for (int o = 1; o < 16; o <<= 1) wsel |= __shfl_xor(wsel, o);
    bf16x8 qf[4];
    { const v4u* qp = (const v4u*)(Z + (size_t)(b * SEQ + q0 + 16 * wave + fr) * ZW + h * 128);
#pragma unroll
      for (int kc = 0; kc < 4; ++kc) qf[kc] = __builtin_bit_cast(bf16x8, qp[kc * 4 + fq]); }
    f32x4 o[8];
#pragma unroll
    for (int i = 0; i < 8; ++i) o[i] = (f32x4){0.f, 0.f, 0.f, 0.f};
    float mrun = -INFINITY, lrun = 0.f;
    const float sc = 0.08838834764831845f * 1.4426950408889634f;
    const int qabs = q0 + 16 * wave + fr;
    v4u kr[2], vr[2];
    auto gload = [&](int ti) { const int kt = tl[1 + ti] & 0xffff; const int key0 = 64 * kt;
        const v4u* kp = (const v4u*)(Z + (size_t)(b * SEQ + key0 + (tid >> 3)) * ZW + 1024 + h * 128) + (tid & 7) * 2; kr[0] = kp[0]; kr[1] = kp[1];
        const v4u* vp = (const v4u*)(VAT + (size_t)(tid >> 2) * SEQ + key0) + (tid & 3) * 2; vr[0] = vp[0]; vr[1] = vp[1]; };
    auto lstore = [&]() { LAS v4u* kd = (LAS v4u*)(Kt + (tid >> 3) * AT_KSTR + (tid & 7) * 16); kd[0] = kr[0]; kd[1] = kr[1];
        LAS v4u* vd = (LAS v4u*)(Vt + (tid >> 2) * AT_VSTR + (tid & 3) * 16); vd[0] = vr[0]; vd[1] = vr[1]; };
    gload(0); lstore(); __syncthreads();
    for (int ti = 0; ti < ntile; ++ti) {
        const int ent = tl[1 + ti]; const int kt64 = ent & 0xffff; const bool own = (ent >> 16) & 1; const int key0 = 64 * kt64;
        if (ti + 1 < ntile) gload(ti + 1);
        const bool wave_active = own || ((wsel >> (kt64 >> 2)) & 1u);
        if (wave_active) {
            f32x4 s[4];
#pragma unroll
            for (int kt = 0; kt < 4; ++kt) { s[kt] = (f32x4){0.f, 0.f, 0.f, 0.f};
#pragma unroll
                for (int kc = 0; kc < 4; ++kc) { const bf16x8 kf = *(const LAS bf16x8*)(Kt + (16 * kt + fr) * AT_KSTR + kc * 32 + fq * 8);
                    s[kt] = __builtin_amdgcn_mfma_f32_16x16x32_bf16(kf, qf[kc], s[kt], 0, 0, 0); } }
            const bool qsel = own || ((mysel >> (kt64 >> 2)) & 1u);
            float mx = -INFINITY;
#pragma unroll
            for (int kt = 0; kt < 4; ++kt)
#pragma unroll
                for (int e = 0; e < 4; ++e) { const int kabs = key0 + 16 * kt + 4 * fq + e; const bool valid = own ? (kabs <= qabs) : qsel;
                    const float v = valid ? s[kt][e] * sc : -INFINITY; s[kt][e] = v; mx = fmaxf(mx, v); }
            mx = fmaxf(mx, __shfl_xor(mx, 16)); mx = fmaxf(mx, __shfl_xor(mx, 32));
            const float mnew = fmaxf(mrun, mx);
            const float alpha = (mnew == -INFINITY) ? 1.f : exp2f(mrun - mnew);
            const float msub = (mnew == -INFINITY) ? 0.f : mnew;
            float psum = 0.f;
#pragma unroll
            for (int kt = 0; kt < 4; ++kt)
#pragma unroll
                for (int e = 0; e < 4; ++e) { const float p = exp2f(s[kt][e] - msub); s[kt][e] = p; psum += p; }
            lrun = lrun * alpha + psum; mrun = mnew;
#pragma unroll
            for (int i = 0; i < 8; ++i) o[i] *= alpha;
            bf16x8 pf[2];
#pragma unroll
            for (int j = 0; j < 2; ++j) { v4u w; w.x = pk2(s[2 * j][0], s[2 * j][1]); w.y = pk2(s[2 * j][2], s[2 * j][3]); w.z = pk2(s[2 * j + 1][0], s[2 * j + 1][1]); w.w = pk2(s[2 * j + 1][2], s[2 * j + 1][3]);
                pf[j] = __builtin_bit_cast(bf16x8, w); }
#pragma unroll
            for (int dt = 0; dt < 8; ++dt)
#pragma unroll
                for (int j = 0; j < 2; ++j) { const LAS bf16* vp = Vt + (16 * dt + fr) * AT_VSTR + 32 * j + 4 * fq;
                    const v2u lo = *(const LAS v2u*)vp, hi = *(const LAS v2u*)(vp + 16);
                    const v4u w = {lo.x, lo.y, hi.x, hi.y};
                    o[dt] = __builtin_amdgcn_mfma_f32_16x16x32_bf16(__builtin_bit_cast(bf16x8, w), pf[j], o[dt], 0, 0, 0); }
        }
        __syncthreads();
        if (ti + 1 < ntile) lstore();
        __syncthreads();
    }
    float lt = lrun; lt += __shfl_xor(lt, 16); lt += __shfl_xor(lt, 32);
    const float inv = 1.f / lt;
    bf16* Y = (bf16*)(ws + WS_YE) + (size_t)(b * SEQ + qabs) * 2048 + h * 128;
#pragma unroll
    for (int dt = 0; dt < 8; ++dt) { v2u w; w.x = pk2(o[dt][0] * inv, o[dt][1] * inv); w.y = pk2(o[dt][2] * inv, o[dt][3] * inv); *(v2u*)(Y + 16 * dt + 4 * fq) = w; }
    __syncthreads();
}

constexpr int ML_CH = 32;
constexpr int ML_Q_OFF = 0, ML_K_OFF = ML_CH * 512, ML_V_OFF = 2 * ML_CH * 512, ML_G_OFF = ML_V_OFF + ML_CH * 64, ML_BUF = ML_G_OFF + ML_CH * 8;
__device__ __forceinline__ void mlstm_unit(const int wv, LAS unsigned char* lds, int b, int h, int eg) {
    const ArgsP a = get_args();
#ifdef NO_MLSTM
    return;
#endif
    OPAQUE_TID(); const int e = tid >> 5, dp = tid & 31;
    unsigned char* ws = a->ws;
    const bf16* QKB = (const bf16*)(ws + WS_QKB) + (size_t)b * SEQ * 2048;
    const bf16* Z = (const bf16*)(ws + WS_Z) + (size_t)b * SEQ * ZW;
    const float* IG = (const float*)(ws + WS_IG) + (size_t)(b * 4 + h) * SEQ; const float* FG = (const float*)(ws + WS_FG) + (size_t)(b * 4 + h) * SEQ;
    float* HB = (float*)(ws + WS_HB) + (size_t)b * SEQ * 1024 + h * 256 + eg * 16;
    LAS float* hbuf = (LAS float*)(lds + 2 * ML_BUF);
    float C[8], nn[8];
#pragma unroll
    for (int j = 0; j < 8; ++j) { C[j] = 0.f; nn[j] = 0.f; }
    v4u rq[2], rk[2]; v4u rv; float rg = 0.f;
    auto gload = [&](int c) { const int t0 = c * ML_CH;
#pragma unroll
        for (int i = 0; i < 2; ++i) { const int idx = tid + 512 * i, st = idx >> 5, pc = idx & 31;
            rq[i] = *(const v4u*)(QKB + (size_t)(t0 + st) * 2048 + h * 256 + pc * 8); rk[i] = *(const v4u*)(QKB + (size_t)(t0 + st) * 2048 + 1024 + h * 256 + pc * 8); }
        if (tid < 64) { const int st = tid >> 1, hf = tid & 1; rv = *(const v4u*)(Z + (size_t)(t0 + st) * ZW + 5120 + h * 256 + eg * 16 + hf * 8); }
        else if (tid < 96) rg = IG[t0 + tid - 64]; else if (tid < 128) rg = FG[t0 + tid - 96]; };
    auto lstore = [&](int bufi) { LAS unsigned char* B = lds + bufi * ML_BUF;
#pragma unroll
        for (int i = 0; i < 2; ++i) { const int idx = tid + 512 * i; *(LAS v4u*)(B + ML_Q_OFF + idx * 16) = rq[i]; *(LAS v4u*)(B + ML_K_OFF + idx * 16) = rk[i]; }
        if (tid < 64) { const int st = tid >> 1, hf = tid & 1; LAS float* vd = (LAS float*)(B + ML_V_OFF) + st * 16 + hf * 8;
            vd[0] = bflo(rv.x); vd[1] = bfhi(rv.x); vd[2] = bflo(rv.y); vd[3] = bfhi(rv.y); vd[4] = bflo(rv.z); vd[5] = bfhi(rv.z); vd[6] = bflo(rv.w); vd[7] = bfhi(rv.w); }
        else if (tid < 96) ((LAS float*)(B + ML_G_OFF))[(tid - 64) * 2] = __expf(rg) * 0.0625f;
        else if (tid < 128) ((LAS float*)(B + ML_G_OFF))[(tid - 96) * 2 + 1] = __expf(rg); };
    gload(0); lstore(0); __syncthreads();
    constexpr int NCH = SEQ / ML_CH;
    for (int c = 0; c < NCH; ++c) {
        if (c + 1 < NCH) gload(c + 1);
        LAS unsigned char* B = lds + (c & 1) * ML_BUF;
#pragma unroll 4
        for (int st = 0; st < ML_CH; ++st) {
            const v4u qw = *(const LAS v4u*)(B + ML_Q_OFF + st * 512 + dp * 16), kw = *(const LAS v4u*)(B + ML_K_OFF + st * 512 + dp * 16);
            const float ve = ((const LAS float*)(B + ML_V_OFF))[st * 16 + e]; const f32x2 gi = *(const LAS f32x2*)((const LAS float*)(B + ML_G_OFF) + st * 2);
            const float it = gi.x, ft = gi.y, iv = it * ve;
            const float q[8] = {bflo(qw.x), bfhi(qw.x), bflo(qw.y), bfhi(qw.y), bflo(qw.z), bfhi(qw.z), bflo(qw.w), bfhi(qw.w)};
            const float k[8] = {bflo(kw.x), bfhi(kw.x), bflo(kw.y), bfhi(kw.y), bflo(kw.z), bfhi(kw.z), bflo(kw.w), bfhi(kw.w)};
            float num = 0.f, den = 0.f;
#pragma unroll
            for (int j = 0; j < 8; ++j) { C[j] = fmaf(iv, k[j], ft * C[j]); nn[j] = fmaf(it, k[j], ft * nn[j]); num = fmaf(q[j], C[j], num); den = fmaf(q[j], nn[j], den); }
            num = red16(num); den = red16(den); num += __shfl_xor(num, 16); den += __shfl_xor(den, 16);
            if (dp == 0) hbuf[st * 16 + e] = num / fmaxf(fabsf(den), 1.f);
        }
        __syncthreads();
        if (c + 1 < NCH) lstore((c + 1) & 1);
        { const int st = tid >> 4, ee = tid & 15; HB[(size_t)(c * ML_CH + st) * 1024 + ee] = hbuf[st * 16 + ee]; }
        __syncthreads();
    }
}

__device__ __forceinline__ void hnorm_phase(const int wv, int e) {
    const ArgsP a = get_args();
#ifdef NO_HNORM
    return;
#endif
    OPAQUE_TID(); const int lane = tid & 63, wave = tid >> 6;
    unsigned char* ws = a->ws;
    const float* HB = (const float*)(ws + WS_HB); const bf16* Z = (const bf16*)(ws + WS_Z); bf16* Y = (bf16*)(ws + WS_YE);
    const float* hg = a->in[5] + (size_t)e * 1024;
    const int gw = blockIdx.x * NWAVES + wave, NGW = gridDim.x * NWAVES;
    for (int it = gw; it < T_ * 4; it += NGW) { const int m = it >> 2, h = it & 3;
        const f32x4 v = *((const f32x4*)(HB + (size_t)m * 1024 + h * 256) + lane);
        const float ss = wave_sum(v.x * v.x + v.y * v.y + v.z * v.z + v.w * v.w);
        const float rs = 1.f / sqrtf(ss * (1.f / 256.f) + 1e-6f);
        const v2u ow = *((const v2u*)(Z + (size_t)m * ZW + 6144 + h * 256) + lane);
        const f32x4 g = *((const f32x4*)(hg + h * 256) + lane);
        v2u w; w.x = pk2(v.x * rs * g.x * sigmoidf_(bflo(ow.x)), v.y * rs * g.y * sigmoidf_(bfhi(ow.x)));
        w.y = pk2(v.z * rs * g.z * sigmoidf_(bflo(ow.y)), v.w * rs * g.w * sigmoidf_(bfhi(ow.y)));
        *((v2u*)(Y + (size_t)m * 2048 + 1024 + h * 256) + lane) = w; }
}

__device__ __forceinline__ void odd_prep(const int wv, int o) {
    const ArgsP a = get_args();
#ifdef NO_OPREP
    return;
#endif
    OPAQUE_TID(); const int lane = tid & 63, wave = tid >> 6;
    unsigned char* ws = a->ws;
    const float* mu = a->in[7] + (size_t)o * 6 * 2048;
    bf16* XR = (bf16*)(ws + WS_XRKV); bf16* XK = XR + (size_t)T_ * 2048; bf16* XV = XK + (size_t)T_ * 2048; bf16* XC = (bf16*)(ws + WS_XC);
    const int gw = blockIdx.x * NWAVES + wave, NGW = gridDim.x * NWAVES;
    for (int m = gw; m < T_; m += NGW) { const bool first = (m % SEQ) == 0;
        const f32x4* xr = (const f32x4*)(a->out + (size_t)m * D_) + lane; const f32x4* xp = (const f32x4*)(a->out + (size_t)(m - 1) * D_) + lane;
#pragma unroll
        for (int j = 0; j < 8; ++j) { const f32x4 x = xr[64 * j]; f32x4 p = {0.f, 0.f, 0.f, 0.f}; if (!first) p = xp[64 * j]; const f32x4 dx = p - x;
            const f32x4 m0 = ((const f32x4*)mu)[lane + 64 * j], m2 = ((const f32x4*)(mu + 2 * 2048))[lane + 64 * j], m3 = ((const f32x4*)(mu + 3 * 2048))[lane + 64 * j];
            const f32x4 r = x + dx * m0, k = x + dx * m2, v = x + dx * m3; const size_t off = (size_t)m * 2048 + 4 * (lane + 64 * j);
            *(v2u*)(XR + off) = (v2u){pk2(r.x, r.y), pk2(r.z, r.w)}; *(v2u*)(XK + off) = (v2u){pk2(k.x, k.y), pk2(k.z, k.w)}; *(v2u*)(XV + off) = (v2u){pk2(v.x, v.y), pk2(v.z, v.w)};
            const size_t offc = (size_t)m * 4096 + 4 * (lane + 64 * j);
            *(v2u*)(XC + offc) = (v2u){pk2(x.x, x.y), pk2(x.z, x.w)}; *(v2u*)(XC + offc + 2048) = (v2u){pk2(dx.x, dx.y), pk2(dx.z, dx.w)}; }
    }
}

constexpr int RW_CH = 32, RW_ARR = RW_CH * 64 * 4;
constexpr int RW_W = 0, RW_KK = RW_ARR, RW_BB = 2 * RW_ARR, RW_KH = 3 * RW_ARR, RW_R = 4 * RW_ARR, RW_V = 5 * RW_ARR, RW_G = 6 * RW_ARR, RW_BUF = 7 * RW_ARR;
__device__ __forceinline__ void rwkv_unit(const int wv, LAS unsigned char* lds, int o, int b, int h) {
    const ArgsP a = get_args();
#ifdef NO_RWKV
    return;
#endif
    OPAQUE_TID(); const int lane = tid & 63, wave = tid >> 6, rp = lane >> 4, kq = lane & 15, pst = tid >> 4;
    unsigned char* ws = a->ws;
    const size_t rowbase = (size_t)b * SEQ * 2048 + h * 64 + 4 * kq;
    const bf16* Rb = (const bf16*)(ws + WS_RKV) + rowbase; const bf16* Kb = Rb + (size_t)T_ * 2048;
    const bf16* Vb = ((o == 0) ? (const bf16*)(ws + WS_VF) : (const bf16*)(ws + WS_RKV) + (size_t)2 * T_ * 2048) + rowbase;
    const bf16* Gb = (const bf16*)(ws + WS_G) + rowbase; const bf16* WDb = (const bf16*)(ws + WS_WD) + rowbase; const bf16* AAb = (const bf16*)(ws + WS_AA) + rowbase;
    bf16* Yb = (bf16*)(ws + WS_YO) + rowbase;
    const int pc = h * 64 + 4 * kq;
    const f32x4 p_kk = *(const f32x4*)(a->in[20] + (size_t)o * 2048 + pc), p_ka = *(const f32x4*)(a->in[21] + (size_t)o * 2048 + pc), p_rk = *(const f32x4*)(a->in[22] + (size_t)o * 2048 + pc);
    const f32x4 p_lg = *(const f32x4*)(a->in[23] + (size_t)o * 2048 + pc), p_lb = *(const f32x4*)(a->in[24] + (size_t)o * 2048 + pc);
    LAS float* ybuf = (LAS float*)(lds + 2 * RW_BUF);
    float S0[4] = {0, 0, 0, 0}, S1[4] = {0, 0, 0, 0};
    v2u gk, ga, gw_, gr, gv, gg;
    auto gload = [&](int c) { const size_t off = (size_t)(c * RW_CH + pst) * 2048;
        gk = *(const v2u*)(Kb + off); ga = *(const v2u*)(AAb + off); gw_ = *(const v2u*)(WDb + off); gr = *(const v2u*)(Rb + off); gv = *(const v2u*)(Vb + off); gg = *(const v2u*)(Gb + off); };
    auto lstore = [&](int bufi) { LAS unsigned char* B = lds + bufi * RW_BUF; const int eo = (pst * 64 + 4 * kq) * 4;
        const f32x4 k = {bflo(gk.x), bfhi(gk.x), bflo(gk.y), bfhi(gk.y)}, aa = {bflo(ga.x), bfhi(ga.x), bflo(ga.y), bfhi(ga.y)};
        const f32x4 kx = k * p_kk; const float n2 = red16(kx.x * kx.x + kx.y * kx.y + kx.z * kx.z + kx.w * kx.w);
        const float inv = 1.f / fmaxf(sqrtf(n2), 1e-12f); const f32x4 kk = kx * inv;
        *(LAS f32x4*)(B + RW_KK + eo) = kk; *(LAS f32x4*)(B + RW_BB + eo) = kk * aa; *(LAS f32x4*)(B + RW_KH + eo) = k * (1.f + (aa - 1.f) * p_ka);
        *(LAS f32x4*)(B + RW_W + eo) = (f32x4){__expf(bflo(gw_.x)), __expf(bfhi(gw_.x)), __expf(bflo(gw_.y)), __expf(bfhi(gw_.y))};
        *(LAS f32x4*)(B + RW_R + eo) = (f32x4){bflo(gr.x), bfhi(gr.x), bflo(gr.y), bfhi(gr.y)};
        *(LAS f32x4*)(B + RW_V + eo) = (f32x4){bflo(gv.x), bfhi(gv.x), bflo(gv.y), bfhi(gv.y)};
        *(LAS f32x4*)(B + RW_G + eo) = (f32x4){bflo(gg.x), bfhi(gg.x), bflo(gg.y), bfhi(gg.y)}; };
    gload(0); lstore(0); __syncthreads();
    constexpr int NCH = SEQ / RW_CH;
    const int vrow = 8 * wave + 2 * rp;
    for (int c = 0; c < NCH; ++c) {
        if (c + 1 < NCH) gload(c + 1);
        LAS unsigned char* B = lds + (c & 1) * RW_BUF;
#pragma unroll 4
        for (int st = 0; st < RW_CH; ++st) { const int eo = (st * 64 + 4 * kq) * 4;
            const f32x4 w = *(const LAS f32x4*)(B + RW_W + eo), kk = *(const LAS f32x4*)(B + RW_KK + eo), bb = *(const LAS f32x4*)(B + RW_BB + eo),
                        kh = *(const LAS f32x4*)(B + RW_KH + eo), r = *(const LAS f32x4*)(B + RW_R + eo);
            const f32x2 vv = *(const LAS f32x2*)(B + RW_V + (st * 64 + vrow) * 4);
            float u0 = S0[0] * kk.x + S0[1] * kk.y + S0[2] * kk.z + S0[3] * kk.w, u1 = S1[0] * kk.x + S1[1] * kk.y + S1[2] * kk.z + S1[3] * kk.w;
            u0 = red16(u0); u1 = red16(u1);
#pragma unroll
            for (int j = 0; j < 4; ++j) { S0[j] = fmaf(S0[j], w[j], fmaf(-u0, bb[j], vv.x * kh[j])); S1[j] = fmaf(S1[j], w[j], fmaf(-u1, bb[j], vv.y * kh[j])); }
            float y0 = S0[0] * r.x + S0[1] * r.y + S0[2] * r.z + S0[3] * r.w, y1 = S1[0] * r.x + S1[1] * r.y + S1[2] * r.z + S1[3] * r.w;
            y0 = red16(y0); y1 = red16(y1);
            if (kq == 0) *(LAS f32x2*)(ybuf + st * 64 + vrow) = (f32x2){y0, y1};
        }
        __syncthreads();
        if (c + 1 < NCH) lstore((c + 1) & 1);
        {
            const int eo = (pst * 64 + 4 * kq) * 4;
            const f32x4 y = *(const LAS f32x4*)((LAS unsigned char*)ybuf + eo), r = *(const LAS f32x4*)(B + RW_R + eo), kh = *(const LAS f32x4*)(B + RW_KH + eo),
                        v = *(const LAS f32x4*)(B + RW_V + eo), g = *(const LAS f32x4*)(B + RW_G + eo);
            const float mean = red16(y.x + y.y + y.z + y.w) * (1.f / 64.f); const f32x4 d = y - mean;
            const float var = red16(d.x * d.x + d.y * d.y + d.z * d.z + d.w * d.w) * (1.f / 64.f); const float rstd = 1.f / sqrtf(var + 64e-5f);
            const f32x4 rk = r * kh * p_rk; const float bon = red16(rk.x + rk.y + rk.z + rk.w);
            const f32x4 ov = (d * rstd * p_lg + p_lb + bon * v) * g;
            *(v2u*)(Yb + (size_t)(c * RW_CH + pst) * 2048) = (v2u){pk2(ov.x, ov.y), pk2(ov.z, ov.w)}; }
        __syncthreads();
    }
}

__device__ __forceinline__ void ln_router(const int wv, int l) {
    const ArgsP a = get_args();
#ifdef NO_ROUTER
    return;
#endif
    OPAQUE_TID(); const int lane = tid & 63, wave = tid >> 6;
    unsigned char* ws = a->ws;
    const float* lg = a->in[28] + (size_t)l * 2048; const float* lb = a->in[29] + (size_t)l * 2048;
    const float* Wg = a->in[32] + (size_t)l * 2048 * 4; const float* bg = a->in[33] + l * 4; const float* We = a->in[34] + (size_t)l * 2048 * 32; const float* be = a->in[35] + l * 32;
    unsigned* cnt = (unsigned*)(ws + WS_CTL) + CW_CNT + (size_t)l * 32 * 64;
    int* TOKE = (int*)(ws + WS_TOKE); int* TOKR = (int*)(ws + WS_TOKR); float* TOKG = (float*)(ws + WS_TOKG);
    const int gw = blockIdx.x * NWAVES + wave, NGW = gridDim.x * NWAVES;
    for (int m = gw; m < T_; m += NGW) {
        f32x4* xr = (f32x4*)(a->out + (size_t)m * D_) + lane; f32x4 v[8]; float s = 0.f;
#pragma unroll
        for (int j = 0; j < 8; ++j) { v[j] = xr[64 * j]; s += (v[j].x + v[j].y) + (v[j].z + v[j].w); }
        const float mean = wave_sum(s) * (1.f / D_); float s2 = 0.f;
#pragma unroll
        for (int j = 0; j < 8; ++j) { v[j] = v[j] - mean; s2 += (v[j].x * v[j].x + v[j].y * v[j].y) + (v[j].z * v[j].z + v[j].w * v[j].w); }
        const float rstd = 1.f / sqrtf(wave_sum(s2) * (1.f / D_) + LN_EPS);
        float ag[4] = {0, 0, 0, 0};
#pragma unroll
        for (int j = 0; j < 8; ++j) { const f32x4 g = ((const f32x4*)lg)[lane + 64 * j], bb = ((const f32x4*)lb)[lane + 64 * j]; v[j] = v[j] * rstd * g + bb; xr[64 * j] = v[j];
            ((v2u*)(ws + WS_XB))[(size_t)m * 512 + lane + 64 * j] = (v2u){pk2(v[j].x, v[j].y), pk2(v[j].z, v[j].w)};
            const f32x4* wp = (const f32x4*)Wg + 4 * (lane + 64 * j);
#pragma unroll
            for (int i = 0; i < 4; ++i) { const f32x4 w = wp[i]; const float x = v[j][i]; ag[0] += x * w.x; ag[1] += x * w.y; ag[2] += x * w.z; ag[3] += x * w.w; } }
#pragma unroll
        for (int i = 0; i < 4; ++i) ag[i] = wave_sum(ag[i]) + bg[i];
        int gi = 0; float gm = ag[0];
#pragma unroll
        for (int i = 1; i < 4; ++i) if (ag[i] > gm) { gm = ag[i]; gi = i; }
        float gs = 0.f;
#pragma unroll
        for (int i = 0; i < 4; ++i) gs += __expf(ag[i] - gm);
        const float gp = 1.f / gs;
        float ae[8] = {0, 0, 0, 0, 0, 0, 0, 0};
#pragma unroll
        for (int j = 0; j < 8; ++j) {
#pragma unroll
            for (int i = 0; i < 4; ++i) { const float* wr = We + (size_t)(4 * (lane + 64 * j) + i) * 32 + 8 * gi; const f32x4 w0 = *(const f32x4*)wr, w1 = *(const f32x4*)(wr + 4); const float x = v[j][i];
                ae[0] += x * w0.x; ae[1] += x * w0.y; ae[2] += x * w0.z; ae[3] += x * w0.w; ae[4] += x * w1.x; ae[5] += x * w1.y; ae[6] += x * w1.z; ae[7] += x * w1.w; } }
#pragma unroll
        for (int i = 0; i < 8; ++i) ae[i] = wave_sum(ae[i]) + be[8 * gi + i];
        int e1 = 0; float m1 = ae[0];
#pragma unroll
        for (int i = 1; i < 8; ++i) if (ae[i] > m1) { m1 = ae[i]; e1 = i; }
        int e2 = -1; float m2 = -3.0e38f;
#pragma unroll
        for (int i = 0; i < 8; ++i) if (i != e1 && ae[i] > m2) { m2 = ae[i]; e2 = i; }
        const float p2 = __expf(m2 - m1), den = 1.f / (1.f + p2);
        if (lane == 0) { const int x1 = 8 * gi + e1, x2 = 8 * gi + e2;
            const unsigned r1 = __hip_atomic_fetch_add(cnt + x1 * 64, 1u, __ATOMIC_RELAXED, __HIP_MEMORY_SCOPE_AGENT);
            const unsigned r2 = __hip_atomic_fetch_add(cnt + x2 * 64, 1u, __ATOMIC_RELAXED, __HIP_MEMORY_SCOPE_AGENT);
            TOKE[2 * m] = x1; TOKE[2 * m + 1] = x2; TOKR[2 * m] = (int)r1; TOKR[2 * m + 1] = (int)r2; TOKG[2 * m] = gp * den; TOKG[2 * m + 1] = gp * p2 * den; }
    }
}

struct MoeTab { LAS int* start; LAS int* tileE; LAS int* ntiles; };
__device__ __forceinline__ MoeTab moe_tables(const int wv, int l, LAS unsigned char* lds) {
    const ArgsP a = get_args();
    MoeTab t; t.start = (LAS int*)(lds + MISC_OFF + 256); t.tileE = t.start + 40; t.ntiles = t.tileE + 168;
    OPAQUE_TID();
    if (tid == 0) { unsigned* cnt = (unsigned*)(a->ws + WS_CTL) + CW_CNT + (size_t)l * 32 * 64; int acc = 0;
        for (int e = 0; e < 32; ++e) { const int c = (int)__hip_atomic_load(cnt + e * 64, __ATOMIC_RELAXED, __HIP_MEMORY_SCOPE_AGENT); const int pad = (c + 255) & ~255;
            t.start[e] = acc; for (int q = acc >> 8; q < ((acc + pad) >> 8) && q < MOE_TILES; ++q) t.tileE[q] = e; acc += pad; }
        int nt = acc >> 8; if (nt > MOE_TILES) nt = MOE_TILES; *t.ntiles = nt; }
    __syncthreads();
    return t;
}
__device__ __forceinline__ void moe_gather(const int wv, const MoeTab& tb) {
    const ArgsP a = get_args();
#ifdef NO_GATHER
    return;
#endif
    OPAQUE_TID(); const int lane = tid & 63, wave = tid >> 6;
    unsigned char* ws = a->ws;
    const int* TOKE = (const int*)(ws + WS_TOKE); const int* TOKR = (const int*)(ws + WS_TOKR); int* SLOT = (int*)(ws + WS_SLOT);
    const int gw = blockIdx.x * NWAVES + wave, NGW = gridDim.x * NWAVES;
    for (int it = gw; it < 2 * T_; it += NGW) { const int m = it >> 1; const int dest = tb.start[TOKE[it]] + TOKR[it];
        if (lane == 0) SLOT[it] = dest;
        const v4u* src = (const v4u*)(ws + WS_XB) + (size_t)m * 256 + lane; v4u* dst = (v4u*)(ws + WS_XS) + (size_t)dest * 256 + lane;
#pragma unroll
        for (int j = 0; j < 4; ++j) dst[64 * j] = src[64 * j]; }
}
template <int NJ> struct MoeOrder {
    LAS int* tileE; int nunits, G, c;
    __device__ bool next(int i, pg8::Unit& u) const { const int L = i * G + c; if (L >= nunits) return false; u.pm = L / NJ; u.pn = tileE[u.pm] * NJ + (L % NJ); u.aoff = 0; return true; }
    __device__ __forceinline__ void a_ready(const pg8::Unit&) const {}
    __device__ __forceinline__ void done(const pg8::Unit&) const {}
};
__device__ __forceinline__ void moe_combine_ln(const int wv, int l) {
    const ArgsP a = get_args();
#ifdef NO_COMBINE
    return;
#endif
    OPAQUE_TID(); const int lane = tid & 63, wave = tid >> 6;
    unsigned char* ws = a->ws;
    const float* lg = a->in[30] + (size_t)l * 2048; const float* lb = a->in[31] + (size_t)l * 2048;
    const int* SLOT = (const int*)(ws + WS_SLOT); const float* TOKG = (const float*)(ws + WS_TOKG); const bf16* YS = (const bf16*)(ws + WS_YS);
    const int gw = blockIdx.x * NWAVES + wave, NGW = gridDim.x * NWAVES;
    for (int m = gw; m < T_; m += NGW) {
        f32x4* xr = (f32x4*)(a->out + (size_t)m * D_) + lane; f32x4 v[8]; float s = 0.f;
        const int s0 = SLOT[2 * m], s1 = SLOT[2 * m + 1]; const float g0 = TOKG[2 * m], g1 = TOKG[2 * m + 1];
        const v2u* y0 = (const v2u*)(YS + (size_t)s0 * 2048) + lane; const v2u* y1 = (const v2u*)(YS + (size_t)s1 * 2048) + lane;
#pragma unroll
        for (int j = 0; j < 8; ++j) { const f32x4 x = xr[64 * j]; const v2u a0 = y0[64 * j], a1 = y1[64 * j];
            v[j].x = DN_ALPHA * x.x + g0 * bflo(a0.x) + g1 * bflo(a1.x); v[j].y = DN_ALPHA * x.y + g0 * bfhi(a0.x) + g1 * bfhi(a1.x);
            v[j].z = DN_ALPHA * x.z + g0 * bflo(a0.y) + g1 * bflo(a1.y); v[j].w = DN_ALPHA * x.w + g0 * bfhi(a0.y) + g1 * bfhi(a1.y);
            s += (v[j].x + v[j].y) + (v[j].z + v[j].w); }
        const float mean = wave_sum(s) * (1.f / D_); float s2 = 0.f;
#pragma unroll
        for (int j = 0; j < 8; ++j) { v[j] = v[j] - mean; s2 += (v[j].x * v[j].x + v[j].y * v[j].y) + (v[j].z * v[j].z + v[j].w * v[j].w); }
        const float rstd = 1.f / sqrtf(wave_sum(s2) * (1.f / D_) + LN_EPS);
#pragma unroll
        for (int j = 0; j < 8; ++j) { const f32x4 g = ((const f32x4*)lg)[lane + 64 * j], bb = ((const f32x4*)lb)[lane + 64 * j]; v[j] = v[j] * rstd * g + bb; xr[64 * j] = v[j];
            ((v2u*)(ws + WS_XB))[(size_t)m * 512 + lane + 64 * j] = (v2u){pk2(v[j].x, v[j].y), pk2(v[j].z, v[j].w)}; }
    }
}

struct RkvOrder {
    pg8::StaticOrder in; int G, c;
    __device__ bool next(int i, pg8::Unit& u) const { const long L = (long)i * G + c; if (L >= 1536) return false; const int g = (int)(L / 512);
        in.at(L % 512, u); u.pm += 64 * g; u.pn += 8 * g; return true; }
    __device__ __forceinline__ void a_ready(const pg8::Unit&) const {}
    __device__ __forceinline__ void done(const pg8::Unit&) const {}
};
struct L2Order {
    int nunits, G, c;
    __device__ bool next(int i, pg8::Unit& u) const { const int L = i * G + c; if (L >= nunits) return false; u.pn = L >> 6; u.pm = L & 63; u.aoff = (u.pn >= 8) ? 512 : 0; return true; }
    __device__ __forceinline__ void a_ready(const pg8::Unit&) const {}
    __device__ __forceinline__ void done(const pg8::Unit&) const {}
};

constexpr int N_PHASES = 41;

__global__ void __launch_bounds__(NTHR, 2) fwd(Args args) {
    extern __shared__ __attribute__((aligned(16))) unsigned char lds_raw[];
    LAS unsigned char* lds = (LAS unsigned char*)lds_raw;
    const int wv = __builtin_amdgcn_readfirstlane((int)threadIdx.x >> 6);
    OPAQUE_TID();
    const ArgsP ap0 = get_args();
    if (tid < 16) ((LAS unsigned*)(lds + MISC_OFF))[tid] = 0u;
    __syncthreads();
#if ONE_LAUNCH
    XcdBarrier bar = xcd_barrier_post((unsigned*)(ap0->ws + WS_CTL) + CW_BAR, (volatile LAS unsigned*)(lds + MISC_OFF), tid == 0);
#define SEAM(k) do { if ((k) + 1 < hi) xcd_barrier(bar, tid == 0); } while (0)
#else
#define SEAM(k) do { } while (0)
#endif
    const int lo = ap0->ph_lo, hi = ap0->ph_hi;
#define IN(k) (lo <= (k) && (k) < hi)
    const int G = gridDim.x, cb = blockIdx.x;

    if (IN(0)) { prologue(wv, lds); SEAM(0); }

    auto layer = [&](auto lc) __attribute__((always_inline)) { constexpr int l = decltype(lc)::value;
        const int pb = 1 + 10 * l, eo = l >> 1;
        if ((l & 1) == 0) {
            if (IN(pb + 0)) {
                const ArgsP ap = get_args(); unsigned char* ws = ap->ws;
                pg8::Gemm g{(const bf16*)(ws + WS_XB), (const bf16*)(ws + WS_WIN) + (size_t)eo * ZW * 2048, 2048, 2048, 2048};
                pg8::StaticOrder S; S.init(T_, ZW, G, cb);
                pg8::EpiBf16 E{(bf16*)(ws + WS_Z), ZW, 0, 0, 0, nullptr};
                pg8::gemm_phase<pg8::EpiBf16, pg8::StaticOrder, true, false>(wv, lds, g, S, E);
                SEAM(pb + 0);
            }
            if (IN(pb + 1)) { for (int u = cb; u < 256; u += G) even_prep(wv, eo, lds, u); SEAM(pb + 1); }
            if (IN(pb + 2)) {
                for (int L = cb; L < 1024; L += G) { const int i = L >> 8, c = L & 255; const int qt = (i & 1) ? (24 - 8 * i + (c >> 5)) : (31 - 8 * i - (c >> 5)); const int bh = c & 31;
                    attn_unit(wv, lds, bh >> 3, bh & 7, qt); }
                for (int u = cb; u < 256; u += G) mlstm_unit(wv, lds, u >> 6, (u >> 4) & 3, u & 15);
                SEAM(pb + 2);
            }
            if (IN(pb + 3)) { hnorm_phase(wv, eo); SEAM(pb + 3); }
        } else {
            if (IN(pb + 0)) { odd_prep(wv, eo); SEAM(pb + 0); }
            if (IN(pb + 1)) {
                const ArgsP ap = get_args(); unsigned char* ws = ap->ws;
                { pg8::Gemm g{(const bf16*)(ws + WS_XRKV), (const bf16*)(ws + WS_WRKV) + (size_t)eo * 3 * 2048 * 2048, 2048, 2048, 2048};
                  RkvOrder S; S.in.init(T_, 2048, G, cb); S.G = G; S.c = cb;
                  pg8::EpiBf16 E{(bf16*)(ws + WS_RKV), 2048, 64, 8, (size_t)T_ * 2048, (eo == 0) ? (bf16*)(ws + WS_VF) : nullptr};
                  pg8::gemm_phase<pg8::EpiBf16, RkvOrder, true, false>(wv, lds, g, S, E); }
                __syncthreads();
                { pg8::Gemm g{(const bf16*)(ws + WS_XC), (const bf16*)(ws + WS_WL1) + (size_t)eo * 512 * 4096, 4096, 4096, 4096};
                  pg8::StaticOrder S; S.init(T_, 512, G, cb);
                  pg8::EpiL1 E{(bf16*)(ws + WS_L1)};
                  pg8::gemm_phase<pg8::EpiL1, pg8::StaticOrder, true, false>(wv, lds, g, S, E); }
                SEAM(pb + 1);
            }
            if (IN(pb + 2)) {
                const ArgsP ap = get_args(); unsigned char* ws = ap->ws;
                pg8::Gemm g{(const bf16*)(ws + WS_L1), (const bf16*)(ws + WS_WL2) + (size_t)eo * 8192 * 256, 256, 512, 256};
                L2Order S{(eo == 0 ? 24 : 32) * 64, G, cb};
                pg8::EpiL2 E{(bf16*)(ws + WS_G), (bf16*)(ws + WS_WD), (bf16*)(ws + WS_AA), (bf16*)(ws + WS_RKV) + (size_t)2 * T_ * 2048, (const bf16*)(ws + WS_VF),
                             ap->in[12] + (size_t)eo * 2048, ap->in[15] + (size_t)eo * 2048, ap->in[25]};
                pg8::gemm_phase<pg8::EpiL2, L2Order, true, false>(wv, lds, g, S, E);
                SEAM(pb + 2);
            }
            if (IN(pb + 3)) { for (int u = cb; u < 128; u += G) rwkv_unit(wv, lds, eo, u >> 5, u & 31); SEAM(pb + 3); }
        }
        if (IN(pb + 4)) {
            const bool ev = (l & 1) == 0; const ArgsP ap = get_args(); unsigned char* ws = ap->ws;
            pg8::Gemm g{(const bf16*)(ws + (ev ? WS_YE : WS_YO)), (const bf16*)(ws + (ev ? WS_WOUT : WS_WO)) + (size_t)eo * 2048 * 2048, 2048, 2048, 2048};
            pg8::StaticOrder S; S.init(T_, 2048, G, cb);
            pg8::EpiResid E{ap->out, 2048, DN_ALPHA};
            pg8::gemm_phase<pg8::EpiResid, pg8::StaticOrder, true, false>(wv, lds, g, S, E);
            SEAM(pb + 4);
        }
        if (IN(pb + 5)) { ln_router(wv, l); SEAM(pb + 5); }
        if (IN(pb + 6)) { const MoeTab tb = moe_tables(wv, l, lds); moe_gather(wv, tb); SEAM(pb + 6); }
        if (IN(pb + 7)) { const MoeTab tb = moe_tables(wv, l, lds); const ArgsP ap = get_args(); unsigned char* ws = ap->ws;
            pg8::Gemm g{(const bf16*)(ws + WS_XS), (const bf16*)(ws + WS_WGU) + (size_t)l * 32 * 1024 * 2048, 2048, 2048, 2048};
            MoeOrder<4> S{tb.tileE, *tb.ntiles * 4, G, cb};
            pg8::EpiSilu E{(bf16*)(ws + WS_HID)};
            pg8::gemm_phase<pg8::EpiSilu, MoeOrder<4>, true, false>(wv, lds, g, S, E);
            SEAM(pb + 7);
        }
        if (IN(pb + 8)) { const MoeTab tb = moe_tables(wv, l, lds); const ArgsP ap = get_args(); unsigned char* ws = ap->ws;
            pg8::Gemm g{(const bf16*)(ws + WS_HID), (const bf16*)(ws + WS_WDN) + (size_t)l * 32 * 2048 * 512, 512, 512, 512};
            MoeOrder<8> S{tb.tileE, *tb.ntiles * 8, G, cb};
            pg8::EpiBf16 E{(bf16*)(ws + WS_YS), 2048, 0, 8, 0, nullptr};
            pg8::gemm_phase<pg8::EpiBf16, MoeOrder<8>, true, false>(wv, lds, g, S, E);
            SEAM(pb + 8);
        }
        if (IN(pb + 9)) { moe_combine_ln(wv, l); SEAM(pb + 9); }
        };
    layer(std::integral_constant<int, 0>{}); layer(std::integral_constant<int, 1>{}); layer(std::integral_constant<int, 2>{}); layer(std::integral_constant<int, 3>{});
#undef IN
#undef SEAM
}

extern "C" void kernel_launch(void* const* d_in, const int* in_sizes, int n_in, void* d_out, int out_size, void* d_ws, size_t ws_size, hipStream_t stream) {
    static int grid = 0;
    if (grid == 0) {
        if (n_in != 39 || in_sizes[0] != T_ * D_ || out_size != T_ * D_ || ws_size < WS_END) {
            fprintf(stderr, "kernel_launch: unexpected problem: n_in %d in0 %d out %d ws %zu (need %zu)\n", n_in, n_in > 0 ? in_sizes[0] : -1, out_size, ws_size, (size_t)WS_END); grid = -1; return; }
        int dev = 0, cus = 0, per_cu = 0;
        if (hipGetDevice(&dev) != hipSuccess || hipDeviceGetAttribute(&cus, hipDeviceAttributeMultiprocessorCount, dev) != hipSuccess) { fprintf(stderr, "kernel_launch: device query failed\n"); grid = -1; return; }
        if (hipFuncSetAttribute((const void*)fwd, hipFuncAttributeMaxDynamicSharedMemorySize, LDS_BYTES) != hipSuccess) { fprintf(stderr, "kernel_launch: hipFuncSetAttribute failed\n"); grid = -1; return; }
        if (hipOccupancyMaxActiveBlocksPerMultiprocessor(&per_cu, (const void*)fwd, NTHR, LDS_BYTES) != hipSuccess || per_cu < 1)
            fprintf(stderr, "kernel_launch: note: occupancy query reports %d workgroups per CU\n", per_cu);
        (void)hipGetLastError();
        grid = cus;
    }
    if (grid < 0) return;
    if (hipMemsetAsync((char*)d_ws + WS_CTL, 0, CTL_ZERO_BYTES, stream) != hipSuccess) { fprintf(stderr, "kernel_launch: memset failed\n"); return; }
    Args a{};
    for (int i = 0; i < 39; ++i) a.in[i] = (const float*)d_in[i];
    a.out = (float*)d_out; a.ws = (unsigned char*)d_ws;
#if ONE_LAUNCH
    a.ph_lo = 0; a.ph_hi = N_PHASES;
    hipLaunchKernelGGL(fwd, dim3(grid), dim3(NTHR), LDS_BYTES, stream, a);
#else
    for (int p = 0; p < N_PHASES; ++p) { a.ph_lo = p; a.ph_hi = p + 1; hipLaunchKernelGGL(fwd, dim3(grid), dim3(NTHR), LDS_BYTES, stream, a); }
#endif
    const hipError_t le = hipPeekAtLastError();
    if (le != hipSuccess) fprintf(stderr, "kernel_launch: launch failed: %s\n", hipGetErrorName(le));
}
```

```cpp
#include <hip/hip_runtime.h>
#include <cstdio>
#include <cstdint>
#include <type_traits>

#ifndef ONE_LAUNCH
#define ONE_LAUNCH 1
#endif

#define LAS __attribute__((address_space(3)))
typedef unsigned short bf16;
typedef unsigned v4u __attribute__((ext_vector_type(4)));
typedef unsigned v2u __attribute__((ext_vector_type(2)));
typedef float f32x4 __attribute__((ext_vector_type(4)));
typedef float f32x2 __attribute__((ext_vector_type(2)));
typedef short bf16x8 __attribute__((ext_vector_type(8)));

__device__ __forceinline__ unsigned f2bf(float f) { unsigned u = __builtin_bit_cast(unsigned, f); return (u + 0x7fffu + ((u >> 16) & 1u)) >> 16; }
__device__ __forceinline__ unsigned pk2(float lo, float hi) { return f2bf(lo) | (f2bf(hi) << 16); }
__device__ __forceinline__ float bflo(unsigned w) { return __builtin_bit_cast(float, w << 16); }
__device__ __forceinline__ float bfhi(unsigned w) { return __builtin_bit_cast(float, w & 0xffff0000u); }
__device__ __forceinline__ float bf2f(bf16 h) { return __builtin_bit_cast(float, (unsigned)h << 16); }
__device__ __forceinline__ float sigmoidf_(float x) { return 1.f / (1.f + __expf(-x)); }
__device__ __forceinline__ float wave_sum(float v) {
#pragma unroll
    for (int o = 1; o < 64; o <<= 1) v += __shfl_xor(v, o);
    return v;
}
template <int CTRL> __device__ __forceinline__ float dppf(float x) { return __builtin_bit_cast(float, __builtin_amdgcn_mov_dpp(__builtin_bit_cast(int, x), CTRL, 0xf, 0xf, true)); }
__device__ __forceinline__ float red16(float x) { x += dppf<0xB1>(x); x += dppf<0x4E>(x); x += dppf<0x141>(x); x += dppf<0x128>(x); return x; }
__device__ __forceinline__ float max16(float x) { x = fmaxf(x, dppf<0xB1>(x)); x = fmaxf(x, dppf<0x4E>(x)); x = fmaxf(x, dppf<0x141>(x)); x = fmaxf(x, dppf<0x128>(x)); return x; }

__device__ __forceinline__ int lane_id_asm() { int l; asm volatile("v_mbcnt_lo_u32_b32 %0, -1, 0\n\tv_mbcnt_hi_u32_b32 %0, -1, %0" : "=v"(l)); return l; }
#define OPAQUE_TID() const int tid = wv * 64 + lane_id_asm()
typedef short v4i16_t __attribute__((ext_vector_type(4)));
__device__ __forceinline__ v2u tr_read(const LAS unsigned char* p) { return __builtin_bit_cast(v2u, __builtin_amdgcn_ds_read_tr16_b64_v4i16((LAS v4i16_t*)p)); }
#define LDS_WAIT() asm volatile("s_waitcnt lgkmcnt(0)" ::: "memory")
#define VM_WAIT() asm volatile("s_waitcnt vmcnt(0)" ::: "memory")

namespace pg8 {
#define PG8_LAS __attribute__((address_space(3)))
typedef unsigned short bf16_t;
typedef short bf16x8 __attribute__((ext_vector_type(8)));
typedef float f32x4 __attribute__((ext_vector_type(4)));
typedef unsigned u32x4 __attribute__((ext_vector_type(4)));
constexpr int BM = 256, BK = 64, HALF = 128, HTB = HALF * BK * 2  , STAGE_BYTES = 8 * HTB, NXCD = 8, WGM = 8;

__host__ __device__ __forceinline__ int lds_byte(int r, int c) { const int st = (r >> 4) * 2 + (c >> 5), rr = r & 15, cc = c & 31, ob = rr * 64 + cc * 2; return st * 1024 + (ob ^ (((ob >> 9) & 1) << 5)); }
__host__ __device__ __forceinline__ void stage_rc(int b, int& R, int& C) { const int st = b / 1024, sb = b % 1024, swz = sb ^ (((sb >> 9) & 1) << 5); R = (st >> 1) * 16 + swz / 64; C = (st & 1) * 32 + (swz % 64) / 2; }
__host__ __device__ __forceinline__ int perm32(int rho) { const int n = rho >> 4, i = rho & 15; return 8 * (i >> 2) + 4 * n + (i & 3); }

struct Unit { int pm, pn, aoff; };
struct Gemm { const bf16_t* A; const bf16_t* Bt; int K, lda, ldb; };

struct StaticOrder {
    int nM, nN, nwg, G, c;
    __device__ void init(int M, int N, int G_, int c_) { nM = M / BM; nN = N / BM; nwg = nM * nN; G = G_; c = c_; }
    __device__ bool next(int i, Unit& u) const { return at((long)i * G + c, u); }
    __device__ bool at(long L, Unit& u) const {
        if (L >= nwg) return false;
        int wgid = (int)L; { const int q = nwg / NXCD, r = nwg % NXCD, xcd = wgid % NXCD, off = wgid / NXCD; wgid = (xcd < r ? xcd * (q + 1) : r * (q + 1) + (xcd - r) * q) + off; }
        const int nig = WGM * nN, gid = wgid / nig, fm = gid * WGM, gsz = (nM - fm) < WGM ? (nM - fm) : WGM;
        u.pm = fm + ((wgid % nig) % gsz); u.pn = (wgid % nig) / gsz; u.aoff = 0; return true;
    }
    __device__ __forceinline__ void a_ready(const Unit&) const {}
    __device__ __forceinline__ void done(const Unit&) const {}
};

__device__ __forceinline__ unsigned cvt_pk_bf16(float lo, float hi) { unsigned r; asm volatile("v_cvt_pk_bf16_f32 %0, %1, %2" : "=v"(r) : "v"(lo), "v"(hi)); return r; }

struct EpiBf16 {
    static constexpr bool PERM = true, AFTER_DRAIN = false;
    bf16_t* O; int ldc; int pm_mod, pn_mod; size_t gstride; bf16_t* O2;
    __device__ __forceinline__ void operator()(const f32x4 (&acc)[2][2][4][2], const Unit& u, int wr, int wc, int fr, int fq) const {
        const int g = pm_mod ? u.pm / pm_mod : 0;
        const int row0 = (u.pm - g * pm_mod) * BM + wr * 64 + fr;
        const int col0 = (pn_mod ? (u.pn % pn_mod) : u.pn) * BM + wc * 32 + 8 * fq;
        bf16_t* base = O + (size_t)g * gstride;
        bf16_t* base2 = (O2 && g == 2) ? O2 : nullptr;
#pragma unroll
        for (int ai = 0; ai < 2; ++ai)
#pragma unroll
            for (int m = 0; m < 4; ++m) { const size_t ro = (size_t)(row0 + ai * HALF + m * 16) * ldc + col0;
#pragma unroll
                for (int bj = 0; bj < 2; ++bj) { const f32x4 v0 = acc[ai][bj][m][0], v1 = acc[ai][bj][m][1];
                    u32x4 w; w.x = cvt_pk_bf16(v0[0], v0[1]); w.y = cvt_pk_bf16(v0[2], v0[3]); w.z = cvt_pk_bf16(v1[0], v1[1]); w.w = cvt_pk_bf16(v1[2], v1[3]);
                    *(u32x4*)(base + ro + bj * HALF) = w; if (base2) *(u32x4*)(base2 + ro + bj * HALF) = w; } }
    }
};
struct EpiResid {
    static constexpr bool PERM = true, AFTER_DRAIN = false;
    float* X; int ldc; float alpha;
    __device__ __forceinline__ void operator()(const f32x4 (&acc)[2][2][4][2], const Unit& u, int wr, int wc, int fr, int fq) const {
        const int row0 = u.pm * BM + wr * 64 + fr, col0 = u.pn * BM + wc * 32 + 8 * fq;
#pragma unroll
        for (int ai = 0; ai < 2; ++ai)
#pragma unroll
            for (int m = 0; m < 4; ++m) { float* rowp = X + (size_t)(row0 + ai * HALF + m * 16) * ldc + col0;
#pragma unroll
                for (int bj = 0; bj < 2; ++bj) { f32x4* p = (f32x4*)(rowp + bj * HALF); const f32x4 x0 = p[0], x1 = p[1];
                    p[0] = x0 * alpha + acc[ai][bj][m][0]; p[1] = x1 * alpha + acc[ai][bj][m][1]; } }
    }
};
struct EpiSilu {
    static constexpr bool PERM = true, AFTER_DRAIN = false;
    bf16_t* O;
    __device__ __forceinline__ void operator()(const f32x4 (&acc)[2][2][4][2], const Unit& u, int wr, int wc, int fr, int fq) const {
        const int row0 = u.pm * BM + wr * 64 + fr, col0 = (u.pn & 3) * 128 + wc * 32 + 8 * fq;
#pragma unroll
        for (int ai = 0; ai < 2; ++ai)
#pragma unroll
            for (int m = 0; m < 4; ++m) { bf16_t* rowp = O + (size_t)(row0 + ai * HALF + m * 16) * 512 + col0;
                float h[8];
#pragma unroll
                for (int n = 0; n < 2; ++n)
#pragma unroll
                    for (int e = 0; e < 4; ++e) { const float gt = acc[ai][0][m][n][e], up = acc[ai][1][m][n][e]; h[n * 4 + e] = gt / (1.f + __expf(-gt)) * up; }
                u32x4 w; w.x = cvt_pk_bf16(h[0], h[1]); w.y = cvt_pk_bf16(h[2], h[3]); w.z = cvt_pk_bf16(h[4], h[5]); w.w = cvt_pk_bf16(h[6], h[7]);
                *(u32x4*)rowp = w; }
    }
};
struct EpiL1 {
    static constexpr bool PERM = true, AFTER_DRAIN = false;
    bf16_t* O;
    __device__ __forceinline__ void operator()(const f32x4 (&acc)[2][2][4][2], const Unit& u, int wr, int wc, int fr, int fq) const {
        const int row0 = u.pm * BM + wr * 64 + fr, col0 = u.pn * BM + wc * 32 + 8 * fq;
#pragma unroll
        for (int ai = 0; ai < 2; ++ai)
#pragma unroll
            for (int m = 0; m < 4; ++m) { bf16_t* rowp = O + (size_t)(row0 + ai * HALF + m * 16) * 512 + col0;
#pragma unroll
                for (int bj = 0; bj < 2; ++bj) { const int c = col0 + bj * HALF; float h[8];
#pragma unroll
                    for (int n = 0; n < 2; ++n)
#pragma unroll
                        for (int e = 0; e < 4; ++e) { const float v = acc[ai][bj][m][n][e];
                            h[n * 4 + e] = (c < 256) ? 1.f / (1.f + __expf(-v)) : ((c < 352) ? (1.f - 2.f / (1.f + __expf(2.f * v))) : v); }
                    u32x4 w; w.x = cvt_pk_bf16(h[0], h[1]); w.y = cvt_pk_bf16(h[2], h[3]); w.z = cvt_pk_bf16(h[4], h[5]); w.w = cvt_pk_bf16(h[6], h[7]);
                    *(u32x4*)(rowp + bj * HALF) = w; } }
    }
};
template <int KIND> __device__ __forceinline__ void epi_l2(const f32x4 (&acc)[2][2][4][2], bf16_t* O, const bf16_t* VF, const float* pv, int row0, int col0) {
    float pr[2][8];
#pragma unroll
    for (int bj = 0; bj < 2; ++bj)
#pragma unroll
        for (int j = 0; j < 8; ++j) pr[bj][j] = (KIND == 0) ? 0.f : pv[col0 + bj * HALF + j];
#pragma unroll
    for (int ai = 0; ai < 2; ++ai)
#pragma unroll
        for (int m = 0; m < 4; ++m) { const size_t ro = (size_t)(row0 + ai * HALF + m * 16) * 2048 + col0;
#pragma unroll
            for (int bj = 0; bj < 2; ++bj) { float h[8];
#pragma unroll
                for (int n = 0; n < 2; ++n)
#pragma unroll
                    for (int e = 0; e < 4; ++e) h[n * 4 + e] = acc[ai][bj][m][n][e] + pr[bj][n * 4 + e];
                if (KIND == 1) {
#pragma unroll
                    for (int j = 0; j < 8; ++j) { const float x = -h[j]; const float sp = fmaxf(x, 0.f) + __logf(1.f + __expf(-fabsf(x))); h[j] = -__expf(-sp - 0.5f); }
                } else if (KIND == 2) {
#pragma unroll
                    for (int j = 0; j < 8; ++j) h[j] = 1.f / (1.f + __expf(-h[j]));
                } else if (KIND == 3) {
                    const u32x4 vv = *(const u32x4*)(O + ro + bj * HALF), vf = *(const u32x4*)(VF + ro + bj * HALF);
#pragma unroll
                    for (int j = 0; j < 4; ++j) { const unsigned a = vv[j], b = vf[j];
                        const float v0_ = __builtin_bit_cast(float, a << 16), v1_ = __builtin_bit_cast(float, a & 0xffff0000u);
                        const float f0_ = __builtin_bit_cast(float, b << 16), f1_ = __builtin_bit_cast(float, b & 0xffff0000u);
                        h[2 * j] = v0_ + (f0_ - v0_) / (1.f + __expf(-h[2 * j])); h[2 * j + 1] = v1_ + (f1_ - v1_) / (1.f + __expf(-h[2 * j + 1])); }
                }
                u32x4 w; w.x = cvt_pk_bf16(h[0], h[1]); w.y = cvt_pk_bf16(h[2], h[3]); w.z = cvt_pk_bf16(h[4], h[5]); w.w = cvt_pk_bf16(h[6], h[7]);
                *(u32x4*)(O + ro + bj * HALF) = w; } }
}
struct EpiL2 {
    static constexpr bool PERM = true, AFTER_DRAIN = false;
    bf16_t *G, *WD, *AA, *V; const bf16_t* VF; const float *w0, *a0, *v0;
    __device__ __forceinline__ void operator()(const f32x4 (&acc)[2][2][4][2], const Unit& u, int wr, int wc, int fr, int fq) const {
        const int kind = u.pn >> 3;
        const int row0 = u.pm * BM + wr * 64 + fr, col0 = (u.pn & 7) * BM + wc * 32 + 8 * fq;
        if (kind == 0) epi_l2<0>(acc, G, nullptr, nullptr, row0, col0);
        else if (kind == 1) epi_l2<1>(acc, WD, nullptr, w0, row0, col0);
        else if (kind == 2) epi_l2<2>(acc, AA, nullptr, a0, row0, col0);
        else epi_l2<3>(acc, V, VF, v0, row0, col0);
    }
};

template <class Epi, class Sched, bool ALIGN_EPI = false, bool SP2 = false>
__device__ __forceinline__ void gemm_phase(const int wv, PG8_LAS unsigned char* lds, const Gemm g, const Sched& S, const Epi& E) {
#ifdef NO_GEMM
    return;
#endif
    const int tid_o = wv * 64 + lane_id_asm();
    const int tid = tid_o, wid = __builtin_amdgcn_readfirstlane(tid >> 6), lane = tid & 63, wr = wid >> 2, wc = wid & 3, fr = lane & 15, fq = lane >> 4;
    const int K = g.K, nt = K / BK;
    unsigned voffA[2], voffB[2];
#pragma unroll
    for (int i = 0; i < 2; ++i) { int R, C; stage_rc(tid * 16 + i * 8192, R, C); const int Rb = Epi::PERM ? ((R & ~31) + perm32(R & 31)) : R;
        voffA[i] = (unsigned)(R * g.lda + C) * 2u; voffB[i] = (unsigned)(Rb * g.ldb + C) * 2u; }
    const size_t kstep = (size_t)(BK * 2);
    const size_t hstepA = (size_t)HALF * g.lda * 2, hstepB = (size_t)HALF * g.ldb * 2;
    const size_t tstepA = 2 * hstepA, tstepB = 2 * hstepB;
    const unsigned ldsw = (unsigned)wid * 1024u;
    const int aoff = lds_byte(wr * 64 + fr, fq * 8), boff = lds_byte(wc * 32 + fr, fq * 8);
#define PG8_SA(b, h) (((b) * 2 + (h)) * HTB)
#define PG8_SB(b, h) ((4 + (b) * 2 + (h)) * HTB)
#define PG8_STAGE(bufoff, gbase, voff) do { _Pragma("unroll") for (int _i = 0; _i < 2; ++_i) \
        __builtin_amdgcn_global_load_lds((const unsigned*)((const char*)(gbase) + (voff)[_i]), (PG8_LAS unsigned*)(lds + (bufoff) + ldsw + _i * 8192), 16, 0, 0); } while (0)
#define PG8_LDA(dst, b, h) do { _Pragma("unroll") for (int m = 0; m < 4; ++m) _Pragma("unroll") for (int k = 0; k < 2; ++k) dst[m][k] = *(const PG8_LAS bf16x8*)(lds + PG8_SA(b, h) + aoff + m * 2048 + k * 1024); } while (0)
#define PG8_LDB(dst, b, h) do { _Pragma("unroll") for (int n = 0; n < 2; ++n) _Pragma("unroll") for (int k = 0; k < 2; ++k) dst[n][k] = *(const PG8_LAS bf16x8*)(lds + PG8_SB(b, h) + boff + n * 2048 + k * 1024); } while (0)
#define PG8_MMA(ai, bj, At, Bt) do { __builtin_amdgcn_s_setprio(1); _Pragma("unroll") for (int m = 0; m < 4; ++m) _Pragma("unroll") for (int n = 0; n < 2; ++n) _Pragma("unroll") for (int k = 0; k < 2; ++k) \
        acc[ai][bj][m][n] = __builtin_amdgcn_mfma_f32_16x16x32_bf16(Bt[n][k], At[m][k], acc[ai][bj][m][n], 0, 0, 0); __builtin_amdgcn_s_setprio(0); } while (0)
#define PG8_WAIT_V(n) asm volatile("s_waitcnt vmcnt(" #n ")" ::: "memory")
#define PG8_WAIT_L(n) asm volatile("s_waitcnt lgkmcnt(" #n ")" ::: "memory")
#define PG8_BAR __builtin_amdgcn_s_barrier()
#define PG8_SCHED __builtin_amdgcn_sched_barrier(0)
    Unit cur, nxt; int ui = 0;
    if (!S.next(0, cur)) return;
    f32x4 acc[2][2][4][2];
#pragma unroll
    for (int a = 0; a < 2; ++a)
#pragma unroll
        for (int b = 0; b < 2; ++b)
#pragma unroll
            for (int m = 0; m < 4; ++m)
#pragma unroll
                for (int n = 0; n < 2; ++n) acc[a][b][m][n] = (f32x4){0.f, 0.f, 0.f, 0.f};
    bf16x8 At[4][2], B0[2][2], B1[2][2];
    const char* cA = (const char*)g.A + (size_t)cur.pm * tstepA + cur.aoff; const char* cB = (const char*)g.Bt + (size_t)cur.pn * tstepB;
    S.a_ready(cur);
    if constexpr (SP2) {
        PG8_STAGE(PG8_SB(0, 0), cB, voffB); PG8_STAGE(PG8_SB(0, 1), cB + hstepB, voffB); PG8_STAGE(PG8_SA(0, 0), cA, voffA); PG8_STAGE(PG8_SA(0, 1), cA + hstepA, voffA);
        if (wr == 1) PG8_BAR;
        PG8_WAIT_V(2); PG8_BAR;
        PG8_STAGE(PG8_SB(1, 0), cB + kstep, voffB); PG8_STAGE(PG8_SA(1, 0), cA + kstep, voffA); PG8_STAGE(PG8_SB(1, 1), cB + hstepB + kstep, voffB);
        PG8_WAIT_V(6); PG8_BAR;
    } else {
        PG8_STAGE(PG8_SB(0, 0), cB, voffB); PG8_STAGE(PG8_SA(0, 0), cA, voffA); PG8_STAGE(PG8_SB(0, 1), cB + hstepB, voffB); PG8_STAGE(PG8_SA(0, 1), cA + hstepA, voffA);
        if (wr == 1) PG8_BAR;
        PG8_WAIT_V(4); PG8_BAR;
        PG8_STAGE(PG8_SB(1, 0), cB + kstep, voffB); PG8_STAGE(PG8_SA(1, 0), cA + kstep, voffA); PG8_STAGE(PG8_SB(1, 1), cB + hstepB + kstep, voffB);
        PG8_WAIT_V(6); PG8_BAR;
    }
    for (;;) {
        const bool has_next = S.next(ui + 1, nxt);
        const char* nA = has_next ? (const char*)g.A + (size_t)nxt.pm * tstepA + nxt.aoff : cA; const char* nB = has_next ? (const char*)g.Bt + (size_t)nxt.pn * tstepB : cB;
        for (int t = 0; t < nt; t += 2) {
            const bool last = (t == nt - 2);
            const char* a1 = cA + (size_t)(t + 1) * kstep;
            const char* a2 = last ? nA : cA + (size_t)(t + 2) * kstep; const char* b2 = last ? nB : cB + (size_t)(t + 2) * kstep;
            const char* a3 = a2 + kstep; const char* b3 = b2 + kstep;
            if (last && has_next) S.a_ready(nxt);
            if constexpr (SP2) {
            PG8_LDB(B0, 0, 0); PG8_LDB(B1, 0, 1); PG8_SCHED; PG8_LDA(At, 0, 0); PG8_STAGE(PG8_SA(1, 1), a1 + hstepA, voffA);
            PG8_WAIT_V(8); PG8_WAIT_L(0); PG8_BAR; PG8_MMA(0, 0, At, B0); PG8_MMA(0, 1, At, B1); PG8_BAR; PG8_SCHED;
            PG8_LDA(At, 0, 1); PG8_STAGE(PG8_SB(0, 0), b2, voffB); PG8_STAGE(PG8_SB(0, 1), b2 + hstepB, voffB); PG8_STAGE(PG8_SA(0, 0), a2, voffA);
            PG8_WAIT_V(8); PG8_WAIT_L(0); PG8_BAR; PG8_MMA(1, 0, At, B0); PG8_MMA(1, 1, At, B1); PG8_BAR; PG8_SCHED;
            PG8_LDB(B0, 1, 0); PG8_LDB(B1, 1, 1); PG8_SCHED; PG8_LDA(At, 1, 0); PG8_STAGE(PG8_SA(0, 1), a2 + hstepA, voffA);
            PG8_WAIT_V(8); PG8_WAIT_L(0); PG8_BAR; PG8_MMA(0, 0, At, B0); PG8_MMA(0, 1, At, B1); PG8_BAR; PG8_SCHED;
            PG8_LDA(At, 1, 1); PG8_STAGE(PG8_SB(1, 0), b3, voffB); PG8_STAGE(PG8_SB(1, 1), b3 + hstepB, voffB); PG8_STAGE(PG8_SA(1, 0), a3, voffA);
            PG8_WAIT_V(8); PG8_WAIT_L(0); PG8_BAR; PG8_MMA(1, 0, At, B0); PG8_MMA(1, 1, At, B1); PG8_BAR; PG8_SCHED;
            } else {
            PG8_LDB(B0, 0, 0); PG8_SCHED; PG8_LDA(At, 0, 0); PG8_STAGE(PG8_SA(1, 1), a1 + hstepA, voffA);
            PG8_WAIT_L(8); PG8_BAR; PG8_WAIT_L(0); PG8_MMA(0, 0, At, B0); PG8_BAR; PG8_SCHED;
            PG8_LDB(B1, 0, 1); PG8_STAGE(PG8_SB(0, 0), b2, voffB);
            PG8_BAR; PG8_WAIT_L(0); PG8_MMA(0, 1, At, B1); PG8_BAR;
            PG8_LDA(At, 0, 1); PG8_STAGE(PG8_SA(0, 0), a2, voffA);
            PG8_BAR; PG8_WAIT_L(0); PG8_MMA(1, 0, At, B0); PG8_BAR; PG8_SCHED;
            PG8_STAGE(PG8_SB(0, 1), b2 + hstepB, voffB);
            PG8_WAIT_V(6); PG8_BAR; PG8_MMA(1, 1, At, B1); PG8_BAR;
            PG8_LDB(B0, 1, 0); PG8_SCHED; PG8_LDA(At, 1, 0); PG8_STAGE(PG8_SA(0, 1), a2 + hstepA, voffA);
            PG8_WAIT_L(8); PG8_BAR; PG8_WAIT_L(0); PG8_MMA(0, 0, At, B0); PG8_BAR; PG8_SCHED;
            PG8_LDB(B1, 1, 1); PG8_STAGE(PG8_SB(1, 0), b3, voffB);
            PG8_BAR; PG8_WAIT_L(0); PG8_MMA(0, 1, At, B1); PG8_BAR;
            PG8_LDA(At, 1, 1); PG8_STAGE(PG8_SA(1, 0), a3, voffA);
            PG8_BAR; PG8_WAIT_L(0); PG8_MMA(1, 0, At, B0); PG8_BAR; PG8_SCHED;
            PG8_STAGE(PG8_SB(1, 1), b3 + hstepB, voffB);
            PG8_WAIT_V(6); PG8_BAR; PG8_MMA(1, 1, At, B1); PG8_BAR;
            }
        }
        if constexpr (ALIGN_EPI) { if (wr == 0) PG8_BAR; }
        if constexpr (!Epi::AFTER_DRAIN) { E(acc, cur, wr, wc, fr, fq); S.done(cur); }
        if (!has_next) break;
#pragma unroll
        for (int a = 0; a < 2; ++a)
#pragma unroll
            for (int b = 0; b < 2; ++b)
#pragma unroll
                for (int m = 0; m < 4; ++m)
#pragma unroll
                    for (int n = 0; n < 2; ++n) acc[a][b][m][n] = (f32x4){0.f, 0.f, 0.f, 0.f};
        cur = nxt; cA = nA; cB = nB; ++ui;
        if constexpr (ALIGN_EPI) { if (wr == 1) PG8_BAR; }
    }
    PG8_WAIT_V(0);
    if constexpr (!ALIGN_EPI) { if (wr == 0) PG8_BAR; }
    PG8_BAR;
    if constexpr (Epi::AFTER_DRAIN) { E.fused(acc, cur, wr, wc, fr, fq, lds, wid, lane); S.done(cur); }
#undef PG8_SA
#undef PG8_SB
#undef PG8_STAGE
#undef PG8_LDA
#undef PG8_LDB
#undef PG8_MMA
#undef PG8_WAIT_V
#undef PG8_WAIT_L
#undef PG8_BAR
#undef PG8_SCHED
}
}

#define XB_TMO      128
#define XB_XCNT(j)  (256  + 64 * (j))
#define XB_XSUB(j)  (1280 + 64 * (j))
#define XB_XGEN(j)  (2304 + 64 * (j))
#define XB_TOP      3328
#define XB_TOPGEN   3392
#define XCD_BAR_WORDS 3456
#define XB_SPIN_CAP (1u << 18)

__device__ __forceinline__ unsigned xb_ld(unsigned* p)              { return __hip_atomic_load(p, __ATOMIC_RELAXED, __HIP_MEMORY_SCOPE_AGENT); }
__device__ __forceinline__ unsigned xb_add(unsigned* p, unsigned v) { return __hip_atomic_fetch_add(p, v, __ATOMIC_RELAXED, __HIP_MEMORY_SCOPE_AGENT); }
__device__ __forceinline__ unsigned xb_xcc_id() { return (unsigned)__builtin_amdgcn_s_getreg((3 << 11) | 20) & 0xFu; }
#define XB_SPIN(cond, bar) do { unsigned _sp = 0; while (cond) { __builtin_amdgcn_s_sleep(1); \
    if ((++_sp & 255u) == 0u) { if (xb_ld(&(bar)[XB_TMO])) break; if (_sp > XB_SPIN_CAP) { atomicAdd(&(bar)[XB_TMO], 1u); break; } } } } while (0)

struct XcdBarrier {
    unsigned* bar; unsigned x;
    volatile LAS unsigned* st;
};

__device__ __forceinline__ XcdBarrier xcd_barrier_post(unsigned* bar, volatile LAS unsigned* st, const bool t0) {
    XcdBarrier b; b.bar = bar; b.x = xb_xcc_id(); b.st = st;
    if (t0) (void)xb_add(&bar[XB_XCNT(b.x)], 1u);
    return b;
}
__device__ __forceinline__ void xcd_barrier_complete(unsigned* bar, unsigned x, unsigned& nloc, unsigned& nx) {
    const unsigned G = gridDim.x * gridDim.y * gridDim.z;
    unsigned sum, cnt, mine, sp = 0u;
    for (;;) {
        sum = 0u; cnt = 0u; mine = 0u;
#pragma unroll
        for (unsigned j = 0; j < 16; ++j) { const unsigned c = xb_ld(&bar[XB_XCNT(j)]); sum += c; cnt += (c > 0u) ? 1u : 0u; mine = (j == x) ? c : mine; }
        if (sum == G) break;
        __builtin_amdgcn_s_sleep(1);
        if ((++sp & 255u) == 0u) { if (xb_ld(&bar[XB_TMO])) break; if (sp > XB_SPIN_CAP) { atomicAdd(&bar[XB_TMO], 1u); break; } }
    }
    nloc = mine > 0u ? mine : 1u; nx = cnt > 0u ? cnt : 1u;
}

__device__ __forceinline__ void xcd_barrier(const XcdBarrier& b, const bool t0) {
    asm volatile("s_waitcnt vmcnt(0)" ::: "memory");
    __syncthreads();
    if (t0) {
        unsigned* bar = b.bar;
        __builtin_amdgcn_s_waitcnt(0);
        unsigned nloc = b.st[0], nx = b.st[1];
        if (nloc == 0u) { xcd_barrier_complete(bar, b.x, nloc, nx); b.st[0] = nloc; b.st[1] = nx; }
        const unsigned old = xb_add(&bar[XB_XSUB(b.x)], 1u);
        const unsigned gen = old / nloc;
        if (old + 1u == (gen + 1u) * nloc) {
            __builtin_amdgcn_fence(__ATOMIC_RELEASE, "agent");
            asm volatile("s_waitcnt vmcnt(0)" ::: "memory");
            const unsigned og = xb_add(&bar[XB_TOP], 1u);
            const unsigned tg = og / nx;
            if (og + 1u == (tg + 1u) * nx) xb_add(&bar[XB_TOPGEN], 1u);
            else XB_SPIN(xb_ld(&bar[XB_TOPGEN]) == tg, bar);
            __builtin_amdgcn_fence(__ATOMIC_ACQUIRE, "agent");
            xb_add(&bar[XB_XGEN(b.x)], 1u);
            asm volatile("s_waitcnt vmcnt(0)" ::: "memory");
        } else {
            XB_SPIN(xb_ld(&bar[XB_XGEN(b.x)]) == gen, bar);
            __builtin_amdgcn_fence(__ATOMIC_ACQUIRE, "agent");
            asm volatile("s_waitcnt vmcnt(0)" ::: "memory");
        }
    }
    __syncthreads();
}

constexpr int NWAVES = 8, NTHR = 512;
constexpr int NB = 4, SEQ = 4096, T_ = NB * SEQ, D_ = 2048;
constexpr int EVEN_IN = 7176, ZW = 7168;
constexpr float DN_ALPHA = 1.6817928305074290f;
constexpr float LN_EPS = 1e-5f;
constexpr int MOE_ROWS = 40960, MOE_TILES = MOE_ROWS / 256;

constexpr size_t MiB = 1u << 20;
constexpr size_t WS_CTL = 0, CTL_ZERO_BYTES = 1 * MiB;
constexpr size_t WS_IG = 1 * MiB, WS_FG = WS_IG + 256 * 1024, WS_KPART = 2 * MiB;
constexpr size_t WS_TOKE = 3 * MiB, WS_TOKR = WS_TOKE + 128 * 1024, WS_TOKG = WS_TOKR + 128 * 1024, WS_SLOT = WS_TOKG + 128 * 1024;
constexpr size_t WS_DN = 4 * MiB, WS_NP = 5 * MiB, WS_DEC = 6 * MiB, WS_BC = 6 * MiB + 65536;
constexpr size_t WS_WIN = 16 * MiB;
constexpr size_t WS_WOUT = 72 * MiB;
constexpr size_t WS_WRKV = 88 * MiB;
constexpr size_t WS_WO = 136 * MiB;
constexpr size_t WS_WL1 = 152 * MiB;
constexpr size_t WS_WL2 = 160 * MiB;
constexpr size_t WS_WGU = 168 * MiB;
constexpr size_t WS_WDN = 680 * MiB;
constexpr size_t WS_XB = 936 * MiB;
constexpr size_t WS_VF = 1000 * MiB;
constexpr size_t WS_R = 1064 * MiB;
constexpr size_t WS_Z = WS_R;
constexpr size_t WS_QKB = WS_R + 224 * MiB;
constexpr size_t WS_VAT = WS_R + 288 * MiB;
constexpr size_t WS_YE = WS_R + 320 * MiB;
constexpr size_t WS_DC = WS_R + 384 * MiB;
constexpr size_t WS_CP = WS_R + 512 * MiB;
constexpr size_t WS_XRKV = WS_R;
constexpr size_t WS_XC = WS_R + 192 * MiB;
constexpr size_t WS_RKV = WS_R + 320 * MiB;
constexpr size_t WS_L1 = WS_R + 512 * MiB;
constexpr size_t WS_G = WS_R + 528 * MiB;
constexpr size_t WS_WD = WS_R + 592 * MiB;
constexpr size_t WS_AA = WS_R + 656 * MiB;
constexpr size_t WS_YO = WS_R + 720 * MiB;
constexpr size_t WS_XS = WS_R;
constexpr size_t WS_HID = WS_R + 160 * MiB;
constexpr size_t WS_YS = WS_R + 200 * MiB;
constexpr size_t WS_END = WS_R + 784 * MiB;

constexpr int CW_BAR = 4096;
constexpr int CW_CNT = 16384;

constexpr int RING_BYTES = 131072;
constexpr int MISC_OFF = RING_BYTES;
constexpr int LDS_BYTES = 147456;

typedef unsigned gu32;

struct Args { const float* in[39]; float* out; unsigned char* ws; int ph_lo, ph_hi; };
#define CAS __attribute__((address_space(4)))
typedef const CAS Args* ArgsP;
__device__ __forceinline__ ArgsP get_args() { ArgsP p = (ArgsP)__builtin_amdgcn_kernarg_segment_ptr(); asm volatile("" : "+s"(p)); return p; }

__device__ __forceinline__ void tr_item(const float* W, int ldw, int k0, int n0, bf16* WT, int ldt, int drow0, int dcol0, LAS float* scr, int lane, const float* kscale) {
    const int r = lane >> 3, c4 = lane & 7;
    f32x4 v[8];
#pragma unroll
    for (int i = 0; i < 8; ++i) v[i] = __builtin_nontemporal_load((const f32x4*)(W + (size_t)(k0 + 8 * i + r) * ldw + n0 + 4 * c4));
    if (kscale) {
#pragma unroll
        for (int i = 0; i < 8; ++i) v[i] = v[i] * kscale[k0 + 8 * i + r]; }
#pragma unroll
    for (int i = 0; i < 8; ++i) { LAS float* d = scr + (8 * i + r) * 33 + 4 * c4; d[0] = v[i].x; d[1] = v[i].y; d[2] = v[i].z; d[3] = v[i].w; }
    LDS_WAIT(); asm volatile("" ::: "memory");
    const int c = lane & 7;
#pragma unroll
    for (int j = 0; j < 4; ++j) { const int n = (lane >> 3) + 8 * j; const LAS float* s = scr + (8 * c) * 33 + n;
        v4u o; o.x = pk2(s[0 * 33], s[1 * 33]); o.y = pk2(s[2 * 33], s[3 * 33]); o.z = pk2(s[4 * 33], s[5 * 33]); o.w = pk2(s[6 * 33], s[7 * 33]);
        *(v4u*)(WT + (size_t)(drow0 + n) * ldt + dcol0 + 8 * c) = o; }
    LDS_WAIT(); asm volatile("" ::: "memory");
}

__device__ __forceinline__ void prologue(const int wv, LAS unsigned char* lds) {
    const ArgsP a = get_args();
#ifdef NO_PROL
    return;
#endif
    OPAQUE_TID(); const int lane = tid & 63, wave = tid >> 6;
    unsigned char* ws = a->ws;
    LAS float* scr = (LAS float*)(lds + wave * 16384);
    const int gw = blockIdx.x * NWAVES + wave, NGW = gridDim.x * NWAVES;
    constexpr int I0 = 2 * 7168, I1 = 2 * 2048, I2 = 2 * 4 * 2048, I3 = 2 * 32 * 16, I4 = 4 * 32 * 1536;
    constexpr int NITEMS = I0 + I1 + I2 + I3 + I4;
    for (int it = gw; it < NITEMS; it += NGW) {
        int r = it;
        if (r < I0) { const int e = r / 7168, rr = r % 7168, kb = rr / 224, nb = rr % 224;
            tr_item(a->in[1] + (size_t)e * 2048 * EVEN_IN, EVEN_IN, 64 * kb, 32 * nb, (bf16*)(ws + WS_WIN) + (size_t)e * ZW * 2048, 2048, 32 * nb, 64 * kb, scr, lane, nullptr); continue; } r -= I0;
        if (r < I1) { const int e = r / 2048, rr = r % 2048, kb = rr / 64, nb = rr % 64;
            tr_item(a->in[6] + (size_t)e * 2048 * 2048, 2048, 64 * kb, 32 * nb, (bf16*)(ws + WS_WOUT) + (size_t)e * 2048 * 2048, 2048, 32 * nb, 64 * kb, scr, lane, nullptr); continue; } r -= I1;
        if (r < I2) { const int o = r / 8192, rr = r % 8192, mat = rr / 2048, q = rr % 2048, kb = q / 64, nb = q % 64;
            const float* src = (mat == 0 ? a->in[8] : mat == 1 ? a->in[9] : mat == 2 ? a->in[10] : a->in[11]) + (size_t)o * 2048 * 2048;
            bf16* dst = (mat < 3) ? (bf16*)(ws + WS_WRKV) + (size_t)o * 3 * 2048 * 2048 + (size_t)mat * 2048 * 2048 : (bf16*)(ws + WS_WO) + (size_t)o * 2048 * 2048;
            tr_item(src, 2048, 64 * kb, 32 * nb, dst, 2048, 32 * nb, 64 * kb, scr, lane, nullptr); continue; } r -= I2;
        if (r < I3) { const int o = r / 512, rr = r % 512, kb = rr / 16, nb = rr % 16;
            const float* src; int ldw, n0, drow0, mu;
            if (nb < 8) { src = a->in[18] + (size_t)o * 2048 * 256; ldw = 256; n0 = 32 * nb; drow0 = 32 * nb; mu = 5; }
            else if (nb < 11) { src = a->in[13] + (size_t)o * 2048 * 96; ldw = 96; n0 = 32 * (nb - 8); drow0 = 256 + n0; mu = 1; }
            else if (nb < 14) { src = a->in[16] + (size_t)o * 2048 * 96; ldw = 96; n0 = 32 * (nb - 11); drow0 = 352 + n0; mu = 4; }
            else { if (o == 0) continue; src = a->in[26]; ldw = 64; n0 = 32 * (nb - 14); drow0 = 448 + n0; mu = 3; }
            bf16* dst = (bf16*)(ws + WS_WL1) + (size_t)o * 512 * 4096;
            tr_item(src, ldw, 64 * kb, n0, dst, 4096, drow0, 64 * kb, scr, lane, nullptr);
            tr_item(src, ldw, 64 * kb, n0, dst, 4096, drow0, 2048 + 64 * kb, scr, lane, a->in[7] + (size_t)(o * 6 + mu) * 2048);
            continue; } r -= I3;
        { const int le = r / 1536, rr = r % 1536, mat = rr / 512, q = rr % 512;
            if (mat < 2) { const int kb = q / 16, nb = q % 16, n0 = 32 * nb;
                tr_item((mat == 0 ? a->in[36] : a->in[37]) + (size_t)le * 2048 * 512, 512, 64 * kb, n0, (bf16*)(ws + WS_WGU) + (size_t)le * 1024 * 2048, 2048,
                        (n0 / 128) * 256 + (n0 % 128) + (mat == 1 ? 128 : 0), 64 * kb, scr, lane, nullptr); }
            else { const int kb = q / 64, nb = q % 64;
                tr_item(a->in[38] + (size_t)le * 512 * 2048, 2048, 64 * kb, 32 * nb, (bf16*)(ws + WS_WDN) + (size_t)le * 2048 * 512, 512, 32 * nb, 64 * kb, scr, lane, nullptr); }
        }
    }
    const int gt = blockIdx.x * NTHR + tid, NGT = gridDim.x * NTHR;
    for (int idx = gt; idx < 2 * 32 * 8192; idx += NGT) {
        const int o = idx / (32 * 8192), rem = idx % (32 * 8192), kg = rem / 8192, n = rem % 8192, mat = n / 2048, nn = n % 2048;
        float v[8];
#pragma unroll
        for (int j = 0; j < 8; ++j) { const int k = 8 * kg + j; float x = 0.f;
            if (mat == 0) x = a->in[19][((size_t)o * 256 + k) * 2048 + nn];
            else if (mat == 1) { if (k < 96) x = a->in[14][((size_t)o * 96 + k) * 2048 + nn]; }
            else if (mat == 2) { if (k >= 96 && k < 192) x = a->in[17][((size_t)o * 96 + (k - 96)) * 2048 + nn]; }
            else { if (o == 1 && k >= 192) x = a->in[27][(size_t)(k - 192) * 2048 + nn]; }
            v[j] = x; }
        v4u w; w.x = pk2(v[0], v[1]); w.y = pk2(v[2], v[3]); w.z = pk2(v[4], v[5]); w.w = pk2(v[6], v[7]);
        *(v4u*)((bf16*)(ws + WS_WL2) + ((size_t)o * 8192 + n) * 256 + 8 * kg) = w;
    }
    for (int i = gt; i < T_ * D_ / 4; i += NGT) { const f32x4 v = ((const f32x4*)a->in[0])[i]; ((f32x4*)a->out)[i] = v;
        v2u w; w.x = pk2(v.x, v.y); w.y = pk2(v.z, v.w); ((v2u*)(ws + WS_XB))[i] = w; }
}

__device__ __forceinline__ void even_prep(const int wv, int e, LAS unsigned char* lds, int u) {
    const ArgsP a = get_args();
#ifdef NO_EPREP
    return;
#endif
    OPAQUE_TID(); const int lane = tid & 63, wave = tid >> 6;
    unsigned char* ws = a->ws;
    bf16* Z = (bf16*)(ws + WS_Z);
    const int m0 = 64 * u, b = u >> 6, ch = u & 63, t0 = ch * 64;
    { LAS float* cst = (LAS float*)lds; LAS float* snt = cst + 1024;
#pragma unroll 1
      for (int q = tid; q < 1024; q += NTHR) { const int r = q >> 4, i = q & 15; const float inv = exp2f(-(float)i * (18.931568569324174f / 16.f));
          float sn_, cs_; sincosf((float)(t0 + r) * inv, &sn_, &cs_); cst[q] = cs_; snt[q] = sn_; }
      __syncthreads();
      const int row = tid >> 3, head = tid & 7;
      float cs[16], sn[16];
#pragma unroll
      for (int i = 0; i < 4; ++i) { const f32x4 c4 = *(const LAS f32x4*)(cst + row * 16 + 4 * i), s4 = *(const LAS f32x4*)(snt + row * 16 + 4 * i);
          cs[4 * i] = c4.x; cs[4 * i + 1] = c4.y; cs[4 * i + 2] = c4.z; cs[4 * i + 3] = c4.w; sn[4 * i] = s4.x; sn[4 * i + 1] = s4.y; sn[4 * i + 2] = s4.z; sn[4 * i + 3] = s4.w; }
#pragma unroll 1
      for (int qk = 0; qk < 2; ++qk) { v4u* p = (v4u*)(Z + (size_t)(m0 + row) * ZW + qk * 1024 + head * 128);
        v4u w0 = p[0], w1 = p[1], w2 = p[2], w3 = p[3]; unsigned x1[8] = {w0.x, w0.y, w0.z, w0.w, w1.x, w1.y, w1.z, w1.w}, x2[8] = {w2.x, w2.y, w2.z, w2.w, w3.x, w3.y, w3.z, w3.w};
        unsigned o1[8], o2[8];
#pragma unroll
        for (int j = 0; j < 8; ++j) { const float a0 = bflo(x1[j]), a1 = bfhi(x1[j]), b0 = bflo(x2[j]), b1 = bfhi(x2[j]);
            o1[j] = pk2(a0 * cs[2 * j] - b0 * sn[2 * j], a1 * cs[2 * j + 1] - b1 * sn[2 * j + 1]);
            o2[j] = pk2(b0 * cs[2 * j] + a0 * sn[2 * j], b1 * cs[2 * j + 1] + a1 * sn[2 * j + 1]); }
        p[0] = (v4u){o1[0], o1[1], o1[2], o1[3]}; p[1] = (v4u){o1[4], o1[5], o1[6], o1[7]}; p[2] = (v4u){o2[0], o2[1], o2[2], o2[3]}; p[3] = (v4u){o2[4], o2[5], o2[6], o2[7]}; }
    }
    VM_WAIT(); __syncthreads();
    { LAS float* red = (LAS float*)lds;
      const int cg = tid & 127, rq = tid >> 7; float s[8] = {0, 0, 0, 0, 0, 0, 0, 0};
      for (int r = 0; r < 16; ++r) { const v4u w = *(const v4u*)(Z + (size_t)(m0 + rq * 16 + r) * ZW + 1024 + cg * 8);
          s[0] += bflo(w.x); s[1] += bfhi(w.x); s[2] += bflo(w.y); s[3] += bfhi(w.y); s[4] += bflo(w.z); s[5] += bfhi(w.z); s[6] += bflo(w.w); s[7] += bfhi(w.w); }
#pragma unroll
      for (int j = 0; j < 8; ++j) red[rq * 1024 + cg * 8 + j] = s[j];
      __syncthreads();
      if (tid < 256) { f32x4 t = {0, 0, 0, 0};
#pragma unroll
          for (int q = 0; q < 4; ++q) { const f32x4 v = *(const LAS f32x4*)(red + q * 1024 + tid * 4); t += v; }
          const int c = tid * 4, h = c >> 7, d = c & 127;
          *(f32x4*)((float*)(ws + WS_KPART) + ((size_t)((b * 8 + h) * 64 + ch)) * 128 + d) = t; }
      __syncthreads();
    }
    { LAS bf16* tile = (LAS bf16*)lds;
      bf16* VAT = (bf16*)(ws + WS_VAT);
      for (int p = 0; p < 4; ++p) {
          { const int r = tid >> 3, seg = tid & 7; const v4u* src = (const v4u*)(Z + (size_t)(m0 + r) * ZW + 2048 + 256 * p + 32 * seg);
#pragma unroll
            for (int j = 0; j < 4; ++j) *(LAS v4u*)(tile + r * 264 + 32 * seg + 8 * j) = src[j]; }
          __syncthreads();
          { const int c = tid & 255, rh = tid >> 8; unsigned w[16];
#pragma unroll
            for (int j = 0; j < 16; ++j) { const unsigned lo = tile[(32 * rh + 2 * j) * 264 + c], hi = tile[(32 * rh + 2 * j + 1) * 264 + c]; w[j] = lo | (hi << 16); }
            const int col = 256 * p + c, h = col >> 7, d = col & 127;
            v4u* dst = (v4u*)(VAT + ((size_t)((b * 8 + h) * 128 + d)) * SEQ + t0 + 32 * rh);
#pragma unroll
            for (int j = 0; j < 4; ++j) dst[j] = (v4u){w[4 * j], w[4 * j + 1], w[4 * j + 2], w[4 * j + 3]}; }
          __syncthreads();
      }
    }
    { const int cg = tid & 255, rh = tid >> 8; const int c0 = 8 * cg;
      const float* cw = a->in[3] + (size_t)e * 4 * 2048; const float* cb = a->in[4] + (size_t)e * 2048;
      float w[4][8], bias[8];
#pragma unroll
      for (int j = 0; j < 4; ++j)
#pragma unroll
          for (int i = 0; i < 8; ++i) w[j][i] = cw[j * 2048 + c0 + i];
#pragma unroll
      for (int i = 0; i < 8; ++i) bias[i] = cb[c0 + i];
      float win[3][8];
#pragma unroll
      for (int j = 0; j < 3; ++j) { const int tt = t0 + 32 * rh - 3 + j;
          v4u x = {0, 0, 0, 0}; if (tt >= 0) x = *(const v4u*)(Z + (size_t)(b * SEQ + tt) * ZW + 3072 + c0);
          win[j][0] = bflo(x.x); win[j][1] = bfhi(x.x); win[j][2] = bflo(x.y); win[j][3] = bfhi(x.y); win[j][4] = bflo(x.z); win[j][5] = bfhi(x.z); win[j][6] = bflo(x.w); win[j][7] = bfhi(x.w); }
      bf16* QKB = (bf16*)(ws + WS_QKB);
      for (int r = 0; r < 32; ++r) { const int m = m0 + 32 * rh + r;
          const v4u x = *(const v4u*)(Z + (size_t)m * ZW + 3072 + c0);
          float cur[8] = {bflo(x.x), bfhi(x.x), bflo(x.y), bfhi(x.y), bflo(x.z), bfhi(x.z), bflo(x.w), bfhi(x.w)}; float o[8];
#pragma unroll
          for (int i = 0; i < 8; ++i) { const float v = bias[i] + w[0][i] * win[0][i] + w[1][i] * win[1][i] + w[2][i] * win[2][i] + w[3][i] * cur[i]; o[i] = v / (1.f + __expf(-v));
              win[0][i] = win[1][i]; win[1][i] = win[2][i]; win[2][i] = cur[i]; }
          *(v4u*)(QKB + (size_t)m * 2048 + c0) = (v4u){pk2(o[0], o[1]), pk2(o[2], o[3]), pk2(o[4], o[5]), pk2(o[6], o[7])}; }
    }
    { LAS float* wg = (LAS float*)lds;
      const float* Win = a->in[1] + (size_t)e * 2048 * EVEN_IN;
      for (int i = tid; i < 2048 * 2; i += NTHR) { const int k = i >> 1, hf = i & 1; *(LAS f32x4*)(wg + k * 8 + hf * 4) = *(const f32x4*)(Win + (size_t)k * EVEN_IN + ZW + hf * 4); }
      __syncthreads();
      const float* gb = a->in[2] + e * 8;
      for (int rr = 0; rr < 8; ++rr) { const int row = wave * 8 + rr, m = m0 + row; const f32x4* xr = (const f32x4*)(a->out + (size_t)m * D_) + lane;
          float acc[8] = {0, 0, 0, 0, 0, 0, 0, 0};
#pragma unroll 2
          for (int j = 0; j < 8; ++j) { const f32x4 xv = xr[64 * j]; const int k0 = 4 * lane + 256 * j;
#pragma unroll
              for (int i = 0; i < 4; ++i) { const f32x4 wa = *(const LAS f32x4*)(wg + (k0 + i) * 8), wb = *(const LAS f32x4*)(wg + (k0 + i) * 8 + 4); const float xx = xv[i];
                  acc[0] += xx * wa.x; acc[1] += xx * wa.y; acc[2] += xx * wa.z; acc[3] += xx * wa.w; acc[4] += xx * wb.x; acc[5] += xx * wb.y; acc[6] += xx * wb.z; acc[7] += xx * wb.w; } }
#pragma unroll
          for (int j = 0; j < 8; ++j) acc[j] = wave_sum(acc[j]);
          if (lane < 4) { const int h = lane; float ip = 0.f, fp = 0.f;
#pragma unroll
              for (int j = 0; j < 4; ++j) { if (j == h) { ip = acc[j]; fp = acc[4 + j]; } }
              ip += gb[h]; fp += gb[4 + h];
              const float lf = -(fmaxf(-fp, 0.f) + __logf(1.f + __expf(-fabsf(fp))));
              ((float*)(ws + WS_IG))[(size_t)(b * 4 + h) * SEQ + t0 + row] = ip;
              ((LAS float*)(lds + 73728))[h * 64 + row] = ip; ((LAS float*)(lds + 73728 + 1024))[h * 64 + row] = lf; } }
      __syncthreads();
    }
    { LAS float* gi = (LAS float*)(lds + 73728); LAS float* gf = gi + 256; LAS float* wsc = gi + 512;
      const int bh0 = b * 4;
      if (wave < 4) { const int h = wave; float x = gf[h * 64 + lane];
#pragma unroll
          for (int o = 1; o < 64; o <<= 1) { const float t = __shfl_up(x, o); if (lane >= o) x += t; }
          const float b63 = __shfl(x, 63);
          wsc[h * 64 + lane] = __expf(b63 - x + gi[h * 64 + lane]) * 0.0625f;
          ((float*)(ws + WS_BC))[(size_t)(bh0 + h) * SEQ + t0 + lane] = x;
          if (lane == 63) ((float*)(ws + WS_DEC))[(bh0 + h) * 64 + ch] = __expf(b63); }
      __syncthreads();
      constexpr int PV = 544;
      LAS unsigned char* Vt = lds; LAS unsigned char* Kt = lds + 64 * PV;
      const int g4 = lane >> 4, q4 = (lane >> 2) & 3, p4 = lane & 3, fr = lane & 15;
      const int wd = wave & 1, we = wave >> 1;
      const bf16* QKB = (const bf16*)(ws + WS_QKB);
      for (int h = 0; h < 4; ++h) {
          { const int sr = tid >> 3, seg = tid & 7; const float wv_ = wsc[h * 64 + sr];
            const v4u* vs = (const v4u*)(Z + (size_t)(m0 + sr) * ZW + 5120 + h * 256 + 32 * seg); const v4u* ks = (const v4u*)(QKB + (size_t)(m0 + sr) * 2048 + 1024 + h * 256 + 32 * seg);
#pragma unroll
            for (int j = 0; j < 4; ++j) { *(LAS v4u*)(Vt + sr * PV + (32 * seg + 8 * j) * 2) = vs[j]; const v4u kk = ks[j];
                *(LAS v4u*)(Kt + sr * PV + (32 * seg + 8 * j) * 2) = (v4u){pk2(bflo(kk.x) * wv_, bfhi(kk.x) * wv_), pk2(bflo(kk.y) * wv_, bfhi(kk.y) * wv_), pk2(bflo(kk.z) * wv_, bfhi(kk.z) * wv_), pk2(bflo(kk.w) * wv_, bfhi(kk.w) * wv_)}; } }
          __syncthreads();
          if (tid < 256) { float sum = 0.f;
#pragma unroll 8
              for (int sr = 0; sr < 64; ++sr) sum += bf2f(*(const LAS bf16*)(Kt + sr * PV + tid * 2));
              ((float*)(ws + WS_DN))[((size_t)(bh0 + h) * 64 + ch) * 256 + tid] = sum; }
          f32x4 acc[8][4];
#pragma unroll
          for (int i = 0; i < 8; ++i)
#pragma unroll
              for (int j = 0; j < 4; ++j) acc[i][j] = (f32x4){0.f, 0.f, 0.f, 0.f};
#pragma unroll
          for (int ks2 = 0; ks2 < 2; ++ks2) {
              bf16x8 yf[4];
#pragma unroll
              for (int et = 0; et < 4; ++et) { const LAS unsigned char* p = Vt + (32 * ks2 + 8 * g4 + q4) * PV + (64 * we + 16 * et + 4 * p4) * 2;
                  const v2u lo = tr_read(p), hi = tr_read(p + 4 * PV); yf[et] = __builtin_bit_cast(bf16x8, (v4u){lo.x, lo.y, hi.x, hi.y}); }
#pragma unroll
              for (int dt = 0; dt < 8; ++dt) { const LAS unsigned char* p = Kt + (32 * ks2 + 8 * g4 + q4) * PV + (128 * wd + 16 * dt + 4 * p4) * 2;
                  const v2u lo = tr_read(p), hi = tr_read(p + 4 * PV); const bf16x8 xf = __builtin_bit_cast(bf16x8, (v4u){lo.x, lo.y, hi.x, hi.y});
#pragma unroll
                  for (int et = 0; et < 4; ++et) acc[dt][et] = __builtin_amdgcn_mfma_f32_16x16x32_bf16(xf, yf[et], acc[dt][et], 0, 0, 0); } }
          { bf16* DC = (bf16*)(ws + WS_DC) + ((size_t)(bh0 + h) * 64 + ch) * 65536;
#pragma unroll
            for (int et = 0; et < 4; ++et)
#pragma unroll
                for (int dt = 0; dt < 8; ++dt) { const f32x4 v = acc[dt][et];
                    *(v2u*)(DC + (size_t)(64 * we + 16 * et + fr) * 256 + 128 * wd + 16 * dt + 4 * g4) = (v2u){pk2(v.x, v.y), pk2(v.z, v.w)}; } }
          __syncthreads();
      }
    }
}

constexpr int AT_KSTR = 136, AT_VSTR = 72;
constexpr int AT_K_OFF = 0, AT_V_OFF = 64 * AT_KSTR * 2, AT_KM_OFF = AT_V_OFF + 128 * AT_VSTR * 2, AT_GATE_OFF = AT_KM_OFF + 16 * 128 * 4,
              AT_SEL_OFF = AT_GATE_OFF + 128 * 16 * 4, AT_TL_OFF = AT_SEL_OFF + 128 * 4, AT_END = AT_TL_OFF + 80 * 4;

__device__ __forceinline__ void attn_unit(const int wv, LAS unsigned char* lds, int b, int h, int qt) {
    const ArgsP a = get_args();
#ifdef NO_ATTN
    return;
#endif
    OPAQUE_TID(); const int lane = tid & 63, wave = __builtin_amdgcn_readfirstlane(tid >> 6), fr = lane & 15, fq = lane >> 4;
    unsigned char* ws = a->ws;
    const bf16* Z = (const bf16*)(ws + WS_Z);
    const bf16* VAT = (const bf16*)(ws + WS_VAT) + (size_t)(b * 8 + h) * 128 * SEQ;
    const int qb = qt >> 1, q0 = 128 * qt;
    LAS bf16* Kt = (LAS bf16*)(lds + AT_K_OFF); LAS bf16* Vt = (LAS bf16*)(lds + AT_V_OFF);
    LAS float* km = (LAS float*)(lds + AT_KM_OFF); LAS float* gate = (LAS float*)(lds + AT_GATE_OFF);
    LAS unsigned* sel = (LAS unsigned*)(lds + AT_SEL_OFF); LAS int* tl = (LAS int*)(lds + AT_TL_OFF);
    for (int i = tid; i < qb * 128; i += NTHR) { const int n = i >> 7, d = i & 127; const float* kp = (const float*)(ws + WS_KPART) + ((size_t)((b * 8 + h) * 64 + 4 * n)) * 128 + d;
        km[i] = (kp[0] + kp[128] + kp[256] + kp[384]) * (1.f / 256.f); }
    __syncthreads();
    { const int ql = tid >> 2, part = tid & 3; const v4u* qp = (const v4u*)(Z + (size_t)(b * SEQ + q0 + ql) * ZW + h * 128);
      if (part < qb) { float g[4] = {0, 0, 0, 0};
          for (int c = 0; c < 16; ++c) { const v4u w = qp[c]; const float qv[8] = {bflo(w.x), bfhi(w.x), bflo(w.y), bfhi(w.y), bflo(w.z), bfhi(w.z), bflo(w.w), bfhi(w.w)};
#pragma unroll
              for (int jj = 0; jj < 4; ++jj) { const int n = part + 4 * jj; if (n < qb) { const LAS float* kk = km + n * 128 + c * 8;
#pragma unroll
                  for (int i = 0; i < 8; ++i) g[jj] += qv[i] * kk[i]; } } }
#pragma unroll
          for (int jj = 0; jj < 4; ++jj) { const int n = part + 4 * jj; if (n < qb) gate[ql * 16 + n] = g[jj]; } }
    }
    __syncthreads();
    if (tid < 128) { unsigned m = 0;
        if (qb <= 3) m = (1u << qb) - 1u;
        else { for (int r = 0; r < 3; ++r) { float best = -3.0e38f; int bi = 0; for (int n = 0; n < qb; ++n) { const float g = gate[tid * 16 + n]; if (!((m >> n) & 1u) && g > best) { best = g; bi = n; } } m |= 1u << bi; } }
        sel[tid] = m; }
    __syncthreads();
    if (tid == 0) { unsigned um = 0; for (int i = 0; i < 128; ++i) um |= sel[i];
        int nt = 0; const int nown = (qt & 1) ? 4 : 2;
        for (int j = 0; j < nown; ++j) tl[1 + nt++] = (4 * qb + j) | (1 << 16);
        for (int n = 0; n < qb; ++n) if ((um >> n) & 1u) for (int j = 0; j < 4; ++j) tl[1 + nt++] = 4 * n + j;
        tl[0] = nt; }
    __syncthreads();
    const int ntile = tl[0];
    const unsigned mysel = sel[16 * wave + fr];
    unsigned wsel = mysel;
#pragma unroll
    for (int o = 1; o < 16; o <<= 1) wsel |= __shfl_xor(wsel, o);
    bf16x8 qf[4];
    { const v4u* qp = (const v4u*)(Z + (size_t)(b * SEQ + q0 + 16 * wave + fr) * ZW + h * 128);
#pragma unroll
      for (int kc = 0; kc < 4; ++kc) qf[kc] = __builtin_bit_cast(bf16x8, qp[kc * 4 + fq]); }
    f32x4 o[8];
#pragma unroll
    for (int i = 0; i < 8; ++i) o[i] = (f32x4){0.f, 0.f, 0.f, 0.f};
    float mrun = -INFINITY, lrun = 0.f;
    const float sc = 0.08838834764831845f * 1.4426950408889634f;
    const int qabs = q0 + 16 * wave + fr;
    v4u kr[2], vr[2];
    auto gload = [&](int ti) { const int kt = tl[1 + ti] & 0xffff; const int key0 = 64 * kt;
        const v4u* kp = (const v4u*)(Z + (size_t)(b * SEQ + key0 + (tid >> 3)) * ZW + 1024 + h * 128) + (tid & 7) * 2; kr[0] = kp[0]; kr[1] = kp[1];
        const v4u* vp = (const v4u*)(VAT + (size_t)(tid >> 2) * SEQ + key0) + (tid & 3) * 2; vr[0] = vp[0]; vr[1] = vp[1]; };
    auto lstore = [&]() { LAS v4u* kd = (LAS v4u*)(Kt + (tid >> 3) * AT_KSTR + (tid & 7) * 16); kd[0] = kr[0]; kd[1] = kr[1];
        LAS v4u* vd = (LAS v4u*)(Vt + (tid >> 2) * AT_VSTR + (tid & 3) * 16); vd[0] = vr[0]; vd[1] = vr[1]; };
    gload(0); lstore(); __syncthreads();
    for (int ti = 0; ti < ntile; ++ti) {
        const int ent = tl[1 + ti]; const int kt64 = ent & 0xffff; const bool own = (ent >> 16) & 1; const int key0 = 64 * kt64;
        if (ti + 1 < ntile) gload(ti + 1);
        const bool wave_active = own || ((wsel >> (kt64 >> 2)) & 1u);
        if (wave_active) {
            f32x4 s[4];
#pragma unroll
            for (int kt = 0; kt < 4; ++kt) { s[kt] = (f32x4){0.f, 0.f, 0.f, 0.f};
#pragma unroll
                for (int kc = 0; kc < 4; ++kc) { const bf16x8 kf = *(const LAS bf16x8*)(Kt + (16 * kt + fr) * AT_KSTR + kc * 32 + fq * 8);
                    s[kt] = __builtin_amdgcn_mfma_f32_16x16x32_bf16(kf, qf[kc], s[kt], 0, 0, 0); } }
            const bool qsel = own || ((mysel >> (kt64 >> 2)) & 1u);
            float mx = -INFINITY;
#pragma unroll
            for (int kt = 0; kt < 4; ++kt)
#pragma unroll
                for (int e = 0; e < 4; ++e) { const int kabs = key0 + 16 * kt + 4 * fq + e; const bool valid = own ? (kabs <= qabs) : qsel;
                    const float v = valid ? s[kt][e] * sc : -INFINITY; s[kt][e] = v; mx = fmaxf(mx, v); }
            mx = fmaxf(mx, __shfl_xor(mx, 16)); mx = fmaxf(mx, __shfl_xor(mx, 32));
            const float mnew = fmaxf(mrun, mx);
            const float alpha = (mnew == -INFINITY) ? 1.f : exp2f(mrun - mnew);
            const float msub = (mnew == -INFINITY) ? 0.f : mnew;
            float psum = 0.f;
#pragma unroll
            for (int kt = 0; kt < 4; ++kt)
#pragma unroll
                for (int e = 0; e < 4; ++e) { const float p = exp2f(s[kt][e] - msub); s[kt][e] = p; psum += p; }
            lrun = lrun * alpha + psum; mrun = mnew;
#pragma unroll
            for (int i = 0; i < 8; ++i) o[i] *= alpha;
            bf16x8 pf[2];
#pragma unroll
            for (int j = 0; j < 2; ++j) { v4u w; w.x = pk2(s[2 * j][0], s[2 * j][1]); w.y = pk2(s[2 * j][2], s[2 * j][3]); w.z = pk2(s[2 * j + 1][0], s[2 * j + 1][1]); w.w = pk2(s[2 * j + 1][2], s[2 * j + 1][3]);
                pf[j] = __builtin_bit_cast(bf16x8, w); }
#pragma unroll
            for (int dt = 0; dt < 8; ++dt)
#pragma unroll
                for (int j = 0; j < 2; ++j) { const LAS bf16* vp = Vt + (16 * dt + fr) * AT_VSTR + 32 * j + 4 * fq;
                    const v2u lo = *(const LAS v2u*)vp, hi = *(const LAS v2u*)(vp + 16);
                    const v4u w = {lo.x, lo.y, hi.x, hi.y};
                    o[dt] = __builtin_amdgcn_mfma_f32_16x16x32_bf16(__builtin_bit_cast(bf16x8, w), pf[j], o[dt], 0, 0, 0); }
        }
        __syncthreads();
        if (ti + 1 < ntile) lstore();
        __syncthreads();
    }
    float lt = lrun; lt += __shfl_xor(lt, 16); lt += __shfl_xor(lt, 32);
    const float inv = 1.f / lt;
    bf16* Y = (bf16*)(ws + WS_YE) + (size_t)(b * SEQ + qabs) * 2048 + h * 128;
#pragma unroll
    for (int dt = 0; dt < 8; ++dt) { v2u w; w.x = pk2(o[dt][0] * inv, o[dt][1] * inv); w.y = pk2(o[dt][2] * inv, o[dt][3] * inv); *(v2u*)(Y + 16 * dt + 4 * fq) = w; }
    __syncthreads();
}

__device__ __forceinline__ void mlstm_scan(const int wv) {
    const ArgsP a = get_args();
    OPAQUE_TID();
    unsigned char* ws = a->ws;
    const int gt = blockIdx.x * NTHR + tid, NGT = gridDim.x * NTHR;
    for (int idx = gt; idx < 16 * 256 * 32; idx += NGT) { const int bh = idx >> 13, rem = idx & 8191;
        const bf16* DC = (const bf16*)(ws + WS_DC) + (size_t)bh * 64 * 65536 + rem * 8; bf16* CP = (bf16*)(ws + WS_CP) + (size_t)bh * 64 * 65536 + rem * 8;
        const float* dec = (const float*)(ws + WS_DEC) + bh * 64;
        float C[8] = {0, 0, 0, 0, 0, 0, 0, 0};
        for (int c0 = 0; c0 < 64; c0 += 8) { v4u in[8];
#pragma unroll
            for (int j = 0; j < 8; ++j) in[j] = __builtin_nontemporal_load((const v4u*)(DC + (size_t)(c0 + j) * 65536));
#pragma unroll
            for (int j = 0; j < 8; ++j) { const float dc = dec[c0 + j];
                *(v4u*)(CP + (size_t)(c0 + j) * 65536) = (v4u){pk2(C[0], C[1]), pk2(C[2], C[3]), pk2(C[4], C[5]), pk2(C[6], C[7])};
                C[0] = fmaf(dc, C[0], bflo(in[j].x)); C[1] = fmaf(dc, C[1], bfhi(in[j].x)); C[2] = fmaf(dc, C[2], bflo(in[j].y)); C[3] = fmaf(dc, C[3], bfhi(in[j].y));
                C[4] = fmaf(dc, C[4], bflo(in[j].z)); C[5] = fmaf(dc, C[5], bfhi(in[j].z)); C[6] = fmaf(dc, C[6], bflo(in[j].w)); C[7] = fmaf(dc, C[7], bfhi(in[j].w)); } }
    }
    for (int idx = gt; idx < 16 * 256; idx += NGT) { const int bh = idx >> 8, d = idx & 255; const float* DN = (const float*)(ws + WS_DN) + (size_t)bh * 64 * 256 + d; float* NP = (float*)(ws + WS_NP) + (size_t)bh * 64 * 256 + d;
        const float* dec = (const float*)(ws + WS_DEC) + bh * 64; float n = 0.f;
        for (int c = 0; c < 64; ++c) { NP[c * 256] = n; n = fmaf(dec[c], n, DN[c * 256]); } }
}

constexpr int M3_PQ = 528, M3_PVv = 544, M3_PP = 144;
constexpr int M3_Q = 0, M3_K = 64 * M3_PQ, M3_V = 2 * 64 * M3_PQ, M3_P = M3_V + 64 * M3_PVv, M3_F = M3_P + 64 * M3_PP;
__device__ __forceinline__ void mlstm_out_unit(const int wv, LAS unsigned char* lds, int e_, int b, int h, int c) {
    const ArgsP a = get_args();
    OPAQUE_TID(); const int lane = tid & 63, wave = wv, fr = lane & 15, fq = lane >> 4, q4 = (lane >> 2) & 3, p4 = lane & 3;
    unsigned char* ws = a->ws;
    const int bh = b * 4 + h, m0 = b * SEQ + 64 * c;
    const bf16* QKB = (const bf16*)(ws + WS_QKB); const bf16* Z = (const bf16*)(ws + WS_Z);
    LAS unsigned char* Qt = lds + M3_Q; LAS unsigned char* Kt = lds + M3_K; LAS unsigned char* Vt = lds + M3_V; LAS unsigned char* Pm = lds + M3_P;
    LAS float* F = (LAS float*)(lds + M3_F); LAS float* bt = F; LAS float* itv = F + 64; LAS float* ebt = F + 128; LAS float* den = F + 192; LAS float* rstd = F + 256; LAS float* np = F + 320; LAS float* rsp = F + 576;
    { const int sr = tid >> 3, seg = tid & 7;
      const v4u* qs = (const v4u*)(QKB + (size_t)(m0 + sr) * 2048 + h * 256 + 32 * seg); const v4u* ks = (const v4u*)(QKB + (size_t)(m0 + sr) * 2048 + 1024 + h * 256 + 32 * seg);
      const v4u* vs = (const v4u*)(Z + (size_t)(m0 + sr) * ZW + 5120 + h * 256 + 32 * seg);
#pragma unroll
      for (int j = 0; j < 4; ++j) { *(LAS v4u*)(Qt + sr * M3_PQ + (32 * seg + 8 * j) * 2) = qs[j]; *(LAS v4u*)(Kt + sr * M3_PQ + (32 * seg + 8 * j) * 2) = ks[j]; *(LAS v4u*)(Vt + sr * M3_PVv + (32 * seg + 8 * j) * 2) = vs[j]; }
      if (tid < 64) { const float bb = ((const float*)(ws + WS_BC))[(size_t)bh * SEQ + 64 * c + tid]; bt[tid] = bb; ebt[tid] = __expf(bb); itv[tid] = ((const float*)(ws + WS_IG))[(size_t)bh * SEQ + 64 * c + tid]; }
      else if (tid < 320) np[tid - 64] = ((const float*)(ws + WS_NP))[((size_t)bh * 64 + c) * 256 + tid - 64]; }
    v4u cf[8][2];
    { const bf16* CP = (const bf16*)(ws + WS_CP) + ((size_t)bh * 64 + c) * 65536 + (size_t)(32 * wave + fr) * 256 + 8 * fq;
#pragma unroll
      for (int kk = 0; kk < 8; ++kk)
#pragma unroll
          for (int et = 0; et < 2; ++et) cf[kk][et] = *(const v4u*)(CP + et * 16 * 256 + 32 * kk); }
    __syncthreads();
    { const int ss = wave >> 1;
#pragma unroll
      for (int ti = 0; ti < 2; ++ti) { const int tt = 2 * (wave & 1) + ti; f32x4 sacc = {0.f, 0.f, 0.f, 0.f};
#pragma unroll
          for (int kk = 0; kk < 8; ++kk) { const bf16x8 kf = *(const LAS bf16x8*)(Kt + (16 * ss + fr) * M3_PQ + (32 * kk + 8 * fq) * 2), qf = *(const LAS bf16x8*)(Qt + (16 * tt + fr) * M3_PQ + (32 * kk + 8 * fq) * 2);
              sacc = __builtin_amdgcn_mfma_f32_16x16x32_bf16(kf, qf, sacc, 0, 0, 0); }
          const int t = 16 * tt + fr; const float btv = bt[t]; float pv[4];
#pragma unroll
          for (int r = 0; r < 4; ++r) { const int s_ = 16 * ss + 4 * fq + r; pv[r] = (s_ <= t) ? sacc[r] * __expf(btv - bt[s_] + itv[s_]) * 0.0625f : 0.f; }
          *(LAS v2u*)(Pm + t * M3_PP + (16 * ss + 4 * fq) * 2) = (v2u){pk2(pv[0], pv[1]), pk2(pv[2], pv[3])}; } }
    float qn;
    { const int t = tid >> 3, part = tid & 7; float sacc = 0.f;
#pragma unroll
      for (int j = 0; j < 4; ++j) { const v4u w = *(const LAS v4u*)(Qt + t * M3_PQ + (32 * part + 8 * j) * 2); const LAS float* nn = np + 32 * part + 8 * j;
          sacc += bflo(w.x) * nn[0] + bfhi(w.x) * nn[1] + bflo(w.y) * nn[2] + bfhi(w.y) * nn[3] + bflo(w.z) * nn[4] + bfhi(w.z) * nn[5] + bflo(w.w) * nn[6] + bfhi(w.w) * nn[7]; }
      sacc += dppf<0xB1>(sacc); sacc += dppf<0x4E>(sacc); sacc += dppf<0x141>(sacc); qn = sacc; }
    __syncthreads();
    { const int t = tid >> 3, part = tid & 7; const v4u w = *(const LAS v4u*)(Pm + t * M3_PP + part * 16);
      float ps = bflo(w.x) + bfhi(w.x) + bflo(w.y) + bfhi(w.y) + bflo(w.z) + bfhi(w.z) + bflo(w.w) + bfhi(w.w);
      ps += dppf<0xB1>(ps); ps += dppf<0x4E>(ps); ps += dppf<0x141>(ps);
      if (part == 0) den[t] = ebt[t] * qn + ps; }
    f32x4 acc[4][2];
#pragma unroll
    for (int tt = 0; tt < 4; ++tt) { acc[tt][0] = (f32x4){0.f, 0.f, 0.f, 0.f}; acc[tt][1] = (f32x4){0.f, 0.f, 0.f, 0.f}; }
#pragma unroll
    for (int kk = 0; kk < 8; ++kk)
#pragma unroll
        for (int tt = 0; tt < 4; ++tt) { const bf16x8 qf = *(const LAS bf16x8*)(Qt + (16 * tt + fr) * M3_PQ + (32 * kk + 8 * fq) * 2);
            acc[tt][0] = __builtin_amdgcn_mfma_f32_16x16x32_bf16(qf, __builtin_bit_cast(bf16x8, cf[kk][0]), acc[tt][0], 0, 0, 0);
            acc[tt][1] = __builtin_amdgcn_mfma_f32_16x16x32_bf16(qf, __builtin_bit_cast(bf16x8, cf[kk][1]), acc[tt][1], 0, 0, 0); }
#pragma unroll
    for (int tt = 0; tt < 4; ++tt) { const f32x4 eb = *(const LAS f32x4*)(ebt + 16 * tt + 4 * fq); acc[tt][0] *= eb; acc[tt][1] *= eb; }
#pragma unroll
    for (int j = 0; j < 2; ++j) { bf16x8 vf[2];
#pragma unroll
        for (int et = 0; et < 2; ++et) { const LAS unsigned char* p = Vt + (32 * j + 8 * fq + q4) * M3_PVv + (32 * wave + 16 * et + 4 * p4) * 2;
            const v2u lo = tr_read(p), hi = tr_read(p + 4 * M3_PVv); vf[et] = __builtin_bit_cast(bf16x8, (v4u){lo.x, lo.y, hi.x, hi.y}); }
#pragma unroll
        for (int tt = 0; tt < 4; ++tt) { const bf16x8 pf = *(const LAS bf16x8*)(Pm + (16 * tt + fr) * M3_PP + (32 * j + 8 * fq) * 2);
            acc[tt][0] = __builtin_amdgcn_mfma_f32_16x16x32_bf16(pf, vf[0], acc[tt][0], 0, 0, 0); acc[tt][1] = __builtin_amdgcn_mfma_f32_16x16x32_bf16(pf, vf[1], acc[tt][1], 0, 0, 0); } }
    __syncthreads();
    LAS unsigned char* Ht = Qt;
#pragma unroll
    for (int tt = 0; tt < 4; ++tt) { const f32x4 dn = *(const LAS f32x4*)(den + 16 * tt + 4 * fq); float ssq[4];
#pragma unroll
        for (int r = 0; r < 4; ++r) { const float dv = 1.f / fmaxf(fabsf(dn[r]), 1.f); const float h0 = acc[tt][0][r] * dv, h1 = acc[tt][1][r] * dv; ssq[r] = red16(h0 * h0 + h1 * h1);
            const int t = 16 * tt + 4 * fq + r;
            *(LAS bf16*)(Ht + t * M3_PQ + (32 * wave + fr) * 2) = (bf16)f2bf(h0); *(LAS bf16*)(Ht + t * M3_PQ + (32 * wave + 16 + fr) * 2) = (bf16)f2bf(h1); }
        if (fr == 0) *(LAS f32x4*)(rsp + wave * 64 + 16 * tt + 4 * fq) = (f32x4){ssq[0], ssq[1], ssq[2], ssq[3]}; }
    __syncthreads();
    if (tid < 64) { float tot = 0.f;
#pragma unroll
        for (int w = 0; w < 8; ++w) tot += rsp[w * 64 + tid];
        rstd[tid] = 1.f / sqrtf(tot * (1.f / 256.f) + 1e-6f); }
    __syncthreads();
    { const int t = tid >> 3, seg = tid & 7; const float rs = rstd[t]; const float* hg = a->in[5] + (size_t)e_ * 1024 + h * 256 + 32 * seg;
      const v4u* os = (const v4u*)(Z + (size_t)(m0 + t) * ZW + 6144 + h * 256 + 32 * seg); v4u* yd = (v4u*)((bf16*)(ws + WS_YE) + (size_t)(m0 + t) * 2048 + 1024 + h * 256 + 32 * seg);
#pragma unroll
      for (int j = 0; j < 4; ++j) { const v4u hw = *(const LAS v4u*)(Ht + t * M3_PQ + (32 * seg + 8 * j) * 2), ow = os[j]; const f32x4 g0 = *(const f32x4*)(hg + 8 * j), g1 = *(const f32x4*)(hg + 8 * j + 4);
          yd[j] = (v4u){pk2(bflo(hw.x) * rs * g0.x * sigmoidf_(bflo(ow.x)), bfhi(hw.x) * rs * g0.y * sigmoidf_(bfhi(ow.x))), pk2(bflo(hw.y) * rs * g0.z * sigmoidf_(bflo(ow.y)), bfhi(hw.y) * rs * g0.w * sigmoidf_(bfhi(ow.y))),
                        pk2(bflo(hw.z) * rs * g1.x * sigmoidf_(bflo(ow.z)), bfhi(hw.z) * rs * g1.y * sigmoidf_(bfhi(ow.z))), pk2(bflo(hw.w) * rs * g1.z * sigmoidf_(bflo(ow.w)), bfhi(hw.w) * rs * g1.w * sigmoidf_(bfhi(ow.w)))}; } }
    __syncthreads();
}

__device__ __forceinline__ void odd_prep(const int wv, int o) {
    const ArgsP a = get_args();
#ifdef NO_OPREP
    return;
#endif
    OPAQUE_TID(); const int lane = tid & 63, wave = tid >> 6;
    unsigned char* ws = a->ws;
    const float* mu = a->in[7] + (size_t)o * 6 * 2048;
    bf16* XR = (bf16*)(ws + WS_XRKV); bf16* XK = XR + (size_t)T_ * 2048; bf16* XV = XK + (size_t)T_ * 2048; bf16* XC = (bf16*)(ws + WS_XC);
    const int gw = blockIdx.x * NWAVES + wave, NGW = gridDim.x * NWAVES;
    for (int m = gw; m < T_; m += NGW) { const bool first = (m % SEQ) == 0;
        const f32x4* xr = (const f32x4*)(a->out + (size_t)m * D_) + lane; const f32x4* xp = (const f32x4*)(a->out + (size_t)(m - 1) * D_) + lane;
#pragma unroll
        for (int j = 0; j < 8; ++j) { const f32x4 x = xr[64 * j]; f32x4 p = {0.f, 0.f, 0.f, 0.f}; if (!first) p = xp[64 * j]; const f32x4 dx = p - x;
            const f32x4 m0 = ((const f32x4*)mu)[lane + 64 * j], m2 = ((const f32x4*)(mu + 2 * 2048))[lane + 64 * j], m3 = ((const f32x4*)(mu + 3 * 2048))[lane + 64 * j];
            const f32x4 r = x + dx * m0, k = x + dx * m2, v = x + dx * m3; const size_t off = (size_t)m * 2048 + 4 * (lane + 64 * j);
            *(v2u*)(XR + off) = (v2u){pk2(r.x, r.y), pk2(r.z, r.w)}; *(v2u*)(XK + off) = (v2u){pk2(k.x, k.y), pk2(k.z, k.w)}; *(v2u*)(XV + off) = (v2u){pk2(v.x, v.y), pk2(v.z, v.w)};
            const size_t offc = (size_t)m * 4096 + 4 * (lane + 64 * j);
            *(v2u*)(XC + offc) = (v2u){pk2(x.x, x.y), pk2(x.z, x.w)}; *(v2u*)(XC + offc + 2048) = (v2u){pk2(dx.x, dx.y), pk2(dx.z, dx.w)}; }
    }
}

constexpr int RW_CH = 32, RW_ARR = RW_CH * 64 * 4;
constexpr int RW_W = 0, RW_KK = RW_ARR, RW_BB = 2 * RW_ARR, RW_KH = 3 * RW_ARR, RW_R = 4 * RW_ARR, RW_V = 5 * RW_ARR, RW_G = 6 * RW_ARR, RW_BUF = 7 * RW_ARR;
__device__ __forceinline__ void rwkv_unit(const int wv, LAS unsigned char* lds, int o, int b, int h) {
    const ArgsP a = get_args();
#ifdef NO_RWKV
    return;
#endif
    OPAQUE_TID(); const int lane = tid & 63, wave = tid >> 6, rp = lane >> 4, kq = lane & 15, pst = tid >> 4;
    unsigned char* ws = a->ws;
    const size_t rowbase = (size_t)b * SEQ * 2048 + h * 64 + 4 * kq;
    const bf16* Rb = (const bf16*)(ws + WS_RKV) + rowbase; const bf16* Kb = Rb + (size_t)T_ * 2048;
    const bf16* Vb = ((o == 0) ? (const bf16*)(ws + WS_VF) : (const bf16*)(ws + WS_RKV) + (size_t)2 * T_ * 2048) + rowbase;
    const bf16* Gb = (const bf16*)(ws + WS_G) + rowbase; const bf16* WDb = (const bf16*)(ws + WS_WD) + rowbase; const bf16* AAb = (const bf16*)(ws + WS_AA) + rowbase;
    bf16* Yb = (bf16*)(ws + WS_YO) + rowbase;
    const int pc = h * 64 + 4 * kq;
    const f32x4 p_kk = *(const f32x4*)(a->in[20] + (size_t)o * 2048 + pc), p_ka = *(const f32x4*)(a->in[21] + (size_t)o * 2048 + pc), p_rk = *(const f32x4*)(a->in[22] + (size_t)o * 2048 + pc);
    const f32x4 p_lg = *(const f32x4*)(a->in[23] + (size_t)o * 2048 + pc), p_lb = *(const f32x4*)(a->in[24] + (size_t)o * 2048 + pc);
    LAS float* ybuf = (LAS float*)(lds + 2 * RW_BUF);
    float S0[4] = {0, 0, 0, 0}, S1[4] = {0, 0, 0, 0};
    v2u gk, ga, gw_, gr, gv, gg;
    auto gload = [&](int c) { const size_t off = (size_t)(c * RW_CH + pst) * 2048;
        gk = *(const v2u*)(Kb + off); ga = *(const v2u*)(AAb + off); gw_ = *(const v2u*)(WDb + off); gr = *(const v2u*)(Rb + off); gv = *(const v2u*)(Vb + off); gg = *(const v2u*)(Gb + off); };
    auto lstore = [&](int bufi) { LAS unsigned char* B = lds + bufi * RW_BUF; const int eo = (pst * 64 + 4 * kq) * 4;
        const f32x4 k = {bflo(gk.x), bfhi(gk.x), bflo(gk.y), bfhi(gk.y)}, aa = {bflo(ga.x), bfhi(ga.x), bflo(ga.y), bfhi(ga.y)};
        const f32x4 kx = k * p_kk; const float n2 = red16(kx.x * kx.x + kx.y * kx.y + kx.z * kx.z + kx.w * kx.w);
        const float inv = 1.f / fmaxf(sqrtf(n2), 1e-12f); const f32x4 kk = kx * inv;
        *(LAS f32x4*)(B + RW_KK + eo) = kk; *(LAS f32x4*)(B + RW_BB + eo) = kk * aa; *(LAS f32x4*)(B + RW_KH + eo) = k * (1.f + (aa - 1.f) * p_ka);
        *(LAS f32x4*)(B + RW_W + eo) = (f32x4){__expf(bflo(gw_.x)), __expf(bfhi(gw_.x)), __expf(bflo(gw_.y)), __expf(bfhi(gw_.y))};
        *(LAS f32x4*)(B + RW_R + eo) = (f32x4){bflo(gr.x), bfhi(gr.x), bflo(gr.y), bfhi(gr.y)};
        *(LAS f32x4*)(B + RW_V + eo) = (f32x4){bflo(gv.x), bfhi(gv.x), bflo(gv.y), bfhi(gv.y)};
        *(LAS f32x4*)(B + RW_G + eo) = (f32x4){bflo(gg.x), bfhi(gg.x), bflo(gg.y), bfhi(gg.y)}; };
    gload(0); lstore(0); __syncthreads();
    constexpr int NCH = SEQ / RW_CH;
    const int vrow = 8 * wave + 2 * rp;
    for (int c = 0; c < NCH; ++c) {
        if (c + 1 < NCH) gload(c + 1);
        LAS unsigned char* B = lds + (c & 1) * RW_BUF;
#pragma unroll 4
        for (int st = 0; st < RW_CH; ++st) { const int eo = (st * 64 + 4 * kq) * 4;
            const f32x4 w = *(const LAS f32x4*)(B + RW_W + eo), kk = *(const LAS f32x4*)(B + RW_KK + eo), bb = *(const LAS f32x4*)(B + RW_BB + eo),
                        kh = *(const LAS f32x4*)(B + RW_KH + eo), r = *(const LAS f32x4*)(B + RW_R + eo);
            const f32x2 vv = *(const LAS f32x2*)(B + RW_V + (st * 64 + vrow) * 4);
            float u0 = S0[0] * kk.x + S0[1] * kk.y + S0[2] * kk.z + S0[3] * kk.w, u1 = S1[0] * kk.x + S1[1] * kk.y + S1[2] * kk.z + S1[3] * kk.w;
            u0 = red16(u0); u1 = red16(u1);
#pragma unroll
            for (int j = 0; j < 4; ++j) { S0[j] = fmaf(S0[j], w[j], fmaf(-u0, bb[j], vv.x * kh[j])); S1[j] = fmaf(S1[j], w[j], fmaf(-u1, bb[j], vv.y * kh[j])); }
            float y0 = S0[0] * r.x + S0[1] * r.y + S0[2] * r.z + S0[3] * r.w, y1 = S1[0] * r.x + S1[1] * r.y + S1[2] * r.z + S1[3] * r.w;
            y0 = red16(y0); y1 = red16(y1);
            if (kq == 0) *(LAS f32x2*)(ybuf + st * 64 + vrow) = (f32x2){y0, y1};
        }
        __syncthreads();
        if (c + 1 < NCH) lstore((c + 1) & 1);
        {
            const int eo = (pst * 64 + 4 * kq) * 4;
            const f32x4 y = *(const LAS f32x4*)((LAS unsigned char*)ybuf + eo), r = *(const LAS f32x4*)(B + RW_R + eo), kh = *(const LAS f32x4*)(B + RW_KH + eo),
                        v = *(const LAS f32x4*)(B + RW_V + eo), g = *(const LAS f32x4*)(B + RW_G + eo);
            const float mean = red16(y.x + y.y + y.z + y.w) * (1.f / 64.f); const f32x4 d = y - mean;
            const float var = red16(d.x * d.x + d.y * d.y + d.z * d.z + d.w * d.w) * (1.f / 64.f); const float rstd = 1.f / sqrtf(var + 64e-5f);
            const f32x4 rk = r * kh * p_rk; const float bon = red16(rk.x + rk.y + rk.z + rk.w);
            const f32x4 ov = (d * rstd * p_lg + p_lb + bon * v) * g;
            *(v2u*)(Yb + (size_t)(c * RW_CH + pst) * 2048) = (v2u){pk2(ov.x, ov.y), pk2(ov.z, ov.w)}; }
        __syncthreads();
    }
}

__device__ __forceinline__ void ln_router(const int wv, int l) {
    const ArgsP a = get_args();
#ifdef NO_ROUTER
    return;
#endif
    OPAQUE_TID(); const int lane = tid & 63, wave = tid >> 6;
    unsigned char* ws = a->ws;
    const float* lg = a->in[28] + (size_t)l * 2048; const float* lb = a->in[29] + (size_t)l * 2048;
    const float* Wg = a->in[32] + (size_t)l * 2048 * 4; const float* bg = a->in[33] + l * 4; const float* We = a->in[34] + (size_t)l * 2048 * 32; const float* be = a->in[35] + l * 32;
    unsigned* cnt = (unsigned*)(ws + WS_CTL) + CW_CNT + (size_t)l * 32 * 64;
    int* TOKE = (int*)(ws + WS_TOKE); int* TOKR = (int*)(ws + WS_TOKR); float* TOKG = (float*)(ws + WS_TOKG);
    const int gw = blockIdx.x * NWAVES + wave, NGW = gridDim.x * NWAVES;
    for (int m = gw; m < T_; m += NGW) {
        f32x4* xr = (f32x4*)(a->out + (size_t)m * D_) + lane; f32x4 v[8]; float s = 0.f;
#pragma unroll
        for (int j = 0; j < 8; ++j) { v[j] = xr[64 * j]; s += (v[j].x + v[j].y) + (v[j].z + v[j].w); }
        const float mean = wave_sum(s) * (1.f / D_); float s2 = 0.f;
#pragma unroll
        for (int j = 0; j < 8; ++j) { v[j] = v[j] - mean; s2 += (v[j].x * v[j].x + v[j].y * v[j].y) + (v[j].z * v[j].z + v[j].w * v[j].w); }
        const float rstd = 1.f / sqrtf(wave_sum(s2) * (1.f / D_) + LN_EPS);
        float ag[4] = {0, 0, 0, 0};
#pragma unroll
        for (int j = 0; j < 8; ++j) { const f32x4 g = ((const f32x4*)lg)[lane + 64 * j], bb = ((const f32x4*)lb)[lane + 64 * j]; v[j] = v[j] * rstd * g + bb; xr[64 * j] = v[j];
            ((v2u*)(ws + WS_XB))[(size_t)m * 512 + lane + 64 * j] = (v2u){pk2(v[j].x, v[j].y), pk2(v[j].z, v[j].w)};
            const f32x4* wp = (const f32x4*)Wg + 4 * (lane + 64 * j);
#pragma unroll
            for (int i = 0; i < 4; ++i) { const f32x4 w = wp[i]; const float x = v[j][i]; ag[0] += x * w.x; ag[1] += x * w.y; ag[2] += x * w.z; ag[3] += x * w.w; } }
#pragma unroll
        for (int i = 0; i < 4; ++i) ag[i] = wave_sum(ag[i]) + bg[i];
        int gi = 0; float gm = ag[0];
#pragma unroll
        for (int i = 1; i < 4; ++i) if (ag[i] > gm) { gm = ag[i]; gi = i; }
        float gs = 0.f;
#pragma unroll
        for (int i = 0; i < 4; ++i) gs += __expf(ag[i] - gm);
        const float gp = 1.f / gs;
        float ae[8] = {0, 0, 0, 0, 0, 0, 0, 0};
#pragma unroll
        for (int j = 0; j < 8; ++j) {
#pragma unroll
            for (int i = 0; i < 4; ++i) { const float* wr = We + (size_t)(4 * (lane + 64 * j) + i) * 32 + 8 * gi; const f32x4 w0 = *(const f32x4*)wr, w1 = *(const f32x4*)(wr + 4); const float x = v[j][i];
                ae[0] += x * w0.x; ae[1] += x * w0.y; ae[2] += x * w0.z; ae[3] += x * w0.w; ae[4] += x * w1.x; ae[5] += x * w1.y; ae[6] += x * w1.z; ae[7] += x * w1.w; } }
#pragma unroll
        for (int i = 0; i < 8; ++i) ae[i] = wave_sum(ae[i]) + be[8 * gi + i];
        int e1 = 0; float m1 = ae[0];
#pragma unroll
        for (int i = 1; i < 8; ++i) if (ae[i] > m1) { m1 = ae[i]; e1 = i; }
        int e2 = -1; float m2 = -3.0e38f;
#pragma unroll
        for (int i = 0; i < 8; ++i) if (i != e1 && ae[i] > m2) { m2 = ae[i]; e2 = i; }
        const float p2 = __expf(m2 - m1), den = 1.f / (1.f + p2);
        if (lane == 0) { const int x1 = 8 * gi + e1, x2 = 8 * gi + e2;
            const unsigned r1 = __hip_atomic_fetch_add(cnt + x1 * 64, 1u, __ATOMIC_RELAXED, __HIP_MEMORY_SCOPE_AGENT);
            const unsigned r2 = __hip_atomic_fetch_add(cnt + x2 * 64, 1u, __ATOMIC_RELAXED, __HIP_MEMORY_SCOPE_AGENT);
            TOKE[2 * m] = x1; TOKE[2 * m + 1] = x2; TOKR[2 * m] = (int)r1; TOKR[2 * m + 1] = (int)r2; TOKG[2 * m] = gp * den; TOKG[2 * m + 1] = gp * p2 * den; }
    }
}

struct MoeTab { LAS int* start; LAS int* tileE; LAS int* ntiles; };
__device__ __forceinline__ MoeTab moe_tables(const int wv, int l, LAS unsigned char* lds) {
    const ArgsP a = get_args();
    MoeTab t; t.start = (LAS int*)(lds + MISC_OFF + 256); t.tileE = t.start + 40; t.ntiles = t.tileE + 168;
    OPAQUE_TID();
    if (tid == 0) { unsigned* cnt = (unsigned*)(a->ws + WS_CTL) + CW_CNT + (size_t)l * 32 * 64; int acc = 0;
        for (int e = 0; e < 32; ++e) { const int c = (int)__hip_atomic_load(cnt + e * 64, __ATOMIC_RELAXED, __HIP_MEMORY_SCOPE_AGENT); const int pad = (c + 255) & ~255;
            t.start[e] = acc; for (int q = acc >> 8; q < ((acc + pad) >> 8) && q < MOE_TILES; ++q) t.tileE[q] = e; acc += pad; }
        int nt = acc >> 8; if (nt > MOE_TILES) nt = MOE_TILES; *t.ntiles = nt; }
    __syncthreads();
    return t;
}
__device__ __forceinline__ void moe_gather(const int wv, const MoeTab& tb) {
    const ArgsP a = get_args();
#ifdef NO_GATHER
    return;
#endif
    OPAQUE_TID(); const int lane = tid & 63, wave = tid >> 6;
    unsigned char* ws = a->ws;
    const int* TOKE = (const int*)(ws + WS_TOKE); const int* TOKR = (const int*)(ws + WS_TOKR); int* SLOT = (int*)(ws + WS_SLOT);
    const int gw = blockIdx.x * NWAVES + wave, NGW = gridDim.x * NWAVES;
    for (int it = gw; it < 2 * T_; it += NGW) { const int m = it >> 1; const int dest = tb.start[TOKE[it]] + TOKR[it];
        if (lane == 0) SLOT[it] = dest;
        const v4u* src = (const v4u*)(ws + WS_XB) + (size_t)m * 256 + lane; v4u* dst = (v4u*)(ws + WS_XS) + (size_t)dest * 256 + lane;
#pragma unroll
        for (int j = 0; j < 4; ++j) dst[64 * j] = src[64 * j]; }
}
template <int NJ> struct MoeOrder {
    LAS int* tileE; int nunits, G, c;
    __device__ bool next(int i, pg8::Unit& u) const { const int L = i * G + c; if (L >= nunits) return false; u.pm = L / NJ; u.pn = tileE[u.pm] * NJ + (L % NJ); u.aoff = 0; return true; }
    __device__ __forceinline__ void a_ready(const pg8::Unit&) const {}
    __device__ __forceinline__ void done(const pg8::Unit&) const {}
};
__device__ __forceinline__ void moe_combine_ln(const int wv, int l) {
    const ArgsP a = get_args();
#ifdef NO_COMBINE
    return;
#endif
    OPAQUE_TID(); const int lane = tid & 63, wave = tid >> 6;
    unsigned char* ws = a->ws;
    const float* lg = a->in[30] + (size_t)l * 2048; const float* lb = a->in[31] + (size_t)l * 2048;
    const int* SLOT = (const int*)(ws + WS_SLOT); const float* TOKG = (const float*)(ws + WS_TOKG); const bf16* YS = (const bf16*)(ws + WS_YS);
    const int gw = blockIdx.x * NWAVES + wave, NGW = gridDim.x * NWAVES;
    for (int m = gw; m < T_; m += NGW) {
        f32x4* xr = (f32x4*)(a->out + (size_t)m * D_) + lane; f32x4 v[8]; float s = 0.f;
        const int s0 = SLOT[2 * m], s1 = SLOT[2 * m + 1]; const float g0 = TOKG[2 * m], g1 = TOKG[2 * m + 1];
        const v2u* y0 = (const v2u*)(YS + (size_t)s0 * 2048) + lane; const v2u* y1 = (const v2u*)(YS + (size_t)s1 * 2048) + lane;
#pragma unroll
        for (int j = 0; j < 8; ++j) { const f32x4 x = xr[64 * j]; const v2u a0 = y0[64 * j], a1 = y1[64 * j];
            v[j].x = DN_ALPHA * x.x + g0 * bflo(a0.x) + g1 * bflo(a1.x); v[j].y = DN_ALPHA * x.y + g0 * bfhi(a0.x) + g1 * bfhi(a1.x);
            v[j].z = DN_ALPHA * x.z + g0 * bflo(a0.y) + g1 * bflo(a1.y); v[j].w = DN_ALPHA * x.w + g0 * bfhi(a0.y) + g1 * bfhi(a1.y);
            s += (v[j].x + v[j].y) + (v[j].z + v[j].w); }
        const float mean = wave_sum(s) * (1.f / D_); float s2 = 0.f;
#pragma unroll
        for (int j = 0; j < 8; ++j) { v[j] = v[j] - mean; s2 += (v[j].x * v[j].x + v[j].y * v[j].y) + (v[j].z * v[j].z + v[j].w * v[j].w); }
        const float rstd = 1.f / sqrtf(wave_sum(s2) * (1.f / D_) + LN_EPS);
#pragma unroll
        for (int j = 0; j < 8; ++j) { const f32x4 g = ((const f32x4*)lg)[lane + 64 * j], bb = ((const f32x4*)lb)[lane + 64 * j]; v[j] = v[j] * rstd * g + bb; xr[64 * j] = v[j];
            ((v2u*)(ws + WS_XB))[(size_t)m * 512 + lane + 64 * j] = (v2u){pk2(v[j].x, v[j].y), pk2(v[j].z, v[j].w)}; }
    }
}

struct RkvOrder {
    pg8::StaticOrder in; int G, c;
    __device__ bool next(int i, pg8::Unit& u) const { const long L = (long)i * G + c; if (L >= 1536) return false; const int g = (int)(L / 512);
        in.at(L % 512, u); u.pm += 64 * g; u.pn += 8 * g; return true; }
    __device__ __forceinline__ void a_ready(const pg8::Unit&) const {}
    __device__ __forceinline__ void done(const pg8::Unit&) const {}
};
struct L2Order {
    int nunits, G, c;
    __device__ bool next(int i, pg8::Unit& u) const { const int L = i * G + c; if (L >= nunits) return false; u.pn = L >> 6; u.pm = L & 63; u.aoff = (u.pn >= 8) ? 512 : 0; return true; }
    __device__ __forceinline__ void a_ready(const pg8::Unit&) const {}
    __device__ __forceinline__ void done(const pg8::Unit&) const {}
};


#ifndef REP_PROL
#define REP_PROL 1
#endif
#ifndef REP_INPROJ
#define REP_INPROJ 1
#endif
#ifndef REP_ATTN
#define REP_ATTN 1
#endif
#ifndef REP_MLSTM
#define REP_MLSTM 1
#endif
#ifndef REP_HNORM
#define REP_HNORM 1
#endif
#ifndef REP_OPREP
#define REP_OPREP 1
#endif
#ifndef REP_RKV
#define REP_RKV 1
#endif
#ifndef REP_RWKV
#define REP_RWKV 1
#endif
#ifndef REP_GATHER
#define REP_GATHER 1
#endif
#ifndef REP_GU
#define REP_GU 1
#endif
#ifndef REP_DN
#define REP_DN 1
#endif
#define REPX_1(...) __VA_ARGS__
#define REPX_2(...) __VA_ARGS__ __VA_ARGS__
#define REPX_3(...) __VA_ARGS__ __VA_ARGS__ __VA_ARGS__
#define REPX_(n, ...) REPX_##n(__VA_ARGS__)
#define REPX(n, ...) REPX_(n, __VA_ARGS__)

constexpr int N_PHASES = 41;

__global__ void __launch_bounds__(NTHR, 2) fwd(Args args) {
    extern __shared__ __attribute__((aligned(16))) unsigned char lds_raw[];
    LAS unsigned char* lds = (LAS unsigned char*)lds_raw;
    const int wv = __builtin_amdgcn_readfirstlane((int)threadIdx.x >> 6);
    OPAQUE_TID();
    const ArgsP ap0 = get_args();
    if (tid < 16) ((LAS unsigned*)(lds + MISC_OFF))[tid] = 0u;
    __syncthreads();
#if ONE_LAUNCH
    XcdBarrier bar = xcd_barrier_post((unsigned*)(ap0->ws + WS_CTL) + CW_BAR, (volatile LAS unsigned*)(lds + MISC_OFF), tid == 0);
#define SEAM(k) do { if ((k) + 1 < hi) xcd_barrier(bar, tid == 0); } while (0)
#define SEAMR() xcd_barrier(bar, tid == 0)
#else
#define SEAM(k) do { } while (0)
#define SEAMR() do { } while (0)
#endif
    const int lo = ap0->ph_lo, hi = ap0->ph_hi;
#define IN(k) (lo <= (k) && (k) < hi)
    const int G = gridDim.x, cb = blockIdx.x;

    if (IN(0)) { REPX(REP_PROL, { prologue(wv, lds); SEAMR(); }) }

    auto layer = [&](auto lc) __attribute__((always_inline)) { constexpr int l = decltype(lc)::value;
        const int pb = 1 + 10 * l, eo = l >> 1;
        if ((l & 1) == 0) {
            if (IN(pb + 0)) {
                const ArgsP ap = get_args(); unsigned char* ws = ap->ws;
                pg8::Gemm g{(const bf16*)(ws + WS_XB), (const bf16*)(ws + WS_WIN) + (size_t)eo * ZW * 2048, 2048, 2048, 2048};
                pg8::StaticOrder S; S.init(T_, ZW, G, cb);
                pg8::EpiBf16 E{(bf16*)(ws + WS_Z), ZW, 0, 0, 0, nullptr};
                REPX(REP_INPROJ, { pg8::gemm_phase<pg8::EpiBf16, pg8::StaticOrder, true, false>(wv, lds, g, S, E); SEAMR(); })
            }
            if (IN(pb + 1)) { for (int u = cb; u < 256; u += G) even_prep(wv, eo, lds, u); SEAM(pb + 1); }
            if (IN(pb + 2)) {
                REPX(REP_ATTN, { for (int L = cb; L < 1024; L += G) { const int i = L >> 8, c = L & 255; const int qt = (i & 1) ? (24 - 8 * i + (c >> 5)) : (31 - 8 * i - (c >> 5)); const int bh = c & 31;
                    attn_unit(wv, lds, bh >> 3, bh & 7, qt); } })
                REPX(REP_MLSTM, { mlstm_scan(wv); })
                SEAM(pb + 2);
            }
            if (IN(pb + 3)) { REPX(REP_HNORM, { for (int u = cb; u < 1024; u += G) mlstm_out_unit(wv, lds, eo, u >> 8, (u >> 6) & 3, u & 63); SEAMR(); }) }
        } else {
            if (IN(pb + 0)) { REPX(REP_OPREP, { odd_prep(wv, eo); SEAMR(); }) }
            if (IN(pb + 1)) {
                const ArgsP ap = get_args(); unsigned char* ws = ap->ws;
                { pg8::Gemm g{(const bf16*)(ws + WS_XRKV), (const bf16*)(ws + WS_WRKV) + (size_t)eo * 3 * 2048 * 2048, 2048, 2048, 2048};
                  RkvOrder S; S.in.init(T_, 2048, G, cb); S.G = G; S.c = cb;
                  pg8::EpiBf16 E{(bf16*)(ws + WS_RKV), 2048, 64, 8, (size_t)T_ * 2048, (eo == 0) ? (bf16*)(ws + WS_VF) : nullptr};
                  REPX(REP_RKV, { pg8::gemm_phase<pg8::EpiBf16, RkvOrder, true, false>(wv, lds, g, S, E); __syncthreads(); }) }
                __syncthreads();
                { pg8::Gemm g{(const bf16*)(ws + WS_XC), (const bf16*)(ws + WS_WL1) + (size_t)eo * 512 * 4096, 4096, 4096, 4096};
                  pg8::StaticOrder S; S.init(T_, 512, G, cb);
                  pg8::EpiL1 E{(bf16*)(ws + WS_L1)};
                  pg8::gemm_phase<pg8::EpiL1, pg8::StaticOrder, true, false>(wv, lds, g, S, E); }
                SEAM(pb + 1);
            }
            if (IN(pb + 2)) {
                const ArgsP ap = get_args(); unsigned char* ws = ap->ws;
                pg8::Gemm g{(const bf16*)(ws + WS_L1), (const bf16*)(ws + WS_WL2) + (size_t)eo * 8192 * 256, 256, 512, 256};
                L2Order S{(eo == 0 ? 24 : 32) * 64, G, cb};
                pg8::EpiL2 E{(bf16*)(ws + WS_G), (bf16*)(ws + WS_WD), (bf16*)(ws + WS_AA), (bf16*)(ws + WS_RKV) + (size_t)2 * T_ * 2048, (const bf16*)(ws + WS_VF),
                             ap->in[12] + (size_t)eo * 2048, ap->in[15] + (size_t)eo * 2048, ap->in[25]};
                pg8::gemm_phase<pg8::EpiL2, L2Order, true, false>(wv, lds, g, S, E);
                SEAM(pb + 2);
            }
            if (IN(pb + 3)) { REPX(REP_RWKV, { for (int u = cb; u < 128; u += G) rwkv_unit(wv, lds, eo, u >> 5, u & 31); SEAMR(); }) }
        }
        if (IN(pb + 4)) {
            const bool ev = (l & 1) == 0; const ArgsP ap = get_args(); unsigned char* ws = ap->ws;
            pg8::Gemm g{(const bf16*)(ws + (ev ? WS_YE : WS_YO)), (const bf16*)(ws + (ev ? WS_WOUT : WS_WO)) + (size_t)eo * 2048 * 2048, 2048, 2048, 2048};
            pg8::StaticOrder S; S.init(T_, 2048, G, cb);
            pg8::EpiResid E{ap->out, 2048, DN_ALPHA};
            pg8::gemm_phase<pg8::EpiResid, pg8::StaticOrder, true, false>(wv, lds, g, S, E);
            SEAM(pb + 4);
        }
        if (IN(pb + 5)) { ln_router(wv, l); SEAM(pb + 5); }
        if (IN(pb + 6)) { const MoeTab tb = moe_tables(wv, l, lds); REPX(REP_GATHER, { moe_gather(wv, tb); SEAMR(); }) }
        if (IN(pb + 7)) { const MoeTab tb = moe_tables(wv, l, lds); const ArgsP ap = get_args(); unsigned char* ws = ap->ws;
            pg8::Gemm g{(const bf16*)(ws + WS_XS), (const bf16*)(ws + WS_WGU) + (size_t)l * 32 * 1024 * 2048, 2048, 2048, 2048};
            MoeOrder<4> S{tb.tileE, *tb.ntiles * 4, G, cb};
            pg8::EpiSilu E{(bf16*)(ws + WS_HID)};
            REPX(REP_GU, { pg8::gemm_phase<pg8::EpiSilu, MoeOrder<4>, true, false>(wv, lds, g, S, E); SEAMR(); })
        }
        if (IN(pb + 8)) { const MoeTab tb = moe_tables(wv, l, lds); const ArgsP ap = get_args(); unsigned char* ws = ap->ws;
            pg8::Gemm g{(const bf16*)(ws + WS_HID), (const bf16*)(ws + WS_WDN) + (size_t)l * 32 * 2048 * 512, 512, 512, 512};
            MoeOrder<8> S{tb.tileE, *tb.ntiles * 8, G, cb};
            pg8::EpiBf16 E{(bf16*)(ws + WS_YS), 2048, 0, 8, 0, nullptr};
            REPX(REP_DN, { pg8::gemm_phase<pg8::EpiBf16, MoeOrder<8>, true, false>(wv, lds, g, S, E); SEAMR(); })
        }
        if (IN(pb + 9)) { moe_combine_ln(wv, l); SEAM(pb + 9); }
        };
    layer(std::integral_constant<int, 0>{}); layer(std::integral_constant<int, 1>{}); layer(std::integral_constant<int, 2>{}); layer(std::integral_constant<int, 3>{});
#undef IN
#undef SEAM
}

extern "C" void kernel_launch(void* const* d_in, const int* in_sizes, int n_in, void* d_out, int out_size, void* d_ws, size_t ws_size, hipStream_t stream) {
    static int grid = 0;
    if (grid == 0) {
        if (n_in != 39 || in_sizes[0] != T_ * D_ || out_size != T_ * D_ || ws_size < WS_END) {
            fprintf(stderr, "kernel_launch: unexpected problem: n_in %d in0 %d out %d ws %zu (need %zu)\n", n_in, n_in > 0 ? in_sizes[0] : -1, out_size, ws_size, (size_t)WS_END); grid = -1; return; }
        int dev = 0, cus = 0, per_cu = 0;
        if (hipGetDevice(&dev) != hipSuccess || hipDeviceGetAttribute(&cus, hipDeviceAttributeMultiprocessorCount, dev) != hipSuccess) { fprintf(stderr, "kernel_launch: device query failed\n"); grid = -1; return; }
        if (hipFuncSetAttribute((const void*)fwd, hipFuncAttributeMaxDynamicSharedMemorySize, LDS_BYTES) != hipSuccess) { fprintf(stderr, "kernel_launch: hipFuncSetAttribute failed\n"); grid = -1; return; }
        if (hipOccupancyMaxActiveBlocksPerMultiprocessor(&per_cu, (const void*)fwd, NTHR, LDS_BYTES) != hipSuccess || per_cu < 1)
            fprintf(stderr, "kernel_launch: note: occupancy query reports %d workgroups per CU\n", per_cu);
        (void)hipGetLastError();
        grid = cus;
    }
    if (grid < 0) return;
    if (hipMemsetAsync((char*)d_ws + WS_CTL, 0, CTL_ZERO_BYTES, stream) != hipSuccess) { fprintf(stderr, "kernel_launch: memset failed\n"); return; }
    Args a{};
    for (int i = 0; i < 39; ++i) a.in[i] = (const float*)d_in[i];
    a.out = (float*)d_out; a.ws = (unsigned char*)d_ws;
#if ONE_LAUNCH
    a.ph_lo = 0; a.ph_hi = N_PHASES;
    hipLaunchKernelGGL(fwd, dim3(grid), dim3(NTHR), LDS_BYTES, stream, a);
#else
    for (int p = 0; p < N_PHASES; ++p) { a.ph_lo = p; a.ph_hi = p + 1; hipLaunchKernelGGL(fwd, dim3(grid), dim3(NTHR), LDS_BYTES, stream, a); }
#endif
    const hipError_t le = hipPeekAtLastError();
    if (le != hipSuccess) fprintf(stderr, "kernel_launch: launch failed: %s\n", hipGetErrorName(le));
}
```

```cpp
#include <hip/hip_runtime.h>
#include <cstdio>
#include <cstdint>
#include <type_traits>

#ifndef ONE_LAUNCH
#define ONE_LAUNCH 1
#endif

#define LAS __attribute__((address_space(3)))
typedef unsigned short bf16;
typedef unsigned v4u __attribute__((ext_vector_type(4)));
typedef unsigned v2u __attribute__((ext_vector_type(2)));
typedef float f32x4 __attribute__((ext_vector_type(4)));
typedef float f32x2 __attribute__((ext_vector_type(2)));
typedef short bf16x8 __attribute__((ext_vector_type(8)));

__device__ __forceinline__ unsigned f2bf(float f) { unsigned u = __builtin_bit_cast(unsigned, f); return (u + 0x7fffu + ((u >> 16) & 1u)) >> 16; }
__device__ __forceinline__ unsigned pk2(float lo, float hi) { return f2bf(lo) | (f2bf(hi) << 16); }
__device__ __forceinline__ float bflo(unsigned w) { return __builtin_bit_cast(float, w << 16); }
__device__ __forceinline__ float bfhi(unsigned w) { return __builtin_bit_cast(float, w & 0xffff0000u); }
__device__ __forceinline__ float bf2f(bf16 h) { return __builtin_bit_cast(float, (unsigned)h << 16); }
__device__ __forceinline__ float sigmoidf_(float x) { return 1.f / (1.f + __expf(-x)); }
__device__ __forceinline__ float wave_sum(float v) {
#pragma unroll
    for (int o = 1; o < 64; o <<= 1) v += __shfl_xor(v, o);
    return v;
}
template <int CTRL> __device__ __forceinline__ float dppf(float x) { return __builtin_bit_cast(float, __builtin_amdgcn_mov_dpp(__builtin_bit_cast(int, x), CTRL, 0xf, 0xf, true)); }
__device__ __forceinline__ float red16(float x) { x += dppf<0xB1>(x); x += dppf<0x4E>(x); x += dppf<0x141>(x); x += dppf<0x128>(x); return x; }
__device__ __forceinline__ float max16(float x) { x = fmaxf(x, dppf<0xB1>(x)); x = fmaxf(x, dppf<0x4E>(x)); x = fmaxf(x, dppf<0x141>(x)); x = fmaxf(x, dppf<0x128>(x)); return x; }

__device__ __forceinline__ int lane_id_asm() { int l; asm volatile("v_mbcnt_lo_u32_b32 %0, -1, 0\n\tv_mbcnt_hi_u32_b32 %0, -1, %0" : "=v"(l)); return l; }
#define OPAQUE_TID() const int tid = wv * 64 + lane_id_asm()
typedef short v4i16_t __attribute__((ext_vector_type(4)));
__device__ __forceinline__ v2u tr_read(const LAS unsigned char* p) { return __builtin_bit_cast(v2u, __builtin_amdgcn_ds_read_tr16_b64_v4i16((LAS v4i16_t*)p)); }
#define LDS_WAIT() asm volatile("s_waitcnt lgkmcnt(0)" ::: "memory")
#define VM_WAIT() asm volatile("s_waitcnt vmcnt(0)" ::: "memory")

namespace pg8 {
#define PG8_LAS __attribute__((address_space(3)))
typedef unsigned short bf16_t;
typedef short bf16x8 __attribute__((ext_vector_type(8)));
typedef float f32x4 __attribute__((ext_vector_type(4)));
typedef unsigned u32x4 __attribute__((ext_vector_type(4)));
constexpr int BM = 256, BK = 64, HALF = 128, HTB = HALF * BK * 2  , STAGE_BYTES = 8 * HTB, NXCD = 8, WGM = 8;

__host__ __device__ __forceinline__ int lds_byte(int r, int c) { const int st = (r >> 4) * 2 + (c >> 5), rr = r & 15, cc = c & 31, ob = rr * 64 + cc * 2; return st * 1024 + (ob ^ (((ob >> 9) & 1) << 5)); }
__host__ __device__ __forceinline__ void stage_rc(int b, int& R, int& C) { const int st = b / 1024, sb = b % 1024, swz = sb ^ (((sb >> 9) & 1) << 5); R = (st >> 1) * 16 + swz / 64; C = (st & 1) * 32 + (swz % 64) / 2; }
__host__ __device__ __forceinline__ int perm32(int rho) { const int n = rho >> 4, i = rho & 15; return 8 * (i >> 2) + 4 * n + (i & 3); }

struct Unit { int pm, pn, aoff; };
struct Gemm { const bf16_t* A; const bf16_t* Bt; int K, lda, ldb; };

struct StaticOrder {
    int nM, nN, nwg, G, c;
    __device__ void init(int M, int N, int G_, int c_) { nM = M / BM; nN = N / BM; nwg = nM * nN; G = G_; c = c_; }
    __device__ bool next(int i, Unit& u) const { return at((long)i * G + c, u); }
    __device__ bool at(long L, Unit& u) const {
        if (L >= nwg) return false;
        int wgid = (int)L; { const int q = nwg / NXCD, r = nwg % NXCD, xcd = wgid % NXCD, off = wgid / NXCD; wgid = (xcd < r ? xcd * (q + 1) : r * (q + 1) + (xcd - r) * q) + off; }
        const int nig = WGM * nN, gid = wgid / nig, fm = gid * WGM, gsz = (nM - fm) < WGM ? (nM - fm) : WGM;
        u.pm = fm + ((wgid % nig) % gsz); u.pn = (wgid % nig) / gsz; u.aoff = 0; return true;
    }
    __device__ __forceinline__ void a_ready(const Unit&) const {}
    __device__ __forceinline__ void done(const Unit&) const {}
};

__device__ __forceinline__ unsigned cvt_pk_bf16(float lo, float hi) { unsigned r; asm volatile("v_cvt_pk_bf16_f32 %0, %1, %2" : "=v"(r) : "v"(lo), "v"(hi)); return r; }

struct EpiBf16 {
    static constexpr bool PERM = true, AFTER_DRAIN = false;
    bf16_t* O; int ldc; int pm_mod, pn_mod; size_t gstride; bf16_t* O2;
    __device__ __forceinline__ void operator()(const f32x4 (&acc)[2][2][4][2], const Unit& u, int wr, int wc, int fr, int fq) const {
        const int g = pm_mod ? u.pm / pm_mod : 0;
        const int row0 = (u.pm - g * pm_mod) * BM + wr * 64 + fr;
        const int col0 = (pn_mod ? (u.pn % pn_mod) : u.pn) * BM + wc * 32 + 8 * fq;
        bf16_t* base = O + (size_t)g * gstride;
        bf16_t* base2 = (O2 && g == 2) ? O2 : nullptr;
#pragma unroll
        for (int ai = 0; ai < 2; ++ai)
#pragma unroll
            for (int m = 0; m < 4; ++m) { const size_t ro = (size_t)(row0 + ai * HALF + m * 16) * ldc + col0;
#pragma unroll
                for (int bj = 0; bj < 2; ++bj) { const f32x4 v0 = acc[ai][bj][m][0], v1 = acc[ai][bj][m][1];
                    u32x4 w; w.x = cvt_pk_bf16(v0[0], v0[1]); w.y = cvt_pk_bf16(v0[2], v0[3]); w.z = cvt_pk_bf16(v1[0], v1[1]); w.w = cvt_pk_bf16(v1[2], v1[3]);
                    *(u32x4*)(base + ro + bj * HALF) = w; if (base2) *(u32x4*)(base2 + ro + bj * HALF) = w; } }
    }
};
struct EpiResid {
    static constexpr bool PERM = true, AFTER_DRAIN = false;
    float* X; int ldc; float alpha;
    __device__ __forceinline__ void operator()(const f32x4 (&acc)[2][2][4][2], const Unit& u, int wr, int wc, int fr, int fq) const {
        const int row0 = u.pm * BM + wr * 64 + fr, col0 = u.pn * BM + wc * 32 + 8 * fq;
#pragma unroll
        for (int ai = 0; ai < 2; ++ai)
#pragma unroll
            for (int m = 0; m < 4; ++m) { float* rowp = X + (size_t)(row0 + ai * HALF + m * 16) * ldc + col0;
#pragma unroll
                for (int bj = 0; bj < 2; ++bj) { f32x4* p = (f32x4*)(rowp + bj * HALF); const f32x4 x0 = p[0], x1 = p[1];
                    p[0] = x0 * alpha + acc[ai][bj][m][0]; p[1] = x1 * alpha + acc[ai][bj][m][1]; } }
    }
};
struct EpiSilu {
    static constexpr bool PERM = true, AFTER_DRAIN = false;
    bf16_t* O;
    __device__ __forceinline__ void operator()(const f32x4 (&acc)[2][2][4][2], const Unit& u, int wr, int wc, int fr, int fq) const {
        const int row0 = u.pm * BM + wr * 64 + fr, col0 = (u.pn & 3) * 128 + wc * 32 + 8 * fq;
#pragma unroll
        for (int ai = 0; ai < 2; ++ai)
#pragma unroll
            for (int m = 0; m < 4; ++m) { bf16_t* rowp = O + (size_t)(row0 + ai * HALF + m * 16) * 512 + col0;
                float h[8];
#pragma unroll
                for (int n = 0; n < 2; ++n)
#pragma unroll
                    for (int e = 0; e < 4; ++e) { const float gt = acc[ai][0][m][n][e], up = acc[ai][1][m][n][e]; h[n * 4 + e] = gt / (1.f + __expf(-gt)) * up; }
                u32x4 w; w.x = cvt_pk_bf16(h[0], h[1]); w.y = cvt_pk_bf16(h[2], h[3]); w.z = cvt_pk_bf16(h[4], h[5]); w.w = cvt_pk_bf16(h[6], h[7]);
                *(u32x4*)rowp = w; }
    }
};
struct EpiL1 {
    static constexpr bool PERM = true, AFTER_DRAIN = false;
    bf16_t* O;
    __device__ __forceinline__ void operator()(const f32x4 (&acc)[2][2][4][2], const Unit& u, int wr, int wc, int fr, int fq) const {
        const int row0 = u.pm * BM + wr * 64 + fr, col0 = u.pn * BM + wc * 32 + 8 * fq;
#pragma unroll
        for (int ai = 0; ai < 2; ++ai)
#pragma unroll
            for (int m = 0; m < 4; ++m) { bf16_t* rowp = O + (size_t)(row0 + ai * HALF + m * 16) * 512 + col0;
#pragma unroll
                for (int bj = 0; bj < 2; ++bj) { const int c = col0 + bj * HALF; float h[8];
#pragma unroll
                    for (int n = 0; n < 2; ++n)
#pragma unroll
                        for (int e = 0; e < 4; ++e) { const float v = acc[ai][bj][m][n][e];
                            h[n * 4 + e] = (c < 256) ? 1.f / (1.f + __expf(-v)) : ((c < 352) ? (1.f - 2.f / (1.f + __expf(2.f * v))) : v); }
                    u32x4 w; w.x = cvt_pk_bf16(h[0], h[1]); w.y = cvt_pk_bf16(h[2], h[3]); w.z = cvt_pk_bf16(h[4], h[5]); w.w = cvt_pk_bf16(h[6], h[7]);
                    *(u32x4*)(rowp + bj * HALF) = w; } }
    }
};
template <int KIND> __device__ __forceinline__ void epi_l2(const f32x4 (&acc)[2][2][4][2], bf16_t* O, const bf16_t* VF, const float* pv, int row0, int col0) {
    float pr[2][8];
#pragma unroll
    for (int bj = 0; bj < 2; ++bj)
#pragma unroll
        for (int j = 0; j < 8; ++j) pr[bj][j] = (KIND == 0) ? 0.f : pv[col0 + bj * HALF + j];
#pragma unroll
    for (int ai = 0; ai < 2; ++ai)
#pragma unroll
        for (int m = 0; m < 4; ++m) { const size_t ro = (size_t)(row0 + ai * HALF + m * 16) * 2048 + col0;
#pragma unroll
            for (int bj = 0; bj < 2; ++bj) { float h[8];
#pragma unroll
                for (int n = 0; n < 2; ++n)
#pragma unroll
                    for (int e = 0; e < 4; ++e) h[n * 4 + e] = acc[ai][bj][m][n][e] + pr[bj][n * 4 + e];
                if (KIND == 1) {
#pragma unroll
                    for (int j = 0; j < 8; ++j) { const float x = -h[j]; const float sp = fmaxf(x, 0.f) + __logf(1.f + __expf(-fabsf(x))); h[j] = -__expf(-sp - 0.5f); }
                } else if (KIND == 2) {
#pragma unroll
                    for (int j = 0; j < 8; ++j) h[j] = 1.f / (1.f + __expf(-h[j]));
                } else if (KIND == 3) {
                    const u32x4 vv = *(const u32x4*)(O + ro + bj * HALF), vf = *(const u32x4*)(VF + ro + bj * HALF);
#pragma unroll
                    for (int j = 0; j < 4; ++j) { const unsigned a = vv[j], b = vf[j];
                        const float v0_ = __builtin_bit_cast(float, a << 16), v1_ = __builtin_bit_cast(float, a & 0xffff0000u);
                        const float f0_ = __builtin_bit_cast(float, b << 16), f1_ = __builtin_bit_cast(float, b & 0xffff0000u);
                        h[2 * j] = v0_ + (f0_ - v0_) / (1.f + __expf(-h[2 * j])); h[2 * j + 1] = v1_ + (f1_ - v1_) / (1.f + __expf(-h[2 * j + 1])); }
                }
                u32x4 w; w.x = cvt_pk_bf16(h[0], h[1]); w.y = cvt_pk_bf16(h[2], h[3]); w.z = cvt_pk_bf16(h[4], h[5]); w.w = cvt_pk_bf16(h[6], h[7]);
                *(u32x4*)(O + ro + bj * HALF) = w; } }
}
struct EpiL2 {
    static constexpr bool PERM = true, AFTER_DRAIN = false;
    bf16_t *G, *WD, *AA, *V; const bf16_t* VF; const float *w0, *a0, *v0;
    __device__ __forceinline__ void operator()(const f32x4 (&acc)[2][2][4][2], const Unit& u, int wr, int wc, int fr, int fq) const {
        const int kind = u.pn >> 3;
        const int row0 = u.pm * BM + wr * 64 + fr, col0 = (u.pn & 7) * BM + wc * 32 + 8 * fq;
        if (kind == 0) epi_l2<0>(acc, G, nullptr, nullptr, row0, col0);
        else if (kind == 1) epi_l2<1>(acc, WD, nullptr, w0, row0, col0);
        else if (kind == 2) epi_l2<2>(acc, AA, nullptr, a0, row0, col0);
        else epi_l2<3>(acc, V, VF, v0, row0, col0);
    }
};

template <class Epi, class Sched, bool ALIGN_EPI = false, bool SP2 = false>
__device__ __forceinline__ void gemm_phase(const int wv, PG8_LAS unsigned char* lds, const Gemm g, const Sched& S, const Epi& E) {
#ifdef NO_GEMM
    return;
#endif
    const int tid_o = wv * 64 + lane_id_asm();
    const int tid = tid_o, wid = __builtin_amdgcn_readfirstlane(tid >> 6), lane = tid & 63, wr = wid >> 2, wc = wid & 3, fr = lane & 15, fq = lane >> 4;
    const int K = g.K, nt = K / BK;
    unsigned voffA[2], voffB[2];
#pragma unroll
    for (int i = 0; i < 2; ++i) { int R, C; stage_rc(tid * 16 + i * 8192, R, C); const int Rb = Epi::PERM ? ((R & ~31) + perm32(R & 31)) : R;
        voffA[i] = (unsigned)(R * g.lda + C) * 2u; voffB[i] = (unsigned)(Rb * g.ldb + C) * 2u; }
    const size_t kstep = (size_t)(BK * 2);
    const size_t hstepA = (size_t)HALF * g.lda * 2, hstepB = (size_t)HALF * g.ldb * 2;
    const size_t tstepA = 2 * hstepA, tstepB = 2 * hstepB;
    const unsigned ldsw = (unsigned)wid * 1024u;
    const int aoff = lds_byte(wr * 64 + fr, fq * 8), boff = lds_byte(wc * 32 + fr, fq * 8);
#define PG8_SA(b, h) (((b) * 2 + (h)) * HTB)
#define PG8_SB(b, h) ((4 + (b) * 2 + (h)) * HTB)
#define PG8_STAGE(bufoff, gbase, voff) do { _Pragma("unroll") for (int _i = 0; _i < 2; ++_i) \
        __builtin_amdgcn_global_load_lds((const unsigned*)((const char*)(gbase) + (voff)[_i]), (PG8_LAS unsigned*)(lds + (bufoff) + ldsw + _i * 8192), 16, 0, 0); } while (0)
#define PG8_LDA(dst, b, h) do { _Pragma("unroll") for (int m = 0; m < 4; ++m) _Pragma("unroll") for (int k = 0; k < 2; ++k) dst[m][k] = *(const PG8_LAS bf16x8*)(lds + PG8_SA(b, h) + aoff + m * 2048 + k * 1024); } while (0)
#define PG8_LDB(dst, b, h) do { _Pragma("unroll") for (int n = 0; n < 2; ++n) _Pragma("unroll") for (int k = 0; k < 2; ++k) dst[n][k] = *(const PG8_LAS bf16x8*)(lds + PG8_SB(b, h) + boff + n * 2048 + k * 1024); } while (0)
#define PG8_MMA(ai, bj, At, Bt) do { __builtin_amdgcn_s_setprio(1); _Pragma("unroll") for (int m = 0; m < 4; ++m) _Pragma("unroll") for (int n = 0; n < 2; ++n) _Pragma("unroll") for (int k = 0; k < 2; ++k) \
        acc[ai][bj][m][n] = __builtin_amdgcn_mfma_f32_16x16x32_bf16(Bt[n][k], At[m][k], acc[ai][bj][m][n], 0, 0, 0); __builtin_amdgcn_s_setprio(0); } while (0)
#define PG8_WAIT_V(n) asm volatile("s_waitcnt vmcnt(" #n ")" ::: "memory")
#define PG8_WAIT_L(n) asm volatile("s_waitcnt lgkmcnt(" #n ")" ::: "memory")
#define PG8_BAR __builtin_amdgcn_s_barrier()
#define PG8_SCHED __builtin_amdgcn_sched_barrier(0)
    Unit cur, nxt; int ui = 0;
    if (!S.next(0, cur)) return;
    f32x4 acc[2][2][4][2];
#pragma unroll
    for (int a = 0; a < 2; ++a)
#pragma unroll
        for (int b = 0; b < 2; ++b)
#pragma unroll
            for (int m = 0; m < 4; ++m)
#pragma unroll
                for (int n = 0; n < 2; ++n) acc[a][b][m][n] = (f32x4){0.f, 0.f, 0.f, 0.f};
    bf16x8 At[4][2], B0[2][2], B1[2][2];
    const char* cA = (const char*)g.A + (size_t)cur.pm * tstepA + cur.aoff; const char* cB = (const char*)g.Bt + (size_t)cur.pn * tstepB;
    S.a_ready(cur);
    if constexpr (SP2) {
        PG8_STAGE(PG8_SB(0, 0), cB, voffB); PG8_STAGE(PG8_SB(0, 1), cB + hstepB, voffB); PG8_STAGE(PG8_SA(0, 0), cA, voffA); PG8_STAGE(PG8_SA(0, 1), cA + hstepA, voffA);
        if (wr == 1) PG8_BAR;
        PG8_WAIT_V(2); PG8_BAR;
        PG8_STAGE(PG8_SB(1, 0), cB + kstep, voffB); PG8_STAGE(PG8_SA(1, 0), cA + kstep, voffA); PG8_STAGE(PG8_SB(1, 1), cB + hstepB + kstep, voffB);
        PG8_WAIT_V(6); PG8_BAR;
    } else {
        PG8_STAGE(PG8_SB(0, 0), cB, voffB); PG8_STAGE(PG8_SA(0, 0), cA, voffA); PG8_STAGE(PG8_SB(0, 1), cB + hstepB, voffB); PG8_STAGE(PG8_SA(0, 1), cA + hstepA, voffA);
        if (wr == 1) PG8_BAR;
        PG8_WAIT_V(4); PG8_BAR;
        PG8_STAGE(PG8_SB(1, 0), cB + kstep, voffB); PG8_STAGE(PG8_SA(1, 0), cA + kstep, voffA); PG8_STAGE(PG8_SB(1, 1), cB + hstepB + kstep, voffB);
        PG8_WAIT_V(6); PG8_BAR;
    }
    for (;;) {
        const bool has_next = S.next(ui + 1, nxt);
        const char* nA = has_next ? (const char*)g.A + (size_t)nxt.pm * tstepA + nxt.aoff : cA; const char* nB = has_next ? (const char*)g.Bt + (size_t)nxt.pn * tstepB : cB;
        for (int t = 0; t < nt; t += 2) {
            const bool last = (t == nt - 2);
            const char* a1 = cA + (size_t)(t + 1) * kstep;
            const char* a2 = last ? nA : cA + (size_t)(t + 2) * kstep; const char* b2 = last ? nB : cB + (size_t)(t + 2) * kstep;
            const char* a3 = a2 + kstep; const char* b3 = b2 + kstep;
            if (last && has_next) S.a_ready(nxt);
            if constexpr (SP2) {
            PG8_LDB(B0, 0, 0); PG8_LDB(B1, 0, 1); PG8_SCHED; PG8_LDA(At, 0, 0); PG8_STAGE(PG8_SA(1, 1), a1 + hstepA, voffA);
            PG8_WAIT_V(8); PG8_WAIT_L(0); PG8_BAR; PG8_MMA(0, 0, At, B0); PG8_MMA(0, 1, At, B1); PG8_BAR; PG8_SCHED;
            PG8_LDA(At, 0, 1); PG8_STAGE(PG8_SB(0, 0), b2, voffB); PG8_STAGE(PG8_SB(0, 1), b2 + hstepB, voffB); PG8_STAGE(PG8_SA(0, 0), a2, voffA);
            PG8_WAIT_V(8); PG8_WAIT_L(0); PG8_BAR; PG8_MMA(1, 0, At, B0); PG8_MMA(1, 1, At, B1); PG8_BAR; PG8_SCHED;
            PG8_LDB(B0, 1, 0); PG8_LDB(B1, 1, 1); PG8_SCHED; PG8_LDA(At, 1, 0); PG8_STAGE(PG8_SA(0, 1), a2 + hstepA, voffA);
            PG8_WAIT_V(8); PG8_WAIT_L(0); PG8_BAR; PG8_MMA(0, 0, At, B0); PG8_MMA(0, 1, At, B1); PG8_BAR; PG8_SCHED;
            PG8_LDA(At, 1, 1); PG8_STAGE(PG8_SB(1, 0), b3, voffB); PG8_STAGE(PG8_SB(1, 1), b3 + hstepB, voffB); PG8_STAGE(PG8_SA(1, 0), a3, voffA);
            PG8_WAIT_V(8); PG8_WAIT_L(0); PG8_BAR; PG8_MMA(1, 0, At, B0); PG8_MMA(1, 1, At, B1); PG8_BAR; PG8_SCHED;
            } else {
            PG8_LDB(B0, 0, 0); PG8_SCHED; PG8_LDA(At, 0, 0); PG8_STAGE(PG8_SA(1, 1), a1 + hstepA, voffA);
            PG8_WAIT_L(8); PG8_BAR; PG8_WAIT_L(0); PG8_MMA(0, 0, At, B0); PG8_BAR; PG8_SCHED;
            PG8_LDB(B1, 0, 1); PG8_STAGE(PG8_SB(0, 0), b2, voffB);
            PG8_BAR; PG8_WAIT_L(0); PG8_MMA(0, 1, At, B1); PG8_BAR;
            PG8_LDA(At, 0, 1); PG8_STAGE(PG8_SA(0, 0), a2, voffA);
            PG8_BAR; PG8_WAIT_L(0); PG8_MMA(1, 0, At, B0); PG8_BAR; PG8_SCHED;
            PG8_STAGE(PG8_SB(0, 1), b2 + hstepB, voffB);
            PG8_WAIT_V(6); PG8_BAR; PG8_MMA(1, 1, At, B1); PG8_BAR;
            PG8_LDB(B0, 1, 0); PG8_SCHED; PG8_LDA(At, 1, 0); PG8_STAGE(PG8_SA(0, 1), a2 + hstepA, voffA);
            PG8_WAIT_L(8); PG8_BAR; PG8_WAIT_L(0); PG8_MMA(0, 0, At, B0); PG8_BAR; PG8_SCHED;
            PG8_LDB(B1, 1, 1); PG8_STAGE(PG8_SB(1, 0), b3, voffB);
            PG8_BAR; PG8_WAIT_L(0); PG8_MMA(0, 1, At, B1); PG8_BAR;
            PG8_LDA(At, 1, 1); PG8_STAGE(PG8_SA(1, 0), a3, voffA);
            PG8_BAR; PG8_WAIT_L(0); PG8_MMA(1, 0, At, B0); PG8_BAR; PG8_SCHED;
            PG8_STAGE(PG8_SB(1, 1), b3 + hstepB, voffB);
            PG8_WAIT_V(6); PG8_BAR; PG8_MMA(1, 1, At, B1); PG8_BAR;
            }
        }
        if constexpr (ALIGN_EPI) { if (wr == 0) PG8_BAR; }
        if constexpr (!Epi::AFTER_DRAIN) { E(acc, cur, wr, wc, fr, fq); S.done(cur); }
        if (!has_next) break;
#pragma unroll
        for (int a = 0; a < 2; ++a)
#pragma unroll
            for (int b = 0; b < 2; ++b)
#pragma unroll
                for (int m = 0; m < 4; ++m)
#pragma unroll
                    for (int n = 0; n < 2; ++n) acc[a][b][m][n] = (f32x4){0.f, 0.f, 0.f, 0.f};
        cur = nxt; cA = nA; cB = nB; ++ui;
        if constexpr (ALIGN_EPI) { if (wr == 1) PG8_BAR; }
    }
    PG8_WAIT_V(0);
    if constexpr (!ALIGN_EPI) { if (wr == 0) PG8_BAR; }
    PG8_BAR;
    if constexpr (Epi::AFTER_DRAIN) { E.fused(acc, cur, wr, wc, fr, fq, lds, wid, lane); S.done(cur); }
#undef PG8_SA
#undef PG8_SB
#undef PG8_STAGE
#undef PG8_LDA
#undef PG8_LDB
#undef PG8_MMA
#undef PG8_WAIT_V
#undef PG8_WAIT_L
#undef PG8_BAR
#undef PG8_SCHED
}
}

#define XB_TMO      128
#define XB_XCNT(j)  (256  + 64 * (j))
#define XB_XSUB(j)  (1280 + 64 * (j))
#define XB_XGEN(j)  (2304 + 64 * (j))
#define XB_TOP      3328
#define XB_TOPGEN   3392
#define XCD_BAR_WORDS 3456
#define XB_SPIN_CAP (1u << 18)

__device__ __forceinline__ unsigned xb_ld(unsigned* p)              { return __hip_atomic_load(p, __ATOMIC_RELAXED, __HIP_MEMORY_SCOPE_AGENT); }
__device__ __forceinline__ unsigned xb_add(unsigned* p, unsigned v) { return __hip_atomic_fetch_add(p, v, __ATOMIC_RELAXED, __HIP_MEMORY_SCOPE_AGENT); }
__device__ __forceinline__ unsigned xb_xcc_id() { return (unsigned)__builtin_amdgcn_s_getreg((3 << 11) | 20) & 0xFu; }
#define XB_SPIN(cond, bar) do { unsigned _sp = 0; while (cond) { __builtin_amdgcn_s_sleep(1); \
    if ((++_sp & 255u) == 0u) { if (xb_ld(&(bar)[XB_TMO])) break; if (_sp > XB_SPIN_CAP) { atomicAdd(&(bar)[XB_TMO], 1u); break; } } } } while (0)

struct XcdBarrier {
    unsigned* bar; unsigned x;
    volatile LAS unsigned* st;
};

__device__ __forceinline__ XcdBarrier xcd_barrier_post(unsigned* bar, volatile LAS unsigned* st, const bool t0) {
    XcdBarrier b; b.bar = bar; b.x = xb_xcc_id(); b.st = st;
    if (t0) (void)xb_add(&bar[XB_XCNT(b.x)], 1u);
    return b;
}
__device__ __forceinline__ void xcd_barrier_complete(unsigned* bar, unsigned x, unsigned& nloc, unsigned& nx) {
    const unsigned G = gridDim.x * gridDim.y * gridDim.z;
    unsigned sum, cnt, mine, sp = 0u;
    for (;;) {
        sum = 0u; cnt = 0u; mine = 0u;
#pragma unroll
        for (unsigned j = 0; j < 16; ++j) { const unsigned c = xb_ld(&bar[XB_XCNT(j)]); sum += c; cnt += (c > 0u) ? 1u : 0u; mine = (j == x) ? c : mine; }
        if (sum == G) break;
        __builtin_amdgcn_s_sleep(1);
        if ((++sp & 255u) == 0u) { if (xb_ld(&bar[XB_TMO])) break; if (sp > XB_SPIN_CAP) { atomicAdd(&bar[XB_TMO], 1u); break; } }
    }
    nloc = mine > 0u ? mine : 1u; nx = cnt > 0u ? cnt : 1u;
}

__device__ __forceinline__ void xcd_barrier(const XcdBarrier& b, const bool t0) {
    asm volatile("s_waitcnt vmcnt(0)" ::: "memory");
    __syncthreads();
    if (t0) {
        unsigned* bar = b.bar;
        __builtin_amdgcn_s_waitcnt(0);
        unsigned nloc = b.st[0], nx = b.st[1];
        if (nloc == 0u) { xcd_barrier_complete(bar, b.x, nloc, nx); b.st[0] = nloc; b.st[1] = nx; }
        const unsigned old = xb_add(&bar[XB_XSUB(b.x)], 1u);
        const unsigned gen = old / nloc;
        if (old + 1u == (gen + 1u) * nloc) {
            __builtin_amdgcn_fence(__ATOMIC_RELEASE, "agent");
            asm volatile("s_waitcnt vmcnt(0)" ::: "memory");
            const unsigned og = xb_add(&bar[XB_TOP], 1u);
            const unsigned tg = og / nx;
            if (og + 1u == (tg + 1u) * nx) xb_add(&bar[XB_TOPGEN], 1u);
            else XB_SPIN(xb_ld(&bar[XB_TOPGEN]) == tg, bar);
            __builtin_amdgcn_fence(__ATOMIC_ACQUIRE, "agent");
            xb_add(&bar[XB_XGEN(b.x)], 1u);
            asm volatile("s_waitcnt vmcnt(0)" ::: "memory");
        } else {
            XB_SPIN(xb_ld(&bar[XB_XGEN(b.x)]) == gen, bar);
            __builtin_amdgcn_fence(__ATOMIC_ACQUIRE, "agent");
            asm volatile("s_waitcnt vmcnt(0)" ::: "memory");
        }
    }
    __syncthreads();
}

constexpr int NWAVES = 8, NTHR = 512;
constexpr int NB = 4, SEQ = 4096, T_ = NB * SEQ, D_ = 2048;
constexpr int EVEN_IN = 7176, ZW = 7168;
constexpr float DN_ALPHA = 1.6817928305074290f;
constexpr float LN_EPS = 1e-5f;
constexpr int MOE_ROWS = 40960, MOE_TILES = MOE_ROWS / 256;

constexpr size_t MiB = 1u << 20;
constexpr size_t WS_CTL = 0, CTL_ZERO_BYTES = 1 * MiB;
constexpr size_t WS_IG = 1 * MiB, WS_FG = WS_IG + 256 * 1024, WS_KPART = 2 * MiB;
constexpr size_t WS_TOKE = 3 * MiB, WS_TOKR = WS_TOKE + 128 * 1024, WS_TOKG = WS_TOKR + 128 * 1024, WS_SLOT = WS_TOKG + 128 * 1024;
constexpr size_t WS_DN = 4 * MiB, WS_NP = 5 * MiB, WS_DEC = 6 * MiB, WS_BC = 6 * MiB + 65536;
constexpr size_t WS_WIN = 16 * MiB;
constexpr size_t WS_WOUT = 72 * MiB;
constexpr size_t WS_WRKV = 88 * MiB;
constexpr size_t WS_WO = 136 * MiB;
constexpr size_t WS_WL1 = 152 * MiB;
constexpr size_t WS_WL2 = 160 * MiB;
constexpr size_t WS_WGU = 168 * MiB;
constexpr size_t WS_WDN = 680 * MiB;
constexpr size_t WS_XB = 936 * MiB;
constexpr size_t WS_VF = 1000 * MiB;
constexpr size_t WS_R = 1064 * MiB;
constexpr size_t WS_Z = WS_R;
constexpr size_t WS_QKB = WS_R + 224 * MiB;
constexpr size_t WS_VAT = WS_R + 288 * MiB;
constexpr size_t WS_YE = WS_R + 320 * MiB;
constexpr size_t WS_DC = WS_R + 384 * MiB;
constexpr size_t WS_CP = WS_R + 512 * MiB;
constexpr size_t WS_XRKV = WS_R;
constexpr size_t WS_XC = WS_R + 192 * MiB;
constexpr size_t WS_RKV = WS_R + 320 * MiB;
constexpr size_t WS_L1 = WS_R + 512 * MiB;
constexpr size_t WS_G = WS_R + 528 * MiB;
constexpr size_t WS_WD = WS_R + 592 * MiB;
constexpr size_t WS_AA = WS_R + 656 * MiB;
constexpr size_t WS_YO = WS_R + 720 * MiB;
constexpr size_t WS_XS = WS_R;
constexpr size_t WS_HID = WS_R + 160 * MiB;
constexpr size_t WS_YS = WS_R + 200 * MiB;
constexpr size_t WS_END = WS_R + 784 * MiB;

constexpr int CW_BAR = 4096;
constexpr int CW_CNT = 16384;

constexpr int RING_BYTES = 131072;
constexpr int MISC_OFF = RING_BYTES;
constexpr int LDS_BYTES = 147456;

typedef unsigned gu32;

struct Args { const float* in[39]; float* out; unsigned char* ws; int ph_lo, ph_hi; };
#define CAS __attribute__((address_space(4)))
typedef const CAS Args* ArgsP;
__device__ __forceinline__ ArgsP get_args() { ArgsP p = (ArgsP)__builtin_amdgcn_kernarg_segment_ptr(); asm volatile("" : "+s"(p)); return p; }

__device__ __forceinline__ void tr_item(const float* W, int ldw, int k0, int n0, bf16* WT, int ldt, int drow0, int dcol0, LAS float* scr, int lane, const float* kscale) {
    const int r = lane >> 3, c4 = lane & 7;
    f32x4 v[8];
#pragma unroll
    for (int i = 0; i < 8; ++i) v[i] = __builtin_nontemporal_load((const f32x4*)(W + (size_t)(k0 + 8 * i + r) * ldw + n0 + 4 * c4));
    if (kscale) {
#pragma unroll
        for (int i = 0; i < 8; ++i) v[i] = v[i] * kscale[k0 + 8 * i + r]; }
#pragma unroll
    for (int i = 0; i < 8; ++i) { LAS float* d = scr + (8 * i + r) * 33 + 4 * c4; d[0] = v[i].x; d[1] = v[i].y; d[2] = v[i].z; d[3] = v[i].w; }
    LDS_WAIT(); asm volatile("" ::: "memory");
    const int c = lane & 7;
#pragma unroll
    for (int j = 0; j < 4; ++j) { const int n = (lane >> 3) + 8 * j; const LAS float* s = scr + (8 * c) * 33 + n;
        v4u o; o.x = pk2(s[0 * 33], s[1 * 33]); o.y = pk2(s[2 * 33], s[3 * 33]); o.z = pk2(s[4 * 33], s[5 * 33]); o.w = pk2(s[6 * 33], s[7 * 33]);
        *(v4u*)(WT + (size_t)(drow0 + n) * ldt + dcol0 + 8 * c) = o; }
    LDS_WAIT(); asm volatile("" ::: "memory");
}

__device__ __forceinline__ void prologue(const int wv, LAS unsigned char* lds) {
    const ArgsP a = get_args();
#ifdef NO_PROL
    return;
#endif
    OPAQUE_TID(); const int lane = tid & 63, wave = tid >> 6;
    unsigned char* ws = a->ws;
    LAS float* scr = (LAS float*)(lds + wave * 16384);
    const int gw = blockIdx.x * NWAVES + wave, NGW = gridDim.x * NWAVES;
    constexpr int I0 = 2 * 7168, I1 = 2 * 2048, I2 = 2 * 4 * 2048, I3 = 2 * 32 * 16, I4 = 4 * 32 * 1536;
    constexpr int NITEMS = I0 + I1 + I2 + I3 + I4;
    for (int it = gw; it < NITEMS; it += NGW) {
        int r = it;
        if (r < I0) { const int e = r / 7168, rr = r % 7168, kb = rr / 224, nb = rr % 224;
            tr_item(a->in[1] + (size_t)e * 2048 * EVEN_IN, EVEN_IN, 64 * kb, 32 * nb, (bf16*)(ws + WS_WIN) + (size_t)e * ZW * 2048, 2048, 32 * nb, 64 * kb, scr, lane, nullptr); continue; } r -= I0;
        if (r < I1) { const int e = r / 2048, rr = r % 2048, kb = rr / 64, nb = rr % 64;
            tr_item(a->in[6] + (size_t)e * 2048 * 2048, 2048, 64 * kb, 32 * nb, (bf16*)(ws + WS_WOUT) + (size_t)e * 2048 * 2048, 2048, 32 * nb, 64 * kb, scr, lane, nullptr); continue; } r -= I1;
        if (r < I2) { const int o = r / 8192, rr = r % 8192, mat = rr / 2048, q = rr % 2048, kb = q / 64, nb = q % 64;
            const float* src = (mat == 0 ? a->in[8] : mat == 1 ? a->in[9] : mat == 2 ? a->in[10] : a->in[11]) + (size_t)o * 2048 * 2048;
            bf16* dst = (mat < 3) ? (bf16*)(ws + WS_WRKV) + (size_t)o * 3 * 2048 * 2048 + (size_t)mat * 2048 * 2048 : (bf16*)(ws + WS_WO) + (size_t)o * 2048 * 2048;
            tr_item(src, 2048, 64 * kb, 32 * nb, dst, 2048, 32 * nb, 64 * kb, scr, lane, nullptr); continue; } r -= I2;
        if (r < I3) { const int o = r / 512, rr = r % 512, kb = rr / 16, nb = rr % 16;
            const float* src; int ldw, n0, drow0, mu;
            if (nb < 8) { src = a->in[18] + (size_t)o * 2048 * 256; ldw = 256; n0 = 32 * nb; drow0 = 32 * nb; mu = 5; }
            else if (nb < 11) { src = a->in[13] + (size_t)o * 2048 * 96; ldw = 96; n0 = 32 * (nb - 8); drow0 = 256 + n0; mu = 1; }
            else if (nb < 14) { src = a->in[16] + (size_t)o * 2048 * 96; ldw = 96; n0 = 32 * (nb - 11); drow0 = 352 + n0; mu = 4; }
            else { if (o == 0) continue; src = a->in[26]; ldw = 64; n0 = 32 * (nb - 14); drow0 = 448 + n0; mu = 3; }
            bf16* dst = (bf16*)(ws + WS_WL1) + (size_t)o * 512 * 4096;
            tr_item(src, ldw, 64 * kb, n0, dst, 4096, drow0, 64 * kb, scr, lane, nullptr);
            tr_item(src, ldw, 64 * kb, n0, dst, 4096, drow0, 2048 + 64 * kb, scr, lane, a->in[7] + (size_t)(o * 6 + mu) * 2048);
            continue; } r -= I3;
        { const int le = r / 1536, rr = r % 1536, mat = rr / 512, q = rr % 512;
            if (mat < 2) { const int kb = q / 16, nb = q % 16, n0 = 32 * nb;
                tr_item((mat == 0 ? a->in[36] : a->in[37]) + (size_t)le * 2048 * 512, 512, 64 * kb, n0, (bf16*)(ws + WS_WGU) + (size_t)le * 1024 * 2048, 2048,
                        (n0 / 128) * 256 + (n0 % 128) + (mat == 1 ? 128 : 0), 64 * kb, scr, lane, nullptr); }
            else { const int kb = q / 64, nb = q % 64;
                tr_item(a->in[38] + (size_t)le * 512 * 2048, 2048, 64 * kb, 32 * nb, (bf16*)(ws + WS_WDN) + (size_t)le * 2048 * 512, 512, 32 * nb, 64 * kb, scr, lane, nullptr); }
        }
    }
    const int gt = blockIdx.x * NTHR + tid, NGT = gridDim.x * NTHR;
    for (int idx = gt; idx < 2 * 32 * 8192; idx += NGT) {
        const int o = idx / (32 * 8192), rem = idx % (32 * 8192), kg = rem / 8192, n = rem % 8192, mat = n / 2048, nn = n % 2048;
        float v[8];
#pragma unroll
        for (int j = 0; j < 8; ++j) { const int k = 8 * kg + j; float x = 0.f;
            if (mat == 0) x = a->in[19][((size_t)o * 256 + k) * 2048 + nn];
            else if (mat == 1) { if (k < 96) x = a->in[14][((size_t)o * 96 + k) * 2048 + nn]; }
            else if (mat == 2) { if (k >= 96 && k < 192) x = a->in[17][((size_t)o * 96 + (k - 96)) * 2048 + nn]; }
            else { if (o == 1 && k >= 192) x = a->in[27][(size_t)(k - 192) * 2048 + nn]; }
            v[j] = x; }
        v4u w; w.x = pk2(v[0], v[1]); w.y = pk2(v[2], v[3]); w.z = pk2(v[4], v[5]); w.w = pk2(v[6], v[7]);
        *(v4u*)((bf16*)(ws + WS_WL2) + ((size_t)o * 8192 + n) * 256 + 8 * kg) = w;
    }
    for (int i = gt; i < T_ * D_ / 4; i += NGT) { const f32x4 v = ((const f32x4*)a->in[0])[i]; ((f32x4*)a->out)[i] = v;
        v2u w; w.x = pk2(v.x, v.y); w.y = pk2(v.z, v.w); ((v2u*)(ws + WS_XB))[i] = w; }
}

__device__ __forceinline__ void even_prep(const int wv, int e, LAS unsigned char* lds, int u) {
    const ArgsP a = get_args();
#ifdef NO_EPREP
    return;
#endif
    OPAQUE_TID(); const int lane = tid & 63, wave = tid >> 6;
    unsigned char* ws = a->ws;
    bf16* Z = (bf16*)(ws + WS_Z);
    const int m0 = 64 * u, b = u >> 6, ch = u & 63, t0 = ch * 64;
    { LAS float* cst = (LAS float*)lds; LAS float* snt = cst + 1024;
#pragma unroll 1
      for (int q = tid; q < 1024; q += NTHR) { const int r = q >> 4, i = q & 15; const float inv = exp2f(-(float)i * (18.931568569324174f / 16.f));
          float sn_, cs_; sincosf((float)(t0 + r) * inv, &sn_, &cs_); cst[q] = cs_; snt[q] = sn_; }
      __syncthreads();
      const int row = tid >> 3, head = tid & 7;
      float cs[16], sn[16];
#pragma unroll
      for (int i = 0; i < 4; ++i) { const f32x4 c4 = *(const LAS f32x4*)(cst + row * 16 + 4 * i), s4 = *(const LAS f32x4*)(snt + row * 16 + 4 * i);
          cs[4 * i] = c4.x; cs[4 * i + 1] = c4.y; cs[4 * i + 2] = c4.z; cs[4 * i + 3] = c4.w; sn[4 * i] = s4.x; sn[4 * i + 1] = s4.y; sn[4 * i + 2] = s4.z; sn[4 * i + 3] = s4.w; }
#pragma unroll 1
      for (int qk = 0; qk < 2; ++qk) { v4u* p = (v4u*)(Z + (size_t)(m0 + row) * ZW + qk * 1024 + head * 128);
        v4u w0 = p[0], w1 = p[1], w2 = p[2], w3 = p[3]; unsigned x1[8] = {w0.x, w0.y, w0.z, w0.w, w1.x, w1.y, w1.z, w1.w}, x2[8] = {w2.x, w2.y, w2.z, w2.w, w3.x, w3.y, w3.z, w3.w};
        unsigned o1[8], o2[8];
#pragma unroll
        for (int j = 0; j < 8; ++j) { const float a0 = bflo(x1[j]), a1 = bfhi(x1[j]), b0 = bflo(x2[j]), b1 = bfhi(x2[j]);
            o1[j] = pk2(a0 * cs[2 * j] - b0 * sn[2 * j], a1 * cs[2 * j + 1] - b1 * sn[2 * j + 1]);
            o2[j] = pk2(b0 * cs[2 * j] + a0 * sn[2 * j], b1 * cs[2 * j + 1] + a1 * sn[2 * j + 1]); }
        p[0] = (v4u){o1[0], o1[1], o1[2], o1[3]}; p[1] = (v4u){o1[4], o1[5], o1[6], o1[7]}; p[2] = (v4u){o2[0], o2[1], o2[2], o2[3]}; p[3] = (v4u){o2[4], o2[5], o2[6], o2[7]}; }
    }
    VM_WAIT(); __syncthreads();
    { LAS float* red = (LAS float*)lds;
      const int cg = tid & 127, rq = tid >> 7; float s[8] = {0, 0, 0, 0, 0, 0, 0, 0};
      for (int r = 0; r < 16; ++r) { const v4u w = *(const v4u*)(Z + (size_t)(m0 + rq * 16 + r) * ZW + 1024 + cg * 8);
          s[0] += bflo(w.x); s[1] += bfhi(w.x); s[2] += bflo(w.y); s[3] += bfhi(w.y); s[4] += bflo(w.z); s[5] += bfhi(w.z); s[6] += bflo(w.w); s[7] += bfhi(w.w); }
#pragma unroll
      for (int j = 0; j < 8; ++j) red[rq * 1024 + cg * 8 + j] = s[j];
      __syncthreads();
      if (tid < 256) { f32x4 t = {0, 0, 0, 0};
#pragma unroll
          for (int q = 0; q < 4; ++q) { const f32x4 v = *(const LAS f32x4*)(red + q * 1024 + tid * 4); t += v; }
          const int c = tid * 4, h = c >> 7, d = c & 127;
          *(f32x4*)((float*)(ws + WS_KPART) + ((size_t)((b * 8 + h) * 64 + ch)) * 128 + d) = t; }
      __syncthreads();
    }
    { LAS bf16* tile = (LAS bf16*)lds;
      bf16* VAT = (bf16*)(ws + WS_VAT);
      for (int p = 0; p < 4; ++p) {
          { const int r = tid >> 3, seg = tid & 7; const v4u* src = (const v4u*)(Z + (size_t)(m0 + r) * ZW + 2048 + 256 * p + 32 * seg);
#pragma unroll
            for (int j = 0; j < 4; ++j) *(LAS v4u*)(tile + r * 264 + 32 * seg + 8 * j) = src[j]; }
          __syncthreads();
          { const int c = tid & 255, rh = tid >> 8; unsigned w[16];
#pragma unroll
            for (int j = 0; j < 16; ++j) { const unsigned lo = tile[(32 * rh + 2 * j) * 264 + c], hi = tile[(32 * rh + 2 * j + 1) * 264 + c]; w[j] = lo | (hi << 16); }
            const int col = 256 * p + c, h = col >> 7, d = col & 127;
            v4u* dst = (v4u*)(VAT + ((size_t)((b * 8 + h) * 128 + d)) * SEQ + t0 + 32 * rh);
#pragma unroll
            for (int j = 0; j < 4; ++j) dst[j] = (v4u){w[4 * j], w[4 * j + 1], w[4 * j + 2], w[4 * j + 3]}; }
          __syncthreads();
      }
    }
    { const int cg = tid & 255, rh = tid >> 8; const int c0 = 8 * cg;
      const float* cw = a->in[3] + (size_t)e * 4 * 2048; const float* cb = a->in[4] + (size_t)e * 2048;
      float w[4][8], bias[8];
#pragma unroll
      for (int j = 0; j < 4; ++j)
#pragma unroll
          for (int i = 0; i < 8; ++i) w[j][i] = cw[j * 2048 + c0 + i];
#pragma unroll
      for (int i = 0; i < 8; ++i) bias[i] = cb[c0 + i];
      float win[3][8];
#pragma unroll
      for (int j = 0; j < 3; ++j) { const int tt = t0 + 32 * rh - 3 + j;
          v4u x = {0, 0, 0, 0}; if (tt >= 0) x = *(const v4u*)(Z + (size_t)(b * SEQ + tt) * ZW + 3072 + c0);
          win[j][0] = bflo(x.x); win[j][1] = bfhi(x.x); win[j][2] = bflo(x.y); win[j][3] = bfhi(x.y); win[j][4] = bflo(x.z); win[j][5] = bfhi(x.z); win[j][6] = bflo(x.w); win[j][7] = bfhi(x.w); }
      bf16* QKB = (bf16*)(ws + WS_QKB);
      for (int r = 0; r < 32; ++r) { const int m = m0 + 32 * rh + r;
          const v4u x = *(const v4u*)(Z + (size_t)m * ZW + 3072 + c0);
          float cur[8] = {bflo(x.x), bfhi(x.x), bflo(x.y), bfhi(x.y), bflo(x.z), bfhi(x.z), bflo(x.w), bfhi(x.w)}; float o[8];
#pragma unroll
          for (int i = 0; i < 8; ++i) { const float v = bias[i] + w[0][i] * win[0][i] + w[1][i] * win[1][i] + w[2][i] * win[2][i] + w[3][i] * cur[i]; o[i] = v / (1.f + __expf(-v));
              win[0][i] = win[1][i]; win[1][i] = win[2][i]; win[2][i] = cur[i]; }
          *(v4u*)(QKB + (size_t)m * 2048 + c0) = (v4u){pk2(o[0], o[1]), pk2(o[2], o[3]), pk2(o[4], o[5]), pk2(o[6], o[7])}; }
    }
    { LAS float* wg = (LAS float*)lds;
      const float* Win = a->in[1] + (size_t)e * 2048 * EVEN_IN;
      for (int i = tid; i < 2048 * 2; i += NTHR) { const int k = i >> 1, hf = i & 1; *(LAS f32x4*)(wg + k * 8 + hf * 4) = *(const f32x4*)(Win + (size_t)k * EVEN_IN + ZW + hf * 4); }
      __syncthreads();
      const float* gb = a->in[2] + e * 8;
      for (int rr = 0; rr < 8; ++rr) { const int row = wave * 8 + rr, m = m0 + row; const f32x4* xr = (const f32x4*)(a->out + (size_t)m * D_) + lane;
          float acc[8] = {0, 0, 0, 0, 0, 0, 0, 0};
#pragma unroll 2
          for (int j = 0; j < 8; ++j) { const f32x4 xv = xr[64 * j]; const int k0 = 4 * lane + 256 * j;
#pragma unroll
              for (int i = 0; i < 4; ++i) { const f32x4 wa = *(const LAS f32x4*)(wg + (k0 + i) * 8), wb = *(const LAS f32x4*)(wg + (k0 + i) * 8 + 4); const float xx = xv[i];
                  acc[0] += xx * wa.x; acc[1] += xx * wa.y; acc[2] += xx * wa.z; acc[3] += xx * wa.w; acc[4] += xx * wb.x; acc[5] += xx * wb.y; acc[6] += xx * wb.z; acc[7] += xx * wb.w; } }
#pragma unroll
          for (int j = 0; j < 8; ++j) acc[j] = wave_sum(acc[j]);
          if (lane < 4) { const int h = lane; float ip = 0.f, fp = 0.f;
#pragma unroll
              for (int j = 0; j < 4; ++j) { if (j == h) { ip = acc[j]; fp = acc[4 + j]; } }
              ip += gb[h]; fp += gb[4 + h];
              const float lf = -(fmaxf(-fp, 0.f) + __logf(1.f + __expf(-fabsf(fp))));
              ((float*)(ws + WS_IG))[(size_t)(b * 4 + h) * SEQ + t0 + row] = ip;
              ((LAS float*)(lds + 73728))[h * 64 + row] = ip; ((LAS float*)(lds + 73728 + 1024))[h * 64 + row] = lf; } }
      __syncthreads();
    }
    { LAS float* gi = (LAS float*)(lds + 73728); LAS float* gf = gi + 256; LAS float* wsc = gi + 512;
      const int bh0 = b * 4;
      if (wave < 4) { const int h = wave; float x = gf[h * 64 + lane];
#pragma unroll
          for (int o = 1; o < 64; o <<= 1) { const float t = __shfl_up(x, o); if (lane >= o) x += t; }
          const float b63 = __shfl(x, 63);
          wsc[h * 64 + lane] = __expf(b63 - x + gi[h * 64 + lane]) * 0.0625f;
          ((float*)(ws + WS_BC))[(size_t)(bh0 + h) * SEQ + t0 + lane] = x;
          if (lane == 63) ((float*)(ws + WS_DEC))[(bh0 + h) * 64 + ch] = __expf(b63); }
      __syncthreads();
      constexpr int PV = 544;
      LAS unsigned char* Vt = lds; LAS unsigned char* Kt = lds + 64 * PV;
      const int g4 = lane >> 4, q4 = (lane >> 2) & 3, p4 = lane & 3, fr = lane & 15;
      const int wd = wave & 1, we = wave >> 1;
      const bf16* QKB = (const bf16*)(ws + WS_QKB);
      for (int h = 0; h < 4; ++h) {
          { const int sr = tid >> 3, seg = tid & 7; const float wv_ = wsc[h * 64 + sr];
            const v4u* vs = (const v4u*)(Z + (size_t)(m0 + sr) * ZW + 5120 + h * 256 + 32 * seg); const v4u* ks = (const v4u*)(QKB + (size_t)(m0 + sr) * 2048 + 1024 + h * 256 + 32 * seg);
#pragma unroll
            for (int j = 0; j < 4; ++j) { *(LAS v4u*)(Vt + sr * PV + (32 * seg + 8 * j) * 2) = vs[j]; const v4u kk = ks[j];
                *(LAS v4u*)(Kt + sr * PV + (32 * seg + 8 * j) * 2) = (v4u){pk2(bflo(kk.x) * wv_, bfhi(kk.x) * wv_), pk2(bflo(kk.y) * wv_, bfhi(kk.y) * wv_), pk2(bflo(kk.z) * wv_, bfhi(kk.z) * wv_), pk2(bflo(kk.w) * wv_, bfhi(kk.w) * wv_)}; } }
          __syncthreads();
          if (tid < 256) { float sum = 0.f;
#pragma unroll 8
              for (int sr = 0; sr < 64; ++sr) sum += bf2f(*(const LAS bf16*)(Kt + sr * PV + tid * 2));
              ((float*)(ws + WS_DN))[((size_t)(bh0 + h) * 64 + ch) * 256 + tid] = sum; }
          f32x4 acc[8][4];
#pragma unroll
          for (int i = 0; i < 8; ++i)
#pragma unroll
              for (int j = 0; j < 4; ++j) acc[i][j] = (f32x4){0.f, 0.f, 0.f, 0.f};
#pragma unroll
          for (int ks2 = 0; ks2 < 2; ++ks2) {
              bf16x8 yf[4];
#pragma unroll
              for (int et = 0; et < 4; ++et) { const LAS unsigned char* p = Vt + (32 * ks2 + 8 * g4 + q4) * PV + (64 * we + 16 * et + 4 * p4) * 2;
                  const v2u lo = tr_read(p), hi = tr_read(p + 4 * PV); yf[et] = __builtin_bit_cast(bf16x8, (v4u){lo.x, lo.y, hi.x, hi.y}); }
#pragma unroll
              for (int dt = 0; dt < 8; ++dt) { const LAS unsigned char* p = Kt + (32 * ks2 + 8 * g4 + q4) * PV + (128 * wd + 16 * dt + 4 * p4) * 2;
                  const v2u lo = tr_read(p), hi = tr_read(p + 4 * PV); const bf16x8 xf = __builtin_bit_cast(bf16x8, (v4u){lo.x, lo.y, hi.x, hi.y});
#pragma unroll
                  for (int et = 0; et < 4; ++et) acc[dt][et] = __builtin_amdgcn_mfma_f32_16x16x32_bf16(xf, yf[et], acc[dt][et], 0, 0, 0); } }
          { bf16* DC = (bf16*)(ws + WS_DC) + ((size_t)(bh0 + h) * 64 + ch) * 65536;
#pragma unroll
            for (int et = 0; et < 4; ++et)
#pragma unroll
                for (int dt = 0; dt < 8; ++dt) { const f32x4 v = acc[dt][et];
                    *(v2u*)(DC + (size_t)(64 * we + 16 * et + fr) * 256 + 128 * wd + 16 * dt + 4 * g4) = (v2u){pk2(v.x, v.y), pk2(v.z, v.w)}; } }
          __syncthreads();
      }
    }
}

constexpr int AT_KSTR = 136, AT_VSTR = 72;
constexpr int AT_K_OFF = 0, AT_V_OFF = 64 * AT_KSTR * 2, AT_KM_OFF = AT_V_OFF + 128 * AT_VSTR * 2, AT_GATE_OFF = AT_KM_OFF + 16 * 128 * 4,
              AT_SEL_OFF = AT_GATE_OFF + 128 * 16 * 4, AT_TL_OFF = AT_SEL_OFF + 128 * 4, AT_END = AT_TL_OFF + 80 * 4;

__device__ __forceinline__ void attn_unit(const int wv, LAS unsigned char* lds, int b, int h, int qt) {
    const ArgsP a = get_args();
#ifdef NO_ATTN
    return;
#endif
    OPAQUE_TID(); const int lane = tid & 63, wave = __builtin_amdgcn_readfirstlane(tid >> 6), fr = lane & 15, fq = lane >> 4;
    unsigned char* ws = a->ws;
    const bf16* Z = (const bf16*)(ws + WS_Z);
    const bf16* VAT = (const bf16*)(ws + WS_VAT) + (size_t)(b * 8 + h) * 128 * SEQ;
    const int qb = qt >> 1, q0 = 128 * qt;
    LAS bf16* Kt = (LAS bf16*)(lds + AT_K_OFF); LAS bf16* Vt = (LAS bf16*)(lds + AT_V_OFF);
    LAS float* km = (LAS float*)(lds + AT_KM_OFF); LAS float* gate = (LAS float*)(lds + AT_GATE_OFF);
    LAS unsigned* sel = (LAS unsigned*)(lds + AT_SEL_OFF); LAS int* tl = (LAS int*)(lds + AT_TL_OFF);
    for (int i = tid; i < qb * 128; i += NTHR) { const int n = i >> 7, d = i & 127; const float* kp = (const float*)(ws + WS_KPART) + ((size_t)((b * 8 + h) * 64 + 4 * n)) * 128 + d;
        km[i] = (kp[0] + kp[128] + kp[256] + kp[384]) * (1.f / 256.f); }
    __syncthreads();
    { const int ql = tid >> 2, part = tid & 3; const v4u* qp = (const v4u*)(Z + (size_t)(b * SEQ + q0 + ql) * ZW + h * 128);
      if (part < qb) { float g[4] = {0, 0, 0, 0};
          for (int c = 0; c < 16; ++c) { const v4u w = qp[c]; const float qv[8] = {bflo(w.x), bfhi(w.x), bflo(w.y), bfhi(w.y), bflo(w.z), bfhi(w.z), bflo(w.w), bfhi(w.w)};
#pragma unroll
              for (int jj = 0; jj < 4; ++jj) { const int n = part + 4 * jj; if (n < qb) { const LAS float* kk = km + n * 128 + c * 8;
#pragma unroll
                  for (int i = 0; i < 8; ++i) g[jj] += qv[i] * kk[i]; } } }
#pragma unroll
          for (int jj = 0; jj < 4; ++jj) { const int n = part + 4 * jj; if (n < qb) gate[ql * 16 + n] = g[jj]; } }
    }
    __syncthreads();
    if (tid < 128) { unsigned m = 0;
        if (qb <= 3) m = (1u << qb) - 1u;
        else { for (int r = 0; r < 3; ++r) { float best = -3.0e38f; int bi = 0; for (int n = 0; n < qb; ++n) { const float g = gate[tid * 16 + n]; if (!((m >> n) & 1u) && g > best) { best = g; bi = n; } } m |= 1u << bi; } }
        sel[tid] = m; }
    __syncthreads();
    if (tid == 0) { unsigned um = 0; for (int i = 0; i < 128; ++i) um |= sel[i];
        int nt = 0; const int nown = (qt & 1) ? 4 : 2;
        for (int j = 0; j < nown; ++j) tl[1 + nt++] = (4 * qb + j) | (1 << 16);
        for (int n = 0; n < qb; ++n) if ((um >> n) & 1u) for (int j = 0; j < 4; ++j) tl[1 + nt++] = 4 * n + j;
        tl[0] = nt; }
    __syncthreads();
    const int ntile = tl[0];
    const unsigned mysel = sel[16 * wave + fr];
    unsigned wsel = mysel;
#pragma unroll
    for (int o = 1; o < 16; o <<= 1) wsel |= __shfl_xor(wsel, o);
    bf16x8 qf[4];
    { const v4u* qp = (const v4u*)(Z + (size_t)(b * SEQ + q0 + 16 * wave + fr) * ZW + h * 128);
#pragma unroll
      for (int kc = 0; kc < 4; ++kc) qf[kc] = __builtin_bit_cast(bf16x8, qp[kc * 4 + fq]); }
    f32x4 o[8];
#pragma unroll
    for (int i = 0; i < 8; ++i) o[i] = (f32x4){0.f, 0.f, 0.f, 0.f};
    float mrun = -INFINITY, lrun = 0.f;
    const float sc = 0.08838834764831845f * 1.4426950408889634f;
    const int qabs = q0 + 16 * wave + fr;
    v4u kr[2], vr[2];
    auto gload = [&](int ti) { const int kt = tl[1 + ti] & 0xffff; const int key0 = 64 * kt;
        const v4u* kp = (const v4u*)(Z + (size_t)(b * SEQ + key0 + (tid >> 3)) * ZW + 1024 + h * 128) + (tid & 7) * 2; kr[0] = kp[0]; kr[1] = kp[1];
        const v4u* vp = (const v4u*)(VAT + (size_t)(tid >> 2) * SEQ + key0) + (tid & 3) * 2; vr[0] = vp[0]; vr[1] = vp[1]; };
    auto lstore = [&]() { LAS v4u* kd = (LAS v4u*)(Kt + (tid >> 3) * AT_KSTR + (tid & 7) * 16); kd[0] = kr[0]; kd[1] = kr[1];
        LAS v4u* vd = (LAS v4u*)(Vt + (tid >> 2) * AT_VSTR + (tid & 3) * 16); vd[0] = vr[0]; vd[1] = vr[1]; };
    gload(0); lstore(); __syncthreads();
    for (int ti = 0; ti < ntile; ++ti) {
        const int ent = tl[1 + ti]; const int kt64 = ent & 0xffff; const bool own = (ent >> 16) & 1; const int key0 = 64 * kt64;
        if (ti + 1 < ntile) gload(ti + 1);
        const bool wave_active = own || ((wsel >> (kt64 >> 2)) & 1u);
        if (wave_active) {
            f32x4 s[4];
#pragma unroll
            for (int kt = 0; kt < 4; ++kt) { s[kt] = (f32x4){0.f, 0.f, 0.f, 0.f};
#pragma unroll
                for (int kc = 0; kc < 4; ++kc) { const bf16x8 kf = *(const LAS bf16x8*)(Kt + (16 * kt + fr) * AT_KSTR + kc * 32 + fq * 8);
                    s[kt] = __builtin_amdgcn_mfma_f32_16x16x32_bf16(kf, qf[kc], s[kt], 0, 0, 0); } }
            const bool qsel = own || ((mysel >> (kt64 >> 2)) & 1u);
            float mx = -INFINITY;
#pragma unroll
            for (int kt = 0; kt < 4; ++kt)
#pragma unroll
                for (int e = 0; e < 4; ++e) { const int kabs = key0 + 16 * kt + 4 * fq + e; const bool valid = own ? (kabs <= qabs) : qsel;
                    const float v = valid ? s[kt][e] * sc : -INFINITY; s[kt][e] = v; mx = fmaxf(mx, v); }
            mx = fmaxf(mx, __shfl_xor(mx, 16)); mx = fmaxf(mx, __shfl_xor(mx, 32));
            const float mnew = fmaxf(mrun, mx);
            const float alpha = (mnew == -INFINITY) ? 1.f : exp2f(mrun - mnew);
            const float msub = (mnew == -INFINITY) ? 0.f : mnew;
            float psum = 0.f;
#pragma unroll
            for (int kt = 0; kt < 4; ++kt)
#pragma unroll
                for (int e = 0; e < 4; ++e) { const float p = exp2f(s[kt][e] - msub); s[kt][e] = p; psum += p; }
            lrun = lrun * alpha + psum; mrun = mnew;
#pragma unroll
            for (int i = 0; i < 8; ++i) o[i] *= alpha;
            bf16x8 pf[2];
#pragma unroll
            for (int j = 0; j < 2; ++j) { v4u w; w.x = pk2(s[2 * j][0], s[2 * j][1]); w.y = pk2(s[2 * j][2], s[2 * j][3]); w.z = pk2(s[2 * j + 1][0], s[2 * j + 1][1]); w.w = pk2(s[2 * j + 1][2], s[2 * j + 1][3]);
                pf[j] = __builtin_bit_cast(bf16x8, w); }
#pragma unroll
            for (int dt = 0; dt < 8; ++dt)
#pragma unroll
                for (int j = 0; j < 2; ++j) { const LAS bf16* vp = Vt + (16 * dt + fr) * AT_VSTR + 32 * j + 4 * fq;
                    const v2u lo = *(const LAS v2u*)vp, hi = *(const LAS v2u*)(vp + 16);
                    const v4u w = {lo.x, lo.y, hi.x, hi.y};
                    o[dt] = __builtin_amdgcn_mfma_f32_16x16x32_bf16(__builtin_bit_cast(bf16x8, w), pf[j], o[dt], 0, 0, 0); }
        }
        __syncthreads();
        if (ti + 1 < ntile) lstore();
        __syncthreads();
    }
    float lt = lrun; lt += __shfl_xor(lt, 16); lt += __shfl_xor(lt, 32);
    const float inv = 1.f / lt;
    bf16* Y = (bf16*)(ws + WS_YE) + (size_t)(b * SEQ + qabs) * 2048 + h * 128;
#pragma unroll
    for (int dt = 0; dt < 8; ++dt) { v2u w; w.x = pk2(o[dt][0] * inv, o[dt][1] * inv); w.y = pk2(o[dt][2] * inv, o[dt][3] * inv); *(v2u*)(Y + 16 * dt + 4 * fq) = w; }
    __syncthreads();
}

__device__ __forceinline__ void mlstm_scan(const int wv) {
    const ArgsP a = get_args();
    OPAQUE_TID();
    unsigned char* ws = a->ws;
    const int gt = blockIdx.x * NTHR + tid, NGT = gridDim.x * NTHR;
    for (int idx = gt; idx < 16 * 256 * 32; idx += NGT) { const int bh = idx >> 13, rem = idx & 8191;
        const bf16* DC = (const bf16*)(ws + WS_DC) + (size_t)bh * 64 * 65536 + rem * 8; bf16* CP = (bf16*)(ws + WS_CP) + (size_t)bh * 64 * 65536 + rem * 8;
        const float* dec = (const float*)(ws + WS_DEC) + bh * 64;
        float C[8] = {0, 0, 0, 0, 0, 0, 0, 0};
        for (int c0 = 0; c0 < 64; c0 += 8) { v4u in[8];
#pragma unroll
            for (int j = 0; j < 8; ++j) in[j] = __builtin_nontemporal_load((const v4u*)(DC + (size_t)(c0 + j) * 65536));
#pragma unroll
            for (int j = 0; j < 8; ++j) { const float dc = dec[c0 + j];
                *(v4u*)(CP + (size_t)(c0 + j) * 65536) = (v4u){pk2(C[0], C[1]), pk2(C[2], C[3]), pk2(C[4], C[5]), pk2(C[6], C[7])};
                C[0] = fmaf(dc, C[0], bflo(in[j].x)); C[1] = fmaf(dc, C[1], bfhi(in[j].x)); C[2] = fmaf(dc, C[2], bflo(in[j].y)); C[3] = fmaf(dc, C[3], bfhi(in[j].y));
                C[4] = fmaf(dc, C[4], bflo(in[j].z)); C[5] = fmaf(dc, C[5], bfhi(in[j].z)); C[6] = fmaf(dc, C[6], bflo(in[j].w)); C[7] = fmaf(dc, C[7], bfhi(in[j].w)); } }
    }
    for (int idx = gt; idx < 16 * 256; idx += NGT) { const int bh = idx >> 8, d = idx & 255; const float* DN = (const float*)(ws + WS_DN) + (size_t)bh * 64 * 256 + d; float* NP = (float*)(ws + WS_NP) + (size_t)bh * 64 * 256 + d;
        const float* dec = (const float*)(ws + WS_DEC) + bh * 64; float n = 0.f;
        for (int c = 0; c < 64; ++c) { NP[c * 256] = n; n = fmaf(dec[c], n, DN[c * 256]); } }
}

constexpr int M3_PQ = 528, M3_PVv = 544, M3_PP = 144;
constexpr int M3_Q = 0, M3_K = 64 * M3_PQ, M3_V = 2 * 64 * M3_PQ, M3_P = M3_V + 64 * M3_PVv, M3_F = M3_P + 64 * M3_PP;
__device__ __forceinline__ void mlstm_out_unit(const int wv, LAS unsigned char* lds, int e_, int b, int h, int c) {
    const ArgsP a = get_args();
    OPAQUE_TID(); const int lane = tid & 63, wave = wv, fr = lane & 15, fq = lane >> 4, q4 = (lane >> 2) & 3, p4 = lane & 3;
    unsigned char* ws = a->ws;
    const int bh = b * 4 + h, m0 = b * SEQ + 64 * c;
    const bf16* QKB = (const bf16*)(ws + WS_QKB); const bf16* Z = (const bf16*)(ws + WS_Z);
    LAS unsigned char* Qt = lds + M3_Q; LAS unsigned char* Kt = lds + M3_K; LAS unsigned char* Vt = lds + M3_V; LAS unsigned char* Pm = lds + M3_P;
    LAS float* F = (LAS float*)(lds + M3_F); LAS float* bt = F; LAS float* itv = F + 64; LAS float* ebt = F + 128; LAS float* den = F + 192; LAS float* rstd = F + 256; LAS float* np = F + 320; LAS float* rsp = F + 576;
    { const int sr = tid >> 3, seg = tid & 7;
      const v4u* qs = (const v4u*)(QKB + (size_t)(m0 + sr) * 2048 + h * 256 + 32 * seg); const v4u* ks = (const v4u*)(QKB + (size_t)(m0 + sr) * 2048 + 1024 + h * 256 + 32 * seg);
      const v4u* vs = (const v4u*)(Z + (size_t)(m0 + sr) * ZW + 5120 + h * 256 + 32 * seg);
#pragma unroll
      for (int j = 0; j < 4; ++j) { *(LAS v4u*)(Qt + sr * M3_PQ + (32 * seg + 8 * j) * 2) = qs[j]; *(LAS v4u*)(Kt + sr * M3_PQ + (32 * seg + 8 * j) * 2) = ks[j]; *(LAS v4u*)(Vt + sr * M3_PVv + (32 * seg + 8 * j) * 2) = vs[j]; }
      if (tid < 64) { const float bb = ((const float*)(ws + WS_BC))[(size_t)bh * SEQ + 64 * c + tid]; bt[tid] = bb; ebt[tid] = __expf(bb); itv[tid] = ((const float*)(ws + WS_IG))[(size_t)bh * SEQ + 64 * c + tid]; }
      else if (tid < 320) np[tid - 64] = ((const float*)(ws + WS_NP))[((size_t)bh * 64 + c) * 256 + tid - 64]; }
    v4u cf[8][2];
    { const bf16* CP = (const bf16*)(ws + WS_CP) + ((size_t)bh * 64 + c) * 65536 + (size_t)(32 * wave + fr) * 256 + 8 * fq;
#pragma unroll
      for (int kk = 0; kk < 8; ++kk)
#pragma unroll
          for (int et = 0; et < 2; ++et) cf[kk][et] = *(const v4u*)(CP + et * 16 * 256 + 32 * kk); }
    __syncthreads();
    { const int ss = wave >> 1;
#pragma unroll
      for (int ti = 0; ti < 2; ++ti) { const int tt = 2 * (wave & 1) + ti; f32x4 sacc = {0.f, 0.f, 0.f, 0.f};
#pragma unroll
          for (int kk = 0; kk < 8; ++kk) { const bf16x8 kf = *(const LAS bf16x8*)(Kt + (16 * ss + fr) * M3_PQ + (32 * kk + 8 * fq) * 2), qf = *(const LAS bf16x8*)(Qt + (16 * tt + fr) * M3_PQ + (32 * kk + 8 * fq) * 2);
              sacc = __builtin_amdgcn_mfma_f32_16x16x32_bf16(kf, qf, sacc, 0, 0, 0); }
          const int t = 16 * tt + fr; const float btv = bt[t]; float pv[4];
#pragma unroll
          for (int r = 0; r < 4; ++r) { const int s_ = 16 * ss + 4 * fq + r; pv[r] = (s_ <= t) ? sacc[r] * __expf(btv - bt[s_] + itv[s_]) * 0.0625f : 0.f; }
          *(LAS v2u*)(Pm + t * M3_PP + (16 * ss + 4 * fq) * 2) = (v2u){pk2(pv[0], pv[1]), pk2(pv[2], pv[3])}; } }
    float qn;
    { const int t = tid >> 3, part = tid & 7; float sacc = 0.f;
#pragma unroll
      for (int j = 0; j < 4; ++j) { const v4u w = *(const LAS v4u*)(Qt + t * M3_PQ + (32 * part + 8 * j) * 2); const LAS float* nn = np + 32 * part + 8 * j;
          sacc += bflo(w.x) * nn[0] + bfhi(w.x) * nn[1] + bflo(w.y) * nn[2] + bfhi(w.y) * nn[3] + bflo(w.z) * nn[4] + bfhi(w.z) * nn[5] + bflo(w.w) * nn[6] + bfhi(w.w) * nn[7]; }
      sacc += dppf<0xB1>(sacc); sacc += dppf<0x4E>(sacc); sacc += dppf<0x141>(sacc); qn = sacc; }
    __syncthreads();
    { const int t = tid >> 3, part = tid & 7; const v4u w = *(const LAS v4u*)(Pm + t * M3_PP + part * 16);
      float ps = bflo(w.x) + bfhi(w.x) + bflo(w.y) + bfhi(w.y) + bflo(w.z) + bfhi(w.z) + bflo(w.w) + bfhi(w.w);
      ps += dppf<0xB1>(ps); ps += dppf<0x4E>(ps); ps += dppf<0x141>(ps);
      if (part == 0) den[t] = ebt[t] * qn + ps; }
    f32x4 acc[4][2];
#pragma unroll
    for (int tt = 0; tt < 4; ++tt) { acc[tt][0] = (f32x4){0.f, 0.f, 0.f, 0.f}; acc[tt][1] = (f32x4){0.f, 0.f, 0.f, 0.f}; }
#pragma unroll
    for (int kk = 0; kk < 8; ++kk)
#pragma unroll
        for (int tt = 0; tt < 4; ++tt) { const bf16x8 qf = *(const LAS bf16x8*)(Qt + (16 * tt + fr) * M3_PQ + (32 * kk + 8 * fq) * 2);
            acc[tt][0] = __builtin_amdgcn_mfma_f32_16x16x32_bf16(qf, __builtin_bit_cast(bf16x8, cf[kk][0]), acc[tt][0], 0, 0, 0);
            acc[tt][1] = __builtin_amdgcn_mfma_f32_16x16x32_bf16(qf, __builtin_bit_cast(bf16x8, cf[kk][1]), acc[tt][1], 0, 0, 0); }
#pragma unroll
    for (int tt = 0; tt < 4; ++tt) { const f32x4 eb = *(const LAS f32x4*)(ebt + 16 * tt + 4 * fq); acc[tt][0] *= eb; acc[tt][1] *= eb; }
#pragma unroll
    for (int j = 0; j < 2; ++j) { bf16x8 vf[2];
#pragma unroll
        for (int et = 0; et < 2; ++et) { const LAS unsigned char* p = Vt + (32 * j + 8 * fq + q4) * M3_PVv + (32 * wave + 16 * et + 4 * p4) * 2;
            const v2u lo = tr_read(p), hi = tr_read(p + 4 * M3_PVv); vf[et] = __builtin_bit_cast(bf16x8, (v4u){lo.x, lo.y, hi.x, hi.y}); }
#pragma unroll
        for (int tt = 0; tt < 4; ++tt) { const bf16x8 pf = *(const LAS bf16x8*)(Pm + (16 * tt + fr) * M3_PP + (32 * j + 8 * fq) * 2);
            acc[tt][0] = __builtin_amdgcn_mfma_f32_16x16x32_bf16(pf, vf[0], acc[tt][0], 0, 0, 0); acc[tt][1] = __builtin_amdgcn_mfma_f32_16x16x32_bf16(pf, vf[1], acc[tt][1], 0, 0, 0); } }
    __syncthreads();
    LAS unsigned char* Ht = Qt;
#pragma unroll
    for (int tt = 0; tt < 4; ++tt) { const f32x4 dn = *(const LAS f32x4*)(den + 16 * tt + 4 * fq); float ssq[4];
#pragma unroll
        for (int r = 0; r < 4; ++r) { const float dv = 1.f / fmaxf(fabsf(dn[r]), 1.f); const float h0 = acc[tt][0][r] * dv, h1 = acc[tt][1][r] * dv; ssq[r] = red16(h0 * h0 + h1 * h1);
            const int t = 16 * tt + 4 * fq + r;
            *(LAS bf16*)(Ht + t * M3_PQ + (32 * wave + fr) * 2) = (bf16)f2bf(h0); *(LAS bf16*)(Ht + t * M3_PQ + (32 * wave + 16 + fr) * 2) = (bf16)f2bf(h1); }
        if (fr == 0) *(LAS f32x4*)(rsp + wave * 64 + 16 * tt + 4 * fq) = (f32x4){ssq[0], ssq[1], ssq[2], ssq[3]}; }
    __syncthreads();
    if (tid < 64) { float tot = 0.f;
#pragma unroll
        for (int w = 0; w < 8; ++w) tot += rsp[w * 64 + tid];
        rstd[tid] = 1.f / sqrtf(tot * (1.f / 256.f) + 1e-6f); }
    __syncthreads();
    { const int t = tid >> 3, seg = tid & 7; const float rs = rstd[t]; const float* hg = a->in[5] + (size_t)e_ * 1024 + h * 256 + 32 * seg;
      const v4u* os = (const v4u*)(Z + (size_t)(m0 + t) * ZW + 6144 + h * 256 + 32 * seg); v4u* yd = (v4u*)((bf16*)(ws + WS_YE) + (size_t)(m0 + t) * 2048 + 1024 + h * 256 + 32 * seg);
#pragma unroll
      for (int j = 0; j < 4; ++j) { const v4u hw = *(const LAS v4u*)(Ht + t * M3_PQ + (32 * seg + 8 * j) * 2), ow = os[j]; const f32x4 g0 = *(const f32x4*)(hg + 8 * j), g1 = *(const f32x4*)(hg + 8 * j + 4);
          yd[j] = (v4u){pk2(bflo(hw.x) * rs * g0.x * sigmoidf_(bflo(ow.x)), bfhi(hw.x) * rs * g0.y * sigmoidf_(bfhi(ow.x))), pk2(bflo(hw.y) * rs * g0.z * sigmoidf_(bflo(ow.y)), bfhi(hw.y) * rs * g0.w * sigmoidf_(bfhi(ow.y))),
                        pk2(bflo(hw.z) * rs * g1.x * sigmoidf_(bflo(ow.z)), bfhi(hw.z) * rs * g1.y * sigmoidf_(bfhi(ow.z))), pk2(bflo(hw.w) * rs * g1.z * sigmoidf_(bflo(ow.w)), bfhi(hw.w) * rs * g1.w * sigmoidf_(bfhi(ow.w)))}; } }
    __syncthreads();
}

__device__ __forceinline__ void odd_prep(const int wv, int o) {
    const ArgsP a = get_args();
#ifdef NO_OPREP
    return;
#endif
    OPAQUE_TID(); const int lane = tid & 63, wave = tid >> 6;
    unsigned char* ws = a->ws;
    const float* mu = a->in[7] + (size_t)o * 6 * 2048;
    bf16* XR = (bf16*)(ws + WS_XRKV); bf16* XK = XR + (size_t)T_ * 2048; bf16* XV = XK + (size_t)T_ * 2048; bf16* XC = (bf16*)(ws + WS_XC);
    const int gw = blockIdx.x * NWAVES + wave, NGW = gridDim.x * NWAVES;
    for (int m = gw; m < T_; m += NGW) { const bool first = (m % SEQ) == 0;
        const f32x4* xr = (const f32x4*)(a->out + (size_t)m * D_) + lane; const f32x4* xp = (const f32x4*)(a->out + (size_t)(m - 1) * D_) + lane;
#pragma unroll
        for (int j = 0; j < 8; ++j) { const f32x4 x = xr[64 * j]; f32x4 p = {0.f, 0.f, 0.f, 0.f}; if (!first) p = xp[64 * j]; const f32x4 dx = p - x;
            const f32x4 m0 = ((const f32x4*)mu)[lane + 64 * j], m2 = ((const f32x4*)(mu + 2 * 2048))[lane + 64 * j], m3 = ((const f32x4*)(mu + 3 * 2048))[lane + 64 * j];
            const f32x4 r = x + dx * m0, k = x + dx * m2, v = x + dx * m3; const size_t off = (size_t)m * 2048 + 4 * (lane + 64 * j);
            *(v2u*)(XR + off) = (v2u){pk2(r.x, r.y), pk2(r.z, r.w)}; *(v2u*)(XK + off) = (v2u){pk2(k.x, k.y), pk2(k.z, k.w)}; *(v2u*)(XV + off) = (v2u){pk2(v.x, v.y), pk2(v.z, v.w)};
            const size_t offc = (size_t)m * 4096 + 4 * (lane + 64 * j);
            *(v2u*)(XC + offc) = (v2u){pk2(x.x, x.y), pk2(x.z, x.w)}; *(v2u*)(XC + offc + 2048) = (v2u){pk2(dx.x, dx.y), pk2(dx.z, dx.w)}; }
    }
}

constexpr int RK_KQ = 0, RK_RQ = 4096, RK_TAB = 8192, RK_XU = 9216, RK_W4 = 17408, RK_VB = 19456, RK_CBUF = 27648;
constexpr int RK_PB0 = 2 * RK_CBUF, RK_PG = 0, RK_PV = 8192, RK_PBON = 16384, RK_PBSZ = 16512;
constexpr int RK_Y0 = RK_PB0 + 3 * RK_PBSZ, RK_YSZ = 64 * 33 * 4;
static_assert(RK_Y0 + 2 * RK_YSZ <= RING_BYTES, "rwkv LDS map");
__device__ __forceinline__ float dot16(const f32x4 x, const f32x4 y) { return red16(x.x * y.x + x.y * y.y + x.z * y.z + x.w * y.w); }
__device__ __forceinline__ v2u pk4(const f32x4 v) { return (v2u){pk2(v.x, v.y), pk2(v.z, v.w)}; }
__device__ __forceinline__ f32x4 unpk4(const v2u w) { return (f32x4){bflo(w.x), bfhi(w.x), bflo(w.y), bfhi(w.y)}; }

__device__ __forceinline__ void rwkv_unit(const int wv, LAS unsigned char* lds, int o, int b, int h) {
    const ArgsP a = get_args();
#ifdef NO_RWKV
    return;
#endif
    OPAQUE_TID(); const int lane = tid & 63, fr = lane & 15, fq = lane >> 4;
    unsigned char* ws = a->ws;
    constexpr int NCH = SEQ / 32;
    if (wv < 4) {
        f32x4 S[4];
#pragma unroll
        for (int kt = 0; kt < 4; ++kt) S[kt] = (f32x4){0.f, 0.f, 0.f, 0.f};
        const int row = 16 * wv + fr;
        const bool f0 = fq == 0;
        __syncthreads();
        for (int c = 0; c < NCH; ++c) {
            const LAS unsigned char* B = lds + (c & 1) * RK_CBUF; LAS float* yb = (LAS float*)(lds + RK_Y0 + (c & 1) * RK_YSZ) + row * 33;
#pragma unroll 2
            for (int bk = 0; bk < 8; ++bk) {
                bf16x8 ys[2];
#pragma unroll
                for (int ks = 0; ks < 2; ++ks) { const v4u w = {pk2(S[2 * ks][0], S[2 * ks][1]), pk2(S[2 * ks][2], S[2 * ks][3]), pk2(S[2 * ks + 1][0], S[2 * ks + 1][1]), pk2(S[2 * ks + 1][2], S[2 * ks + 1][3])}; ys[ks] = __builtin_bit_cast(bf16x8, w); }
                f32x4 du = {0.f, 0.f, 0.f, 0.f}, dy = {0.f, 0.f, 0.f, 0.f};
#pragma unroll
                for (int ks = 0; ks < 2; ++ks) { const LAS unsigned char* kp = B + RK_KQ + bk * 512 + (fr & 3) * 128 + (32 * ks + 4 * fq) * 2; const LAS unsigned char* rp = kp + (RK_RQ - RK_KQ);
                    const v2u k0 = *(const LAS v2u*)kp, k1 = *(const LAS v2u*)(kp + 32), r0 = *(const LAS v2u*)rp, r1 = *(const LAS v2u*)(rp + 32);
                    du = __builtin_amdgcn_mfma_f32_16x16x32_bf16(__builtin_bit_cast(bf16x8, (v4u){k0.x, k0.y, k1.x, k1.y}), ys[ks], du, 0, 0, 0);
                    dy = __builtin_amdgcn_mfma_f32_16x16x32_bf16(__builtin_bit_cast(bf16x8, (v4u){r0.x, r0.y, r1.x, r1.y}), ys[ks], dy, 0, 0, 0); }
                const LAS f32x4* T = (const LAS f32x4*)(B + RK_TAB + bk * 128);
                const f32x4 c1a = T[0], c1b = T[1], c2a = T[2], c2b = T[3], e1a = T[4], e1b = T[5], e1c = T[6], e2a = T[7];
                const f32x4 vv = *(const LAS f32x4*)(B + RK_VB + bk * 1024 + row * 16);
                const float tb[32] = {c1a.x, c1a.y, c1a.z, c1a.w, c1b.x, c1b.y, c1b.z, c1b.w, c2a.x, c2a.y, c2a.z, c2a.w, c2b.x, c2b.y, c2b.z, c2b.w,
                                      e1a.x, e1a.y, e1a.z, e1a.w, e1b.x, e1b.y, e1b.z, e1b.w, e1c.x, e1c.y, e1c.z, e1c.w, e2a.x, e2a.y, e2a.z, e2a.w};
                const float u0 = du[0];
                const float u1 = du[1] + vv.x * tb[0] - u0 * tb[6];
                const float u2 = du[2] + vv.x * tb[1] - u0 * tb[7] + vv.y * tb[2] - u1 * tb[8];
                const float u3 = du[3] + vv.x * tb[3] - u0 * tb[9] + vv.y * tb[4] - u1 * tb[10] + vv.z * tb[5] - u2 * tb[11];
                const float y0 = dy[0] + vv.x * tb[12] - u0 * tb[22];
                const float y1 = dy[1] + vv.x * tb[13] - u0 * tb[23] + vv.y * tb[14] - u1 * tb[24];
                const float y2 = dy[2] + vv.x * tb[15] - u0 * tb[25] + vv.y * tb[16] - u1 * tb[26] + vv.z * tb[17] - u2 * tb[27];
                const float y3 = dy[3] + vv.x * tb[18] - u0 * tb[28] + vv.y * tb[19] - u1 * tb[29] + vv.z * tb[20] - u2 * tb[30] + vv.w * tb[21] - u3 * tb[31];
                if (f0) { yb[4 * bk] = y0; yb[4 * bk + 1] = y1; yb[4 * bk + 2] = y2; yb[4 * bk + 3] = y3; }
                v4u yw = {pk2(vv.x, vv.y), pk2(vv.z, vv.w), pk2(u0, u1), pk2(u2, u3)};
                if (!f0) yw = (v4u){0u, 0u, 0u, 0u};
                const bf16x8 yop = __builtin_bit_cast(bf16x8, yw);
#pragma unroll
                for (int kt = 0; kt < 4; ++kt) { const f32x4 w4 = *(const LAS f32x4*)(B + RK_W4 + bk * 256 + (16 * kt + 4 * fq) * 4);
                    v4u xw = *(const LAS v4u*)(B + RK_XU + bk * 1024 + (16 * kt + fr) * 16); if (!f0) xw = (v4u){0u, 0u, 0u, 0u};
                    S[kt] = __builtin_amdgcn_mfma_f32_16x16x32_bf16(__builtin_bit_cast(bf16x8, xw), yop, S[kt] * w4, 0, 0, 0); }
            }
            __syncthreads();
        }
    } else if (wv < 6) {
        const int ptid = tid - 256, g8 = ptid >> 4, kq = ptid & 15;
        const size_t rowbase = (size_t)b * SEQ * 2048 + h * 64 + 4 * kq;
        const bf16* Rb = (const bf16*)(ws + WS_RKV) + rowbase; const bf16* Kb = Rb + (size_t)T_ * 2048; const bf16* Vb = Kb + (size_t)T_ * 2048;
        const bf16* Gb = (const bf16*)(ws + WS_G) + rowbase; const bf16* WDb = (const bf16*)(ws + WS_WD) + rowbase; const bf16* AAb = (const bf16*)(ws + WS_AA) + rowbase;
        const int pc = h * 64 + 4 * kq;
        const f32x4 p_kk = *(const f32x4*)(a->in[20] + (size_t)o * 2048 + pc), p_ka = *(const f32x4*)(a->in[21] + (size_t)o * 2048 + pc), p_rk = *(const f32x4*)(a->in[22] + (size_t)o * 2048 + pc);
        v2u gk[4], ga[4], gw[4], gr[4], gv[4], gg[4];
        auto gload = [&](int c) {
#pragma unroll
            for (int j = 0; j < 4; ++j) { const size_t off = (size_t)(32 * c + 4 * g8 + j) * 2048;
                gk[j] = *(const v2u*)(Kb + off); ga[j] = *(const v2u*)(AAb + off); gw[j] = *(const v2u*)(WDb + off); gr[j] = *(const v2u*)(Rb + off); gv[j] = *(const v2u*)(Vb + off); gg[j] = *(const v2u*)(Gb + off); } };
        auto prep = [&](int c) {
            LAS unsigned char* B = lds + (c & 1) * RK_CBUF; LAS unsigned char* P = lds + RK_PB0 + (c % 3) * RK_PBSZ;
            f32x4 kk[4], bbv[4], kh[4], w[4], r[4], v[4];
#pragma unroll
            for (int j = 0; j < 4; ++j) { const f32x4 k = unpk4(gk[j]), aa = unpk4(ga[j]), wd = unpk4(gw[j]); r[j] = unpk4(gr[j]); v[j] = unpk4(gv[j]);
                const f32x4 kx = k * p_kk; const float inv = 1.f / fmaxf(sqrtf(dot16(kx, kx)), 1e-12f); kk[j] = kx * inv; bbv[j] = kk[j] * aa; kh[j] = k * (1.f + (aa - 1.f) * p_ka);
                w[j] = (f32x4){__expf(wd.x), __expf(wd.y), __expf(wd.z), __expf(wd.w)};
                const float bon = dot16(r[j] * kh[j], p_rk);
                *(LAS f32x4*)(P + RK_PG + ((4 * g8 + j) * 64 + 4 * kq) * 4) = unpk4(gg[j]); *(LAS f32x4*)(P + RK_PV + ((4 * g8 + j) * 64 + 4 * kq) * 4) = v[j];
                if (kq == 0) *(LAS float*)(P + RK_PBON + (4 * g8 + j) * 4) = bon; }
            const f32x4 w12 = w[1] * w[2], w23 = w[2] * w[3], w123 = w12 * w[3], W2 = w[0] * w[1], W3 = W2 * w[2], W4 = W3 * w[3];
            *(LAS v2u*)(B + RK_KQ + g8 * 512 + 0 * 128 + 8 * kq) = pk4(kk[0]);      *(LAS v2u*)(B + RK_RQ + g8 * 512 + 0 * 128 + 8 * kq) = pk4(r[0] * w[0]);
            *(LAS v2u*)(B + RK_KQ + g8 * 512 + 1 * 128 + 8 * kq) = pk4(kk[1] * w[0]); *(LAS v2u*)(B + RK_RQ + g8 * 512 + 1 * 128 + 8 * kq) = pk4(r[1] * W2);
            *(LAS v2u*)(B + RK_KQ + g8 * 512 + 2 * 128 + 8 * kq) = pk4(kk[2] * W2);   *(LAS v2u*)(B + RK_RQ + g8 * 512 + 2 * 128 + 8 * kq) = pk4(r[2] * W3);
            *(LAS v2u*)(B + RK_KQ + g8 * 512 + 3 * 128 + 8 * kq) = pk4(kk[3] * W3);   *(LAS v2u*)(B + RK_RQ + g8 * 512 + 3 * 128 + 8 * kq) = pk4(r[3] * W4);
            float tb[32];
            { const f32x4 h0w1 = kh[0] * w[1], h0w12 = kh[0] * w12, h1w2 = kh[1] * w[2], b0w1 = bbv[0] * w[1], b0w12 = bbv[0] * w12, b1w2 = bbv[1] * w[2];
              tb[0] = dot16(kh[0], kk[1]); tb[1] = dot16(h0w1, kk[2]); tb[2] = dot16(kh[1], kk[2]); tb[3] = dot16(h0w12, kk[3]); tb[4] = dot16(h1w2, kk[3]); tb[5] = dot16(kh[2], kk[3]);
              tb[6] = dot16(bbv[0], kk[1]); tb[7] = dot16(b0w1, kk[2]); tb[8] = dot16(bbv[1], kk[2]); tb[9] = dot16(b0w12, kk[3]); tb[10] = dot16(b1w2, kk[3]); tb[11] = dot16(bbv[2], kk[3]);
              tb[12] = dot16(kh[0], r[0]); tb[13] = dot16(h0w1, r[1]); tb[14] = dot16(kh[1], r[1]); tb[15] = dot16(h0w12, r[2]); tb[16] = dot16(h1w2, r[2]); tb[17] = dot16(kh[2], r[2]);
              tb[18] = dot16(kh[0] * w123, r[3]); tb[19] = dot16(kh[1] * w23, r[3]); tb[20] = dot16(kh[2] * w[3], r[3]); tb[21] = dot16(kh[3], r[3]);
              tb[22] = dot16(bbv[0], r[0]); tb[23] = dot16(b0w1, r[1]); tb[24] = dot16(bbv[1], r[1]); tb[25] = dot16(b0w12, r[2]); tb[26] = dot16(b1w2, r[2]); tb[27] = dot16(bbv[2], r[2]);
              tb[28] = dot16(bbv[0] * w123, r[3]); tb[29] = dot16(bbv[1] * w23, r[3]); tb[30] = dot16(bbv[2] * w[3], r[3]); tb[31] = dot16(bbv[3], r[3]); }
            if (kq < 8) { f32x4 tv;
#pragma unroll
                for (int q = 0; q < 8; ++q) if (kq == q) tv = (f32x4){tb[4 * q], tb[4 * q + 1], tb[4 * q + 2], tb[4 * q + 3]};
                *(LAS f32x4*)(B + RK_TAB + g8 * 128 + kq * 16) = tv; }
            { const f32x4 hw0 = kh[0] * w123, hw1 = kh[1] * w23, hw2 = kh[2] * w[3], hw3 = kh[3], bw0 = bbv[0] * w123, bw1 = bbv[1] * w23, bw2 = bbv[2] * w[3], bw3 = bbv[3];
#pragma unroll
              for (int i = 0; i < 4; ++i) *(LAS v4u*)(B + RK_XU + g8 * 1024 + (4 * kq + i) * 16) = (v4u){pk2(hw0[i], hw1[i]), pk2(hw2[i], hw3[i]), pk2(-bw0[i], -bw1[i]), pk2(-bw2[i], -bw3[i])};
              *(LAS f32x4*)(B + RK_W4 + g8 * 256 + 16 * kq) = W4;
#pragma unroll
              for (int i = 0; i < 4; ++i) *(LAS f32x4*)(B + RK_VB + g8 * 1024 + (4 * kq + i) * 16) = (f32x4){v[0][i], v[1][i], v[2][i], v[3][i]}; }
        };
        gload(0); prep(0); gload(1);
        __syncthreads();
        for (int c = 0; c < NCH; ++c) {
            if (c + 1 < NCH) { prep(c + 1); if (c + 2 < NCH) gload(c + 2); }
            __syncthreads();
        }
    } else {
        const int qtid = tid - 384, st = qtid >> 2, rq = qtid & 3;
        bf16* Yb = (bf16*)(ws + WS_YO) + (size_t)b * SEQ * 2048 + h * 64 + 16 * rq;
        const float* lg = a->in[23] + (size_t)o * 2048 + h * 64 + 16 * rq; const float* lb = a->in[24] + (size_t)o * 2048 + h * 64 + 16 * rq;
        auto post = [&](int c) {
            const LAS float* yb = (const LAS float*)(lds + RK_Y0 + (c & 1) * RK_YSZ); const LAS unsigned char* P = lds + RK_PB0 + (c % 3) * RK_PBSZ;
            float y[16]; float s1 = 0.f;
#pragma unroll
            for (int i = 0; i < 16; ++i) { y[i] = yb[(16 * rq + i) * 33 + st]; s1 += y[i]; }
            s1 += dppf<0xB1>(s1); s1 += dppf<0x4E>(s1); const float mean = s1 * (1.f / 64.f); float s2 = 0.f;
#pragma unroll
            for (int i = 0; i < 16; ++i) { y[i] -= mean; s2 += y[i] * y[i]; }
            s2 += dppf<0xB1>(s2); s2 += dppf<0x4E>(s2); const float rstd = 1.f / sqrtf(s2 * (1.f / 64.f) + 64e-5f);
            const float bon = *(const LAS float*)(P + RK_PBON + st * 4);
            unsigned ow[8];
#pragma unroll
            for (int i4 = 0; i4 < 4; ++i4) { const f32x4 g = *(const LAS f32x4*)(P + RK_PG + (st * 64 + 16 * rq + 4 * i4) * 4), v = *(const LAS f32x4*)(P + RK_PV + (st * 64 + 16 * rq + 4 * i4) * 4);
                const f32x4 lgv = *(const f32x4*)(lg + 4 * i4), lbv = *(const f32x4*)(lb + 4 * i4); float o4[4];
#pragma unroll
                for (int i = 0; i < 4; ++i) o4[i] = (y[4 * i4 + i] * rstd * lgv[i] + lbv[i] + bon * v[i]) * g[i];
                ow[2 * i4] = pk2(o4[0], o4[1]); ow[2 * i4 + 1] = pk2(o4[2], o4[3]); }
            v4u* dst = (v4u*)(Yb + (size_t)(32 * c + st) * 2048); dst[0] = (v4u){ow[0], ow[1], ow[2], ow[3]}; dst[1] = (v4u){ow[4], ow[5], ow[6], ow[7]};
        };
        __syncthreads();
        for (int c = 0; c < NCH; ++c) {
            if (c >= 1) post(c - 1);
            __syncthreads();
        }
        post(NCH - 1);
    }
    __syncthreads();
}

__device__ __forceinline__ void ln_router(const int wv, int l) {
    const ArgsP a = get_args();
#ifdef NO_ROUTER
    return;
#endif
    OPAQUE_TID(); const int lane = tid & 63, wave = tid >> 6;
    unsigned char* ws = a->ws;
    const float* lg = a->in[28] + (size_t)l * 2048; const float* lb = a->in[29] + (size_t)l * 2048;
    const float* Wg = a->in[32] + (size_t)l * 2048 * 4; const float* bg = a->in[33] + l * 4; const float* We = a->in[34] + (size_t)l * 2048 * 32; const float* be = a->in[35] + l * 32;
    unsigned* cnt = (unsigned*)(ws + WS_CTL) + CW_CNT + (size_t)l * 32 * 64;
    int* TOKE = (int*)(ws + WS_TOKE); int* TOKR = (int*)(ws + WS_TOKR); float* TOKG = (float*)(ws + WS_TOKG);
    const int gw = blockIdx.x * NWAVES + wave, NGW = gridDim.x * NWAVES;
    for (int m = gw; m < T_; m += NGW) {
        f32x4* xr = (f32x4*)(a->out + (size_t)m * D_) + lane; f32x4 v[8]; float s = 0.f;
#pragma unroll
        for (int j = 0; j < 8; ++j) { v[j] = xr[64 * j]; s += (v[j].x + v[j].y) + (v[j].z + v[j].w); }
        const float mean = wave_sum(s) * (1.f / D_); float s2 = 0.f;
#pragma unroll
        for (int j = 0; j < 8; ++j) { v[j] = v[j] - mean; s2 += (v[j].x * v[j].x + v[j].y * v[j].y) + (v[j].z * v[j].z + v[j].w * v[j].w); }
        const float rstd = 1.f / sqrtf(wave_sum(s2) * (1.f / D_) + LN_EPS);
        float ag[4] = {0, 0, 0, 0};
#pragma unroll
        for (int j = 0; j < 8; ++j) { const f32x4 g = ((const f32x4*)lg)[lane + 64 * j], bb = ((const f32x4*)lb)[lane + 64 * j]; v[j] = v[j] * rstd * g + bb; xr[64 * j] = v[j];
            ((v2u*)(ws + WS_XB))[(size_t)m * 512 + lane + 64 * j] = (v2u){pk2(v[j].x, v[j].y), pk2(v[j].z, v[j].w)};
            const f32x4* wp = (const f32x4*)Wg + 4 * (lane + 64 * j);
#pragma unroll
            for (int i = 0; i < 4; ++i) { const f32x4 w = wp[i]; const float x = v[j][i]; ag[0] += x * w.x; ag[1] += x * w.y; ag[2] += x * w.z; ag[3] += x * w.w; } }
#pragma unroll
        for (int i = 0; i < 4; ++i) ag[i] = wave_sum(ag[i]) + bg[i];
        int gi = 0; float gm = ag[0];
#pragma unroll
        for (int i = 1; i < 4; ++i) if (ag[i] > gm) { gm = ag[i]; gi = i; }
        float gs = 0.f;
#pragma unroll
        for (int i = 0; i < 4; ++i) gs += __expf(ag[i] - gm);
        const float gp = 1.f / gs;
        float ae[8] = {0, 0, 0, 0, 0, 0, 0, 0};
#pragma unroll
        for (int j = 0; j < 8; ++j) {
#pragma unroll
            for (int i = 0; i < 4; ++i) { const float* wr = We + (size_t)(4 * (lane + 64 * j) + i) * 32 + 8 * gi; const f32x4 w0 = *(const f32x4*)wr, w1 = *(const f32x4*)(wr + 4); const float x = v[j][i];
                ae[0] += x * w0.x; ae[1] += x * w0.y; ae[2] += x * w0.z; ae[3] += x * w0.w; ae[4] += x * w1.x; ae[5] += x * w1.y; ae[6] += x * w1.z; ae[7] += x * w1.w; } }
#pragma unroll
        for (int i = 0; i < 8; ++i) ae[i] = wave_sum(ae[i]) + be[8 * gi + i];
        int e1 = 0; float m1 = ae[0];
#pragma unroll
        for (int i = 1; i < 8; ++i) if (ae[i] > m1) { m1 = ae[i]; e1 = i; }
        int e2 = -1; float m2 = -3.0e38f;
#pragma unroll
        for (int i = 0; i < 8; ++i) if (i != e1 && ae[i] > m2) { m2 = ae[i]; e2 = i; }
        const float p2 = __expf(m2 - m1), den = 1.f / (1.f + p2);
        if (lane == 0) { const int x1 = 8 * gi + e1, x2 = 8 * gi + e2;
            const unsigned r1 = __hip_atomic_fetch_add(cnt + x1 * 64, 1u, __ATOMIC_RELAXED, __HIP_MEMORY_SCOPE_AGENT);
            const unsigned r2 = __hip_atomic_fetch_add(cnt + x2 * 64, 1u, __ATOMIC_RELAXED, __HIP_MEMORY_SCOPE_AGENT);
            TOKE[2 * m] = x1; TOKE[2 * m + 1] = x2; TOKR[2 * m] = (int)r1; TOKR[2 * m + 1] = (int)r2; TOKG[2 * m] = gp * den; TOKG[2 * m + 1] = gp * p2 * den; }
    }
}

struct MoeTab { LAS int* start; LAS int* tileE; LAS int* ntiles; };
__device__ __forceinline__ MoeTab moe_tables(const int wv, int l, LAS unsigned char* lds) {
    const ArgsP a = get_args();
    MoeTab t; t.start = (LAS int*)(lds + MISC_OFF + 256); t.tileE = t.start + 40; t.ntiles = t.tileE + 168;
    OPAQUE_TID();
    if (tid == 0) { unsigned* cnt = (unsigned*)(a->ws + WS_CTL) + CW_CNT + (size_t)l * 32 * 64; int acc = 0;
        for (int e = 0; e < 32; ++e) { const int c = (int)__hip_atomic_load(cnt + e * 64, __ATOMIC_RELAXED, __HIP_MEMORY_SCOPE_AGENT); const int pad = (c + 255) & ~255;
            t.start[e] = acc; for (int q = acc >> 8; q < ((acc + pad) >> 8) && q < MOE_TILES; ++q) t.tileE[q] = e; acc += pad; }
        int nt = acc >> 8; if (nt > MOE_TILES) nt = MOE_TILES; *t.ntiles = nt; }
    __syncthreads();
    return t;
}
__device__ __forceinline__ void moe_gather(const int wv, const MoeTab& tb) {
    const ArgsP a = get_args();
#ifdef NO_GATHER
    return;
#endif
    OPAQUE_TID(); const int lane = tid & 63, wave = tid >> 6;
    unsigned char* ws = a->ws;
    const int* TOKE = (const int*)(ws + WS_TOKE); const int* TOKR = (const int*)(ws + WS_TOKR); int* SLOT = (int*)(ws + WS_SLOT);
    const int gw = blockIdx.x * NWAVES + wave, NGW = gridDim.x * NWAVES;
    for (int it = gw; it < 2 * T_; it += NGW) { const int m = it >> 1; const int dest = tb.start[TOKE[it]] + TOKR[it];
        if (lane == 0) SLOT[it] = dest;
        const v4u* src = (const v4u*)(ws + WS_XB) + (size_t)m * 256 + lane; v4u* dst = (v4u*)(ws + WS_XS) + (size_t)dest * 256 + lane;
#pragma unroll
        for (int j = 0; j < 4; ++j) dst[64 * j] = src[64 * j]; }
}
template <int NJ> struct MoeOrder {
    LAS int* tileE; int nunits, G, c;
    __device__ bool next(int i, pg8::Unit& u) const { const int L = i * G + c; if (L >= nunits) return false; u.pm = L / NJ; u.pn = tileE[u.pm] * NJ + (L % NJ); u.aoff = 0; return true; }
    __device__ __forceinline__ void a_ready(const pg8::Unit&) const {}
    __device__ __forceinline__ void done(const pg8::Unit&) const {}
};
__device__ __forceinline__ void moe_combine_ln(const int wv, int l) {
    const ArgsP a = get_args();
#ifdef NO_COMBINE
    return;
#endif
    OPAQUE_TID(); const int lane = tid & 63, wave = tid >> 6;
    unsigned char* ws = a->ws;
    const float* lg = a->in[30] + (size_t)l * 2048; const float* lb = a->in[31] + (size_t)l * 2048;
    const int* SLOT = (const int*)(ws + WS_SLOT); const float* TOKG = (const float*)(ws + WS_TOKG); const bf16* YS = (const bf16*)(ws + WS_YS);
    const int gw = blockIdx.x * NWAVES + wave, NGW = gridDim.x * NWAVES;
    for (int m = gw; m < T_; m += NGW) {
        f32x4* xr = (f32x4*)(a->out + (size_t)m * D_) + lane; f32x4 v[8]; float s = 0.f;
        const int s0 = SLOT[2 * m], s1 = SLOT[2 * m + 1]; const float g0 = TOKG[2 * m], g1 = TOKG[2 * m + 1];
        const v2u* y0 = (const v2u*)(YS + (size_t)s0 * 2048) + lane; const v2u* y1 = (const v2u*)(YS + (size_t)s1 * 2048) + lane;
#pragma unroll
        for (int j = 0; j < 8; ++j) { const f32x4 x = xr[64 * j]; const v2u a0 = y0[64 * j], a1 = y1[64 * j];
            v[j].x = DN_ALPHA * x.x + g0 * bflo(a0.x) + g1 * bflo(a1.x); v[j].y = DN_ALPHA * x.y + g0 * bfhi(a0.x) + g1 * bfhi(a1.x);
            v[j].z = DN_ALPHA * x.z + g0 * bflo(a0.y) + g1 * bflo(a1.y); v[j].w = DN_ALPHA * x.w + g0 * bfhi(a0.y) + g1 * bfhi(a1.y);
            s += (v[j].x + v[j].y) + (v[j].z + v[j].w); }
        const float mean = wave_sum(s) * (1.f / D_); float s2 = 0.f;
#pragma unroll
        for (int j = 0; j < 8; ++j) { v[j] = v[j] - mean; s2 += (v[j].x * v[j].x + v[j].y * v[j].y) + (v[j].z * v[j].z + v[j].w * v[j].w); }
        const float rstd = 1.f / sqrtf(wave_sum(s2) * (1.f / D_) + LN_EPS);
#pragma unroll
        for (int j = 0; j < 8; ++j) { const f32x4 g = ((const f32x4*)lg)[lane + 64 * j], bb = ((const f32x4*)lb)[lane + 64 * j]; v[j] = v[j] * rstd * g + bb; xr[64 * j] = v[j];
            ((v2u*)(ws + WS_XB))[(size_t)m * 512 + lane + 64 * j] = (v2u){pk2(v[j].x, v[j].y), pk2(v[j].z, v[j].w)}; }
    }
}

struct RkvOrder {
    pg8::StaticOrder in; int G, c;
    __device__ bool next(int i, pg8::Unit& u) const { const long L = (long)i * G + c; if (L >= 1536) return false; const int g = (int)(L / 512);
        in.at(L % 512, u); u.pm += 64 * g; u.pn += 8 * g; return true; }
    __device__ __forceinline__ void a_ready(const pg8::Unit&) const {}
    __device__ __forceinline__ void done(const pg8::Unit&) const {}
};
struct L2Order {
    int nunits, G, c;
    __device__ bool next(int i, pg8::Unit& u) const { const int L = i * G + c; if (L >= nunits) return false; u.pn = L >> 6; u.pm = L & 63; u.aoff = (u.pn >= 8) ? 512 : 0; return true; }
    __device__ __forceinline__ void a_ready(const pg8::Unit&) const {}
    __device__ __forceinline__ void done(const pg8::Unit&) const {}
};


#ifndef REP_PROL
#define REP_PROL 1
#endif
#ifndef REP_INPROJ
#define REP_INPROJ 1
#endif
#ifndef REP_ATTN
#define REP_ATTN 1
#endif
#ifndef REP_MLSTM
#define REP_MLSTM 1
#endif
#ifndef REP_HNORM
#define REP_HNORM 1
#endif
#ifndef REP_OPREP
#define REP_OPREP 1
#endif
#ifndef REP_RKV
#define REP_RKV 1
#endif
#ifndef REP_RWKV
#define REP_RWKV 1
#endif
#ifndef REP_GATHER
#define REP_GATHER 1
#endif
#ifndef REP_GU
#define REP_GU 1
#endif
#ifndef REP_DN
#define REP_DN 1
#endif
#define REPX_1(...) __VA_ARGS__
#define REPX_2(...) __VA_ARGS__ __VA_ARGS__
#define REPX_3(...) __VA_ARGS__ __VA_ARGS__ __VA_ARGS__
#define REPX_(n, ...) REPX_##n(__VA_ARGS__)
#define REPX(n, ...) REPX_(n, __VA_ARGS__)

constexpr int N_PHASES = 41;

__global__ void __launch_bounds__(NTHR, 2) fwd(Args args) {
    extern __shared__ __attribute__((aligned(16))) unsigned char lds_raw[];
    LAS unsigned char* lds = (LAS unsigned char*)lds_raw;
    const int wv = __builtin_amdgcn_readfirstlane((int)threadIdx.x >> 6);
    OPAQUE_TID();
    const ArgsP ap0 = get_args();
    if (tid < 16) ((LAS unsigned*)(lds + MISC_OFF))[tid] = 0u;
    __syncthreads();
#if ONE_LAUNCH
    XcdBarrier bar = xcd_barrier_post((unsigned*)(ap0->ws + WS_CTL) + CW_BAR, (volatile LAS unsigned*)(lds + MISC_OFF), tid == 0);
#define SEAM(k) do { if ((k) + 1 < hi) xcd_barrier(bar, tid == 0); } while (0)
#define SEAMR() xcd_barrier(bar, tid == 0)
#else
#define SEAM(k) do { } while (0)
#define SEAMR() do { } while (0)
#endif
    const int lo = ap0->ph_lo, hi = ap0->ph_hi;
#define IN(k) (lo <= (k) && (k) < hi)
    const int G = gridDim.x, cb = blockIdx.x;

    if (IN(0)) { REPX(REP_PROL, { prologue(wv, lds); SEAMR(); }) }

    auto layer = [&](auto lc) __attribute__((always_inline)) { constexpr int l = decltype(lc)::value;
        const int pb = 1 + 10 * l, eo = l >> 1;
        if ((l & 1) == 0) {
            if (IN(pb + 0)) {
                const ArgsP ap = get_args(); unsigned char* ws = ap->ws;
                pg8::Gemm g{(const bf16*)(ws + WS_XB), (const bf16*)(ws + WS_WIN) + (size_t)eo * ZW * 2048, 2048, 2048, 2048};
                pg8::StaticOrder S; S.init(T_, ZW, G, cb);
                pg8::EpiBf16 E{(bf16*)(ws + WS_Z), ZW, 0, 0, 0, nullptr};
                REPX(REP_INPROJ, { pg8::gemm_phase<pg8::EpiBf16, pg8::StaticOrder, true, false>(wv, lds, g, S, E); SEAMR(); })
            }
            if (IN(pb + 1)) { for (int u = cb; u < 256; u += G) even_prep(wv, eo, lds, u); SEAM(pb + 1); }
            if (IN(pb + 2)) {
                REPX(REP_ATTN, { for (int L = cb; L < 1024; L += G) { const int i = L >> 8, c = L & 255; const int qt = (i & 1) ? (24 - 8 * i + (c >> 5)) : (31 - 8 * i - (c >> 5)); const int bh = c & 31;
                    attn_unit(wv, lds, bh >> 3, bh & 7, qt); } })
                REPX(REP_MLSTM, { mlstm_scan(wv); })
                SEAM(pb + 2);
            }
            if (IN(pb + 3)) { REPX(REP_HNORM, { for (int u = cb; u < 1024; u += G) mlstm_out_unit(wv, lds, eo, u >> 8, (u >> 6) & 3, u & 63); SEAMR(); }) }
        } else {
            if (IN(pb + 0)) { REPX(REP_OPREP, { odd_prep(wv, eo); SEAMR(); }) }
            if (IN(pb + 1)) {
                const ArgsP ap = get_args(); unsigned char* ws = ap->ws;
                { pg8::Gemm g{(const bf16*)(ws + WS_XRKV), (const bf16*)(ws + WS_WRKV) + (size_t)eo * 3 * 2048 * 2048, 2048, 2048, 2048};
                  RkvOrder S; S.in.init(T_, 2048, G, cb); S.G = G; S.c = cb;
                  pg8::EpiBf16 E{(bf16*)(ws + WS_RKV), 2048, 64, 8, (size_t)T_ * 2048, (eo == 0) ? (bf16*)(ws + WS_VF) : nullptr};
                  REPX(REP_RKV, { pg8::gemm_phase<pg8::EpiBf16, RkvOrder, true, false>(wv, lds, g, S, E); __syncthreads(); }) }
                __syncthreads();
                { pg8::Gemm g{(const bf16*)(ws + WS_XC), (const bf16*)(ws + WS_WL1) + (size_t)eo * 512 * 4096, 4096, 4096, 4096};
                  pg8::StaticOrder S; S.init(T_, 512, G, cb);
                  pg8::EpiL1 E{(bf16*)(ws + WS_L1)};
                  pg8::gemm_phase<pg8::EpiL1, pg8::StaticOrder, true, false>(wv, lds, g, S, E); }
                SEAM(pb + 1);
            }
            if (IN(pb + 2)) {
                const ArgsP ap = get_args(); unsigned char* ws = ap->ws;
                pg8::Gemm g{(const bf16*)(ws + WS_L1), (const bf16*)(ws + WS_WL2) + (size_t)eo * 8192 * 256, 256, 512, 256};
                L2Order S{(eo == 0 ? 24 : 32) * 64, G, cb};
                pg8::EpiL2 E{(bf16*)(ws + WS_G), (bf16*)(ws + WS_WD), (bf16*)(ws + WS_AA), (bf16*)(ws + WS_RKV) + (size_t)2 * T_ * 2048, (const bf16*)(ws + WS_VF),
                             ap->in[12] + (size_t)eo * 2048, ap->in[15] + (size_t)eo * 2048, ap->in[25]};
                pg8::gemm_phase<pg8::EpiL2, L2Order, true, false>(wv, lds, g, S, E);
                SEAM(pb + 2);
            }
            if (IN(pb + 3)) { REPX(REP_RWKV, { for (int u = cb; u < 128; u += G) rwkv_unit(wv, lds, eo, u >> 5, u & 31); SEAMR(); }) }
        }
        if (IN(pb + 4)) {
            const bool ev = (l & 1) == 0; const ArgsP ap = get_args(); unsigned char* ws = ap->ws;
            pg8::Gemm g{(const bf16*)(ws + (ev ? WS_YE : WS_YO)), (const bf16*)(ws + (ev ? WS_WOUT : WS_WO)) + (size_t)eo * 2048 * 2048, 2048, 2048, 2048};
            pg8::StaticOrder S; S.init(T_, 2048, G, cb);
            pg8::EpiResid E{ap->out, 2048, DN_ALPHA};
            pg8::gemm_phase<pg8::EpiResid, pg8::StaticOrder, true, false>(wv, lds, g, S, E);
            SEAM(pb + 4);
        }
        if (IN(pb + 5)) { ln_router(wv, l); SEAM(pb + 5); }
        if (IN(pb + 6)) { const MoeTab tb = moe_tables(wv, l, lds); REPX(REP_GATHER, { moe_gather(wv, tb); SEAMR(); }) }
        if (IN(pb + 7)) { const MoeTab tb = moe_tables(wv, l, lds); const ArgsP ap = get_args(); unsigned char* ws = ap->ws;
            pg8::Gemm g{(const bf16*)(ws + WS_XS), (const bf16*)(ws + WS_WGU) + (size_t)l * 32 * 1024 * 2048, 2048, 2048, 2048};
            MoeOrder<4> S{tb.tileE, *tb.ntiles * 4, G, cb};
            pg8::EpiSilu E{(bf16*)(ws + WS_HID)};
            REPX(REP_GU, { pg8::gemm_phase<pg8::EpiSilu, MoeOrder<4>, true, false>(wv, lds, g, S, E); SEAMR(); })
        }
        if (IN(pb + 8)) { const MoeTab tb = moe_tables(wv, l, lds); const ArgsP ap = get_args(); unsigned char* ws = ap->ws;
            pg8::Gemm g{(const bf16*)(ws + WS_HID), (const bf16*)(ws + WS_WDN) + (size_t)l * 32 * 2048 * 512, 512, 512, 512};
            MoeOrder<8> S{tb.tileE, *tb.ntiles * 8, G, cb};
            pg8::EpiBf16 E{(bf16*)(ws + WS_YS), 2048, 0, 8, 0, nullptr};
            REPX(REP_DN, { pg8::gemm_phase<pg8::EpiBf16, MoeOrder<8>, true, false>(wv, lds, g, S, E); SEAMR(); })
        }
        if (IN(pb + 9)) { moe_combine_ln(wv, l); SEAM(pb + 9); }
        };
    layer(std::integral_constant<int, 0>{}); layer(std::integral_constant<int, 1>{}); layer(std::integral_constant<int, 2>{}); layer(std::integral_constant<int, 3>{});
#undef IN
#undef SEAM
}

extern "C" void kernel_launch(void* const* d_in, const int* in_sizes, int n_in, void* d_out, int out_size, void* d_ws, size_t ws_size, hipStream_t stream) {
    static int grid = 0;
    if (grid == 0) {
        if (n_in != 39 || in_sizes[0] != T_ * D_ || out_size != T_ * D_ || ws_size < WS_END) {
            fprintf(stderr, "kernel_launch: unexpected problem: n_in %d in0 %d out %d ws %zu (need %zu)\n", n_in, n_in > 0 ? in_sizes[0] : -1, out_size, ws_size, (size_t)WS_END); grid = -1; return; }
        int dev = 0, cus = 0, per_cu = 0;
        if (hipGetDevice(&dev) != hipSuccess || hipDeviceGetAttribute(&cus, hipDeviceAttributeMultiprocessorCount, dev) != hipSuccess) { fprintf(stderr, "kernel_launch: device query failed\n"); grid = -1; return; }
        if (hipFuncSetAttribute((const void*)fwd, hipFuncAttributeMaxDynamicSharedMemorySize, LDS_BYTES) != hipSuccess) { fprintf(stderr, "kernel_launch: hipFuncSetAttribute failed\n"); grid = -1; return; }
        if (hipOccupancyMaxActiveBlocksPerMultiprocessor(&per_cu, (const void*)fwd, NTHR, LDS_BYTES) != hipSuccess || per_cu < 1)
            fprintf(stderr, "kernel_launch: note: occupancy query reports %d workgroups per CU\n", per_cu);
        (void)hipGetLastError();
        grid = cus;
    }
    if (grid < 0) return;
    if (hipMemsetAsync((char*)d_ws + WS_CTL, 0, CTL_ZERO_BYTES, stream) != hipSuccess) { fprintf(stderr, "kernel_launch: memset failed\n"); return; }
    Args a{};
    for (int i = 0; i < 39; ++i) a.in[i] = (const float*)d_in[i];
    a.out = (float*)d_out; a.ws = (unsigned char*)d_ws;
#if ONE_LAUNCH
    a.ph_lo = 0; a.ph_hi = N_PHASES;
    hipLaunchKernelGGL(fwd, dim3(grid), dim3(NTHR), LDS_BYTES, stream, a);
#else
    for (int p = 0; p < N_PHASES; ++p) { a.ph_lo = p; a.ph_hi = p + 1; hipLaunchKernelGGL(fwd, dim3(grid), dim3(NTHR), LDS_BYTES, stream, a); }
#endif
    const hipError_t le = hipPeekAtLastError();
    if (le != hipSuccess) fprintf(stderr, "kernel_launch: launch failed: %s\n", hipGetErrorName(le));
}
```

```cpp
#include <hip/hip_runtime.h>
#include <cstdio>
#include <cstdint>
#include <type_traits>

#ifndef ONE_LAUNCH
#define ONE_LAUNCH 1
#endif

#define LAS __attribute__((address_space(3)))
typedef unsigned short bf16;
typedef unsigned v4u __attribute__((ext_vector_type(4)));
typedef unsigned v2u __attribute__((ext_vector_type(2)));
typedef float f32x4 __attribute__((ext_vector_type(4)));
typedef float f32x2 __attribute__((ext_vector_type(2)));
typedef short bf16x8 __attribute__((ext_vector_type(8)));

__device__ __forceinline__ unsigned f2bf(float f) { unsigned u = __builtin_bit_cast(unsigned, f); return (u + 0x7fffu + ((u >> 16) & 1u)) >> 16; }
typedef __bf16 bf16x2_t __attribute__((ext_vector_type(2)));
__device__ __forceinline__ unsigned pk2(float lo, float hi) { const f32x2 v = {lo, hi}; return __builtin_bit_cast(unsigned, __builtin_convertvector(v, bf16x2_t)); }
__device__ __forceinline__ float bflo(unsigned w) { return __builtin_bit_cast(float, w << 16); }
__device__ __forceinline__ float bfhi(unsigned w) { return __builtin_bit_cast(float, w & 0xffff0000u); }
__device__ __forceinline__ float bf2f(bf16 h) { return __builtin_bit_cast(float, (unsigned)h << 16); }
__device__ __forceinline__ float sigmoidf_(float x) { return 1.f / (1.f + __expf(-x)); }
__device__ __forceinline__ float wave_sum(float v) {
#pragma unroll
    for (int o = 1; o < 64; o <<= 1) v += __shfl_xor(v, o);
    return v;
}
template <int CTRL> __device__ __forceinline__ float dppf(float x) { return __builtin_bit_cast(float, __builtin_amdgcn_mov_dpp(__builtin_bit_cast(int, x), CTRL, 0xf, 0xf, true)); }
__device__ __forceinline__ float red16(float x) { x += dppf<0xB1>(x); x += dppf<0x4E>(x); x += dppf<0x141>(x); x += dppf<0x128>(x); return x; }
__device__ __forceinline__ float max16(float x) { x = fmaxf(x, dppf<0xB1>(x)); x = fmaxf(x, dppf<0x4E>(x)); x = fmaxf(x, dppf<0x141>(x)); x = fmaxf(x, dppf<0x128>(x)); return x; }

__device__ __forceinline__ int lane_id_asm() { int l; asm volatile("v_mbcnt_lo_u32_b32 %0, -1, 0\n\tv_mbcnt_hi_u32_b32 %0, -1, %0" : "=v"(l)); return l; }
#define OPAQUE_TID() const int tid = wv * 64 + lane_id_asm()
typedef short v4i16_t __attribute__((ext_vector_type(4)));
__device__ __forceinline__ v2u tr_read(const LAS unsigned char* p) { return __builtin_bit_cast(v2u, __builtin_amdgcn_ds_read_tr16_b64_v4i16((LAS v4i16_t*)p)); }
#define LDS_WAIT() asm volatile("s_waitcnt lgkmcnt(0)" ::: "memory")
#define VM_WAIT() asm volatile("s_waitcnt vmcnt(0)" ::: "memory")

namespace pg8 {
#define PG8_LAS __attribute__((address_space(3)))
typedef unsigned short bf16_t;
typedef short bf16x8 __attribute__((ext_vector_type(8)));
typedef float f32x4 __attribute__((ext_vector_type(4)));
typedef unsigned u32x4 __attribute__((ext_vector_type(4)));
constexpr int BM = 256, BK = 64, HALF = 128, HTB = HALF * BK * 2  , STAGE_BYTES = 8 * HTB, NXCD = 8, WGM = 8;

__host__ __device__ __forceinline__ int lds_byte(int r, int c) { const int st = (r >> 4) * 2 + (c >> 5), rr = r & 15, cc = c & 31, ob = rr * 64 + cc * 2; return st * 1024 + (ob ^ (((ob >> 9) & 1) << 5)); }
__host__ __device__ __forceinline__ void stage_rc(int b, int& R, int& C) { const int st = b / 1024, sb = b % 1024, swz = sb ^ (((sb >> 9) & 1) << 5); R = (st >> 1) * 16 + swz / 64; C = (st & 1) * 32 + (swz % 64) / 2; }
__host__ __device__ __forceinline__ int perm32(int rho) { const int n = rho >> 4, i = rho & 15; return 8 * (i >> 2) + 4 * n + (i & 3); }

struct Unit { int pm, pn, aoff; };
struct Gemm { const bf16_t* A; const bf16_t* Bt; int K, lda, ldb; };

struct StaticOrder {
    int nM, nN, nwg, G, c;
    __device__ void init(int M, int N, int G_, int c_) { nM = M / BM; nN = N / BM; nwg = nM * nN; G = G_; c = c_; }
    __device__ bool next(int i, Unit& u) const { return at((long)i * G + c, u); }
    __device__ bool at(long L, Unit& u) const {
        if (L >= nwg) return false;
        int wgid = (int)L; { const int q = nwg / NXCD, r = nwg % NXCD, xcd = wgid % NXCD, off = wgid / NXCD; wgid = (xcd < r ? xcd * (q + 1) : r * (q + 1) + (xcd - r) * q) + off; }
        const int nig = WGM * nN, gid = wgid / nig, fm = gid * WGM, gsz = (nM - fm) < WGM ? (nM - fm) : WGM;
        u.pm = fm + ((wgid % nig) % gsz); u.pn = (wgid % nig) / gsz; u.aoff = 0; return true;
    }
    __device__ __forceinline__ void a_ready(const Unit&) const {}
    __device__ __forceinline__ void done(const Unit&) const {}
};

__device__ __forceinline__ unsigned cvt_pk_bf16(float lo, float hi) { unsigned r; asm volatile("v_cvt_pk_bf16_f32 %0, %1, %2" : "=v"(r) : "v"(lo), "v"(hi)); return r; }

struct EpiBf16 {
    static constexpr bool PERM = true, AFTER_DRAIN = false;
    bf16_t* O; int ldc; int pm_mod, pn_mod; size_t gstride; bf16_t* O2;
    __device__ __forceinline__ void operator()(const f32x4 (&acc)[2][2][4][2], const Unit& u, int wr, int wc, int fr, int fq) const {
        const int g = pm_mod ? u.pm / pm_mod : 0;
        const int row0 = (u.pm - g * pm_mod) * BM + wr * 64 + fr;
        const int col0 = (pn_mod ? (u.pn % pn_mod) : u.pn) * BM + wc * 32 + 8 * fq;
        bf16_t* base = O + (size_t)g * gstride;
        bf16_t* base2 = (O2 && g == 2) ? O2 : nullptr;
#pragma unroll
        for (int ai = 0; ai < 2; ++ai)
#pragma unroll
            for (int m = 0; m < 4; ++m) { const size_t ro = (size_t)(row0 + ai * HALF + m * 16) * ldc + col0;
#pragma unroll
                for (int bj = 0; bj < 2; ++bj) { const f32x4 v0 = acc[ai][bj][m][0], v1 = acc[ai][bj][m][1];
                    u32x4 w; w.x = cvt_pk_bf16(v0[0], v0[1]); w.y = cvt_pk_bf16(v0[2], v0[3]); w.z = cvt_pk_bf16(v1[0], v1[1]); w.w = cvt_pk_bf16(v1[2], v1[3]);
                    *(u32x4*)(base + ro + bj * HALF) = w; if (base2) *(u32x4*)(base2 + ro + bj * HALF) = w; } }
    }
};
struct EpiResid {
    static constexpr bool PERM = true, AFTER_DRAIN = false;
    float* X; int ldc; float alpha;
    __device__ __forceinline__ void operator()(const f32x4 (&acc)[2][2][4][2], const Unit& u, int wr, int wc, int fr, int fq) const {
        const int row0 = u.pm * BM + wr * 64 + fr, col0 = u.pn * BM + wc * 32 + 8 * fq;
#pragma unroll
        for (int ai = 0; ai < 2; ++ai)
#pragma unroll
            for (int m = 0; m < 4; ++m) { float* rowp = X + (size_t)(row0 + ai * HALF + m * 16) * ldc + col0;
#pragma unroll
                for (int bj = 0; bj < 2; ++bj) { f32x4* p = (f32x4*)(rowp + bj * HALF); const f32x4 x0 = p[0], x1 = p[1];
                    p[0] = x0 * alpha + acc[ai][bj][m][0]; p[1] = x1 * alpha + acc[ai][bj][m][1]; } }
    }
};
struct EpiSilu {
    static constexpr bool PERM = true, AFTER_DRAIN = false;
    bf16_t* O;
    __device__ __forceinline__ void operator()(const f32x4 (&acc)[2][2][4][2], const Unit& u, int wr, int wc, int fr, int fq) const {
        const int row0 = u.pm * BM + wr * 64 + fr, col0 = (u.pn & 3) * 128 + wc * 32 + 8 * fq;
#pragma unroll
        for (int ai = 0; ai < 2; ++ai)
#pragma unroll
            for (int m = 0; m < 4; ++m) { bf16_t* rowp = O + (size_t)(row0 + ai * HALF + m * 16) * 512 + col0;
                float h[8];
#pragma unroll
                for (int n = 0; n < 2; ++n)
#pragma unroll
                    for (int e = 0; e < 4; ++e) { const float gt = acc[ai][0][m][n][e], up = acc[ai][1][m][n][e]; h[n * 4 + e] = gt / (1.f + __expf(-gt)) * up; }
                u32x4 w; w.x = cvt_pk_bf16(h[0], h[1]); w.y = cvt_pk_bf16(h[2], h[3]); w.z = cvt_pk_bf16(h[4], h[5]); w.w = cvt_pk_bf16(h[6], h[7]);
                *(u32x4*)rowp = w; }
    }
};
struct EpiL1 {
    static constexpr bool PERM = true, AFTER_DRAIN = false;
    bf16_t* O;
    __device__ __forceinline__ void operator()(const f32x4 (&acc)[2][2][4][2], const Unit& u, int wr, int wc, int fr, int fq) const {
        const int row0 = u.pm * BM + wr * 64 + fr, col0 = u.pn * BM + wc * 32 + 8 * fq;
#pragma unroll
        for (int ai = 0; ai < 2; ++ai)
#pragma unroll
            for (int m = 0; m < 4; ++m) { bf16_t* rowp = O + (size_t)(row0 + ai * HALF + m * 16) * 512 + col0;
#pragma unroll
                for (int bj = 0; bj < 2; ++bj) { const int c = col0 + bj * HALF; float h[8];
#pragma unroll
                    for (int n = 0; n < 2; ++n)
#pragma unroll
                        for (int e = 0; e < 4; ++e) { const float v = acc[ai][bj][m][n][e];
                            h[n * 4 + e] = (c < 256) ? 1.f / (1.f + __expf(-v)) : ((c < 352) ? (1.f - 2.f / (1.f + __expf(2.f * v))) : v); }
                    u32x4 w; w.x = cvt_pk_bf16(h[0], h[1]); w.y = cvt_pk_bf16(h[2], h[3]); w.z = cvt_pk_bf16(h[4], h[5]); w.w = cvt_pk_bf16(h[6], h[7]);
                    *(u32x4*)(rowp + bj * HALF) = w; } }
    }
};
template <int KIND> __device__ __forceinline__ void epi_l2(const f32x4 (&acc)[2][2][4][2], bf16_t* O, const bf16_t* VF, const float* pv, int row0, int col0) {
    float pr[2][8];
#pragma unroll
    for (int bj = 0; bj < 2; ++bj)
#pragma unroll
        for (int j = 0; j < 8; ++j) pr[bj][j] = (KIND == 0) ? 0.f : pv[col0 + bj * HALF + j];
#pragma unroll
    for (int ai = 0; ai < 2; ++ai)
#pragma unroll
        for (int m = 0; m < 4; ++m) { const size_t ro = (size_t)(row0 + ai * HALF + m * 16) * 2048 + col0;
#pragma unroll
            for (int bj = 0; bj < 2; ++bj) { float h[8];
#pragma unroll
                for (int n = 0; n < 2; ++n)
#pragma unroll
                    for (int e = 0; e < 4; ++e) h[n * 4 + e] = acc[ai][bj][m][n][e] + pr[bj][n * 4 + e];
                if (KIND == 1) {
#pragma unroll
                    for (int j = 0; j < 8; ++j) { const float x = -h[j]; const float sp = fmaxf(x, 0.f) + __logf(1.f + __expf(-fabsf(x))); h[j] = -__expf(-sp - 0.5f); }
                } else if (KIND == 2) {
#pragma unroll
                    for (int j = 0; j < 8; ++j) h[j] = 1.f / (1.f + __expf(-h[j]));
                } else if (KIND == 3) {
                    const u32x4 vv = *(const u32x4*)(O + ro + bj * HALF), vf = *(const u32x4*)(VF + ro + bj * HALF);
#pragma unroll
                    for (int j = 0; j < 4; ++j) { const unsigned a = vv[j], b = vf[j];
                        const float v0_ = __builtin_bit_cast(float, a << 16), v1_ = __builtin_bit_cast(float, a & 0xffff0000u);
                        const float f0_ = __builtin_bit_cast(float, b << 16), f1_ = __builtin_bit_cast(float, b & 0xffff0000u);
                        h[2 * j] = v0_ + (f0_ - v0_) / (1.f + __expf(-h[2 * j])); h[2 * j + 1] = v1_ + (f1_ - v1_) / (1.f + __expf(-h[2 * j + 1])); }
                }
                u32x4 w; w.x = cvt_pk_bf16(h[0], h[1]); w.y = cvt_pk_bf16(h[2], h[3]); w.z = cvt_pk_bf16(h[4], h[5]); w.w = cvt_pk_bf16(h[6], h[7]);
                *(u32x4*)(O + ro + bj * HALF) = w; } }
}
struct EpiL2 {
    static constexpr bool PERM = true, AFTER_DRAIN = false;
    bf16_t *G, *WD, *AA, *V; const bf16_t* VF; const float *w0, *a0, *v0;
    __device__ __forceinline__ void operator()(const f32x4 (&acc)[2][2][4][2], const Unit& u, int wr, int wc, int fr, int fq) const {
        const int kind = u.pn >> 3;
        const int row0 = u.pm * BM + wr * 64 + fr, col0 = (u.pn & 7) * BM + wc * 32 + 8 * fq;
        if (kind == 0) epi_l2<0>(acc, G, nullptr, nullptr, row0, col0);
        else if (kind == 1) epi_l2<1>(acc, WD, nullptr, w0, row0, col0);
        else if (kind == 2) epi_l2<2>(acc, AA, nullptr, a0, row0, col0);
        else epi_l2<3>(acc, V, VF, v0, row0, col0);
    }
};

template <class Epi, class Sched, bool ALIGN_EPI = false, bool SP2 = false>
__device__ __forceinline__ void gemm_phase(const int wv, PG8_LAS unsigned char* lds, const Gemm g, const Sched& S, const Epi& E) {
#ifdef NO_GEMM
    return;
#endif
    const int tid_o = wv * 64 + lane_id_asm();
    const int tid = tid_o, wid = __builtin_amdgcn_readfirstlane(tid >> 6), lane = tid & 63, wr = wid >> 2, wc = wid & 3, fr = lane & 15, fq = lane >> 4;
    const int K = g.K, nt = K / BK;
    unsigned voffA[2], voffB[2];
#pragma unroll
    for (int i = 0; i < 2; ++i) { int R, C; stage_rc(tid * 16 + i * 8192, R, C); const int Rb = Epi::PERM ? ((R & ~31) + perm32(R & 31)) : R;
        voffA[i] = (unsigned)(R * g.lda + C) * 2u; voffB[i] = (unsigned)(Rb * g.ldb + C) * 2u; }
    const size_t kstep = (size_t)(BK * 2);
    const size_t hstepA = (size_t)HALF * g.lda * 2, hstepB = (size_t)HALF * g.ldb * 2;
    const size_t tstepA = 2 * hstepA, tstepB = 2 * hstepB;
    const unsigned ldsw = (unsigned)wid * 1024u;
    const int aoff = lds_byte(wr * 64 + fr, fq * 8), boff = lds_byte(wc * 32 + fr, fq * 8);
#define PG8_SA(b, h) (((b) * 2 + (h)) * HTB)
#define PG8_SB(b, h) ((4 + (b) * 2 + (h)) * HTB)
#define PG8_STAGE(bufoff, gbase, voff) do { _Pragma("unroll") for (int _i = 0; _i < 2; ++_i) \
        __builtin_amdgcn_global_load_lds((const unsigned*)((const char*)(gbase) + (voff)[_i]), (PG8_LAS unsigned*)(lds + (bufoff) + ldsw + _i * 8192), 16, 0, 0); } while (0)
#define PG8_LDA(dst, b, h) do { _Pragma("unroll") for (int m = 0; m < 4; ++m) _Pragma("unroll") for (int k = 0; k < 2; ++k) dst[m][k] = *(const PG8_LAS bf16x8*)(lds + PG8_SA(b, h) + aoff + m * 2048 + k * 1024); } while (0)
#define PG8_LDB(dst, b, h) do { _Pragma("unroll") for (int n = 0; n < 2; ++n) _Pragma("unroll") for (int k = 0; k < 2; ++k) dst[n][k] = *(const PG8_LAS bf16x8*)(lds + PG8_SB(b, h) + boff + n * 2048 + k * 1024); } while (0)
#define PG8_MMA(ai, bj, At, Bt) do { __builtin_amdgcn_s_setprio(1); _Pragma("unroll") for (int m = 0; m < 4; ++m) _Pragma("unroll") for (int n = 0; n < 2; ++n) _Pragma("unroll") for (int k = 0; k < 2; ++k) \
        acc[ai][bj][m][n] = __builtin_amdgcn_mfma_f32_16x16x32_bf16(Bt[n][k], At[m][k], acc[ai][bj][m][n], 0, 0, 0); __builtin_amdgcn_s_setprio(0); } while (0)
#define PG8_WAIT_V(n) asm volatile("s_waitcnt vmcnt(" #n ")" ::: "memory")
#define PG8_WAIT_L(n) asm volatile("s_waitcnt lgkmcnt(" #n ")" ::: "memory")
#define PG8_BAR __builtin_amdgcn_s_barrier()
#define PG8_SCHED __builtin_amdgcn_sched_barrier(0)
    Unit cur, nxt; int ui = 0;
    if (!S.next(0, cur)) return;
    f32x4 acc[2][2][4][2];
#pragma unroll
    for (int a = 0; a < 2; ++a)
#pragma unroll
        for (int b = 0; b < 2; ++b)
#pragma unroll
            for (int m = 0; m < 4; ++m)
#pragma unroll
                for (int n = 0; n < 2; ++n) acc[a][b][m][n] = (f32x4){0.f, 0.f, 0.f, 0.f};
    bf16x8 At[4][2], B0[2][2], B1[2][2];
    const char* cA = (const char*)g.A + (size_t)cur.pm * tstepA + cur.aoff; const char* cB = (const char*)g.Bt + (size_t)cur.pn * tstepB;
    S.a_ready(cur);
    if constexpr (SP2) {
        PG8_STAGE(PG8_SB(0, 0), cB, voffB); PG8_STAGE(PG8_SB(0, 1), cB + hstepB, voffB); PG8_STAGE(PG8_SA(0, 0), cA, voffA); PG8_STAGE(PG8_SA(0, 1), cA + hstepA, voffA);
        if (wr == 1) PG8_BAR;
        PG8_WAIT_V(2); PG8_BAR;
        PG8_STAGE(PG8_SB(1, 0), cB + kstep, voffB); PG8_STAGE(PG8_SA(1, 0), cA + kstep, voffA); PG8_STAGE(PG8_SB(1, 1), cB + hstepB + kstep, voffB);
        PG8_WAIT_V(6); PG8_BAR;
    } else {
        PG8_STAGE(PG8_SB(0, 0), cB, voffB); PG8_STAGE(PG8_SA(0, 0), cA, voffA); PG8_STAGE(PG8_SB(0, 1), cB + hstepB, voffB); PG8_STAGE(PG8_SA(0, 1), cA + hstepA, voffA);
        if (wr == 1) PG8_BAR;
        PG8_WAIT_V(4); PG8_BAR;
        PG8_STAGE(PG8_SB(1, 0), cB + kstep, voffB); PG8_STAGE(PG8_SA(1, 0), cA + kstep, voffA); PG8_STAGE(PG8_SB(1, 1), cB + hstepB + kstep, voffB);
        PG8_WAIT_V(6); PG8_BAR;
    }
    for (;;) {
        const bool has_next = S.next(ui + 1, nxt);
        const char* nA = has_next ? (const char*)g.A + (size_t)nxt.pm * tstepA + nxt.aoff : cA; const char* nB = has_next ? (const char*)g.Bt + (size_t)nxt.pn * tstepB : cB;
        for (int t = 0; t < nt; t += 2) {
            const bool last = (t == nt - 2);
            const char* a1 = cA + (size_t)(t + 1) * kstep;
            const char* a2 = last ? nA : cA + (size_t)(t + 2) * kstep; const char* b2 = last ? nB : cB + (size_t)(t + 2) * kstep;
            const char* a3 = a2 + kstep; const char* b3 = b2 + kstep;
            if (last && has_next) S.a_ready(nxt);
            if constexpr (SP2) {
            PG8_LDB(B0, 0, 0); PG8_LDB(B1, 0, 1); PG8_SCHED; PG8_LDA(At, 0, 0); PG8_STAGE(PG8_SA(1, 1), a1 + hstepA, voffA);
            PG8_WAIT_V(8); PG8_WAIT_L(0); PG8_BAR; PG8_MMA(0, 0, At, B0); PG8_MMA(0, 1, At, B1); PG8_BAR; PG8_SCHED;
            PG8_LDA(At, 0, 1); PG8_STAGE(PG8_SB(0, 0), b2, voffB); PG8_STAGE(PG8_SB(0, 1), b2 + hstepB, voffB); PG8_STAGE(PG8_SA(0, 0), a2, voffA);
            PG8_WAIT_V(8); PG8_WAIT_L(0); PG8_BAR; PG8_MMA(1, 0, At, B0); PG8_MMA(1, 1, At, B1); PG8_BAR; PG8_SCHED;
            PG8_LDB(B0, 1, 0); PG8_LDB(B1, 1, 1); PG8_SCHED; PG8_LDA(At, 1, 0); PG8_STAGE(PG8_SA(0, 1), a2 + hstepA, voffA);
            PG8_WAIT_V(8); PG8_WAIT_L(0); PG8_BAR; PG8_MMA(0, 0, At, B0); PG8_MMA(0, 1, At, B1); PG8_BAR; PG8_SCHED;
            PG8_LDA(At, 1, 1); PG8_STAGE(PG8_SB(1, 0), b3, voffB); PG8_STAGE(PG8_SB(1, 1), b3 + hstepB, voffB); PG8_STAGE(PG8_SA(1, 0), a3, voffA);
            PG8_WAIT_V(8); PG8_WAIT_L(0); PG8_BAR; PG8_MMA(1, 0, At, B0); PG8_MMA(1, 1, At, B1); PG8_BAR; PG8_SCHED;
            } else {
            PG8_LDB(B0, 0, 0); PG8_SCHED; PG8_LDA(At, 0, 0); PG8_STAGE(PG8_SA(1, 1), a1 + hstepA, voffA);
            PG8_WAIT_L(8); PG8_BAR; PG8_WAIT_L(0); PG8_MMA(0, 0, At, B0); PG8_BAR; PG8_SCHED;
            PG8_LDB(B1, 0, 1); PG8_STAGE(PG8_SB(0, 0), b2, voffB);
            PG8_BAR; PG8_WAIT_L(0); PG8_MMA(0, 1, At, B1); PG8_BAR;
            PG8_LDA(At, 0, 1); PG8_STAGE(PG8_SA(0, 0), a2, voffA);
            PG8_BAR; PG8_WAIT_L(0); PG8_MMA(1, 0, At, B0); PG8_BAR; PG8_SCHED;
            PG8_STAGE(PG8_SB(0, 1), b2 + hstepB, voffB);
            PG8_WAIT_V(6); PG8_BAR; PG8_MMA(1, 1, At, B1); PG8_BAR;
            PG8_LDB(B0, 1, 0); PG8_SCHED; PG8_LDA(At, 1, 0); PG8_STAGE(PG8_SA(0, 1), a2 + hstepA, voffA);
            PG8_WAIT_L(8); PG8_BAR; PG8_WAIT_L(0); PG8_MMA(0, 0, At, B0); PG8_BAR; PG8_SCHED;
            PG8_LDB(B1, 1, 1); PG8_STAGE(PG8_SB(1, 0), b3, voffB);
            PG8_BAR; PG8_WAIT_L(0); PG8_MMA(0, 1, At, B1); PG8_BAR;
            PG8_LDA(At, 1, 1); PG8_STAGE(PG8_SA(1, 0), a3, voffA);
            PG8_BAR; PG8_WAIT_L(0); PG8_MMA(1, 0, At, B0); PG8_BAR; PG8_SCHED;
            PG8_STAGE(PG8_SB(1, 1), b3 + hstepB, voffB);
            PG8_WAIT_V(6); PG8_BAR; PG8_MMA(1, 1, At, B1); PG8_BAR;
            }
        }
        if constexpr (ALIGN_EPI) { if (wr == 0) PG8_BAR; }
        if constexpr (!Epi::AFTER_DRAIN) { E(acc, cur, wr, wc, fr, fq); S.done(cur); }
        if (!has_next) break;
#pragma unroll
        for (int a = 0; a < 2; ++a)
#pragma unroll
            for (int b = 0; b < 2; ++b)
#pragma unroll
                for (int m = 0; m < 4; ++m)
#pragma unroll
                    for (int n = 0; n < 2; ++n) acc[a][b][m][n] = (f32x4){0.f, 0.f, 0.f, 0.f};
        cur = nxt; cA = nA; cB = nB; ++ui;
        if constexpr (ALIGN_EPI) { if (wr == 1) PG8_BAR; }
    }
    PG8_WAIT_V(0);
    if constexpr (!ALIGN_EPI) { if (wr == 0) PG8_BAR; }
    PG8_BAR;
    if constexpr (Epi::AFTER_DRAIN) { E.fused(acc, cur, wr, wc, fr, fq, lds, wid, lane); S.done(cur); }
#undef PG8_SA
#undef PG8_SB
#undef PG8_STAGE
#undef PG8_LDA
#undef PG8_LDB
#undef PG8_MMA
#undef PG8_WAIT_V
#undef PG8_WAIT_L
#undef PG8_BAR
#undef PG8_SCHED
}
}

#define XB_TMO      128
#define XB_XCNT(j)  (256  + 64 * (j))
#define XB_XSUB(j)  (1280 + 64 * (j))
#define XB_XGEN(j)  (2304 + 64 * (j))
#define XB_TOP      3328
#define XB_TOPGEN   3392
#define XCD_BAR_WORDS 3456
#define XB_SPIN_CAP (1u << 18)

__device__ __forceinline__ unsigned xb_ld(unsigned* p)              { return __hip_atomic_load(p, __ATOMIC_RELAXED, __HIP_MEMORY_SCOPE_AGENT); }
__device__ __forceinline__ unsigned xb_add(unsigned* p, unsigned v) { return __hip_atomic_fetch_add(p, v, __ATOMIC_RELAXED, __HIP_MEMORY_SCOPE_AGENT); }
__device__ __forceinline__ unsigned xb_xcc_id() { return (unsigned)__builtin_amdgcn_s_getreg((3 << 11) | 20) & 0xFu; }
#define XB_SPIN(cond, bar) do { unsigned _sp = 0; while (cond) { __builtin_amdgcn_s_sleep(1); \
    if ((++_sp & 255u) == 0u) { if (xb_ld(&(bar)[XB_TMO])) break; if (_sp > XB_SPIN_CAP) { atomicAdd(&(bar)[XB_TMO], 1u); break; } } } } while (0)

struct XcdBarrier {
    unsigned* bar; unsigned x;
    volatile LAS unsigned* st;
};

__device__ __forceinline__ XcdBarrier xcd_barrier_post(unsigned* bar, volatile LAS unsigned* st, const bool t0) {
    XcdBarrier b; b.bar = bar; b.x = xb_xcc_id(); b.st = st;
    if (t0) (void)xb_add(&bar[XB_XCNT(b.x)], 1u);
    return b;
}
__device__ __forceinline__ void xcd_barrier_complete(unsigned* bar, unsigned x, unsigned& nloc, unsigned& nx) {
    const unsigned G = gridDim.x * gridDim.y * gridDim.z;
    unsigned sum, cnt, mine, sp = 0u;
    for (;;) {
        sum = 0u; cnt = 0u; mine = 0u;
#pragma unroll
        for (unsigned j = 0; j < 16; ++j) { const unsigned c = xb_ld(&bar[XB_XCNT(j)]); sum += c; cnt += (c > 0u) ? 1u : 0u; mine = (j == x) ? c : mine; }
        if (sum == G) break;
        __builtin_amdgcn_s_sleep(1);
        if ((++sp & 255u) == 0u) { if (xb_ld(&bar[XB_TMO])) break; if (sp > XB_SPIN_CAP) { atomicAdd(&bar[XB_TMO], 1u); break; } }
    }
    nloc = mine > 0u ? mine : 1u; nx = cnt > 0u ? cnt : 1u;
}

__device__ __forceinline__ void xcd_barrier(const XcdBarrier& b, const bool t0) {
    asm volatile("s_waitcnt vmcnt(0)" ::: "memory");
    __syncthreads();
    if (t0) {
        unsigned* bar = b.bar;
        __builtin_amdgcn_s_waitcnt(0);
        unsigned nloc = b.st[0], nx = b.st[1];
        if (nloc == 0u) { xcd_barrier_complete(bar, b.x, nloc, nx); b.st[0] = nloc; b.st[1] = nx; }
        const unsigned old = xb_add(&bar[XB_XSUB(b.x)], 1u);
        const unsigned gen = old / nloc;
        if (old + 1u == (gen + 1u) * nloc) {
            __builtin_amdgcn_fence(__ATOMIC_RELEASE, "agent");
            asm volatile("s_waitcnt vmcnt(0)" ::: "memory");
            const unsigned og = xb_add(&bar[XB_TOP], 1u);
            const unsigned tg = og / nx;
            if (og + 1u == (tg + 1u) * nx) xb_add(&bar[XB_TOPGEN], 1u);
            else XB_SPIN(xb_ld(&bar[XB_TOPGEN]) == tg, bar);
            __builtin_amdgcn_fence(__ATOMIC_ACQUIRE, "agent");
            xb_add(&bar[XB_XGEN(b.x)], 1u);
            asm volatile("s_waitcnt vmcnt(0)" ::: "memory");
        } else {
            XB_SPIN(xb_ld(&bar[XB_XGEN(b.x)]) == gen, bar);
            __builtin_amdgcn_fence(__ATOMIC_ACQUIRE, "agent");
            asm volatile("s_waitcnt vmcnt(0)" ::: "memory");
        }
    }
    __syncthreads();
}

constexpr int NWAVES = 8, NTHR = 512;
constexpr int NB = 4, SEQ = 4096, T_ = NB * SEQ, D_ = 2048;
constexpr int EVEN_IN = 7176, ZW = 7168;
constexpr float DN_ALPHA = 1.6817928305074290f;
constexpr float LN_EPS = 1e-5f;
constexpr int MOE_ROWS = 40960, MOE_TILES = MOE_ROWS / 256;

constexpr size_t MiB = 1u << 20;
constexpr size_t WS_CTL = 0, CTL_ZERO_BYTES = 1 * MiB;
constexpr size_t WS_IG = 1 * MiB, WS_FG = WS_IG + 256 * 1024, WS_KPART = 2 * MiB;
constexpr size_t WS_TOKE = 3 * MiB, WS_TOKR = WS_TOKE + 128 * 1024, WS_TOKG = WS_TOKR + 128 * 1024, WS_SLOT = WS_TOKG + 128 * 1024;
constexpr size_t WS_DN = 4 * MiB, WS_NP = 5 * MiB, WS_DEC = 6 * MiB, WS_BC = 6 * MiB + 65536;
constexpr size_t WS_WIN = 16 * MiB;
constexpr size_t WS_WOUT = 72 * MiB;
constexpr size_t WS_WRKV = 88 * MiB;
constexpr size_t WS_WO = 136 * MiB;
constexpr size_t WS_WL1 = 152 * MiB;
constexpr size_t WS_WL2 = 160 * MiB;
constexpr size_t WS_WGU = 168 * MiB;
constexpr size_t WS_WDN = 680 * MiB;
constexpr size_t WS_XB = 936 * MiB;
constexpr size_t WS_VF = 1000 * MiB;
constexpr size_t WS_R = 1064 * MiB;
constexpr size_t WS_Z = WS_R;
constexpr size_t WS_QKB = WS_R + 224 * MiB;
constexpr size_t WS_VAT = WS_R + 288 * MiB;
constexpr size_t WS_YE = WS_R + 320 * MiB;
constexpr size_t WS_DC = WS_R + 384 * MiB;
constexpr size_t WS_CP = WS_R + 512 * MiB;
constexpr size_t WS_XRKV = WS_R;
constexpr size_t WS_XC = WS_R + 192 * MiB;
constexpr size_t WS_RKV = WS_R + 320 * MiB;
constexpr size_t WS_L1 = WS_R + 512 * MiB;
constexpr size_t WS_G = WS_R + 528 * MiB;
constexpr size_t WS_WD = WS_R + 592 * MiB;
constexpr size_t WS_AA = WS_R + 656 * MiB;
constexpr size_t WS_YO = WS_R + 720 * MiB;
constexpr size_t WS_XS = WS_R;
constexpr size_t WS_HID = WS_R + 160 * MiB;
constexpr size_t WS_YS = WS_R + 200 * MiB;
constexpr size_t WS_END = WS_R + 784 * MiB;

constexpr int CW_BAR = 4096;
constexpr int CW_CNT = 16384;

constexpr int RING_BYTES = 131072;
constexpr int MISC_OFF = RING_BYTES;
constexpr int LDS_BYTES = 147456;

typedef unsigned gu32;

struct Args { const float* in[39]; float* out; unsigned char* ws; int ph_lo, ph_hi; };
#define CAS __attribute__((address_space(4)))
typedef const CAS Args* ArgsP;
__device__ __forceinline__ ArgsP get_args() { ArgsP p = (ArgsP)__builtin_amdgcn_kernarg_segment_ptr(); asm volatile("" : "+s"(p)); return p; }

__device__ __forceinline__ void tr_item(const float* W, int ldw, int k0, int n0, bf16* WT, int ldt, int drow0, int dcol0, LAS float* scr, int lane, const float* kscale) {
    const int r = lane >> 3, c4 = lane & 7;
    f32x4 v[8];
#pragma unroll
    for (int i = 0; i < 8; ++i) v[i] = __builtin_nontemporal_load((const f32x4*)(W + (size_t)(k0 + 8 * i + r) * ldw + n0 + 4 * c4));
    if (kscale) {
#pragma unroll
        for (int i = 0; i < 8; ++i) v[i] = v[i] * kscale[k0 + 8 * i + r]; }
#pragma unroll
    for (int i = 0; i < 8; ++i) { LAS float* d = scr + (8 * i + r) * 33 + 4 * c4; d[0] = v[i].x; d[1] = v[i].y; d[2] = v[i].z; d[3] = v[i].w; }
    LDS_WAIT(); asm volatile("" ::: "memory");
    const int c = lane & 7;
#pragma unroll
    for (int j = 0; j < 4; ++j) { const int n = (lane >> 3) + 8 * j; const LAS float* s = scr + (8 * c) * 33 + n;
        v4u o; o.x = pk2(s[0 * 33], s[1 * 33]); o.y = pk2(s[2 * 33], s[3 * 33]); o.z = pk2(s[4 * 33], s[5 * 33]); o.w = pk2(s[6 * 33], s[7 * 33]);
        *(v4u*)(WT + (size_t)(drow0 + n) * ldt + dcol0 + 8 * c) = o; }
    LDS_WAIT(); asm volatile("" ::: "memory");
}

__device__ __forceinline__ void prologue(const int wv, LAS unsigned char* lds) {
    const ArgsP a = get_args();
#ifdef NO_PROL
    return;
#endif
    OPAQUE_TID(); const int lane = tid & 63, wave = tid >> 6;
    unsigned char* ws = a->ws;
    LAS float* scr = (LAS float*)(lds + wave * 16384);
    const int gw = blockIdx.x * NWAVES + wave, NGW = gridDim.x * NWAVES;
    constexpr int I0 = 2 * 7168, I1 = 2 * 2048, I2 = 2 * 4 * 2048, I3 = 2 * 32 * 16, I4 = 4 * 32 * 1536;
    constexpr int NITEMS = I0 + I1 + I2 + I3 + I4;
    for (int it = gw; it < NITEMS; it += NGW) {
        int r = it;
        if (r < I0) { const int e = r / 7168, rr = r % 7168, kb = rr / 224, nb = rr % 224;
            tr_item(a->in[1] + (size_t)e * 2048 * EVEN_IN, EVEN_IN, 64 * kb, 32 * nb, (bf16*)(ws + WS_WIN) + (size_t)e * ZW * 2048, 2048, 32 * nb, 64 * kb, scr, lane, nullptr); continue; } r -= I0;
        if (r < I1) { const int e = r / 2048, rr = r % 2048, kb = rr / 64, nb = rr % 64;
            tr_item(a->in[6] + (size_t)e * 2048 * 2048, 2048, 64 * kb, 32 * nb, (bf16*)(ws + WS_WOUT) + (size_t)e * 2048 * 2048, 2048, 32 * nb, 64 * kb, scr, lane, nullptr); continue; } r -= I1;
        if (r < I2) { const int o = r / 8192, rr = r % 8192, mat = rr / 2048, q = rr % 2048, kb = q / 64, nb = q % 64;
            const float* src = (mat == 0 ? a->in[8] : mat == 1 ? a->in[9] : mat == 2 ? a->in[10] : a->in[11]) + (size_t)o * 2048 * 2048;
            bf16* dst = (mat < 3) ? (bf16*)(ws + WS_WRKV) + (size_t)o * 3 * 2048 * 2048 + (size_t)mat * 2048 * 2048 : (bf16*)(ws + WS_WO) + (size_t)o * 2048 * 2048;
            tr_item(src, 2048, 64 * kb, 32 * nb, dst, 2048, 32 * nb, 64 * kb, scr, lane, nullptr); continue; } r -= I2;
        if (r < I3) { const int o = r / 512, rr = r % 512, kb = rr / 16, nb = rr % 16;
            const float* src; int ldw, n0, drow0, mu;
            if (nb < 8) { src = a->in[18] + (size_t)o * 2048 * 256; ldw = 256; n0 = 32 * nb; drow0 = 32 * nb; mu = 5; }
            else if (nb < 11) { src = a->in[13] + (size_t)o * 2048 * 96; ldw = 96; n0 = 32 * (nb - 8); drow0 = 256 + n0; mu = 1; }
            else if (nb < 14) { src = a->in[16] + (size_t)o * 2048 * 96; ldw = 96; n0 = 32 * (nb - 11); drow0 = 352 + n0; mu = 4; }
            else { if (o == 0) continue; src = a->in[26]; ldw = 64; n0 = 32 * (nb - 14); drow0 = 448 + n0; mu = 3; }
            bf16* dst = (bf16*)(ws + WS_WL1) + (size_t)o * 512 * 4096;
            tr_item(src, ldw, 64 * kb, n0, dst, 4096, drow0, 64 * kb, scr, lane, nullptr);
            tr_item(src, ldw, 64 * kb, n0, dst, 4096, drow0, 2048 + 64 * kb, scr, lane, a->in[7] + (size_t)(o * 6 + mu) * 2048);
            continue; } r -= I3;
        { const int le = r / 1536, rr = r % 1536, mat = rr / 512, q = rr % 512;
            if (mat < 2) { const int kb = q / 16, nb = q % 16, n0 = 32 * nb;
                tr_item((mat == 0 ? a->in[36] : a->in[37]) + (size_t)le * 2048 * 512, 512, 64 * kb, n0, (bf16*)(ws + WS_WGU) + (size_t)le * 1024 * 2048, 2048,
                        (n0 / 128) * 256 + (n0 % 128) + (mat == 1 ? 128 : 0), 64 * kb, scr, lane, nullptr); }
            else { const int kb = q / 64, nb = q % 64;
                tr_item(a->in[38] + (size_t)le * 512 * 2048, 2048, 64 * kb, 32 * nb, (bf16*)(ws + WS_WDN) + (size_t)le * 2048 * 512, 512, 32 * nb, 64 * kb, scr, lane, nullptr); }
        }
    }
    const int gt = blockIdx.x * NTHR + tid, NGT = gridDim.x * NTHR;
    for (int idx = gt; idx < 2 * 32 * 8192; idx += NGT) {
        const int o = idx / (32 * 8192), rem = idx % (32 * 8192), kg = rem / 8192, n = rem % 8192, mat = n / 2048, nn = n % 2048;
        float v[8];
#pragma unroll
        for (int j = 0; j < 8; ++j) { const int k = 8 * kg + j; float x = 0.f;
            if (mat == 0) x = a->in[19][((size_t)o * 256 + k) * 2048 + nn];
            else if (mat == 1) { if (k < 96) x = a->in[14][((size_t)o * 96 + k) * 2048 + nn]; }
            else if (mat == 2) { if (k >= 96 && k < 192) x = a->in[17][((size_t)o * 96 + (k - 96)) * 2048 + nn]; }
            else { if (o == 1 && k >= 192) x = a->in[27][(size_t)(k - 192) * 2048 + nn]; }
            v[j] = x; }
        v4u w; w.x = pk2(v[0], v[1]); w.y = pk2(v[2], v[3]); w.z = pk2(v[4], v[5]); w.w = pk2(v[6], v[7]);
        *(v4u*)((bf16*)(ws + WS_WL2) + ((size_t)o * 8192 + n) * 256 + 8 * kg) = w;
    }
    for (int i = gt; i < T_ * D_ / 4; i += NGT) { const f32x4 v = ((const f32x4*)a->in[0])[i]; ((f32x4*)a->out)[i] = v;
        v2u w; w.x = pk2(v.x, v.y); w.y = pk2(v.z, v.w); ((v2u*)(ws + WS_XB))[i] = w; }
}

__device__ __forceinline__ void even_prep(const int wv, int e, LAS unsigned char* lds, int u) {
    const ArgsP a = get_args();
#ifdef NO_EPREP
    return;
#endif
    OPAQUE_TID(); const int lane = tid & 63, wave = tid >> 6;
    unsigned char* ws = a->ws;
    bf16* Z = (bf16*)(ws + WS_Z);
    const int m0 = 64 * u, b = u >> 6, ch = u & 63, t0 = ch * 64;
    { LAS float* cst = (LAS float*)lds; LAS float* snt = cst + 1024;
#pragma unroll 1
      for (int q = tid; q < 1024; q += NTHR) { const int r = q >> 4, i = q & 15; const float inv = exp2f(-(float)i * (18.931568569324174f / 16.f));
          float sn_, cs_; sincosf((float)(t0 + r) * inv, &sn_, &cs_); cst[q] = cs_; snt[q] = sn_; }
      __syncthreads();
      const int row = tid >> 3, head = tid & 7;
      float cs[16], sn[16];
#pragma unroll
      for (int i = 0; i < 4; ++i) { const f32x4 c4 = *(const LAS f32x4*)(cst + row * 16 + 4 * i), s4 = *(const LAS f32x4*)(snt + row * 16 + 4 * i);
          cs[4 * i] = c4.x; cs[4 * i + 1] = c4.y; cs[4 * i + 2] = c4.z; cs[4 * i + 3] = c4.w; sn[4 * i] = s4.x; sn[4 * i + 1] = s4.y; sn[4 * i + 2] = s4.z; sn[4 * i + 3] = s4.w; }
#pragma unroll 1
      for (int qk = 0; qk < 2; ++qk) { v4u* p = (v4u*)(Z + (size_t)(m0 + row) * ZW + qk * 1024 + head * 128);
        v4u w0 = p[0], w1 = p[1], w2 = p[2], w3 = p[3]; unsigned x1[8] = {w0.x, w0.y, w0.z, w0.w, w1.x, w1.y, w1.z, w1.w}, x2[8] = {w2.x, w2.y, w2.z, w2.w, w3.x, w3.y, w3.z, w3.w};
        unsigned o1[8], o2[8];
#pragma unroll
        for (int j = 0; j < 8; ++j) { const float a0 = bflo(x1[j]), a1 = bfhi(x1[j]), b0 = bflo(x2[j]), b1 = bfhi(x2[j]);
            o1[j] = pk2(a0 * cs[2 * j] - b0 * sn[2 * j], a1 * cs[2 * j + 1] - b1 * sn[2 * j + 1]);
            o2[j] = pk2(b0 * cs[2 * j] + a0 * sn[2 * j], b1 * cs[2 * j + 1] + a1 * sn[2 * j + 1]); }
        p[0] = (v4u){o1[0], o1[1], o1[2], o1[3]}; p[1] = (v4u){o1[4], o1[5], o1[6], o1[7]}; p[2] = (v4u){o2[0], o2[1], o2[2], o2[3]}; p[3] = (v4u){o2[4], o2[5], o2[6], o2[7]}; }
    }
    VM_WAIT(); __syncthreads();
    { LAS float* red = (LAS float*)lds;
      const int cg = tid & 127, rq = tid >> 7; float s[8] = {0, 0, 0, 0, 0, 0, 0, 0};
      for (int r = 0; r < 16; ++r) { const v4u w = *(const v4u*)(Z + (size_t)(m0 + rq * 16 + r) * ZW + 1024 + cg * 8);
          s[0] += bflo(w.x); s[1] += bfhi(w.x); s[2] += bflo(w.y); s[3] += bfhi(w.y); s[4] += bflo(w.z); s[5] += bfhi(w.z); s[6] += bflo(w.w); s[7] += bfhi(w.w); }
#pragma unroll
      for (int j = 0; j < 8; ++j) red[rq * 1024 + cg * 8 + j] = s[j];
      __syncthreads();
      if (tid < 256) { f32x4 t = {0, 0, 0, 0};
#pragma unroll
          for (int q = 0; q < 4; ++q) { const f32x4 v = *(const LAS f32x4*)(red + q * 1024 + tid * 4); t += v; }
          const int c = tid * 4, h = c >> 7, d = c & 127;
          *(f32x4*)((float*)(ws + WS_KPART) + ((size_t)((b * 8 + h) * 64 + ch)) * 128 + d) = t; }
      __syncthreads();
    }
    { LAS bf16* tile = (LAS bf16*)lds;
      bf16* VAT = (bf16*)(ws + WS_VAT);
      for (int p = 0; p < 4; ++p) {
          { const int r = tid >> 3, seg = tid & 7; const v4u* src = (const v4u*)(Z + (size_t)(m0 + r) * ZW + 2048 + 256 * p + 32 * seg);
#pragma unroll
            for (int j = 0; j < 4; ++j) *(LAS v4u*)(tile + r * 264 + 32 * seg + 8 * j) = src[j]; }
          __syncthreads();
          { const int c = tid & 255, rh = tid >> 8; unsigned w[16];
#pragma unroll
            for (int j = 0; j < 16; ++j) { const unsigned lo = tile[(32 * rh + 2 * j) * 264 + c], hi = tile[(32 * rh + 2 * j + 1) * 264 + c]; w[j] = lo | (hi << 16); }
            const int col = 256 * p + c, h = col >> 7, d = col & 127;
            v4u* dst = (v4u*)(VAT + ((size_t)((b * 8 + h) * 128 + d)) * SEQ + t0 + 32 * rh);
#pragma unroll
            for (int j = 0; j < 4; ++j) dst[j] = (v4u){w[4 * j], w[4 * j + 1], w[4 * j + 2], w[4 * j + 3]}; }
          __syncthreads();
      }
    }
    { const int cg = tid & 255, rh = tid >> 8; const int c0 = 8 * cg;
      const float* cw = a->in[3] + (size_t)e * 4 * 2048; const float* cb = a->in[4] + (size_t)e * 2048;
      float w[4][8], bias[8];
#pragma unroll
      for (int j = 0; j < 4; ++j)
#pragma unroll
          for (int i = 0; i < 8; ++i) w[j][i] = cw[j * 2048 + c0 + i];
#pragma unroll
      for (int i = 0; i < 8; ++i) bias[i] = cb[c0 + i];
      float win[3][8];
#pragma unroll
      for (int j = 0; j < 3; ++j) { const int tt = t0 + 32 * rh - 3 + j;
          v4u x = {0, 0, 0, 0}; if (tt >= 0) x = *(const v4u*)(Z + (size_t)(b * SEQ + tt) * ZW + 3072 + c0);
          win[j][0] = bflo(x.x); win[j][1] = bfhi(x.x); win[j][2] = bflo(x.y); win[j][3] = bfhi(x.y); win[j][4] = bflo(x.z); win[j][5] = bfhi(x.z); win[j][6] = bflo(x.w); win[j][7] = bfhi(x.w); }
      bf16* QKB = (bf16*)(ws + WS_QKB);
      for (int r = 0; r < 32; ++r) { const int m = m0 + 32 * rh + r;
          const v4u x = *(const v4u*)(Z + (size_t)m * ZW + 3072 + c0);
          float cur[8] = {bflo(x.x), bfhi(x.x), bflo(x.y), bfhi(x.y), bflo(x.z), bfhi(x.z), bflo(x.w), bfhi(x.w)}; float o[8];
#pragma unroll
          for (int i = 0; i < 8; ++i) { const float v = bias[i] + w[0][i] * win[0][i] + w[1][i] * win[1][i] + w[2][i] * win[2][i] + w[3][i] * cur[i]; o[i] = v / (1.f + __expf(-v));
              win[0][i] = win[1][i]; win[1][i] = win[2][i]; win[2][i] = cur[i]; }
          *(v4u*)(QKB + (size_t)m * 2048 + c0) = (v4u){pk2(o[0], o[1]), pk2(o[2], o[3]), pk2(o[4], o[5]), pk2(o[6], o[7])}; }
    }
    { LAS float* wg = (LAS float*)lds;
      const float* Win = a->in[1] + (size_t)e * 2048 * EVEN_IN;
      for (int i = tid; i < 2048 * 2; i += NTHR) { const int k = i >> 1, hf = i & 1; *(LAS f32x4*)(wg + k * 8 + hf * 4) = *(const f32x4*)(Win + (size_t)k * EVEN_IN + ZW + hf * 4); }
      __syncthreads();
      const float* gb = a->in[2] + e * 8;
      for (int rr = 0; rr < 8; ++rr) { const int row = wave * 8 + rr, m = m0 + row; const f32x4* xr = (const f32x4*)(a->out + (size_t)m * D_) + lane;
          float acc[8] = {0, 0, 0, 0, 0, 0, 0, 0};
#pragma unroll 2
          for (int j = 0; j < 8; ++j) { const f32x4 xv = xr[64 * j]; const int k0 = 4 * lane + 256 * j;
#pragma unroll
              for (int i = 0; i < 4; ++i) { const f32x4 wa = *(const LAS f32x4*)(wg + (k0 + i) * 8), wb = *(const LAS f32x4*)(wg + (k0 + i) * 8 + 4); const float xx = xv[i];
                  acc[0] += xx * wa.x; acc[1] += xx * wa.y; acc[2] += xx * wa.z; acc[3] += xx * wa.w; acc[4] += xx * wb.x; acc[5] += xx * wb.y; acc[6] += xx * wb.z; acc[7] += xx * wb.w; } }
#pragma unroll
          for (int j = 0; j < 8; ++j) acc[j] = wave_sum(acc[j]);
          if (lane < 4) { const int h = lane; float ip = 0.f, fp = 0.f;
#pragma unroll
              for (int j = 0; j < 4; ++j) { if (j == h) { ip = acc[j]; fp = acc[4 + j]; } }
              ip += gb[h]; fp += gb[4 + h];
              const float lf = -(fmaxf(-fp, 0.f) + __logf(1.f + __expf(-fabsf(fp))));
              ((float*)(ws + WS_IG))[(size_t)(b * 4 + h) * SEQ + t0 + row] = ip;
              ((LAS float*)(lds + 73728))[h * 64 + row] = ip; ((LAS float*)(lds + 73728 + 1024))[h * 64 + row] = lf; } }
      __syncthreads();
    }
    { LAS float* gi = (LAS float*)(lds + 73728); LAS float* gf = gi + 256; LAS float* wsc = gi + 512;
      const int bh0 = b * 4;
      if (wave < 4) { const int h = wave; float x = gf[h * 64 + lane];
#pragma unroll
          for (int o = 1; o < 64; o <<= 1) { const float t = __shfl_up(x, o); if (lane >= o) x += t; }
          const float b63 = __shfl(x, 63);
          wsc[h * 64 + lane] = __expf(b63 - x + gi[h * 64 + lane]) * 0.0625f;
          ((float*)(ws + WS_BC))[(size_t)(bh0 + h) * SEQ + t0 + lane] = x;
          if (lane == 63) ((float*)(ws + WS_DEC))[(bh0 + h) * 64 + ch] = __expf(b63); }
      __syncthreads();
      constexpr int PV = 544;
      LAS unsigned char* Vt = lds; LAS unsigned char* Kt = lds + 64 * PV;
      const int g4 = lane >> 4, q4 = (lane >> 2) & 3, p4 = lane & 3, fr = lane & 15;
      const int wd = wave & 1, we = wave >> 1;
      const bf16* QKB = (const bf16*)(ws + WS_QKB);
      for (int h = 0; h < 4; ++h) {
          { const int sr = tid >> 3, seg = tid & 7; const float wv_ = wsc[h * 64 + sr];
            const v4u* vs = (const v4u*)(Z + (size_t)(m0 + sr) * ZW + 5120 + h * 256 + 32 * seg); const v4u* ks = (const v4u*)(QKB + (size_t)(m0 + sr) * 2048 + 1024 + h * 256 + 32 * seg);
#pragma unroll
            for (int j = 0; j < 4; ++j) { *(LAS v4u*)(Vt + sr * PV + (32 * seg + 8 * j) * 2) = vs[j]; const v4u kk = ks[j];
                *(LAS v4u*)(Kt + sr * PV + (32 * seg + 8 * j) * 2) = (v4u){pk2(bflo(kk.x) * wv_, bfhi(kk.x) * wv_), pk2(bflo(kk.y) * wv_, bfhi(kk.y) * wv_), pk2(bflo(kk.z) * wv_, bfhi(kk.z) * wv_), pk2(bflo(kk.w) * wv_, bfhi(kk.w) * wv_)}; } }
          __syncthreads();
          if (tid < 256) { float sum = 0.f;
#pragma unroll 8
              for (int sr = 0; sr < 64; ++sr) sum += bf2f(*(const LAS bf16*)(Kt + sr * PV + tid * 2));
              ((float*)(ws + WS_DN))[((size_t)(bh0 + h) * 64 + ch) * 256 + tid] = sum; }
          f32x4 acc[8][4];
#pragma unroll
          for (int i = 0; i < 8; ++i)
#pragma unroll
              for (int j = 0; j < 4; ++j) acc[i][j] = (f32x4){0.f, 0.f, 0.f, 0.f};
#pragma unroll
          for (int ks2 = 0; ks2 < 2; ++ks2) {
              bf16x8 yf[4];
#pragma unroll
              for (int et = 0; et < 4; ++et) { const LAS unsigned char* p = Vt + (32 * ks2 + 8 * g4 + q4) * PV + (64 * we + 16 * et + 4 * p4) * 2;
                  const v2u lo = tr_read(p), hi = tr_read(p + 4 * PV); yf[et] = __builtin_bit_cast(bf16x8, (v4u){lo.x, lo.y, hi.x, hi.y}); }
#pragma unroll
              for (int dt = 0; dt < 8; ++dt) { const LAS unsigned char* p = Kt + (32 * ks2 + 8 * g4 + q4) * PV + (128 * wd + 16 * dt + 4 * p4) * 2;
                  const v2u lo = tr_read(p), hi = tr_read(p + 4 * PV); const bf16x8 xf = __builtin_bit_cast(bf16x8, (v4u){lo.x, lo.y, hi.x, hi.y});
#pragma unroll
                  for (int et = 0; et < 4; ++et) acc[dt][et] = __builtin_amdgcn_mfma_f32_16x16x32_bf16(xf, yf[et], acc[dt][et], 0, 0, 0); } }
          { bf16* DC = (bf16*)(ws + WS_DC) + ((size_t)(bh0 + h) * 64 + ch) * 65536;
#pragma unroll
            for (int et = 0; et < 4; ++et)
#pragma unroll
                for (int dt = 0; dt < 8; ++dt) { const f32x4 v = acc[dt][et];
                    *(v2u*)(DC + (size_t)(64 * we + 16 * et + fr) * 256 + 128 * wd + 16 * dt + 4 * g4) = (v2u){pk2(v.x, v.y), pk2(v.z, v.w)}; } }
          __syncthreads();
      }
    }
}

constexpr int AT_KSTR = 136, AT_VSTR = 72;
constexpr int AT_K_OFF = 0, AT_V_OFF = 64 * AT_KSTR * 2, AT_KM_OFF = AT_V_OFF + 128 * AT_VSTR * 2, AT_GATE_OFF = AT_KM_OFF + 16 * 128 * 4,
              AT_SEL_OFF = AT_GATE_OFF + 128 * 16 * 4, AT_TL_OFF = AT_SEL_OFF + 128 * 4, AT_END = AT_TL_OFF + 80 * 4;

__device__ __forceinline__ void attn_unit(const int wv, LAS unsigned char* lds, int b, int h, int qt) {
    const ArgsP a = get_args();
#ifdef NO_ATTN
    return;
#endif
    OPAQUE_TID(); const int lane = tid & 63, wave = __builtin_amdgcn_readfirstlane(tid >> 6), fr = lane & 15, fq = lane >> 4;
    unsigned char* ws = a->ws;
    const bf16* Z = (const bf16*)(ws + WS_Z);
    const bf16* VAT = (const bf16*)(ws + WS_VAT) + (size_t)(b * 8 + h) * 128 * SEQ;
    const int qb = qt >> 1, q0 = 128 * qt;
    LAS bf16* Kt = (LAS bf16*)(lds + AT_K_OFF); LAS bf16* Vt = (LAS bf16*)(lds + AT_V_OFF);
    LAS float* km = (LAS float*)(lds + AT_KM_OFF); LAS float* gate = (LAS float*)(lds + AT_GATE_OFF);
    LAS unsigned* sel = (LAS unsigned*)(lds + AT_SEL_OFF); LAS int* tl = (LAS int*)(lds + AT_TL_OFF);
    for (int i = tid; i < qb * 128; i += NTHR) { const int n = i >> 7, d = i & 127; const float* kp = (const float*)(ws + WS_KPART) + ((size_t)((b * 8 + h) * 64 + 4 * n)) * 128 + d;
        km[i] = (kp[0] + kp[128] + kp[256] + kp[384]) * (1.f / 256.f); }
    __syncthreads();
    { const int ql = tid >> 2, part = tid & 3; const v4u* qp = (const v4u*)(Z + (size_t)(b * SEQ + q0 + ql) * ZW + h * 128);
      if (part < qb) { float g[4] = {0, 0, 0, 0};
          for (int c = 0; c < 16; ++c) { const v4u w = qp[c]; const float qv[8] = {bflo(w.x), bfhi(w.x), bflo(w.y), bfhi(w.y), bflo(w.z), bfhi(w.z), bflo(w.w), bfhi(w.w)};
#pragma unroll
              for (int jj = 0; jj < 4; ++jj) { const int n = part + 4 * jj; if (n < qb) { const LAS float* kk = km + n * 128 + c * 8;
#pragma unroll
                  for (int i = 0; i < 8; ++i) g[jj] += qv[i] * kk[i]; } } }
#pragma unroll
          for (int jj = 0; jj < 4; ++jj) { const int n = part + 4 * jj; if (n < qb) gate[ql * 16 + n] = g[jj]; } }
    }
    __syncthreads();
    if (tid < 128) { unsigned m = 0;
        if (qb <= 3) m = (1u << qb) - 1u;
        else { for (int r = 0; r < 3; ++r) { float best = -3.0e38f; int bi = 0; for (int n = 0; n < qb; ++n) { const float g = gate[tid * 16 + n]; if (!((m >> n) & 1u) && g > best) { best = g; bi = n; } } m |= 1u << bi; } }
        sel[tid] = m; }
    __syncthreads();
    if (tid == 0) { unsigned um = 0; for (int i = 0; i < 128; ++i) um |= sel[i];
        int nt = 0; const int nown = (qt & 1) ? 4 : 2;
        for (int j = 0; j < nown; ++j) tl[1 + nt++] = (4 * qb + j) | (1 << 16);
        for (int n = 0; n < qb; ++n) if ((um >> n) & 1u) for (int j = 0; j < 4; ++j) tl[1 + nt++] = 4 * n + j;
        tl[0] = nt; }
    __syncthreads();
    const int ntile = tl[0];
    const unsigned mysel = sel[16 * wave + fr];
    unsigned wsel = mysel;
#pragma unroll
    for (int o = 1; o < 16; o <<= 1) wsel |= __shfl_xor(wsel, o);
    bf16x8 qf[4];
    { const v4u* qp = (const v4u*)(Z + (size_t)(b * SEQ + q0 + 16 * wave + fr) * ZW + h * 128);
#pragma unroll
      for (int kc = 0; kc < 4; ++kc) qf[kc] = __builtin_bit_cast(bf16x8, qp[kc * 4 + fq]); }
    f32x4 o[8];
#pragma unroll
    for (int i = 0; i < 8; ++i) o[i] = (f32x4){0.f, 0.f, 0.f, 0.f};
    float mrun = -INFINITY, lrun = 0.f;
    const float sc = 0.08838834764831845f * 1.4426950408889634f;
    const int qabs = q0 + 16 * wave + fr;
    v4u kr[2], vr[2];
    auto gload = [&](int ti) { const int kt = tl[1 + ti] & 0xffff; const int key0 = 64 * kt;
        const v4u* kp = (const v4u*)(Z + (size_t)(b * SEQ + key0 + (tid >> 3)) * ZW + 1024 + h * 128) + (tid & 7) * 2; kr[0] = kp[0]; kr[1] = kp[1];
        const v4u* vp = (const v4u*)(VAT + (size_t)(tid >> 2) * SEQ + key0) + (tid & 3) * 2; vr[0] = vp[0]; vr[1] = vp[1]; };
    auto lstore = [&]() { LAS v4u* kd = (LAS v4u*)(Kt + (tid >> 3) * AT_KSTR + (tid & 7) * 16); kd[0] = kr[0]; kd[1] = kr[1];
        LAS v4u* vd = (LAS v4u*)(Vt + (tid >> 2) * AT_VSTR + (tid & 3) * 16); vd[0] = vr[0]; vd[1] = vr[1]; };
    gload(0); lstore(); __syncthreads();
    for (int ti = 0; ti < ntile; ++ti) {
        const int ent = tl[1 + ti]; const int kt64 = ent & 0xffff; const bool own = (ent >> 16) & 1; const int key0 = 64 * kt64;
        if (ti + 1 < ntile) gload(ti + 1);
        const bool wave_active = own || ((wsel >> (kt64 >> 2)) & 1u);
        if (wave_active) {
            f32x4 s[4];
#pragma unroll
            for (int kt = 0; kt < 4; ++kt) { s[kt] = (f32x4){0.f, 0.f, 0.f, 0.f};
#pragma unroll
                for (int kc = 0; kc < 4; ++kc) { const bf16x8 kf = *(const LAS bf16x8*)(Kt + (16 * kt + fr) * AT_KSTR + kc * 32 + fq * 8);
                    s[kt] = __builtin_amdgcn_mfma_f32_16x16x32_bf16(kf, qf[kc], s[kt], 0, 0, 0); } }
            const bool qsel = own || ((mysel >> (kt64 >> 2)) & 1u);
            float mx = -INFINITY;
#pragma unroll
            for (int kt = 0; kt < 4; ++kt)
#pragma unroll
                for (int e = 0; e < 4; ++e) { const int kabs = key0 + 16 * kt + 4 * fq + e; const bool valid = own ? (kabs <= qabs) : qsel;
                    const float v = valid ? s[kt][e] * sc : -INFINITY; s[kt][e] = v; mx = fmaxf(mx, v); }
            mx = fmaxf(mx, __shfl_xor(mx, 16)); mx = fmaxf(mx, __shfl_xor(mx, 32));
            const float mnew = fmaxf(mrun, mx);
            const float alpha = (mnew == -INFINITY) ? 1.f : exp2f(mrun - mnew);
            const float msub = (mnew == -INFINITY) ? 0.f : mnew;
            float psum = 0.f;
#pragma unroll
            for (int kt = 0; kt < 4; ++kt)
#pragma unroll
                for (int e = 0; e < 4; ++e) { const float p = exp2f(s[kt][e] - msub); s[kt][e] = p; psum += p; }
            lrun = lrun * alpha + psum; mrun = mnew;
#pragma unroll
            for (int i = 0; i < 8; ++i) o[i] *= alpha;
            bf16x8 pf[2];
#pragma unroll
            for (int j = 0; j < 2; ++j) { v4u w; w.x = pk2(s[2 * j][0], s[2 * j][1]); w.y = pk2(s[2 * j][2], s[2 * j][3]); w.z = pk2(s[2 * j + 1][0], s[2 * j + 1][1]); w.w = pk2(s[2 * j + 1][2], s[2 * j + 1][3]);
                pf[j] = __builtin_bit_cast(bf16x8, w); }
#pragma unroll
            for (int dt = 0; dt < 8; ++dt)
#pragma unroll
                for (int j = 0; j < 2; ++j) { const LAS bf16* vp = Vt + (16 * dt + fr) * AT_VSTR + 32 * j + 4 * fq;
                    const v2u lo = *(const LAS v2u*)vp, hi = *(const LAS v2u*)(vp + 16);
                    const v4u w = {lo.x, lo.y, hi.x, hi.y};
                    o[dt] = __builtin_amdgcn_mfma_f32_16x16x32_bf16(__builtin_bit_cast(bf16x8, w), pf[j], o[dt], 0, 0, 0); }
        }
        __syncthreads();
        if (ti + 1 < ntile) lstore();
        __syncthreads();
    }
    float lt = lrun; lt += __shfl_xor(lt, 16); lt += __shfl_xor(lt, 32);
    const float inv = 1.f / lt;
    bf16* Y = (bf16*)(ws + WS_YE) + (size_t)(b * SEQ + qabs) * 2048 + h * 128;
#pragma unroll
    for (int dt = 0; dt < 8; ++dt) { v2u w; w.x = pk2(o[dt][0] * inv, o[dt][1] * inv); w.y = pk2(o[dt][2] * inv, o[dt][3] * inv); *(v2u*)(Y + 16 * dt + 4 * fq) = w; }
    __syncthreads();
}

__device__ __forceinline__ void mlstm_scan(const int wv) {
    const ArgsP a = get_args();
    OPAQUE_TID();
    unsigned char* ws = a->ws;
    const int gt = blockIdx.x * NTHR + tid, NGT = gridDim.x * NTHR;
    for (int idx = gt; idx < 16 * 256 * 32; idx += NGT) { const int bh = idx >> 13, rem = idx & 8191;
        const bf16* DC = (const bf16*)(ws + WS_DC) + (size_t)bh * 64 * 65536 + rem * 8; bf16* CP = (bf16*)(ws + WS_CP) + (size_t)bh * 64 * 65536 + rem * 8;
        const float* dec = (const float*)(ws + WS_DEC) + bh * 64;
        float C[8] = {0, 0, 0, 0, 0, 0, 0, 0};
        for (int c0 = 0; c0 < 64; c0 += 8) { v4u in[8];
#pragma unroll
            for (int j = 0; j < 8; ++j) in[j] = __builtin_nontemporal_load((const v4u*)(DC + (size_t)(c0 + j) * 65536));
#pragma unroll
            for (int j = 0; j < 8; ++j) { const float dc = dec[c0 + j];
                *(v4u*)(CP + (size_t)(c0 + j) * 65536) = (v4u){pk2(C[0], C[1]), pk2(C[2], C[3]), pk2(C[4], C[5]), pk2(C[6], C[7])};
                C[0] = fmaf(dc, C[0], bflo(in[j].x)); C[1] = fmaf(dc, C[1], bfhi(in[j].x)); C[2] = fmaf(dc, C[2], bflo(in[j].y)); C[3] = fmaf(dc, C[3], bfhi(in[j].y));
                C[4] = fmaf(dc, C[4], bflo(in[j].z)); C[5] = fmaf(dc, C[5], bfhi(in[j].z)); C[6] = fmaf(dc, C[6], bflo(in[j].w)); C[7] = fmaf(dc, C[7], bfhi(in[j].w)); } }
    }
    for (int idx = gt; idx < 16 * 256; idx += NGT) { const int bh = idx >> 8, d = idx & 255; const float* DN = (const float*)(ws + WS_DN) + (size_t)bh * 64 * 256 + d; float* NP = (float*)(ws + WS_NP) + (size_t)bh * 64 * 256 + d;
        const float* dec = (const float*)(ws + WS_DEC) + bh * 64; float n = 0.f;
        for (int c = 0; c < 64; ++c) { NP[c * 256] = n; n = fmaf(dec[c], n, DN[c * 256]); } }
}

constexpr int M3_PQ = 528, M3_PVv = 544, M3_PP = 144;
constexpr int M3_Q = 0, M3_K = 64 * M3_PQ, M3_V = 2 * 64 * M3_PQ, M3_P = M3_V + 64 * M3_PVv, M3_F = M3_P + 64 * M3_PP;
__device__ __forceinline__ void mlstm_out_unit(const int wv, LAS unsigned char* lds, int e_, int b, int h, int c) {
    const ArgsP a = get_args();
    OPAQUE_TID(); const int lane = tid & 63, wave = wv, fr = lane & 15, fq = lane >> 4, q4 = (lane >> 2) & 3, p4 = lane & 3;
    unsigned char* ws = a->ws;
    const int bh = b * 4 + h, m0 = b * SEQ + 64 * c;
    const bf16* QKB = (const bf16*)(ws + WS_QKB); const bf16* Z = (const bf16*)(ws + WS_Z);
    LAS unsigned char* Qt = lds + M3_Q; LAS unsigned char* Kt = lds + M3_K; LAS unsigned char* Vt = lds + M3_V; LAS unsigned char* Pm = lds + M3_P;
    LAS float* F = (LAS float*)(lds + M3_F); LAS float* bt = F; LAS float* itv = F + 64; LAS float* ebt = F + 128; LAS float* den = F + 192; LAS float* rstd = F + 256; LAS float* np = F + 320; LAS float* rsp = F + 576;
    { const int sr = tid >> 3, seg = tid & 7;
      const v4u* qs = (const v4u*)(QKB + (size_t)(m0 + sr) * 2048 + h * 256 + 32 * seg); const v4u* ks = (const v4u*)(QKB + (size_t)(m0 + sr) * 2048 + 1024 + h * 256 + 32 * seg);
      const v4u* vs = (const v4u*)(Z + (size_t)(m0 + sr) * ZW + 5120 + h * 256 + 32 * seg);
#pragma unroll
      for (int j = 0; j < 4; ++j) { *(LAS v4u*)(Qt + sr * M3_PQ + (32 * seg + 8 * j) * 2) = qs[j]; *(LAS v4u*)(Kt + sr * M3_PQ + (32 * seg + 8 * j) * 2) = ks[j]; *(LAS v4u*)(Vt + sr * M3_PVv + (32 * seg + 8 * j) * 2) = vs[j]; }
      if (tid < 64) { const float bb = ((const float*)(ws + WS_BC))[(size_t)bh * SEQ + 64 * c + tid]; bt[tid] = bb; ebt[tid] = __expf(bb); itv[tid] = ((const float*)(ws + WS_IG))[(size_t)bh * SEQ + 64 * c + tid]; }
      else if (tid < 320) np[tid - 64] = ((const float*)(ws + WS_NP))[((size_t)bh * 64 + c) * 256 + tid - 64]; }
    v4u cf[8][2];
    { const bf16* CP = (const bf16*)(ws + WS_CP) + ((size_t)bh * 64 + c) * 65536 + (size_t)(32 * wave + fr) * 256 + 8 * fq;
#pragma unroll
      for (int kk = 0; kk < 8; ++kk)
#pragma unroll
          for (int et = 0; et < 2; ++et) cf[kk][et] = *(const v4u*)(CP + et * 16 * 256 + 32 * kk); }
    __syncthreads();
    { const int ss = wave >> 1;
#pragma unroll
      for (int ti = 0; ti < 2; ++ti) { const int tt = 2 * (wave & 1) + ti; f32x4 sacc = {0.f, 0.f, 0.f, 0.f};
#pragma unroll
          for (int kk = 0; kk < 8; ++kk) { const bf16x8 kf = *(const LAS bf16x8*)(Kt + (16 * ss + fr) * M3_PQ + (32 * kk + 8 * fq) * 2), qf = *(const LAS bf16x8*)(Qt + (16 * tt + fr) * M3_PQ + (32 * kk + 8 * fq) * 2);
              sacc = __builtin_amdgcn_mfma_f32_16x16x32_bf16(kf, qf, sacc, 0, 0, 0); }
          const int t = 16 * tt + fr; const float btv = bt[t]; float pv[4];
#pragma unroll
          for (int r = 0; r < 4; ++r) { const int s_ = 16 * ss + 4 * fq + r; pv[r] = (s_ <= t) ? sacc[r] * __expf(btv - bt[s_] + itv[s_]) * 0.0625f : 0.f; }
          *(LAS v2u*)(Pm + t * M3_PP + (16 * ss + 4 * fq) * 2) = (v2u){pk2(pv[0], pv[1]), pk2(pv[2], pv[3])}; } }
    float qn;
    { const int t = tid >> 3, part = tid & 7; float sacc = 0.f;
#pragma unroll
      for (int j = 0; j < 4; ++j) { const v4u w = *(const LAS v4u*)(Qt + t * M3_PQ + (32 * part + 8 * j) * 2); const LAS float* nn = np + 32 * part + 8 * j;
          sacc += bflo(w.x) * nn[0] + bfhi(w.x) * nn[1] + bflo(w.y) * nn[2] + bfhi(w.y) * nn[3] + bflo(w.z) * nn[4] + bfhi(w.z) * nn[5] + bflo(w.w) * nn[6] + bfhi(w.w) * nn[7]; }
      sacc += dppf<0xB1>(sacc); sacc += dppf<0x4E>(sacc); sacc += dppf<0x141>(sacc); qn = sacc; }
    __syncthreads();
    { const int t = tid >> 3, part = tid & 7; const v4u w = *(const LAS v4u*)(Pm + t * M3_PP + part * 16);
      float ps = bflo(w.x) + bfhi(w.x) + bflo(w.y) + bfhi(w.y) + bflo(w.z) + bfhi(w.z) + bflo(w.w) + bfhi(w.w);
      ps += dppf<0xB1>(ps); ps += dppf<0x4E>(ps); ps += dppf<0x141>(ps);
      if (part == 0) den[t] = ebt[t] * qn + ps; }
    f32x4 acc[4][2];
#pragma unroll
    for (int tt = 0; tt < 4; ++tt) { acc[tt][0] = (f32x4){0.f, 0.f, 0.f, 0.f}; acc[tt][1] = (f32x4){0.f, 0.f, 0.f, 0.f}; }
#pragma unroll
    for (int kk = 0; kk < 8; ++kk)
#pragma unroll
        for (int tt = 0; tt < 4; ++tt) { const bf16x8 qf = *(const LAS bf16x8*)(Qt + (16 * tt + fr) * M3_PQ + (32 * kk + 8 * fq) * 2);
            acc[tt][0] = __builtin_amdgcn_mfma_f32_16x16x32_bf16(qf, __builtin_bit_cast(bf16x8, cf[kk][0]), acc[tt][0], 0, 0, 0);
            acc[tt][1] = __builtin_amdgcn_mfma_f32_16x16x32_bf16(qf, __builtin_bit_cast(bf16x8, cf[kk][1]), acc[tt][1], 0, 0, 0); }
#pragma unroll
    for (int tt = 0; tt < 4; ++tt) { const f32x4 eb = *(const LAS f32x4*)(ebt + 16 * tt + 4 * fq); acc[tt][0] *= eb; acc[tt][1] *= eb; }
#pragma unroll
    for (int j = 0; j < 2; ++j) { bf16x8 vf[2];
#pragma unroll
        for (int et = 0; et < 2; ++et) { const LAS unsigned char* p = Vt + (32 * j + 8 * fq + q4) * M3_PVv + (32 * wave + 16 * et + 4 * p4) * 2;
            const v2u lo = tr_read(p), hi = tr_read(p + 4 * M3_PVv); vf[et] = __builtin_bit_cast(bf16x8, (v4u){lo.x, lo.y, hi.x, hi.y}); }
#pragma unroll
        for (int tt = 0; tt < 4; ++tt) { const bf16x8 pf = *(const LAS bf16x8*)(Pm + (16 * tt + fr) * M3_PP + (32 * j + 8 * fq) * 2);
            acc[tt][0] = __builtin_amdgcn_mfma_f32_16x16x32_bf16(pf, vf[0], acc[tt][0], 0, 0, 0); acc[tt][1] = __builtin_amdgcn_mfma_f32_16x16x32_bf16(pf, vf[1], acc[tt][1], 0, 0, 0); } }
    __syncthreads();
    LAS unsigned char* Ht = Qt;
#pragma unroll
    for (int tt = 0; tt < 4; ++tt) { const f32x4 dn = *(const LAS f32x4*)(den + 16 * tt + 4 * fq); float ssq[4];
#pragma unroll
        for (int r = 0; r < 4; ++r) { const float dv = 1.f / fmaxf(fabsf(dn[r]), 1.f); const float h0 = acc[tt][0][r] * dv, h1 = acc[tt][1][r] * dv; ssq[r] = red16(h0 * h0 + h1 * h1);
            const int t = 16 * tt + 4 * fq + r;
            *(LAS bf16*)(Ht + t * M3_PQ + (32 * wave + fr) * 2) = (bf16)f2bf(h0); *(LAS bf16*)(Ht + t * M3_PQ + (32 * wave + 16 + fr) * 2) = (bf16)f2bf(h1); }
        if (fr == 0) *(LAS f32x4*)(rsp + wave * 64 + 16 * tt + 4 * fq) = (f32x4){ssq[0], ssq[1], ssq[2], ssq[3]}; }
    __syncthreads();
    if (tid < 64) { float tot = 0.f;
#pragma unroll
        for (int w = 0; w < 8; ++w) tot += rsp[w * 64 + tid];
        rstd[tid] = 1.f / sqrtf(tot * (1.f / 256.f) + 1e-6f); }
    __syncthreads();
    { const int t = tid >> 3, seg = tid & 7; const float rs = rstd[t]; const float* hg = a->in[5] + (size_t)e_ * 1024 + h * 256 + 32 * seg;
      const v4u* os = (const v4u*)(Z + (size_t)(m0 + t) * ZW + 6144 + h * 256 + 32 * seg); v4u* yd = (v4u*)((bf16*)(ws + WS_YE) + (size_t)(m0 + t) * 2048 + 1024 + h * 256 + 32 * seg);
#pragma unroll
      for (int j = 0; j < 4; ++j) { const v4u hw = *(const LAS v4u*)(Ht + t * M3_PQ + (32 * seg + 8 * j) * 2), ow = os[j]; const f32x4 g0 = *(const f32x4*)(hg + 8 * j), g1 = *(const f32x4*)(hg + 8 * j + 4);
          yd[j] = (v4u){pk2(bflo(hw.x) * rs * g0.x * sigmoidf_(bflo(ow.x)), bfhi(hw.x) * rs * g0.y * sigmoidf_(bfhi(ow.x))), pk2(bflo(hw.y) * rs * g0.z * sigmoidf_(bflo(ow.y)), bfhi(hw.y) * rs * g0.w * sigmoidf_(bfhi(ow.y))),
                        pk2(bflo(hw.z) * rs * g1.x * sigmoidf_(bflo(ow.z)), bfhi(hw.z) * rs * g1.y * sigmoidf_(bfhi(ow.z))), pk2(bflo(hw.w) * rs * g1.z * sigmoidf_(bflo(ow.w)), bfhi(hw.w) * rs * g1.w * sigmoidf_(bfhi(ow.w)))}; } }
    __syncthreads();
}

__device__ __forceinline__ void odd_prep(const int wv, int o) {
    const ArgsP a = get_args();
#ifdef NO_OPREP
    return;
#endif
    OPAQUE_TID(); const int lane = tid & 63, wave = tid >> 6;
    unsigned char* ws = a->ws;
    const float* mu = a->in[7] + (size_t)o * 6 * 2048;
    bf16* XR = (bf16*)(ws + WS_XRKV); bf16* XK = XR + (size_t)T_ * 2048; bf16* XV = XK + (size_t)T_ * 2048; bf16* XC = (bf16*)(ws + WS_XC);
    const int gw = blockIdx.x * NWAVES + wave, NGW = gridDim.x * NWAVES;
    for (int m = gw; m < T_; m += NGW) { const bool first = (m % SEQ) == 0;
        const f32x4* xr = (const f32x4*)(a->out + (size_t)m * D_) + lane; const f32x4* xp = (const f32x4*)(a->out + (size_t)(m - 1) * D_) + lane;
#pragma unroll
        for (int j = 0; j < 8; ++j) { const f32x4 x = xr[64 * j]; f32x4 p = {0.f, 0.f, 0.f, 0.f}; if (!first) p = xp[64 * j]; const f32x4 dx = p - x;
            const f32x4 m0 = ((const f32x4*)mu)[lane + 64 * j], m2 = ((const f32x4*)(mu + 2 * 2048))[lane + 64 * j], m3 = ((const f32x4*)(mu + 3 * 2048))[lane + 64 * j];
            const f32x4 r = x + dx * m0, k = x + dx * m2, v = x + dx * m3; const size_t off = (size_t)m * 2048 + 4 * (lane + 64 * j);
            *(v2u*)(XR + off) = (v2u){pk2(r.x, r.y), pk2(r.z, r.w)}; *(v2u*)(XK + off) = (v2u){pk2(k.x, k.y), pk2(k.z, k.w)}; *(v2u*)(XV + off) = (v2u){pk2(v.x, v.y), pk2(v.z, v.w)};
            const size_t offc = (size_t)m * 4096 + 4 * (lane + 64 * j);
            *(v2u*)(XC + offc) = (v2u){pk2(x.x, x.y), pk2(x.z, x.w)}; *(v2u*)(XC + offc + 2048) = (v2u){pk2(dx.x, dx.y), pk2(dx.z, dx.w)}; }
    }
}

constexpr int RK_KQ = 0, RK_RQ = 4096, RK_TAB = 8192, RK_XU = 9216, RK_W4 = 17408, RK_VB = 19456, RK_CBUF = 27648;
constexpr int RK_XS = MISC_OFF + 4096;
constexpr int RK_PB0 = 2 * RK_CBUF, RK_PG = 0, RK_PV = 8192, RK_PBON = 16384, RK_PBSZ = 16512;
constexpr int RK_Y0 = RK_PB0 + 3 * RK_PBSZ, RK_YSZ = 64 * 36 * 4;
static_assert(RK_Y0 + 2 * RK_YSZ <= RING_BYTES && RK_XS + 8192 <= LDS_BYTES, "rwkv LDS map");
__device__ __forceinline__ float dot16(const f32x4 x, const f32x4 y) { return red16(x.x * y.x + x.y * y.y + x.z * y.z + x.w * y.w); }
__device__ __forceinline__ v2u pk4(const f32x4 v) { return (v2u){pk2(v.x, v.y), pk2(v.z, v.w)}; }
__device__ __forceinline__ f32x4 unpk4(const v2u w) { return (f32x4){bflo(w.x), bfhi(w.x), bflo(w.y), bfhi(w.y)}; }

__device__ __forceinline__ void rwkv_unit(const int wv, LAS unsigned char* lds, int o, int b, int h) {
    const ArgsP a = get_args();
#ifdef NO_RWKV
    return;
#endif
    OPAQUE_TID(); const int lane = tid & 63, fr = lane & 15, fq = lane >> 4;
    unsigned char* ws = a->ws;
    constexpr int NCH = SEQ / 32;
    if (wv < 4) {
        f32x4 S[4];
#pragma unroll
        for (int kt = 0; kt < 4; ++kt) S[kt] = (f32x4){0.f, 0.f, 0.f, 0.f};
        const int row = 16 * wv + fr;
        const bool f0 = fq == 0;
        struct Ops { v2u kq[4], rq[4]; f32x4 tab[8], vv, w4[4]; v4u xu[4]; };
        auto load_ops = [&](const LAS unsigned char* B, int bk, Ops& o) {
            const LAS unsigned char* kp = B + RK_KQ + bk * 512 + (fr & 3) * 128 + 8 * fq; const LAS unsigned char* rp = kp + (RK_RQ - RK_KQ);
#pragma unroll
            for (int ks = 0; ks < 2; ++ks) { o.kq[2 * ks] = *(const LAS v2u*)(kp + 64 * ks); o.kq[2 * ks + 1] = *(const LAS v2u*)(kp + 64 * ks + 32); o.rq[2 * ks] = *(const LAS v2u*)(rp + 64 * ks); o.rq[2 * ks + 1] = *(const LAS v2u*)(rp + 64 * ks + 32); }
#pragma unroll
            for (int i = 0; i < 8; ++i) o.tab[i] = *(const LAS f32x4*)(B + RK_TAB + bk * 128 + 16 * i);
            o.vv = *(const LAS f32x4*)(B + RK_VB + bk * 1024 + row * 16);
#pragma unroll
            for (int kt = 0; kt < 4; ++kt) { o.w4[kt] = *(const LAS f32x4*)(B + RK_W4 + bk * 256 + (16 * kt + 4 * fq) * 4); o.xu[kt] = *(const LAS v4u*)(B + RK_XU + bk * 1024 + (16 * kt + fr) * 16); } };
        auto step = [&](const Ops& o, f32x4& yout) {
            bf16x8 ys[2];
#pragma unroll
            for (int ks = 0; ks < 2; ++ks) { const v4u w = {pk2(S[2 * ks][0], S[2 * ks][1]), pk2(S[2 * ks][2], S[2 * ks][3]), pk2(S[2 * ks + 1][0], S[2 * ks + 1][1]), pk2(S[2 * ks + 1][2], S[2 * ks + 1][3])}; ys[ks] = __builtin_bit_cast(bf16x8, w); }
            f32x4 du = {0.f, 0.f, 0.f, 0.f}, dy = {0.f, 0.f, 0.f, 0.f};
#pragma unroll
            for (int ks = 0; ks < 2; ++ks) {
                du = __builtin_amdgcn_mfma_f32_16x16x32_bf16(__builtin_bit_cast(bf16x8, (v4u){o.kq[2 * ks].x, o.kq[2 * ks].y, o.kq[2 * ks + 1].x, o.kq[2 * ks + 1].y}), ys[ks], du, 0, 0, 0);
                dy = __builtin_amdgcn_mfma_f32_16x16x32_bf16(__builtin_bit_cast(bf16x8, (v4u){o.rq[2 * ks].x, o.rq[2 * ks].y, o.rq[2 * ks + 1].x, o.rq[2 * ks + 1].y}), ys[ks], dy, 0, 0, 0); }
            const f32x4 t0 = o.tab[0], t1 = o.tab[1], t2 = o.tab[2], t3 = o.tab[3], t4 = o.tab[4], t5 = o.tab[5], t6 = o.tab[6], t7 = o.tab[7]; const f32x4 vv = o.vv;
            const float u0 = du[0];
            const float u1 = du[1] + vv.x * t0.x - u0 * t0.y;
            const float u2 = du[2] + vv.x * t0.z - u0 * t1.x + vv.y * t0.w - u1 * t1.y;
            const float u3 = du[3] + vv.x * t1.z - u0 * t2.y + vv.y * t1.w - u1 * t2.z + vv.z * t2.x - u2 * t2.w;
            yout.x = dy[0] + vv.x * t3.x - u0 * t3.y;
            yout.y = dy[1] + vv.x * t3.z - u0 * t4.x + vv.y * t3.w - u1 * t4.y;
            yout.z = dy[2] + vv.x * t4.z - u0 * t5.y + vv.y * t4.w - u1 * t5.z + vv.z * t5.x - u2 * t5.w;
            yout.w = dy[3] + vv.x * t6.x - u0 * t7.x + vv.y * t6.y - u1 * t7.y + vv.z * t6.z - u2 * t7.z + vv.w * t6.w - u3 * t7.w;
            v4u yw = {pk2(vv.x, vv.y), pk2(vv.z, vv.w), pk2(u0, u1), pk2(u2, u3)};
            if (!f0) yw = (v4u){0u, 0u, 0u, 0u};
            const bf16x8 yop = __builtin_bit_cast(bf16x8, yw);
#pragma unroll
            for (int kt = 0; kt < 4; ++kt) { v4u xw = o.xu[kt]; if (!f0) xw = (v4u){0u, 0u, 0u, 0u};
                S[kt] = __builtin_amdgcn_mfma_f32_16x16x32_bf16(__builtin_bit_cast(bf16x8, xw), yop, S[kt] * o.w4[kt], 0, 0, 0); } };
        __syncthreads();
        for (int c = 0; c < NCH; ++c) {
            const LAS unsigned char* B = lds + (c & 1) * RK_CBUF; LAS float* yb = (LAS float*)(lds + RK_Y0 + (c & 1) * RK_YSZ) + row * 36;
            Ops oa, ob; f32x4 yk[8];
            load_ops(B, 0, oa);
#pragma unroll
            for (int bp = 0; bp < 4; ++bp) { load_ops(B, 2 * bp + 1, ob); step(oa, yk[2 * bp]); if (bp < 3) load_ops(B, 2 * bp + 2, oa); step(ob, yk[2 * bp + 1]); }
            if (f0) {
#pragma unroll
                for (int bk = 0; bk < 8; ++bk) *(LAS f32x4*)(yb + 4 * bk) = yk[bk]; }
            __syncthreads();
        }
    } else if (wv < 6) {
        const int ptid = tid - 256, g8 = ptid >> 4, kq = ptid & 15;
        const size_t rowbase = (size_t)b * SEQ * 2048 + h * 64 + 4 * kq;
        const bf16* Rb = (const bf16*)(ws + WS_RKV) + rowbase; const bf16* Kb = Rb + (size_t)T_ * 2048; const bf16* Vb = Kb + (size_t)T_ * 2048;
        const bf16* Gb = (const bf16*)(ws + WS_G) + rowbase; const bf16* WDb = (const bf16*)(ws + WS_WD) + rowbase; const bf16* AAb = (const bf16*)(ws + WS_AA) + rowbase;
        const int pc = h * 64 + 4 * kq;
        const f32x4 p_kk = *(const f32x4*)(a->in[20] + (size_t)o * 2048 + pc), p_ka = *(const f32x4*)(a->in[21] + (size_t)o * 2048 + pc), p_rk = *(const f32x4*)(a->in[22] + (size_t)o * 2048 + pc);
        v2u gk[4], ga[4], gw[4], gr[4], gv[4], gg[4];
        auto gload = [&](int c) {
#pragma unroll
            for (int j = 0; j < 4; ++j) { const size_t off = (size_t)(32 * c + 4 * g8 + j) * 2048;
                gk[j] = *(const v2u*)(Kb + off); ga[j] = *(const v2u*)(AAb + off); gw[j] = *(const v2u*)(WDb + off); gr[j] = *(const v2u*)(Rb + off); gv[j] = *(const v2u*)(Vb + off); gg[j] = *(const v2u*)(Gb + off); } };
        v2u hk[4], ha[4], hw[4], hr[4], hv[4], hg[4];
        auto take = [&]() {
#pragma unroll
            for (int j = 0; j < 4; ++j) { hk[j] = gk[j]; ha[j] = ga[j]; hw[j] = gw[j]; hr[j] = gr[j]; hv[j] = gv[j]; hg[j] = gg[j]; } };
        auto prep = [&](int c) {
            LAS unsigned char* B = lds + (c & 1) * RK_CBUF; LAS unsigned char* P = lds + RK_PB0 + (c % 3) * RK_PBSZ;
            f32x4 kk[4], bbv[4], kh[4], w[4], r[4], v[4];
#pragma unroll
            for (int j = 0; j < 4; ++j) { const f32x4 k = unpk4(hk[j]), aa = unpk4(ha[j]), wd = unpk4(hw[j]); r[j] = unpk4(hr[j]); v[j] = unpk4(hv[j]);
                const f32x4 kx = k * p_kk; const float inv = __builtin_amdgcn_rsqf(fmaxf(dot16(kx, kx), 1e-24f)); kk[j] = kx * inv; bbv[j] = kk[j] * aa; kh[j] = k * (1.f + (aa - 1.f) * p_ka);
                w[j] = (f32x4){__expf(wd.x), __expf(wd.y), __expf(wd.z), __expf(wd.w)};
                const float bon = dot16(r[j] * kh[j], p_rk);
                *(LAS f32x4*)(P + RK_PG + ((4 * g8 + j) * 64 + 4 * kq) * 4) = unpk4(hg[j]); *(LAS f32x4*)(P + RK_PV + ((4 * g8 + j) * 64 + 4 * kq) * 4) = v[j];
                if (kq == 0) *(LAS float*)(P + RK_PBON + (4 * g8 + j) * 4) = bon; }
            const f32x4 W1 = w[0], W2 = w[0] * w[1], W3 = W2 * w[2], W4 = W3 * w[3];
            const f32x4 i1 = {__builtin_amdgcn_rcpf(W1.x), __builtin_amdgcn_rcpf(W1.y), __builtin_amdgcn_rcpf(W1.z), __builtin_amdgcn_rcpf(W1.w)}, i2 = {__builtin_amdgcn_rcpf(W2.x), __builtin_amdgcn_rcpf(W2.y), __builtin_amdgcn_rcpf(W2.z), __builtin_amdgcn_rcpf(W2.w)},
                        i3 = {__builtin_amdgcn_rcpf(W3.x), __builtin_amdgcn_rcpf(W3.y), __builtin_amdgcn_rcpf(W3.z), __builtin_amdgcn_rcpf(W3.w)}, i4 = {__builtin_amdgcn_rcpf(W4.x), __builtin_amdgcn_rcpf(W4.y), __builtin_amdgcn_rcpf(W4.z), __builtin_amdgcn_rcpf(W4.w)};
            const f32x4 hh0 = kh[0] * i1, hh1 = kh[1] * i2, hh2 = kh[2] * i3, hh3 = kh[3] * i4, bh0 = bbv[0] * i1, bh1 = bbv[1] * i2, bh2 = bbv[2] * i3, bh3 = bbv[3] * i4;
            *(LAS v2u*)(B + RK_KQ + g8 * 512 + 0 * 128 + 8 * kq) = pk4(kk[0]);      *(LAS v2u*)(B + RK_RQ + g8 * 512 + 0 * 128 + 8 * kq) = pk4(r[0] * W1);
            *(LAS v2u*)(B + RK_KQ + g8 * 512 + 1 * 128 + 8 * kq) = pk4(kk[1] * W1); *(LAS v2u*)(B + RK_RQ + g8 * 512 + 1 * 128 + 8 * kq) = pk4(r[1] * W2);
            *(LAS v2u*)(B + RK_KQ + g8 * 512 + 2 * 128 + 8 * kq) = pk4(kk[2] * W2); *(LAS v2u*)(B + RK_RQ + g8 * 512 + 2 * 128 + 8 * kq) = pk4(r[2] * W3);
            *(LAS v2u*)(B + RK_KQ + g8 * 512 + 3 * 128 + 8 * kq) = pk4(kk[3] * W3); *(LAS v2u*)(B + RK_RQ + g8 * 512 + 3 * 128 + 8 * kq) = pk4(r[3] * W4);
            { LAS unsigned char* xs = lds + RK_XS + (wv - 4) * 4096 + (lane >> 4) * 1024 + 8 * kq;
              *(LAS v2u*)(xs + 0 * 128) = pk4(hh0); *(LAS v2u*)(xs + 1 * 128) = pk4(hh1); *(LAS v2u*)(xs + 2 * 128) = pk4(hh2); *(LAS v2u*)(xs + 3 * 128) = pk4(hh3);
              *(LAS v2u*)(xs + 4 * 128) = pk4(bh0); *(LAS v2u*)(xs + 5 * 128) = pk4(bh1); *(LAS v2u*)(xs + 6 * 128) = pk4(bh2); *(LAS v2u*)(xs + 7 * 128) = pk4(bh3); }
            { const f32x4 hw0 = hh0 * W4, hw1 = hh1 * W4, hw2 = hh2 * W4, hw3 = kh[3], bw0 = bh0 * W4, bw1 = bh1 * W4, bw2 = bh2 * W4, bw3 = bbv[3];
#pragma unroll
              for (int i = 0; i < 4; ++i) *(LAS v4u*)(B + RK_XU + g8 * 1024 + (4 * kq + i) * 16) = (v4u){pk2(hw0[i], hw1[i]), pk2(hw2[i], hw3[i]), pk2(-bw0[i], -bw1[i]), pk2(-bw2[i], -bw3[i])};
              *(LAS f32x4*)(B + RK_W4 + g8 * 256 + 16 * kq) = W4;
#pragma unroll
              for (int i = 0; i < 4; ++i) *(LAS f32x4*)(B + RK_VB + g8 * 1024 + (4 * kq + i) * 16) = (f32x4){v[0][i], v[1][i], v[2][i], v[3][i]}; }
            asm volatile("s_waitcnt lgkmcnt(0)" ::: "memory");
            { const int fr = lane & 15, fq = lane >> 4;
#pragma unroll
              for (int p = 0; p < 2; ++p) { const int grp = 2 * p + (fr >> 3), rw = fr & 7, blk = 4 * (wv - 4) + grp;
                  const LAS unsigned char* xp = lds + RK_XS + (wv - 4) * 4096 + grp * 1024 + rw * 128 + 16 * fq;
                  const LAS unsigned char* yp = B + ((rw < 4) ? RK_KQ + blk * 512 + rw * 128 : RK_RQ + blk * 512 + (rw - 4) * 128) + 16 * fq;
                  f32x4 d = {0.f, 0.f, 0.f, 0.f};
                  d = __builtin_amdgcn_mfma_f32_16x16x32_bf16(*(const LAS bf16x8*)xp, *(const LAS bf16x8*)yp, d, 0, 0, 0);
                  d = __builtin_amdgcn_mfma_f32_16x16x32_bf16(*(const LAS bf16x8*)(xp + 64), *(const LAS bf16x8*)(yp + 64), d, 0, 0, 0);
                  if ((fr >> 3) == (fq >> 1) && rw >= 1) { const int cnt = (rw < 4) ? rw : rw - 3; const int base = (rw == 1) ? 0 : (rw == 2) ? 2 : (rw == 3) ? 6 : (rw == 4) ? 12 : (rw == 5) ? 14 : (rw == 6) ? 18 : 24;
                      LAS float* tp = (LAS float*)(B + RK_TAB + blk * 128) + base + (fq & 1) * cnt;
                      tp[0] = d[0]; if (cnt > 1) tp[1] = d[1]; if (cnt > 2) tp[2] = d[2]; if (cnt > 3) tp[3] = d[3]; } } }
            asm volatile("" ::: "memory");
        };
        gload(0); take(); gload(1); prep(0);
        __syncthreads();
        for (int c = 0; c < NCH; ++c) {
            if (c + 1 < NCH) { take(); if (c + 2 < NCH) gload(c + 2); prep(c + 1); }
            __syncthreads();
        }
    } else {
        const int qtid = tid - 384, st = qtid >> 2, rq = qtid & 3;
        bf16* Yb = (bf16*)(ws + WS_YO) + (size_t)b * SEQ * 2048 + h * 64 + 16 * rq;
        const float* lg = a->in[23] + (size_t)o * 2048 + h * 64 + 16 * rq; const float* lb = a->in[24] + (size_t)o * 2048 + h * 64 + 16 * rq;
        auto post = [&](int c) {
            const LAS float* yb = (const LAS float*)(lds + RK_Y0 + (c & 1) * RK_YSZ); const LAS unsigned char* P = lds + RK_PB0 + (c % 3) * RK_PBSZ;
            float y[16]; float s1 = 0.f;
#pragma unroll
            for (int i = 0; i < 16; ++i) { y[i] = yb[(16 * rq + i) * 36 + st]; s1 += y[i]; }
            s1 += dppf<0xB1>(s1); s1 += dppf<0x4E>(s1); const float mean = s1 * (1.f / 64.f); float s2 = 0.f;
#pragma unroll
            for (int i = 0; i < 16; ++i) { y[i] -= mean; s2 += y[i] * y[i]; }
            s2 += dppf<0xB1>(s2); s2 += dppf<0x4E>(s2); const float rstd = 1.f / sqrtf(s2 * (1.f / 64.f) + 64e-5f);
            const float bon = *(const LAS float*)(P + RK_PBON + st * 4);
            unsigned ow[8];
#pragma unroll
            for (int i4 = 0; i4 < 4; ++i4) { const f32x4 g = *(const LAS f32x4*)(P + RK_PG + (st * 64 + 16 * rq + 4 * i4) * 4), v = *(const LAS f32x4*)(P + RK_PV + (st * 64 + 16 * rq + 4 * i4) * 4);
                const f32x4 lgv = *(const f32x4*)(lg + 4 * i4), lbv = *(const f32x4*)(lb + 4 * i4); float o4[4];
#pragma unroll
                for (int i = 0; i < 4; ++i) o4[i] = (y[4 * i4 + i] * rstd * lgv[i] + lbv[i] + bon * v[i]) * g[i];
                ow[2 * i4] = pk2(o4[0], o4[1]); ow[2 * i4 + 1] = pk2(o4[2], o4[3]); }
            v4u* dst = (v4u*)(Yb + (size_t)(32 * c + st) * 2048); dst[0] = (v4u){ow[0], ow[1], ow[2], ow[3]}; dst[1] = (v4u){ow[4], ow[5], ow[6], ow[7]};
        };
        __syncthreads();
        for (int c = 0; c < NCH; ++c) {
            if (c >= 1) post(c - 1);
            __syncthreads();
        }
        post(NCH - 1);
    }
    __syncthreads();
}

__device__ __forceinline__ void ln_router(const int wv, int l) {
    const ArgsP a = get_args();
#ifdef NO_ROUTER
    return;
#endif
    OPAQUE_TID(); const int lane = tid & 63, wave = tid >> 6;
    unsigned char* ws = a->ws;
    const float* lg = a->in[28] + (size_t)l * 2048; const float* lb = a->in[29] + (size_t)l * 2048;
    const float* Wg = a->in[32] + (size_t)l * 2048 * 4; const float* bg = a->in[33] + l * 4; const float* We = a->in[34] + (size_t)l * 2048 * 32; const float* be = a->in[35] + l * 32;
    unsigned* cnt = (unsigned*)(ws + WS_CTL) + CW_CNT + (size_t)l * 32 * 64;
    int* TOKE = (int*)(ws + WS_TOKE); int* TOKR = (int*)(ws + WS_TOKR); float* TOKG = (float*)(ws + WS_TOKG);
    const int gw = blockIdx.x * NWAVES + wave, NGW = gridDim.x * NWAVES;
    for (int m = gw; m < T_; m += NGW) {
        f32x4* xr = (f32x4*)(a->out + (size_t)m * D_) + lane; f32x4 v[8]; float s = 0.f;
#pragma unroll
        for (int j = 0; j < 8; ++j) { v[j] = xr[64 * j]; s += (v[j].x + v[j].y) + (v[j].z + v[j].w); }
        const float mean = wave_sum(s) * (1.f / D_); float s2 = 0.f;
#pragma unroll
        for (int j = 0; j < 8; ++j) { v[j] = v[j] - mean; s2 += (v[j].x * v[j].x + v[j].y * v[j].y) + (v[j].z * v[j].z + v[j].w * v[j].w); }
        const float rstd = 1.f / sqrtf(wave_sum(s2) * (1.f / D_) + LN_EPS);
        float ag[4] = {0, 0, 0, 0};
#pragma unroll
        for (int j = 0; j < 8; ++j) { const f32x4 g = ((const f32x4*)lg)[lane + 64 * j], bb = ((const f32x4*)lb)[lane + 64 * j]; v[j] = v[j] * rstd * g + bb; xr[64 * j] = v[j];
            ((v2u*)(ws + WS_XB))[(size_t)m * 512 + lane + 64 * j] = (v2u){pk2(v[j].x, v[j].y), pk2(v[j].z, v[j].w)};
            const f32x4* wp = (const f32x4*)Wg + 4 * (lane + 64 * j);
#pragma unroll
            for (int i = 0; i < 4; ++i) { const f32x4 w = wp[i]; const float x = v[j][i]; ag[0] += x * w.x; ag[1] += x * w.y; ag[2] += x * w.z; ag[3] += x * w.w; } }
#pragma unroll
        for (int i = 0; i < 4; ++i) ag[i] = wave_sum(ag[i]) + bg[i];
        int gi = 0; float gm = ag[0];
#pragma unroll
        for (int i = 1; i < 4; ++i) if (ag[i] > gm) { gm = ag[i]; gi = i; }
        float gs = 0.f;
#pragma unroll
        for (int i = 0; i < 4; ++i) gs += __expf(ag[i] - gm);
        const float gp = 1.f / gs;
        float ae[8] = {0, 0, 0, 0, 0, 0, 0, 0};
#pragma unroll
        for (int j = 0; j < 8; ++j) {
#pragma unroll
            for (int i = 0; i < 4; ++i) { const float* wr = We + (size_t)(4 * (lane + 64 * j) + i) * 32 + 8 * gi; const f32x4 w0 = *(const f32x4*)wr, w1 = *(const f32x4*)(wr + 4); const float x = v[j][i];
                ae[0] += x * w0.x; ae[1] += x * w0.y; ae[2] += x * w0.z; ae[3] += x * w0.w; ae[4] += x * w1.x; ae[5] += x * w1.y; ae[6] += x * w1.z; ae[7] += x * w1.w; } }
#pragma unroll
        for (int i = 0; i < 8; ++i) ae[i] = wave_sum(ae[i]) + be[8 * gi + i];
        int e1 = 0; float m1 = ae[0];
#pragma unroll
        for (int i = 1; i < 8; ++i) if (ae[i] > m1) { m1 = ae[i]; e1 = i; }
        int e2 = -1; float m2 = -3.0e38f;
#pragma unroll
        for (int i = 0; i < 8; ++i) if (i != e1 && ae[i] > m2) { m2 = ae[i]; e2 = i; }
        const float p2 = __expf(m2 - m1), den = 1.f / (1.f + p2);
        if (lane == 0) { const int x1 = 8 * gi + e1, x2 = 8 * gi + e2;
            const unsigned r1 = __hip_atomic_fetch_add(cnt + x1 * 64, 1u, __ATOMIC_RELAXED, __HIP_MEMORY_SCOPE_AGENT);
            const unsigned r2 = __hip_atomic_fetch_add(cnt + x2 * 64, 1u, __ATOMIC_RELAXED, __HIP_MEMORY_SCOPE_AGENT);
            TOKE[2 * m] = x1; TOKE[2 * m + 1] = x2; TOKR[2 * m] = (int)r1; TOKR[2 * m + 1] = (int)r2; TOKG[2 * m] = gp * den; TOKG[2 * m + 1] = gp * p2 * den; }
    }
}

struct MoeTab { LAS int* start; LAS int* tileE; LAS int* ntiles; };
__device__ __forceinline__ MoeTab moe_tables(const int wv, int l, LAS unsigned char* lds) {
    const ArgsP a = get_args();
    MoeTab t; t.start = (LAS int*)(lds + MISC_OFF + 256); t.tileE = t.start + 40; t.ntiles = t.tileE + 168;
    OPAQUE_TID();
    if (tid == 0) { unsigned* cnt = (unsigned*)(a->ws + WS_CTL) + CW_CNT + (size_t)l * 32 * 64; int acc = 0;
        for (int e = 0; e < 32; ++e) { const int c = (int)__hip_atomic_load(cnt + e * 64, __ATOMIC_RELAXED, __HIP_MEMORY_SCOPE_AGENT); const int pad = (c + 255) & ~255;
            t.start[e] = acc; for (int q = acc >> 8; q < ((acc + pad) >> 8) && q < MOE_TILES; ++q) t.tileE[q] = e; acc += pad; }
        int nt = acc >> 8; if (nt > MOE_TILES) nt = MOE_TILES; *t.ntiles = nt; }
    __syncthreads();
    return t;
}
__device__ __forceinline__ void moe_gather(const int wv, const MoeTab& tb) {
    const ArgsP a = get_args();
#ifdef NO_GATHER
    return;
#endif
    OPAQUE_TID(); const int lane = tid & 63, wave = tid >> 6;
    unsigned char* ws = a->ws;
    const int* TOKE = (const int*)(ws + WS_TOKE); const int* TOKR = (const int*)(ws + WS_TOKR); int* SLOT = (int*)(ws + WS_SLOT);
    const int gw = blockIdx.x * NWAVES + wave, NGW = gridDim.x * NWAVES;
    for (int it = gw; it < 2 * T_; it += NGW) { const int m = it >> 1; const int dest = tb.start[TOKE[it]] + TOKR[it];
        if (lane == 0) SLOT[it] = dest;
        const v4u* src = (const v4u*)(ws + WS_XB) + (size_t)m * 256 + lane; v4u* dst = (v4u*)(ws + WS_XS) + (size_t)dest * 256 + lane;
#pragma unroll
        for (int j = 0; j < 4; ++j) dst[64 * j] = src[64 * j]; }
}
template <int NJ> struct MoeOrder {
    LAS int* tileE; int nunits, G, c;
    __device__ bool next(int i, pg8::Unit& u) const { const int L = i * G + c; if (L >= nunits) return false; u.pm = L / NJ; u.pn = tileE[u.pm] * NJ + (L % NJ); u.aoff = 0; return true; }
    __device__ __forceinline__ void a_ready(const pg8::Unit&) const {}
    __device__ __forceinline__ void done(const pg8::Unit&) const {}
};
__device__ __forceinline__ void moe_combine_ln(const int wv, int l) {
    const ArgsP a = get_args();
#ifdef NO_COMBINE
    return;
#endif
    OPAQUE_TID(); const int lane = tid & 63, wave = tid >> 6;
    unsigned char* ws = a->ws;
    const float* lg = a->in[30] + (size_t)l * 2048; const float* lb = a->in[31] + (size_t)l * 2048;
    const int* SLOT = (const int*)(ws + WS_SLOT); const float* TOKG = (const float*)(ws + WS_TOKG); const bf16* YS = (const bf16*)(ws + WS_YS);
    const int gw = blockIdx.x * NWAVES + wave, NGW = gridDim.x * NWAVES;
    for (int m = gw; m < T_; m += NGW) {
        f32x4* xr = (f32x4*)(a->out + (size_t)m * D_) + lane; f32x4 v[8]; float s = 0.f;
        const int s0 = SLOT[2 * m], s1 = SLOT[2 * m + 1]; const float g0 = TOKG[2 * m], g1 = TOKG[2 * m + 1];
        const v2u* y0 = (const v2u*)(YS + (size_t)s0 * 2048) + lane; const v2u* y1 = (const v2u*)(YS + (size_t)s1 * 2048) + lane;
#pragma unroll
        for (int j = 0; j < 8; ++j) { const f32x4 x = xr[64 * j]; const v2u a0 = y0[64 * j], a1 = y1[64 * j];
            v[j].x = DN_ALPHA * x.x + g0 * bflo(a0.x) + g1 * bflo(a1.x); v[j].y = DN_ALPHA * x.y + g0 * bfhi(a0.x) + g1 * bfhi(a1.x);
            v[j].z = DN_ALPHA * x.z + g0 * bflo(a0.y) + g1 * bflo(a1.y); v[j].w = DN_ALPHA * x.w + g0 * bfhi(a0.y) + g1 * bfhi(a1.y);
            s += (v[j].x + v[j].y) + (v[j].z + v[j].w); }
        const float mean = wave_sum(s) * (1.f / D_); float s2 = 0.f;
#pragma unroll
        for (int j = 0; j < 8; ++j) { v[j] = v[j] - mean; s2 += (v[j].x * v[j].x + v[j].y * v[j].y) + (v[j].z * v[j].z + v[j].w * v[j].w); }
        const float rstd = 1.f / sqrtf(wave_sum(s2) * (1.f / D_) + LN_EPS);
#pragma unroll
        for (int j = 0; j < 8; ++j) { const f32x4 g = ((const f32x4*)lg)[lane + 64 * j], bb = ((const f32x4*)lb)[lane + 64 * j]; v[j] = v[j] * rstd * g + bb; xr[64 * j] = v[j];
            ((v2u*)(ws + WS_XB))[(size_t)m * 512 + lane + 64 * j] = (v2u){pk2(v[j].x, v[j].y), pk2(v[j].z, v[j].w)}; }
    }
}

struct RkvOrder {
    pg8::StaticOrder in; int G, c;
    __device__ bool next(int i, pg8::Unit& u) const { const long L = (long)i * G + c; if (L >= 1536) return false; const int g = (int)(L / 512);
        in.at(L % 512, u); u.pm += 64 * g; u.pn += 8 * g; return true; }
    __device__ __forceinline__ void a_ready(const pg8::Unit&) const {}
    __device__ __forceinline__ void done(const pg8::Unit&) const {}
};
struct L2Order {
    int nunits, G, c;
    __device__ bool next(int i, pg8::Unit& u) const { const int L = i * G + c; if (L >= nunits) return false; u.pn = L >> 6; u.pm = L & 63; u.aoff = (u.pn >= 8) ? 512 : 0; return true; }
    __device__ __forceinline__ void a_ready(const pg8::Unit&) const {}
    __device__ __forceinline__ void done(const pg8::Unit&) const {}
};


#ifndef REP_PROL
#define REP_PROL 1
#endif
#ifndef REP_INPROJ
#define REP_INPROJ 1
#endif
#ifndef REP_ATTN
#define REP_ATTN 1
#endif
#ifndef REP_MLSTM
#define REP_MLSTM 1
#endif
#ifndef REP_HNORM
#define REP_HNORM 1
#endif
#ifndef REP_OPREP
#define REP_OPREP 1
#endif
#ifndef REP_RKV
#define REP_RKV 1
#endif
#ifndef REP_RWKV
#define REP_RWKV 1
#endif
#ifndef REP_GATHER
#define REP_GATHER 1
#endif
#ifndef REP_GU
#define REP_GU 1
#endif
#ifndef REP_DN
#define REP_DN 1
#endif
#define REPX_1(...) __VA_ARGS__
#define REPX_2(...) __VA_ARGS__ __VA_ARGS__
#define REPX_3(...) __VA_ARGS__ __VA_ARGS__ __VA_ARGS__
#define REPX_(n, ...) REPX_##n(__VA_ARGS__)
#define REPX(n, ...) REPX_(n, __VA_ARGS__)

constexpr int N_PHASES = 41;

__global__ void __launch_bounds__(NTHR, 2) fwd(Args args) {
    extern __shared__ __attribute__((aligned(16))) unsigned char lds_raw[];
    LAS unsigned char* lds = (LAS unsigned char*)lds_raw;
    const int wv = __builtin_amdgcn_readfirstlane((int)threadIdx.x >> 6);
    OPAQUE_TID();
    const ArgsP ap0 = get_args();
    if (tid < 16) ((LAS unsigned*)(lds + MISC_OFF))[tid] = 0u;
    __syncthreads();
#if ONE_LAUNCH
    XcdBarrier bar = xcd_barrier_post((unsigned*)(ap0->ws + WS_CTL) + CW_BAR, (volatile LAS unsigned*)(lds + MISC_OFF), tid == 0);
#define SEAM(k) do { if ((k) + 1 < hi) xcd_barrier(bar, tid == 0); } while (0)
#define SEAMR() xcd_barrier(bar, tid == 0)
#else
#define SEAM(k) do { } while (0)
#define SEAMR() do { } while (0)
#endif
    const int lo = ap0->ph_lo, hi = ap0->ph_hi;
#define IN(k) (lo <= (k) && (k) < hi)
    const int G = gridDim.x, cb = blockIdx.x;

    if (IN(0)) { REPX(REP_PROL, { prologue(wv, lds); SEAMR(); }) }

    auto layer = [&](auto lc) __attribute__((always_inline)) { constexpr int l = decltype(lc)::value;
        const int pb = 1 + 10 * l, eo = l >> 1;
        if ((l & 1) == 0) {
            if (IN(pb + 0)) {
                const ArgsP ap = get_args(); unsigned char* ws = ap->ws;
                pg8::Gemm g{(const bf16*)(ws + WS_XB), (const bf16*)(ws + WS_WIN) + (size_t)eo * ZW * 2048, 2048, 2048, 2048};
                pg8::StaticOrder S; S.init(T_, ZW, G, cb);
                pg8::EpiBf16 E{(bf16*)(ws + WS_Z), ZW, 0, 0, 0, nullptr};
                REPX(REP_INPROJ, { pg8::gemm_phase<pg8::EpiBf16, pg8::StaticOrder, true, false>(wv, lds, g, S, E); SEAMR(); })
            }
            if (IN(pb + 1)) { for (int u = cb; u < 256; u += G) even_prep(wv, eo, lds, u); SEAM(pb + 1); }
            if (IN(pb + 2)) {
                REPX(REP_ATTN, { for (int L = cb; L < 1024; L += G) { const int i = L >> 8, c = L & 255; const int qt = (i & 1) ? (24 - 8 * i + (c >> 5)) : (31 - 8 * i - (c >> 5)); const int bh = c & 31;
                    attn_unit(wv, lds, bh >> 3, bh & 7, qt); } })
                REPX(REP_MLSTM, { mlstm_scan(wv); })
                SEAM(pb + 2);
            }
            if (IN(pb + 3)) { REPX(REP_HNORM, { for (int u = cb; u < 1024; u += G) mlstm_out_unit(wv, lds, eo, u >> 8, (u >> 6) & 3, u & 63); SEAMR(); }) }
        } else {
            if (IN(pb + 0)) { REPX(REP_OPREP, { odd_prep(wv, eo); SEAMR(); }) }
            if (IN(pb + 1)) {
                const ArgsP ap = get_args(); unsigned char* ws = ap->ws;
                { pg8::Gemm g{(const bf16*)(ws + WS_XRKV), (const bf16*)(ws + WS_WRKV) + (size_t)eo * 3 * 2048 * 2048, 2048, 2048, 2048};
                  RkvOrder S; S.in.init(T_, 2048, G, cb); S.G = G; S.c = cb;
                  pg8::EpiBf16 E{(bf16*)(ws + WS_RKV), 2048, 64, 8, (size_t)T_ * 2048, (eo == 0) ? (bf16*)(ws + WS_VF) : nullptr};
                  REPX(REP_RKV, { pg8::gemm_phase<pg8::EpiBf16, RkvOrder, true, false>(wv, lds, g, S, E); __syncthreads(); }) }
                __syncthreads();
                { pg8::Gemm g{(const bf16*)(ws + WS_XC), (const bf16*)(ws + WS_WL1) + (size_t)eo * 512 * 4096, 4096, 4096, 4096};
                  pg8::StaticOrder S; S.init(T_, 512, G, cb);
                  pg8::EpiL1 E{(bf16*)(ws + WS_L1)};
                  pg8::gemm_phase<pg8::EpiL1, pg8::StaticOrder, true, false>(wv, lds, g, S, E); }
                SEAM(pb + 1);
            }
            if (IN(pb + 2)) {
                const ArgsP ap = get_args(); unsigned char* ws = ap->ws;
                pg8::Gemm g{(const bf16*)(ws + WS_L1), (const bf16*)(ws + WS_WL2) + (size_t)eo * 8192 * 256, 256, 512, 256};
                L2Order S{(eo == 0 ? 24 : 32) * 64, G, cb};
                pg8::EpiL2 E{(bf16*)(ws + WS_G), (bf16*)(ws + WS_WD), (bf16*)(ws + WS_AA), (bf16*)(ws + WS_RKV) + (size_t)2 * T_ * 2048, (const bf16*)(ws + WS_VF),
                             ap->in[12] + (size_t)eo * 2048, ap->in[15] + (size_t)eo * 2048, ap->in[25]};
                pg8::gemm_phase<pg8::EpiL2, L2Order, true, false>(wv, lds, g, S, E);
                SEAM(pb + 2);
            }
            if (IN(pb + 3)) { REPX(REP_RWKV, { for (int u = cb; u < 128; u += G) rwkv_unit(wv, lds, eo, u >> 5, u & 31); SEAMR(); }) }
        }
        if (IN(pb + 4)) {
            const bool ev = (l & 1) == 0; const ArgsP ap = get_args(); unsigned char* ws = ap->ws;
            pg8::Gemm g{(const bf16*)(ws + (ev ? WS_YE : WS_YO)), (const bf16*)(ws + (ev ? WS_WOUT : WS_WO)) + (size_t)eo * 2048 * 2048, 2048, 2048, 2048};
            pg8::StaticOrder S; S.init(T_, 2048, G, cb);
            pg8::EpiResid E{ap->out, 2048, DN_ALPHA};
            pg8::gemm_phase<pg8::EpiResid, pg8::StaticOrder, true, false>(wv, lds, g, S, E);
            SEAM(pb + 4);
        }
        if (IN(pb + 5)) { ln_router(wv, l); SEAM(pb + 5); }
        if (IN(pb + 6)) { const MoeTab tb = moe_tables(wv, l, lds); REPX(REP_GATHER, { moe_gather(wv, tb); SEAMR(); }) }
        if (IN(pb + 7)) { const MoeTab tb = moe_tables(wv, l, lds); const ArgsP ap = get_args(); unsigned char* ws = ap->ws;
            pg8::Gemm g{(const bf16*)(ws + WS_XS), (const bf16*)(ws + WS_WGU) + (size_t)l * 32 * 1024 * 2048, 2048, 2048, 2048};
            MoeOrder<4> S{tb.tileE, *tb.ntiles * 4, G, cb};
            pg8::EpiSilu E{(bf16*)(ws + WS_HID)};
            REPX(REP_GU, { pg8::gemm_phase<pg8::EpiSilu, MoeOrder<4>, true, false>(wv, lds, g, S, E); SEAMR(); })
        }
        if (IN(pb + 8)) { const MoeTab tb = moe_tables(wv, l, lds); const ArgsP ap = get_args(); unsigned char* ws = ap->ws;
            pg8::Gemm g{(const bf16*)(ws + WS_HID), (const bf16*)(ws + WS_WDN) + (size_t)l * 32 * 2048 * 512, 512, 512, 512};
            MoeOrder<8> S{tb.tileE, *tb.ntiles * 8, G, cb};
            pg8::EpiBf16 E{(bf16*)(ws + WS_YS), 2048, 0, 8, 0, nullptr};
            REPX(REP_DN, { pg8::gemm_phase<pg8::EpiBf16, MoeOrder<8>, true, false>(wv, lds, g, S, E); SEAMR(); })
        }
        if (IN(pb + 9)) { moe_combine_ln(wv, l); SEAM(pb + 9); }
        };
    layer(std::integral_constant<int, 0>{}); layer(std::integral_constant<int, 1>{}); layer(std::integral_constant<int, 2>{}); layer(std::integral_constant<int, 3>{});
#undef IN
#undef SEAM
}

extern "C" void kernel_launch(void* const* d_in, const int* in_sizes, int n_in, void* d_out, int out_size, void* d_ws, size_t ws_size, hipStream_t stream) {
    static int grid = 0;
    if (grid == 0) {
        if (n_in != 39 || in_sizes[0] != T_ * D_ || out_size != T_ * D_ || ws_size < WS_END) {
            fprintf(stderr, "kernel_launch: unexpected problem: n_in %d in0 %d out %d ws %zu (need %zu)\n", n_in, n_in > 0 ? in_sizes[0] : -1, out_size, ws_size, (size_t)WS_END); grid = -1; return; }
        int dev = 0, cus = 0, per_cu = 0;
        if (hipGetDevice(&dev) != hipSuccess || hipDeviceGetAttribute(&cus, hipDeviceAttributeMultiprocessorCount, dev) != hipSuccess) { fprintf(stderr, "kernel_launch: device query failed\n"); grid = -1; return; }
        if (hipFuncSetAttribute((const void*)fwd, hipFuncAttributeMaxDynamicSharedMemorySize, LDS_BYTES) != hipSuccess) { fprintf(stderr, "kernel_launch: hipFuncSetAttribute failed\n"); grid = -1; return; }
        if (hipOccupancyMaxActiveBlocksPerMultiprocessor(&per_cu, (const void*)fwd, NTHR, LDS_BYTES) != hipSuccess || per_cu < 1)
            fprintf(stderr, "kernel_launch: note: occupancy query reports %d workgroups per CU\n", per_cu);
        (void)hipGetLastError();
        grid = cus;
    }
    if (grid < 0) return;
    if (hipMemsetAsync((char*)d_ws + WS_CTL, 0, CTL_ZERO_BYTES, stream) != hipSuccess) { fprintf(stderr, "kernel_launch: memset failed\n"); return; }
    Args a{};
    for (int i = 0; i < 39; ++i) a.in[i] = (const float*)d_in[i];
    a.out = (float*)d_out; a.ws = (unsigned char*)d_ws;
#if ONE_LAUNCH
    a.ph_lo = 0; a.ph_hi = N_PHASES;
    hipLaunchKernelGGL(fwd, dim3(grid), dim3(NTHR), LDS_BYTES, stream, a);
#else
    for (int p = 0; p < N_PHASES; ++p) { a.ph_lo = p; a.ph_hi = p + 1; hipLaunchKernelGGL(fwd, dim3(grid), dim3(NTHR), LDS_BYTES, stream, a); }
#endif
    const hipError_t le = hipPeekAtLastError();
    if (le != hipSuccess) fprintf(stderr, "kernel_launch: launch failed: %s\n", hipGetErrorName(le));
}
```

```cpp
#include <hip/hip_runtime.h>
#include <cstdio>
#include <cstdint>
#include <type_traits>

#ifndef ONE_LAUNCH
#define ONE_LAUNCH 1
#endif

#define LAS __attribute__((address_space(3)))
typedef unsigned short bf16;
typedef unsigned v4u __attribute__((ext_vector_type(4)));
typedef unsigned v2u __attribute__((ext_vector_type(2)));
typedef float f32x4 __attribute__((ext_vector_type(4)));
typedef float f32x2 __attribute__((ext_vector_type(2)));
typedef short bf16x8 __attribute__((ext_vector_type(8)));

__device__ __forceinline__ unsigned f2bf(float f) { unsigned u = __builtin_bit_cast(unsigned, f); return (u + 0x7fffu + ((u >> 16) & 1u)) >> 16; }
typedef __bf16 bf16x2_t __attribute__((ext_vector_type(2)));
__device__ __forceinline__ unsigned pk2(float lo, float hi) { const f32x2 v = {lo, hi}; return __builtin_bit_cast(unsigned, __builtin_convertvector(v, bf16x2_t)); }
__device__ __forceinline__ float bflo(unsigned w) { return __builtin_bit_cast(float, w << 16); }
__device__ __forceinline__ float bfhi(unsigned w) { return __builtin_bit_cast(float, w & 0xffff0000u); }
__device__ __forceinline__ float bf2f(bf16 h) { return __builtin_bit_cast(float, (unsigned)h << 16); }
__device__ __forceinline__ float sigmoidf_(float x) { return 1.f / (1.f + __expf(-x)); }
__device__ __forceinline__ float wave_sum(float v) {
#pragma unroll
    for (int o = 1; o < 64; o <<= 1) v += __shfl_xor(v, o);
    return v;
}
template <int CTRL> __device__ __forceinline__ float dppf(float x) { return __builtin_bit_cast(float, __builtin_amdgcn_mov_dpp(__builtin_bit_cast(int, x), CTRL, 0xf, 0xf, true)); }
__device__ __forceinline__ float red16(float x) { x += dppf<0xB1>(x); x += dppf<0x4E>(x); x += dppf<0x141>(x); x += dppf<0x128>(x); return x; }
__device__ __forceinline__ float max16(float x) { x = fmaxf(x, dppf<0xB1>(x)); x = fmaxf(x, dppf<0x4E>(x)); x = fmaxf(x, dppf<0x141>(x)); x = fmaxf(x, dppf<0x128>(x)); return x; }

__device__ __forceinline__ int lane_id_asm() { int l; asm volatile("v_mbcnt_lo_u32_b32 %0, -1, 0\n\tv_mbcnt_hi_u32_b32 %0, -1, %0" : "=v"(l)); return l; }
#define OPAQUE_TID() const int tid = wv * 64 + lane_id_asm()
typedef short v4i16_t __attribute__((ext_vector_type(4)));
__device__ __forceinline__ v2u tr_read(const LAS unsigned char* p) { return __builtin_bit_cast(v2u, __builtin_amdgcn_ds_read_tr16_b64_v4i16((LAS v4i16_t*)p)); }
#define LDS_WAIT() asm volatile("s_waitcnt lgkmcnt(0)" ::: "memory")
#define VM_WAIT() asm volatile("s_waitcnt vmcnt(0)" ::: "memory")

namespace pg8 {
#define PG8_LAS __attribute__((address_space(3)))
typedef unsigned short bf16_t;
typedef short bf16x8 __attribute__((ext_vector_type(8)));
typedef float f32x4 __attribute__((ext_vector_type(4)));
typedef unsigned u32x4 __attribute__((ext_vector_type(4)));
constexpr int BM = 256, BK = 64, HALF = 128, HTB = HALF * BK * 2  , STAGE_BYTES = 8 * HTB, NXCD = 8, WGM = 8;

__host__ __device__ __forceinline__ int lds_byte(int r, int c) { const int st = (r >> 4) * 2 + (c >> 5), rr = r & 15, cc = c & 31, ob = rr * 64 + cc * 2; return st * 1024 + (ob ^ (((ob >> 9) & 1) << 5)); }
__host__ __device__ __forceinline__ void stage_rc(int b, int& R, int& C) { const int st = b / 1024, sb = b % 1024, swz = sb ^ (((sb >> 9) & 1) << 5); R = (st >> 1) * 16 + swz / 64; C = (st & 1) * 32 + (swz % 64) / 2; }
__host__ __device__ __forceinline__ int perm32(int rho) { const int n = rho >> 4, i = rho & 15; return 8 * (i >> 2) + 4 * n + (i & 3); }

struct Unit { int pm, pn, aoff; };
struct Gemm { const bf16_t* A; const bf16_t* Bt; int K, lda, ldb; };

struct StaticOrder {
    int nM, nN, nwg, G, c;
    __device__ void init(int M, int N, int G_, int c_) { nM = M / BM; nN = N / BM; nwg = nM * nN; G = G_; c = c_; }
    __device__ bool next(int i, Unit& u) const { return at((long)i * G + c, u); }
    __device__ bool at(long L, Unit& u) const {
        if (L >= nwg) return false;
        int wgid = (int)L; { const int q = nwg / NXCD, r = nwg % NXCD, xcd = wgid % NXCD, off = wgid / NXCD; wgid = (xcd < r ? xcd * (q + 1) : r * (q + 1) + (xcd - r) * q) + off; }
        const int nig = WGM * nN, gid = wgid / nig, fm = gid * WGM, gsz = (nM - fm) < WGM ? (nM - fm) : WGM;
        u.pm = fm + ((wgid % nig) % gsz); u.pn = (wgid % nig) / gsz; u.aoff = 0; return true;
    }
    __device__ __forceinline__ void a_ready(const Unit&) const {}
    __device__ __forceinline__ void done(const Unit&) const {}
};

__device__ __forceinline__ unsigned cvt_pk_bf16(float lo, float hi) { unsigned r; asm volatile("v_cvt_pk_bf16_f32 %0, %1, %2" : "=v"(r) : "v"(lo), "v"(hi)); return r; }

struct EpiBf16 {
    static constexpr bool PERM = true, AFTER_DRAIN = false;
    bf16_t* O; int ldc; int pm_mod, pn_mod; size_t gstride; bf16_t* O2;
    __device__ __forceinline__ void operator()(const f32x4 (&acc)[2][2][4][2], const Unit& u, int wr, int wc, int fr, int fq) const {
        const int g = pm_mod ? u.pm / pm_mod : 0;
        const int row0 = (u.pm - g * pm_mod) * BM + wr * 64 + fr;
        const int col0 = (pn_mod ? (u.pn % pn_mod) : u.pn) * BM + wc * 32 + 8 * fq;
        bf16_t* base = O + (size_t)g * gstride;
        bf16_t* base2 = (O2 && g == 2) ? O2 : nullptr;
#pragma unroll
        for (int ai = 0; ai < 2; ++ai)
#pragma unroll
            for (int m = 0; m < 4; ++m) { const size_t ro = (size_t)(row0 + ai * HALF + m * 16) * ldc + col0;
#pragma unroll
                for (int bj = 0; bj < 2; ++bj) { const f32x4 v0 = acc[ai][bj][m][0], v1 = acc[ai][bj][m][1];
                    u32x4 w; w.x = cvt_pk_bf16(v0[0], v0[1]); w.y = cvt_pk_bf16(v0[2], v0[3]); w.z = cvt_pk_bf16(v1[0], v1[1]); w.w = cvt_pk_bf16(v1[2], v1[3]);
                    *(u32x4*)(base + ro + bj * HALF) = w; if (base2) *(u32x4*)(base2 + ro + bj * HALF) = w; } }
    }
};
struct EpiResid {
    static constexpr bool PERM = true, AFTER_DRAIN = false;
    float* X; int ldc; float alpha;
    __device__ __forceinline__ void operator()(const f32x4 (&acc)[2][2][4][2], const Unit& u, int wr, int wc, int fr, int fq) const {
        const int row0 = u.pm * BM + wr * 64 + fr, col0 = u.pn * BM + wc * 32 + 8 * fq;
#pragma unroll
        for (int ai = 0; ai < 2; ++ai)
#pragma unroll
            for (int m = 0; m < 4; ++m) { float* rowp = X + (size_t)(row0 + ai * HALF + m * 16) * ldc + col0;
#pragma unroll
                for (int bj = 0; bj < 2; ++bj) { f32x4* p = (f32x4*)(rowp + bj * HALF); const f32x4 x0 = p[0], x1 = p[1];
                    p[0] = x0 * alpha + acc[ai][bj][m][0]; p[1] = x1 * alpha + acc[ai][bj][m][1]; } }
    }
};
struct EpiSilu {
    static constexpr bool PERM = true, AFTER_DRAIN = false;
    bf16_t* O;
    __device__ __forceinline__ void operator()(const f32x4 (&acc)[2][2][4][2], const Unit& u, int wr, int wc, int fr, int fq) const {
        const int row0 = u.pm * BM + wr * 64 + fr, col0 = (u.pn & 3) * 128 + wc * 32 + 8 * fq;
#pragma unroll
        for (int ai = 0; ai < 2; ++ai)
#pragma unroll
            for (int m = 0; m < 4; ++m) { bf16_t* rowp = O + (size_t)(row0 + ai * HALF + m * 16) * 512 + col0;
                float h[8];
#pragma unroll
                for (int n = 0; n < 2; ++n)
#pragma unroll
                    for (int e = 0; e < 4; ++e) { const float gt = acc[ai][0][m][n][e], up = acc[ai][1][m][n][e]; h[n * 4 + e] = gt / (1.f + __expf(-gt)) * up; }
                u32x4 w; w.x = cvt_pk_bf16(h[0], h[1]); w.y = cvt_pk_bf16(h[2], h[3]); w.z = cvt_pk_bf16(h[4], h[5]); w.w = cvt_pk_bf16(h[6], h[7]);
                *(u32x4*)rowp = w; }
    }
};
struct EpiL1 {
    static constexpr bool PERM = true, AFTER_DRAIN = false;
    bf16_t* O;
    __device__ __forceinline__ void operator()(const f32x4 (&acc)[2][2][4][2], const Unit& u, int wr, int wc, int fr, int fq) const {
        const int row0 = u.pm * BM + wr * 64 + fr, col0 = u.pn * BM + wc * 32 + 8 * fq;
#pragma unroll
        for (int ai = 0; ai < 2; ++ai)
#pragma unroll
            for (int m = 0; m < 4; ++m) { bf16_t* rowp = O + (size_t)(row0 + ai * HALF + m * 16) * 512 + col0;
#pragma unroll
                for (int bj = 0; bj < 2; ++bj) { const int c = col0 + bj * HALF; float h[8];
#pragma unroll
                    for (int n = 0; n < 2; ++n)
#pragma unroll
                        for (int e = 0; e < 4; ++e) { const float v = acc[ai][bj][m][n][e];
                            h[n * 4 + e] = (c < 256) ? 1.f / (1.f + __expf(-v)) : ((c < 352) ? (1.f - 2.f / (1.f + __expf(2.f * v))) : v); }
                    u32x4 w; w.x = cvt_pk_bf16(h[0], h[1]); w.y = cvt_pk_bf16(h[2], h[3]); w.z = cvt_pk_bf16(h[4], h[5]); w.w = cvt_pk_bf16(h[6], h[7]);
                    *(u32x4*)(rowp + bj * HALF) = w; } }
    }
};
template <int KIND> __device__ __forceinline__ void epi_l2(const f32x4 (&acc)[2][2][4][2], bf16_t* O, const bf16_t* VF, const float* pv, int row0, int col0) {
    float pr[2][8];
#pragma unroll
    for (int bj = 0; bj < 2; ++bj)
#pragma unroll
        for (int j = 0; j < 8; ++j) pr[bj][j] = (KIND == 0) ? 0.f : pv[col0 + bj * HALF + j];
#pragma unroll
    for (int ai = 0; ai < 2; ++ai)
#pragma unroll
        for (int m = 0; m < 4; ++m) { const size_t ro = (size_t)(row0 + ai * HALF + m * 16) * 2048 + col0;
#pragma unroll
            for (int bj = 0; bj < 2; ++bj) { float h[8];
#pragma unroll
                for (int n = 0; n < 2; ++n)
#pragma unroll
                    for (int e = 0; e < 4; ++e) h[n * 4 + e] = acc[ai][bj][m][n][e] + pr[bj][n * 4 + e];
                if (KIND == 1) {
#pragma unroll
                    for (int j = 0; j < 8; ++j) { const float x = -h[j]; const float sp = fmaxf(x, 0.f) + __logf(1.f + __expf(-fabsf(x))); h[j] = -__expf(-sp - 0.5f); }
                } else if (KIND == 2) {
#pragma unroll
                    for (int j = 0; j < 8; ++j) h[j] = 1.f / (1.f + __expf(-h[j]));
                } else if (KIND == 3) {
                    const u32x4 vv = *(const u32x4*)(O + ro + bj * HALF), vf = *(const u32x4*)(VF + ro + bj * HALF);
#pragma unroll
                    for (int j = 0; j < 4; ++j) { const unsigned a = vv[j], b = vf[j];
                        const float v0_ = __builtin_bit_cast(float, a << 16), v1_ = __builtin_bit_cast(float, a & 0xffff0000u);
                        const float f0_ = __builtin_bit_cast(float, b << 16), f1_ = __builtin_bit_cast(float, b & 0xffff0000u);
                        h[2 * j] = v0_ + (f0_ - v0_) / (1.f + __expf(-h[2 * j])); h[2 * j + 1] = v1_ + (f1_ - v1_) / (1.f + __expf(-h[2 * j + 1])); }
                }
                u32x4 w; w.x = cvt_pk_bf16(h[0], h[1]); w.y = cvt_pk_bf16(h[2], h[3]); w.z = cvt_pk_bf16(h[4], h[5]); w.w = cvt_pk_bf16(h[6], h[7]);
                *(u32x4*)(O + ro + bj * HALF) = w; } }
}
struct EpiL2 {
    static constexpr bool PERM = true, AFTER_DRAIN = false;
    bf16_t *G, *WD, *AA, *V; const bf16_t* VF; const float *w0, *a0, *v0;
    __device__ __forceinline__ void operator()(const f32x4 (&acc)[2][2][4][2], const Unit& u, int wr, int wc, int fr, int fq) const {
        const int kind = u.pn >> 3;
        const int row0 = u.pm * BM + wr * 64 + fr, col0 = (u.pn & 7) * BM + wc * 32 + 8 * fq;
        if (kind == 0) epi_l2<0>(acc, G, nullptr, nullptr, row0, col0);
        else if (kind == 1) epi_l2<1>(acc, WD, nullptr, w0, row0, col0);
        else if (kind == 2) epi_l2<2>(acc, AA, nullptr, a0, row0, col0);
        else epi_l2<3>(acc, V, VF, v0, row0, col0);
    }
};

template <class Epi, class Sched, bool ALIGN_EPI = false, bool SP2 = false>
__device__ __forceinline__ void gemm_phase(const int wv, PG8_LAS unsigned char* lds, const Gemm g, const Sched& S, const Epi& E) {
#ifdef NO_GEMM
    return;
#endif
    const int tid_o = wv * 64 + lane_id_asm();
    const int tid = tid_o, wid = __builtin_amdgcn_readfirstlane(tid >> 6), lane = tid & 63, wr = wid >> 2, wc = wid & 3, fr = lane & 15, fq = lane >> 4;
    const int K = g.K, nt = K / BK;
    unsigned voffA[2], voffB[2];
#pragma unroll
    for (int i = 0; i < 2; ++i) { int R, C; stage_rc(tid * 16 + i * 8192, R, C); const int Rb = Epi::PERM ? ((R & ~31) + perm32(R & 31)) : R;
        voffA[i] = (unsigned)(R * g.lda + C) * 2u; voffB[i] = (unsigned)(Rb * g.ldb + C) * 2u; }
    const size_t kstep = (size_t)(BK * 2);
    const size_t hstepA = (size_t)HALF * g.lda * 2, hstepB = (size_t)HALF * g.ldb * 2;
    const size_t tstepA = 2 * hstepA, tstepB = 2 * hstepB;
    const unsigned ldsw = (unsigned)wid * 1024u;
    const int aoff = lds_byte(wr * 64 + fr, fq * 8), boff = lds_byte(wc * 32 + fr, fq * 8);
#define PG8_SA(b, h) (((b) * 2 + (h)) * HTB)
#define PG8_SB(b, h) ((4 + (b) * 2 + (h)) * HTB)
#define PG8_STAGE(bufoff, gbase, voff) do { _Pragma("unroll") for (int _i = 0; _i < 2; ++_i) \
        __builtin_amdgcn_global_load_lds((const unsigned*)((const char*)(gbase) + (voff)[_i]), (PG8_LAS unsigned*)(lds + (bufoff) + ldsw + _i * 8192), 16, 0, 0); } while (0)
#define PG8_LDA(dst, b, h) do { _Pragma("unroll") for (int m = 0; m < 4; ++m) _Pragma("unroll") for (int k = 0; k < 2; ++k) dst[m][k] = *(const PG8_LAS bf16x8*)(lds + PG8_SA(b, h) + aoff + m * 2048 + k * 1024); } while (0)
#define PG8_LDB(dst, b, h) do { _Pragma("unroll") for (int n = 0; n < 2; ++n) _Pragma("unroll") for (int k = 0; k < 2; ++k) dst[n][k] = *(const PG8_LAS bf16x8*)(lds + PG8_SB(b, h) + boff + n * 2048 + k * 1024); } while (0)
#define PG8_MMA(ai, bj, At, Bt) do { __builtin_amdgcn_s_setprio(1); _Pragma("unroll") for (int m = 0; m < 4; ++m) _Pragma("unroll") for (int n = 0; n < 2; ++n) _Pragma("unroll") for (int k = 0; k < 2; ++k) \
        acc[ai][bj][m][n] = __builtin_amdgcn_mfma_f32_16x16x32_bf16(Bt[n][k], At[m][k], acc[ai][bj][m][n], 0, 0, 0); __builtin_amdgcn_s_setprio(0); } while (0)
#define PG8_WAIT_V(n) asm volatile("s_waitcnt vmcnt(" #n ")" ::: "memory")
#define PG8_WAIT_L(n) asm volatile("s_waitcnt lgkmcnt(" #n ")" ::: "memory")
#define PG8_BAR __builtin_amdgcn_s_barrier()
#define PG8_SCHED __builtin_amdgcn_sched_barrier(0)
    Unit cur, nxt; int ui = 0;
    if (!S.next(0, cur)) return;
    f32x4 acc[2][2][4][2];
#pragma unroll
    for (int a = 0; a < 2; ++a)
#pragma unroll
        for (int b = 0; b < 2; ++b)
#pragma unroll
            for (int m = 0; m < 4; ++m)
#pragma unroll
                for (int n = 0; n < 2; ++n) acc[a][b][m][n] = (f32x4){0.f, 0.f, 0.f, 0.f};
    bf16x8 At[4][2], B0[2][2], B1[2][2];
    const char* cA = (const char*)g.A + (size_t)cur.pm * tstepA + cur.aoff; const char* cB = (const char*)g.Bt + (size_t)cur.pn * tstepB;
    S.a_ready(cur);
    if constexpr (SP2) {
        PG8_STAGE(PG8_SB(0, 0), cB, voffB); PG8_STAGE(PG8_SB(0, 1), cB + hstepB, voffB); PG8_STAGE(PG8_SA(0, 0), cA, voffA); PG8_STAGE(PG8_SA(0, 1), cA + hstepA, voffA);
        if (wr == 1) PG8_BAR;
        PG8_WAIT_V(2); PG8_BAR;
        PG8_STAGE(PG8_SB(1, 0), cB + kstep, voffB); PG8_STAGE(PG8_SA(1, 0), cA + kstep, voffA); PG8_STAGE(PG8_SB(1, 1), cB + hstepB + kstep, voffB);
        PG8_WAIT_V(6); PG8_BAR;
    } else {
        PG8_STAGE(PG8_SB(0, 0), cB, voffB); PG8_STAGE(PG8_SA(0, 0), cA, voffA); PG8_STAGE(PG8_SB(0, 1), cB + hstepB, voffB); PG8_STAGE(PG8_SA(0, 1), cA + hstepA, voffA);
        if (wr == 1) PG8_BAR;
        PG8_WAIT_V(4); PG8_BAR;
        PG8_STAGE(PG8_SB(1, 0), cB + kstep, voffB); PG8_STAGE(PG8_SA(1, 0), cA + kstep, voffA); PG8_STAGE(PG8_SB(1, 1), cB + hstepB + kstep, voffB);
        PG8_WAIT_V(6); PG8_BAR;
    }
    for (;;) {
        const bool has_next = S.next(ui + 1, nxt);
        const char* nA = has_next ? (const char*)g.A + (size_t)nxt.pm * tstepA + nxt.aoff : cA; const char* nB = has_next ? (const char*)g.Bt + (size_t)nxt.pn * tstepB : cB;
        for (int t = 0; t < nt; t += 2) {
            const bool last = (t == nt - 2);
            const char* a1 = cA + (size_t)(t + 1) * kstep;
            const char* a2 = last ? nA : cA + (size_t)(t + 2) * kstep; const char* b2 = last ? nB : cB + (size_t)(t + 2) * kstep;
            const char* a3 = a2 + kstep; const char* b3 = b2 + kstep;
            if (last && has_next) S.a_ready(nxt);
            if constexpr (SP2) {
            PG8_LDB(B0, 0, 0); PG8_LDB(B1, 0, 1); PG8_SCHED; PG8_LDA(At, 0, 0); PG8_STAGE(PG8_SA(1, 1), a1 + hstepA, voffA);
            PG8_WAIT_V(8); PG8_WAIT_L(0); PG8_BAR; PG8_MMA(0, 0, At, B0); PG8_MMA(0, 1, At, B1); PG8_BAR; PG8_SCHED;
            PG8_LDA(At, 0, 1); PG8_STAGE(PG8_SB(0, 0), b2, voffB); PG8_STAGE(PG8_SB(0, 1), b2 + hstepB, voffB); PG8_STAGE(PG8_SA(0, 0), a2, voffA);
            PG8_WAIT_V(8); PG8_WAIT_L(0); PG8_BAR; PG8_MMA(1, 0, At, B0); PG8_MMA(1, 1, At, B1); PG8_BAR; PG8_SCHED;
            PG8_LDB(B0, 1, 0); PG8_LDB(B1, 1, 1); PG8_SCHED; PG8_LDA(At, 1, 0); PG8_STAGE(PG8_SA(0, 1), a2 + hstepA, voffA);
            PG8_WAIT_V(8); PG8_WAIT_L(0); PG8_BAR; PG8_MMA(0, 0, At, B0); PG8_MMA(0, 1, At, B1); PG8_BAR; PG8_SCHED;
            PG8_LDA(At, 1, 1); PG8_STAGE(PG8_SB(1, 0), b3, voffB); PG8_STAGE(PG8_SB(1, 1), b3 + hstepB, voffB); PG8_STAGE(PG8_SA(1, 0), a3, voffA);
            PG8_WAIT_V(8); PG8_WAIT_L(0); PG8_BAR; PG8_MMA(1, 0, At, B0); PG8_MMA(1, 1, At, B1); PG8_BAR; PG8_SCHED;
            } else {
            PG8_LDB(B0, 0, 0); PG8_SCHED; PG8_LDA(At, 0, 0); PG8_STAGE(PG8_SA(1, 1), a1 + hstepA, voffA);
            PG8_WAIT_L(8); PG8_BAR; PG8_WAIT_L(0); PG8_MMA(0, 0, At, B0); PG8_BAR; PG8_SCHED;
            PG8_LDB(B1, 0, 1); PG8_STAGE(PG8_SB(0, 0), b2, voffB);
            PG8_BAR; PG8_WAIT_L(0); PG8_MMA(0, 1, At, B1); PG8_BAR;
            PG8_LDA(At, 0, 1); PG8_STAGE(PG8_SA(0, 0), a2, voffA);
            PG8_BAR; PG8_WAIT_L(0); PG8_MMA(1, 0, At, B0); PG8_BAR; PG8_SCHED;
            PG8_STAGE(PG8_SB(0, 1), b2 + hstepB, voffB);
            PG8_WAIT_V(6); PG8_BAR; PG8_MMA(1, 1, At, B1); PG8_BAR;
            PG8_LDB(B0, 1, 0); PG8_SCHED; PG8_LDA(At, 1, 0); PG8_STAGE(PG8_SA(0, 1), a2 + hstepA, voffA);
            PG8_WAIT_L(8); PG8_BAR; PG8_WAIT_L(0); PG8_MMA(0, 0, At, B0); PG8_BAR; PG8_SCHED;
            PG8_LDB(B1, 1, 1); PG8_STAGE(PG8_SB(1, 0), b3, voffB);
            PG8_BAR; PG8_WAIT_L(0); PG8_MMA(0, 1, At, B1); PG8_BAR;
            PG8_LDA(At, 1, 1); PG8_STAGE(PG8_SA(1, 0), a3, voffA);
            PG8_BAR; PG8_WAIT_L(0); PG8_MMA(1, 0, At, B0); PG8_BAR; PG8_SCHED;
            PG8_STAGE(PG8_SB(1, 1), b3 + hstepB, voffB);
            PG8_WAIT_V(6); PG8_BAR; PG8_MMA(1, 1, At, B1); PG8_BAR;
            }
        }
        if constexpr (ALIGN_EPI) { if (wr == 0) PG8_BAR; }
        if constexpr (!Epi::AFTER_DRAIN) { E(acc, cur, wr, wc, fr, fq); S.done(cur); }
        if (!has_next) break;
#pragma unroll
        for (int a = 0; a < 2; ++a)
#pragma unroll
            for (int b = 0; b < 2; ++b)
#pragma unroll
                for (int m = 0; m < 4; ++m)
#pragma unroll
                    for (int n = 0; n < 2; ++n) acc[a][b][m][n] = (f32x4){0.f, 0.f, 0.f, 0.f};
        cur = nxt; cA = nA; cB = nB; ++ui;
        if constexpr (ALIGN_EPI) { if (wr == 1) PG8_BAR; }
    }
    PG8_WAIT_V(0);
    if constexpr (!ALIGN_EPI) { if (wr == 0) PG8_BAR; }
    PG8_BAR;
    if constexpr (Epi::AFTER_DRAIN) { E.fused(acc, cur, wr, wc, fr, fq, lds, wid, lane); S.done(cur); }
#undef PG8_SA
#undef PG8_SB
#undef PG8_STAGE
#undef PG8_LDA
#undef PG8_LDB
#undef PG8_MMA
#undef PG8_WAIT_V
#undef PG8_WAIT_L
#undef PG8_BAR
#undef PG8_SCHED
}
}

#define XB_TMO      128
#define XB_XCNT(j)  (256  + 64 * (j))
#define XB_XSUB(j)  (1280 + 64 * (j))
#define XB_XGEN(j)  (2304 + 64 * (j))
#define XB_TOP      3328
#define XB_TOPGEN   3392
#define XCD_BAR_WORDS 3456
#define XB_SPIN_CAP (1u << 18)

__device__ __forceinline__ unsigned xb_ld(unsigned* p)              { return __hip_atomic_load(p, __ATOMIC_RELAXED, __HIP_MEMORY_SCOPE_AGENT); }
__device__ __forceinline__ unsigned xb_add(unsigned* p, unsigned v) { return __hip_atomic_fetch_add(p, v, __ATOMIC_RELAXED, __HIP_MEMORY_SCOPE_AGENT); }
__device__ __forceinline__ unsigned xb_xcc_id() { return (unsigned)__builtin_amdgcn_s_getreg((3 << 11) | 20) & 0xFu; }
#define XB_SPIN(cond, bar) do { unsigned _sp = 0; while (cond) { __builtin_amdgcn_s_sleep(1); \
    if ((++_sp & 255u) == 0u) { if (xb_ld(&(bar)[XB_TMO])) break; if (_sp > XB_SPIN_CAP) { atomicAdd(&(bar)[XB_TMO], 1u); break; } } } } while (0)

struct XcdBarrier {
    unsigned* bar; unsigned x;
    volatile LAS unsigned* st;
};

__device__ __forceinline__ XcdBarrier xcd_barrier_post(unsigned* bar, volatile LAS unsigned* st, const bool t0) {
    XcdBarrier b; b.bar = bar; b.x = xb_xcc_id(); b.st = st;
    if (t0) (void)xb_add(&bar[XB_XCNT(b.x)], 1u);
    return b;
}
__device__ __forceinline__ void xcd_barrier_complete(unsigned* bar, unsigned x, unsigned& nloc, unsigned& nx) {
    const unsigned G = gridDim.x * gridDim.y * gridDim.z;
    unsigned sum, cnt, mine, sp = 0u;
    for (;;) {
        sum = 0u; cnt = 0u; mine = 0u;
#pragma unroll
        for (unsigned j = 0; j < 16; ++j) { const unsigned c = xb_ld(&bar[XB_XCNT(j)]); sum += c; cnt += (c > 0u) ? 1u : 0u; mine = (j == x) ? c : mine; }
        if (sum == G) break;
        __builtin_amdgcn_s_sleep(1);
        if ((++sp & 255u) == 0u) { if (xb_ld(&bar[XB_TMO])) break; if (sp > XB_SPIN_CAP) { atomicAdd(&bar[XB_TMO], 1u); break; } }
    }
    nloc = mine > 0u ? mine : 1u; nx = cnt > 0u ? cnt : 1u;
}

__device__ __forceinline__ void xcd_barrier(const XcdBarrier& b, const bool t0) {
    asm volatile("s_waitcnt vmcnt(0)" ::: "memory");
    __syncthreads();
    if (t0) {
        unsigned* bar = b.bar;
        __builtin_amdgcn_s_waitcnt(0);
        unsigned nloc = b.st[0], nx = b.st[1];
        if (nloc == 0u) { xcd_barrier_complete(bar, b.x, nloc, nx); b.st[0] = nloc; b.st[1] = nx; }
        const unsigned old = xb_add(&bar[XB_XSUB(b.x)], 1u);
        const unsigned gen = old / nloc;
        if (old + 1u == (gen + 1u) * nloc) {
            __builtin_amdgcn_fence(__ATOMIC_RELEASE, "agent");
            asm volatile("s_waitcnt vmcnt(0)" ::: "memory");
            const unsigned og = xb_add(&bar[XB_TOP], 1u);
            const unsigned tg = og / nx;
            if (og + 1u == (tg + 1u) * nx) xb_add(&bar[XB_TOPGEN], 1u);
            else XB_SPIN(xb_ld(&bar[XB_TOPGEN]) == tg, bar);
            __builtin_amdgcn_fence(__ATOMIC_ACQUIRE, "agent");
            xb_add(&bar[XB_XGEN(b.x)], 1u);
            asm volatile("s_waitcnt vmcnt(0)" ::: "memory");
        } else {
            XB_SPIN(xb_ld(&bar[XB_XGEN(b.x)]) == gen, bar);
            __builtin_amdgcn_fence(__ATOMIC_ACQUIRE, "agent");
            asm volatile("s_waitcnt vmcnt(0)" ::: "memory");
        }
    }
    __syncthreads();
}

constexpr int NWAVES = 8, NTHR = 512;
constexpr int NB = 4, SEQ = 4096, T_ = NB * SEQ, D_ = 2048;
constexpr int EVEN_IN = 7176, ZW = 7168;
constexpr float DN_ALPHA = 1.6817928305074290f;
constexpr float LN_EPS = 1e-5f;
constexpr int MOE_ROWS = 40960, MOE_TILES = MOE_ROWS / 256;

constexpr size_t MiB = 1u << 20;
constexpr size_t WS_CTL = 0, CTL_ZERO_BYTES = 1 * MiB;
constexpr size_t WS_IG = 1 * MiB, WS_FG = WS_IG + 256 * 1024, WS_KPART = 2 * MiB;
constexpr size_t WS_TOKE = 3 * MiB, WS_TOKR = WS_TOKE + 128 * 1024, WS_TOKG = WS_TOKR + 128 * 1024, WS_SLOT = WS_TOKG + 128 * 1024;
constexpr size_t WS_DN = 4 * MiB, WS_NP = 5 * MiB, WS_DEC = 6 * MiB, WS_BC = 6 * MiB + 65536;
constexpr size_t WS_WIN = 16 * MiB;
constexpr size_t WS_WOUT = 72 * MiB;
constexpr size_t WS_WRKV = 88 * MiB;
constexpr size_t WS_WO = 136 * MiB;
constexpr size_t WS_WL1 = 152 * MiB;
constexpr size_t WS_WL2 = 160 * MiB;
constexpr size_t WS_WGU = 168 * MiB;
constexpr size_t WS_WDN = 680 * MiB;
constexpr size_t WS_XB = 936 * MiB;
constexpr size_t WS_VF = 1000 * MiB;
constexpr size_t WS_R = 1064 * MiB;
constexpr size_t WS_Z = WS_R;
constexpr size_t WS_QKB = WS_R + 224 * MiB;
constexpr size_t WS_VAT = WS_R + 288 * MiB;
constexpr size_t WS_YE = WS_R + 320 * MiB;
constexpr size_t WS_DC = WS_R + 384 * MiB;
constexpr size_t WS_CP = WS_R + 512 * MiB;
constexpr size_t WS_XRKV = WS_R;
constexpr size_t WS_XC = WS_R + 192 * MiB;
constexpr size_t WS_RKV = WS_R + 320 * MiB;
constexpr size_t WS_L1 = WS_R + 512 * MiB;
constexpr size_t WS_G = WS_R + 528 * MiB;
constexpr size_t WS_WD = WS_R + 592 * MiB;
constexpr size_t WS_AA = WS_R + 656 * MiB;
constexpr size_t WS_YO = WS_R + 720 * MiB;
constexpr size_t WS_XS = WS_R;
constexpr size_t WS_HID = WS_R + 160 * MiB;
constexpr size_t WS_YS = WS_R + 200 * MiB;
constexpr size_t WS_END = WS_R + 784 * MiB;

constexpr int CW_BAR = 4096;
constexpr int CW_CNT = 16384;

constexpr int RING_BYTES = 131072;
constexpr int MISC_OFF = RING_BYTES;
constexpr int LDS_BYTES = 147456;

typedef unsigned gu32;

struct Args { const float* in[39]; float* out; unsigned char* ws; int ph_lo, ph_hi; };
#define CAS __attribute__((address_space(4)))
typedef const CAS Args* ArgsP;
__device__ __forceinline__ ArgsP get_args() { ArgsP p = (ArgsP)__builtin_amdgcn_kernarg_segment_ptr(); asm volatile("" : "+s"(p)); return p; }

__device__ __forceinline__ void tr_item(const float* W, int ldw, int k0, int n0, bf16* WT, int ldt, int drow0, int dcol0, LAS float* scr, int lane, const float* kscale) {
    const int r = lane >> 3, c4 = lane & 7;
    f32x4 v[8];
#pragma unroll
    for (int i = 0; i < 8; ++i) v[i] = __builtin_nontemporal_load((const f32x4*)(W + (size_t)(k0 + 8 * i + r) * ldw + n0 + 4 * c4));
    if (kscale) {
#pragma unroll
        for (int i = 0; i < 8; ++i) v[i] = v[i] * kscale[k0 + 8 * i + r]; }
#pragma unroll
    for (int i = 0; i < 8; ++i) { LAS float* d = scr + (8 * i + r) * 33 + 4 * c4; d[0] = v[i].x; d[1] = v[i].y; d[2] = v[i].z; d[3] = v[i].w; }
    LDS_WAIT(); asm volatile("" ::: "memory");
    const int c = lane & 7;
#pragma unroll
    for (int j = 0; j < 4; ++j) { const int n = (lane >> 3) + 8 * j; const LAS float* s = scr + (8 * c) * 33 + n;
        v4u o; o.x = pk2(s[0 * 33], s[1 * 33]); o.y = pk2(s[2 * 33], s[3 * 33]); o.z = pk2(s[4 * 33], s[5 * 33]); o.w = pk2(s[6 * 33], s[7 * 33]);
        *(v4u*)(WT + (size_t)(drow0 + n) * ldt + dcol0 + 8 * c) = o; }
    LDS_WAIT(); asm volatile("" ::: "memory");
}

__device__ __forceinline__ void moe_convert(const int wv, LAS unsigned char* lds, int le_lo, int le_hi, int vb, int nvb) {
    const ArgsP a = get_args();
    OPAQUE_TID(); const int lane = tid & 63, wave = tid >> 6;
    unsigned char* ws = a->ws;
    LAS float* scr = (LAS float*)(lds + wave * 16384);
    const int n = (le_hi - le_lo) * 1536;
    for (int it = vb * NWAVES + wave; it < n; it += nvb * NWAVES) {
        const int le = le_lo + it / 1536, rr = it % 1536, mat = rr / 512, q = rr % 512;
        if (mat < 2) { const int kb = q / 16, nb = q % 16, n0 = 32 * nb;
            tr_item((mat == 0 ? a->in[36] : a->in[37]) + (size_t)le * 2048 * 512, 512, 64 * kb, n0, (bf16*)(ws + WS_WGU) + (size_t)le * 1024 * 2048, 2048,
                    (n0 / 128) * 256 + (n0 % 128) + (mat == 1 ? 128 : 0), 64 * kb, scr, lane, nullptr); }
        else { const int kb = q / 64, nb = q % 64;
            tr_item(a->in[38] + (size_t)le * 512 * 2048, 2048, 64 * kb, 32 * nb, (bf16*)(ws + WS_WDN) + (size_t)le * 2048 * 512, 512, 32 * nb, 64 * kb, scr, lane, nullptr); }
    }
}

__device__ __forceinline__ void prologue(const int wv, LAS unsigned char* lds) {
    const ArgsP a = get_args();
#ifdef NO_PROL
    return;
#endif
    OPAQUE_TID(); const int lane = tid & 63, wave = tid >> 6;
    unsigned char* ws = a->ws;
    LAS float* scr = (LAS float*)(lds + wave * 16384);
    const int gw = blockIdx.x * NWAVES + wave, NGW = gridDim.x * NWAVES;
    constexpr int I0 = 2 * 7168, I1 = 2 * 2048, I2 = 2 * 4 * 2048, I3 = 2 * 32 * 16, I4 = 1 * 32 * 1536;
    constexpr int NITEMS = I0 + I1 + I2 + I3 + I4;
    for (int it = gw; it < NITEMS; it += NGW) {
        int r = it;
        if (r < I0) { const int e = r / 7168, rr = r % 7168, kb = rr / 224, nb = rr % 224;
            tr_item(a->in[1] + (size_t)e * 2048 * EVEN_IN, EVEN_IN, 64 * kb, 32 * nb, (bf16*)(ws + WS_WIN) + (size_t)e * ZW * 2048, 2048, 32 * nb, 64 * kb, scr, lane, nullptr); continue; } r -= I0;
        if (r < I1) { const int e = r / 2048, rr = r % 2048, kb = rr / 64, nb = rr % 64;
            tr_item(a->in[6] + (size_t)e * 2048 * 2048, 2048, 64 * kb, 32 * nb, (bf16*)(ws + WS_WOUT) + (size_t)e * 2048 * 2048, 2048, 32 * nb, 64 * kb, scr, lane, nullptr); continue; } r -= I1;
        if (r < I2) { const int o = r / 8192, rr = r % 8192, mat = rr / 2048, q = rr % 2048, kb = q / 64, nb = q % 64;
            const float* src = (mat == 0 ? a->in[8] : mat == 1 ? a->in[9] : mat == 2 ? a->in[10] : a->in[11]) + (size_t)o * 2048 * 2048;
            bf16* dst = (mat < 3) ? (bf16*)(ws + WS_WRKV) + (size_t)o * 3 * 2048 * 2048 + (size_t)mat * 2048 * 2048 : (bf16*)(ws + WS_WO) + (size_t)o * 2048 * 2048;
            tr_item(src, 2048, 64 * kb, 32 * nb, dst, 2048, 32 * nb, 64 * kb, scr, lane, nullptr); continue; } r -= I2;
        if (r < I3) { const int o = r / 512, rr = r % 512, kb = rr / 16, nb = rr % 16;
            const float* src; int ldw, n0, drow0, mu;
            if (nb < 8) { src = a->in[18] + (size_t)o * 2048 * 256; ldw = 256; n0 = 32 * nb; drow0 = 32 * nb; mu = 5; }
            else if (nb < 11) { src = a->in[13] + (size_t)o * 2048 * 96; ldw = 96; n0 = 32 * (nb - 8); drow0 = 256 + n0; mu = 1; }
            else if (nb < 14) { src = a->in[16] + (size_t)o * 2048 * 96; ldw = 96; n0 = 32 * (nb - 11); drow0 = 352 + n0; mu = 4; }
            else { if (o == 0) continue; src = a->in[26]; ldw = 64; n0 = 32 * (nb - 14); drow0 = 448 + n0; mu = 3; }
            bf16* dst = (bf16*)(ws + WS_WL1) + (size_t)o * 512 * 4096;
            tr_item(src, ldw, 64 * kb, n0, dst, 4096, drow0, 64 * kb, scr, lane, nullptr);
            tr_item(src, ldw, 64 * kb, n0, dst, 4096, drow0, 2048 + 64 * kb, scr, lane, a->in[7] + (size_t)(o * 6 + mu) * 2048);
            continue; } r -= I3;
        { const int le = r / 1536, rr = r % 1536, mat = rr / 512, q = rr % 512;
            if (mat < 2) { const int kb = q / 16, nb = q % 16, n0 = 32 * nb;
                tr_item((mat == 0 ? a->in[36] : a->in[37]) + (size_t)le * 2048 * 512, 512, 64 * kb, n0, (bf16*)(ws + WS_WGU) + (size_t)le * 1024 * 2048, 2048,
                        (n0 / 128) * 256 + (n0 % 128) + (mat == 1 ? 128 : 0), 64 * kb, scr, lane, nullptr); }
            else { const int kb = q / 64, nb = q % 64;
                tr_item(a->in[38] + (size_t)le * 512 * 2048, 2048, 64 * kb, 32 * nb, (bf16*)(ws + WS_WDN) + (size_t)le * 2048 * 512, 512, 32 * nb, 64 * kb, scr, lane, nullptr); }
        }
    }
    const int gt = blockIdx.x * NTHR + tid, NGT = gridDim.x * NTHR;
    for (int idx = gt; idx < 2 * 32 * 8192; idx += NGT) {
        const int o = idx / (32 * 8192), rem = idx % (32 * 8192), kg = rem / 8192, n = rem % 8192, mat = n / 2048, nn = n % 2048;
        float v[8];
#pragma unroll
        for (int j = 0; j < 8; ++j) { const int k = 8 * kg + j; float x = 0.f;
            if (mat == 0) x = a->in[19][((size_t)o * 256 + k) * 2048 + nn];
            else if (mat == 1) { if (k < 96) x = a->in[14][((size_t)o * 96 + k) * 2048 + nn]; }
            else if (mat == 2) { if (k >= 96 && k < 192) x = a->in[17][((size_t)o * 96 + (k - 96)) * 2048 + nn]; }
            else { if (o == 1 && k >= 192) x = a->in[27][(size_t)(k - 192) * 2048 + nn]; }
            v[j] = x; }
        v4u w; w.x = pk2(v[0], v[1]); w.y = pk2(v[2], v[3]); w.z = pk2(v[4], v[5]); w.w = pk2(v[6], v[7]);
        *(v4u*)((bf16*)(ws + WS_WL2) + ((size_t)o * 8192 + n) * 256 + 8 * kg) = w;
    }
    for (int i = gt; i < T_ * D_ / 4; i += NGT) { const f32x4 v = ((const f32x4*)a->in[0])[i]; ((f32x4*)a->out)[i] = v;
        v2u w; w.x = pk2(v.x, v.y); w.y = pk2(v.z, v.w); ((v2u*)(ws + WS_XB))[i] = w; }
}

__device__ __forceinline__ void even_prep(const int wv, int e, LAS unsigned char* lds, int u) {
    const ArgsP a = get_args();
#ifdef NO_EPREP
    return;
#endif
    OPAQUE_TID(); const int lane = tid & 63, wave = tid >> 6;
    unsigned char* ws = a->ws;
    bf16* Z = (bf16*)(ws + WS_Z);
    const int m0 = 64 * u, b = u >> 6, ch = u & 63, t0 = ch * 64;
    { LAS float* cst = (LAS float*)lds; LAS float* snt = cst + 1024;
#pragma unroll 1
      for (int q = tid; q < 1024; q += NTHR) { const int r = q >> 4, i = q & 15; const float inv = exp2f(-(float)i * (18.931568569324174f / 16.f));
          float sn_, cs_; sincosf((float)(t0 + r) * inv, &sn_, &cs_); cst[q] = cs_; snt[q] = sn_; }
      __syncthreads();
      const int row = tid >> 3, head = tid & 7;
      float cs[16], sn[16];
#pragma unroll
      for (int i = 0; i < 4; ++i) { const f32x4 c4 = *(const LAS f32x4*)(cst + row * 16 + 4 * i), s4 = *(const LAS f32x4*)(snt + row * 16 + 4 * i);
          cs[4 * i] = c4.x; cs[4 * i + 1] = c4.y; cs[4 * i + 2] = c4.z; cs[4 * i + 3] = c4.w; sn[4 * i] = s4.x; sn[4 * i + 1] = s4.y; sn[4 * i + 2] = s4.z; sn[4 * i + 3] = s4.w; }
#pragma unroll 1
      for (int qk = 0; qk < 2; ++qk) { v4u* p = (v4u*)(Z + (size_t)(m0 + row) * ZW + qk * 1024 + head * 128);
        v4u w0 = p[0], w1 = p[1], w2 = p[2], w3 = p[3]; unsigned x1[8] = {w0.x, w0.y, w0.z, w0.w, w1.x, w1.y, w1.z, w1.w}, x2[8] = {w2.x, w2.y, w2.z, w2.w, w3.x, w3.y, w3.z, w3.w};
        unsigned o1[8], o2[8];
#pragma unroll
        for (int j = 0; j < 8; ++j) { const float a0 = bflo(x1[j]), a1 = bfhi(x1[j]), b0 = bflo(x2[j]), b1 = bfhi(x2[j]);
            o1[j] = pk2(a0 * cs[2 * j] - b0 * sn[2 * j], a1 * cs[2 * j + 1] - b1 * sn[2 * j + 1]);
            o2[j] = pk2(b0 * cs[2 * j] + a0 * sn[2 * j], b1 * cs[2 * j + 1] + a1 * sn[2 * j + 1]); }
        p[0] = (v4u){o1[0], o1[1], o1[2], o1[3]}; p[1] = (v4u){o1[4], o1[5], o1[6], o1[7]}; p[2] = (v4u){o2[0], o2[1], o2[2], o2[3]}; p[3] = (v4u){o2[4], o2[5], o2[6], o2[7]}; }
    }
    VM_WAIT(); __syncthreads();
    { LAS float* red = (LAS float*)lds;
      const int cg = tid & 127, rq = tid >> 7; float s[8] = {0, 0, 0, 0, 0, 0, 0, 0};
      for (int r = 0; r < 16; ++r) { const v4u w = *(const v4u*)(Z + (size_t)(m0 + rq * 16 + r) * ZW + 1024 + cg * 8);
          s[0] += bflo(w.x); s[1] += bfhi(w.x); s[2] += bflo(w.y); s[3] += bfhi(w.y); s[4] += bflo(w.z); s[5] += bfhi(w.z); s[6] += bflo(w.w); s[7] += bfhi(w.w); }
#pragma unroll
      for (int j = 0; j < 8; ++j) red[rq * 1024 + cg * 8 + j] = s[j];
      __syncthreads();
      if (tid < 256) { f32x4 t = {0, 0, 0, 0};
#pragma unroll
          for (int q = 0; q < 4; ++q) { const f32x4 v = *(const LAS f32x4*)(red + q * 1024 + tid * 4); t += v; }
          const int c = tid * 4, h = c >> 7, d = c & 127;
          *(f32x4*)((float*)(ws + WS_KPART) + ((size_t)((b * 8 + h) * 64 + ch)) * 128 + d) = t; }
      __syncthreads();
    }
    { const int cg = tid & 255, rh = tid >> 8; const int c0 = 8 * cg;
      const float* cw = a->in[3] + (size_t)e * 4 * 2048; const float* cb = a->in[4] + (size_t)e * 2048;
      float w[4][8], bias[8];
#pragma unroll
      for (int j = 0; j < 4; ++j)
#pragma unroll
          for (int i = 0; i < 8; ++i) w[j][i] = cw[j * 2048 + c0 + i];
#pragma unroll
      for (int i = 0; i < 8; ++i) bias[i] = cb[c0 + i];
      float win[3][8];
#pragma unroll
      for (int j = 0; j < 3; ++j) { const int tt = t0 + 32 * rh - 3 + j;
          v4u x = {0, 0, 0, 0}; if (tt >= 0) x = *(const v4u*)(Z + (size_t)(b * SEQ + tt) * ZW + 3072 + c0);
          win[j][0] = bflo(x.x); win[j][1] = bfhi(x.x); win[j][2] = bflo(x.y); win[j][3] = bfhi(x.y); win[j][4] = bflo(x.z); win[j][5] = bfhi(x.z); win[j][6] = bflo(x.w); win[j][7] = bfhi(x.w); }
      bf16* QKB = (bf16*)(ws + WS_QKB);
      for (int r = 0; r < 32; ++r) { const int m = m0 + 32 * rh + r;
          const v4u x = *(const v4u*)(Z + (size_t)m * ZW + 3072 + c0);
          float cur[8] = {bflo(x.x), bfhi(x.x), bflo(x.y), bfhi(x.y), bflo(x.z), bfhi(x.z), bflo(x.w), bfhi(x.w)}; float o[8];
#pragma unroll
          for (int i = 0; i < 8; ++i) { const float v = bias[i] + w[0][i] * win[0][i] + w[1][i] * win[1][i] + w[2][i] * win[2][i] + w[3][i] * cur[i]; o[i] = v / (1.f + __expf(-v));
              win[0][i] = win[1][i]; win[1][i] = win[2][i]; win[2][i] = cur[i]; }
          *(v4u*)(QKB + (size_t)m * 2048 + c0) = (v4u){pk2(o[0], o[1]), pk2(o[2], o[3]), pk2(o[4], o[5]), pk2(o[6], o[7])}; }
    }
    { LAS float* wg = (LAS float*)lds;
      const float* Win = a->in[1] + (size_t)e * 2048 * EVEN_IN;
      for (int i = tid; i < 2048 * 2; i += NTHR) { const int k = i >> 1, hf = i & 1; *(LAS f32x4*)(wg + k * 8 + hf * 4) = *(const f32x4*)(Win + (size_t)k * EVEN_IN + ZW + hf * 4); }
      __syncthreads();
      const float* gb = a->in[2] + e * 8;
      for (int rr = 0; rr < 8; ++rr) { const int row = wave * 8 + rr, m = m0 + row; const f32x4* xr = (const f32x4*)(a->out + (size_t)m * D_) + lane;
          float acc[8] = {0, 0, 0, 0, 0, 0, 0, 0};
#pragma unroll 2
          for (int j = 0; j < 8; ++j) { const f32x4 xv = xr[64 * j]; const int k0 = 4 * lane + 256 * j;
#pragma unroll
              for (int i = 0; i < 4; ++i) { const f32x4 wa = *(const LAS f32x4*)(wg + (k0 + i) * 8), wb = *(const LAS f32x4*)(wg + (k0 + i) * 8 + 4); const float xx = xv[i];
                  acc[0] += xx * wa.x; acc[1] += xx * wa.y; acc[2] += xx * wa.z; acc[3] += xx * wa.w; acc[4] += xx * wb.x; acc[5] += xx * wb.y; acc[6] += xx * wb.z; acc[7] += xx * wb.w; } }
#pragma unroll
          for (int j = 0; j < 8; ++j) acc[j] = wave_sum(acc[j]);
          if (lane < 4) { const int h = lane; float ip = 0.f, fp = 0.f;
#pragma unroll
              for (int j = 0; j < 4; ++j) { if (j == h) { ip = acc[j]; fp = acc[4 + j]; } }
              ip += gb[h]; fp += gb[4 + h];
              const float lf = -(fmaxf(-fp, 0.f) + __logf(1.f + __expf(-fabsf(fp))));
              ((float*)(ws + WS_IG))[(size_t)(b * 4 + h) * SEQ + t0 + row] = ip;
              ((LAS float*)(lds + 73728))[h * 64 + row] = ip; ((LAS float*)(lds + 73728 + 1024))[h * 64 + row] = lf; } }
      __syncthreads();
    }
    { LAS float* gi = (LAS float*)(lds + 73728); LAS float* gf = gi + 256; LAS float* wsc = gi + 512;
      const int bh0 = b * 4;
      if (wave < 4) { const int h = wave; float x = gf[h * 64 + lane];
#pragma unroll
          for (int o = 1; o < 64; o <<= 1) { const float t = __shfl_up(x, o); if (lane >= o) x += t; }
          const float b63 = __shfl(x, 63);
          wsc[h * 64 + lane] = __expf(b63 - x + gi[h * 64 + lane]) * 0.0625f;
          ((float*)(ws + WS_BC))[(size_t)(bh0 + h) * SEQ + t0 + lane] = x;
          if (lane == 63) ((float*)(ws + WS_DEC))[(bh0 + h) * 64 + ch] = __expf(b63); }
      __syncthreads();
      constexpr int PV = 544;
      LAS unsigned char* Vt = lds; LAS unsigned char* Kt = lds + 64 * PV;
      const int g4 = lane >> 4, q4 = (lane >> 2) & 3, p4 = lane & 3, fr = lane & 15;
      const int wd = wave & 1, we = wave >> 1;
      const bf16* QKB = (const bf16*)(ws + WS_QKB);
      for (int h = 0; h < 4; ++h) {
          { const int sr = tid >> 3, seg = tid & 7; const float wv_ = wsc[h * 64 + sr];
            const v4u* vs = (const v4u*)(Z + (size_t)(m0 + sr) * ZW + 5120 + h * 256 + 32 * seg); const v4u* ks = (const v4u*)(QKB + (size_t)(m0 + sr) * 2048 + 1024 + h * 256 + 32 * seg);
#pragma unroll
            for (int j = 0; j < 4; ++j) { *(LAS v4u*)(Vt + sr * PV + (32 * seg + 8 * j) * 2) = vs[j]; const v4u kk = ks[j];
                *(LAS v4u*)(Kt + sr * PV + (32 * seg + 8 * j) * 2) = (v4u){pk2(bflo(kk.x) * wv_, bfhi(kk.x) * wv_), pk2(bflo(kk.y) * wv_, bfhi(kk.y) * wv_), pk2(bflo(kk.z) * wv_, bfhi(kk.z) * wv_), pk2(bflo(kk.w) * wv_, bfhi(kk.w) * wv_)}; } }
          __syncthreads();
          if (tid < 256) { float sum = 0.f;
#pragma unroll 8
              for (int sr = 0; sr < 64; ++sr) sum += bf2f(*(const LAS bf16*)(Kt + sr * PV + tid * 2));
              ((float*)(ws + WS_DN))[((size_t)(bh0 + h) * 64 + ch) * 256 + tid] = sum; }
          f32x4 acc[8][4];
#pragma unroll
          for (int i = 0; i < 8; ++i)
#pragma unroll
              for (int j = 0; j < 4; ++j) acc[i][j] = (f32x4){0.f, 0.f, 0.f, 0.f};
#pragma unroll
          for (int ks2 = 0; ks2 < 2; ++ks2) {
              bf16x8 yf[4];
#pragma unroll
              for (int et = 0; et < 4; ++et) { const LAS unsigned char* p = Vt + (32 * ks2 + 8 * g4 + q4) * PV + (64 * we + 16 * et + 4 * p4) * 2;
                  const v2u lo = tr_read(p), hi = tr_read(p + 4 * PV); yf[et] = __builtin_bit_cast(bf16x8, (v4u){lo.x, lo.y, hi.x, hi.y}); }
#pragma unroll
              for (int dt = 0; dt < 8; ++dt) { const LAS unsigned char* p = Kt + (32 * ks2 + 8 * g4 + q4) * PV + (128 * wd + 16 * dt + 4 * p4) * 2;
                  const v2u lo = tr_read(p), hi = tr_read(p + 4 * PV); const bf16x8 xf = __builtin_bit_cast(bf16x8, (v4u){lo.x, lo.y, hi.x, hi.y});
#pragma unroll
                  for (int et = 0; et < 4; ++et) acc[dt][et] = __builtin_amdgcn_mfma_f32_16x16x32_bf16(xf, yf[et], acc[dt][et], 0, 0, 0); } }
          { bf16* DC = (bf16*)(ws + WS_DC) + ((size_t)(bh0 + h) * 64 + ch) * 65536;
#pragma unroll
            for (int et = 0; et < 4; ++et)
#pragma unroll
                for (int dt = 0; dt < 8; ++dt) { const f32x4 v = acc[dt][et];
                    *(v2u*)(DC + (size_t)(64 * we + 16 * et + fr) * 256 + 128 * wd + 16 * dt + 4 * g4) = (v2u){pk2(v.x, v.y), pk2(v.z, v.w)}; } }
          __syncthreads();
      }
    }
}

constexpr int AT_PITCH = 272;
constexpr int AT_BUF = 2 * 64 * AT_PITCH;
constexpr int AT_KM_OFF = 2 * AT_BUF, AT_GATE_OFF = AT_KM_OFF + 16 * 128 * 4, AT_SEL_OFF = AT_GATE_OFF + 256 * 16 * 4, AT_TL_OFF = AT_SEL_OFF + 256 * 4, AT_END = AT_TL_OFF + 80 * 4;
static_assert(AT_END <= RING_BYTES, "attention LDS map");

__device__ __forceinline__ void attn_unit(const int wv, LAS unsigned char* lds, int b, int h, int qb) {
    const ArgsP a = get_args();
#ifdef NO_ATTN
    return;
#endif
    OPAQUE_TID(); const int lane = tid & 63, wave = wv, fr = lane & 15, fq = lane >> 4, q4 = (lane >> 2) & 3, p4 = lane & 3;
    unsigned char* ws = a->ws;
    const bf16* Z = (const bf16*)(ws + WS_Z);
    const int q0 = 256 * qb;
    LAS float* km = (LAS float*)(lds + AT_KM_OFF); LAS float* gate = (LAS float*)(lds + AT_GATE_OFF);
    LAS unsigned* sel = (LAS unsigned*)(lds + AT_SEL_OFF); LAS int* tl = (LAS int*)(lds + AT_TL_OFF);
    for (int i = tid; i < qb * 128; i += NTHR) { const int n = i >> 7, d = i & 127; const float* kp = (const float*)(ws + WS_KPART) + ((size_t)((b * 8 + h) * 64 + 4 * n)) * 128 + d;
        km[i] = (kp[0] + kp[128] + kp[256] + kp[384]) * (1.f / 256.f); }
    __syncthreads();
    if (qb > 3) { const int ql = tid >> 1, part = tid & 1; const v4u* qp = (const v4u*)(Z + (size_t)(b * SEQ + q0 + ql) * ZW + h * 128);
        float g[8] = {0, 0, 0, 0, 0, 0, 0, 0};
        for (int c = 0; c < 16; ++c) { const v4u w = qp[c]; const float qv[8] = {bflo(w.x), bfhi(w.x), bflo(w.y), bfhi(w.y), bflo(w.z), bfhi(w.z), bflo(w.w), bfhi(w.w)};
#pragma unroll
            for (int jj = 0; jj < 8; ++jj) { const int n = part + 2 * jj; if (n < qb) { const LAS float* kk = km + n * 128 + c * 8;
#pragma unroll
                for (int i = 0; i < 8; ++i) g[jj] += qv[i] * kk[i]; } } }
#pragma unroll
        for (int jj = 0; jj < 8; ++jj) { const int n = part + 2 * jj; if (n < qb) gate[ql * 16 + n] = g[jj]; }
    }
    __syncthreads();
    if (tid < 256) { unsigned m = 0;
        if (qb <= 3) m = (1u << qb) - 1u;
        else { for (int r = 0; r < 3; ++r) { float best = -3.0e38f; int bi = 0; for (int n = 0; n < qb; ++n) { const float g = gate[tid * 16 + n]; if (!((m >> n) & 1u) && g > best) { best = g; bi = n; } } m |= 1u << bi; } }
        sel[tid] = m; }
    __syncthreads();
    if (tid == 0) { unsigned um = 0; for (int i = 0; i < 256; ++i) um |= sel[i];
        int nt = 0;
        for (int j = 0; j < 4; ++j) tl[1 + nt++] = (4 * qb + j) | (1 << 16);
        for (int n = 0; n < qb; ++n) if ((um >> n) & 1u) for (int j = 0; j < 4; ++j) tl[1 + nt++] = 4 * n + j;
        tl[0] = nt; }
    __syncthreads();
    const int ntile = tl[0];
    const unsigned mysel0 = sel[32 * wave + fr], mysel1 = sel[32 * wave + 16 + fr];
    unsigned wsel = mysel0 | mysel1;
#pragma unroll
    for (int o = 1; o < 16; o <<= 1) wsel |= __shfl_xor(wsel, o);
    bf16x8 qf[2][4];
#pragma unroll
    for (int t = 0; t < 2; ++t) { const v4u* qp = (const v4u*)(Z + (size_t)(b * SEQ + q0 + 32 * wave + 16 * t + fr) * ZW + h * 128);
#pragma unroll
        for (int kc = 0; kc < 4; ++kc) qf[t][kc] = __builtin_bit_cast(bf16x8, qp[kc * 4 + fq]); }
    f32x4 o[2][8];
#pragma unroll
    for (int t = 0; t < 2; ++t)
#pragma unroll
        for (int i = 0; i < 8; ++i) o[t][i] = (f32x4){0.f, 0.f, 0.f, 0.f};
    float mrun[2] = {-INFINITY, -INFINITY}, lrun[2] = {0.f, 0.f};
    const float sc = 0.08838834764831845f * 1.4426950408889634f;
    v4u kr[2], vr[2];
    auto gload = [&](int ti) { const int key0 = 64 * (tl[1 + ti] & 0xffff);
        const v4u* kp = (const v4u*)(Z + (size_t)(b * SEQ + key0 + (tid >> 3)) * ZW + 1024 + h * 128) + (tid & 7) * 2; kr[0] = kp[0]; kr[1] = kp[1]; vr[0] = kp[128]; vr[1] = kp[129]; };
    auto lstore = [&](int bufi) { LAS v4u* kd = (LAS v4u*)(lds + bufi * AT_BUF + (tid >> 3) * AT_PITCH + (tid & 7) * 32); kd[0] = kr[0]; kd[1] = kr[1];
        LAS v4u* vd = (LAS v4u*)(lds + bufi * AT_BUF + 64 * AT_PITCH + (tid >> 3) * AT_PITCH + (tid & 7) * 32); vd[0] = vr[0]; vd[1] = vr[1]; };
    gload(0); lstore(0); __syncthreads();
    for (int ti = 0; ti < ntile; ++ti) {
        const int ent = tl[1 + ti]; const int kt64 = ent & 0xffff; const bool own = (ent >> 16) & 1; const int key0 = 64 * kt64;
        if (ti + 1 < ntile) gload(ti + 1);
        const LAS unsigned char* Kt = lds + (ti & 1) * AT_BUF; const LAS unsigned char* Vt = Kt + 64 * AT_PITCH;
        const bool wave_active = own ? (key0 <= q0 + 32 * wave + 31) : (((wsel >> (kt64 >> 2)) & 1u) != 0u);
        if (wave_active) {
            f32x4 s[2][4];
#pragma unroll
            for (int kt = 0; kt < 4; ++kt) { s[0][kt] = (f32x4){0.f, 0.f, 0.f, 0.f}; s[1][kt] = (f32x4){0.f, 0.f, 0.f, 0.f};
#pragma unroll
                for (int kc = 0; kc < 4; ++kc) { const bf16x8 kf = *(const LAS bf16x8*)(Kt + (16 * kt + fr) * AT_PITCH + (kc * 32 + fq * 8) * 2);
                    s[0][kt] = __builtin_amdgcn_mfma_f32_16x16x32_bf16(kf, qf[0][kc], s[0][kt], 0, 0, 0); s[1][kt] = __builtin_amdgcn_mfma_f32_16x16x32_bf16(kf, qf[1][kc], s[1][kt], 0, 0, 0); } }
            bf16x8 pf[2][2];
#pragma unroll
            for (int t = 0; t < 2; ++t) { const int qabs = q0 + 32 * wave + 16 * t + fr; const unsigned ms = t ? mysel1 : mysel0;
                const bool qsel = own || ((ms >> (kt64 >> 2)) & 1u);
                float mx = -INFINITY;
#pragma unroll
                for (int kt = 0; kt < 4; ++kt)
#pragma unroll
                    for (int e = 0; e < 4; ++e) { const int kabs = key0 + 16 * kt + 4 * fq + e; const bool valid = own ? (kabs <= qabs) : qsel;
                        const float v = valid ? s[t][kt][e] * sc : -INFINITY; s[t][kt][e] = v; mx = fmaxf(mx, v); }
                mx = fmaxf(mx, __shfl_xor(mx, 16)); mx = fmaxf(mx, __shfl_xor(mx, 32));
                const float mnew = fmaxf(mrun[t], mx);
                const float alpha = (mnew == -INFINITY) ? 1.f : __builtin_amdgcn_exp2f(mrun[t] - mnew);
                const float msub = (mnew == -INFINITY) ? 0.f : mnew;
                float psum = 0.f;
#pragma unroll
                for (int kt = 0; kt < 4; ++kt)
#pragma unroll
                    for (int e = 0; e < 4; ++e) { const float p = __builtin_amdgcn_exp2f(s[t][kt][e] - msub); s[t][kt][e] = p; psum += p; }
                lrun[t] = lrun[t] * alpha + psum; mrun[t] = mnew;
#pragma unroll
                for (int i = 0; i < 8; ++i) o[t][i] *= alpha;
#pragma unroll
                for (int j = 0; j < 2; ++j) { const v4u w = {pk2(s[t][2 * j][0], s[t][2 * j][1]), pk2(s[t][2 * j][2], s[t][2 * j][3]), pk2(s[t][2 * j + 1][0], s[t][2 * j + 1][1]), pk2(s[t][2 * j + 1][2], s[t][2 * j + 1][3])};
                    pf[t][j] = __builtin_bit_cast(bf16x8, w); } }
#pragma unroll
            for (int dt = 0; dt < 8; ++dt)
#pragma unroll
                for (int j = 0; j < 2; ++j) { const LAS unsigned char* vp = Vt + (32 * j + 4 * fq + q4) * AT_PITCH + (16 * dt + 4 * p4) * 2;
                    const v2u lo = tr_read(vp), hi = tr_read(vp + 16 * AT_PITCH);
                    const bf16x8 vf = __builtin_bit_cast(bf16x8, (v4u){lo.x, lo.y, hi.x, hi.y});
                    o[0][dt] = __builtin_amdgcn_mfma_f32_16x16x32_bf16(vf, pf[0][j], o[0][dt], 0, 0, 0); o[1][dt] = __builtin_amdgcn_mfma_f32_16x16x32_bf16(vf, pf[1][j], o[1][dt], 0, 0, 0); }
        }
        if (ti + 1 < ntile) lstore((ti + 1) & 1);
        __syncthreads();
    }
#pragma unroll
    for (int t = 0; t < 2; ++t) { float lt = lrun[t]; lt += __shfl_xor(lt, 16); lt += __shfl_xor(lt, 32);
        const float inv = 1.f / lt;
        bf16* Y = (bf16*)(ws + WS_YE) + (size_t)(b * SEQ + q0 + 32 * wave + 16 * t + fr) * 2048 + h * 128;
#pragma unroll
        for (int dt = 0; dt < 8; ++dt) { v2u w; w.x = pk2(o[t][dt][0] * inv, o[t][dt][1] * inv); w.y = pk2(o[t][dt][2] * inv, o[t][dt][3] * inv); *(v2u*)(Y + 16 * dt + 4 * fq) = w; } }
    __syncthreads();
}

__device__ __forceinline__ void mlstm_scan(const int wv) {
    const ArgsP a = get_args();
    OPAQUE_TID();
    unsigned char* ws = a->ws;
    const int gt = blockIdx.x * NTHR + tid, NGT = gridDim.x * NTHR;
    for (int idx = gt; idx < 16 * 256 * 32; idx += NGT) { const int bh = idx >> 13, rem = idx & 8191;
        const bf16* DC = (const bf16*)(ws + WS_DC) + (size_t)bh * 64 * 65536 + rem * 8; bf16* CP = (bf16*)(ws + WS_CP) + (size_t)bh * 64 * 65536 + rem * 8;
        const float* dec = (const float*)(ws + WS_DEC) + bh * 64;
        float C[8] = {0, 0, 0, 0, 0, 0, 0, 0};
        for (int c0 = 0; c0 < 64; c0 += 8) { v4u in[8];
#pragma unroll
            for (int j = 0; j < 8; ++j) in[j] = __builtin_nontemporal_load((const v4u*)(DC + (size_t)(c0 + j) * 65536));
#pragma unroll
            for (int j = 0; j < 8; ++j) { const float dc = dec[c0 + j];
                *(v4u*)(CP + (size_t)(c0 + j) * 65536) = (v4u){pk2(C[0], C[1]), pk2(C[2], C[3]), pk2(C[4], C[5]), pk2(C[6], C[7])};
                C[0] = fmaf(dc, C[0], bflo(in[j].x)); C[1] = fmaf(dc, C[1], bfhi(in[j].x)); C[2] = fmaf(dc, C[2], bflo(in[j].y)); C[3] = fmaf(dc, C[3], bfhi(in[j].y));
                C[4] = fmaf(dc, C[4], bflo(in[j].z)); C[5] = fmaf(dc, C[5], bfhi(in[j].z)); C[6] = fmaf(dc, C[6], bflo(in[j].w)); C[7] = fmaf(dc, C[7], bfhi(in[j].w)); } }
    }
    for (int idx = gt; idx < 16 * 256; idx += NGT) { const int bh = idx >> 8, d = idx & 255; const float* DN = (const float*)(ws + WS_DN) + (size_t)bh * 64 * 256 + d; float* NP = (float*)(ws + WS_NP) + (size_t)bh * 64 * 256 + d;
        const float* dec = (const float*)(ws + WS_DEC) + bh * 64; float n = 0.f;
        for (int c = 0; c < 64; ++c) { NP[c * 256] = n; n = fmaf(dec[c], n, DN[c * 256]); } }
}

constexpr int M3_PQ = 528, M3_PVv = 544, M3_PP = 144;
constexpr int M3_Q = 0, M3_K = 64 * M3_PQ, M3_V = 2 * 64 * M3_PQ, M3_P = M3_V + 64 * M3_PVv, M3_F = M3_P + 64 * M3_PP;
__device__ __forceinline__ void mlstm_out_unit(const int wv, LAS unsigned char* lds, int e_, int b, int h, int c) {
    const ArgsP a = get_args();
    OPAQUE_TID(); const int lane = tid & 63, wave = wv, fr = lane & 15, fq = lane >> 4, q4 = (lane >> 2) & 3, p4 = lane & 3;
    unsigned char* ws = a->ws;
    const int bh = b * 4 + h, m0 = b * SEQ + 64 * c;
    const bf16* QKB = (const bf16*)(ws + WS_QKB); const bf16* Z = (const bf16*)(ws + WS_Z);
    LAS unsigned char* Qt = lds + M3_Q; LAS unsigned char* Kt = lds + M3_K; LAS unsigned char* Vt = lds + M3_V; LAS unsigned char* Pm = lds + M3_P;
    LAS float* F = (LAS float*)(lds + M3_F); LAS float* bt = F; LAS float* itv = F + 64; LAS float* ebt = F + 128; LAS float* den = F + 192; LAS float* rstd = F + 256; LAS float* np = F + 320; LAS float* rsp = F + 576;
    { const int sr = tid >> 3, seg = tid & 7;
      const v4u* qs = (const v4u*)(QKB + (size_t)(m0 + sr) * 2048 + h * 256 + 32 * seg); const v4u* ks = (const v4u*)(QKB + (size_t)(m0 + sr) * 2048 + 1024 + h * 256 + 32 * seg);
      const v4u* vs = (const v4u*)(Z + (size_t)(m0 + sr) * ZW + 5120 + h * 256 + 32 * seg);
#pragma unroll
      for (int j = 0; j < 4; ++j) { *(LAS v4u*)(Qt + sr * M3_PQ + (32 * seg + 8 * j) * 2) = qs[j]; *(LAS v4u*)(Kt + sr * M3_PQ + (32 * seg + 8 * j) * 2) = ks[j]; *(LAS v4u*)(Vt + sr * M3_PVv + (32 * seg + 8 * j) * 2) = vs[j]; }
      if (tid < 64) { const float bb = ((const float*)(ws + WS_BC))[(size_t)bh * SEQ + 64 * c + tid]; bt[tid] = bb; ebt[tid] = __expf(bb); itv[tid] = ((const float*)(ws + WS_IG))[(size_t)bh * SEQ + 64 * c + tid]; }
      else if (tid < 320) np[tid - 64] = ((const float*)(ws + WS_NP))[((size_t)bh * 64 + c) * 256 + tid - 64]; }
    v4u cf[8][2];
    { const bf16* CP = (const bf16*)(ws + WS_CP) + ((size_t)bh * 64 + c) * 65536 + (size_t)(32 * wave + fr) * 256 + 8 * fq;
#pragma unroll
      for (int kk = 0; kk < 8; ++kk)
#pragma unroll
          for (int et = 0; et < 2; ++et) cf[kk][et] = *(const v4u*)(CP + et * 16 * 256 + 32 * kk); }
    __syncthreads();
    { const int ss = wave >> 1;
#pragma unroll
      for (int ti = 0; ti < 2; ++ti) { const int tt = 2 * (wave & 1) + ti; f32x4 sacc = {0.f, 0.f, 0.f, 0.f};
#pragma unroll
          for (int kk = 0; kk < 8; ++kk) { const bf16x8 kf = *(const LAS bf16x8*)(Kt + (16 * ss + fr) * M3_PQ + (32 * kk + 8 * fq) * 2), qf = *(const LAS bf16x8*)(Qt + (16 * tt + fr) * M3_PQ + (32 * kk + 8 * fq) * 2);
              sacc = __builtin_amdgcn_mfma_f32_16x16x32_bf16(kf, qf, sacc, 0, 0, 0); }
          const int t = 16 * tt + fr; const float btv = bt[t]; float pv[4];
#pragma unroll
          for (int r = 0; r < 4; ++r) { const int s_ = 16 * ss + 4 * fq + r; pv[r] = (s_ <= t) ? sacc[r] * __expf(btv - bt[s_] + itv[s_]) * 0.0625f : 0.f; }
          *(LAS v2u*)(Pm + t * M3_PP + (16 * ss + 4 * fq) * 2) = (v2u){pk2(pv[0], pv[1]), pk2(pv[2], pv[3])}; } }
    float qn;
    { const int t = tid >> 3, part = tid & 7; float sacc = 0.f;
#pragma unroll
      for (int j = 0; j < 4; ++j) { const v4u w = *(const LAS v4u*)(Qt + t * M3_PQ + (32 * part + 8 * j) * 2); const LAS float* nn = np + 32 * part + 8 * j;
          sacc += bflo(w.x) * nn[0] + bfhi(w.x) * nn[1] + bflo(w.y) * nn[2] + bfhi(w.y) * nn[3] + bflo(w.z) * nn[4] + bfhi(w.z) * nn[5] + bflo(w.w) * nn[6] + bfhi(w.w) * nn[7]; }
      sacc += dppf<0xB1>(sacc); sacc += dppf<0x4E>(sacc); sacc += dppf<0x141>(sacc); qn = sacc; }
    __syncthreads();
    { const int t = tid >> 3, part = tid & 7; const v4u w = *(const LAS v4u*)(Pm + t * M3_PP + part * 16);
      float ps = bflo(w.x) + bfhi(w.x) + bflo(w.y) + bfhi(w.y) + bflo(w.z) + bfhi(w.z) + bflo(w.w) + bfhi(w.w);
      ps += dppf<0xB1>(ps); ps += dppf<0x4E>(ps); ps += dppf<0x141>(ps);
      if (part == 0) den[t] = ebt[t] * qn + ps; }
    f32x4 acc[4][2];
#pragma unroll
    for (int tt = 0; tt < 4; ++tt) { acc[tt][0] = (f32x4){0.f, 0.f, 0.f, 0.f}; acc[tt][1] = (f32x4){0.f, 0.f, 0.f, 0.f}; }
#pragma unroll
    for (int kk = 0; kk < 8; ++kk)
#pragma unroll
        for (int tt = 0; tt < 4; ++tt) { const bf16x8 qf = *(const LAS bf16x8*)(Qt + (16 * tt + fr) * M3_PQ + (32 * kk + 8 * fq) * 2);
            acc[tt][0] = __builtin_amdgcn_mfma_f32_16x16x32_bf16(qf, __builtin_bit_cast(bf16x8, cf[kk][0]), acc[tt][0], 0, 0, 0);
            acc[tt][1] = __builtin_amdgcn_mfma_f32_16x16x32_bf16(qf, __builtin_bit_cast(bf16x8, cf[kk][1]), acc[tt][1], 0, 0, 0); }
#pragma unroll
    for (int tt = 0; tt < 4; ++tt) { const f32x4 eb = *(const LAS f32x4*)(ebt + 16 * tt + 4 * fq); acc[tt][0] *= eb; acc[tt][1] *= eb; }
#pragma unroll
    for (int j = 0; j < 2; ++j) { bf16x8 vf[2];
#pragma unroll
        for (int et = 0; et < 2; ++et) { const LAS unsigned char* p = Vt + (32 * j + 8 * fq + q4) * M3_PVv + (32 * wave + 16 * et + 4 * p4) * 2;
            const v2u lo = tr_read(p), hi = tr_read(p + 4 * M3_PVv); vf[et] = __builtin_bit_cast(bf16x8, (v4u){lo.x, lo.y, hi.x, hi.y}); }
#pragma unroll
        for (int tt = 0; tt < 4; ++tt) { const bf16x8 pf = *(const LAS bf16x8*)(Pm + (16 * tt + fr) * M3_PP + (32 * j + 8 * fq) * 2);
            acc[tt][0] = __builtin_amdgcn_mfma_f32_16x16x32_bf16(pf, vf[0], acc[tt][0], 0, 0, 0); acc[tt][1] = __builtin_amdgcn_mfma_f32_16x16x32_bf16(pf, vf[1], acc[tt][1], 0, 0, 0); } }
    __syncthreads();
    LAS unsigned char* Ht = Qt;
#pragma unroll
    for (int tt = 0; tt < 4; ++tt) { const f32x4 dn = *(const LAS f32x4*)(den + 16 * tt + 4 * fq); float ssq[4];
#pragma unroll
        for (int r = 0; r < 4; ++r) { const float dv = 1.f / fmaxf(fabsf(dn[r]), 1.f); const float h0 = acc[tt][0][r] * dv, h1 = acc[tt][1][r] * dv; ssq[r] = red16(h0 * h0 + h1 * h1);
            const int t = 16 * tt + 4 * fq + r;
            *(LAS bf16*)(Ht + t * M3_PQ + (32 * wave + fr) * 2) = (bf16)f2bf(h0); *(LAS bf16*)(Ht + t * M3_PQ + (32 * wave + 16 + fr) * 2) = (bf16)f2bf(h1); }
        if (fr == 0) *(LAS f32x4*)(rsp + wave * 64 + 16 * tt + 4 * fq) = (f32x4){ssq[0], ssq[1], ssq[2], ssq[3]}; }
    __syncthreads();
    if (tid < 64) { float tot = 0.f;
#pragma unroll
        for (int w = 0; w < 8; ++w) tot += rsp[w * 64 + tid];
        rstd[tid] = 1.f / sqrtf(tot * (1.f / 256.f) + 1e-6f); }
    __syncthreads();
    { const int t = tid >> 3, seg = tid & 7; const float rs = rstd[t]; const float* hg = a->in[5] + (size_t)e_ * 1024 + h * 256 + 32 * seg;
      const v4u* os = (const v4u*)(Z + (size_t)(m0 + t) * ZW + 6144 + h * 256 + 32 * seg); v4u* yd = (v4u*)((bf16*)(ws + WS_YE) + (size_t)(m0 + t) * 2048 + 1024 + h * 256 + 32 * seg);
#pragma unroll
      for (int j = 0; j < 4; ++j) { const v4u hw = *(const LAS v4u*)(Ht + t * M3_PQ + (32 * seg + 8 * j) * 2), ow = os[j]; const f32x4 g0 = *(const f32x4*)(hg + 8 * j), g1 = *(const f32x4*)(hg + 8 * j + 4);
          yd[j] = (v4u){pk2(bflo(hw.x) * rs * g0.x * sigmoidf_(bflo(ow.x)), bfhi(hw.x) * rs * g0.y * sigmoidf_(bfhi(ow.x))), pk2(bflo(hw.y) * rs * g0.z * sigmoidf_(bflo(ow.y)), bfhi(hw.y) * rs * g0.w * sigmoidf_(bfhi(ow.y))),
                        pk2(bflo(hw.z) * rs * g1.x * sigmoidf_(bflo(ow.z)), bfhi(hw.z) * rs * g1.y * sigmoidf_(bfhi(ow.z))), pk2(bflo(hw.w) * rs * g1.z * sigmoidf_(bflo(ow.w)), bfhi(hw.w) * rs * g1.w * sigmoidf_(bfhi(ow.w)))}; } }
    __syncthreads();
}

__device__ __forceinline__ void odd_prep(const int wv, int o) {
    const ArgsP a = get_args();
#ifdef NO_OPREP
    return;
#endif
    OPAQUE_TID(); const int lane = tid & 63, wave = tid >> 6;
    unsigned char* ws = a->ws;
    const float* mu = a->in[7] + (size_t)o * 6 * 2048;
    bf16* XR = (bf16*)(ws + WS_XRKV); bf16* XK = XR + (size_t)T_ * 2048; bf16* XV = XK + (size_t)T_ * 2048; bf16* XC = (bf16*)(ws + WS_XC);
    const int gw = blockIdx.x * NWAVES + wave, NGW = gridDim.x * NWAVES;
    for (int m = gw; m < T_; m += NGW) { const bool first = (m % SEQ) == 0;
        const f32x4* xr = (const f32x4*)(a->out + (size_t)m * D_) + lane; const f32x4* xp = (const f32x4*)(a->out + (size_t)(m - 1) * D_) + lane;
#pragma unroll
        for (int j = 0; j < 8; ++j) { const f32x4 x = xr[64 * j]; f32x4 p = {0.f, 0.f, 0.f, 0.f}; if (!first) p = xp[64 * j]; const f32x4 dx = p - x;
            const f32x4 m0 = ((const f32x4*)mu)[lane + 64 * j], m2 = ((const f32x4*)(mu + 2 * 2048))[lane + 64 * j], m3 = ((const f32x4*)(mu + 3 * 2048))[lane + 64 * j];
            const f32x4 r = x + dx * m0, k = x + dx * m2, v = x + dx * m3; const size_t off = (size_t)m * 2048 + 4 * (lane + 64 * j);
            *(v2u*)(XR + off) = (v2u){pk2(r.x, r.y), pk2(r.z, r.w)}; *(v2u*)(XK + off) = (v2u){pk2(k.x, k.y), pk2(k.z, k.w)}; *(v2u*)(XV + off) = (v2u){pk2(v.x, v.y), pk2(v.z, v.w)};
            const size_t offc = (size_t)m * 4096 + 4 * (lane + 64 * j);
            *(v2u*)(XC + offc) = (v2u){pk2(x.x, x.y), pk2(x.z, x.w)}; *(v2u*)(XC + offc + 2048) = (v2u){pk2(dx.x, dx.y), pk2(dx.z, dx.w)}; }
    }
}

constexpr int RK_KQ = 0, RK_RQ = 4096, RK_TAB = 8192, RK_XU = 9216, RK_W4 = 17408, RK_VB = 19456, RK_CBUF = 27648;
constexpr int RK_XS = MISC_OFF + 4096;
constexpr int RK_PB0 = 2 * RK_CBUF, RK_PG = 0, RK_PV = 8192, RK_PBON = 16384, RK_PBSZ = 16512;
constexpr int RK_Y0 = RK_PB0 + 3 * RK_PBSZ, RK_YSZ = 64 * 36 * 4;
static_assert(RK_Y0 + 2 * RK_YSZ <= RING_BYTES && RK_XS + 8192 <= LDS_BYTES, "rwkv LDS map");
__device__ __forceinline__ float dot16(const f32x4 x, const f32x4 y) { return red16(x.x * y.x + x.y * y.y + x.z * y.z + x.w * y.w); }
__device__ __forceinline__ v2u pk4(const f32x4 v) { return (v2u){pk2(v.x, v.y), pk2(v.z, v.w)}; }
__device__ __forceinline__ f32x4 unpk4(const v2u w) { return (f32x4){bflo(w.x), bfhi(w.x), bflo(w.y), bfhi(w.y)}; }

__device__ __forceinline__ void rwkv_unit(const int wv, LAS unsigned char* lds, int o, int b, int h) {
    const ArgsP a = get_args();
#ifdef NO_RWKV
    return;
#endif
    OPAQUE_TID(); const int lane = tid & 63, fr = lane & 15, fq = lane >> 4;
    unsigned char* ws = a->ws;
    constexpr int NCH = SEQ / 32;
    if (wv < 4) {
        f32x4 S[4];
#pragma unroll
        for (int kt = 0; kt < 4; ++kt) S[kt] = (f32x4){0.f, 0.f, 0.f, 0.f};
        const int row = 16 * wv + fr;
        const bool f0 = fq == 0;
        struct Ops { v2u kq[4], rq[4]; f32x4 tab[8], vv, w4[4]; v4u xu[4]; };
        auto load_ops = [&](const LAS unsigned char* B, int bk, Ops& o) {
            const LAS unsigned char* kp = B + RK_KQ + bk * 512 + (fr & 3) * 128 + 8 * fq; const LAS unsigned char* rp = kp + (RK_RQ - RK_KQ);
#pragma unroll
            for (int ks = 0; ks < 2; ++ks) { o.kq[2 * ks] = *(const LAS v2u*)(kp + 64 * ks); o.kq[2 * ks + 1] = *(const LAS v2u*)(kp + 64 * ks + 32); o.rq[2 * ks] = *(const LAS v2u*)(rp + 64 * ks); o.rq[2 * ks + 1] = *(const LAS v2u*)(rp + 64 * ks + 32); }
#pragma unroll
            for (int i = 0; i < 8; ++i) o.tab[i] = *(const LAS f32x4*)(B + RK_TAB + bk * 128 + 16 * i);
            o.vv = *(const LAS f32x4*)(B + RK_VB + bk * 1024 + row * 16);
#pragma unroll
            for (int kt = 0; kt < 4; ++kt) { o.w4[kt] = *(const LAS f32x4*)(B + RK_W4 + bk * 256 + (16 * kt + 4 * fq) * 4); o.xu[kt] = *(const LAS v4u*)(B + RK_XU + bk * 1024 + (16 * kt + fr) * 16); } };
        auto step = [&](const Ops& o, f32x4& yout) {
            bf16x8 ys[2];
#pragma unroll
            for (int ks = 0; ks < 2; ++ks) { const v4u w = {pk2(S[2 * ks][0], S[2 * ks][1]), pk2(S[2 * ks][2], S[2 * ks][3]), pk2(S[2 * ks + 1][0], S[2 * ks + 1][1]), pk2(S[2 * ks + 1][2], S[2 * ks + 1][3])}; ys[ks] = __builtin_bit_cast(bf16x8, w); }
            f32x4 du = {0.f, 0.f, 0.f, 0.f}, dy = {0.f, 0.f, 0.f, 0.f};
#pragma unroll
            for (int ks = 0; ks < 2; ++ks) {
                du = __builtin_amdgcn_mfma_f32_16x16x32_bf16(__builtin_bit_cast(bf16x8, (v4u){o.kq[2 * ks].x, o.kq[2 * ks].y, o.kq[2 * ks + 1].x, o.kq[2 * ks + 1].y}), ys[ks], du, 0, 0, 0);
                dy = __builtin_amdgcn_mfma_f32_16x16x32_bf16(__builtin_bit_cast(bf16x8, (v4u){o.rq[2 * ks].x, o.rq[2 * ks].y, o.rq[2 * ks + 1].x, o.rq[2 * ks + 1].y}), ys[ks], dy, 0, 0, 0); }
            const f32x4 t0 = o.tab[0], t1 = o.tab[1], t2 = o.tab[2], t3 = o.tab[3], t4 = o.tab[4], t5 = o.tab[5], t6 = o.tab[6], t7 = o.tab[7]; const f32x4 vv = o.vv;
            const float u0 = du[0];
            const float u1 = du[1] + vv.x * t0.x - u0 * t0.y;
            const float u2 = du[2] + vv.x * t0.z - u0 * t1.x + vv.y * t0.w - u1 * t1.y;
            const float u3 = du[3] + vv.x * t1.z - u0 * t2.y + vv.y * t1.w - u1 * t2.z + vv.z * t2.x - u2 * t2.w;
            yout.x = dy[0] + vv.x * t3.x - u0 * t3.y;
            yout.y = dy[1] + vv.x * t3.z - u0 * t4.x + vv.y * t3.w - u1 * t4.y;
            yout.z = dy[2] + vv.x * t4.z - u0 * t5.y + vv.y * t4.w - u1 * t5.z + vv.z * t5.x - u2 * t5.w;
            yout.w = dy[3] + vv.x * t6.x - u0 * t7.x + vv.y * t6.y - u1 * t7.y + vv.z * t6.z - u2 * t7.z + vv.w * t6.w - u3 * t7.w;
            v4u yw = {pk2(vv.x, vv.y), pk2(vv.z, vv.w), pk2(u0, u1), pk2(u2, u3)};
            if (!f0) yw = (v4u){0u, 0u, 0u, 0u};
            const bf16x8 yop = __builtin_bit_cast(bf16x8, yw);
#pragma unroll
            for (int kt = 0; kt < 4; ++kt) { v4u xw = o.xu[kt]; if (!f0) xw = (v4u){0u, 0u, 0u, 0u};
                S[kt] = __builtin_amdgcn_mfma_f32_16x16x32_bf16(__builtin_bit_cast(bf16x8, xw), yop, S[kt] * o.w4[kt], 0, 0, 0); } };
        __syncthreads();
        for (int c = 0; c < NCH; ++c) {
            const LAS unsigned char* B = lds + (c & 1) * RK_CBUF; LAS float* yb = (LAS float*)(lds + RK_Y0 + (c & 1) * RK_YSZ) + row * 36;
            Ops oa, ob; f32x4 yk[8];
            load_ops(B, 0, oa);
#pragma unroll
            for (int bp = 0; bp < 4; ++bp) { load_ops(B, 2 * bp + 1, ob); step(oa, yk[2 * bp]); if (bp < 3) load_ops(B, 2 * bp + 2, oa); step(ob, yk[2 * bp + 1]); }
            if (f0) {
#pragma unroll
                for (int bk = 0; bk < 8; ++bk) *(LAS f32x4*)(yb + 4 * bk) = yk[bk]; }
            __syncthreads();
        }
    } else if (wv < 6) {
        const int ptid = tid - 256, g8 = ptid >> 4, kq = ptid & 15;
        const size_t rowbase = (size_t)b * SEQ * 2048 + h * 64 + 4 * kq;
        const bf16* Rb = (const bf16*)(ws + WS_RKV) + rowbase; const bf16* Kb = Rb + (size_t)T_ * 2048; const bf16* Vb = Kb + (size_t)T_ * 2048;
        const bf16* Gb = (const bf16*)(ws + WS_G) + rowbase; const bf16* WDb = (const bf16*)(ws + WS_WD) + rowbase; const bf16* AAb = (const bf16*)(ws + WS_AA) + rowbase;
        const int pc = h * 64 + 4 * kq;
        const f32x4 p_kk = *(const f32x4*)(a->in[20] + (size_t)o * 2048 + pc), p_ka = *(const f32x4*)(a->in[21] + (size_t)o * 2048 + pc), p_rk = *(const f32x4*)(a->in[22] + (size_t)o * 2048 + pc);
        v2u gk[4], ga[4], gw[4], gr[4], gv[4], gg[4];
        auto gload = [&](int c) {
#pragma unroll
            for (int j = 0; j < 4; ++j) { const size_t off = (size_t)(32 * c + 4 * g8 + j) * 2048;
                gk[j] = *(const v2u*)(Kb + off); ga[j] = *(const v2u*)(AAb + off); gw[j] = *(const v2u*)(WDb + off); gr[j] = *(const v2u*)(Rb + off); gv[j] = *(const v2u*)(Vb + off); gg[j] = *(const v2u*)(Gb + off); } };
        v2u hk[4], ha[4], hw[4], hr[4], hv[4], hg[4];
        auto take = [&]() {
#pragma unroll
            for (int j = 0; j < 4; ++j) { hk[j] = gk[j]; ha[j] = ga[j]; hw[j] = gw[j]; hr[j] = gr[j]; hv[j] = gv[j]; hg[j] = gg[j]; } };
        auto prep = [&](int c) {
            LAS unsigned char* B = lds + (c & 1) * RK_CBUF; LAS unsigned char* P = lds + RK_PB0 + (c % 3) * RK_PBSZ;
            f32x4 kk[4], bbv[4], kh[4], w[4], r[4], v[4];
#pragma unroll
            for (int j = 0; j < 4; ++j) { const f32x4 k = unpk4(hk[j]), aa = unpk4(ha[j]), wd = unpk4(hw[j]); r[j] = unpk4(hr[j]); v[j] = unpk4(hv[j]);
                const f32x4 kx = k * p_kk; const float inv = __builtin_amdgcn_rsqf(fmaxf(dot16(kx, kx), 1e-24f)); kk[j] = kx * inv; bbv[j] = kk[j] * aa; kh[j] = k * (1.f + (aa - 1.f) * p_ka);
                w[j] = (f32x4){__expf(wd.x), __expf(wd.y), __expf(wd.z), __expf(wd.w)};
                const float bon = dot16(r[j] * kh[j], p_rk);
                *(LAS f32x4*)(P + RK_PG + ((4 * g8 + j) * 64 + 4 * kq) * 4) = unpk4(hg[j]); *(LAS f32x4*)(P + RK_PV + ((4 * g8 + j) * 64 + 4 * kq) * 4) = v[j];
                if (kq == 0) *(LAS float*)(P + RK_PBON + (4 * g8 + j) * 4) = bon; }
            const f32x4 W1 = w[0], W2 = w[0] * w[1], W3 = W2 * w[2], W4 = W3 * w[3];
            const f32x4 i1 = {__builtin_amdgcn_rcpf(W1.x), __builtin_amdgcn_rcpf(W1.y), __builtin_amdgcn_rcpf(W1.z), __builtin_amdgcn_rcpf(W1.w)}, i2 = {__builtin_amdgcn_rcpf(W2.x), __builtin_amdgcn_rcpf(W2.y), __builtin_amdgcn_rcpf(W2.z), __builtin_amdgcn_rcpf(W2.w)},
                        i3 = {__builtin_amdgcn_rcpf(W3.x), __builtin_amdgcn_rcpf(W3.y), __builtin_amdgcn_rcpf(W3.z), __builtin_amdgcn_rcpf(W3.w)}, i4 = {__builtin_amdgcn_rcpf(W4.x), __builtin_amdgcn_rcpf(W4.y), __builtin_amdgcn_rcpf(W4.z), __builtin_amdgcn_rcpf(W4.w)};
            const f32x4 hh0 = kh[0] * i1, hh1 = kh[1] * i2, hh2 = kh[2] * i3, hh3 = kh[3] * i4, bh0 = bbv[0] * i1, bh1 = bbv[1] * i2, bh2 = bbv[2] * i3, bh3 = bbv[3] * i4;
            *(LAS v2u*)(B + RK_KQ + g8 * 512 + 0 * 128 + 8 * kq) = pk4(kk[0]);      *(LAS v2u*)(B + RK_RQ + g8 * 512 + 0 * 128 + 8 * kq) = pk4(r[0] * W1);
            *(LAS v2u*)(B + RK_KQ + g8 * 512 + 1 * 128 + 8 * kq) = pk4(kk[1] * W1); *(LAS v2u*)(B + RK_RQ + g8 * 512 + 1 * 128 + 8 * kq) = pk4(r[1] * W2);
            *(LAS v2u*)(B + RK_KQ + g8 * 512 + 2 * 128 + 8 * kq) = pk4(kk[2] * W2); *(LAS v2u*)(B + RK_RQ + g8 * 512 + 2 * 128 + 8 * kq) = pk4(r[2] * W3);
            *(LAS v2u*)(B + RK_KQ + g8 * 512 + 3 * 128 + 8 * kq) = pk4(kk[3] * W3); *(LAS v2u*)(B + RK_RQ + g8 * 512 + 3 * 128 + 8 * kq) = pk4(r[3] * W4);
            { LAS unsigned char* xs = lds + RK_XS + (wv - 4) * 4096 + (lane >> 4) * 1024 + 8 * kq;
              *(LAS v2u*)(xs + 0 * 128) = pk4(hh0); *(LAS v2u*)(xs + 1 * 128) = pk4(hh1); *(LAS v2u*)(xs + 2 * 128) = pk4(hh2); *(LAS v2u*)(xs + 3 * 128) = pk4(hh3);
              *(LAS v2u*)(xs + 4 * 128) = pk4(bh0); *(LAS v2u*)(xs + 5 * 128) = pk4(bh1); *(LAS v2u*)(xs + 6 * 128) = pk4(bh2); *(LAS v2u*)(xs + 7 * 128) = pk4(bh3); }
            { const f32x4 hw0 = hh0 * W4, hw1 = hh1 * W4, hw2 = hh2 * W4, hw3 = kh[3], bw0 = bh0 * W4, bw1 = bh1 * W4, bw2 = bh2 * W4, bw3 = bbv[3];
#pragma unroll
              for (int i = 0; i < 4; ++i) *(LAS v4u*)(B + RK_XU + g8 * 1024 + (4 * kq + i) * 16) = (v4u){pk2(hw0[i], hw1[i]), pk2(hw2[i], hw3[i]), pk2(-bw0[i], -bw1[i]), pk2(-bw2[i], -bw3[i])};
              *(LAS f32x4*)(B + RK_W4 + g8 * 256 + 16 * kq) = W4;
#pragma unroll
              for (int i = 0; i < 4; ++i) *(LAS f32x4*)(B + RK_VB + g8 * 1024 + (4 * kq + i) * 16) = (f32x4){v[0][i], v[1][i], v[2][i], v[3][i]}; }
            asm volatile("s_waitcnt lgkmcnt(0)" ::: "memory");
            { const int fr = lane & 15, fq = lane >> 4;
#pragma unroll
              for (int p = 0; p < 2; ++p) { const int grp = 2 * p + (fr >> 3), rw = fr & 7, blk = 4 * (wv - 4) + grp;
                  const LAS unsigned char* xp = lds + RK_XS + (wv - 4) * 4096 + grp * 1024 + rw * 128 + 16 * fq;
                  const LAS unsigned char* yp = B + ((rw < 4) ? RK_KQ + blk * 512 + rw * 128 : RK_RQ + blk * 512 + (rw - 4) * 128) + 16 * fq;
                  f32x4 d = {0.f, 0.f, 0.f, 0.f};
                  d = __builtin_amdgcn_mfma_f32_16x16x32_bf16(*(const LAS bf16x8*)xp, *(const LAS bf16x8*)yp, d, 0, 0, 0);
                  d = __builtin_amdgcn_mfma_f32_16x16x32_bf16(*(const LAS bf16x8*)(xp + 64), *(const LAS bf16x8*)(yp + 64), d, 0, 0, 0);
                  if ((fr >> 3) == (fq >> 1) && rw >= 1) { const int cnt = (rw < 4) ? rw : rw - 3; const int base = (rw == 1) ? 0 : (rw == 2) ? 2 : (rw == 3) ? 6 : (rw == 4) ? 12 : (rw == 5) ? 14 : (rw == 6) ? 18 : 24;
                      LAS float* tp = (LAS float*)(B + RK_TAB + blk * 128) + base + (fq & 1) * cnt;
                      tp[0] = d[0]; if (cnt > 1) tp[1] = d[1]; if (cnt > 2) tp[2] = d[2]; if (cnt > 3) tp[3] = d[3]; } } }
            asm volatile("" ::: "memory");
        };
        gload(0); take(); gload(1); prep(0);
        __syncthreads();
        for (int c = 0; c < NCH; ++c) {
            if (c + 1 < NCH) { take(); if (c + 2 < NCH) gload(c + 2); prep(c + 1); }
            __syncthreads();
        }
    } else {
        const int qtid = tid - 384, st = qtid >> 2, rq = qtid & 3;
        bf16* Yb = (bf16*)(ws + WS_YO) + (size_t)b * SEQ * 2048 + h * 64 + 16 * rq;
        const float* lg = a->in[23] + (size_t)o * 2048 + h * 64 + 16 * rq; const float* lb = a->in[24] + (size_t)o * 2048 + h * 64 + 16 * rq;
        auto post = [&](int c) {
            const LAS float* yb = (const LAS float*)(lds + RK_Y0 + (c & 1) * RK_YSZ); const LAS unsigned char* P = lds + RK_PB0 + (c % 3) * RK_PBSZ;
            float y[16]; float s1 = 0.f;
#pragma unroll
            for (int i = 0; i < 16; ++i) { y[i] = yb[(16 * rq + i) * 36 + st]; s1 += y[i]; }
            s1 += dppf<0xB1>(s1); s1 += dppf<0x4E>(s1); const float mean = s1 * (1.f / 64.f); float s2 = 0.f;
#pragma unroll
            for (int i = 0; i < 16; ++i) { y[i] -= mean; s2 += y[i] * y[i]; }
            s2 += dppf<0xB1>(s2); s2 += dppf<0x4E>(s2); const float rstd = 1.f / sqrtf(s2 * (1.f / 64.f) + 64e-5f);
            const float bon = *(const LAS float*)(P + RK_PBON + st * 4);
            unsigned ow[8];
#pragma unroll
            for (int i4 = 0; i4 < 4; ++i4) { const f32x4 g = *(const LAS f32x4*)(P + RK_PG + (st * 64 + 16 * rq + 4 * i4) * 4), v = *(const LAS f32x4*)(P + RK_PV + (st * 64 + 16 * rq + 4 * i4) * 4);
                const f32x4 lgv = *(const f32x4*)(lg + 4 * i4), lbv = *(const f32x4*)(lb + 4 * i4); float o4[4];
#pragma unroll
                for (int i = 0; i < 4; ++i) o4[i] = (y[4 * i4 + i] * rstd * lgv[i] + lbv[i] + bon * v[i]) * g[i];
                ow[2 * i4] = pk2(o4[0], o4[1]); ow[2 * i4 + 1] = pk2(o4[2], o4[3]); }
            v4u* dst = (v4u*)(Yb + (size_t)(32 * c + st) * 2048); dst[0] = (v4u){ow[0], ow[1], ow[2], ow[3]}; dst[1] = (v4u){ow[4], ow[5], ow[6], ow[7]};
        };
        __syncthreads();
        for (int c = 0; c < NCH; ++c) {
            if (c >= 1) post(c - 1);
            __syncthreads();
        }
        post(NCH - 1);
    }
    __syncthreads();
}

__device__ __forceinline__ void ln_router(const int wv, int l) {
    const ArgsP a = get_args();
#ifdef NO_ROUTER
    return;
#endif
    OPAQUE_TID(); const int lane = tid & 63, wave = tid >> 6;
    unsigned char* ws = a->ws;
    const float* lg = a->in[28] + (size_t)l * 2048; const float* lb = a->in[29] + (size_t)l * 2048;
    const float* Wg = a->in[32] + (size_t)l * 2048 * 4; const float* bg = a->in[33] + l * 4; const float* We = a->in[34] + (size_t)l * 2048 * 32; const float* be = a->in[35] + l * 32;
    unsigned* cnt = (unsigned*)(ws + WS_CTL) + CW_CNT + (size_t)l * 32 * 64;
    int* TOKE = (int*)(ws + WS_TOKE); int* TOKR = (int*)(ws + WS_TOKR); float* TOKG = (float*)(ws + WS_TOKG);
    const int gw = blockIdx.x * NWAVES + wave, NGW = gridDim.x * NWAVES;
    for (int m = gw; m < T_; m += NGW) {
        f32x4* xr = (f32x4*)(a->out + (size_t)m * D_) + lane; f32x4 v[8]; float s = 0.f;
#pragma unroll
        for (int j = 0; j < 8; ++j) { v[j] = xr[64 * j]; s += (v[j].x + v[j].y) + (v[j].z + v[j].w); }
        const float mean = wave_sum(s) * (1.f / D_); float s2 = 0.f;
#pragma unroll
        for (int j = 0; j < 8; ++j) { v[j] = v[j] - mean; s2 += (v[j].x * v[j].x + v[j].y * v[j].y) + (v[j].z * v[j].z + v[j].w * v[j].w); }
        const float rstd = 1.f / sqrtf(wave_sum(s2) * (1.f / D_) + LN_EPS);
        float ag[4] = {0, 0, 0, 0};
#pragma unroll
        for (int j = 0; j < 8; ++j) { const f32x4 g = ((const f32x4*)lg)[lane + 64 * j], bb = ((const f32x4*)lb)[lane + 64 * j]; v[j] = v[j] * rstd * g + bb; xr[64 * j] = v[j];
            ((v2u*)(ws + WS_XB))[(size_t)m * 512 + lane + 64 * j] = (v2u){pk2(v[j].x, v[j].y), pk2(v[j].z, v[j].w)};
            const f32x4* wp = (const f32x4*)Wg + 4 * (lane + 64 * j);
#pragma unroll
            for (int i = 0; i < 4; ++i) { const f32x4 w = wp[i]; const float x = v[j][i]; ag[0] += x * w.x; ag[1] += x * w.y; ag[2] += x * w.z; ag[3] += x * w.w; } }
#pragma unroll
        for (int i = 0; i < 4; ++i) ag[i] = wave_sum(ag[i]) + bg[i];
        int gi = 0; float gm = ag[0];
#pragma unroll
        for (int i = 1; i < 4; ++i) if (ag[i] > gm) { gm = ag[i]; gi = i; }
        float gs = 0.f;
#pragma unroll
        for (int i = 0; i < 4; ++i) gs += __expf(ag[i] - gm);
        const float gp = 1.f / gs;
        float ae[8] = {0, 0, 0, 0, 0, 0, 0, 0};
#pragma unroll
        for (int j = 0; j < 8; ++j) {
#pragma unroll
            for (int i = 0; i < 4; ++i) { const float* wr = We + (size_t)(4 * (lane + 64 * j) + i) * 32 + 8 * gi; const f32x4 w0 = *(const f32x4*)wr, w1 = *(const f32x4*)(wr + 4); const float x = v[j][i];
                ae[0] += x * w0.x; ae[1] += x * w0.y; ae[2] += x * w0.z; ae[3] += x * w0.w; ae[4] += x * w1.x; ae[5] += x * w1.y; ae[6] += x * w1.z; ae[7] += x * w1.w; } }
#pragma unroll
        for (int i = 0; i < 8; ++i) ae[i] = wave_sum(ae[i]) + be[8 * gi + i];
        int e1 = 0; float m1 = ae[0];
#pragma unroll
        for (int i = 1; i < 8; ++i) if (ae[i] > m1) { m1 = ae[i]; e1 = i; }
        int e2 = -1; float m2 = -3.0e38f;
#pragma unroll
        for (int i = 0; i < 8; ++i) if (i != e1 && ae[i] > m2) { m2 = ae[i]; e2 = i; }
        const float p2 = __expf(m2 - m1), den = 1.f / (1.f + p2);
        if (lane == 0) { const int x1 = 8 * gi + e1, x2 = 8 * gi + e2;
            const unsigned r1 = __hip_atomic_fetch_add(cnt + x1 * 64, 1u, __ATOMIC_RELAXED, __HIP_MEMORY_SCOPE_AGENT);
            const unsigned r2 = __hip_atomic_fetch_add(cnt + x2 * 64, 1u, __ATOMIC_RELAXED, __HIP_MEMORY_SCOPE_AGENT);
            TOKE[2 * m] = x1; TOKE[2 * m + 1] = x2; TOKR[2 * m] = (int)r1; TOKR[2 * m + 1] = (int)r2; TOKG[2 * m] = gp * den; TOKG[2 * m + 1] = gp * p2 * den; }
    }
}

struct MoeTab { LAS int* start; LAS int* tileE; LAS int* ntiles; };
__device__ __forceinline__ MoeTab moe_tables(const int wv, int l, LAS unsigned char* lds) {
    const ArgsP a = get_args();
    MoeTab t; t.start = (LAS int*)(lds + MISC_OFF + 256); t.tileE = t.start + 40; t.ntiles = t.tileE + 168;
    OPAQUE_TID();
    if (tid == 0) { unsigned* cnt = (unsigned*)(a->ws + WS_CTL) + CW_CNT + (size_t)l * 32 * 64; int acc = 0;
        for (int e = 0; e < 32; ++e) { const int c = (int)__hip_atomic_load(cnt + e * 64, __ATOMIC_RELAXED, __HIP_MEMORY_SCOPE_AGENT); const int pad = (c + 255) & ~255;
            t.start[e] = acc; for (int q = acc >> 8; q < ((acc + pad) >> 8) && q < MOE_TILES; ++q) t.tileE[q] = e; acc += pad; }
        int nt = acc >> 8; if (nt > MOE_TILES) nt = MOE_TILES; *t.ntiles = nt; }
    __syncthreads();
    return t;
}
__device__ __forceinline__ void moe_gather(const int wv, const MoeTab& tb) {
    const ArgsP a = get_args();
#ifdef NO_GATHER
    return;
#endif
    OPAQUE_TID(); const int lane = tid & 63, wave = tid >> 6;
    unsigned char* ws = a->ws;
    const int* TOKE = (const int*)(ws + WS_TOKE); const int* TOKR = (const int*)(ws + WS_TOKR); int* SLOT = (int*)(ws + WS_SLOT);
    const int gw = blockIdx.x * NWAVES + wave, NGW = gridDim.x * NWAVES;
    for (int it = gw; it < 2 * T_; it += NGW) { const int m = it >> 1; const int dest = tb.start[TOKE[it]] + TOKR[it];
        if (lane == 0) SLOT[it] = dest;
        const v4u* src = (const v4u*)(ws + WS_XB) + (size_t)m * 256 + lane; v4u* dst = (v4u*)(ws + WS_XS) + (size_t)dest * 256 + lane;
#pragma unroll
        for (int j = 0; j < 4; ++j) dst[64 * j] = src[64 * j]; }
}
template <int NJ> struct MoeOrder {
    LAS int* tileE; int nunits, G, c;
    __device__ bool next(int i, pg8::Unit& u) const { const int L = i * G + c; if (L >= nunits) return false; u.pm = L / NJ; u.pn = tileE[u.pm] * NJ + (L % NJ); u.aoff = 0; return true; }
    __device__ __forceinline__ void a_ready(const pg8::Unit&) const {}
    __device__ __forceinline__ void done(const pg8::Unit&) const {}
};
__device__ __forceinline__ void moe_combine_ln(const int wv, int l) {
    const ArgsP a = get_args();
#ifdef NO_COMBINE
    return;
#endif
    OPAQUE_TID(); const int lane = tid & 63, wave = tid >> 6;
    unsigned char* ws = a->ws;
    const float* lg = a->in[30] + (size_t)l * 2048; const float* lb = a->in[31] + (size_t)l * 2048;
    const int* SLOT = (const int*)(ws + WS_SLOT); const float* TOKG = (const float*)(ws + WS_TOKG); const bf16* YS = (const bf16*)(ws + WS_YS);
    const int gw = blockIdx.x * NWAVES + wave, NGW = gridDim.x * NWAVES;
    for (int m = gw; m < T_; m += NGW) {
        f32x4* xr = (f32x4*)(a->out + (size_t)m * D_) + lane; f32x4 v[8]; float s = 0.f;
        const int s0 = SLOT[2 * m], s1 = SLOT[2 * m + 1]; const float g0 = TOKG[2 * m], g1 = TOKG[2 * m + 1];
        const v2u* y0 = (const v2u*)(YS + (size_t)s0 * 2048) + lane; const v2u* y1 = (const v2u*)(YS + (size_t)s1 * 2048) + lane;
#pragma unroll
        for (int j = 0; j < 8; ++j) { const f32x4 x = xr[64 * j]; const v2u a0 = y0[64 * j], a1 = y1[64 * j];
            v[j].x = DN_ALPHA * x.x + g0 * bflo(a0.x) + g1 * bflo(a1.x); v[j].y = DN_ALPHA * x.y + g0 * bfhi(a0.x) + g1 * bfhi(a1.x);
            v[j].z = DN_ALPHA * x.z + g0 * bflo(a0.y) + g1 * bflo(a1.y); v[j].w = DN_ALPHA * x.w + g0 * bfhi(a0.y) + g1 * bfhi(a1.y);
            s += (v[j].x + v[j].y) + (v[j].z + v[j].w); }
        const float mean = wave_sum(s) * (1.f / D_); float s2 = 0.f;
#pragma unroll
        for (int j = 0; j < 8; ++j) { v[j] = v[j] - mean; s2 += (v[j].x * v[j].x + v[j].y * v[j].y) + (v[j].z * v[j].z + v[j].w * v[j].w); }
        const float rstd = 1.f / sqrtf(wave_sum(s2) * (1.f / D_) + LN_EPS);
#pragma unroll
        for (int j = 0; j < 8; ++j) { const f32x4 g = ((const f32x4*)lg)[lane + 64 * j], bb = ((const f32x4*)lb)[lane + 64 * j]; v[j] = v[j] * rstd * g + bb; xr[64 * j] = v[j];
            ((v2u*)(ws + WS_XB))[(size_t)m * 512 + lane + 64 * j] = (v2u){pk2(v[j].x, v[j].y), pk2(v[j].z, v[j].w)}; }
    }
}

struct RkvOrder {
    pg8::StaticOrder in; int G, c;
    __device__ bool next(int i, pg8::Unit& u) const { const long L = (long)i * G + c; if (L >= 1536) return false; const int g = (int)(L / 512);
        in.at(L % 512, u); u.pm += 64 * g; u.pn += 8 * g; return true; }
    __device__ __forceinline__ void a_ready(const pg8::Unit&) const {}
    __device__ __forceinline__ void done(const pg8::Unit&) const {}
};
struct L2Order {
    int nunits, G, c;
    __device__ bool next(int i, pg8::Unit& u) const { const int L = i * G + c; if (L >= nunits) return false; u.pn = L >> 6; u.pm = L & 63; u.aoff = (u.pn >= 8) ? 512 : 0; return true; }
    __device__ __forceinline__ void a_ready(const pg8::Unit&) const {}
    __device__ __forceinline__ void done(const pg8::Unit&) const {}
};


#ifndef REP_PROL
#define REP_PROL 1
#endif
#ifndef REP_INPROJ
#define REP_INPROJ 1
#endif
#ifndef REP_ATTN
#define REP_ATTN 1
#endif
#ifndef REP_MLSTM
#define REP_MLSTM 1
#endif
#ifndef REP_HNORM
#define REP_HNORM 1
#endif
#ifndef REP_OPREP
#define REP_OPREP 1
#endif
#ifndef REP_RKV
#define REP_RKV 1
#endif
#ifndef REP_RWKV
#define REP_RWKV 1
#endif
#ifndef REP_GATHER
#define REP_GATHER 1
#endif
#ifndef REP_GU
#define REP_GU 1
#endif
#ifndef REP_DN
#define REP_DN 1
#endif
#define REPX_1(...) __VA_ARGS__
#define REPX_2(...) __VA_ARGS__ __VA_ARGS__
#define REPX_3(...) __VA_ARGS__ __VA_ARGS__ __VA_ARGS__
#define REPX_(n, ...) REPX_##n(__VA_ARGS__)
#define REPX(n, ...) REPX_(n, __VA_ARGS__)

constexpr int N_PHASES = 41;

__global__ void __launch_bounds__(NTHR, 2) fwd(Args args) {
    extern __shared__ __attribute__((aligned(16))) unsigned char lds_raw[];
    LAS unsigned char* lds = (LAS unsigned char*)lds_raw;
    const int wv = __builtin_amdgcn_readfirstlane((int)threadIdx.x >> 6);
    OPAQUE_TID();
    const ArgsP ap0 = get_args();
    if (tid < 16) ((LAS unsigned*)(lds + MISC_OFF))[tid] = 0u;
    __syncthreads();
#if ONE_LAUNCH
    XcdBarrier bar = xcd_barrier_post((unsigned*)(ap0->ws + WS_CTL) + CW_BAR, (volatile LAS unsigned*)(lds + MISC_OFF), tid == 0);
#define SEAM(k) do { if ((k) + 1 < hi) xcd_barrier(bar, tid == 0); } while (0)
#define SEAMR() xcd_barrier(bar, tid == 0)
#else
#define SEAM(k) do { } while (0)
#define SEAMR() do { } while (0)
#endif
    const int lo = ap0->ph_lo, hi = ap0->ph_hi;
#define IN(k) (lo <= (k) && (k) < hi)
    const int G = gridDim.x, cb = blockIdx.x;

    if (IN(0)) { REPX(REP_PROL, { prologue(wv, lds); SEAMR(); }) }

    auto layer = [&](auto lc) __attribute__((always_inline)) { constexpr int l = decltype(lc)::value;
        const int pb = 1 + 10 * l, eo = l >> 1;
        if ((l & 1) == 0) {
            if (IN(pb + 0)) {
                const ArgsP ap = get_args(); unsigned char* ws = ap->ws;
                pg8::Gemm g{(const bf16*)(ws + WS_XB), (const bf16*)(ws + WS_WIN) + (size_t)eo * ZW * 2048, 2048, 2048, 2048};
                pg8::StaticOrder S; S.init(T_, ZW, G, cb);
                pg8::EpiBf16 E{(bf16*)(ws + WS_Z), ZW, 0, 0, 0, nullptr};
                REPX(REP_INPROJ, { pg8::gemm_phase<pg8::EpiBf16, pg8::StaticOrder, true, false>(wv, lds, g, S, E); SEAMR(); })
            }
            if (IN(pb + 1)) { for (int u = cb; u < 256; u += G) even_prep(wv, eo, lds, u); SEAM(pb + 1); }
            if (IN(pb + 2)) {
                REPX(REP_ATTN, { for (int L = cb; L < 512; L += G) { const int i = L >> 8, c = L & 255; const int qbk = (i & 1) ? (c >> 5) : (15 - (c >> 5)); const int bh = c & 31;
                    attn_unit(wv, lds, bh >> 3, bh & 7, qbk); } })
                REPX(REP_MLSTM, { mlstm_scan(wv); })
                SEAM(pb + 2);
            }
            if (IN(pb + 3)) { REPX(REP_HNORM, { for (int u = cb; u < 1024; u += G) mlstm_out_unit(wv, lds, eo, u >> 8, (u >> 6) & 3, u & 63); SEAMR(); }) }
        } else {
            if (IN(pb + 0)) { REPX(REP_OPREP, { odd_prep(wv, eo); SEAMR(); }) }
            if (IN(pb + 1)) {
                const ArgsP ap = get_args(); unsigned char* ws = ap->ws;
                { pg8::Gemm g{(const bf16*)(ws + WS_XRKV), (const bf16*)(ws + WS_WRKV) + (size_t)eo * 3 * 2048 * 2048, 2048, 2048, 2048};
                  RkvOrder S; S.in.init(T_, 2048, G, cb); S.G = G; S.c = cb;
                  pg8::EpiBf16 E{(bf16*)(ws + WS_RKV), 2048, 64, 8, (size_t)T_ * 2048, (eo == 0) ? (bf16*)(ws + WS_VF) : nullptr};
                  REPX(REP_RKV, { pg8::gemm_phase<pg8::EpiBf16, RkvOrder, true, false>(wv, lds, g, S, E); __syncthreads(); }) }
                __syncthreads();
                { pg8::Gemm g{(const bf16*)(ws + WS_XC), (const bf16*)(ws + WS_WL1) + (size_t)eo * 512 * 4096, 4096, 4096, 4096};
                  pg8::StaticOrder S; S.init(T_, 512, G, cb);
                  pg8::EpiL1 E{(bf16*)(ws + WS_L1)};
                  pg8::gemm_phase<pg8::EpiL1, pg8::StaticOrder, true, false>(wv, lds, g, S, E); }
                SEAM(pb + 1);
            }
            if (IN(pb + 2)) {
                const ArgsP ap = get_args(); unsigned char* ws = ap->ws;
                pg8::Gemm g{(const bf16*)(ws + WS_L1), (const bf16*)(ws + WS_WL2) + (size_t)eo * 8192 * 256, 256, 512, 256};
                L2Order S{(eo == 0 ? 24 : 32) * 64, G, cb};
                pg8::EpiL2 E{(bf16*)(ws + WS_G), (bf16*)(ws + WS_WD), (bf16*)(ws + WS_AA), (bf16*)(ws + WS_RKV) + (size_t)2 * T_ * 2048, (const bf16*)(ws + WS_VF),
                             ap->in[12] + (size_t)eo * 2048, ap->in[15] + (size_t)eo * 2048, ap->in[25]};
                pg8::gemm_phase<pg8::EpiL2, L2Order, true, false>(wv, lds, g, S, E);
                SEAM(pb + 2);
            }
            if (IN(pb + 3)) { REPX(REP_RWKV, { for (int u = cb; u < 128; u += G) rwkv_unit(wv, lds, eo, u >> 5, u & 31);
                if (G > 128 && cb >= 128) moe_convert(wv, lds, (l == 1) ? 32 : 96, (l == 1) ? 96 : 128, cb - 128, G - 128);
                else if (G <= 128) moe_convert(wv, lds, (l == 1) ? 32 : 96, (l == 1) ? 96 : 128, cb, G);
                SEAMR(); }) }
        }
        if (IN(pb + 4)) {
            const bool ev = (l & 1) == 0; const ArgsP ap = get_args(); unsigned char* ws = ap->ws;
            pg8::Gemm g{(const bf16*)(ws + (ev ? WS_YE : WS_YO)), (const bf16*)(ws + (ev ? WS_WOUT : WS_WO)) + (size_t)eo * 2048 * 2048, 2048, 2048, 2048};
            pg8::StaticOrder S; S.init(T_, 2048, G, cb);
            pg8::EpiResid E{ap->out, 2048, DN_ALPHA};
            pg8::gemm_phase<pg8::EpiResid, pg8::StaticOrder, true, false>(wv, lds, g, S, E);
            SEAM(pb + 4);
        }
        if (IN(pb + 5)) { ln_router(wv, l); SEAM(pb + 5); }
        if (IN(pb + 6)) { const MoeTab tb = moe_tables(wv, l, lds); REPX(REP_GATHER, { moe_gather(wv, tb); SEAMR(); }) }
        if (IN(pb + 7)) { const MoeTab tb = moe_tables(wv, l, lds); const ArgsP ap = get_args(); unsigned char* ws = ap->ws;
            pg8::Gemm g{(const bf16*)(ws + WS_XS), (const bf16*)(ws + WS_WGU) + (size_t)l * 32 * 1024 * 2048, 2048, 2048, 2048};
            MoeOrder<4> S{tb.tileE, *tb.ntiles * 4, G, cb};
            pg8::EpiSilu E{(bf16*)(ws + WS_HID)};
            REPX(REP_GU, { pg8::gemm_phase<pg8::EpiSilu, MoeOrder<4>, true, false>(wv, lds, g, S, E); SEAMR(); })
        }
        if (IN(pb + 8)) { const MoeTab tb = moe_tables(wv, l, lds); const ArgsP ap = get_args(); unsigned char* ws = ap->ws;
            pg8::Gemm g{(const bf16*)(ws + WS_HID), (const bf16*)(ws + WS_WDN) + (size_t)l * 32 * 2048 * 512, 512, 512, 512};
            MoeOrder<8> S{tb.tileE, *tb.ntiles * 8, G, cb};
            pg8::EpiBf16 E{(bf16*)(ws + WS_YS), 2048, 0, 8, 0, nullptr};
            REPX(REP_DN, { pg8::gemm_phase<pg8::EpiBf16, MoeOrder<8>, true, false>(wv, lds, g, S, E); SEAMR(); })
        }
        if (IN(pb + 9)) { moe_combine_ln(wv, l); SEAM(pb + 9); }
        };
    layer(std::integral_constant<int, 0>{}); layer(std::integral_constant<int, 1>{}); layer(std::integral_constant<int, 2>{}); layer(std::integral_constant<int, 3>{});
#undef IN
#undef SEAM
}

extern "C" void kernel_launch(void* const* d_in, const int* in_sizes, int n_in, void* d_out, int out_size, void* d_ws, size_t ws_size, hipStream_t stream) {
    static int grid = 0;
    if (grid == 0) {
        if (n_in != 39 || in_sizes[0] != T_ * D_ || out_size != T_ * D_ || ws_size < WS_END) {
            fprintf(stderr, "kernel_launch: unexpected problem: n_in %d in0 %d out %d ws %zu (need %zu)\n", n_in, n_in > 0 ? in_sizes[0] : -1, out_size, ws_size, (size_t)WS_END); grid = -1; return; }
        int dev = 0, cus = 0, per_cu = 0;
        if (hipGetDevice(&dev) != hipSuccess || hipDeviceGetAttribute(&cus, hipDeviceAttributeMultiprocessorCount, dev) != hipSuccess) { fprintf(stderr, "kernel_launch: device query failed\n"); grid = -1; return; }
        if (hipFuncSetAttribute((const void*)fwd, hipFuncAttributeMaxDynamicSharedMemorySize, LDS_BYTES) != hipSuccess) { fprintf(stderr, "kernel_launch: hipFuncSetAttribute failed\n"); grid = -1; return; }
        if (hipOccupancyMaxActiveBlocksPerMultiprocessor(&per_cu, (const void*)fwd, NTHR, LDS_BYTES) != hipSuccess || per_cu < 1)
            fprintf(stderr, "kernel_launch: note: occupancy query reports %d workgroups per CU\n", per_cu);
        (void)hipGetLastError();
        grid = cus;
    }
    if (grid < 0) return;
    if (hipMemsetAsync((char*)d_ws + WS_CTL, 0, CTL_ZERO_BYTES, stream) != hipSuccess) { fprintf(stderr, "kernel_launch: memset failed\n"); return; }
    Args a{};
    for (int i = 0; i < 39; ++i) a.in[i] = (const float*)d_in[i];
    a.out = (float*)d_out; a.ws = (unsigned char*)d_ws;
#if ONE_LAUNCH
    a.ph_lo = 0; a.ph_hi = N_PHASES;
    hipLaunchKernelGGL(fwd, dim3(grid), dim3(NTHR), LDS_BYTES, stream, a);
#else
    for (int p = 0; p < N_PHASES; ++p) { a.ph_lo = p; a.ph_hi = p + 1; hipLaunchKernelGGL(fwd, dim3(grid), dim3(NTHR), LDS_BYTES, stream, a); }
#endif
    const hipError_t le = hipPeekAtLastError();
    if (le != hipSuccess) fprintf(stderr, "kernel_launch: launch failed: %s\n", hipGetErrorName(le));
}
```

```cpp
#include <hip/hip_runtime.h>
#include <cstdio>
#include <cstdint>
#include <type_traits>

#ifndef ONE_LAUNCH
#define ONE_LAUNCH 1
#endif

#define LAS __attribute__((address_space(3)))
typedef unsigned short bf16;
typedef unsigned v4u __attribute__((ext_vector_type(4)));
typedef unsigned v2u __attribute__((ext_vector_type(2)));
typedef float f32x4 __attribute__((ext_vector_type(4)));
typedef float f32x2 __attribute__((ext_vector_type(2)));
typedef short bf16x8 __attribute__((ext_vector_type(8)));

__device__ __forceinline__ unsigned f2bf(float f) { unsigned u = __builtin_bit_cast(unsigned, f); return (u + 0x7fffu + ((u >> 16) & 1u)) >> 16; }
typedef __bf16 bf16x2_t __attribute__((ext_vector_type(2)));
__device__ __forceinline__ unsigned pk2(float lo, float hi) { const f32x2 v = {lo, hi}; return __builtin_bit_cast(unsigned, __builtin_convertvector(v, bf16x2_t)); }
__device__ __forceinline__ float bflo(unsigned w) { return __builtin_bit_cast(float, w << 16); }
__device__ __forceinline__ float bfhi(unsigned w) { return __builtin_bit_cast(float, w & 0xffff0000u); }
__device__ __forceinline__ float bf2f(bf16 h) { return __builtin_bit_cast(float, (unsigned)h << 16); }
__device__ __forceinline__ float sigmoidf_(float x) { return __builtin_amdgcn_rcpf(1.f + __expf(-x)); }
__device__ __forceinline__ float wave_sum(float v) {
#pragma unroll
    for (int o = 1; o < 64; o <<= 1) v += __shfl_xor(v, o);
    return v;
}
template <int CTRL> __device__ __forceinline__ float dppf(float x) { return __builtin_bit_cast(float, __builtin_amdgcn_mov_dpp(__builtin_bit_cast(int, x), CTRL, 0xf, 0xf, true)); }
__device__ __forceinline__ float red16(float x) { x += dppf<0xB1>(x); x += dppf<0x4E>(x); x += dppf<0x141>(x); x += dppf<0x128>(x); return x; }
__device__ __forceinline__ float max16(float x) { x = fmaxf(x, dppf<0xB1>(x)); x = fmaxf(x, dppf<0x4E>(x)); x = fmaxf(x, dppf<0x141>(x)); x = fmaxf(x, dppf<0x128>(x)); return x; }

__device__ __forceinline__ int lane_id_asm() { int l; asm volatile("v_mbcnt_lo_u32_b32 %0, -1, 0\n\tv_mbcnt_hi_u32_b32 %0, -1, %0" : "=v"(l)); return l; }
#define OPAQUE_TID() const int tid = wv * 64 + lane_id_asm()
typedef short v4i16_t __attribute__((ext_vector_type(4)));
__device__ __forceinline__ v2u tr_read(const LAS unsigned char* p) { return __builtin_bit_cast(v2u, __builtin_amdgcn_ds_read_tr16_b64_v4i16((LAS v4i16_t*)p)); }
#define LDS_WAIT() asm volatile("s_waitcnt lgkmcnt(0)" ::: "memory")
#define VM_WAIT() asm volatile("s_waitcnt vmcnt(0)" ::: "memory")

namespace pg8 {
#define PG8_LAS __attribute__((address_space(3)))
typedef unsigned short bf16_t;
typedef short bf16x8 __attribute__((ext_vector_type(8)));
typedef float f32x4 __attribute__((ext_vector_type(4)));
typedef unsigned u32x4 __attribute__((ext_vector_type(4)));
constexpr int BM = 256, BK = 64, HALF = 128, HTB = HALF * BK * 2  , STAGE_BYTES = 8 * HTB, NXCD = 8, WGM = 8;

__host__ __device__ __forceinline__ int lds_byte(int r, int c) { const int st = (r >> 4) * 2 + (c >> 5), rr = r & 15, cc = c & 31, ob = rr * 64 + cc * 2; return st * 1024 + (ob ^ (((ob >> 9) & 1) << 5)); }
__host__ __device__ __forceinline__ void stage_rc(int b, int& R, int& C) { const int st = b / 1024, sb = b % 1024, swz = sb ^ (((sb >> 9) & 1) << 5); R = (st >> 1) * 16 + swz / 64; C = (st & 1) * 32 + (swz % 64) / 2; }
__host__ __device__ __forceinline__ int perm32(int rho) { const int n = rho >> 4, i = rho & 15; return 8 * (i >> 2) + 4 * n + (i & 3); }

struct Unit { int pm, pn, aoff; };
struct Gemm { const bf16_t* A; const bf16_t* Bt; int K, lda, ldb; };

struct StaticOrder {
    int nM, nN, nwg, G, c;
    __device__ void init(int M, int N, int G_, int c_) { nM = M / BM; nN = N / BM; nwg = nM * nN; G = G_; c = c_; }
    __device__ bool next(int i, Unit& u) const { return at((long)i * G + c, u); }
    __device__ bool at(long L, Unit& u) const {
        if (L >= nwg) return false;
        int wgid = (int)L; { const int q = nwg / NXCD, r = nwg % NXCD, xcd = wgid % NXCD, off = wgid / NXCD; wgid = (xcd < r ? xcd * (q + 1) : r * (q + 1) + (xcd - r) * q) + off; }
        const int nig = WGM * nN, gid = wgid / nig, fm = gid * WGM, gsz = (nM - fm) < WGM ? (nM - fm) : WGM;
        u.pm = fm + ((wgid % nig) % gsz); u.pn = (wgid % nig) / gsz; u.aoff = 0; return true;
    }
    __device__ __forceinline__ void a_ready(const Unit&) const {}
    __device__ __forceinline__ void done(const Unit&) const {}
};

__device__ __forceinline__ unsigned cvt_pk_bf16(float lo, float hi) { return ::pk2(lo, hi); }

struct EpiNull {
    static constexpr bool PERM = true, AFTER_DRAIN = false;
    __device__ __forceinline__ void operator()(const f32x4 (&acc)[2][2][4][2], const Unit&, int, int, int, int) const {
#pragma unroll
        for (int a = 0; a < 2; ++a)
#pragma unroll
            for (int b = 0; b < 2; ++b)
#pragma unroll
                for (int m = 0; m < 4; ++m)
#pragma unroll
                    for (int n = 0; n < 2; ++n) asm volatile("" :: "v"(acc[a][b][m][n]));
    }
};
struct EpiBf16 {
    static constexpr bool PERM = true, AFTER_DRAIN = false;
    bf16_t* O; int ldc; int pm_mod, pn_mod; size_t gstride; bf16_t* O2;
    __device__ __forceinline__ void operator()(const f32x4 (&acc)[2][2][4][2], const Unit& u, int wr, int wc, int fr, int fq) const {
        const int g = pm_mod ? u.pm / pm_mod : 0;
        const int row0 = (u.pm - g * pm_mod) * BM + wr * 64 + fr;
        const int col0 = (pn_mod ? (u.pn % pn_mod) : u.pn) * BM + wc * 32 + 8 * fq;
        bf16_t* base = O + (size_t)g * gstride;
        bf16_t* base2 = (O2 && g == 2) ? O2 : nullptr;
#pragma unroll
        for (int ai = 0; ai < 2; ++ai)
#pragma unroll
            for (int m = 0; m < 4; ++m) { const size_t ro = (size_t)(row0 + ai * HALF + m * 16) * ldc + col0;
#pragma unroll
                for (int bj = 0; bj < 2; ++bj) { const f32x4 v0 = acc[ai][bj][m][0], v1 = acc[ai][bj][m][1];
                    u32x4 w; w.x = cvt_pk_bf16(v0[0], v0[1]); w.y = cvt_pk_bf16(v0[2], v0[3]); w.z = cvt_pk_bf16(v1[0], v1[1]); w.w = cvt_pk_bf16(v1[2], v1[3]);
                    *(u32x4*)(base + ro + bj * HALF) = w; if (base2) *(u32x4*)(base2 + ro + bj * HALF) = w; } }
    }
};
struct EpiResid {
    static constexpr bool PERM = true, AFTER_DRAIN = false;
    const bf16_t* X; bf16_t* S; int ldc; float alpha;
    __device__ __forceinline__ void operator()(const f32x4 (&acc)[2][2][4][2], const Unit& u, int wr, int wc, int fr, int fq) const {
        const int row0 = u.pm * BM + wr * 64 + fr, col0 = u.pn * BM + wc * 32 + 8 * fq;
#pragma unroll
        for (int ai = 0; ai < 2; ++ai)
#pragma unroll
            for (int m = 0; m < 4; ++m) { const size_t ro = (size_t)(row0 + ai * HALF + m * 16) * ldc + col0;
#pragma unroll
                for (int bj = 0; bj < 2; ++bj) { const u32x4 xw = *(const u32x4*)(X + ro + bj * HALF);
                    const f32x4 x0 = {__builtin_bit_cast(float, xw.x << 16), __builtin_bit_cast(float, xw.x & 0xffff0000u), __builtin_bit_cast(float, xw.y << 16), __builtin_bit_cast(float, xw.y & 0xffff0000u)};
                    const f32x4 x1 = {__builtin_bit_cast(float, xw.z << 16), __builtin_bit_cast(float, xw.z & 0xffff0000u), __builtin_bit_cast(float, xw.w << 16), __builtin_bit_cast(float, xw.w & 0xffff0000u)};
                    const f32x4 s0 = x0 * alpha + acc[ai][bj][m][0], s1 = x1 * alpha + acc[ai][bj][m][1];
                    u32x4 w; w.x = cvt_pk_bf16(s0[0], s0[1]); w.y = cvt_pk_bf16(s0[2], s0[3]); w.z = cvt_pk_bf16(s1[0], s1[1]); w.w = cvt_pk_bf16(s1[2], s1[3]);
                    *(u32x4*)(S + ro + bj * HALF) = w; } }
    }
};
struct EpiSilu {
    static constexpr bool PERM = true, AFTER_DRAIN = false;
    bf16_t* O;
    __device__ __forceinline__ void operator()(const f32x4 (&acc)[2][2][4][2], const Unit& u, int wr, int wc, int fr, int fq) const {
        const int row0 = u.pm * BM + wr * 64 + fr, col0 = (u.pn & 3) * 128 + wc * 32 + 8 * fq;
#pragma unroll
        for (int ai = 0; ai < 2; ++ai)
#pragma unroll
            for (int m = 0; m < 4; ++m) { bf16_t* rowp = O + (size_t)(row0 + ai * HALF + m * 16) * 512 + col0;
                float h[8];
#pragma unroll
                for (int n = 0; n < 2; ++n)
#pragma unroll
                    for (int e = 0; e < 4; ++e) { const float gt = acc[ai][0][m][n][e], up = acc[ai][1][m][n][e]; h[n * 4 + e] = gt * __builtin_amdgcn_rcpf(1.f + __expf(-gt)) * up; }
                u32x4 w; w.x = cvt_pk_bf16(h[0], h[1]); w.y = cvt_pk_bf16(h[2], h[3]); w.z = cvt_pk_bf16(h[4], h[5]); w.w = cvt_pk_bf16(h[6], h[7]);
                *(u32x4*)rowp = w; }
    }
};
struct EpiL1 {
    static constexpr bool PERM = true, AFTER_DRAIN = false;
    bf16_t* O;
    __device__ __forceinline__ void operator()(const f32x4 (&acc)[2][2][4][2], const Unit& u, int wr, int wc, int fr, int fq) const {
        const int row0 = u.pm * BM + wr * 64 + fr, col0 = u.pn * BM + wc * 32 + 8 * fq;
#pragma unroll
        for (int ai = 0; ai < 2; ++ai)
#pragma unroll
            for (int m = 0; m < 4; ++m) { bf16_t* rowp = O + (size_t)(row0 + ai * HALF + m * 16) * 512 + col0;
#pragma unroll
                for (int bj = 0; bj < 2; ++bj) { const int c = col0 + bj * HALF; float h[8];
#pragma unroll
                    for (int n = 0; n < 2; ++n)
#pragma unroll
                        for (int e = 0; e < 4; ++e) { const float v = acc[ai][bj][m][n][e];
                            h[n * 4 + e] = (c < 256) ? __builtin_amdgcn_rcpf(1.f + __expf(-v)) : ((c < 352) ? (1.f - 2.f * __builtin_amdgcn_rcpf(1.f + __expf(2.f * v))) : v); }
                    u32x4 w; w.x = cvt_pk_bf16(h[0], h[1]); w.y = cvt_pk_bf16(h[2], h[3]); w.z = cvt_pk_bf16(h[4], h[5]); w.w = cvt_pk_bf16(h[6], h[7]);
                    *(u32x4*)(rowp + bj * HALF) = w; } }
    }
};
template <int KIND> __device__ __forceinline__ void epi_l2(const f32x4 (&acc)[2][2][4][2], bf16_t* O, const bf16_t* VF, const float* pv, int row0, int col0) {
    float pr[2][8];
#pragma unroll
    for (int bj = 0; bj < 2; ++bj)
#pragma unroll
        for (int j = 0; j < 8; ++j) pr[bj][j] = (KIND == 0) ? 0.f : pv[col0 + bj * HALF + j];
#pragma unroll
    for (int ai = 0; ai < 2; ++ai)
#pragma unroll
        for (int m = 0; m < 4; ++m) { const size_t ro = (size_t)(row0 + ai * HALF + m * 16) * 2048 + col0;
#pragma unroll
            for (int bj = 0; bj < 2; ++bj) { float h[8];
#pragma unroll
                for (int n = 0; n < 2; ++n)
#pragma unroll
                    for (int e = 0; e < 4; ++e) h[n * 4 + e] = acc[ai][bj][m][n][e] + pr[bj][n * 4 + e];
                if (KIND == 1) {
#pragma unroll
                    for (int j = 0; j < 8; ++j) h[j] = -0.60653065971263342f * __builtin_amdgcn_rcpf(1.f + __expf(-h[j]));
                } else if (KIND == 2) {
#pragma unroll
                    for (int j = 0; j < 8; ++j) h[j] = __builtin_amdgcn_rcpf(1.f + __expf(-h[j]));
                } else if (KIND == 3) {
                    const u32x4 vv = *(const u32x4*)(O + ro + bj * HALF), vf = *(const u32x4*)(VF + ro + bj * HALF);
#pragma unroll
                    for (int j = 0; j < 4; ++j) { const unsigned a = vv[j], b = vf[j];
                        const float v0_ = __builtin_bit_cast(float, a << 16), v1_ = __builtin_bit_cast(float, a & 0xffff0000u);
                        const float f0_ = __builtin_bit_cast(float, b << 16), f1_ = __builtin_bit_cast(float, b & 0xffff0000u);
                        h[2 * j] = v0_ + (f0_ - v0_) * __builtin_amdgcn_rcpf(1.f + __expf(-h[2 * j])); h[2 * j + 1] = v1_ + (f1_ - v1_) * __builtin_amdgcn_rcpf(1.f + __expf(-h[2 * j + 1])); }
                }
                u32x4 w; w.x = cvt_pk_bf16(h[0], h[1]); w.y = cvt_pk_bf16(h[2], h[3]); w.z = cvt_pk_bf16(h[4], h[5]); w.w = cvt_pk_bf16(h[6], h[7]);
                *(u32x4*)(O + ro + bj * HALF) = w; } }
}
struct EpiL2 {
    static constexpr bool PERM = true, AFTER_DRAIN = false;
    bf16_t *G, *WD, *AA, *V; const bf16_t* VF; const float *w0, *a0, *v0;
    __device__ __forceinline__ void operator()(const f32x4 (&acc)[2][2][4][2], const Unit& u, int wr, int wc, int fr, int fq) const {
        const int kind = u.pn >> 3;
        const int row0 = u.pm * BM + wr * 64 + fr, col0 = (u.pn & 7) * BM + wc * 32 + 8 * fq;
        if (kind == 0) epi_l2<0>(acc, G, nullptr, nullptr, row0, col0);
        else if (kind == 1) epi_l2<1>(acc, WD, nullptr, w0, row0, col0);
        else if (kind == 2) epi_l2<2>(acc, AA, nullptr, a0, row0, col0);
        else epi_l2<3>(acc, V, VF, v0, row0, col0);
    }
};

template <class Epi, class Sched, bool ALIGN_EPI = false, bool SP2 = false>
__device__ __forceinline__ void gemm_phase(const int wv, PG8_LAS unsigned char* lds, const Gemm g, const Sched& S, const Epi& E) {
#ifdef NO_GEMM
    return;
#endif
    const int tid_o = wv * 64 + lane_id_asm();
    const int tid = tid_o, wid = __builtin_amdgcn_readfirstlane(tid >> 6), lane = tid & 63, wr = wid >> 2, wc = wid & 3, fr = lane & 15, fq = lane >> 4;
    const int K = g.K, nt = K / BK;
    unsigned voffA[2], voffB[2];
#pragma unroll
    for (int i = 0; i < 2; ++i) { int R, C; stage_rc(tid * 16 + i * 8192, R, C); const int Rb = Epi::PERM ? ((R & ~31) + perm32(R & 31)) : R;
        voffA[i] = (unsigned)(R * g.lda + C) * 2u; voffB[i] = (unsigned)(Rb * g.ldb + C) * 2u; }
    const size_t kstep = (size_t)(BK * 2);
    const size_t hstepA = (size_t)HALF * g.lda * 2, hstepB = (size_t)HALF * g.ldb * 2;
    const size_t tstepA = 2 * hstepA, tstepB = 2 * hstepB;
    const unsigned ldsw = (unsigned)wid * 1024u;
    const int aoff = lds_byte(wr * 64 + fr, fq * 8), boff = lds_byte(wc * 32 + fr, fq * 8);
#define PG8_SA(b, h) (((b) * 2 + (h)) * HTB)
#define PG8_SB(b, h) ((4 + (b) * 2 + (h)) * HTB)
#define PG8_STAGE(bufoff, gbase, voff) do { _Pragma("unroll") for (int _i = 0; _i < 2; ++_i) \
        __builtin_amdgcn_global_load_lds((const unsigned*)((const char*)(gbase) + (voff)[_i]), (PG8_LAS unsigned*)(lds + (bufoff) + ldsw + _i * 8192), 16, 0, 0); } while (0)
#define PG8_LDA(dst, b, h) do { _Pragma("unroll") for (int m = 0; m < 4; ++m) _Pragma("unroll") for (int k = 0; k < 2; ++k) dst[m][k] = *(const PG8_LAS bf16x8*)(lds + PG8_SA(b, h) + aoff + m * 2048 + k * 1024); } while (0)
#define PG8_LDB(dst, b, h) do { _Pragma("unroll") for (int n = 0; n < 2; ++n) _Pragma("unroll") for (int k = 0; k < 2; ++k) dst[n][k] = *(const PG8_LAS bf16x8*)(lds + PG8_SB(b, h) + boff + n * 2048 + k * 1024); } while (0)
#define PG8_MMA(ai, bj, At, Bt) do { __builtin_amdgcn_s_setprio(1); _Pragma("unroll") for (int m = 0; m < 4; ++m) _Pragma("unroll") for (int n = 0; n < 2; ++n) _Pragma("unroll") for (int k = 0; k < 2; ++k) \
        acc[ai][bj][m][n] = __builtin_amdgcn_mfma_f32_16x16x32_bf16(Bt[n][k], At[m][k], acc[ai][bj][m][n], 0, 0, 0); __builtin_amdgcn_s_setprio(0); } while (0)
#define PG8_WAIT_V(n) asm volatile("s_waitcnt vmcnt(" #n ")" ::: "memory")
#define PG8_WAIT_L(n) asm volatile("s_waitcnt lgkmcnt(" #n ")" ::: "memory")
#define PG8_BAR __builtin_amdgcn_s_barrier()
#define PG8_SCHED __builtin_amdgcn_sched_barrier(0)
    Unit cur, nxt; int ui = 0;
    if (!S.next(0, cur)) return;
    f32x4 acc[2][2][4][2];
#pragma unroll
    for (int a = 0; a < 2; ++a)
#pragma unroll
        for (int b = 0; b < 2; ++b)
#pragma unroll
            for (int m = 0; m < 4; ++m)
#pragma unroll
                for (int n = 0; n < 2; ++n) acc[a][b][m][n] = (f32x4){0.f, 0.f, 0.f, 0.f};
    bf16x8 At[4][2], B0[2][2], B1[2][2];
    const char* cA = (const char*)g.A + (size_t)cur.pm * tstepA + cur.aoff; const char* cB = (const char*)g.Bt + (size_t)cur.pn * tstepB;
    S.a_ready(cur);
    if constexpr (SP2) {
        PG8_STAGE(PG8_SB(0, 0), cB, voffB); PG8_STAGE(PG8_SB(0, 1), cB + hstepB, voffB); PG8_STAGE(PG8_SA(0, 0), cA, voffA); PG8_STAGE(PG8_SA(0, 1), cA + hstepA, voffA);
        if (wr == 1) PG8_BAR;
        PG8_WAIT_V(2); PG8_BAR;
        PG8_STAGE(PG8_SB(1, 0), cB + kstep, voffB); PG8_STAGE(PG8_SA(1, 0), cA + kstep, voffA); PG8_STAGE(PG8_SB(1, 1), cB + hstepB + kstep, voffB);
        PG8_WAIT_V(6); PG8_BAR;
    } else {
        PG8_STAGE(PG8_SB(0, 0), cB, voffB); PG8_STAGE(PG8_SA(0, 0), cA, voffA); PG8_STAGE(PG8_SB(0, 1), cB + hstepB, voffB); PG8_STAGE(PG8_SA(0, 1), cA + hstepA, voffA);
        if (wr == 1) PG8_BAR;
        PG8_WAIT_V(4); PG8_BAR;
        PG8_STAGE(PG8_SB(1, 0), cB + kstep, voffB); PG8_STAGE(PG8_SA(1, 0), cA + kstep, voffA); PG8_STAGE(PG8_SB(1, 1), cB + hstepB + kstep, voffB);
        PG8_WAIT_V(6); PG8_BAR;
    }
    for (;;) {
        const bool has_next = S.next(ui + 1, nxt);
        const char* nA = has_next ? (const char*)g.A + (size_t)nxt.pm * tstepA + nxt.aoff : cA; const char* nB = has_next ? (const char*)g.Bt + (size_t)nxt.pn * tstepB : cB;
        for (int t = 0; t < nt; t += 2) {
            const bool last = (t == nt - 2);
            const char* a1 = cA + (size_t)(t + 1) * kstep;
            const char* a2 = last ? nA : cA + (size_t)(t + 2) * kstep; const char* b2 = last ? nB : cB + (size_t)(t + 2) * kstep;
            const char* a3 = a2 + kstep; const char* b3 = b2 + kstep;
            if (last && has_next) S.a_ready(nxt);
            if constexpr (SP2) {
            PG8_LDB(B0, 0, 0); PG8_LDB(B1, 0, 1); PG8_SCHED; PG8_LDA(At, 0, 0); PG8_STAGE(PG8_SA(1, 1), a1 + hstepA, voffA);
            PG8_WAIT_V(8); PG8_WAIT_L(0); PG8_BAR; PG8_MMA(0, 0, At, B0); PG8_MMA(0, 1, At, B1); PG8_BAR; PG8_SCHED;
            PG8_LDA(At, 0, 1); PG8_STAGE(PG8_SB(0, 0), b2, voffB); PG8_STAGE(PG8_SB(0, 1), b2 + hstepB, voffB); PG8_STAGE(PG8_SA(0, 0), a2, voffA);
            PG8_WAIT_V(8); PG8_WAIT_L(0); PG8_BAR; PG8_MMA(1, 0, At, B0); PG8_MMA(1, 1, At, B1); PG8_BAR; PG8_SCHED;
            PG8_LDB(B0, 1, 0); PG8_LDB(B1, 1, 1); PG8_SCHED; PG8_LDA(At, 1, 0); PG8_STAGE(PG8_SA(0, 1), a2 + hstepA, voffA);
            PG8_WAIT_V(8); PG8_WAIT_L(0); PG8_BAR; PG8_MMA(0, 0, At, B0); PG8_MMA(0, 1, At, B1); PG8_BAR; PG8_SCHED;
            PG8_LDA(At, 1, 1); PG8_STAGE(PG8_SB(1, 0), b3, voffB); PG8_STAGE(PG8_SB(1, 1), b3 + hstepB, voffB); PG8_STAGE(PG8_SA(1, 0), a3, voffA);
            PG8_WAIT_V(8); PG8_WAIT_L(0); PG8_BAR; PG8_MMA(1, 0, At, B0); PG8_MMA(1, 1, At, B1); PG8_BAR; PG8_SCHED;
            } else {
            PG8_LDB(B0, 0, 0); PG8_SCHED; PG8_LDA(At, 0, 0); PG8_STAGE(PG8_SA(1, 1), a1 + hstepA, voffA);
            PG8_WAIT_L(8); PG8_BAR; PG8_WAIT_L(0); PG8_MMA(0, 0, At, B0); PG8_BAR; PG8_SCHED;
            PG8_LDB(B1, 0, 1); PG8_STAGE(PG8_SB(0, 0), b2, voffB);
            PG8_BAR; PG8_WAIT_L(0); PG8_MMA(0, 1, At, B1); PG8_BAR;
            PG8_LDA(At, 0, 1); PG8_STAGE(PG8_SA(0, 0), a2, voffA);
            PG8_BAR; PG8_WAIT_L(0); PG8_MMA(1, 0, At, B0); PG8_BAR; PG8_SCHED;
            PG8_STAGE(PG8_SB(0, 1), b2 + hstepB, voffB);
            PG8_WAIT_V(6); PG8_BAR; PG8_MMA(1, 1, At, B1); PG8_BAR;
            PG8_LDB(B0, 1, 0); PG8_SCHED; PG8_LDA(At, 1, 0); PG8_STAGE(PG8_SA(0, 1), a2 + hstepA, voffA);
            PG8_WAIT_L(8); PG8_BAR; PG8_WAIT_L(0); PG8_MMA(0, 0, At, B0); PG8_BAR; PG8_SCHED;
            PG8_LDB(B1, 1, 1); PG8_STAGE(PG8_SB(1, 0), b3, voffB);
            PG8_BAR; PG8_WAIT_L(0); PG8_MMA(0, 1, At, B1); PG8_BAR;
            PG8_LDA(At, 1, 1); PG8_STAGE(PG8_SA(1, 0), a3, voffA);
            PG8_BAR; PG8_WAIT_L(0); PG8_MMA(1, 0, At, B0); PG8_BAR; PG8_SCHED;
            PG8_STAGE(PG8_SB(1, 1), b3 + hstepB, voffB);
            PG8_WAIT_V(6); PG8_BAR; PG8_MMA(1, 1, At, B1); PG8_BAR;
            }
        }
        if constexpr (ALIGN_EPI) { if (wr == 0) PG8_BAR; }
        if constexpr (!Epi::AFTER_DRAIN) { E(acc, cur, wr, wc, fr, fq); S.done(cur); }
        if (!has_next) break;
#pragma unroll
        for (int a = 0; a < 2; ++a)
#pragma unroll
            for (int b = 0; b < 2; ++b)
#pragma unroll
                for (int m = 0; m < 4; ++m)
#pragma unroll
                    for (int n = 0; n < 2; ++n) acc[a][b][m][n] = (f32x4){0.f, 0.f, 0.f, 0.f};
        cur = nxt; cA = nA; cB = nB; ++ui;
        if constexpr (ALIGN_EPI) { if (wr == 1) PG8_BAR; }
    }
    PG8_WAIT_V(0);
    if constexpr (!ALIGN_EPI) { if (wr == 0) PG8_BAR; }
    PG8_BAR;
    if constexpr (Epi::AFTER_DRAIN) { E.fused(acc, cur, wr, wc, fr, fq, lds, wid, lane); S.done(cur); }
#undef PG8_SA
#undef PG8_SB
#undef PG8_STAGE
#undef PG8_LDA
#undef PG8_LDB
#undef PG8_MMA
#undef PG8_WAIT_V
#undef PG8_WAIT_L
#undef PG8_BAR
#undef PG8_SCHED
}
template <class Epi, class Sched, bool ALIGN_EPI = false, bool SP2 = false>
__device__ __forceinline__ void gemm_phase_g(const int wv, PG8_LAS unsigned char* lds, const Gemm g, const Sched& S, const Epi& E) {
#ifdef NO_GEMM
    return;
#endif
    const int tid_o = wv * 64 + lane_id_asm();
    const int tid = tid_o, wid = __builtin_amdgcn_readfirstlane(tid >> 6), lane = tid & 63, wr = wid >> 2, wc = wid & 3, fr = lane & 15, fq = lane >> 4;
    const int K = g.K, nt = K / BK;
    unsigned voffA[2], voffB[2];
#pragma unroll
    for (int i = 0; i < 2; ++i) { int R, C; stage_rc(tid * 16 + i * 8192, R, C); const int Rb = Epi::PERM ? ((R & ~31) + perm32(R & 31)) : R;
        voffA[i] = (unsigned)(R * g.lda + C) * 2u; voffB[i] = (unsigned)(Rb * g.ldb + C) * 2u; }
    const size_t kstep = (size_t)(BK * 2);
    const size_t hstepA = (size_t)HALF * g.lda * 2, hstepB = (size_t)HALF * g.ldb * 2;
    const size_t tstepA = 2 * hstepA, tstepB = 2 * hstepB;
    const unsigned ldsw = (unsigned)wid * 1024u;
    const int aoff = lds_byte(wr * 64 + fr, fq * 8), boff = lds_byte(wc * 32 + fr, fq * 8);
#define PG8_SA(b, h) (((b) * 2 + (h)) * HTB)
#define PG8_SB(b, h) ((4 + (b) * 2 + (h)) * HTB)
#define PG8_STAGE(bufoff, gbase, voff) do { _Pragma("unroll") for (int _i = 0; _i < 2; ++_i) \
        __builtin_amdgcn_global_load_lds((const unsigned*)((const char*)(gbase) + (voff)[_i]), (PG8_LAS unsigned*)(lds + (bufoff) + ldsw + _i * 8192), 16, 0, 0); } while (0)
#define PG8_LDA(dst, b, h) do { _Pragma("unroll") for (int m = 0; m < 4; ++m) _Pragma("unroll") for (int k = 0; k < 2; ++k) dst[m][k] = *(const PG8_LAS bf16x8*)(lds + PG8_SA(b, h) + aoff + m * 2048 + k * 1024); } while (0)
#define PG8_LDB(dst, b, h) do { _Pragma("unroll") for (int n = 0; n < 2; ++n) _Pragma("unroll") for (int k = 0; k < 2; ++k) dst[n][k] = *(const PG8_LAS bf16x8*)(lds + PG8_SB(b, h) + boff + n * 2048 + k * 1024); } while (0)
#define PG8_MMA(ai, bj, At, Bt) do { __builtin_amdgcn_s_setprio(1); _Pragma("unroll") for (int m = 0; m < 4; ++m) _Pragma("unroll") for (int n = 0; n < 2; ++n) _Pragma("unroll") for (int k = 0; k < 2; ++k) \
        acc[ai][bj][m][n] = __builtin_amdgcn_mfma_f32_16x16x32_bf16(Bt[n][k], At[m][k], acc[ai][bj][m][n], 0, 0, 0); __builtin_amdgcn_s_setprio(0); } while (0)
#define PG8_WAIT_V(n) asm volatile("s_waitcnt vmcnt(" #n ")" ::: "memory")
#define PG8_WAIT_L(n) asm volatile("s_waitcnt lgkmcnt(" #n ")" ::: "memory")
#define PG8_BAR __builtin_amdgcn_s_barrier()
#define PG8_SCHED __builtin_amdgcn_sched_barrier(0)
    Unit cur, nxt; int ui = 0;
    if (!S.next(0, cur)) return;
    unsigned vc[2][2], vn[2][2];
    { int R0, C0, R1, C1; stage_rc(tid * 16, R0, C0); stage_rc(tid * 16 + 8192, R1, C1); S.gather_voff(cur, R0, C0, R1, C1, g.lda, vc); }
    f32x4 acc[2][2][4][2];
#pragma unroll
    for (int a = 0; a < 2; ++a)
#pragma unroll
        for (int b = 0; b < 2; ++b)
#pragma unroll
            for (int m = 0; m < 4; ++m)
#pragma unroll
                for (int n = 0; n < 2; ++n) acc[a][b][m][n] = (f32x4){0.f, 0.f, 0.f, 0.f};
    bf16x8 At[4][2], B0[2][2], B1[2][2];
    const char* const cA = (const char*)g.A; const char* cB = (const char*)g.Bt + (size_t)cur.pn * tstepB;
    S.a_ready(cur);
    if constexpr (SP2) {
        PG8_STAGE(PG8_SB(0, 0), cB, voffB); PG8_STAGE(PG8_SB(0, 1), cB + hstepB, voffB); PG8_STAGE(PG8_SA(0, 0), cA, voffA); PG8_STAGE(PG8_SA(0, 1), cA + hstepA, voffA);
        if (wr == 1) PG8_BAR;
        PG8_WAIT_V(2); PG8_BAR;
        PG8_STAGE(PG8_SB(1, 0), cB + kstep, voffB); PG8_STAGE(PG8_SA(1, 0), cA + kstep, voffA); PG8_STAGE(PG8_SB(1, 1), cB + hstepB + kstep, voffB);
        PG8_WAIT_V(6); PG8_BAR;
    } else {
        PG8_STAGE(PG8_SB(0, 0), cB, voffB); PG8_STAGE(PG8_SA(0, 0), cA, vc[0]); PG8_STAGE(PG8_SB(0, 1), cB + hstepB, voffB); PG8_STAGE(PG8_SA(0, 1), cA, vc[1]);
        if (wr == 1) PG8_BAR;
        PG8_WAIT_V(4); PG8_BAR;
        PG8_STAGE(PG8_SB(1, 0), cB + kstep, voffB); PG8_STAGE(PG8_SA(1, 0), cA + kstep, vc[0]); PG8_STAGE(PG8_SB(1, 1), cB + hstepB + kstep, voffB);
        PG8_WAIT_V(6); PG8_BAR;
    }
    for (;;) {
        const bool has_next = S.next(ui + 1, nxt);
        const char* nB = has_next ? (const char*)g.Bt + (size_t)nxt.pn * tstepB : cB;
        if (has_next) { int R0, C0, R1, C1; stage_rc(tid * 16, R0, C0); stage_rc(tid * 16 + 8192, R1, C1); S.gather_voff(nxt, R0, C0, R1, C1, g.lda, vn); }
        else { vn[0][0] = vc[0][0]; vn[0][1] = vc[0][1]; vn[1][0] = vc[1][0]; vn[1][1] = vc[1][1]; }
        for (int t = 0; t < nt; t += 2) {
            const bool last = (t == nt - 2);
            const char* a1 = cA + (size_t)(t + 1) * kstep;
            const char* a2 = last ? cA : cA + (size_t)(t + 2) * kstep; const char* b2 = last ? nB : cB + (size_t)(t + 2) * kstep;
            unsigned vs[2][2]; vs[0][0] = last ? vn[0][0] : vc[0][0]; vs[0][1] = last ? vn[0][1] : vc[0][1]; vs[1][0] = last ? vn[1][0] : vc[1][0]; vs[1][1] = last ? vn[1][1] : vc[1][1];
            const char* a3 = a2 + kstep; const char* b3 = b2 + kstep;
            if (last && has_next) S.a_ready(nxt);
            if constexpr (SP2) {
            PG8_LDB(B0, 0, 0); PG8_LDB(B1, 0, 1); PG8_SCHED; PG8_LDA(At, 0, 0); PG8_STAGE(PG8_SA(1, 1), a1 + hstepA, voffA);
            PG8_WAIT_V(8); PG8_WAIT_L(0); PG8_BAR; PG8_MMA(0, 0, At, B0); PG8_MMA(0, 1, At, B1); PG8_BAR; PG8_SCHED;
            PG8_LDA(At, 0, 1); PG8_STAGE(PG8_SB(0, 0), b2, voffB); PG8_STAGE(PG8_SB(0, 1), b2 + hstepB, voffB); PG8_STAGE(PG8_SA(0, 0), a2, voffA);
            PG8_WAIT_V(8); PG8_WAIT_L(0); PG8_BAR; PG8_MMA(1, 0, At, B0); PG8_MMA(1, 1, At, B1); PG8_BAR; PG8_SCHED;
            PG8_LDB(B0, 1, 0); PG8_LDB(B1, 1, 1); PG8_SCHED; PG8_LDA(At, 1, 0); PG8_STAGE(PG8_SA(0, 1), a2 + hstepA, voffA);
            PG8_WAIT_V(8); PG8_WAIT_L(0); PG8_BAR; PG8_MMA(0, 0, At, B0); PG8_MMA(0, 1, At, B1); PG8_BAR; PG8_SCHED;
            PG8_LDA(At, 1, 1); PG8_STAGE(PG8_SB(1, 0), b3, voffB); PG8_STAGE(PG8_SB(1, 1), b3 + hstepB, voffB); PG8_STAGE(PG8_SA(1, 0), a3, voffA);
            PG8_WAIT_V(8); PG8_WAIT_L(0); PG8_BAR; PG8_MMA(1, 0, At, B0); PG8_MMA(1, 1, At, B1); PG8_BAR; PG8_SCHED;
            } else {
            PG8_LDB(B0, 0, 0); PG8_SCHED; PG8_LDA(At, 0, 0); PG8_STAGE(PG8_SA(1, 1), a1, vc[1]);
            PG8_WAIT_L(8); PG8_BAR; PG8_WAIT_L(0); PG8_MMA(0, 0, At, B0); PG8_BAR; PG8_SCHED;
            PG8_LDB(B1, 0, 1); PG8_STAGE(PG8_SB(0, 0), b2, voffB);
            PG8_BAR; PG8_WAIT_L(0); PG8_MMA(0, 1, At, B1); PG8_BAR;
            PG8_LDA(At, 0, 1); PG8_STAGE(PG8_SA(0, 0), a2, vs[0]);
            PG8_BAR; PG8_WAIT_L(0); PG8_MMA(1, 0, At, B0); PG8_BAR; PG8_SCHED;
            PG8_STAGE(PG8_SB(0, 1), b2 + hstepB, voffB);
            PG8_WAIT_V(6); PG8_BAR; PG8_MMA(1, 1, At, B1); PG8_BAR;
            PG8_LDB(B0, 1, 0); PG8_SCHED; PG8_LDA(At, 1, 0); PG8_STAGE(PG8_SA(0, 1), a2, vs[1]);
            PG8_WAIT_L(8); PG8_BAR; PG8_WAIT_L(0); PG8_MMA(0, 0, At, B0); PG8_BAR; PG8_SCHED;
            PG8_LDB(B1, 1, 1); PG8_STAGE(PG8_SB(1, 0), b3, voffB);
            PG8_BAR; PG8_WAIT_L(0); PG8_MMA(0, 1, At, B1); PG8_BAR;
            PG8_LDA(At, 1, 1); PG8_STAGE(PG8_SA(1, 0), a3, vs[0]);
            PG8_BAR; PG8_WAIT_L(0); PG8_MMA(1, 0, At, B0); PG8_BAR; PG8_SCHED;
            PG8_STAGE(PG8_SB(1, 1), b3 + hstepB, voffB);
            PG8_WAIT_V(6); PG8_BAR; PG8_MMA(1, 1, At, B1); PG8_BAR;
            }
        }
        if constexpr (ALIGN_EPI) { if (wr == 0) PG8_BAR; }
        if constexpr (!Epi::AFTER_DRAIN) { E(acc, cur, wr, wc, fr, fq); S.done(cur); }
        if (!has_next) break;
#pragma unroll
        for (int a = 0; a < 2; ++a)
#pragma unroll
            for (int b = 0; b < 2; ++b)
#pragma unroll
                for (int m = 0; m < 4; ++m)
#pragma unroll
                    for (int n = 0; n < 2; ++n) acc[a][b][m][n] = (f32x4){0.f, 0.f, 0.f, 0.f};
        cur = nxt; cB = nB; ++ui; vc[0][0] = vn[0][0]; vc[0][1] = vn[0][1]; vc[1][0] = vn[1][0]; vc[1][1] = vn[1][1];
        if constexpr (ALIGN_EPI) { if (wr == 1) PG8_BAR; }
    }
    PG8_WAIT_V(0);
    if constexpr (!ALIGN_EPI) { if (wr == 0) PG8_BAR; }
    PG8_BAR;
    if constexpr (Epi::AFTER_DRAIN) { E.fused(acc, cur, wr, wc, fr, fq, lds, wid, lane); S.done(cur); }
#undef PG8_SA
#undef PG8_SB
#undef PG8_STAGE
#undef PG8_LDA
#undef PG8_LDB
#undef PG8_MMA
#undef PG8_WAIT_V
#undef PG8_WAIT_L
#undef PG8_BAR
#undef PG8_SCHED
}

template <class Epi, class Epi1, class Sched, bool ALIGN_EPI = false, bool SP2 = false>
__device__ __forceinline__ void gemm_phase_m(const int wv, PG8_LAS unsigned char* lds, const Gemm g, const Sched& S, const Epi& E, const Epi1& E1) {
#ifdef NO_GEMM
    return;
#endif
    const int tid_o = wv * 64 + lane_id_asm();
    const int tid = tid_o, wid = __builtin_amdgcn_readfirstlane(tid >> 6), lane = tid & 63, wr = wid >> 2, wc = wid & 3, fr = lane & 15, fq = lane >> 4;
    int nt;
    unsigned voffA[2], voffB[2];
#pragma unroll
    for (int i = 0; i < 2; ++i) { int R, C; stage_rc(tid * 16 + i * 8192, R, C); const int Rb = Epi::PERM ? ((R & ~31) + perm32(R & 31)) : R;
        voffA[i] = (unsigned)(R * g.lda + C) * 2u; voffB[i] = (unsigned)(Rb * g.ldb + C) * 2u; }
    const size_t kstep = (size_t)(BK * 2);
    const size_t hstepA = (size_t)HALF * g.lda * 2, hstepB = (size_t)HALF * g.ldb * 2;
    const size_t tstepA = 2 * hstepA, tstepB = 2 * hstepB;
    const unsigned ldsw = (unsigned)wid * 1024u;
    const int aoff = lds_byte(wr * 64 + fr, fq * 8), boff = lds_byte(wc * 32 + fr, fq * 8);
#define PG8_SA(b, h) (((b) * 2 + (h)) * HTB)
#define PG8_SB(b, h) ((4 + (b) * 2 + (h)) * HTB)
#define PG8_STAGE(bufoff, gbase, voff) do { _Pragma("unroll") for (int _i = 0; _i < 2; ++_i) \
        __builtin_amdgcn_global_load_lds((const unsigned*)((const char*)(gbase) + (voff)[_i]), (PG8_LAS unsigned*)(lds + (bufoff) + ldsw + _i * 8192), 16, 0, 0); } while (0)
#define PG8_LDA(dst, b, h) do { _Pragma("unroll") for (int m = 0; m < 4; ++m) _Pragma("unroll") for (int k = 0; k < 2; ++k) dst[m][k] = *(const PG8_LAS bf16x8*)(lds + PG8_SA(b, h) + aoff + m * 2048 + k * 1024); } while (0)
#define PG8_LDB(dst, b, h) do { _Pragma("unroll") for (int n = 0; n < 2; ++n) _Pragma("unroll") for (int k = 0; k < 2; ++k) dst[n][k] = *(const PG8_LAS bf16x8*)(lds + PG8_SB(b, h) + boff + n * 2048 + k * 1024); } while (0)
#define PG8_MMA(ai, bj, At, Bt) do { __builtin_amdgcn_s_setprio(1); _Pragma("unroll") for (int m = 0; m < 4; ++m) _Pragma("unroll") for (int n = 0; n < 2; ++n) _Pragma("unroll") for (int k = 0; k < 2; ++k) \
        acc[ai][bj][m][n] = __builtin_amdgcn_mfma_f32_16x16x32_bf16(Bt[n][k], At[m][k], acc[ai][bj][m][n], 0, 0, 0); __builtin_amdgcn_s_setprio(0); } while (0)
#define PG8_WAIT_V(n) asm volatile("s_waitcnt vmcnt(" #n ")" ::: "memory")
#define PG8_WAIT_L(n) asm volatile("s_waitcnt lgkmcnt(" #n ")" ::: "memory")
#define PG8_BAR __builtin_amdgcn_s_barrier()
#define PG8_SCHED __builtin_amdgcn_sched_barrier(0)
    Unit cur, nxt; int ui = 0;
    if (!S.next(0, cur)) return;
    f32x4 acc[2][2][4][2];
#pragma unroll
    for (int a = 0; a < 2; ++a)
#pragma unroll
        for (int b = 0; b < 2; ++b)
#pragma unroll
            for (int m = 0; m < 4; ++m)
#pragma unroll
                for (int n = 0; n < 2; ++n) acc[a][b][m][n] = (f32x4){0.f, 0.f, 0.f, 0.f};
    bf16x8 At[4][2], B0[2][2], B1[2][2];
    const char *cA, *cA2, *cB, *cB2; S.ptrs(cur, cA, cA2, cB, cB2, nt);
    S.a_ready(cur);
    if constexpr (SP2) {
        PG8_STAGE(PG8_SB(0, 0), cB, voffB); PG8_STAGE(PG8_SB(0, 1), cB + hstepB, voffB); PG8_STAGE(PG8_SA(0, 0), cA, voffA); PG8_STAGE(PG8_SA(0, 1), cA + hstepA, voffA);
        if (wr == 1) PG8_BAR;
        PG8_WAIT_V(2); PG8_BAR;
        PG8_STAGE(PG8_SB(1, 0), cB + kstep, voffB); PG8_STAGE(PG8_SA(1, 0), cA + kstep, voffA); PG8_STAGE(PG8_SB(1, 1), cB + hstepB + kstep, voffB);
        PG8_WAIT_V(6); PG8_BAR;
    } else {
        PG8_STAGE(PG8_SB(0, 0), cB, voffB); PG8_STAGE(PG8_SA(0, 0), cA, voffA); PG8_STAGE(PG8_SB(0, 1), cB + hstepB, voffB); PG8_STAGE(PG8_SA(0, 1), cA + hstepA, voffA);
        if (wr == 1) PG8_BAR;
        PG8_WAIT_V(4); PG8_BAR;
        PG8_STAGE(PG8_SB(1, 0), cB + kstep, voffB); PG8_STAGE(PG8_SA(1, 0), cA + kstep, voffA); PG8_STAGE(PG8_SB(1, 1), cB + hstepB + kstep, voffB);
        PG8_WAIT_V(6); PG8_BAR;
    }
    for (;;) {
        const bool has_next = S.next(ui + 1, nxt);
        const char *nA = cA, *nA2 = cA2, *nB = cB, *nB2 = cB2; int nnt = nt; if (has_next) S.ptrs(nxt, nA, nA2, nB, nB2, nnt);
        for (int t = 0; t < nt; t += 2) {
            const bool last = (t == nt - 2);
            const char* a1 = (t + 1 < 32) ? cA + (size_t)(t + 1) * kstep : cA2 + (size_t)(t + 1 - 32) * kstep;
            const char* a2 = last ? nA : ((t + 2 < 32) ? cA + (size_t)(t + 2) * kstep : cA2 + (size_t)(t + 2 - 32) * kstep);
            const char* b2 = last ? nB : ((t + 2 < 32) ? cB + (size_t)(t + 2) * kstep : cB2 + (size_t)(t + 2 - 32) * kstep);
            const char* a3 = a2 + kstep; const char* b3 = b2 + kstep;
            if (last && has_next) S.a_ready(nxt);
            if constexpr (SP2) {
            PG8_LDB(B0, 0, 0); PG8_LDB(B1, 0, 1); PG8_SCHED; PG8_LDA(At, 0, 0); PG8_STAGE(PG8_SA(1, 1), a1 + hstepA, voffA);
            PG8_WAIT_V(8); PG8_WAIT_L(0); PG8_BAR; PG8_MMA(0, 0, At, B0); PG8_MMA(0, 1, At, B1); PG8_BAR; PG8_SCHED;
            PG8_LDA(At, 0, 1); PG8_STAGE(PG8_SB(0, 0), b2, voffB); PG8_STAGE(PG8_SB(0, 1), b2 + hstepB, voffB); PG8_STAGE(PG8_SA(0, 0), a2, voffA);
            PG8_WAIT_V(8); PG8_WAIT_L(0); PG8_BAR; PG8_MMA(1, 0, At, B0); PG8_MMA(1, 1, At, B1); PG8_BAR; PG8_SCHED;
            PG8_LDB(B0, 1, 0); PG8_LDB(B1, 1, 1); PG8_SCHED; PG8_LDA(At, 1, 0); PG8_STAGE(PG8_SA(0, 1), a2 + hstepA, voffA);
            PG8_WAIT_V(8); PG8_WAIT_L(0); PG8_BAR; PG8_MMA(0, 0, At, B0); PG8_MMA(0, 1, At, B1); PG8_BAR; PG8_SCHED;
            PG8_LDA(At, 1, 1); PG8_STAGE(PG8_SB(1, 0), b3, voffB); PG8_STAGE(PG8_SB(1, 1), b3 + hstepB, voffB); PG8_STAGE(PG8_SA(1, 0), a3, voffA);
            PG8_WAIT_V(8); PG8_WAIT_L(0); PG8_BAR; PG8_MMA(1, 0, At, B0); PG8_MMA(1, 1, At, B1); PG8_BAR; PG8_SCHED;
            } else {
            PG8_LDB(B0, 0, 0); PG8_SCHED; PG8_LDA(At, 0, 0); PG8_STAGE(PG8_SA(1, 1), a1 + hstepA, voffA);
            PG8_WAIT_L(8); PG8_BAR; PG8_WAIT_L(0); PG8_MMA(0, 0, At, B0); PG8_BAR; PG8_SCHED;
            PG8_LDB(B1, 0, 1); PG8_STAGE(PG8_SB(0, 0), b2, voffB);
            PG8_BAR; PG8_WAIT_L(0); PG8_MMA(0, 1, At, B1); PG8_BAR;
            PG8_LDA(At, 0, 1); PG8_STAGE(PG8_SA(0, 0), a2, voffA);
            PG8_BAR; PG8_WAIT_L(0); PG8_MMA(1, 0, At, B0); PG8_BAR; PG8_SCHED;
            PG8_STAGE(PG8_SB(0, 1), b2 + hstepB, voffB);
            PG8_WAIT_V(6); PG8_BAR; PG8_MMA(1, 1, At, B1); PG8_BAR;
            PG8_LDB(B0, 1, 0); PG8_SCHED; PG8_LDA(At, 1, 0); PG8_STAGE(PG8_SA(0, 1), a2 + hstepA, voffA);
            PG8_WAIT_L(8); PG8_BAR; PG8_WAIT_L(0); PG8_MMA(0, 0, At, B0); PG8_BAR; PG8_SCHED;
            PG8_LDB(B1, 1, 1); PG8_STAGE(PG8_SB(1, 0), b3, voffB);
            PG8_BAR; PG8_WAIT_L(0); PG8_MMA(0, 1, At, B1); PG8_BAR;
            PG8_LDA(At, 1, 1); PG8_STAGE(PG8_SA(1, 0), a3, voffA);
            PG8_BAR; PG8_WAIT_L(0); PG8_MMA(1, 0, At, B0); PG8_BAR; PG8_SCHED;
            PG8_STAGE(PG8_SB(1, 1), b3 + hstepB, voffB);
            PG8_WAIT_V(6); PG8_BAR; PG8_MMA(1, 1, At, B1); PG8_BAR;
            }
        }
        if constexpr (ALIGN_EPI) { if (wr == 0) PG8_BAR; }
        if (cur.aoff == 0) E(acc, cur, wr, wc, fr, fq); else E1(acc, cur, wr, wc, fr, fq);
        if (!has_next) break;
#pragma unroll
        for (int a = 0; a < 2; ++a)
#pragma unroll
            for (int b = 0; b < 2; ++b)
#pragma unroll
                for (int m = 0; m < 4; ++m)
#pragma unroll
                    for (int n = 0; n < 2; ++n) acc[a][b][m][n] = (f32x4){0.f, 0.f, 0.f, 0.f};
        cur = nxt; cA = nA; cA2 = nA2; cB = nB; cB2 = nB2; nt = nnt; ++ui;
        if constexpr (ALIGN_EPI) { if (wr == 1) PG8_BAR; }
    }
    PG8_WAIT_V(0);
    if constexpr (!ALIGN_EPI) { if (wr == 0) PG8_BAR; }
    PG8_BAR;
#undef PG8_SA
#undef PG8_SB
#undef PG8_STAGE
#undef PG8_LDA
#undef PG8_LDB
#undef PG8_MMA
#undef PG8_WAIT_V
#undef PG8_WAIT_L
#undef PG8_BAR
#undef PG8_SCHED
}


}

#define XB_TMO      128
#define XB_XCNT(j)  (256  + 64 * (j))
#define XB_XSUB(j)  (1280 + 64 * (j))
#define XB_XGEN(j)  (2304 + 64 * (j))
#define XB_TOP      3328
#define XB_TOPGEN   3392
#define XCD_BAR_WORDS 3456
#define XB_SPIN_CAP (1u << 18)

__device__ __forceinline__ unsigned xb_ld(unsigned* p)              { return __hip_atomic_load(p, __ATOMIC_RELAXED, __HIP_MEMORY_SCOPE_AGENT); }
__device__ __forceinline__ unsigned xb_add(unsigned* p, unsigned v) { return __hip_atomic_fetch_add(p, v, __ATOMIC_RELAXED, __HIP_MEMORY_SCOPE_AGENT); }
__device__ __forceinline__ unsigned xb_xcc_id() { return (unsigned)__builtin_amdgcn_s_getreg((3 << 11) | 20) & 0xFu; }
#define XB_SPIN(cond, bar) do { unsigned _sp = 0; while (cond) { __builtin_amdgcn_s_sleep(1); \
    if ((++_sp & 255u) == 0u) { if (xb_ld(&(bar)[XB_TMO])) break; if (_sp > XB_SPIN_CAP) { atomicAdd(&(bar)[XB_TMO], 1u); break; } } } } while (0)

struct XcdBarrier {
    unsigned* bar; unsigned x;
    volatile LAS unsigned* st;
};

__device__ __forceinline__ XcdBarrier xcd_barrier_post(unsigned* bar, volatile LAS unsigned* st, const bool t0) {
    XcdBarrier b; b.bar = bar; b.x = xb_xcc_id(); b.st = st;
    if (t0) (void)xb_add(&bar[XB_XCNT(b.x)], 1u);
    return b;
}
__device__ __forceinline__ void xcd_barrier_complete(unsigned* bar, unsigned x, unsigned& nloc, unsigned& nx) {
    const unsigned G = gridDim.x * gridDim.y * gridDim.z;
    unsigned sum, cnt, mine, sp = 0u;
    for (;;) {
        sum = 0u; cnt = 0u; mine = 0u;
#pragma unroll
        for (unsigned j = 0; j < 16; ++j) { const unsigned c = xb_ld(&bar[XB_XCNT(j)]); sum += c; cnt += (c > 0u) ? 1u : 0u; mine = (j == x) ? c : mine; }
        if (sum == G) break;
        __builtin_amdgcn_s_sleep(1);
        if ((++sp & 255u) == 0u) { if (xb_ld(&bar[XB_TMO])) break; if (sp > XB_SPIN_CAP) { atomicAdd(&bar[XB_TMO], 1u); break; } }
    }
    nloc = mine > 0u ? mine : 1u; nx = cnt > 0u ? cnt : 1u;
}

__device__ __forceinline__ void xcd_barrier(const XcdBarrier& b, const bool t0) {
    asm volatile("s_waitcnt vmcnt(0)" ::: "memory");
    __syncthreads();
    if (t0) {
        unsigned* bar = b.bar;
        __builtin_amdgcn_s_waitcnt(0);
        unsigned nloc = b.st[0], nx = b.st[1];
        if (nloc == 0u) { xcd_barrier_complete(bar, b.x, nloc, nx); b.st[0] = nloc; b.st[1] = nx; }
        const unsigned old = xb_add(&bar[XB_XSUB(b.x)], 1u);
        const unsigned gen = old / nloc;
        if (old + 1u == (gen + 1u) * nloc) {
            __builtin_amdgcn_fence(__ATOMIC_RELEASE, "agent");
            asm volatile("s_waitcnt vmcnt(0)" ::: "memory");
            const unsigned og = xb_add(&bar[XB_TOP], 1u);
            const unsigned tg = og / nx;
            if (og + 1u == (tg + 1u) * nx) xb_add(&bar[XB_TOPGEN], 1u);
            else XB_SPIN(xb_ld(&bar[XB_TOPGEN]) == tg, bar);
            __builtin_amdgcn_fence(__ATOMIC_ACQUIRE, "agent");
            xb_add(&bar[XB_XGEN(b.x)], 1u);
            asm volatile("s_waitcnt vmcnt(0)" ::: "memory");
        } else {
            XB_SPIN(xb_ld(&bar[XB_XGEN(b.x)]) == gen, bar);
            __builtin_amdgcn_fence(__ATOMIC_ACQUIRE, "agent");
            asm volatile("s_waitcnt vmcnt(0)" ::: "memory");
        }
    }
    __syncthreads();
}

constexpr int NWAVES = 8, NTHR = 512;
constexpr int NB = 4, SEQ = 4096, T_ = NB * SEQ, D_ = 2048;
constexpr int EVEN_IN = 7176, ZW = 7168;
constexpr float DN_ALPHA = 1.6817928305074290f;
constexpr float LN_EPS = 1e-5f;
constexpr int MOE_ROWS = 40960, MOE_TILES = MOE_ROWS / 256;

constexpr size_t MiB = 1u << 20;
constexpr size_t WS_CTL = 0, CTL_ZERO_BYTES = 1 * MiB;
constexpr size_t WS_IG = 1 * MiB, WS_FG = WS_IG + 256 * 1024, WS_KPART = 2 * MiB;
constexpr size_t WS_TOKE = 3 * MiB, WS_TOKR = WS_TOKE + 128 * 1024, WS_TOKG = WS_TOKR + 128 * 1024, WS_SLOT = WS_TOKG + 128 * 1024;
constexpr size_t WS_DN = 4 * MiB, WS_NP = 5 * MiB, WS_DEC = 6 * MiB, WS_BC = 6 * MiB + 65536;
constexpr size_t WS_LIST = 8 * MiB;
constexpr size_t WS_RW = 12 * MiB;
constexpr size_t WS_WIN = 16 * MiB;
constexpr size_t WS_WOUT = 72 * MiB;
constexpr size_t WS_WRKV = 88 * MiB;
constexpr size_t WS_WO = 136 * MiB;
constexpr size_t WS_WL1 = 152 * MiB;
constexpr size_t WS_WL2 = 160 * MiB;
constexpr size_t WS_WGU = 168 * MiB;
constexpr size_t WS_WDN = 680 * MiB;
constexpr size_t WS_XB = 936 * MiB;
constexpr size_t WS_VF = 1000 * MiB;
constexpr size_t WS_R = 1064 * MiB;
constexpr size_t WS_Z = WS_R;
constexpr size_t WS_QKB = WS_R + 224 * MiB;
constexpr size_t WS_VAT = WS_R + 288 * MiB;
constexpr size_t WS_YE = WS_R + 320 * MiB;
constexpr size_t WS_DC = WS_R + 384 * MiB;
constexpr size_t WS_CP = WS_R + 512 * MiB;
constexpr size_t WS_XRKV = WS_R;
constexpr size_t WS_XC = WS_R + 192 * MiB;
constexpr size_t WS_RKV = WS_R + 320 * MiB;
constexpr size_t WS_L1 = WS_R + 512 * MiB;
constexpr size_t WS_G = WS_R + 528 * MiB;
constexpr size_t WS_WD = WS_R + 592 * MiB;
constexpr size_t WS_AA = WS_R + 656 * MiB;
constexpr size_t WS_YO = WS_R + 720 * MiB;
constexpr size_t WS_XS = WS_R;
constexpr size_t WS_HID = WS_R + 160 * MiB;
constexpr size_t WS_YS = WS_R + 400 * MiB;
constexpr size_t WS_X2 = WS_R + 784 * MiB;
constexpr size_t WS_VG = WS_X2 + 64 * MiB;
constexpr size_t WS_XSUM = WS_X2 + 64 * MiB;
constexpr size_t WS_END = WS_X2 + 128 * MiB;

constexpr int CW_BAR = 4096;
constexpr int CW_CNT = 16384;

constexpr int LDS_BYTES = 163840;
constexpr int MISC_OFF = LDS_BYTES - 4096;
constexpr int RING_BYTES = MISC_OFF;

typedef unsigned gu32;

#ifndef MOE_PROLOGUE_LAYERS
#define MOE_PROLOGUE_LAYERS 1
#endif
struct Args { const float* in[39]; float* out; unsigned char* ws; int ph_lo, ph_hi; };
#define CAS __attribute__((address_space(4)))
typedef const CAS Args* ArgsP;
#define XIN(a, l) ((bf16*)((a)->ws + (((l) == 0 || (l) == 3) ? WS_XB : WS_X2)))
#define XOUT(a, l) ((bf16*)((a)->ws + (((l) <= 1) ? WS_X2 : WS_XB)))
__device__ __forceinline__ ArgsP get_args() { ArgsP p = (ArgsP)__builtin_amdgcn_kernarg_segment_ptr(); asm volatile("" : "+s"(p)); return p; }

template <int NH> __device__ __forceinline__ void tr_item_n(const float* W, int ldw, int k0, int n0, bf16* WT, int ldt, int drow0, int dcol0, LAS float* scr, int lane, const float* kscale) {
    const int r = lane >> 3, c4 = lane & 7;
    f32x4 v[NH][8];
#pragma unroll
    for (int hh = 0; hh < NH; ++hh)
#pragma unroll
        for (int i = 0; i < 8; ++i) v[hh][i] = __builtin_nontemporal_load((const f32x4*)(W + (size_t)(k0 + 64 * hh + 8 * i + r) * ldw + n0 + 4 * c4));
#pragma unroll
    for (int hh = 0; hh < NH; ++hh) {
        if (kscale) {
#pragma unroll
            for (int i = 0; i < 8; ++i) v[hh][i] = v[hh][i] * kscale[k0 + 64 * hh + 8 * i + r]; }
#pragma unroll
        for (int i = 0; i < 8; ++i) { LAS float* d = scr + (8 * i + r) * 33 + 4 * c4; d[0] = v[hh][i].x; d[1] = v[hh][i].y; d[2] = v[hh][i].z; d[3] = v[hh][i].w; }
        LDS_WAIT(); asm volatile("" ::: "memory");
        const int c = lane & 7;
#pragma unroll
        for (int j = 0; j < 4; ++j) { const int n = (lane >> 3) + 8 * j; const LAS float* s = scr + (8 * c) * 33 + n;
            v4u o; o.x = pk2(s[0 * 33], s[1 * 33]); o.y = pk2(s[2 * 33], s[3 * 33]); o.z = pk2(s[4 * 33], s[5 * 33]); o.w = pk2(s[6 * 33], s[7 * 33]);
            *(v4u*)(WT + (size_t)(drow0 + n) * ldt + dcol0 + 64 * hh + 8 * c) = o; }
        LDS_WAIT(); asm volatile("" ::: "memory");
    }
}
__device__ __forceinline__ void tr_item(const float* W, int ldw, int k0, int n0, bf16* WT, int ldt, int drow0, int dcol0, LAS float* scr, int lane, const float* kscale) {
    tr_item_n<1>(W, ldw, k0, n0, WT, ldt, drow0, dcol0, scr, lane, kscale); }

__device__ __forceinline__ void moe_convert(const int wv, LAS unsigned char* lds, int le_lo, int le_hi, int vb, int nvb) {
    const ArgsP a = get_args();
    OPAQUE_TID(); const int lane = tid & 63, wave = tid >> 6;
    unsigned char* ws = a->ws;
    LAS float* scr = (LAS float*)(lds + wave * 16384);
    const int n = (le_hi - le_lo) * 768;
    for (int it = vb * NWAVES + wave; it < n; it += nvb * NWAVES) {
        const int le = le_lo + it / 768, rr = it % 768, mat = rr / 256, q = rr % 256;
        if (mat < 2) { const int kb = q / 16, nb = q % 16, n0 = 32 * nb;
            tr_item_n<2>((mat == 0 ? a->in[36] : a->in[37]) + (size_t)le * 2048 * 512, 512, 128 * kb, n0, (bf16*)(ws + WS_WGU) + (size_t)le * 1024 * 2048, 2048,
                    (n0 / 128) * 256 + (n0 % 128) + (mat == 1 ? 128 : 0), 128 * kb, scr, lane, nullptr); }
        else { const int kb = q / 64, nb = q % 64;
            tr_item_n<2>(a->in[38] + (size_t)le * 512 * 2048, 2048, 128 * kb, 32 * nb, (bf16*)(ws + WS_WDN) + (size_t)le * 2048 * 512, 512, 32 * nb, 128 * kb, scr, lane, nullptr); }
    }
}

__device__ __forceinline__ void prologue(const int wv, LAS unsigned char* lds, const int part) {
    const ArgsP a = get_args();
#ifdef NO_PROL
    return;
#endif
    OPAQUE_TID(); const int lane = tid & 63, wave = tid >> 6;
    unsigned char* ws = a->ws;
    LAS float* scr = (LAS float*)(lds + wave * 16384);
    const int gw = blockIdx.x * NWAVES + wave, NGW = gridDim.x * NWAVES;
    constexpr int I0 = 2 * 3584, I1 = 2 * 1024, I2 = 2 * 4 * 1024,     I3 = 2 * 32 * 16, I4 = MOE_PROLOGUE_LAYERS * 32 * 768;
    constexpr int NITEMS = I0 + I1 + I2 + I3 + I4;
    for (int it = (part == 0 ? 0 : 3584) + gw; it < (part == 0 ? 3584 : NITEMS); it += NGW) {
        int r = it;
        if (r < I0) { const int e = r / 3584, rr = r % 3584, kb = rr / 224, nb = rr % 224;
            tr_item_n<2>(a->in[1] + (size_t)e * 2048 * EVEN_IN, EVEN_IN, 128 * kb, 32 * nb, (bf16*)(ws + WS_WIN) + (size_t)e * ZW * 2048, 2048, 32 * nb, 128 * kb, scr, lane, nullptr); continue; } r -= I0;
        if (r < I1) { const int e = r / 1024, rr = r % 1024, kb = rr / 64, nb = rr % 64;
            tr_item_n<2>(a->in[6] + (size_t)e * 2048 * 2048, 2048, 128 * kb, 32 * nb, (bf16*)(ws + WS_WOUT) + (size_t)e * 2048 * 2048, 2048, 32 * nb, 128 * kb, scr, lane, nullptr); continue; } r -= I1;
        if (r < I2) { const int o = r / 4096, rr = r % 4096, mat = rr / 1024, q = rr % 1024, kb = q / 64, nb = q % 64;
            const float* src = (mat == 0 ? a->in[8] : mat == 1 ? a->in[9] : mat == 2 ? a->in[10] : a->in[11]) + (size_t)o * 2048 * 2048;
            bf16* dst = (mat < 3) ? (bf16*)(ws + WS_WRKV) + (size_t)o * 3 * 2048 * 2048 + (size_t)mat * 2048 * 2048 : (bf16*)(ws + WS_WO) + (size_t)o * 2048 * 2048;
            tr_item_n<2>(src, 2048, 128 * kb, 32 * nb, dst, 2048, 32 * nb, 128 * kb, scr, lane, nullptr); continue; } r -= I2;
        if (r < I3) { const int o = r / 512, rr = r % 512, kb = rr / 16, nb = rr % 16;
            const float* src; int ldw, n0, drow0, mu;
            if (nb < 8) { src = a->in[18] + (size_t)o * 2048 * 256; ldw = 256; n0 = 32 * nb; drow0 = 32 * nb; mu = 5; }
            else if (nb < 11) { src = a->in[13] + (size_t)o * 2048 * 96; ldw = 96; n0 = 32 * (nb - 8); drow0 = 256 + n0; mu = 1; }
            else if (nb < 14) { src = a->in[16] + (size_t)o * 2048 * 96; ldw = 96; n0 = 32 * (nb - 11); drow0 = 352 + n0; mu = 4; }
            else { if (o == 0) continue; src = a->in[26]; ldw = 64; n0 = 32 * (nb - 14); drow0 = 448 + n0; mu = 3; }
            bf16* dst = (bf16*)(ws + WS_WL1) + (size_t)o * 2 * 512 * 2048;
            tr_item(src, ldw, 64 * kb, n0, dst, 2048, drow0, 64 * kb, scr, lane, nullptr);
            tr_item(src, ldw, 64 * kb, n0, dst + (size_t)512 * 2048, 2048, drow0, 64 * kb, scr, lane, a->in[7] + (size_t)(o * 6 + mu) * 2048);
            continue; } r -= I3;
        { const int le = r / 768, rr = r % 768, mat = rr / 256, q = rr % 256;
            if (mat < 2) { const int kb = q / 16, nb = q % 16, n0 = 32 * nb;
                tr_item_n<2>((mat == 0 ? a->in[36] : a->in[37]) + (size_t)le * 2048 * 512, 512, 128 * kb, n0, (bf16*)(ws + WS_WGU) + (size_t)le * 1024 * 2048, 2048,
                        (n0 / 128) * 256 + (n0 % 128) + (mat == 1 ? 128 : 0), 128 * kb, scr, lane, nullptr); }
            else { const int kb = q / 64, nb = q % 64;
                tr_item_n<2>(a->in[38] + (size_t)le * 512 * 2048, 2048, 128 * kb, 32 * nb, (bf16*)(ws + WS_WDN) + (size_t)le * 2048 * 512, 512, 32 * nb, 128 * kb, scr, lane, nullptr); }
        }
    }
    const int gt = blockIdx.x * NTHR + tid, NGT = gridDim.x * NTHR;
    for (int idx = gt; part == 1 && idx < 2 * 32 * 8192; idx += NGT) {
        const int o = idx / (32 * 8192), rem = idx % (32 * 8192), kg = rem / 8192, n = rem % 8192, mat = n / 2048, nn = n % 2048;
        float v[8];
#pragma unroll
        for (int j = 0; j < 8; ++j) { const int k = 8 * kg + j; float x = 0.f;
            if (mat == 0) x = a->in[19][((size_t)o * 256 + k) * 2048 + nn];
            else if (mat == 1) { if (k < 96) x = a->in[14][((size_t)o * 96 + k) * 2048 + nn]; }
            else if (mat == 2) { if (k >= 96 && k < 192) x = a->in[17][((size_t)o * 96 + (k - 96)) * 2048 + nn]; }
            else { if (o == 1 && k >= 192) x = a->in[27][(size_t)(k - 192) * 2048 + nn]; }
            v[j] = x; }
        v4u w; w.x = pk2(v[0], v[1]); w.y = pk2(v[2], v[3]); w.z = pk2(v[4], v[5]); w.w = pk2(v[6], v[7]);
        *(v4u*)((bf16*)(ws + WS_WL2) + ((size_t)o * 8192 + n) * 256 + 8 * kg) = w;
    }
    for (int idx = gt; part == 0 && idx < 4 * 2048 * 9; idx += NGT) { const int l = idx / (2048 * 9), rem = idx % (2048 * 9), k = rem / 9, q = rem % 9;
        const f32x4 v = (q == 0) ? *(const f32x4*)(a->in[32] + ((size_t)l * 2048 + k) * 4) : *(const f32x4*)(a->in[34] + ((size_t)l * 2048 + k) * 32 + 4 * (q - 1));
        ((f32x4*)(ws + WS_RW))[(size_t)l * 9 * 2048 + q * 2048 + ((k >> 8) * 4 + (k & 3)) * 64 + ((k >> 2) & 63)] = v; }
    for (int i0 = gt; part == 0 && i0 < T_ * D_ / 4; i0 += 8 * NGT) { f32x4 v[8];
#pragma unroll
        for (int k = 0; k < 8; ++k) { const int i = i0 + k * NGT; v[k] = (i < T_ * D_ / 4) ? __builtin_nontemporal_load((const f32x4*)a->in[0] + i) : (f32x4){0.f, 0.f, 0.f, 0.f}; }
#pragma unroll
        for (int k = 0; k < 8; ++k) { const int i = i0 + k * NGT; if (i < T_ * D_ / 4) { v2u w; w.x = pk2(v[k].x, v[k].y); w.y = pk2(v[k].z, v[k].w); ((v2u*)(ws + WS_XB))[i] = w; } } }
}

__device__ __forceinline__ void even_prep(const int wv, int e, LAS unsigned char* lds, int u) {
    const ArgsP a = get_args();
#ifdef NO_EPREP
    return;
#endif
    OPAQUE_TID(); const int lane = tid & 63, wave = tid >> 6;
    unsigned char* ws = a->ws;
    bf16* Z = (bf16*)(ws + WS_Z);
    const int m0 = 64 * u, b = u >> 6, ch = u & 63, t0 = ch * 64;
    { LAS float* cst = (LAS float*)lds; LAS float* snt = cst + 1024;
#pragma unroll 1
      for (int q = tid; q < 1024; q += NTHR) { const int r = q >> 4, i = q & 15; const float inv = exp2f(-(float)i * (18.931568569324174f / 16.f));
          float sn_, cs_; sincosf((float)(t0 + r) * inv, &sn_, &cs_); cst[q] = cs_; snt[q] = sn_; }
      __syncthreads();
      const int row = tid >> 3, head = tid & 7;
      float cs[16], sn[16];
#pragma unroll
      for (int i = 0; i < 4; ++i) { const f32x4 c4 = *(const LAS f32x4*)(cst + row * 16 + 4 * i), s4 = *(const LAS f32x4*)(snt + row * 16 + 4 * i);
          cs[4 * i] = c4.x; cs[4 * i + 1] = c4.y; cs[4 * i + 2] = c4.z; cs[4 * i + 3] = c4.w; sn[4 * i] = s4.x; sn[4 * i + 1] = s4.y; sn[4 * i + 2] = s4.z; sn[4 * i + 3] = s4.w; }
#pragma unroll 1
      for (int qk = 0; qk < 2; ++qk) { v4u* p = (v4u*)(Z + (size_t)(m0 + row) * ZW + qk * 1024 + head * 128);
        v4u w0 = p[0], w1 = p[1], w2 = p[2], w3 = p[3]; unsigned x1[8] = {w0.x, w0.y, w0.z, w0.w, w1.x, w1.y, w1.z, w1.w}, x2[8] = {w2.x, w2.y, w2.z, w2.w, w3.x, w3.y, w3.z, w3.w};
        unsigned o1[8], o2[8];
#pragma unroll
        for (int j = 0; j < 8; ++j) { const float a0 = bflo(x1[j]), a1 = bfhi(x1[j]), b0 = bflo(x2[j]), b1 = bfhi(x2[j]);
            o1[j] = pk2(a0 * cs[2 * j] - b0 * sn[2 * j], a1 * cs[2 * j + 1] - b1 * sn[2 * j + 1]);
            o2[j] = pk2(b0 * cs[2 * j] + a0 * sn[2 * j], b1 * cs[2 * j + 1] + a1 * sn[2 * j + 1]); }
        p[0] = (v4u){o1[0], o1[1], o1[2], o1[3]}; p[1] = (v4u){o1[4], o1[5], o1[6], o1[7]}; p[2] = (v4u){o2[0], o2[1], o2[2], o2[3]}; p[3] = (v4u){o2[4], o2[5], o2[6], o2[7]}; }
    }
    VM_WAIT(); __syncthreads();
    { LAS float* red = (LAS float*)lds;
      const int cg = tid & 127, rq = tid >> 7; float s[8] = {0, 0, 0, 0, 0, 0, 0, 0};
      for (int r = 0; r < 16; ++r) { const v4u w = *(const v4u*)(Z + (size_t)(m0 + rq * 16 + r) * ZW + 1024 + cg * 8);
          s[0] += bflo(w.x); s[1] += bfhi(w.x); s[2] += bflo(w.y); s[3] += bfhi(w.y); s[4] += bflo(w.z); s[5] += bfhi(w.z); s[6] += bflo(w.w); s[7] += bfhi(w.w); }
#pragma unroll
      for (int j = 0; j < 8; ++j) red[rq * 1024 + cg * 8 + j] = s[j];
      __syncthreads();
      if (tid < 256) { f32x4 t = {0, 0, 0, 0};
#pragma unroll
          for (int q = 0; q < 4; ++q) { const f32x4 v = *(const LAS f32x4*)(red + q * 1024 + tid * 4); t += v; }
          const int c = tid * 4, h = c >> 7, d = c & 127;
          *(f32x4*)((float*)(ws + WS_KPART) + ((size_t)((b * 8 + h) * 64 + ch)) * 128 + d) = t; }
      __syncthreads();
    }
    { const int cg = tid & 255, rh = tid >> 8; const int c0 = 8 * cg;
      const float* cw = a->in[3] + (size_t)e * 4 * 2048; const float* cb = a->in[4] + (size_t)e * 2048;
      float w[4][8], bias[8];
#pragma unroll
      for (int j = 0; j < 4; ++j)
#pragma unroll
          for (int i = 0; i < 8; ++i) w[j][i] = cw[j * 2048 + c0 + i];
#pragma unroll
      for (int i = 0; i < 8; ++i) bias[i] = cb[c0 + i];
      float win[3][8];
#pragma unroll
      for (int j = 0; j < 3; ++j) { const int tt = t0 + 32 * rh - 3 + j;
          v4u x = {0, 0, 0, 0}; if (tt >= 0) x = *(const v4u*)(Z + (size_t)(b * SEQ + tt) * ZW + 3072 + c0);
          win[j][0] = bflo(x.x); win[j][1] = bfhi(x.x); win[j][2] = bflo(x.y); win[j][3] = bfhi(x.y); win[j][4] = bflo(x.z); win[j][5] = bfhi(x.z); win[j][6] = bflo(x.w); win[j][7] = bfhi(x.w); }
      bf16* QKB = (bf16*)(ws + WS_QKB);
      for (int r = 0; r < 32; ++r) { const int m = m0 + 32 * rh + r;
          const v4u x = *(const v4u*)(Z + (size_t)m * ZW + 3072 + c0);
          float cur[8] = {bflo(x.x), bfhi(x.x), bflo(x.y), bfhi(x.y), bflo(x.z), bfhi(x.z), bflo(x.w), bfhi(x.w)}; float o[8];
#pragma unroll
          for (int i = 0; i < 8; ++i) { const float v = bias[i] + w[0][i] * win[0][i] + w[1][i] * win[1][i] + w[2][i] * win[2][i] + w[3][i] * cur[i]; o[i] = v * __builtin_amdgcn_rcpf(1.f + __expf(-v));
              win[0][i] = win[1][i]; win[1][i] = win[2][i]; win[2][i] = cur[i]; }
          *(v4u*)(QKB + (size_t)m * 2048 + c0) = (v4u){pk2(o[0], o[1]), pk2(o[2], o[3]), pk2(o[4], o[5]), pk2(o[6], o[7])}; }
    }
    { LAS float* wg = (LAS float*)lds;
      const float* Win = a->in[1] + (size_t)e * 2048 * EVEN_IN;
      for (int i = tid; i < 2048 * 2; i += NTHR) { const int k = i >> 1, hf = i & 1;
          *(LAS f32x4*)(wg + ((((k >> 8) * 4 + (k & 3)) * 2 + hf) * 64 + ((k >> 2) & 63)) * 4) = *(const f32x4*)(Win + (size_t)k * EVEN_IN + ZW + hf * 4); }
      __syncthreads();
      const float* gb = a->in[2] + e * 8;
      for (int rr = 0; rr < 8; ++rr) { const int row = wave * 8 + rr, m = m0 + row; const v2u* xr = (const v2u*)(XIN(a, 2 * e) + (size_t)m * D_) + lane;
          float acc[8] = {0, 0, 0, 0, 0, 0, 0, 0};
#pragma unroll 2
          for (int j = 0; j < 8; ++j) { const v2u xw = xr[64 * j]; const f32x4 xv = {bflo(xw.x), bfhi(xw.x), bflo(xw.y), bfhi(xw.y)};
#pragma unroll
              for (int i = 0; i < 4; ++i) { const f32x4 wa = *(const LAS f32x4*)(wg + (((4 * j + i) * 2) * 64 + lane) * 4), wb = *(const LAS f32x4*)(wg + (((4 * j + i) * 2 + 1) * 64 + lane) * 4); const float xx = xv[i];
                  acc[0] += xx * wa.x; acc[1] += xx * wa.y; acc[2] += xx * wa.z; acc[3] += xx * wa.w; acc[4] += xx * wb.x; acc[5] += xx * wb.y; acc[6] += xx * wb.z; acc[7] += xx * wb.w; } }
#pragma unroll
          for (int j = 0; j < 8; ++j) acc[j] = wave_sum(acc[j]);
          if (lane < 4) { const int h = lane; float ip = 0.f, fp = 0.f;
#pragma unroll
              for (int j = 0; j < 4; ++j) { if (j == h) { ip = acc[j]; fp = acc[4 + j]; } }
              ip += gb[h]; fp += gb[4 + h];
              const float lf = -(fmaxf(-fp, 0.f) + __logf(1.f + __expf(-fabsf(fp))));
              ((float*)(ws + WS_IG))[(size_t)(b * 4 + h) * SEQ + t0 + row] = ip;
              ((LAS float*)(lds + 73728))[h * 64 + row] = ip; ((LAS float*)(lds + 73728 + 1024))[h * 64 + row] = lf; } }
      __syncthreads();
    }
    { LAS float* gi = (LAS float*)(lds + 73728); LAS float* gf = gi + 256; LAS float* wsc = gi + 512;
      const int bh0 = b * 4;
      if (wave < 4) { const int h = wave; float x = gf[h * 64 + lane];
#pragma unroll
          for (int o = 1; o < 64; o <<= 1) { const float t = __shfl_up(x, o); if (lane >= o) x += t; }
          const float b63 = __shfl(x, 63);
          wsc[h * 64 + lane] = __expf(b63 - x + gi[h * 64 + lane]) * 0.0625f;
          ((float*)(ws + WS_BC))[(size_t)(bh0 + h) * SEQ + t0 + lane] = x;
          if (lane == 63) ((float*)(ws + WS_DEC))[(bh0 + h) * 64 + ch] = __expf(b63); }
      __syncthreads();
      constexpr int PV = 544;
      LAS unsigned char* Vt = lds; LAS unsigned char* Kt = lds + 64 * PV;
      const int g4 = lane >> 4, q4 = (lane >> 2) & 3, p4 = lane & 3, fr = lane & 15;
      const int wd = wave & 1, we = wave >> 1;
      const bf16* QKB = (const bf16*)(ws + WS_QKB);
      for (int h = 0; h < 4; ++h) {
          { const int sr = tid >> 3, seg = tid & 7; const float wv_ = wsc[h * 64 + sr];
            const v4u* vs = (const v4u*)(Z + (size_t)(m0 + sr) * ZW + 5120 + h * 256 + 32 * seg); const v4u* ks = (const v4u*)(QKB + (size_t)(m0 + sr) * 2048 + 1024 + h * 256 + 32 * seg);
#pragma unroll
            for (int j = 0; j < 4; ++j) { *(LAS v4u*)(Vt + sr * PV + (32 * seg + 8 * j) * 2) = vs[j]; const v4u kk = ks[j];
                *(LAS v4u*)(Kt + sr * PV + (32 * seg + 8 * j) * 2) = (v4u){pk2(bflo(kk.x) * wv_, bfhi(kk.x) * wv_), pk2(bflo(kk.y) * wv_, bfhi(kk.y) * wv_), pk2(bflo(kk.z) * wv_, bfhi(kk.z) * wv_), pk2(bflo(kk.w) * wv_, bfhi(kk.w) * wv_)}; } }
          __syncthreads();
          if (tid < 256) { float sum = 0.f;
#pragma unroll 8
              for (int sr = 0; sr < 64; ++sr) sum += bf2f(*(const LAS bf16*)(Kt + sr * PV + tid * 2));
              ((float*)(ws + WS_DN))[((size_t)(bh0 + h) * 64 + ch) * 256 + tid] = sum; }
          f32x4 acc[8][4];
#pragma unroll
          for (int i = 0; i < 8; ++i)
#pragma unroll
              for (int j = 0; j < 4; ++j) acc[i][j] = (f32x4){0.f, 0.f, 0.f, 0.f};
#pragma unroll
          for (int ks2 = 0; ks2 < 2; ++ks2) {
              bf16x8 yf[4];
#pragma unroll
              for (int et = 0; et < 4; ++et) { const LAS unsigned char* p = Vt + (32 * ks2 + 8 * g4 + q4) * PV + (64 * we + 16 * et + 4 * p4) * 2;
                  const v2u lo = tr_read(p), hi = tr_read(p + 4 * PV); yf[et] = __builtin_bit_cast(bf16x8, (v4u){lo.x, lo.y, hi.x, hi.y}); }
#pragma unroll
              for (int dt = 0; dt < 8; ++dt) { const LAS unsigned char* p = Kt + (32 * ks2 + 8 * g4 + q4) * PV + (128 * wd + 16 * dt + 4 * p4) * 2;
                  const v2u lo = tr_read(p), hi = tr_read(p + 4 * PV); const bf16x8 xf = __builtin_bit_cast(bf16x8, (v4u){lo.x, lo.y, hi.x, hi.y});
#pragma unroll
                  for (int et = 0; et < 4; ++et) acc[dt][et] = __builtin_amdgcn_mfma_f32_16x16x32_bf16(xf, yf[et], acc[dt][et], 0, 0, 0); } }
          { bf16* DC = (bf16*)(ws + WS_DC) + ((size_t)(bh0 + h) * 64 + ch) * 65536;
#pragma unroll
            for (int et = 0; et < 4; ++et)
#pragma unroll
                for (int dt = 0; dt < 8; ++dt) { const f32x4 v = acc[dt][et];
                    *(v2u*)(DC + (size_t)(64 * we + 16 * et + fr) * 256 + 128 * wd + 16 * dt + 4 * g4) = (v2u){pk2(v.x, v.y), pk2(v.z, v.w)}; } }
          __syncthreads();
      }
    }
}

constexpr int AT_PITCH = 272;
constexpr int AT_BUF = 2 * 64 * AT_PITCH;
constexpr int AT_KM_OFF = 2 * AT_BUF, AT_GATE_OFF = AT_KM_OFF + 16 * 128 * 4, AT_SEL_OFF = AT_GATE_OFF + 256 * 16 * 4, AT_TL_OFF = AT_SEL_OFF + 256 * 4, AT_END = AT_TL_OFF + 80 * 4;
static_assert(AT_END <= RING_BYTES, "attention LDS map");

__device__ __forceinline__ void attn_unit(const int wv, LAS unsigned char* lds, int b, int h, int qb) {
    const ArgsP a = get_args();
#ifdef NO_ATTN
    return;
#endif
    OPAQUE_TID(); const int lane = tid & 63, wave = wv, fr = lane & 15, fq = lane >> 4, q4 = (lane >> 2) & 3, p4 = lane & 3;
    unsigned char* ws = a->ws;
    const bf16* Z = (const bf16*)(ws + WS_Z);
    const int q0 = 256 * qb;
    LAS float* km = (LAS float*)(lds + AT_KM_OFF); LAS float* gate = (LAS float*)(lds + AT_GATE_OFF);
    LAS unsigned* sel = (LAS unsigned*)(lds + AT_SEL_OFF); LAS int* tl = (LAS int*)(lds + AT_TL_OFF);
    if (tid == 0) tl[72] = 0;
    for (int i = tid; i < qb * 128; i += NTHR) { const int n = i >> 7, d = i & 127; const float* kp = (const float*)(ws + WS_KPART) + ((size_t)((b * 8 + h) * 64 + 4 * n)) * 128 + d;
        km[i] = (kp[0] + kp[128] + kp[256] + kp[384]) * (1.f / 256.f); }
    __syncthreads();
    if (qb > 3) { const int ql = tid >> 1, part = tid & 1; const v4u* qp = (const v4u*)(Z + (size_t)(b * SEQ + q0 + ql) * ZW + h * 128);
        float g[8] = {0, 0, 0, 0, 0, 0, 0, 0};
        for (int c = 0; c < 16; ++c) { const v4u w = qp[c]; const float qv[8] = {bflo(w.x), bfhi(w.x), bflo(w.y), bfhi(w.y), bflo(w.z), bfhi(w.z), bflo(w.w), bfhi(w.w)};
#pragma unroll
            for (int jj = 0; jj < 8; ++jj) { const int n = part + 2 * jj; if (n < qb) { const LAS float* kk = km + n * 128 + c * 8;
#pragma unroll
                for (int i = 0; i < 8; ++i) g[jj] += qv[i] * kk[i]; } } }
#pragma unroll
        for (int jj = 0; jj < 8; ++jj) { const int n = part + 2 * jj; if (n < qb) gate[ql * 16 + n] = g[jj]; }
    }
    __syncthreads();
    if (tid < 256) { unsigned m = 0;
        if (qb <= 3) m = (1u << qb) - 1u;
        else { for (int r = 0; r < 3; ++r) { float best = -3.0e38f; int bi = 0; for (int n = 0; n < qb; ++n) { const float g = gate[tid * 16 + n]; if (!((m >> n) & 1u) && g > best) { best = g; bi = n; } } m |= 1u << bi; } }
        sel[tid] = m;
        unsigned wm = m;
#pragma unroll
        for (int o = 1; o < 64; o <<= 1) wm |= __shfl_xor(wm, o);
        if (lane == 0) atomicOr((unsigned*)&tl[72], wm); }
    __syncthreads();
    if (tid == 0) { const unsigned um = (unsigned)tl[72];
        int nt = 0;
        for (int j = 0; j < 4; ++j) tl[1 + nt++] = (4 * qb + j) | (1 << 16);
        for (int n = 0; n < qb; ++n) if ((um >> n) & 1u) for (int j = 0; j < 4; ++j) tl[1 + nt++] = 4 * n + j;
        tl[0] = nt; }
    __syncthreads();
    const int ntile = tl[0];
    const unsigned mysel0 = sel[32 * wave + fr], mysel1 = sel[32 * wave + 16 + fr];
    unsigned wsel = mysel0 | mysel1;
#pragma unroll
    for (int o = 1; o < 16; o <<= 1) wsel |= __shfl_xor(wsel, o);
    bf16x8 qf[2][4];
#pragma unroll
    for (int t = 0; t < 2; ++t) { const v4u* qp = (const v4u*)(Z + (size_t)(b * SEQ + q0 + 32 * wave + 16 * t + fr) * ZW + h * 128);
#pragma unroll
        for (int kc = 0; kc < 4; ++kc) qf[t][kc] = __builtin_bit_cast(bf16x8, qp[kc * 4 + fq]); }
    f32x4 o[2][8];
#pragma unroll
    for (int t = 0; t < 2; ++t)
#pragma unroll
        for (int i = 0; i < 8; ++i) o[t][i] = (f32x4){0.f, 0.f, 0.f, 0.f};
    float mrun[2] = {-INFINITY, -INFINITY}, lrun[2] = {0.f, 0.f};
    const float sc = 0.08838834764831845f * 1.4426950408889634f;
    v4u kr0[2], vr0[2], kr1[2], vr1[2];
    auto gload = [&](int ti, v4u (&kr)[2], v4u (&vr)[2]) { const int key0 = 64 * (tl[1 + ti] & 0xffff);
        const v4u* kp = (const v4u*)(Z + (size_t)(b * SEQ + key0 + (tid >> 3)) * ZW + 1024 + h * 128) + (tid & 7) * 2; kr[0] = kp[0]; kr[1] = kp[1]; vr[0] = kp[128]; vr[1] = kp[129]; };
    auto lstore = [&](int bufi, const v4u (&kr)[2], const v4u (&vr)[2]) { LAS v4u* kd = (LAS v4u*)(lds + bufi * AT_BUF + (tid >> 3) * AT_PITCH + (tid & 7) * 32); kd[0] = kr[0]; kd[1] = kr[1];
        LAS v4u* vd = (LAS v4u*)(lds + bufi * AT_BUF + 64 * AT_PITCH + (tid >> 3) * AT_PITCH + (tid & 7) * 32); vd[0] = vr[0]; vd[1] = vr[1]; };
    gload(0, kr0, vr0); gload(1, kr1, vr1); lstore(0, kr0, vr0); __syncthreads();
    auto tile = [&](const int ti, v4u (&ldk)[2], v4u (&ldv)[2], const v4u (&stk)[2], const v4u (&stv)[2]) {
        const int ent = __builtin_amdgcn_readfirstlane(tl[1 + ti]); const int kt64 = ent & 0xffff; const bool own = (ent >> 16) & 1; const int key0 = 64 * kt64;
        if (ti + 2 < ntile) gload(ti + 2, ldk, ldv);
        const LAS unsigned char* Kt = lds + (ti & 1) * AT_BUF; const LAS unsigned char* Vt = Kt + 64 * AT_PITCH;
        const bool wave_active = own ? (key0 <= q0 + 32 * wave + 31) : (((wsel >> (kt64 >> 2)) & 1u) != 0u);
        if (wave_active) {
            f32x4 s[2][4];
            { bf16x8 kfa[2][4], kfb[2][4];
#pragma unroll
              for (int kt = 0; kt < 2; ++kt)
#pragma unroll
                  for (int kc = 0; kc < 4; ++kc) kfa[kt][kc] = *(const LAS bf16x8*)(Kt + (16 * kt + fr) * AT_PITCH + (kc * 32 + fq * 8) * 2);
#pragma unroll
              for (int kt = 0; kt < 2; ++kt)
#pragma unroll
                  for (int kc = 0; kc < 4; ++kc) kfb[kt][kc] = *(const LAS bf16x8*)(Kt + (16 * (kt + 2) + fr) * AT_PITCH + (kc * 32 + fq * 8) * 2);
              __builtin_amdgcn_sched_barrier(0);
#pragma unroll
              for (int kt = 0; kt < 2; ++kt) { s[0][kt] = (f32x4){0.f, 0.f, 0.f, 0.f}; s[1][kt] = (f32x4){0.f, 0.f, 0.f, 0.f};
#pragma unroll
                  for (int kc = 0; kc < 4; ++kc) { s[0][kt] = __builtin_amdgcn_mfma_f32_16x16x32_bf16(kfa[kt][kc], qf[0][kc], s[0][kt], 0, 0, 0); s[1][kt] = __builtin_amdgcn_mfma_f32_16x16x32_bf16(kfa[kt][kc], qf[1][kc], s[1][kt], 0, 0, 0); } }
              __builtin_amdgcn_sched_barrier(0);
#pragma unroll
              for (int kt = 0; kt < 2; ++kt) { s[0][kt + 2] = (f32x4){0.f, 0.f, 0.f, 0.f}; s[1][kt + 2] = (f32x4){0.f, 0.f, 0.f, 0.f};
#pragma unroll
                  for (int kc = 0; kc < 4; ++kc) { s[0][kt + 2] = __builtin_amdgcn_mfma_f32_16x16x32_bf16(kfb[kt][kc], qf[0][kc], s[0][kt + 2], 0, 0, 0); s[1][kt + 2] = __builtin_amdgcn_mfma_f32_16x16x32_bf16(kfb[kt][kc], qf[1][kc], s[1][kt + 2], 0, 0, 0); } }
            }
            bf16x8 vfa[4][2];
#pragma unroll
            for (int dt = 0; dt < 4; ++dt)
#pragma unroll
                for (int j = 0; j < 2; ++j) { const LAS unsigned char* vp = Vt + (32 * j + 4 * fq + q4) * AT_PITCH + (16 * dt + 4 * p4) * 2;
                    const v2u lo = tr_read(vp), hi = tr_read(vp + 16 * AT_PITCH); vfa[dt][j] = __builtin_bit_cast(bf16x8, (v4u){lo.x, lo.y, hi.x, hi.y}); }
            __builtin_amdgcn_sched_barrier(0);
            bf16x8 pf[2][2];
            const bool diag = own && (key0 + 63 > q0 + 32 * wave);
#pragma unroll
            for (int t = 0; t < 2; ++t) { const int qabs = q0 + 32 * wave + 16 * t + fr; const unsigned ms = t ? mysel1 : mysel0;
                const bool qsel = own || ((ms >> (kt64 >> 2)) & 1u);
                if (diag) {
#pragma unroll
                    for (int kt = 0; kt < 4; ++kt)
#pragma unroll
                        for (int e = 0; e < 4; ++e) { const int kabs = key0 + 16 * kt + 4 * fq + e; if (kabs > qabs) s[t][kt][e] = -INFINITY; } }
                float mx = s[t][0][0];
#pragma unroll
                for (int kt = 0; kt < 4; ++kt)
#pragma unroll
                    for (int e = 0; e < 4; ++e) mx = fmaxf(mx, s[t][kt][e]);
                mx = qsel ? mx * sc : -INFINITY;
                mx = fmaxf(mx, __shfl_xor(mx, 16)); mx = fmaxf(mx, __shfl_xor(mx, 32));
                const bool need = mx > mrun[t] + 8.f;
                if (__builtin_amdgcn_ballot_w64(need) != 0ull) {
                    const float mnew = need ? mx : mrun[t];
                    const float alpha = need ? __builtin_amdgcn_exp2f(mrun[t] - mnew) : 1.f;
                    lrun[t] *= alpha; mrun[t] = mnew;
#pragma unroll
                    for (int i = 0; i < 8; ++i) o[t][i] *= alpha; }
                const float scl = qsel ? sc : 0.f, nbias = qsel ? -mrun[t] : -1.0e30f;
                float psum = 0.f;
#pragma unroll
                for (int kt = 0; kt < 4; ++kt)
#pragma unroll
                    for (int e = 0; e < 4; ++e) { const float p = __builtin_amdgcn_exp2f(fmaf(s[t][kt][e], scl, nbias)); s[t][kt][e] = p; psum += p; }
                lrun[t] += psum;
#pragma unroll
                for (int j = 0; j < 2; ++j) { const v4u w = {pk2(s[t][2 * j][0], s[t][2 * j][1]), pk2(s[t][2 * j][2], s[t][2 * j][3]), pk2(s[t][2 * j + 1][0], s[t][2 * j + 1][1]), pk2(s[t][2 * j + 1][2], s[t][2 * j + 1][3])};
                    pf[t][j] = __builtin_bit_cast(bf16x8, w); } }
            { bf16x8 vfb[4][2];
              __builtin_amdgcn_sched_barrier(0);
#pragma unroll
              for (int dt = 0; dt < 4; ++dt)
#pragma unroll
                  for (int j = 0; j < 2; ++j) { const LAS unsigned char* vp = Vt + (32 * j + 4 * fq + q4) * AT_PITCH + (16 * (dt + 4) + 4 * p4) * 2;
                      const v2u lo = tr_read(vp), hi = tr_read(vp + 16 * AT_PITCH); vfb[dt][j] = __builtin_bit_cast(bf16x8, (v4u){lo.x, lo.y, hi.x, hi.y}); }
              __builtin_amdgcn_sched_barrier(0);
#pragma unroll
              for (int dt = 0; dt < 4; ++dt)
#pragma unroll
                  for (int j = 0; j < 2; ++j) { o[0][dt] = __builtin_amdgcn_mfma_f32_16x16x32_bf16(vfa[dt][j], pf[0][j], o[0][dt], 0, 0, 0); o[1][dt] = __builtin_amdgcn_mfma_f32_16x16x32_bf16(vfa[dt][j], pf[1][j], o[1][dt], 0, 0, 0); }
              __builtin_amdgcn_sched_barrier(0);
#pragma unroll
              for (int dt = 0; dt < 4; ++dt)
#pragma unroll
                  for (int j = 0; j < 2; ++j) { o[0][dt + 4] = __builtin_amdgcn_mfma_f32_16x16x32_bf16(vfb[dt][j], pf[0][j], o[0][dt + 4], 0, 0, 0); o[1][dt + 4] = __builtin_amdgcn_mfma_f32_16x16x32_bf16(vfb[dt][j], pf[1][j], o[1][dt + 4], 0, 0, 0); }
            }
        }
        if (ti + 1 < ntile) lstore((ti + 1) & 1, stk, stv);
        __syncthreads();
    };
    for (int ti = 0; ti < ntile; ti += 2) { tile(ti, kr0, vr0, kr1, vr1); if (ti + 1 < ntile) tile(ti + 1, kr1, vr1, kr0, vr0); }
#pragma unroll
    for (int t = 0; t < 2; ++t) { float lt = lrun[t]; lt += __shfl_xor(lt, 16); lt += __shfl_xor(lt, 32);
        const float inv = 1.f / lt;
        bf16* Y = (bf16*)(ws + WS_YE) + (size_t)(b * SEQ + q0 + 32 * wave + 16 * t + fr) * 2048 + h * 128;
#pragma unroll
        for (int dt = 0; dt < 8; ++dt) { v2u w; w.x = pk2(o[t][dt][0] * inv, o[t][dt][1] * inv); w.y = pk2(o[t][dt][2] * inv, o[t][dt][3] * inv); *(v2u*)(Y + 16 * dt + 4 * fq) = w; } }
    __syncthreads();
}

__device__ __forceinline__ void mlstm_scan(const int wv) {
    const ArgsP a = get_args();
    OPAQUE_TID();
    unsigned char* ws = a->ws;
    const int gt = blockIdx.x * NTHR + tid, NGT = gridDim.x * NTHR;
    for (int idx = gt; idx < 16 * 256 * 32; idx += NGT) { const int bh = idx >> 13, rem = idx & 8191;
        const bf16* DC = (const bf16*)(ws + WS_DC) + (size_t)bh * 64 * 65536 + rem * 8; bf16* CP = (bf16*)(ws + WS_CP) + (size_t)bh * 64 * 65536 + rem * 8;
        const float* dec = (const float*)(ws + WS_DEC) + bh * 64;
        float C[8] = {0, 0, 0, 0, 0, 0, 0, 0};
        for (int c0 = 0; c0 < 64; c0 += 16) { v4u in[16];
#pragma unroll
            for (int j = 0; j < 16; ++j) in[j] = __builtin_nontemporal_load((const v4u*)(DC + (size_t)(c0 + j) * 65536));
#pragma unroll
            for (int j = 0; j < 16; ++j) { const float dc = dec[c0 + j];
                *(v4u*)(CP + (size_t)(c0 + j) * 65536) = (v4u){pk2(C[0], C[1]), pk2(C[2], C[3]), pk2(C[4], C[5]), pk2(C[6], C[7])};
                C[0] = fmaf(dc, C[0], bflo(in[j].x)); C[1] = fmaf(dc, C[1], bfhi(in[j].x)); C[2] = fmaf(dc, C[2], bflo(in[j].y)); C[3] = fmaf(dc, C[3], bfhi(in[j].y));
                C[4] = fmaf(dc, C[4], bflo(in[j].z)); C[5] = fmaf(dc, C[5], bfhi(in[j].z)); C[6] = fmaf(dc, C[6], bflo(in[j].w)); C[7] = fmaf(dc, C[7], bfhi(in[j].w)); } }
    }
    for (int idx = gt; idx < 16 * 256; idx += NGT) { const int bh = idx >> 8, d = idx & 255; const float* DN = (const float*)(ws + WS_DN) + (size_t)bh * 64 * 256 + d; float* NP = (float*)(ws + WS_NP) + (size_t)bh * 64 * 256 + d;
        const float* dec = (const float*)(ws + WS_DEC) + bh * 64; float n = 0.f;
        for (int c = 0; c < 64; ++c) { NP[c * 256] = n; n = fmaf(dec[c], n, DN[c * 256]); } }
}

constexpr int M3_PQ = 528, M3_PVv = 544, M3_PP = 144;
constexpr int M3_Q = 0, M3_K = 64 * M3_PQ, M3_V = 2 * 64 * M3_PQ, M3_P = M3_V + 64 * M3_PVv, M3_F = M3_P + 64 * M3_PP;
__device__ __forceinline__ void mlstm_out_unit(const int wv, LAS unsigned char* lds, int e_, int b, int h, int c) {
    const ArgsP a = get_args();
    OPAQUE_TID(); const int lane = tid & 63, wave = wv, fr = lane & 15, fq = lane >> 4, q4 = (lane >> 2) & 3, p4 = lane & 3;
    unsigned char* ws = a->ws;
    const int bh = b * 4 + h, m0 = b * SEQ + 64 * c;
    const bf16* QKB = (const bf16*)(ws + WS_QKB); const bf16* Z = (const bf16*)(ws + WS_Z);
    LAS unsigned char* Qt = lds + M3_Q; LAS unsigned char* Kt = lds + M3_K; LAS unsigned char* Vt = lds + M3_V; LAS unsigned char* Pm = lds + M3_P;
    LAS float* F = (LAS float*)(lds + M3_F); LAS float* bt = F; LAS float* itv = F + 64; LAS float* ebt = F + 128; LAS float* den = F + 192; LAS float* rstd = F + 256; LAS float* np = F + 320; LAS float* rsp = F + 576;
    { const int sr = tid >> 3, seg = tid & 7;
      const v4u* qs = (const v4u*)(QKB + (size_t)(m0 + sr) * 2048 + h * 256 + 32 * seg); const v4u* ks = (const v4u*)(QKB + (size_t)(m0 + sr) * 2048 + 1024 + h * 256 + 32 * seg);
      const v4u* vs = (const v4u*)(Z + (size_t)(m0 + sr) * ZW + 5120 + h * 256 + 32 * seg);
#pragma unroll
      for (int j = 0; j < 4; ++j) { *(LAS v4u*)(Qt + sr * M3_PQ + (32 * seg + 8 * j) * 2) = qs[j]; *(LAS v4u*)(Kt + sr * M3_PQ + (32 * seg + 8 * j) * 2) = ks[j]; *(LAS v4u*)(Vt + sr * M3_PVv + (32 * seg + 8 * j) * 2) = vs[j]; }
      if (tid < 64) { const float bb = ((const float*)(ws + WS_BC))[(size_t)bh * SEQ + 64 * c + tid]; bt[tid] = bb; ebt[tid] = __expf(bb); itv[tid] = ((const float*)(ws + WS_IG))[(size_t)bh * SEQ + 64 * c + tid]; }
      else if (tid < 320) np[tid - 64] = ((const float*)(ws + WS_NP))[((size_t)bh * 64 + c) * 256 + tid - 64]; }
    v4u cf[8][2];
    { const bf16* CP = (const bf16*)(ws + WS_CP) + ((size_t)bh * 64 + c) * 65536 + (size_t)(32 * wave + fr) * 256 + 8 * fq;
#pragma unroll
      for (int kk = 0; kk < 8; ++kk)
#pragma unroll
          for (int et = 0; et < 2; ++et) cf[kk][et] = *(const v4u*)(CP + et * 16 * 256 + 32 * kk); }
    __syncthreads();
    { const int ss = wave >> 1;
#pragma unroll
      for (int ti = 0; ti < 2; ++ti) { const int tt = 2 * (wave & 1) + ti; f32x4 sacc = {0.f, 0.f, 0.f, 0.f};
#pragma unroll
          for (int kk = 0; kk < 8; ++kk) { const bf16x8 kf = *(const LAS bf16x8*)(Kt + (16 * ss + fr) * M3_PQ + (32 * kk + 8 * fq) * 2), qf = *(const LAS bf16x8*)(Qt + (16 * tt + fr) * M3_PQ + (32 * kk + 8 * fq) * 2);
              sacc = __builtin_amdgcn_mfma_f32_16x16x32_bf16(kf, qf, sacc, 0, 0, 0); }
          const int t = 16 * tt + fr; const float btv = bt[t]; float pv[4];
#pragma unroll
          for (int r = 0; r < 4; ++r) { const int s_ = 16 * ss + 4 * fq + r; pv[r] = (s_ <= t) ? sacc[r] * __expf(btv - bt[s_] + itv[s_]) * 0.0625f : 0.f; }
          *(LAS v2u*)(Pm + t * M3_PP + (16 * ss + 4 * fq) * 2) = (v2u){pk2(pv[0], pv[1]), pk2(pv[2], pv[3])}; } }
    float qn;
    { const int t = tid >> 3, part = tid & 7; float sacc = 0.f;
#pragma unroll
      for (int j = 0; j < 4; ++j) { const v4u w = *(const LAS v4u*)(Qt + t * M3_PQ + (32 * part + 8 * j) * 2); const LAS float* nn = np + 32 * part + 8 * j;
          sacc += bflo(w.x) * nn[0] + bfhi(w.x) * nn[1] + bflo(w.y) * nn[2] + bfhi(w.y) * nn[3] + bflo(w.z) * nn[4] + bfhi(w.z) * nn[5] + bflo(w.w) * nn[6] + bfhi(w.w) * nn[7]; }
      sacc += dppf<0xB1>(sacc); sacc += dppf<0x4E>(sacc); sacc += dppf<0x141>(sacc); qn = sacc; }
    __syncthreads();
    { const int t = tid >> 3, part = tid & 7; const v4u w = *(const LAS v4u*)(Pm + t * M3_PP + part * 16);
      float ps = bflo(w.x) + bfhi(w.x) + bflo(w.y) + bfhi(w.y) + bflo(w.z) + bfhi(w.z) + bflo(w.w) + bfhi(w.w);
      ps += dppf<0xB1>(ps); ps += dppf<0x4E>(ps); ps += dppf<0x141>(ps);
      if (part == 0) den[t] = ebt[t] * qn + ps; }
    f32x4 acc[4][2];
#pragma unroll
    for (int tt = 0; tt < 4; ++tt) { acc[tt][0] = (f32x4){0.f, 0.f, 0.f, 0.f}; acc[tt][1] = (f32x4){0.f, 0.f, 0.f, 0.f}; }
#pragma unroll
    for (int kk = 0; kk < 8; ++kk)
#pragma unroll
        for (int tt = 0; tt < 4; ++tt) { const bf16x8 qf = *(const LAS bf16x8*)(Qt + (16 * tt + fr) * M3_PQ + (32 * kk + 8 * fq) * 2);
            acc[tt][0] = __builtin_amdgcn_mfma_f32_16x16x32_bf16(qf, __builtin_bit_cast(bf16x8, cf[kk][0]), acc[tt][0], 0, 0, 0);
            acc[tt][1] = __builtin_amdgcn_mfma_f32_16x16x32_bf16(qf, __builtin_bit_cast(bf16x8, cf[kk][1]), acc[tt][1], 0, 0, 0); }
#pragma unroll
    for (int tt = 0; tt < 4; ++tt) { const f32x4 eb = *(const LAS f32x4*)(ebt + 16 * tt + 4 * fq); acc[tt][0] *= eb; acc[tt][1] *= eb; }
#pragma unroll
    for (int j = 0; j < 2; ++j) { bf16x8 vf[2];
#pragma unroll
        for (int et = 0; et < 2; ++et) { const LAS unsigned char* p = Vt + (32 * j + 8 * fq + q4) * M3_PVv + (32 * wave + 16 * et + 4 * p4) * 2;
            const v2u lo = tr_read(p), hi = tr_read(p + 4 * M3_PVv); vf[et] = __builtin_bit_cast(bf16x8, (v4u){lo.x, lo.y, hi.x, hi.y}); }
#pragma unroll
        for (int tt = 0; tt < 4; ++tt) { const bf16x8 pf = *(const LAS bf16x8*)(Pm + (16 * tt + fr) * M3_PP + (32 * j + 8 * fq) * 2);
            acc[tt][0] = __builtin_amdgcn_mfma_f32_16x16x32_bf16(pf, vf[0], acc[tt][0], 0, 0, 0); acc[tt][1] = __builtin_amdgcn_mfma_f32_16x16x32_bf16(pf, vf[1], acc[tt][1], 0, 0, 0); } }
    __syncthreads();
    LAS unsigned char* Ht = Qt;
#pragma unroll
    for (int tt = 0; tt < 4; ++tt) { const f32x4 dn = *(const LAS f32x4*)(den + 16 * tt + 4 * fq); float ssq[4];
#pragma unroll
        for (int r = 0; r < 4; ++r) { const float dv = __builtin_amdgcn_rcpf(fmaxf(fabsf(dn[r]), 1.f)); const float h0 = acc[tt][0][r] * dv, h1 = acc[tt][1][r] * dv; ssq[r] = red16(h0 * h0 + h1 * h1);
            const int t = 16 * tt + 4 * fq + r;
            *(LAS bf16*)(Ht + t * M3_PQ + (32 * wave + fr) * 2) = (bf16)f2bf(h0); *(LAS bf16*)(Ht + t * M3_PQ + (32 * wave + 16 + fr) * 2) = (bf16)f2bf(h1); }
        if (fr == 0) *(LAS f32x4*)(rsp + wave * 64 + 16 * tt + 4 * fq) = (f32x4){ssq[0], ssq[1], ssq[2], ssq[3]}; }
    __syncthreads();
    if (tid < 64) { float tot = 0.f;
#pragma unroll
        for (int w = 0; w < 8; ++w) tot += rsp[w * 64 + tid];
        rstd[tid] = 1.f / sqrtf(tot * (1.f / 256.f) + 1e-6f); }
    __syncthreads();
    { const int t = tid >> 3, seg = tid & 7; const float rs = rstd[t]; const float* hg = a->in[5] + (size_t)e_ * 1024 + h * 256 + 32 * seg;
      const v4u* os = (const v4u*)(Z + (size_t)(m0 + t) * ZW + 6144 + h * 256 + 32 * seg); v4u* yd = (v4u*)((bf16*)(ws + WS_YE) + (size_t)(m0 + t) * 2048 + 1024 + h * 256 + 32 * seg);
#pragma unroll
      for (int j = 0; j < 4; ++j) { const v4u hw = *(const LAS v4u*)(Ht + t * M3_PQ + (32 * seg + 8 * j) * 2), ow = os[j]; const f32x4 g0 = *(const f32x4*)(hg + 8 * j), g1 = *(const f32x4*)(hg + 8 * j + 4);
          yd[j] = (v4u){pk2(bflo(hw.x) * rs * g0.x * sigmoidf_(bflo(ow.x)), bfhi(hw.x) * rs * g0.y * sigmoidf_(bfhi(ow.x))), pk2(bflo(hw.y) * rs * g0.z * sigmoidf_(bflo(ow.y)), bfhi(hw.y) * rs * g0.w * sigmoidf_(bfhi(ow.y))),
                        pk2(bflo(hw.z) * rs * g1.x * sigmoidf_(bflo(ow.z)), bfhi(hw.z) * rs * g1.y * sigmoidf_(bfhi(ow.z))), pk2(bflo(hw.w) * rs * g1.z * sigmoidf_(bflo(ow.w)), bfhi(hw.w) * rs * g1.w * sigmoidf_(bfhi(ow.w)))}; } }
    __syncthreads();
}

__device__ __forceinline__ void odd_prep(const int wv, int o) {
    const ArgsP a = get_args();
#ifdef NO_OPREP
    return;
#endif
    OPAQUE_TID(); const int lane = tid & 63, wave = tid >> 6;
    unsigned char* ws = a->ws;
    const float* mu = a->in[7] + (size_t)o * 6 * 2048;
    bf16* XR = (bf16*)(ws + WS_XRKV); bf16* XK = XR + (size_t)T_ * 2048; bf16* XV = XK + (size_t)T_ * 2048; bf16* XC = (bf16*)(ws + WS_XC);
    const int gw = blockIdx.x * NWAVES + wave, NGW = gridDim.x * NWAVES;
    for (int m = gw; m < T_; m += NGW) { const bool first = (m % SEQ) == 0;
        const f32x4* xr = (const f32x4*)(a->out + (size_t)m * D_) + lane; const f32x4* xp = (const f32x4*)(a->out + (size_t)(m - 1) * D_) + lane;
#pragma unroll
        for (int j = 0; j < 8; ++j) { const f32x4 x = xr[64 * j]; f32x4 p = {0.f, 0.f, 0.f, 0.f}; if (!first) p = xp[64 * j]; const f32x4 dx = p - x;
            const f32x4 m0 = ((const f32x4*)mu)[lane + 64 * j], m2 = ((const f32x4*)(mu + 2 * 2048))[lane + 64 * j], m3 = ((const f32x4*)(mu + 3 * 2048))[lane + 64 * j];
            const f32x4 r = x + dx * m0, k = x + dx * m2, v = x + dx * m3; const size_t off = (size_t)m * 2048 + 4 * (lane + 64 * j);
            *(v2u*)(XR + off) = (v2u){pk2(r.x, r.y), pk2(r.z, r.w)}; *(v2u*)(XK + off) = (v2u){pk2(k.x, k.y), pk2(k.z, k.w)}; *(v2u*)(XV + off) = (v2u){pk2(v.x, v.y), pk2(v.z, v.w)};
            const size_t offc = (size_t)m * 4096 + 4 * (lane + 64 * j);
            *(v2u*)(XC + offc) = (v2u){pk2(x.x, x.y), pk2(x.z, x.w)}; *(v2u*)(XC + offc + 2048) = (v2u){pk2(dx.x, dx.y), pk2(dx.z, dx.w)}; }
    }
}

constexpr int RK_KQ = 0, RK_RQ = 4096, RK_TAB = 8192, RK_XU = 9216, RK_W4 = 17408, RK_VB = 19456, RK_CBUF = 27648;
constexpr int RK_PB0 = 3 * RK_CBUF, RK_PG = 0, RK_PV = 4096, RK_PBON = 8192, RK_PBSZ = 8320;
constexpr int RK_Y0 = RK_PB0 + 4 * RK_PBSZ, RK_YSZ = 64 * 36 * 4;
constexpr int RK_XS = RK_Y0 + 2 * RK_YSZ;
constexpr int RK_ZERO = RK_XS + 16384;
static_assert(RK_ZERO + 8192 <= RING_BYTES, "rwkv LDS map");
__device__ __forceinline__ float dot16(const f32x4 x, const f32x4 y) { return red16(x.x * y.x + x.y * y.y + x.z * y.z + x.w * y.w); }
__device__ __forceinline__ v2u pk4(const f32x4 v) { return (v2u){pk2(v.x, v.y), pk2(v.z, v.w)}; }
__device__ __forceinline__ f32x4 unpk4(const v2u w) { return (f32x4){bflo(w.x), bfhi(w.x), bflo(w.y), bfhi(w.y)}; }

template <bool DRY = false> __device__ __forceinline__ void rwkv_unit(const int wv, LAS unsigned char* lds, int o, int b, int h) {
    const ArgsP a = get_args();
#ifdef NO_RWKV
    return;
#endif
    OPAQUE_TID(); const int lane = tid & 63, fr = lane & 15, fq = lane >> 4;
    unsigned char* ws = a->ws;
    constexpr int NCH = SEQ / 32;
    for (int i = tid; i < 8192 / 16; i += NTHR) *(LAS v4u*)(lds + RK_ZERO + 16 * i) = (v4u){0u, 0u, 0u, 0u};
    if (wv < 4) {
        f32x4 S[4];
#pragma unroll
        for (int kt = 0; kt < 4; ++kt) S[kt] = (f32x4){0.f, 0.f, 0.f, 0.f};
        const int row = 16 * wv + fr;
        const bool f0 = fq == 0;
        struct Ops { v2u kq[4], rq[4]; f32x4 tab[8], vv, w4[4]; v4u xu[4]; };
        auto load_ops = [&](const LAS unsigned char* B, const LAS unsigned char* xb, int bk, Ops& o) {
            const LAS unsigned char* kp = B + RK_KQ + bk * 512 + (fr & 3) * 128 + 8 * fq; const LAS unsigned char* rp = kp + (RK_RQ - RK_KQ);
#pragma unroll
            for (int ks = 0; ks < 2; ++ks) { o.kq[2 * ks] = *(const LAS v2u*)(kp + 64 * ks); o.kq[2 * ks + 1] = *(const LAS v2u*)(kp + 64 * ks + 32); o.rq[2 * ks] = *(const LAS v2u*)(rp + 64 * ks); o.rq[2 * ks + 1] = *(const LAS v2u*)(rp + 64 * ks + 32); }
#pragma unroll
            for (int i = 0; i < 8; ++i) o.tab[i] = *(const LAS f32x4*)(B + RK_TAB + bk * 128 + 16 * i);
            o.vv = *(const LAS f32x4*)(B + RK_VB + bk * 1024 + row * 16);
#pragma unroll
            for (int kt = 0; kt < 4; ++kt) { o.w4[kt] = *(const LAS f32x4*)(B + RK_W4 + bk * 256 + (16 * kt + 4 * fq) * 4); o.xu[kt] = *(const LAS v4u*)(xb + bk * 1024 + (16 * kt + fr) * 16); } };
        auto step = [&](const Ops& o, f32x4& yout) {
            bf16x8 ys[2];
#pragma unroll
            for (int ks = 0; ks < 2; ++ks) { const v4u w = {pk2(S[2 * ks][0], S[2 * ks][1]), pk2(S[2 * ks][2], S[2 * ks][3]), pk2(S[2 * ks + 1][0], S[2 * ks + 1][1]), pk2(S[2 * ks + 1][2], S[2 * ks + 1][3])}; ys[ks] = __builtin_bit_cast(bf16x8, w); }
            f32x4 du = {0.f, 0.f, 0.f, 0.f}, dy = {0.f, 0.f, 0.f, 0.f};
#pragma unroll
            for (int ks = 0; ks < 2; ++ks) {
                du = __builtin_amdgcn_mfma_f32_16x16x32_bf16(__builtin_bit_cast(bf16x8, (v4u){o.kq[2 * ks].x, o.kq[2 * ks].y, o.kq[2 * ks + 1].x, o.kq[2 * ks + 1].y}), ys[ks], du, 0, 0, 0);
                dy = __builtin_amdgcn_mfma_f32_16x16x32_bf16(__builtin_bit_cast(bf16x8, (v4u){o.rq[2 * ks].x, o.rq[2 * ks].y, o.rq[2 * ks + 1].x, o.rq[2 * ks + 1].y}), ys[ks], dy, 0, 0, 0); }
            const f32x4 t0 = o.tab[0], t1 = o.tab[1], t2 = o.tab[2], t3 = o.tab[3], t4 = o.tab[4], t5 = o.tab[5], t6 = o.tab[6], t7 = o.tab[7]; const f32x4 vv = o.vv;
#define FMA_(a, b, c) ([](float x_, float y_, float z_) { float r_; asm("v_fma_f32 %0, %1, %2, %3" : "=v"(r_) : "v"(x_), "v"(y_), "v"(z_)); return r_; }((a), (b), (c)))
#define FNMA_(a, b, c) ([](float x_, float y_, float z_) { float r_; asm("v_fma_f32 %0, -%1, %2, %3" : "=v"(r_) : "v"(x_), "v"(y_), "v"(z_)); return r_; }((a), (b), (c)))
            const float u0 = du[0] + 0.f * vv.x;
            float a1_ = fmaf(vv.x, t0.x, du[1]);
            float a2_ = FMA_(vv.y, t0.w, fmaf(vv.x, t0.z, du[2]));
            float a3_ = FMA_(vv.z, t2.x, FMA_(vv.y, t1.w, fmaf(vv.x, t1.z, du[3])));
            float b0_ = fmaf(vv.x, t3.x, dy[0]);
            float b1_ = FMA_(vv.y, t3.w, fmaf(vv.x, t3.z, dy[1]));
            float b2_ = FMA_(vv.z, t5.x, FMA_(vv.y, t4.w, fmaf(vv.x, t4.z, dy[2])));
            float b3_ = FMA_(vv.w, t6.w, FMA_(vv.z, t6.z, FMA_(vv.y, t6.y, fmaf(vv.x, t6.x, dy[3]))));
            const float u1 = FNMA_(u0, t0.y, a1_);
            a2_ = FNMA_(u0, t1.x, a2_); a3_ = FNMA_(u0, t2.y, a3_); b0_ = FNMA_(u0, t3.y, b0_); b1_ = FNMA_(u0, t4.x, b1_); b2_ = FNMA_(u0, t5.y, b2_); b3_ = FNMA_(u0, t7.x, b3_);
            const float u2 = FNMA_(u1, t1.y, a2_);
            a3_ = FNMA_(u1, t2.z, a3_); b1_ = FNMA_(u1, t4.y, b1_); b2_ = FNMA_(u1, t5.z, b2_); b3_ = FNMA_(u1, t7.y, b3_);
            const float u3 = FNMA_(u2, t2.w, a3_);
            b2_ = FNMA_(u2, t5.w, b2_); b3_ = FNMA_(u2, t7.z, b3_);
            b3_ = FNMA_(u3, t7.w, b3_);
            yout.x = b0_; yout.y = b1_; yout.z = b2_; yout.w = b3_;
#undef FMA_
#undef FNMA_
            const bf16x8 yop = __builtin_bit_cast(bf16x8, (v4u){pk2(vv.x, vv.y), pk2(vv.z, vv.w), pk2(u0, u1), pk2(u2, u3)});
#pragma unroll
            for (int kt = 0; kt < 4; ++kt) S[kt] = __builtin_amdgcn_mfma_f32_16x16x32_bf16(__builtin_bit_cast(bf16x8, o.xu[kt]), yop, S[kt] * o.w4[kt], 0, 0, 0); };
        __syncthreads();
        __builtin_amdgcn_s_setprio(3);
#ifdef PROBE_RWKV
        float pacc_iter = 0.f, pacc_comp = 0.f;
#endif
        for (int c = 0; c < NCH; ++c) {
            const LAS unsigned char* B = lds + (c % 3) * RK_CBUF; LAS float* yb = (LAS float*)(lds + RK_Y0 + (c & 1) * RK_YSZ) + row * 36;
            const LAS unsigned char* xb = f0 ? B + RK_XU : (const LAS unsigned char*)(lds + RK_ZERO);
            Ops oa, ob; f32x4 yk[8];
#ifdef PROBE_RWKV
            const unsigned long long pt0 = __builtin_amdgcn_s_memtime();
#endif
            load_ops(B, xb, 0, oa);
#pragma unroll
            for (int bp = 0; bp < 4; ++bp) { load_ops(B, xb, 2 * bp + 1, ob); step(oa, yk[2 * bp]); if (bp < 3) load_ops(B, xb, 2 * bp + 2, oa); step(ob, yk[2 * bp + 1]); }
            if (f0) {
#pragma unroll
                for (int bk = 0; bk < 8; ++bk) *(LAS f32x4*)(yb + 4 * bk) = yk[bk]; }
#ifdef PROBE_RWKV
            const unsigned long long pt1 = __builtin_amdgcn_s_memtime();
#endif
            __syncthreads();
#ifdef PROBE_RWKV
            { const unsigned long long pt2 = __builtin_amdgcn_s_memtime();
              if (c >= 8) { pacc_iter += (float)(pt2 - pt0); pacc_comp += (float)(pt1 - pt0); }
              if (c == NCH - 1 && o == 1 && blockIdx.x == 0 && wv == 0 && lane == 0) { float* pw = (float*)(ws + WS_CTL) + 200000;
                  pw[0] = __expf(rintf(__logf(pacc_iter * (1.f / 120.f)) * 20.f) * 0.05f); pw[1] = __expf(rintf(__logf(pacc_comp * (1.f / 120.f)) * 20.f) * 0.05f); } }
#endif
        }
        __builtin_amdgcn_s_setprio(0);
    } else {
        const int pr = (wv - 4) >> 1, w2 = (wv - 4) & 1, ptid = w2 * 64 + lane, g8 = ptid >> 4, kq = ptid & 15;
        const size_t ub = ((size_t)b * SEQ * 2048 + h * 64) * 2;
        const char* Rs = (const char*)(ws + WS_RKV) + ub; const char* Ks = Rs + (size_t)T_ * 2048 * 2; const char* Vs = Ks + (size_t)T_ * 2048 * 2;
        const char* Gs = (const char*)(ws + WS_G) + ub; const char* WDs = (const char*)(ws + WS_WD) + ub; const char* AAs = (const char*)(ws + WS_AA) + ub;
        const unsigned lvo = (unsigned)(4 * kq + 4 * g8 * 2048) * 2u;
        const int pc = h * 64 + 4 * kq;
        const f32x4 p_kk = *(const f32x4*)(a->in[20] + (size_t)o * 2048 + pc), p_ka = *(const f32x4*)(a->in[21] + (size_t)o * 2048 + pc), p_rk = *(const f32x4*)(a->in[22] + (size_t)o * 2048 + pc);
        v2u gk[4], ga[4], gw[4], gr[4], gv[4], gg[4];
        auto gload = [&](int c) {
            const size_t co = (size_t)c * (32 * 2048 * 2);
            typedef const __attribute__((address_space(1))) char* gptr; typedef const __attribute__((address_space(1))) v2u* gv2;
            gptr k_ = (gptr)(Ks + co); gptr a_ = (gptr)(AAs + co); gptr w_ = (gptr)(WDs + co); gptr r_ = (gptr)(Rs + co); gptr v_ = (gptr)(Vs + co); gptr g_ = (gptr)(Gs + co);
            asm volatile("" : "+s"(k_), "+s"(a_), "+s"(w_), "+s"(r_), "+s"(v_), "+s"(g_));
#pragma unroll
            for (int j = 0; j < 4; ++j) { const unsigned off = lvo + (unsigned)j * 4096u;
                gk[j] = *(gv2)(k_ + off); ga[j] = *(gv2)(a_ + off); gw[j] = *(gv2)(w_ + off); gr[j] = *(gv2)(r_ + off); gv[j] = *(gv2)(v_ + off); gg[j] = *(gv2)(g_ + off); } };
        f32x4 kh3, bb3, hh0, hh1, hh2, hh3, bh0, bh1, bh2, bh3, W4;
        auto partA = [&](int c) {
            LAS unsigned char* B = lds + (c % 3) * RK_CBUF; LAS unsigned char* P = lds + RK_PB0 + (c & 3) * RK_PBSZ;
            f32x4 kk[4], bbv[4], kh[4], w[4], r[4], v[4];
#pragma unroll
            for (int j = 0; j < 4; ++j) { const f32x4 k = unpk4(gk[j]), aa = unpk4(ga[j]), wd = unpk4(gw[j]); r[j] = unpk4(gr[j]); v[j] = unpk4(gv[j]);
                const f32x4 kx = k * p_kk; const float inv = __builtin_amdgcn_rsqf(fmaxf(dot16(kx, kx), 1e-24f)); kk[j] = kx * inv; bbv[j] = kk[j] * aa; kh[j] = k * (1.f + (aa - 1.f) * p_ka);
                w[j] = (f32x4){__expf(wd.x), __expf(wd.y), __expf(wd.z), __expf(wd.w)};
                const float bon = dot16(r[j] * kh[j], p_rk);
                *(LAS v2u*)(P + RK_PG + ((4 * g8 + j) * 64 + 4 * kq) * 2) = gg[j];
                if (kq == 0) *(LAS float*)(P + RK_PBON + (4 * g8 + j) * 4) = bon; }
            const f32x4 W1 = w[0], W2 = w[0] * w[1], W3 = W2 * w[2]; W4 = W3 * w[3];
            const f32x4 i1 = {__builtin_amdgcn_rcpf(W1.x), __builtin_amdgcn_rcpf(W1.y), __builtin_amdgcn_rcpf(W1.z), __builtin_amdgcn_rcpf(W1.w)}, i2 = {__builtin_amdgcn_rcpf(W2.x), __builtin_amdgcn_rcpf(W2.y), __builtin_amdgcn_rcpf(W2.z), __builtin_amdgcn_rcpf(W2.w)},
                        i3 = {__builtin_amdgcn_rcpf(W3.x), __builtin_amdgcn_rcpf(W3.y), __builtin_amdgcn_rcpf(W3.z), __builtin_amdgcn_rcpf(W3.w)}, i4 = {__builtin_amdgcn_rcpf(W4.x), __builtin_amdgcn_rcpf(W4.y), __builtin_amdgcn_rcpf(W4.z), __builtin_amdgcn_rcpf(W4.w)};
            hh0 = kh[0] * i1; hh1 = kh[1] * i2; hh2 = kh[2] * i3; hh3 = kh[3] * i4; bh0 = bbv[0] * i1; bh1 = bbv[1] * i2; bh2 = bbv[2] * i3; bh3 = bbv[3] * i4; kh3 = kh[3]; bb3 = bbv[3];
            *(LAS v2u*)(B + RK_KQ + g8 * 512 + 0 * 128 + 8 * kq) = pk4(kk[0]);      *(LAS v2u*)(B + RK_RQ + g8 * 512 + 0 * 128 + 8 * kq) = pk4(r[0] * W1);
            *(LAS v2u*)(B + RK_KQ + g8 * 512 + 1 * 128 + 8 * kq) = pk4(kk[1] * W1); *(LAS v2u*)(B + RK_RQ + g8 * 512 + 1 * 128 + 8 * kq) = pk4(r[1] * W2);
            *(LAS v2u*)(B + RK_KQ + g8 * 512 + 2 * 128 + 8 * kq) = pk4(kk[2] * W2); *(LAS v2u*)(B + RK_RQ + g8 * 512 + 2 * 128 + 8 * kq) = pk4(r[2] * W3);
            *(LAS v2u*)(B + RK_KQ + g8 * 512 + 3 * 128 + 8 * kq) = pk4(kk[3] * W3); *(LAS v2u*)(B + RK_RQ + g8 * 512 + 3 * 128 + 8 * kq) = pk4(r[3] * W4);
            *(LAS f32x4*)(B + RK_W4 + g8 * 256 + 16 * kq) = W4;
#pragma unroll
            for (int j = 0; j < 4; ++j) *(LAS v2u*)(P + RK_PV + ((4 * g8 + j) * 64 + 4 * kq) * 2) = gv[j];
#pragma unroll
            for (int i = 0; i < 4; ++i) *(LAS f32x4*)(B + RK_VB + g8 * 1024 + (4 * kq + i) * 16) = (f32x4){v[0][i], v[1][i], v[2][i], v[3][i]};
        };
        auto partB = [&](int c) {
            LAS unsigned char* B = lds + (c % 3) * RK_CBUF;
            { LAS unsigned char* xs = lds + RK_XS + (wv - 4) * 4096 + (lane >> 4) * 1024 + 8 * kq;
              *(LAS v2u*)(xs + 0 * 128) = pk4(hh0); *(LAS v2u*)(xs + 1 * 128) = pk4(hh1); *(LAS v2u*)(xs + 2 * 128) = pk4(hh2); *(LAS v2u*)(xs + 3 * 128) = pk4(hh3);
              *(LAS v2u*)(xs + 4 * 128) = pk4(bh0); *(LAS v2u*)(xs + 5 * 128) = pk4(bh1); *(LAS v2u*)(xs + 6 * 128) = pk4(bh2); *(LAS v2u*)(xs + 7 * 128) = pk4(bh3); }
            { const f32x4 hw0 = hh0 * W4, hw1 = hh1 * W4, hw2 = hh2 * W4, hw3 = kh3, bw0 = bh0 * W4, bw1 = bh1 * W4, bw2 = bh2 * W4, bw3 = bb3;
#pragma unroll
              for (int i = 0; i < 4; ++i) *(LAS v4u*)(B + RK_XU + g8 * 1024 + (4 * kq + i) * 16) = (v4u){pk2(hw0[i], hw1[i]), pk2(hw2[i], hw3[i]), pk2(-bw0[i], -bw1[i]), pk2(-bw2[i], -bw3[i])};
            }
            asm volatile("s_waitcnt lgkmcnt(0)" ::: "memory");
#pragma unroll
            for (int p = 0; p < 2; ++p) { const int grp = 2 * p + (fr >> 3), rw = fr & 7, blk = 4 * w2 + grp;
                const LAS unsigned char* xp = lds + RK_XS + (wv - 4) * 4096 + grp * 1024 + rw * 128 + 16 * fq;
                const LAS unsigned char* yp = B + ((rw < 4) ? RK_KQ + blk * 512 + rw * 128 : RK_RQ + blk * 512 + (rw - 4) * 128) + 16 * fq;
                f32x4 d = {0.f, 0.f, 0.f, 0.f};
                d = __builtin_amdgcn_mfma_f32_16x16x32_bf16(*(const LAS bf16x8*)xp, *(const LAS bf16x8*)yp, d, 0, 0, 0);
                d = __builtin_amdgcn_mfma_f32_16x16x32_bf16(*(const LAS bf16x8*)(xp + 64), *(const LAS bf16x8*)(yp + 64), d, 0, 0, 0);
                if ((fr >> 3) == (fq >> 1) && rw >= 1) { const int cnt = (rw < 4) ? rw : rw - 3; const int base = (rw == 1) ? 0 : (rw == 2) ? 2 : (rw == 3) ? 6 : (rw == 4) ? 12 : (rw == 5) ? 14 : (rw == 6) ? 18 : 24;
                    LAS float* tp = (LAS float*)(B + RK_TAB + blk * 128) + base + (fq & 1) * cnt;
                    tp[0] = d[0]; if (cnt > 1) tp[1] = d[1]; if (cnt > 2) tp[2] = d[2]; if (cnt > 3) tp[3] = d[3]; } }
            asm volatile("" ::: "memory");
        };
        const int st = ptid >> 2, rq = ptid & 3;
        bf16* Yb = (bf16*)(ws + WS_YO) + (size_t)b * SEQ * 2048 + h * 64 + 16 * rq;
        const float* lg = a->in[23] + (size_t)o * 2048 + h * 64 + 16 * rq; const float* lb = a->in[24] + (size_t)o * 2048 + h * 64 + 16 * rq;
        auto post = [&](int c) {
            const LAS float* yb = (const LAS float*)(lds + RK_Y0 + (c & 1) * RK_YSZ); const LAS unsigned char* P = lds + RK_PB0 + (c & 3) * RK_PBSZ;
            float y[16]; float s1 = 0.f;
#pragma unroll
            for (int i = 0; i < 16; ++i) { y[i] = yb[(16 * rq + i) * 36 + st]; s1 += y[i]; }
            s1 += dppf<0xB1>(s1); s1 += dppf<0x4E>(s1); const float mean = s1 * (1.f / 64.f); float s2 = 0.f;
#pragma unroll
            for (int i = 0; i < 16; ++i) { y[i] -= mean; s2 += y[i] * y[i]; }
            s2 += dppf<0xB1>(s2); s2 += dppf<0x4E>(s2); const float rstd = __builtin_amdgcn_rsqf(s2 * (1.f / 64.f) + 64e-5f);
            const float bon = *(const LAS float*)(P + RK_PBON + st * 4);
            unsigned ow[8];
#pragma unroll
            for (int i4 = 0; i4 < 4; ++i4) { const f32x4 g = unpk4(*(const LAS v2u*)(P + RK_PG + (st * 64 + 16 * rq + 4 * i4) * 2)), vq = unpk4(*(const LAS v2u*)(P + RK_PV + (st * 64 + 16 * rq + 4 * i4) * 2));
                const f32x4 lgv = *(const f32x4*)(lg + 4 * i4), lbv = *(const f32x4*)(lb + 4 * i4); float o4[4];
#pragma unroll
                for (int i = 0; i < 4; ++i) o4[i] = (y[4 * i4 + i] * rstd * lgv[i] + lbv[i] + bon * vq[i]) * g[i];
                ow[2 * i4] = pk2(o4[0], o4[1]); ow[2 * i4 + 1] = pk2(o4[2], o4[3]); }
            v4u* dst = (v4u*)(Yb + (size_t)(32 * c + st) * 2048); dst[0] = (v4u){ow[0], ow[1], ow[2], ow[3]}; dst[1] = (v4u){ow[4], ow[5], ow[6], ow[7]};
        };
        if (!DRY) { gload(pr); partA(pr); gload(pr + 2); partB(pr); }
        __syncthreads();
        for (int c = 0; c < NCH; ++c) {
            if (!DRY) {
            if ((c & 1) == pr) { if (c + 2 < NCH) { partA(c + 2); if (c + 4 < NCH) gload(c + 4); } }
            else { if (c >= 1 && c + 1 < NCH) partB(c + 1); if (c >= 1) post(c - 1); } }
            __syncthreads();
        }
        if (!DRY && pr == 0) post(NCH - 1);
    }
    __syncthreads();
}

template <bool DRY = false> __device__ __forceinline__ void ln_router(const int wv, int l) {
    const ArgsP a = get_args();
#ifdef NO_ROUTER
    return;
#endif
    OPAQUE_TID(); const int lane = tid & 63, wave = tid >> 6;
    unsigned char* ws = a->ws;
    const float* lg = a->in[28] + (size_t)l * 2048; const float* lb = a->in[29] + (size_t)l * 2048;
    const float* bg = a->in[33] + l * 4; const float* be = a->in[35] + l * 32;
    const f32x4* RW = (const f32x4*)(ws + WS_RW) + (size_t)l * 9 * 2048;
    unsigned* cnt = (unsigned*)(ws + WS_CTL) + CW_CNT + (size_t)l * 32 * 64;
    int* TOKE = (int*)(ws + WS_TOKE); int* TOKR = (int*)(ws + WS_TOKR); float* TOKG = (float*)(ws + WS_TOKG);
    const int gw = blockIdx.x * NWAVES + wave, NGW = gridDim.x * NWAVES;
    const unsigned lo = (unsigned)lane * 16u;
    typedef const __attribute__((address_space(1))) char* gcp; typedef const __attribute__((address_space(1))) f32x4* gf4;
    for (int m = gw; m < T_; m += NGW) {
        const v2u* xr = (const v2u*)((const bf16*)(ws + WS_XSUM) + (size_t)m * D_) + lane; f32x4 v[8]; float s = 0.f;
#pragma unroll
        for (int j = 0; j < 8; ++j) { const v2u w_ = xr[64 * j]; v[j] = (f32x4){bflo(w_.x), bfhi(w_.x), bflo(w_.y), bfhi(w_.y)}; s += (v[j].x + v[j].y) + (v[j].z + v[j].w); }
        const float mean = wave_sum(s) * (1.f / D_); float s2 = 0.f;
#pragma unroll
        for (int j = 0; j < 8; ++j) { v[j] = v[j] - mean; s2 += (v[j].x * v[j].x + v[j].y * v[j].y) + (v[j].z * v[j].z + v[j].w * v[j].w); }
        const float rstd = 1.f / sqrtf(wave_sum(s2) * (1.f / D_) + LN_EPS);
        float ag[4] = {0, 0, 0, 0};
#pragma unroll
        for (int j = 0; j < 8; ++j) { const f32x4 g = ((const f32x4*)lg)[lane + 64 * j], bb = ((const f32x4*)lb)[lane + 64 * j]; v[j] = v[j] * rstd * g + bb;
            ((v2u*)XIN(a, l))[(size_t)m * 512 + lane + 64 * j] = (v2u){pk2(v[j].x, v[j].y), pk2(v[j].z, v[j].w)};
            gcp wp = (gcp)((const char*)RW + j * 4096); asm volatile("" : "+s"(wp));
#pragma unroll
            for (int i = 0; i < 4; ++i) { const f32x4 w = *(gf4)(wp + i * 1024 + lo); const float x = v[j][i]; ag[0] += x * w.x; ag[1] += x * w.y; ag[2] += x * w.z; ag[3] += x * w.w; } }
#pragma unroll
        for (int i = 0; i < 4; ++i) ag[i] = wave_sum(ag[i]) + bg[i];
        int gi = 0; float gm = ag[0];
#pragma unroll
        for (int i = 1; i < 4; ++i) if (ag[i] > gm) { gm = ag[i]; gi = i; }
        float gs = 0.f;
#pragma unroll
        for (int i = 0; i < 4; ++i) gs += __expf(ag[i] - gm);
        const float gp = 1.f / gs;
        float ae[8] = {0, 0, 0, 0, 0, 0, 0, 0};
        const int gis = __builtin_amdgcn_readfirstlane(gi);
#pragma unroll
        for (int j = 0; j < 8; ++j) {
            gcp we0 = (gcp)((const char*)RW + (size_t)(1 + 2 * gis) * 32768 + j * 4096); asm volatile("" : "+s"(we0)); gcp we1 = we0 + 32768; asm volatile("" : "+s"(we1));
#pragma unroll
            for (int i = 0; i < 4; ++i) { const f32x4 w0 = *(gf4)(we0 + i * 1024 + lo), w1 = *(gf4)(we1 + i * 1024 + lo); const float x = v[j][i];
                ae[0] += x * w0.x; ae[1] += x * w0.y; ae[2] += x * w0.z; ae[3] += x * w0.w; ae[4] += x * w1.x; ae[5] += x * w1.y; ae[6] += x * w1.z; ae[7] += x * w1.w; } }
#pragma unroll
        for (int i = 0; i < 8; ++i) ae[i] = wave_sum(ae[i]) + be[8 * gi + i];
        int e1 = 0; float m1 = ae[0];
#pragma unroll
        for (int i = 1; i < 8; ++i) if (ae[i] > m1) { m1 = ae[i]; e1 = i; }
        int e2 = -1; float m2 = -3.0e38f;
#pragma unroll
        for (int i = 0; i < 8; ++i) if (i != e1 && ae[i] > m2) { m2 = ae[i]; e2 = i; }
        const float p2 = __expf(m2 - m1), den = 1.f / (1.f + p2);
        if (!DRY && lane == 0) { const int x1 = 8 * gi + e1, x2 = 8 * gi + e2;
            const unsigned r1 = __hip_atomic_fetch_add(cnt + x1 * 64, 1u, __ATOMIC_RELAXED, __HIP_MEMORY_SCOPE_AGENT);
            const unsigned r2 = __hip_atomic_fetch_add(cnt + x2 * 64, 1u, __ATOMIC_RELAXED, __HIP_MEMORY_SCOPE_AGENT);
            { int* LIST = (int*)(ws + WS_LIST); LIST[x1 * 16384 + (int)r1] = m; LIST[x2 * 16384 + (int)r2] = m; }
            TOKE[2 * m] = x1; TOKE[2 * m + 1] = x2; TOKR[2 * m] = (int)r1; TOKR[2 * m + 1] = (int)r2; TOKG[2 * m] = gp * den; TOKG[2 * m + 1] = gp * p2 * den; }
    }
}

struct MoeTab { LAS int* start; LAS int* tileE; LAS int* ntiles; LAS int* cntv; };
__device__ __forceinline__ MoeTab moe_tables(const int wv, int l, LAS unsigned char* lds) {
    const ArgsP a = get_args();
    MoeTab t; t.start = (LAS int*)(lds + MISC_OFF + 256); t.tileE = t.start + 40; t.ntiles = t.tileE + 168; t.cntv = t.ntiles + 8;
    OPAQUE_TID();
    if (wv == 0) { unsigned* cnt = (unsigned*)(a->ws + WS_CTL) + CW_CNT + (size_t)l * 32 * 64; const int e = tid & 31;
        const int c = (int)__hip_atomic_load(cnt + e * 64, __ATOMIC_RELAXED, __HIP_MEMORY_SCOPE_AGENT); const int pad = (c + 255) & ~255;
        int inc = pad;
#pragma unroll
        for (int d = 1; d < 32; d <<= 1) { const int v = __shfl_up(inc, d, 32); if (e >= d) inc += v; }
        if ((tid & 63) < 32) { const int st = inc - pad; t.start[e] = st; t.cntv[e] = c;
            int q1 = inc >> 8; if (q1 > MOE_TILES) q1 = MOE_TILES;
            for (int q = st >> 8; q < q1; ++q) t.tileE[q] = e;
            if (e == 31) *t.ntiles = q1; } }
    __syncthreads();
    return t;
}
__device__ __forceinline__ void moe_gather(const int wv, const MoeTab& tb) {
    const ArgsP a = get_args();
#ifdef NO_GATHER
    return;
#endif
    OPAQUE_TID(); const int lane = tid & 63, wave = tid >> 6;
    unsigned char* ws = a->ws;
    const int* TOKE = (const int*)(ws + WS_TOKE); const int* TOKR = (const int*)(ws + WS_TOKR); int* SLOT = (int*)(ws + WS_SLOT);
    const int gw = blockIdx.x * NWAVES + wave, NGW = gridDim.x * NWAVES;
    for (int it = gw; it < 2 * T_; it += NGW) { const int m = it >> 1; const int dest = tb.start[TOKE[it]] + TOKR[it];
        if (lane == 0) SLOT[it] = dest;
        const v4u* src = (const v4u*)(ws + WS_XB) + (size_t)m * 256 + lane; v4u* dst = (v4u*)(ws + WS_XS) + (size_t)dest * 256 + lane;
#pragma unroll
        for (int j = 0; j < 4; ++j) dst[64 * j] = src[64 * j]; }
}
template <int NJ> struct MoeOrder {
    LAS int* tileE; int nunits, G, c;
    __device__ bool next(int i, pg8::Unit& u) const {
        const int nt = nunits / NJ, x = c & 7, r = c >> 3, nx = G >> 3;
        const int t0 = (x * nt) >> 3, t1 = ((x + 1) * nt) >> 3, q = i * nx + r;
        if (q >= (t1 - t0) * NJ) return false;
        u.pm = t0 + q / NJ; u.pn = tileE[u.pm] * NJ + (q % NJ); u.aoff = 0; return true; }
    __device__ __forceinline__ void a_ready(const pg8::Unit&) const {}
    __device__ __forceinline__ void done(const pg8::Unit&) const {}
};
template <int NJ> struct MoeOrderG {
    LAS int* tileE; LAS int* start; LAS int* cntv; const int* list; int nunits, G, c; int ilo, ihi;
    __device__ bool next(int i_, pg8::Unit& u) const {
        const int i = i_ + ilo; if (i >= ihi) return false;
        const int nt = nunits / NJ, x = c & 7, r = c >> 3, nx = G >> 3;
        const int t0 = (x * nt) >> 3, t1 = ((x + 1) * nt) >> 3, q = i * nx + r;
        if (q >= (t1 - t0) * NJ) return false;
        u.pm = t0 + q / NJ; u.pn = tileE[u.pm] * NJ + (q % NJ); u.aoff = 0; return true; }
    __device__ __forceinline__ void gather_voff(const pg8::Unit& u, int R0, int C0, int R1, int C1, int lda, unsigned (&v)[2][2]) const {
        const int e = tileE[u.pm], roff = u.pm * 256 - start[e], cnt = cntv[e]; const int* le = list + e * 16384;
#pragma unroll
        for (int hh = 0; hh < 2; ++hh) { const int r0 = roff + 128 * hh + R0, r1 = roff + 128 * hh + R1;
            const int t0 = (r0 < cnt) ? le[r0] : 0, t1 = (r1 < cnt) ? le[r1] : 0;
            v[hh][0] = (unsigned)(t0 * lda + C0) * 2u; v[hh][1] = (unsigned)(t1 * lda + C1) * 2u; } }
    __device__ __forceinline__ void a_ready(const pg8::Unit&) const {}
    __device__ __forceinline__ void done(const pg8::Unit&) const {}
};
struct MoeOrderDn {
    LAS int* tileE; int ntiles, G, c, mode, KB;
    __device__ __forceinline__ void split(int& t0, int& ntx, int& busy, int& nB) const {
        const int x = c & 7, nx = G >> 3; t0 = (x * ntiles) >> 3; ntx = (((x + 1) * ntiles) >> 3) - t0;
        busy = ntx * 4 - 2 * nx; busy = busy < 0 ? 0 : (busy > nx ? nx : busy);
        const int cA = ntx < (nx >> 1) ? ntx : (nx >> 1);
        nB = KB * (nx - busy); if (nB > cA * 8) nB = cA * 8; }
    __device__ bool third_round() const { int t0, ntx, busy, nB; split(t0, ntx, busy, nB); return (c >> 3) < busy; }
    __device__ bool next(int i, pg8::Unit& u) const {
        int t0, ntx, busy, nB; split(t0, ntx, busy, nB); const int r = c >> 3, nx = G >> 3; int idx;
        if (mode == 0) { if (r < busy || i >= KB) return false; idx = i * (nx - busy) + (r - busy); if (idx >= nB) return false; }
        else { idx = nB + i * nx + r; if (idx >= ntx * 8) return false; }
        u.pm = t0 + (idx >> 3); u.pn = tileE[u.pm] * 8 + (idx & 7); u.aoff = 0; return true; }
    __device__ __forceinline__ void a_ready(const pg8::Unit&) const {}
    __device__ __forceinline__ void done(const pg8::Unit&) const {}
};
template <bool FUSE_ODD> __device__ __forceinline__ void moe_combine_ln(const int wv, int l) {
    const ArgsP a = get_args();
#ifdef NO_COMBINE
    return;
#endif
    OPAQUE_TID(); const int lane = tid & 63, wave = tid >> 6;
    unsigned char* ws = a->ws;
    const float* lg = a->in[30] + (size_t)l * 2048; const float* lb = a->in[31] + (size_t)l * 2048;
    const int* TOKE = (const int*)(ws + WS_TOKE); const int* TOKR = (const int*)(ws + WS_TOKR); const float* TOKG = (const float*)(ws + WS_TOKG); const bf16* YS = (const bf16*)(ws + WS_YS);
    const int gw = blockIdx.x * NWAVES + wave, NGW = gridDim.x * NWAVES;
    int mystart = 0;
    { unsigned* cnt = (unsigned*)(ws + WS_CTL) + CW_CNT + (size_t)l * 32 * 64; const int e = lane & 31;
      const int c = (int)__hip_atomic_load(cnt + e * 64, __ATOMIC_RELAXED, __HIP_MEMORY_SCOPE_AGENT); const int pad = (c + 255) & ~255;
      int inc = pad;
#pragma unroll
      for (int d = 1; d < 32; d <<= 1) { const int v = __shfl_up(inc, d, 32); if (e >= d) inc += v; }
      mystart = inc - pad; }
    const float* mu = FUSE_ODD ? a->in[7] + (size_t)((l + 1) >> 1) * 6 * 2048 : nullptr;
    bf16* XR = (bf16*)(ws + WS_XRKV); bf16* XK = XR + (size_t)T_ * 2048; bf16* XV = XK + (size_t)T_ * 2048; bf16* XC = (bf16*)(ws + WS_XC);
    const int nrows = FUSE_ODD ? 9 : 1;
    for (int base = FUSE_ODD ? gw * 8 : gw; base < T_; base += FUSE_ODD ? NGW * 8 : NGW) {
        f32x4 prev[8];
#pragma unroll 1
        for (int rr = 0; rr < nrows; ++rr) {
            const int m = FUSE_ODD ? base - 1 + rr : base;
            const bool halo = FUSE_ODD && rr == 0;
            if (halo && (base % SEQ) == 0) {
#pragma unroll
                for (int j = 0; j < 8; ++j) prev[j] = (f32x4){0.f, 0.f, 0.f, 0.f};
                continue; }
            const v2u* xr = (const v2u*)(XIN(a, l) + (size_t)m * D_) + lane; f32x4 v[8]; float s = 0.f;
            const int e0 = TOKE[2 * m], e1 = TOKE[2 * m + 1];
            const int s0 = __shfl(mystart, e0) + TOKR[2 * m], s1 = __shfl(mystart, e1) + TOKR[2 * m + 1]; const float g0 = TOKG[2 * m], g1 = TOKG[2 * m + 1];
            const v2u* y0 = (const v2u*)(YS + (size_t)s0 * 2048) + lane; const v2u* y1 = (const v2u*)(YS + (size_t)s1 * 2048) + lane;
#pragma unroll
            for (int j = 0; j < 8; ++j) { const v2u xw_ = xr[64 * j]; const f32x4 x = {bflo(xw_.x), bfhi(xw_.x), bflo(xw_.y), bfhi(xw_.y)}; const v2u a0 = y0[64 * j], a1 = y1[64 * j];
                v[j].x = DN_ALPHA * x.x + g0 * bflo(a0.x) + g1 * bflo(a1.x); v[j].y = DN_ALPHA * x.y + g0 * bfhi(a0.x) + g1 * bfhi(a1.x);
                v[j].z = DN_ALPHA * x.z + g0 * bflo(a0.y) + g1 * bflo(a1.y); v[j].w = DN_ALPHA * x.w + g0 * bfhi(a0.y) + g1 * bfhi(a1.y);
                s += (v[j].x + v[j].y) + (v[j].z + v[j].w); }
            const float mean = wave_sum(s) * (1.f / D_); float s2 = 0.f;
#pragma unroll
            for (int j = 0; j < 8; ++j) { v[j] = v[j] - mean; s2 += (v[j].x * v[j].x + v[j].y * v[j].y) + (v[j].z * v[j].z + v[j].w * v[j].w); }
            const float rstd = 1.f / sqrtf(wave_sum(s2) * (1.f / D_) + LN_EPS);
#pragma unroll
            for (int j = 0; j < 8; ++j) { const f32x4 g = ((const f32x4*)lg)[lane + 64 * j], bb = ((const f32x4*)lb)[lane + 64 * j]; v[j] = v[j] * rstd * g + bb;
                if (!halo) { if (l == 3) ((f32x4*)(a->out + (size_t)m * D_))[lane + 64 * j] = v[j]; else ((v2u*)XOUT(a, l))[(size_t)m * 512 + lane + 64 * j] = (v2u){pk2(v[j].x, v[j].y), pk2(v[j].z, v[j].w)}; }
                if (FUSE_ODD) {
                    if (!halo) { const f32x4 x = v[j], dx = prev[j] - x;
                        const f32x4 m0 = ((const f32x4*)mu)[lane + 64 * j], m2 = ((const f32x4*)(mu + 2 * 2048))[lane + 64 * j], m3 = ((const f32x4*)(mu + 3 * 2048))[lane + 64 * j];
                        const f32x4 r = x + dx * m0, k = x + dx * m2, vv = x + dx * m3; const size_t off = (size_t)m * 2048 + 4 * (lane + 64 * j);
                        *(v2u*)(XR + off) = (v2u){pk2(r.x, r.y), pk2(r.z, r.w)}; *(v2u*)(XK + off) = (v2u){pk2(k.x, k.y), pk2(k.z, k.w)}; *(v2u*)(XV + off) = (v2u){pk2(vv.x, vv.y), pk2(vv.z, vv.w)};
                        *(v2u*)(XC + off) = (v2u){pk2(dx.x, dx.y), pk2(dx.z, dx.w)}; }
                    prev[j] = v[j]; } }
        }
    }
}

struct RkvOrder {
    pg8::StaticOrder in; int lo, n, G, c;
    __device__ bool next(int i, pg8::Unit& u) const { const long L = (long)lo + (long)i * G + c; if (L >= lo + n) return false; const int g = (int)(L / 512);
        in.at(L % 512, u); u.pm += 64 * g; u.pn += 8 * g; return true; }
    __device__ __forceinline__ void a_ready(const pg8::Unit&) const {}
    __device__ __forceinline__ void done(const pg8::Unit&) const {}
};
struct MergedOrder {
    pg8::StaticOrder in; const char *A0, *B0, *A1a, *A1b, *B1a, *B1b; int G, c;
    __device__ bool next(int i, pg8::Unit& u) const {
        int idx;
        if (G == 256) { if (c < 128) { if (i == 0) idx = -1 - c; else idx = (i - 1) * 128 + c; if (i > 5) return false; } else { idx = 640 + i * 128 + (c - 128); if (i > 6) return false; } }
        else { const int L = i * G + c; if (L >= 1664) return false; idx = (L < 128) ? -1 - L : L - 128; }
        if (idx < 0) { const int q = -1 - idx; u.pm = q & 63; u.pn = q >> 6; u.aoff = 1; return true; }
        const int g = idx / 512; in.at(idx % 512, u); u.pm += 64 * g; u.pn += 8 * g; u.aoff = 0; return true; }
    __device__ __forceinline__ void ptrs(const pg8::Unit& u, const char*& a, const char*& a2, const char*& b, const char*& b2, int& nt) const {
        const size_t ts = (size_t)256 * 2048 * 2;
        if (u.aoff == 0) { a = A0 + (size_t)u.pm * ts; b = B0 + (size_t)u.pn * ts; a2 = a; b2 = b; nt = 32; }
        else { a = A1a + (size_t)u.pm * ts; a2 = A1b + (size_t)u.pm * ts; b = B1a + (size_t)u.pn * ts; b2 = B1b + (size_t)u.pn * ts; nt = 64; } }
    __device__ __forceinline__ void a_ready(const pg8::Unit&) const {}
    __device__ __forceinline__ void done(const pg8::Unit&) const {}
};
struct L2Order {
    int nunits, G, c;
    __device__ bool next(int i, pg8::Unit& u) const { const int L = i * G + c; if (L >= nunits) return false; u.pn = L >> 6; u.pm = L & 63; u.aoff = (u.pn >= 8) ? 512 : 0; return true; }
    __device__ __forceinline__ void a_ready(const pg8::Unit&) const {}
    __device__ __forceinline__ void done(const pg8::Unit&) const {}
};


#ifndef REP_PROL
#define REP_PROL 1
#endif
#ifndef REP_INPROJ
#define REP_INPROJ 1
#endif
#ifndef REP_ATTN
#define REP_ATTN 1
#endif
#ifndef REP_MLSTM
#define REP_MLSTM 1
#endif
#ifndef REP_HNORM
#define REP_HNORM 1
#endif
#ifndef REP_OPREP
#define REP_OPREP 1
#endif
#ifndef REP_RKV
#define REP_RKV 1
#endif
#ifndef REP_RWKV
#define REP_RWKV 1
#endif
#ifndef REP_GATHER
#define REP_GATHER 1
#endif
#ifndef REP_GU
#define REP_GU 1
#endif
#ifndef REP_DN
#define REP_DN 1
#endif
#define REPX_1(...) __VA_ARGS__
#define REPX_2(...) __VA_ARGS__ __VA_ARGS__
#define REPX_3(...) __VA_ARGS__ __VA_ARGS__ __VA_ARGS__
#define REPX_(n, ...) REPX_##n(__VA_ARGS__)
#define REPX(n, ...) REPX_(n, __VA_ARGS__)

struct RangeOrder { pg8::StaticOrder S; int i0, cnt;
    __device__ bool next(int i, pg8::Unit& u) const { if (i >= cnt) return false; return S.next(i + i0, u); }
    __device__ __forceinline__ void a_ready(const pg8::Unit&) const {}
    __device__ __forceinline__ void done(const pg8::Unit&) const {}
};
constexpr int N_PHASES = 41;

__global__ void __launch_bounds__(NTHR, 2) fwd(Args args) {
    extern __shared__ __attribute__((aligned(16))) unsigned char lds_raw[];
    LAS unsigned char* lds = (LAS unsigned char*)lds_raw;
    const int wv = __builtin_amdgcn_readfirstlane((int)threadIdx.x >> 6);
    OPAQUE_TID();
    const ArgsP ap0 = get_args();
    if (tid < 16) ((LAS unsigned*)(lds + MISC_OFF))[tid] = 0u;
    __syncthreads();
#if ONE_LAUNCH
    XcdBarrier bar = xcd_barrier_post((unsigned*)(ap0->ws + WS_CTL) + CW_BAR, (volatile LAS unsigned*)(lds + MISC_OFF), tid == 0);
#define SEAM(k) do { if ((k) + 1 < hi) xcd_barrier(bar, tid == 0); } while (0)
#define SEAMR() xcd_barrier(bar, tid == 0)
#else
#define SEAM(k) do { } while (0)
#define SEAMR() do { } while (0)
#endif
    const int lo = ap0->ph_lo, hi = ap0->ph_hi;
#define IN(k) (lo <= (k) && (k) < hi)
    const int G = gridDim.x, cb = blockIdx.x;

    if (IN(0)) { REPX(REP_PROL, { prologue(wv, lds, 0); SEAMR(); }) }
#ifdef PROBE_BAR
    for (int pb_i = 0; pb_i < 20; ++pb_i) SEAMR();
#endif

    auto layer = [&](auto lc) __attribute__((always_inline)) { constexpr int l = decltype(lc)::value;
        const int pb = 1 + 10 * l, eo = l >> 1;
        if ((l & 1) == 0) {
            if (IN(pb + 0)) {
                const ArgsP ap = get_args(); unsigned char* ws = ap->ws;
                pg8::Gemm g{XIN(ap, l), (const bf16*)(ws + WS_WIN) + (size_t)eo * ZW * 2048, 2048, 2048, 2048};
                pg8::StaticOrder S; S.init(T_, ZW, G, cb);
                pg8::EpiBf16 E{(bf16*)(ws + WS_Z), ZW, 0, 0, 0, nullptr};
                if constexpr (l == 0) {
                    const int n0 = 2 * (cb & 3);
                    RangeOrder S0{S, 0, n0}, S1{S, n0, 1 << 20};
                    if (n0 > 0) { pg8::gemm_phase<pg8::EpiBf16, RangeOrder, true, false>(wv, lds, g, S0, E); __syncthreads(); }
                    prologue(wv, lds, 1); __syncthreads();
                    pg8::gemm_phase<pg8::EpiBf16, RangeOrder, true, false>(wv, lds, g, S1, E); SEAMR();
                } else {
                REPX(REP_INPROJ, { pg8::gemm_phase<pg8::EpiBf16, pg8::StaticOrder, true, false>(wv, lds, g, S, E); SEAMR(); }) }
#if defined(PROBE_NULLEPI)
                { pg8::EpiNull EN; pg8::gemm_phase<pg8::EpiNull, pg8::StaticOrder, true, false>(wv, lds, g, S, EN); SEAMR(); }
#endif
#if defined(PROBE_FULLREP)
                pg8::gemm_phase<pg8::EpiBf16, pg8::StaticOrder, true, false>(wv, lds, g, S, E); SEAMR();
#endif
#if defined(REP_EPAIR)
                for (int u = cb; u < 256; u += G) even_prep(wv, eo, lds, u); SEAMR();
                pg8::gemm_phase<pg8::EpiBf16, pg8::StaticOrder, true, false>(wv, lds, g, S, E); SEAMR();
#endif
            }
            if (IN(pb + 1)) { for (int u = cb; u < 256; u += G) even_prep(wv, eo, lds, u); SEAM(pb + 1); }
            if (IN(pb + 2)) {
                if (cb & 1) { REPX(REP_MLSTM, { mlstm_scan(wv); }) }
                REPX(REP_ATTN, { for (int L = cb; L < 512; L += G) { const int i = L >> 8, c = L & 255; const int qbk = (i & 1) ? (c >> 5) : (15 - (c >> 5)); const int bh = c & 31;
                    attn_unit(wv, lds, bh >> 3, bh & 7, qbk); } })
                if (!(cb & 1)) { REPX(REP_MLSTM, { mlstm_scan(wv); }) }
                SEAM(pb + 2);
            }
            if (IN(pb + 3)) { REPX(REP_HNORM, { for (int u = cb; u < 1024; u += G) mlstm_out_unit(wv, lds, eo, u >> 8, (u >> 6) & 3, u & 63); SEAMR(); }) }
        } else {
            if (IN(pb + 1)) {
                const ArgsP ap = get_args(); unsigned char* ws = ap->ws;
                pg8::Gemm g{nullptr, nullptr, 2048, 2048, 2048};
                MergedOrder S; S.in.init(T_, 2048, 1, 0); S.G = G; S.c = cb;
                S.A0 = (const char*)(ws + WS_XRKV); S.B0 = (const char*)((const bf16*)(ws + WS_WRKV) + (size_t)eo * 3 * 2048 * 2048);
                S.A1a = (const char*)XIN(ap, l); S.A1b = (const char*)(ws + WS_XC);
                S.B1a = (const char*)((const bf16*)(ws + WS_WL1) + (size_t)eo * 2 * 512 * 2048); S.B1b = S.B1a + (size_t)512 * 2048 * 2;
                pg8::EpiBf16 E{(bf16*)(ws + WS_RKV), 2048, 64, 8, (size_t)T_ * 2048, (eo == 0) ? (bf16*)(ws + WS_VF) : nullptr};
                pg8::EpiL1 E1{(bf16*)(ws + WS_L1)};
                REPX(REP_RKV, { pg8::gemm_phase_m<pg8::EpiBf16, pg8::EpiL1, MergedOrder, true, false>(wv, lds, g, S, E, E1); __syncthreads(); })
                SEAM(pb + 1);
            }
            if (IN(pb + 2)) {
                const ArgsP ap = get_args(); unsigned char* ws = ap->ws;
                pg8::Gemm g{(const bf16*)(ws + WS_L1), (const bf16*)(ws + WS_WL2) + (size_t)eo * 8192 * 256, 256, 512, 256};
                L2Order S{(eo == 0 ? 24 : 32) * 64, G, cb};
                pg8::EpiL2 E{(bf16*)(ws + WS_G), (bf16*)(ws + WS_WD), (bf16*)(ws + WS_AA), (bf16*)(ws + WS_RKV) + (size_t)2 * T_ * 2048, (const bf16*)(ws + WS_VF),
                             ap->in[12] + (size_t)eo * 2048, ap->in[15] + (size_t)eo * 2048, ap->in[25]};
                pg8::gemm_phase<pg8::EpiL2, L2Order, true, false>(wv, lds, g, S, E);
#if defined(REP_L2A)
                if (eo == 0) { SEAMR(); pg8::gemm_phase<pg8::EpiL2, L2Order, true, false>(wv, lds, g, S, E); }
#endif
                SEAM(pb + 2);
            }
            if (IN(pb + 3)) { REPX(REP_RWKV, { for (int u = cb; u < 128; u += G) rwkv_unit(wv, lds, eo, u >> 5, u & 31);
#ifdef PROBE_DRY
                for (int u = cb; u < 128; u += G) rwkv_unit<true>(wv, lds, eo, u >> 5, u & 31);
#endif
                if (MOE_PROLOGUE_LAYERS >= 4) { } else if (G > 128 && cb >= 128) moe_convert(wv, lds, (l == 1) ? 32 : 96, (l == 1) ? 96 : 128, cb - 128, G - 128);
                else if (G <= 128) moe_convert(wv, lds, (l == 1) ? 32 : 96, (l == 1) ? 96 : 128, cb, G);
                SEAMR(); }) }
        }
        if (IN(pb + 4)) {
            const bool ev = (l & 1) == 0; const ArgsP ap = get_args(); unsigned char* ws = ap->ws;
            pg8::Gemm g{(const bf16*)(ws + (ev ? WS_YE : WS_YO)), (const bf16*)(ws + (ev ? WS_WOUT : WS_WO)) + (size_t)eo * 2048 * 2048, 2048, 2048, 2048};
            pg8::StaticOrder S; S.init(T_, 2048, G, cb);
            pg8::EpiResid E{XIN(ap, l), (bf16*)(ws + WS_XSUM), 2048, DN_ALPHA};
            pg8::gemm_phase<pg8::EpiResid, pg8::StaticOrder, true, false>(wv, lds, g, S, E);
#if defined(REP_OUT)
            SEAMR(); pg8::gemm_phase<pg8::EpiResid, pg8::StaticOrder, true, false>(wv, lds, g, S, E);
#endif
            SEAM(pb + 4);
        }
        if (IN(pb + 5)) { ln_router(wv, l);
#ifdef PROBE_ROUTER
            SEAMR(); ln_router<true>(wv, l);
#endif
            SEAM(pb + 5); }
        if (IN(pb + 7)) { const MoeTab tb = moe_tables(wv, l, lds); const ArgsP ap = get_args(); unsigned char* ws = ap->ws;
            pg8::Gemm g{XIN(ap, l), (const bf16*)(ws + WS_WGU) + (size_t)l * 32 * 1024 * 2048, 2048, 2048, 2048};
            pg8::EpiSilu E{(bf16*)(ws + WS_HID)};
            { MoeOrderG<4> S{tb.tileE, tb.start, tb.cntv, (const int*)(ws + WS_LIST), *tb.ntiles * 4, G, cb, 0, 2};
              pg8::gemm_phase_g<pg8::EpiSilu, MoeOrderG<4>, true, false>(wv, lds, g, S, E); SEAMR(); }
            { pg8::Gemm gd{(const bf16*)(ws + WS_HID), (const bf16*)(ws + WS_WDN) + (size_t)l * 32 * 2048 * 512, 512, 512, 512};
              MoeOrderDn SD{tb.tileE, *tb.ntiles, G, cb, 0, 4};
              if (SD.third_round()) { MoeOrderG<4> S{tb.tileE, tb.start, tb.cntv, (const int*)(ws + WS_LIST), *tb.ntiles * 4, G, cb, 2, 1 << 20};
                  pg8::gemm_phase_g<pg8::EpiSilu, MoeOrderG<4>, true, false>(wv, lds, g, S, E); }
              else { pg8::EpiBf16 ED{(bf16*)(ws + WS_YS), 2048, 0, 8, 0, nullptr};
                  pg8::gemm_phase<pg8::EpiBf16, MoeOrderDn, true, false>(wv, lds, gd, SD, ED); }
              SEAMR(); }
        }
        if (IN(pb + 8)) { const MoeTab tb = moe_tables(wv, l, lds); const ArgsP ap = get_args(); unsigned char* ws = ap->ws;
            pg8::Gemm g{(const bf16*)(ws + WS_HID), (const bf16*)(ws + WS_WDN) + (size_t)l * 32 * 2048 * 512, 512, 512, 512};
            MoeOrderDn S{tb.tileE, *tb.ntiles, G, cb, 1, 4};
            pg8::EpiBf16 E{(bf16*)(ws + WS_YS), 2048, 0, 8, 0, nullptr};
            pg8::gemm_phase<pg8::EpiBf16, MoeOrderDn, true, false>(wv, lds, g, S, E); SEAMR();
        }
        if (IN(pb + 9)) { moe_combine_ln<(l & 1) == 0>(wv, l);
#if defined(REP_COMB)
            if ((l & 1) == 0) { SEAMR(); moe_combine_ln<(l & 1) == 0>(wv, l); }
#endif
            SEAM(pb + 9); }
#ifdef PROBE_RWKV
        if (l == 3 && IN(pb + 9) && cb == 0) { __syncthreads(); const ArgsP ap = get_args(); if (tid == 0) { asm volatile("s_waitcnt vmcnt(0)" ::: "memory"); const float* pw = (const float*)(ap->ws + WS_CTL) + 200000; ap->out[0] = pw[0]; ap->out[1] = pw[1]; } }
#endif
        };
    layer(std::integral_constant<int, 0>{}); layer(std::integral_constant<int, 1>{}); layer(std::integral_constant<int, 2>{}); layer(std::integral_constant<int, 3>{});
#undef IN
#undef SEAM
}

extern "C" void kernel_launch(void* const* d_in, const int* in_sizes, int n_in, void* d_out, int out_size, void* d_ws, size_t ws_size, hipStream_t stream) {
    static int grid = 0;
    if (grid == 0) {
        if (n_in != 39 || in_sizes[0] != T_ * D_ || out_size != T_ * D_ || ws_size < WS_END) {
            fprintf(stderr, "kernel_launch: unexpected problem: n_in %d in0 %d out %d ws %zu (need %zu)\n", n_in, n_in > 0 ? in_sizes[0] : -1, out_size, ws_size, (size_t)WS_END); grid = -1; return; }
        int dev = 0, cus = 0, per_cu = 0;
        if (hipGetDevice(&dev) != hipSuccess || hipDeviceGetAttribute(&cus, hipDeviceAttributeMultiprocessorCount, dev) != hipSuccess) { fprintf(stderr, "kernel_launch: device query failed\n"); grid = -1; return; }
        if (hipFuncSetAttribute((const void*)fwd, hipFuncAttributeMaxDynamicSharedMemorySize, LDS_BYTES) != hipSuccess) { fprintf(stderr, "kernel_launch: hipFuncSetAttribute failed\n"); grid = -1; return; }
        if (hipOccupancyMaxActiveBlocksPerMultiprocessor(&per_cu, (const void*)fwd, NTHR, LDS_BYTES) != hipSuccess || per_cu < 1)
            fprintf(stderr, "kernel_launch: note: occupancy query reports %d workgroups per CU\n", per_cu);
        (void)hipGetLastError();
        grid = cus;
    }
    if (grid < 0) return;
    if (hipMemsetAsync((char*)d_ws + WS_CTL, 0, CTL_ZERO_BYTES, stream) != hipSuccess) { fprintf(stderr, "kernel_launch: memset failed\n"); return; }
    Args a{};
    for (int i = 0; i < 39; ++i) a.in[i] = (const float*)d_in[i];
    a.out = (float*)d_out; a.ws = (unsigned char*)d_ws;
#if ONE_LAUNCH
    a.ph_lo = 0; a.ph_hi = N_PHASES;
    hipLaunchKernelGGL(fwd, dim3(grid), dim3(NTHR), LDS_BYTES, stream, a);
#else
    for (int p = 0; p < N_PHASES; ++p) { a.ph_lo = p; a.ph_hi = p + 1; hipLaunchKernelGGL(fwd, dim3(grid), dim3(NTHR), LDS_BYTES, stream, a); }
#endif
    const hipError_t le = hipPeekAtLastError();
    if (le != hipSuccess) fprintf(stderr, "kernel_launch: launch failed: %s\n", hipGetErrorName(le));
}
```

```cpp
#include <hip/hip_runtime.h>
#include <cstdio>
#include <cstdint>
#include <type_traits>

#ifndef ONE_LAUNCH
#define ONE_LAUNCH 1
#endif

#define LAS __attribute__((address_space(3)))
typedef unsigned short bf16;
typedef unsigned v4u __attribute__((ext_vector_type(4)));
typedef unsigned v2u __attribute__((ext_vector_type(2)));
typedef float f32x4 __attribute__((ext_vector_type(4)));
typedef float f32x2 __attribute__((ext_vector_type(2)));
typedef short bf16x8 __attribute__((ext_vector_type(8)));

__device__ __forceinline__ unsigned f2bf(float f) { unsigned u = __builtin_bit_cast(unsigned, f); return (u + 0x7fffu + ((u >> 16) & 1u)) >> 16; }
typedef __bf16 bf16x2_t __attribute__((ext_vector_type(2)));
__device__ __forceinline__ unsigned pk2(float lo, float hi) { const f32x2 v = {lo, hi}; return __builtin_bit_cast(unsigned, __builtin_convertvector(v, bf16x2_t)); }
__device__ __forceinline__ float bflo(unsigned w) { return __builtin_bit_cast(float, w << 16); }
__device__ __forceinline__ float bfhi(unsigned w) { return __builtin_bit_cast(float, w & 0xffff0000u); }
__device__ __forceinline__ float bf2f(bf16 h) { return __builtin_bit_cast(float, (unsigned)h << 16); }
__device__ __forceinline__ float sigmoidf_(float x) { return __builtin_amdgcn_rcpf(1.f + __expf(-x)); }
__device__ __forceinline__ float wave_sum(float v) {
#pragma unroll
    for (int o = 1; o < 64; o <<= 1) v += __shfl_xor(v, o);
    return v;
}
template <int CTRL> __device__ __forceinline__ float dppf(float x) { return __builtin_bit_cast(float, __builtin_amdgcn_mov_dpp(__builtin_bit_cast(int, x), CTRL, 0xf, 0xf, true)); }
__device__ __forceinline__ float red16(float x) { x += dppf<0xB1>(x); x += dppf<0x4E>(x); x += dppf<0x141>(x); x += dppf<0x128>(x); return x; }
__device__ __forceinline__ float max16(float x) { x = fmaxf(x, dppf<0xB1>(x)); x = fmaxf(x, dppf<0x4E>(x)); x = fmaxf(x, dppf<0x141>(x)); x = fmaxf(x, dppf<0x128>(x)); return x; }

__device__ __forceinline__ int lane_id_asm() { int l; asm volatile("v_mbcnt_lo_u32_b32 %0, -1, 0\n\tv_mbcnt_hi_u32_b32 %0, -1, %0" : "=v"(l)); return l; }
#define OPAQUE_TID() const int tid = wv * 64 + lane_id_asm()
typedef short v4i16_t __attribute__((ext_vector_type(4)));
__device__ __forceinline__ v2u tr_read(const LAS unsigned char* p) { return __builtin_bit_cast(v2u, __builtin_amdgcn_ds_read_tr16_b64_v4i16((LAS v4i16_t*)p)); }
#define LDS_WAIT() asm volatile("s_waitcnt lgkmcnt(0)" ::: "memory")
#define VM_WAIT() asm volatile("s_waitcnt vmcnt(0)" ::: "memory")

namespace pg8 {
#define PG8_LAS __attribute__((address_space(3)))
typedef unsigned short bf16_t;
typedef short bf16x8 __attribute__((ext_vector_type(8)));
typedef float f32x4 __attribute__((ext_vector_type(4)));
typedef unsigned u32x4 __attribute__((ext_vector_type(4)));
constexpr int BM = 256, BK = 64, HALF = 128, HTB = HALF * BK * 2  , STAGE_BYTES = 8 * HTB, NXCD = 8, WGM = 8;

__host__ __device__ __forceinline__ int lds_byte(int r, int c) { const int st = (r >> 4) * 2 + (c >> 5), rr = r & 15, cc = c & 31, ob = rr * 64 + cc * 2; return st * 1024 + (ob ^ (((ob >> 9) & 1) << 5)); }
__host__ __device__ __forceinline__ void stage_rc(int b, int& R, int& C) { const int st = b / 1024, sb = b % 1024, swz = sb ^ (((sb >> 9) & 1) << 5); R = (st >> 1) * 16 + swz / 64; C = (st & 1) * 32 + (swz % 64) / 2; }
__host__ __device__ __forceinline__ int perm32(int rho) { const int n = rho >> 4, i = rho & 15; return 8 * (i >> 2) + 4 * n + (i & 3); }

struct Unit { int pm, pn, aoff; };
struct Gemm { const bf16_t* A; const bf16_t* Bt; int K, lda, ldb; };

struct StaticOrder {
    int nM, nN, nwg, G, c;
    __device__ void init(int M, int N, int G_, int c_) { nM = M / BM; nN = N / BM; nwg = nM * nN; G = G_; c = c_; }
    __device__ bool next(int i, Unit& u) const { return at((long)i * G + c, u); }
    __device__ bool at(long L, Unit& u) const {
        if (L >= nwg) return false;
        int wgid = (int)L; { const int q = nwg / NXCD, r = nwg % NXCD, xcd = wgid % NXCD, off = wgid / NXCD; wgid = (xcd < r ? xcd * (q + 1) : r * (q + 1) + (xcd - r) * q) + off; }
        const int nig = WGM * nN, gid = wgid / nig, fm = gid * WGM, gsz = (nM - fm) < WGM ? (nM - fm) : WGM;
        u.pm = fm + ((wgid % nig) % gsz); u.pn = (wgid % nig) / gsz; u.aoff = 0; return true;
    }
    __device__ __forceinline__ void a_ready(const Unit&) const {}
    __device__ __forceinline__ void done(const Unit&) const {}
};

__device__ __forceinline__ unsigned cvt_pk_bf16(float lo, float hi) { return ::pk2(lo, hi); }

struct EpiNull {
    static constexpr bool PERM = true, AFTER_DRAIN = false;
    __device__ __forceinline__ void operator()(const f32x4 (&acc)[2][2][4][2], const Unit&, int, int, int, int) const {
#pragma unroll
        for (int a = 0; a < 2; ++a)
#pragma unroll
            for (int b = 0; b < 2; ++b)
#pragma unroll
                for (int m = 0; m < 4; ++m)
#pragma unroll
                    for (int n = 0; n < 2; ++n) asm volatile("" :: "v"(acc[a][b][m][n]));
    }
};
struct EpiBf16 {
    static constexpr bool PERM = true, AFTER_DRAIN = false;
    bf16_t* O; int ldc; int pm_mod, pn_mod; size_t gstride; bf16_t* O2;
    __device__ __forceinline__ void operator()(const f32x4 (&acc)[2][2][4][2], const Unit& u, int wr, int wc, int fr, int fq) const {
        const int g = pm_mod ? u.pm / pm_mod : 0;
        const int row0 = (u.pm - g * pm_mod) * BM + wr * 64 + fr;
        const int col0 = (pn_mod ? (u.pn % pn_mod) : u.pn) * BM + wc * 32 + 8 * fq;
        bf16_t* base = O + (size_t)g * gstride;
        bf16_t* base2 = (O2 && g == 2) ? O2 : nullptr;
#pragma unroll
        for (int ai = 0; ai < 2; ++ai)
#pragma unroll
            for (int m = 0; m < 4; ++m) { const size_t ro = (size_t)(row0 + ai * HALF + m * 16) * ldc + col0;
#pragma unroll
                for (int bj = 0; bj < 2; ++bj) { const f32x4 v0 = acc[ai][bj][m][0], v1 = acc[ai][bj][m][1];
                    u32x4 w; w.x = cvt_pk_bf16(v0[0], v0[1]); w.y = cvt_pk_bf16(v0[2], v0[3]); w.z = cvt_pk_bf16(v1[0], v1[1]); w.w = cvt_pk_bf16(v1[2], v1[3]);
                    *(u32x4*)(base + ro + bj * HALF) = w; if (base2) *(u32x4*)(base2 + ro + bj * HALF) = w; } }
    }
};
struct EpiResid {
    static constexpr bool PERM = true, AFTER_DRAIN = false;
    const bf16_t* X; bf16_t* S; int ldc; float alpha;
    __device__ __forceinline__ void operator()(const f32x4 (&acc)[2][2][4][2], const Unit& u, int wr, int wc, int fr, int fq) const {
        const int row0 = u.pm * BM + wr * 64 + fr, col0 = u.pn * BM + wc * 32 + 8 * fq;
#pragma unroll
        for (int ai = 0; ai < 2; ++ai)
#pragma unroll
            for (int m = 0; m < 4; ++m) { const size_t ro = (size_t)(row0 + ai * HALF + m * 16) * ldc + col0;
#pragma unroll
                for (int bj = 0; bj < 2; ++bj) { const u32x4 xw = *(const u32x4*)(X + ro + bj * HALF);
                    const f32x4 x0 = {__builtin_bit_cast(float, xw.x << 16), __builtin_bit_cast(float, xw.x & 0xffff0000u), __builtin_bit_cast(float, xw.y << 16), __builtin_bit_cast(float, xw.y & 0xffff0000u)};
                    const f32x4 x1 = {__builtin_bit_cast(float, xw.z << 16), __builtin_bit_cast(float, xw.z & 0xffff0000u), __builtin_bit_cast(float, xw.w << 16), __builtin_bit_cast(float, xw.w & 0xffff0000u)};
                    const f32x4 s0 = x0 * alpha + acc[ai][bj][m][0], s1 = x1 * alpha + acc[ai][bj][m][1];
                    u32x4 w; w.x = cvt_pk_bf16(s0[0], s0[1]); w.y = cvt_pk_bf16(s0[2], s0[3]); w.z = cvt_pk_bf16(s1[0], s1[1]); w.w = cvt_pk_bf16(s1[2], s1[3]);
                    *(u32x4*)(S + ro + bj * HALF) = w; } }
    }
};
struct EpiSilu {
    static constexpr bool PERM = true, AFTER_DRAIN = false;
    bf16_t* O;
    __device__ __forceinline__ void operator()(const f32x4 (&acc)[2][2][4][2], const Unit& u, int wr, int wc, int fr, int fq) const {
        const int row0 = u.pm * BM + wr * 64 + fr, col0 = (u.pn & 3) * 128 + wc * 32 + 8 * fq;
#pragma unroll
        for (int ai = 0; ai < 2; ++ai)
#pragma unroll
            for (int m = 0; m < 4; ++m) { bf16_t* rowp = O + (size_t)(row0 + ai * HALF + m * 16) * 512 + col0;
                float h[8];
#pragma unroll
                for (int n = 0; n < 2; ++n)
#pragma unroll
                    for (int e = 0; e < 4; ++e) { const float gt = acc[ai][0][m][n][e], up = acc[ai][1][m][n][e]; h[n * 4 + e] = gt * __builtin_amdgcn_rcpf(1.f + __expf(-gt)) * up; }
                u32x4 w; w.x = cvt_pk_bf16(h[0], h[1]); w.y = cvt_pk_bf16(h[2], h[3]); w.z = cvt_pk_bf16(h[4], h[5]); w.w = cvt_pk_bf16(h[6], h[7]);
                *(u32x4*)rowp = w; }
    }
};
struct EpiL1 {
    static constexpr bool PERM = true, AFTER_DRAIN = false;
    bf16_t* O;
    __device__ __forceinline__ void operator()(const f32x4 (&acc)[2][2][4][2], const Unit& u, int wr, int wc, int fr, int fq) const {
        const int row0 = u.pm * BM + wr * 64 + fr, col0 = u.pn * BM + wc * 32 + 8 * fq;
#pragma unroll
        for (int ai = 0; ai < 2; ++ai)
#pragma unroll
            for (int m = 0; m < 4; ++m) { bf16_t* rowp = O + (size_t)(row0 + ai * HALF + m * 16) * 512 + col0;
#pragma unroll
                for (int bj = 0; bj < 2; ++bj) { const int c = col0 + bj * HALF; float h[8];
#pragma unroll
                    for (int n = 0; n < 2; ++n)
#pragma unroll
                        for (int e = 0; e < 4; ++e) { const float v = acc[ai][bj][m][n][e];
                            h[n * 4 + e] = (c < 256) ? __builtin_amdgcn_rcpf(1.f + __expf(-v)) : ((c < 352) ? (1.f - 2.f * __builtin_amdgcn_rcpf(1.f + __expf(2.f * v))) : v); }
                    u32x4 w; w.x = cvt_pk_bf16(h[0], h[1]); w.y = cvt_pk_bf16(h[2], h[3]); w.z = cvt_pk_bf16(h[4], h[5]); w.w = cvt_pk_bf16(h[6], h[7]);
                    *(u32x4*)(rowp + bj * HALF) = w; } }
    }
};
template <int KIND> __device__ __forceinline__ void epi_l2(const f32x4 (&acc)[2][2][4][2], bf16_t* O, const bf16_t* VF, const float* pv, int row0, int col0) {
    float pr[2][8];
#pragma unroll
    for (int bj = 0; bj < 2; ++bj)
#pragma unroll
        for (int j = 0; j < 8; ++j) pr[bj][j] = (KIND == 0) ? 0.f : pv[col0 + bj * HALF + j];
#pragma unroll
    for (int ai = 0; ai < 2; ++ai)
#pragma unroll
        for (int m = 0; m < 4; ++m) { const size_t ro = (size_t)(row0 + ai * HALF + m * 16) * 2048 + col0;
#pragma unroll
            for (int bj = 0; bj < 2; ++bj) { float h[8];
#pragma unroll
                for (int n = 0; n < 2; ++n)
#pragma unroll
                    for (int e = 0; e < 4; ++e) h[n * 4 + e] = acc[ai][bj][m][n][e] + pr[bj][n * 4 + e];
                if (KIND == 1) {
#pragma unroll
                    for (int j = 0; j < 8; ++j) h[j] = -0.60653065971263342f * __builtin_amdgcn_rcpf(1.f + __expf(-h[j]));
                } else if (KIND == 2) {
#pragma unroll
                    for (int j = 0; j < 8; ++j) h[j] = __builtin_amdgcn_rcpf(1.f + __expf(-h[j]));
                } else if (KIND == 3) {
                    const u32x4 vv = *(const u32x4*)(O + ro + bj * HALF), vf = *(const u32x4*)(VF + ro + bj * HALF);
#pragma unroll
                    for (int j = 0; j < 4; ++j) { const unsigned a = vv[j], b = vf[j];
                        const float v0_ = __builtin_bit_cast(float, a << 16), v1_ = __builtin_bit_cast(float, a & 0xffff0000u);
                        const float f0_ = __builtin_bit_cast(float, b << 16), f1_ = __builtin_bit_cast(float, b & 0xffff0000u);
                        h[2 * j] = v0_ + (f0_ - v0_) * __builtin_amdgcn_rcpf(1.f + __expf(-h[2 * j])); h[2 * j + 1] = v1_ + (f1_ - v1_) * __builtin_amdgcn_rcpf(1.f + __expf(-h[2 * j + 1])); }
                }
                u32x4 w; w.x = cvt_pk_bf16(h[0], h[1]); w.y = cvt_pk_bf16(h[2], h[3]); w.z = cvt_pk_bf16(h[4], h[5]); w.w = cvt_pk_bf16(h[6], h[7]);
                *(u32x4*)(O + ro + bj * HALF) = w; } }
}
struct EpiL2 {
    static constexpr bool PERM = true, AFTER_DRAIN = false;
    bf16_t *G, *WD, *AA, *V; const bf16_t* VF; const float *w0, *a0, *v0;
    __device__ __forceinline__ void operator()(const f32x4 (&acc)[2][2][4][2], const Unit& u, int wr, int wc, int fr, int fq) const {
        const int kind = u.pn >> 3;
        const int row0 = u.pm * BM + wr * 64 + fr, col0 = (u.pn & 7) * BM + wc * 32 + 8 * fq;
        if (kind == 0) epi_l2<0>(acc, G, nullptr, nullptr, row0, col0);
        else if (kind == 1) epi_l2<1>(acc, WD, nullptr, w0, row0, col0);
        else if (kind == 2) epi_l2<2>(acc, AA, nullptr, a0, row0, col0);
        else epi_l2<3>(acc, V, VF, v0, row0, col0);
    }
};

template <class Epi, class Sched, bool ALIGN_EPI = false, bool SP2 = false>
__device__ __forceinline__ void gemm_phase(const int wv, PG8_LAS unsigned char* lds, const Gemm g, const Sched& S, const Epi& E) {
#ifdef NO_GEMM
    return;
#endif
    const int tid_o = wv * 64 + lane_id_asm();
    const int tid = tid_o, wid = __builtin_amdgcn_readfirstlane(tid >> 6), lane = tid & 63, wr = wid >> 2, wc = wid & 3, fr = lane & 15, fq = lane >> 4;
    const int K = g.K, nt = K / BK;
    unsigned voffA[2], voffB[2];
#pragma unroll
    for (int i = 0; i < 2; ++i) { int R, C; stage_rc(tid * 16 + i * 8192, R, C); const int Rb = Epi::PERM ? ((R & ~31) + perm32(R & 31)) : R;
        voffA[i] = (unsigned)(R * g.lda + C) * 2u; voffB[i] = (unsigned)(Rb * g.ldb + C) * 2u; }
    const size_t kstep = (size_t)(BK * 2);
    const size_t hstepA = (size_t)HALF * g.lda * 2, hstepB = (size_t)HALF * g.ldb * 2;
    const size_t tstepA = 2 * hstepA, tstepB = 2 * hstepB;
    const unsigned ldsw = (unsigned)wid * 1024u;
    const int aoff = lds_byte(wr * 64 + fr, fq * 8), boff = lds_byte(wc * 32 + fr, fq * 8);
#define PG8_SA(b, h) (((b) * 2 + (h)) * HTB)
#define PG8_SB(b, h) ((4 + (b) * 2 + (h)) * HTB)
#define PG8_STAGE(bufoff, gbase, voff) do { _Pragma("unroll") for (int _i = 0; _i < 2; ++_i) \
        __builtin_amdgcn_global_load_lds((const unsigned*)((const char*)(gbase) + (voff)[_i]), (PG8_LAS unsigned*)(lds + (bufoff) + ldsw + _i * 8192), 16, 0, 0); } while (0)
#define PG8_LDA(dst, b, h) do { _Pragma("unroll") for (int m = 0; m < 4; ++m) _Pragma("unroll") for (int k = 0; k < 2; ++k) dst[m][k] = *(const PG8_LAS bf16x8*)(lds + PG8_SA(b, h) + aoff + m * 2048 + k * 1024); } while (0)
#define PG8_LDB(dst, b, h) do { _Pragma("unroll") for (int n = 0; n < 2; ++n) _Pragma("unroll") for (int k = 0; k < 2; ++k) dst[n][k] = *(const PG8_LAS bf16x8*)(lds + PG8_SB(b, h) + boff + n * 2048 + k * 1024); } while (0)
#define PG8_MMA(ai, bj, At, Bt) do { __builtin_amdgcn_s_setprio(1); _Pragma("unroll") for (int m = 0; m < 4; ++m) _Pragma("unroll") for (int n = 0; n < 2; ++n) _Pragma("unroll") for (int k = 0; k < 2; ++k) \
        acc[ai][bj][m][n] = __builtin_amdgcn_mfma_f32_16x16x32_bf16(Bt[n][k], At[m][k], acc[ai][bj][m][n], 0, 0, 0); __builtin_amdgcn_s_setprio(0); } while (0)
#define PG8_WAIT_V(n) asm volatile("s_waitcnt vmcnt(" #n ")" ::: "memory")
#define PG8_WAIT_L(n) asm volatile("s_waitcnt lgkmcnt(" #n ")" ::: "memory")
#define PG8_BAR __builtin_amdgcn_s_barrier()
#define PG8_SCHED __builtin_amdgcn_sched_barrier(0)
    Unit cur, nxt; int ui = 0;
    if (!S.next(0, cur)) return;
    f32x4 acc[2][2][4][2];
#pragma unroll
    for (int a = 0; a < 2; ++a)
#pragma unroll
        for (int b = 0; b < 2; ++b)
#pragma unroll
            for (int m = 0; m < 4; ++m)
#pragma unroll
                for (int n = 0; n < 2; ++n) acc[a][b][m][n] = (f32x4){0.f, 0.f, 0.f, 0.f};
    bf16x8 At[4][2], B0[2][2], B1[2][2];
    const char* cA = (const char*)g.A + (size_t)cur.pm * tstepA + cur.aoff; const char* cB = (const char*)g.Bt + (size_t)cur.pn * tstepB;
    S.a_ready(cur);
    if constexpr (SP2) {
        PG8_STAGE(PG8_SB(0, 0), cB, voffB); PG8_STAGE(PG8_SB(0, 1), cB + hstepB, voffB); PG8_STAGE(PG8_SA(0, 0), cA, voffA); PG8_STAGE(PG8_SA(0, 1), cA + hstepA, voffA);
        if (wr == 1) PG8_BAR;
        PG8_WAIT_V(2); PG8_BAR;
        PG8_STAGE(PG8_SB(1, 0), cB + kstep, voffB); PG8_STAGE(PG8_SA(1, 0), cA + kstep, voffA); PG8_STAGE(PG8_SB(1, 1), cB + hstepB + kstep, voffB);
        PG8_WAIT_V(6); PG8_BAR;
    } else {
        PG8_STAGE(PG8_SB(0, 0), cB, voffB); PG8_STAGE(PG8_SA(0, 0), cA, voffA); PG8_STAGE(PG8_SB(0, 1), cB + hstepB, voffB); PG8_STAGE(PG8_SA(0, 1), cA + hstepA, voffA);
        if (wr == 1) PG8_BAR;
        PG8_WAIT_V(4); PG8_BAR;
        PG8_STAGE(PG8_SB(1, 0), cB + kstep, voffB); PG8_STAGE(PG8_SA(1, 0), cA + kstep, voffA); PG8_STAGE(PG8_SB(1, 1), cB + hstepB + kstep, voffB);
        PG8_WAIT_V(6); PG8_BAR;
    }
    for (;;) {
        const bool has_next = S.next(ui + 1, nxt);
        const char* nA = has_next ? (const char*)g.A + (size_t)nxt.pm * tstepA + nxt.aoff : cA; const char* nB = has_next ? (const char*)g.Bt + (size_t)nxt.pn * tstepB : cB;
        for (int t = 0; t < nt; t += 2) {
            const bool last = (t == nt - 2);
            const char* a1 = cA + (size_t)(t + 1) * kstep;
            const char* a2 = last ? nA : cA + (size_t)(t + 2) * kstep; const char* b2 = last ? nB : cB + (size_t)(t + 2) * kstep;
            const char* a3 = a2 + kstep; const char* b3 = b2 + kstep;
            if (last && has_next) S.a_ready(nxt);
            if constexpr (SP2) {
            PG8_LDB(B0, 0, 0); PG8_LDB(B1, 0, 1); PG8_SCHED; PG8_LDA(At, 0, 0); PG8_STAGE(PG8_SA(1, 1), a1 + hstepA, voffA);
            PG8_WAIT_V(8); PG8_WAIT_L(0); PG8_BAR; PG8_MMA(0, 0, At, B0); PG8_MMA(0, 1, At, B1); PG8_BAR; PG8_SCHED;
            PG8_LDA(At, 0, 1); PG8_STAGE(PG8_SB(0, 0), b2, voffB); PG8_STAGE(PG8_SB(0, 1), b2 + hstepB, voffB); PG8_STAGE(PG8_SA(0, 0), a2, voffA);
            PG8_WAIT_V(8); PG8_WAIT_L(0); PG8_BAR; PG8_MMA(1, 0, At, B0); PG8_MMA(1, 1, At, B1); PG8_BAR; PG8_SCHED;
            PG8_LDB(B0, 1, 0); PG8_LDB(B1, 1, 1); PG8_SCHED; PG8_LDA(At, 1, 0); PG8_STAGE(PG8_SA(0, 1), a2 + hstepA, voffA);
            PG8_WAIT_V(8); PG8_WAIT_L(0); PG8_BAR; PG8_MMA(0, 0, At, B0); PG8_MMA(0, 1, At, B1); PG8_BAR; PG8_SCHED;
            PG8_LDA(At, 1, 1); PG8_STAGE(PG8_SB(1, 0), b3, voffB); PG8_STAGE(PG8_SB(1, 1), b3 + hstepB, voffB); PG8_STAGE(PG8_SA(1, 0), a3, voffA);
            PG8_WAIT_V(8); PG8_WAIT_L(0); PG8_BAR; PG8_MMA(1, 0, At, B0); PG8_MMA(1, 1, At, B1); PG8_BAR; PG8_SCHED;
            } else {
            PG8_LDB(B0, 0, 0); PG8_SCHED; PG8_LDA(At, 0, 0); PG8_STAGE(PG8_SA(1, 1), a1 + hstepA, voffA);
            PG8_WAIT_L(8); PG8_BAR; PG8_WAIT_L(0); PG8_MMA(0, 0, At, B0); PG8_BAR; PG8_SCHED;
            PG8_LDB(B1, 0, 1); PG8_STAGE(PG8_SB(0, 0), b2, voffB);
            PG8_BAR; PG8_WAIT_L(0); PG8_MMA(0, 1, At, B1); PG8_BAR;
            PG8_LDA(At, 0, 1); PG8_STAGE(PG8_SA(0, 0), a2, voffA);
            PG8_BAR; PG8_WAIT_L(0); PG8_MMA(1, 0, At, B0); PG8_BAR; PG8_SCHED;
            PG8_STAGE(PG8_SB(0, 1), b2 + hstepB, voffB);
            PG8_WAIT_V(6); PG8_BAR; PG8_MMA(1, 1, At, B1); PG8_BAR;
            PG8_LDB(B0, 1, 0); PG8_SCHED; PG8_LDA(At, 1, 0); PG8_STAGE(PG8_SA(0, 1), a2 + hstepA, voffA);
            PG8_WAIT_L(8); PG8_BAR; PG8_WAIT_L(0); PG8_MMA(0, 0, At, B0); PG8_BAR; PG8_SCHED;
            PG8_LDB(B1, 1, 1); PG8_STAGE(PG8_SB(1, 0), b3, voffB);
            PG8_BAR; PG8_WAIT_L(0); PG8_MMA(0, 1, At, B1); PG8_BAR;
            PG8_LDA(At, 1, 1); PG8_STAGE(PG8_SA(1, 0), a3, voffA);
            PG8_BAR; PG8_WAIT_L(0); PG8_MMA(1, 0, At, B0); PG8_BAR; PG8_SCHED;
            PG8_STAGE(PG8_SB(1, 1), b3 + hstepB, voffB);
            PG8_WAIT_V(6); PG8_BAR; PG8_MMA(1, 1, At, B1); PG8_BAR;
            }
        }
        if constexpr (ALIGN_EPI) { if (wr == 0) PG8_BAR; }
        if constexpr (!Epi::AFTER_DRAIN) { E(acc, cur, wr, wc, fr, fq); S.done(cur); }
        if (!has_next) break;
#pragma unroll
        for (int a = 0; a < 2; ++a)
#pragma unroll
            for (int b = 0; b < 2; ++b)
#pragma unroll
                for (int m = 0; m < 4; ++m)
#pragma unroll
                    for (int n = 0; n < 2; ++n) acc[a][b][m][n] = (f32x4){0.f, 0.f, 0.f, 0.f};
        cur = nxt; cA = nA; cB = nB; ++ui;
        if constexpr (ALIGN_EPI) { if (wr == 1) PG8_BAR; }
    }
    PG8_WAIT_V(0);
    if constexpr (!ALIGN_EPI) { if (wr == 0) PG8_BAR; }
    PG8_BAR;
    if constexpr (Epi::AFTER_DRAIN) { E.fused(acc, cur, wr, wc, fr, fq, lds, wid, lane); S.done(cur); }
#undef PG8_SA
#undef PG8_SB
#undef PG8_STAGE
#undef PG8_LDA
#undef PG8_LDB
#undef PG8_MMA
#undef PG8_WAIT_V
#undef PG8_WAIT_L
#undef PG8_BAR
#undef PG8_SCHED
}
template <class Epi, class Sched, bool ALIGN_EPI = false, bool SP2 = false>
__device__ __forceinline__ void gemm_phase_g(const int wv, PG8_LAS unsigned char* lds, const Gemm g, const Sched& S, const Epi& E) {
#ifdef NO_GEMM
    return;
#endif
    const int tid_o = wv * 64 + lane_id_asm();
    const int tid = tid_o, wid = __builtin_amdgcn_readfirstlane(tid >> 6), lane = tid & 63, wr = wid >> 2, wc = wid & 3, fr = lane & 15, fq = lane >> 4;
    const int K = g.K, nt = K / BK;
    unsigned voffA[2], voffB[2];
#pragma unroll
    for (int i = 0; i < 2; ++i) { int R, C; stage_rc(tid * 16 + i * 8192, R, C); const int Rb = Epi::PERM ? ((R & ~31) + perm32(R & 31)) : R;
        voffA[i] = (unsigned)(R * g.lda + C) * 2u; voffB[i] = (unsigned)(Rb * g.ldb + C) * 2u; }
    const size_t kstep = (size_t)(BK * 2);
    const size_t hstepA = (size_t)HALF * g.lda * 2, hstepB = (size_t)HALF * g.ldb * 2;
    const size_t tstepA = 2 * hstepA, tstepB = 2 * hstepB;
    const unsigned ldsw = (unsigned)wid * 1024u;
    const int aoff = lds_byte(wr * 64 + fr, fq * 8), boff = lds_byte(wc * 32 + fr, fq * 8);
#define PG8_SA(b, h) (((b) * 2 + (h)) * HTB)
#define PG8_SB(b, h) ((4 + (b) * 2 + (h)) * HTB)
#define PG8_STAGE(bufoff, gbase, voff) do { _Pragma("unroll") for (int _i = 0; _i < 2; ++_i) \
        __builtin_amdgcn_global_load_lds((const unsigned*)((const char*)(gbase) + (voff)[_i]), (PG8_LAS unsigned*)(lds + (bufoff) + ldsw + _i * 8192), 16, 0, 0); } while (0)
#define PG8_LDA(dst, b, h) do { _Pragma("unroll") for (int m = 0; m < 4; ++m) _Pragma("unroll") for (int k = 0; k < 2; ++k) dst[m][k] = *(const PG8_LAS bf16x8*)(lds + PG8_SA(b, h) + aoff + m * 2048 + k * 1024); } while (0)
#define PG8_LDB(dst, b, h) do { _Pragma("unroll") for (int n = 0; n < 2; ++n) _Pragma("unroll") for (int k = 0; k < 2; ++k) dst[n][k] = *(const PG8_LAS bf16x8*)(lds + PG8_SB(b, h) + boff + n * 2048 + k * 1024); } while (0)
#define PG8_MMA(ai, bj, At, Bt) do { __builtin_amdgcn_s_setprio(1); _Pragma("unroll") for (int m = 0; m < 4; ++m) _Pragma("unroll") for (int n = 0; n < 2; ++n) _Pragma("unroll") for (int k = 0; k < 2; ++k) \
        acc[ai][bj][m][n] = __builtin_amdgcn_mfma_f32_16x16x32_bf16(Bt[n][k], At[m][k], acc[ai][bj][m][n], 0, 0, 0); __builtin_amdgcn_s_setprio(0); } while (0)
#define PG8_WAIT_V(n) asm volatile("s_waitcnt vmcnt(" #n ")" ::: "memory")
#define PG8_WAIT_L(n) asm volatile("s_waitcnt lgkmcnt(" #n ")" ::: "memory")
#define PG8_BAR __builtin_amdgcn_s_barrier()
#define PG8_SCHED __builtin_amdgcn_sched_barrier(0)
    Unit cur, nxt; int ui = 0;
    if (!S.next(0, cur)) return;
    unsigned vc[2][2], vn[2][2];
    { int R0, C0, R1, C1; stage_rc(tid * 16, R0, C0); stage_rc(tid * 16 + 8192, R1, C1); S.gather_voff(cur, R0, C0, R1, C1, g.lda, vc); }
    f32x4 acc[2][2][4][2];
#pragma unroll
    for (int a = 0; a < 2; ++a)
#pragma unroll
        for (int b = 0; b < 2; ++b)
#pragma unroll
            for (int m = 0; m < 4; ++m)
#pragma unroll
                for (int n = 0; n < 2; ++n) acc[a][b][m][n] = (f32x4){0.f, 0.f, 0.f, 0.f};
    bf16x8 At[4][2], B0[2][2], B1[2][2];
    const char* const cA = (const char*)g.A; const char* cB = (const char*)g.Bt + (size_t)cur.pn * tstepB;
    S.a_ready(cur);
    if constexpr (SP2) {
        PG8_STAGE(PG8_SB(0, 0), cB, voffB); PG8_STAGE(PG8_SB(0, 1), cB + hstepB, voffB); PG8_STAGE(PG8_SA(0, 0), cA, voffA); PG8_STAGE(PG8_SA(0, 1), cA + hstepA, voffA);
        if (wr == 1) PG8_BAR;
        PG8_WAIT_V(2); PG8_BAR;
        PG8_STAGE(PG8_SB(1, 0), cB + kstep, voffB); PG8_STAGE(PG8_SA(1, 0), cA + kstep, voffA); PG8_STAGE(PG8_SB(1, 1), cB + hstepB + kstep, voffB);
        PG8_WAIT_V(6); PG8_BAR;
    } else {
        PG8_STAGE(PG8_SB(0, 0), cB, voffB); PG8_STAGE(PG8_SA(0, 0), cA, vc[0]); PG8_STAGE(PG8_SB(0, 1), cB + hstepB, voffB); PG8_STAGE(PG8_SA(0, 1), cA, vc[1]);
        if (wr == 1) PG8_BAR;
        PG8_WAIT_V(4); PG8_BAR;
        PG8_STAGE(PG8_SB(1, 0), cB + kstep, voffB); PG8_STAGE(PG8_SA(1, 0), cA + kstep, vc[0]); PG8_STAGE(PG8_SB(1, 1), cB + hstepB + kstep, voffB);
        PG8_WAIT_V(6); PG8_BAR;
    }
    for (;;) {
        const bool has_next = S.next(ui + 1, nxt);
        const char* nB = has_next ? (const char*)g.Bt + (size_t)nxt.pn * tstepB : cB;
        if (has_next) { int R0, C0, R1, C1; stage_rc(tid * 16, R0, C0); stage_rc(tid * 16 + 8192, R1, C1); S.gather_voff(nxt, R0, C0, R1, C1, g.lda, vn); }
        else { vn[0][0] = vc[0][0]; vn[0][1] = vc[0][1]; vn[1][0] = vc[1][0]; vn[1][1] = vc[1][1]; }
        for (int t = 0; t < nt; t += 2) {
            const bool last = (t == nt - 2);
            const char* a1 = cA + (size_t)(t + 1) * kstep;
            const char* a2 = last ? cA : cA + (size_t)(t + 2) * kstep; const char* b2 = last ? nB : cB + (size_t)(t + 2) * kstep;
            unsigned vs[2][2]; vs[0][0] = last ? vn[0][0] : vc[0][0]; vs[0][1] = last ? vn[0][1] : vc[0][1]; vs[1][0] = last ? vn[1][0] : vc[1][0]; vs[1][1] = last ? vn[1][1] : vc[1][1];
            const char* a3 = a2 + kstep; const char* b3 = b2 + kstep;
            if (last && has_next) S.a_ready(nxt);
            if constexpr (SP2) {
            PG8_LDB(B0, 0, 0); PG8_LDB(B1, 0, 1); PG8_SCHED; PG8_LDA(At, 0, 0); PG8_STAGE(PG8_SA(1, 1), a1 + hstepA, voffA);
            PG8_WAIT_V(8); PG8_WAIT_L(0); PG8_BAR; PG8_MMA(0, 0, At, B0); PG8_MMA(0, 1, At, B1); PG8_BAR; PG8_SCHED;
            PG8_LDA(At, 0, 1); PG8_STAGE(PG8_SB(0, 0), b2, voffB); PG8_STAGE(PG8_SB(0, 1), b2 + hstepB, voffB); PG8_STAGE(PG8_SA(0, 0), a2, voffA);
            PG8_WAIT_V(8); PG8_WAIT_L(0); PG8_BAR; PG8_MMA(1, 0, At, B0); PG8_MMA(1, 1, At, B1); PG8_BAR; PG8_SCHED;
            PG8_LDB(B0, 1, 0); PG8_LDB(B1, 1, 1); PG8_SCHED; PG8_LDA(At, 1, 0); PG8_STAGE(PG8_SA(0, 1), a2 + hstepA, voffA);
            PG8_WAIT_V(8); PG8_WAIT_L(0); PG8_BAR; PG8_MMA(0, 0, At, B0); PG8_MMA(0, 1, At, B1); PG8_BAR; PG8_SCHED;
            PG8_LDA(At, 1, 1); PG8_STAGE(PG8_SB(1, 0), b3, voffB); PG8_STAGE(PG8_SB(1, 1), b3 + hstepB, voffB); PG8_STAGE(PG8_SA(1, 0), a3, voffA);
            PG8_WAIT_V(8); PG8_WAIT_L(0); PG8_BAR; PG8_MMA(1, 0, At, B0); PG8_MMA(1, 1, At, B1); PG8_BAR; PG8_SCHED;
            } else {
            PG8_LDB(B0, 0, 0); PG8_SCHED; PG8_LDA(At, 0, 0); PG8_STAGE(PG8_SA(1, 1), a1, vc[1]);
            PG8_WAIT_L(8); PG8_BAR; PG8_WAIT_L(0); PG8_MMA(0, 0, At, B0); PG8_BAR; PG8_SCHED;
            PG8_LDB(B1, 0, 1); PG8_STAGE(PG8_SB(0, 0), b2, voffB);
            PG8_BAR; PG8_WAIT_L(0); PG8_MMA(0, 1, At, B1); PG8_BAR;
            PG8_LDA(At, 0, 1); PG8_STAGE(PG8_SA(0, 0), a2, vs[0]);
            PG8_BAR; PG8_WAIT_L(0); PG8_MMA(1, 0, At, B0); PG8_BAR; PG8_SCHED;
            PG8_STAGE(PG8_SB(0, 1), b2 + hstepB, voffB);
            PG8_WAIT_V(6); PG8_BAR; PG8_MMA(1, 1, At, B1); PG8_BAR;
            PG8_LDB(B0, 1, 0); PG8_SCHED; PG8_LDA(At, 1, 0); PG8_STAGE(PG8_SA(0, 1), a2, vs[1]);
            PG8_WAIT_L(8); PG8_BAR; PG8_WAIT_L(0); PG8_MMA(0, 0, At, B0); PG8_BAR; PG8_SCHED;
            PG8_LDB(B1, 1, 1); PG8_STAGE(PG8_SB(1, 0), b3, voffB);
            PG8_BAR; PG8_WAIT_L(0); PG8_MMA(0, 1, At, B1); PG8_BAR;
            PG8_LDA(At, 1, 1); PG8_STAGE(PG8_SA(1, 0), a3, vs[0]);
            PG8_BAR; PG8_WAIT_L(0); PG8_MMA(1, 0, At, B0); PG8_BAR; PG8_SCHED;
            PG8_STAGE(PG8_SB(1, 1), b3 + hstepB, voffB);
            PG8_WAIT_V(6); PG8_BAR; PG8_MMA(1, 1, At, B1); PG8_BAR;
            }
        }
        if constexpr (ALIGN_EPI) { if (wr == 0) PG8_BAR; }
        if constexpr (!Epi::AFTER_DRAIN) { E(acc, cur, wr, wc, fr, fq); S.done(cur); }
        if (!has_next) break;
#pragma unroll
        for (int a = 0; a < 2; ++a)
#pragma unroll
            for (int b = 0; b < 2; ++b)
#pragma unroll
                for (int m = 0; m < 4; ++m)
#pragma unroll
                    for (int n = 0; n < 2; ++n) acc[a][b][m][n] = (f32x4){0.f, 0.f, 0.f, 0.f};
        cur = nxt; cB = nB; ++ui; vc[0][0] = vn[0][0]; vc[0][1] = vn[0][1]; vc[1][0] = vn[1][0]; vc[1][1] = vn[1][1];
        if constexpr (ALIGN_EPI) { if (wr == 1) PG8_BAR; }
    }
    PG8_WAIT_V(0);
    if constexpr (!ALIGN_EPI) { if (wr == 0) PG8_BAR; }
    PG8_BAR;
    if constexpr (Epi::AFTER_DRAIN) { E.fused(acc, cur, wr, wc, fr, fq, lds, wid, lane); S.done(cur); }
#undef PG8_SA
#undef PG8_SB
#undef PG8_STAGE
#undef PG8_LDA
#undef PG8_LDB
#undef PG8_MMA
#undef PG8_WAIT_V
#undef PG8_WAIT_L
#undef PG8_BAR
#undef PG8_SCHED
}

template <class Epi, class Epi1, class Sched, bool ALIGN_EPI = false, bool SP2 = false>
__device__ __forceinline__ void gemm_phase_m(const int wv, PG8_LAS unsigned char* lds, const Gemm g, const Sched& S, const Epi& E, const Epi1& E1) {
#ifdef NO_GEMM
    return;
#endif
    const int tid_o = wv * 64 + lane_id_asm();
    const int tid = tid_o, wid = __builtin_amdgcn_readfirstlane(tid >> 6), lane = tid & 63, wr = wid >> 2, wc = wid & 3, fr = lane & 15, fq = lane >> 4;
    int nt;
    unsigned voffA[2], voffB[2];
#pragma unroll
    for (int i = 0; i < 2; ++i) { int R, C; stage_rc(tid * 16 + i * 8192, R, C); const int Rb = Epi::PERM ? ((R & ~31) + perm32(R & 31)) : R;
        voffA[i] = (unsigned)(R * g.lda + C) * 2u; voffB[i] = (unsigned)(Rb * g.ldb + C) * 2u; }
    const size_t kstep = (size_t)(BK * 2);
    const size_t hstepA = (size_t)HALF * g.lda * 2, hstepB = (size_t)HALF * g.ldb * 2;
    const size_t tstepA = 2 * hstepA, tstepB = 2 * hstepB;
    const unsigned ldsw = (unsigned)wid * 1024u;
    const int aoff = lds_byte(wr * 64 + fr, fq * 8), boff = lds_byte(wc * 32 + fr, fq * 8);
#define PG8_SA(b, h) (((b) * 2 + (h)) * HTB)
#define PG8_SB(b, h) ((4 + (b) * 2 + (h)) * HTB)
#define PG8_STAGE(bufoff, gbase, voff) do { _Pragma("unroll") for (int _i = 0; _i < 2; ++_i) \
        __builtin_amdgcn_global_load_lds((const unsigned*)((const char*)(gbase) + (voff)[_i]), (PG8_LAS unsigned*)(lds + (bufoff) + ldsw + _i * 8192), 16, 0, 0); } while (0)
#define PG8_LDA(dst, b, h) do { _Pragma("unroll") for (int m = 0; m < 4; ++m) _Pragma("unroll") for (int k = 0; k < 2; ++k) dst[m][k] = *(const PG8_LAS bf16x8*)(lds + PG8_SA(b, h) + aoff + m * 2048 + k * 1024); } while (0)
#define PG8_LDB(dst, b, h) do { _Pragma("unroll") for (int n = 0; n < 2; ++n) _Pragma("unroll") for (int k = 0; k < 2; ++k) dst[n][k] = *(const PG8_LAS bf16x8*)(lds + PG8_SB(b, h) + boff + n * 2048 + k * 1024); } while (0)
#define PG8_MMA(ai, bj, At, Bt) do { __builtin_amdgcn_s_setprio(1); _Pragma("unroll") for (int m = 0; m < 4; ++m) _Pragma("unroll") for (int n = 0; n < 2; ++n) _Pragma("unroll") for (int k = 0; k < 2; ++k) \
        acc[ai][bj][m][n] = __builtin_amdgcn_mfma_f32_16x16x32_bf16(Bt[n][k], At[m][k], acc[ai][bj][m][n], 0, 0, 0); __builtin_amdgcn_s_setprio(0); } while (0)
#define PG8_WAIT_V(n) asm volatile("s_waitcnt vmcnt(" #n ")" ::: "memory")
#define PG8_WAIT_L(n) asm volatile("s_waitcnt lgkmcnt(" #n ")" ::: "memory")
#define PG8_BAR __builtin_amdgcn_s_barrier()
#define PG8_SCHED __builtin_amdgcn_sched_barrier(0)
    Unit cur, nxt; int ui = 0;
    if (!S.next(0, cur)) return;
    f32x4 acc[2][2][4][2];
#pragma unroll
    for (int a = 0; a < 2; ++a)
#pragma unroll
        for (int b = 0; b < 2; ++b)
#pragma unroll
            for (int m = 0; m < 4; ++m)
#pragma unroll
                for (int n = 0; n < 2; ++n) acc[a][b][m][n] = (f32x4){0.f, 0.f, 0.f, 0.f};
    bf16x8 At[4][2], B0[2][2], B1[2][2];
    const char *cA, *cA2, *cB, *cB2; S.ptrs(cur, cA, cA2, cB, cB2, nt);
    S.a_ready(cur);
    if constexpr (SP2) {
        PG8_STAGE(PG8_SB(0, 0), cB, voffB); PG8_STAGE(PG8_SB(0, 1), cB + hstepB, voffB); PG8_STAGE(PG8_SA(0, 0), cA, voffA); PG8_STAGE(PG8_SA(0, 1), cA + hstepA, voffA);
        if (wr == 1) PG8_BAR;
        PG8_WAIT_V(2); PG8_BAR;
        PG8_STAGE(PG8_SB(1, 0), cB + kstep, voffB); PG8_STAGE(PG8_SA(1, 0), cA + kstep, voffA); PG8_STAGE(PG8_SB(1, 1), cB + hstepB + kstep, voffB);
        PG8_WAIT_V(6); PG8_BAR;
    } else {
        PG8_STAGE(PG8_SB(0, 0), cB, voffB); PG8_STAGE(PG8_SA(0, 0), cA, voffA); PG8_STAGE(PG8_SB(0, 1), cB + hstepB, voffB); PG8_STAGE(PG8_SA(0, 1), cA + hstepA, voffA);
        if (wr == 1) PG8_BAR;
        PG8_WAIT_V(4); PG8_BAR;
        PG8_STAGE(PG8_SB(1, 0), cB + kstep, voffB); PG8_STAGE(PG8_SA(1, 0), cA + kstep, voffA); PG8_STAGE(PG8_SB(1, 1), cB + hstepB + kstep, voffB);
        PG8_WAIT_V(6); PG8_BAR;
    }
    for (;;) {
        const bool has_next = S.next(ui + 1, nxt);
        const char *nA = cA, *nA2 = cA2, *nB = cB, *nB2 = cB2; int nnt = nt; if (has_next) S.ptrs(nxt, nA, nA2, nB, nB2, nnt);
        for (int t = 0; t < nt; t += 2) {
            const bool last = (t == nt - 2);
            const char* a1 = (t + 1 < 32) ? cA + (size_t)(t + 1) * kstep : cA2 + (size_t)(t + 1 - 32) * kstep;
            const char* a2 = last ? nA : ((t + 2 < 32) ? cA + (size_t)(t + 2) * kstep : cA2 + (size_t)(t + 2 - 32) * kstep);
            const char* b2 = last ? nB : ((t + 2 < 32) ? cB + (size_t)(t + 2) * kstep : cB2 + (size_t)(t + 2 - 32) * kstep);
            const char* a3 = a2 + kstep; const char* b3 = b2 + kstep;
            if (last && has_next) S.a_ready(nxt);
            if constexpr (SP2) {
            PG8_LDB(B0, 0, 0); PG8_LDB(B1, 0, 1); PG8_SCHED; PG8_LDA(At, 0, 0); PG8_STAGE(PG8_SA(1, 1), a1 + hstepA, voffA);
            PG8_WAIT_V(8); PG8_WAIT_L(0); PG8_BAR; PG8_MMA(0, 0, At, B0); PG8_MMA(0, 1, At, B1); PG8_BAR; PG8_SCHED;
            PG8_LDA(At, 0, 1); PG8_STAGE(PG8_SB(0, 0), b2, voffB); PG8_STAGE(PG8_SB(0, 1), b2 + hstepB, voffB); PG8_STAGE(PG8_SA(0, 0), a2, voffA);
            PG8_WAIT_V(8); PG8_WAIT_L(0); PG8_BAR; PG8_MMA(1, 0, At, B0); PG8_MMA(1, 1, At, B1); PG8_BAR; PG8_SCHED;
            PG8_LDB(B0, 1, 0); PG8_LDB(B1, 1, 1); PG8_SCHED; PG8_LDA(At, 1, 0); PG8_STAGE(PG8_SA(0, 1), a2 + hstepA, voffA);
            PG8_WAIT_V(8); PG8_WAIT_L(0); PG8_BAR; PG8_MMA(0, 0, At, B0); PG8_MMA(0, 1, At, B1); PG8_BAR; PG8_SCHED;
            PG8_LDA(At, 1, 1); PG8_STAGE(PG8_SB(1, 0), b3, voffB); PG8_STAGE(PG8_SB(1, 1), b3 + hstepB, voffB); PG8_STAGE(PG8_SA(1, 0), a3, voffA);
            PG8_WAIT_V(8); PG8_WAIT_L(0); PG8_BAR; PG8_MMA(1, 0, At, B0); PG8_MMA(1, 1, At, B1); PG8_BAR; PG8_SCHED;
            } else {
            PG8_LDB(B0, 0, 0); PG8_SCHED; PG8_LDA(At, 0, 0); PG8_STAGE(PG8_SA(1, 1), a1 + hstepA, voffA);
            PG8_WAIT_L(8); PG8_BAR; PG8_WAIT_L(0); PG8_MMA(0, 0, At, B0); PG8_BAR; PG8_SCHED;
            PG8_LDB(B1, 0, 1); PG8_STAGE(PG8_SB(0, 0), b2, voffB);
            PG8_BAR; PG8_WAIT_L(0); PG8_MMA(0, 1, At, B1); PG8_BAR;
            PG8_LDA(At, 0, 1); PG8_STAGE(PG8_SA(0, 0), a2, voffA);
            PG8_BAR; PG8_WAIT_L(0); PG8_MMA(1, 0, At, B0); PG8_BAR; PG8_SCHED;
            PG8_STAGE(PG8_SB(0, 1), b2 + hstepB, voffB);
            PG8_WAIT_V(6); PG8_BAR; PG8_MMA(1, 1, At, B1); PG8_BAR;
            PG8_LDB(B0, 1, 0); PG8_SCHED; PG8_LDA(At, 1, 0); PG8_STAGE(PG8_SA(0, 1), a2 + hstepA, voffA);
            PG8_WAIT_L(8); PG8_BAR; PG8_WAIT_L(0); PG8_MMA(0, 0, At, B0); PG8_BAR; PG8_SCHED;
            PG8_LDB(B1, 1, 1); PG8_STAGE(PG8_SB(1, 0), b3, voffB);
            PG8_BAR; PG8_WAIT_L(0); PG8_MMA(0, 1, At, B1); PG8_BAR;
            PG8_LDA(At, 1, 1); PG8_STAGE(PG8_SA(1, 0), a3, voffA);
            PG8_BAR; PG8_WAIT_L(0); PG8_MMA(1, 0, At, B0); PG8_BAR; PG8_SCHED;
            PG8_STAGE(PG8_SB(1, 1), b3 + hstepB, voffB);
            PG8_WAIT_V(6); PG8_BAR; PG8_MMA(1, 1, At, B1); PG8_BAR;
            }
        }
        if constexpr (ALIGN_EPI) { if (wr == 0) PG8_BAR; }
        if (cur.aoff == 0) E(acc, cur, wr, wc, fr, fq); else E1(acc, cur, wr, wc, fr, fq);
        if (!has_next) break;
#pragma unroll
        for (int a = 0; a < 2; ++a)
#pragma unroll
            for (int b = 0; b < 2; ++b)
#pragma unroll
                for (int m = 0; m < 4; ++m)
#pragma unroll
                    for (int n = 0; n < 2; ++n) acc[a][b][m][n] = (f32x4){0.f, 0.f, 0.f, 0.f};
        cur = nxt; cA = nA; cA2 = nA2; cB = nB; cB2 = nB2; nt = nnt; ++ui;
        if constexpr (ALIGN_EPI) { if (wr == 1) PG8_BAR; }
    }
    PG8_WAIT_V(0);
    if constexpr (!ALIGN_EPI) { if (wr == 0) PG8_BAR; }
    PG8_BAR;
#undef PG8_SA
#undef PG8_SB
#undef PG8_STAGE
#undef PG8_LDA
#undef PG8_LDB
#undef PG8_MMA
#undef PG8_WAIT_V
#undef PG8_WAIT_L
#undef PG8_BAR
#undef PG8_SCHED
}


}

#define XB_TMO      128
#define XB_XCNT(j)  (256  + 64 * (j))
#define XB_XSUB(j)  (1280 + 64 * (j))
#define XB_XGEN(j)  (2304 + 64 * (j))
#define XB_TOP      3328
#define XB_TOPGEN   3392
#define XCD_BAR_WORDS 3456
#define XB_SPIN_CAP (1u << 18)

__device__ __forceinline__ unsigned xb_ld(unsigned* p)              { return __hip_atomic_load(p, __ATOMIC_RELAXED, __HIP_MEMORY_SCOPE_AGENT); }
__device__ __forceinline__ unsigned xb_add(unsigned* p, unsigned v) { return __hip_atomic_fetch_add(p, v, __ATOMIC_RELAXED, __HIP_MEMORY_SCOPE_AGENT); }
__device__ __forceinline__ unsigned xb_xcc_id() { return (unsigned)__builtin_amdgcn_s_getreg((3 << 11) | 20) & 0xFu; }
#define XB_SPIN(cond, bar) do { unsigned _sp = 0; while (cond) { __builtin_amdgcn_s_sleep(1); \
    if ((++_sp & 255u) == 0u) { if (xb_ld(&(bar)[XB_TMO])) break; if (_sp > XB_SPIN_CAP) { atomicAdd(&(bar)[XB_TMO], 1u); break; } } } } while (0)

struct XcdBarrier {
    unsigned* bar; unsigned x;
    volatile LAS unsigned* st;
};

__device__ __forceinline__ XcdBarrier xcd_barrier_post(unsigned* bar, volatile LAS unsigned* st, const bool t0) {
    XcdBarrier b; b.bar = bar; b.x = xb_xcc_id(); b.st = st;
    if (t0) (void)xb_add(&bar[XB_XCNT(b.x)], 1u);
    return b;
}
__device__ __forceinline__ void xcd_barrier_complete(unsigned* bar, unsigned x, unsigned& nloc, unsigned& nx) {
    const unsigned G = gridDim.x * gridDim.y * gridDim.z;
    unsigned sum, cnt, mine, sp = 0u;
    for (;;) {
        sum = 0u; cnt = 0u; mine = 0u;
#pragma unroll
        for (unsigned j = 0; j < 16; ++j) { const unsigned c = xb_ld(&bar[XB_XCNT(j)]); sum += c; cnt += (c > 0u) ? 1u : 0u; mine = (j == x) ? c : mine; }
        if (sum == G) break;
        __builtin_amdgcn_s_sleep(1);
        if ((++sp & 255u) == 0u) { if (xb_ld(&bar[XB_TMO])) break; if (sp > XB_SPIN_CAP) { atomicAdd(&bar[XB_TMO], 1u); break; } }
    }
    nloc = mine > 0u ? mine : 1u; nx = cnt > 0u ? cnt : 1u;
}

__device__ __forceinline__ void xcd_barrier(const XcdBarrier& b, const bool t0) {
    asm volatile("s_waitcnt vmcnt(0)" ::: "memory");
    __syncthreads();
    if (t0) {
        unsigned* bar = b.bar;
        __builtin_amdgcn_s_waitcnt(0);
        unsigned nloc = b.st[0], nx = b.st[1];
        if (nloc == 0u) { xcd_barrier_complete(bar, b.x, nloc, nx); b.st[0] = nloc; b.st[1] = nx; }
        const unsigned old = xb_add(&bar[XB_XSUB(b.x)], 1u);
        const unsigned gen = old / nloc;
        if (old + 1u == (gen + 1u) * nloc) {
            __builtin_amdgcn_fence(__ATOMIC_RELEASE, "agent");
            asm volatile("s_waitcnt vmcnt(0)" ::: "memory");
            const unsigned og = xb_add(&bar[XB_TOP], 1u);
            const unsigned tg = og / nx;
            if (og + 1u == (tg + 1u) * nx) xb_add(&bar[XB_TOPGEN], 1u);
            else XB_SPIN(xb_ld(&bar[XB_TOPGEN]) == tg, bar);
            __builtin_amdgcn_fence(__ATOMIC_ACQUIRE, "agent");
            xb_add(&bar[XB_XGEN(b.x)], 1u);
            asm volatile("s_waitcnt vmcnt(0)" ::: "memory");
        } else {
            XB_SPIN(xb_ld(&bar[XB_XGEN(b.x)]) == gen, bar);
            __builtin_amdgcn_fence(__ATOMIC_ACQUIRE, "agent");
            asm volatile("s_waitcnt vmcnt(0)" ::: "memory");
        }
    }
    __syncthreads();
}

constexpr int NWAVES = 8, NTHR = 512;
constexpr int NB = 4, SEQ = 4096, T_ = NB * SEQ, D_ = 2048;
constexpr int EVEN_IN = 7176, ZW = 7168;
constexpr float DN_ALPHA = 1.6817928305074290f;
constexpr float LN_EPS = 1e-5f;
constexpr int MOE_ROWS = 40960, MOE_TILES = MOE_ROWS / 256;

constexpr size_t MiB = 1u << 20;
constexpr size_t WS_CTL = 0, CTL_ZERO_BYTES = 1 * MiB;
constexpr size_t WS_IG = 1 * MiB, WS_FG = WS_IG + 256 * 1024, WS_KPART = 2 * MiB;
constexpr size_t WS_TOKE = 3 * MiB, WS_TOKR = WS_TOKE + 128 * 1024, WS_TOKG = WS_TOKR + 128 * 1024, WS_SLOT = WS_TOKG + 128 * 1024;
constexpr size_t WS_DN = 4 * MiB, WS_NP = 5 * MiB, WS_DEC = 6 * MiB, WS_BC = 6 * MiB + 65536;
constexpr size_t WS_LIST = 8 * MiB;
constexpr size_t WS_RW = 12 * MiB;
constexpr size_t WS_WIN = 16 * MiB;
constexpr size_t WS_WOUT = 72 * MiB;
constexpr size_t WS_WRKV = 88 * MiB;
constexpr size_t WS_WO = 136 * MiB;
constexpr size_t WS_WL1 = 152 * MiB;
constexpr size_t WS_WL2 = 160 * MiB;
constexpr size_t WS_WGU = 168 * MiB;
constexpr size_t WS_WDN = 680 * MiB;
constexpr size_t WS_XB = 936 * MiB;
constexpr size_t WS_VF = 1000 * MiB;
constexpr size_t WS_R = 1064 * MiB;
constexpr size_t WS_Z = WS_R;
constexpr size_t WS_QKB = WS_R + 224 * MiB;
constexpr size_t WS_VAT = WS_R + 288 * MiB;
constexpr size_t WS_YE = WS_R + 320 * MiB;
constexpr size_t WS_DC = WS_R + 384 * MiB;
constexpr size_t WS_CP = WS_R + 512 * MiB;
constexpr size_t WS_XRKV = WS_R;
constexpr size_t WS_XC = WS_R + 192 * MiB;
constexpr size_t WS_RKV = WS_R + 320 * MiB;
constexpr size_t WS_L1 = WS_R + 512 * MiB;
constexpr size_t WS_G = WS_R + 528 * MiB;
constexpr size_t WS_WD = WS_R + 592 * MiB;
constexpr size_t WS_AA = WS_R + 656 * MiB;
constexpr size_t WS_YO = WS_R + 720 * MiB;
constexpr size_t WS_XS = WS_R;
constexpr size_t WS_HID = WS_R + 160 * MiB;
constexpr size_t WS_YS = WS_R + 400 * MiB;
constexpr size_t WS_X2 = WS_R + 784 * MiB;
constexpr size_t WS_VG = WS_X2 + 64 * MiB;
constexpr size_t WS_XSUM = WS_X2 + 64 * MiB;
constexpr size_t WS_END = WS_X2 + 128 * MiB;

constexpr int CW_BAR = 4096;
constexpr int CW_CNT = 16384;

constexpr int LDS_BYTES = 163840;
constexpr int MISC_OFF = LDS_BYTES - 4096;
constexpr int RING_BYTES = MISC_OFF;

typedef unsigned gu32;

#ifndef MOE_PROLOGUE_LAYERS
#define MOE_PROLOGUE_LAYERS 1
#endif
struct Args { const float* in[39]; float* out; unsigned char* ws; int ph_lo, ph_hi; };
#define CAS __attribute__((address_space(4)))
typedef const CAS Args* ArgsP;
#define XIN(a, l) ((bf16*)((a)->ws + (((l) == 0 || (l) == 3) ? WS_XB : WS_X2)))
#define XOUT(a, l) ((bf16*)((a)->ws + (((l) <= 1) ? WS_X2 : WS_XB)))
__device__ __forceinline__ ArgsP get_args() { ArgsP p = (ArgsP)__builtin_amdgcn_kernarg_segment_ptr(); asm volatile("" : "+s"(p)); return p; }

template <int NH> __device__ __forceinline__ void tr_item_n(const float* W, int ldw, int k0, int n0, bf16* WT, int ldt, int drow0, int dcol0, LAS float* scr, int lane, const float* kscale) {
    const int r = lane >> 3, c4 = lane & 7;
    f32x4 v[NH][8];
#pragma unroll
    for (int hh = 0; hh < NH; ++hh)
#pragma unroll
        for (int i = 0; i < 8; ++i) v[hh][i] = __builtin_nontemporal_load((const f32x4*)(W + (size_t)(k0 + 64 * hh + 8 * i + r) * ldw + n0 + 4 * c4));
#pragma unroll
    for (int hh = 0; hh < NH; ++hh) {
        if (kscale) {
#pragma unroll
            for (int i = 0; i < 8; ++i) v[hh][i] = v[hh][i] * kscale[k0 + 64 * hh + 8 * i + r]; }
#pragma unroll
        for (int i = 0; i < 8; ++i) { LAS float* d = scr + (8 * i + r) * 33 + 4 * c4; d[0] = v[hh][i].x; d[1] = v[hh][i].y; d[2] = v[hh][i].z; d[3] = v[hh][i].w; }
        LDS_WAIT(); asm volatile("" ::: "memory");
        const int c = lane & 7;
#pragma unroll
        for (int j = 0; j < 4; ++j) { const int n = (lane >> 3) + 8 * j; const LAS float* s = scr + (8 * c) * 33 + n;
            v4u o; o.x = pk2(s[0 * 33], s[1 * 33]); o.y = pk2(s[2 * 33], s[3 * 33]); o.z = pk2(s[4 * 33], s[5 * 33]); o.w = pk2(s[6 * 33], s[7 * 33]);
            *(v4u*)(WT + (size_t)(drow0 + n) * ldt + dcol0 + 64 * hh + 8 * c) = o; }
        LDS_WAIT(); asm volatile("" ::: "memory");
    }
}
__device__ __forceinline__ void tr_item(const float* W, int ldw, int k0, int n0, bf16* WT, int ldt, int drow0, int dcol0, LAS float* scr, int lane, const float* kscale) {
    tr_item_n<1>(W, ldw, k0, n0, WT, ldt, drow0, dcol0, scr, lane, kscale); }

__device__ __forceinline__ void moe_convert(const int wv, LAS unsigned char* lds, int le_lo, int le_hi, int vb, int nvb) {
    const ArgsP a = get_args();
    OPAQUE_TID(); const int lane = tid & 63, wave = tid >> 6;
    unsigned char* ws = a->ws;
    LAS float* scr = (LAS float*)(lds + wave * 16384);
    const int n = (le_hi - le_lo) * 768;
    for (int it = vb * NWAVES + wave; it < n; it += nvb * NWAVES) {
        const int le = le_lo + it / 768, rr = it % 768, mat = rr / 256, q = rr % 256;
        if (mat < 2) { const int kb = q / 16, nb = q % 16, n0 = 32 * nb;
            tr_item_n<2>((mat == 0 ? a->in[36] : a->in[37]) + (size_t)le * 2048 * 512, 512, 128 * kb, n0, (bf16*)(ws + WS_WGU) + (size_t)le * 1024 * 2048, 2048,
                    (n0 / 128) * 256 + (n0 % 128) + (mat == 1 ? 128 : 0), 128 * kb, scr, lane, nullptr); }
        else { const int kb = q / 64, nb = q % 64;
            tr_item_n<2>(a->in[38] + (size_t)le * 512 * 2048, 2048, 128 * kb, 32 * nb, (bf16*)(ws + WS_WDN) + (size_t)le * 2048 * 512, 512, 32 * nb, 128 * kb, scr, lane, nullptr); }
    }
}

__device__ __forceinline__ void prologue(const int wv, LAS unsigned char* lds, const int part) {
    const ArgsP a = get_args();
#ifdef NO_PROL
    return;
#endif
    OPAQUE_TID(); const int lane = tid & 63, wave = tid >> 6;
    unsigned char* ws = a->ws;
    LAS float* scr = (LAS float*)(lds + wave * 16384);
    const int gw = blockIdx.x * NWAVES + wave, NGW = gridDim.x * NWAVES;
    constexpr int I0 = 2 * 7168, I1 = 2 * 2048, I2 = 2 * 4 * 2048, I3 = 2 * 32 * 16, I4 = MOE_PROLOGUE_LAYERS * 32 * 768;
    constexpr int NITEMS = I0 + I1 + I2 + I3 + I4;
    for (int it = (part == 0 ? 0 : 7168) + gw; it < (part == 0 ? 7168 : NITEMS); it += NGW) {
        int r = it;
        if (r < I0) { const int e = r / 7168, rr = r % 7168, kb = rr / 224, nb = rr % 224;
            tr_item(a->in[1] + (size_t)e * 2048 * EVEN_IN, EVEN_IN, 64 * kb, 32 * nb, (bf16*)(ws + WS_WIN) + (size_t)e * ZW * 2048, 2048, 32 * nb, 64 * kb, scr, lane, nullptr); continue; } r -= I0;
        if (r < I1) { const int e = r / 2048, rr = r % 2048, kb = rr / 64, nb = rr % 64;
            tr_item(a->in[6] + (size_t)e * 2048 * 2048, 2048, 64 * kb, 32 * nb, (bf16*)(ws + WS_WOUT) + (size_t)e * 2048 * 2048, 2048, 32 * nb, 64 * kb, scr, lane, nullptr); continue; } r -= I1;
        if (r < I2) { const int o = r / 8192, rr = r % 8192, mat = rr / 2048, q = rr % 2048, kb = q / 64, nb = q % 64;
            const float* src = (mat == 0 ? a->in[8] : mat == 1 ? a->in[9] : mat == 2 ? a->in[10] : a->in[11]) + (size_t)o * 2048 * 2048;
            bf16* dst = (mat < 3) ? (bf16*)(ws + WS_WRKV) + (size_t)o * 3 * 2048 * 2048 + (size_t)mat * 2048 * 2048 : (bf16*)(ws + WS_WO) + (size_t)o * 2048 * 2048;
            tr_item(src, 2048, 64 * kb, 32 * nb, dst, 2048, 32 * nb, 64 * kb, scr, lane, nullptr); continue; } r -= I2;
        if (r < I3) { const int o = r / 512, rr = r % 512, kb = rr / 16, nb = rr % 16;
            const float* src; int ldw, n0, drow0, mu;
            if (nb < 8) { src = a->in[18] + (size_t)o * 2048 * 256; ldw = 256; n0 = 32 * nb; drow0 = 32 * nb; mu = 5; }
            else if (nb < 11) { src = a->in[13] + (size_t)o * 2048 * 96; ldw = 96; n0 = 32 * (nb - 8); drow0 = 256 + n0; mu = 1; }
            else if (nb < 14) { src = a->in[16] + (size_t)o * 2048 * 96; ldw = 96; n0 = 32 * (nb - 11); drow0 = 352 + n0; mu = 4; }
            else { if (o == 0) continue; src = a->in[26]; ldw = 64; n0 = 32 * (nb - 14); drow0 = 448 + n0; mu = 3; }
            bf16* dst = (bf16*)(ws + WS_WL1) + (size_t)o * 2 * 512 * 2048;
            tr_item(src, ldw, 64 * kb, n0, dst, 2048, drow0, 64 * kb, scr, lane, nullptr);
            tr_item(src, ldw, 64 * kb, n0, dst + (size_t)512 * 2048, 2048, drow0, 64 * kb, scr, lane, a->in[7] + (size_t)(o * 6 + mu) * 2048);
            continue; } r -= I3;
        { const int le = r / 768, rr = r % 768, mat = rr / 256, q = rr % 256;
            if (mat < 2) { const int kb = q / 16, nb = q % 16, n0 = 32 * nb;
                tr_item_n<2>((mat == 0 ? a->in[36] : a->in[37]) + (size_t)le * 2048 * 512, 512, 128 * kb, n0, (bf16*)(ws + WS_WGU) + (size_t)le * 1024 * 2048, 2048,
                        (n0 / 128) * 256 + (n0 % 128) + (mat == 1 ? 128 : 0), 128 * kb, scr, lane, nullptr); }
            else { const int kb = q / 64, nb = q % 64;
                tr_item_n<2>(a->in[38] + (size_t)le * 512 * 2048, 2048, 128 * kb, 32 * nb, (bf16*)(ws + WS_WDN) + (size_t)le * 2048 * 512, 512, 32 * nb, 128 * kb, scr, lane, nullptr); }
        }
    }
    const int gt = blockIdx.x * NTHR + tid, NGT = gridDim.x * NTHR;
    for (int idx = gt; part == 1 && idx < 2 * 32 * 8192; idx += NGT) {
        const int o = idx / (32 * 8192), rem = idx % (32 * 8192), kg = rem / 8192, n = rem % 8192, mat = n / 2048, nn = n % 2048;
        float v[8];
#pragma unroll
        for (int j = 0; j < 8; ++j) { const int k = 8 * kg + j; float x = 0.f;
            if (mat == 0) x = a->in[19][((size_t)o * 256 + k) * 2048 + nn];
            else if (mat == 1) { if (k < 96) x = a->in[14][((size_t)o * 96 + k) * 2048 + nn]; }
            else if (mat == 2) { if (k >= 96 && k < 192) x = a->in[17][((size_t)o * 96 + (k - 96)) * 2048 + nn]; }
            else { if (o == 1 && k >= 192) x = a->in[27][(size_t)(k - 192) * 2048 + nn]; }
            v[j] = x; }
        v4u w; w.x = pk2(v[0], v[1]); w.y = pk2(v[2], v[3]); w.z = pk2(v[4], v[5]); w.w = pk2(v[6], v[7]);
        *(v4u*)((bf16*)(ws + WS_WL2) + ((size_t)o * 8192 + n) * 256 + 8 * kg) = w;
    }
    for (int idx = gt; part == 0 && idx < 4 * 2048 * 9; idx += NGT) { const int l = idx / (2048 * 9), rem = idx % (2048 * 9), k = rem / 9, q = rem % 9;
        const f32x4 v = (q == 0) ? *(const f32x4*)(a->in[32] + ((size_t)l * 2048 + k) * 4) : *(const f32x4*)(a->in[34] + ((size_t)l * 2048 + k) * 32 + 4 * (q - 1));
        ((f32x4*)(ws + WS_RW))[(size_t)l * 9 * 2048 + q * 2048 + ((k >> 8) * 4 + (k & 3)) * 64 + ((k >> 2) & 63)] = v; }
    for (int i0 = gt; part == 0 && i0 < T_ * D_ / 4; i0 += 8 * NGT) { f32x4 v[8];
#pragma unroll
        for (int k = 0; k < 8; ++k) { const int i = i0 + k * NGT; v[k] = (i < T_ * D_ / 4) ? __builtin_nontemporal_load((const f32x4*)a->in[0] + i) : (f32x4){0.f, 0.f, 0.f, 0.f}; }
#pragma unroll
        for (int k = 0; k < 8; ++k) { const int i = i0 + k * NGT; if (i < T_ * D_ / 4) { v2u w; w.x = pk2(v[k].x, v[k].y); w.y = pk2(v[k].z, v[k].w); ((v2u*)(ws + WS_XB))[i] = w; } } }
}

__device__ __forceinline__ void even_prep(const int wv, int e, LAS unsigned char* lds, int u) {
    const ArgsP a = get_args();
#ifdef NO_EPREP
    return;
#endif
    OPAQUE_TID(); const int lane = tid & 63, wave = tid >> 6;
    unsigned char* ws = a->ws;
    bf16* Z = (bf16*)(ws + WS_Z);
    const int m0 = 64 * u, b = u >> 6, ch = u & 63, t0 = ch * 64;
    { LAS float* cst = (LAS float*)lds; LAS float* snt = cst + 1024;
#pragma unroll 1
      for (int q = tid; q < 1024; q += NTHR) { const int r = q >> 4, i = q & 15; const float inv = exp2f(-(float)i * (18.931568569324174f / 16.f));
          float sn_, cs_; sincosf((float)(t0 + r) * inv, &sn_, &cs_); cst[q] = cs_; snt[q] = sn_; }
      __syncthreads();
      const int row = tid >> 3, head = tid & 7;
      float cs[16], sn[16];
#pragma unroll
      for (int i = 0; i < 4; ++i) { const f32x4 c4 = *(const LAS f32x4*)(cst + row * 16 + 4 * i), s4 = *(const LAS f32x4*)(snt + row * 16 + 4 * i);
          cs[4 * i] = c4.x; cs[4 * i + 1] = c4.y; cs[4 * i + 2] = c4.z; cs[4 * i + 3] = c4.w; sn[4 * i] = s4.x; sn[4 * i + 1] = s4.y; sn[4 * i + 2] = s4.z; sn[4 * i + 3] = s4.w; }
#pragma unroll 1
      for (int qk = 0; qk < 2; ++qk) { v4u* p = (v4u*)(Z + (size_t)(m0 + row) * ZW + qk * 1024 + head * 128);
        v4u w0 = p[0], w1 = p[1], w2 = p[2], w3 = p[3]; unsigned x1[8] = {w0.x, w0.y, w0.z, w0.w, w1.x, w1.y, w1.z, w1.w}, x2[8] = {w2.x, w2.y, w2.z, w2.w, w3.x, w3.y, w3.z, w3.w};
        unsigned o1[8], o2[8];
#pragma unroll
        for (int j = 0; j < 8; ++j) { const float a0 = bflo(x1[j]), a1 = bfhi(x1[j]), b0 = bflo(x2[j]), b1 = bfhi(x2[j]);
            o1[j] = pk2(a0 * cs[2 * j] - b0 * sn[2 * j], a1 * cs[2 * j + 1] - b1 * sn[2 * j + 1]);
            o2[j] = pk2(b0 * cs[2 * j] + a0 * sn[2 * j], b1 * cs[2 * j + 1] + a1 * sn[2 * j + 1]); }
        p[0] = (v4u){o1[0], o1[1], o1[2], o1[3]}; p[1] = (v4u){o1[4], o1[5], o1[6], o1[7]}; p[2] = (v4u){o2[0], o2[1], o2[2], o2[3]}; p[3] = (v4u){o2[4], o2[5], o2[6], o2[7]}; }
    }
    VM_WAIT(); __syncthreads();
    { LAS float* red = (LAS float*)lds;
      const int cg = tid & 127, rq = tid >> 7; float s[8] = {0, 0, 0, 0, 0, 0, 0, 0};
      for (int r = 0; r < 16; ++r) { const v4u w = *(const v4u*)(Z + (size_t)(m0 + rq * 16 + r) * ZW + 1024 + cg * 8);
          s[0] += bflo(w.x); s[1] += bfhi(w.x); s[2] += bflo(w.y); s[3] += bfhi(w.y); s[4] += bflo(w.z); s[5] += bfhi(w.z); s[6] += bflo(w.w); s[7] += bfhi(w.w); }
#pragma unroll
      for (int j = 0; j < 8; ++j) red[rq * 1024 + cg * 8 + j] = s[j];
      __syncthreads();
      if (tid < 256) { f32x4 t = {0, 0, 0, 0};
#pragma unroll
          for (int q = 0; q < 4; ++q) { const f32x4 v = *(const LAS f32x4*)(red + q * 1024 + tid * 4); t += v; }
          const int c = tid * 4, h = c >> 7, d = c & 127;
          *(f32x4*)((float*)(ws + WS_KPART) + ((size_t)((b * 8 + h) * 64 + ch)) * 128 + d) = t; }
      __syncthreads();
    }
    { const int cg = tid & 255, rh = tid >> 8; const int c0 = 8 * cg;
      const float* cw = a->in[3] + (size_t)e * 4 * 2048; const float* cb = a->in[4] + (size_t)e * 2048;
      float w[4][8], bias[8];
#pragma unroll
      for (int j = 0; j < 4; ++j)
#pragma unroll
          for (int i = 0; i < 8; ++i) w[j][i] = cw[j * 2048 + c0 + i];
#pragma unroll
      for (int i = 0; i < 8; ++i) bias[i] = cb[c0 + i];
      float win[3][8];
#pragma unroll
      for (int j = 0; j < 3; ++j) { const int tt = t0 + 32 * rh - 3 + j;
          v4u x = {0, 0, 0, 0}; if (tt >= 0) x = *(const v4u*)(Z + (size_t)(b * SEQ + tt) * ZW + 3072 + c0);
          win[j][0] = bflo(x.x); win[j][1] = bfhi(x.x); win[j][2] = bflo(x.y); win[j][3] = bfhi(x.y); win[j][4] = bflo(x.z); win[j][5] = bfhi(x.z); win[j][6] = bflo(x.w); win[j][7] = bfhi(x.w); }
      bf16* QKB = (bf16*)(ws + WS_QKB);
      for (int r = 0; r < 32; ++r) { const int m = m0 + 32 * rh + r;
          const v4u x = *(const v4u*)(Z + (size_t)m * ZW + 3072 + c0);
          float cur[8] = {bflo(x.x), bfhi(x.x), bflo(x.y), bfhi(x.y), bflo(x.z), bfhi(x.z), bflo(x.w), bfhi(x.w)}; float o[8];
#pragma unroll
          for (int i = 0; i < 8; ++i) { const float v = bias[i] + w[0][i] * win[0][i] + w[1][i] * win[1][i] + w[2][i] * win[2][i] + w[3][i] * cur[i]; o[i] = v * __builtin_amdgcn_rcpf(1.f + __expf(-v));
              win[0][i] = win[1][i]; win[1][i] = win[2][i]; win[2][i] = cur[i]; }
          *(v4u*)(QKB + (size_t)m * 2048 + c0) = (v4u){pk2(o[0], o[1]), pk2(o[2], o[3]), pk2(o[4], o[5]), pk2(o[6], o[7])}; }
    }
    { LAS float* wg = (LAS float*)lds;
      const float* Win = a->in[1] + (size_t)e * 2048 * EVEN_IN;
      for (int i = tid; i < 2048 * 2; i += NTHR) { const int k = i >> 1, hf = i & 1;
          *(LAS f32x4*)(wg + ((((k >> 8) * 4 + (k & 3)) * 2 + hf) * 64 + ((k >> 2) & 63)) * 4) = *(const f32x4*)(Win + (size_t)k * EVEN_IN + ZW + hf * 4); }
      __syncthreads();
      const float* gb = a->in[2] + e * 8;
      for (int rr = 0; rr < 8; ++rr) { const int row = wave * 8 + rr, m = m0 + row; const v2u* xr = (const v2u*)(XIN(a, 2 * e) + (size_t)m * D_) + lane;
          float acc[8] = {0, 0, 0, 0, 0, 0, 0, 0};
#pragma unroll 2
          for (int j = 0; j < 8; ++j) { const v2u xw = xr[64 * j]; const f32x4 xv = {bflo(xw.x), bfhi(xw.x), bflo(xw.y), bfhi(xw.y)};
#pragma unroll
              for (int i = 0; i < 4; ++i) { const f32x4 wa = *(const LAS f32x4*)(wg + (((4 * j + i) * 2) * 64 + lane) * 4), wb = *(const LAS f32x4*)(wg + (((4 * j + i) * 2 + 1) * 64 + lane) * 4); const float xx = xv[i];
                  acc[0] += xx * wa.x; acc[1] += xx * wa.y; acc[2] += xx * wa.z; acc[3] += xx * wa.w; acc[4] += xx * wb.x; acc[5] += xx * wb.y; acc[6] += xx * wb.z; acc[7] += xx * wb.w; } }
#pragma unroll
          for (int j = 0; j < 8; ++j) acc[j] = wave_sum(acc[j]);
          if (lane < 4) { const int h = lane; float ip = 0.f, fp = 0.f;
#pragma unroll
              for (int j = 0; j < 4; ++j) { if (j == h) { ip = acc[j]; fp = acc[4 + j]; } }
              ip += gb[h]; fp += gb[4 + h];
              const float lf = -(fmaxf(-fp, 0.f) + __logf(1.f + __expf(-fabsf(fp))));
              ((float*)(ws + WS_IG))[(size_t)(b * 4 + h) * SEQ + t0 + row] = ip;
              ((LAS float*)(lds + 73728))[h * 64 + row] = ip; ((LAS float*)(lds + 73728 + 1024))[h * 64 + row] = lf; } }
      __syncthreads();
    }
    { LAS float* gi = (LAS float*)(lds + 73728); LAS float* gf = gi + 256; LAS float* wsc = gi + 512;
      const int bh0 = b * 4;
      if (wave < 4) { const int h = wave; float x = gf[h * 64 + lane];
#pragma unroll
          for (int o = 1; o < 64; o <<= 1) { const float t = __shfl_up(x, o); if (lane >= o) x += t; }
          const float b63 = __shfl(x, 63);
          wsc[h * 64 + lane] = __expf(b63 - x + gi[h * 64 + lane]) * 0.0625f;
          ((float*)(ws + WS_BC))[(size_t)(bh0 + h) * SEQ + t0 + lane] = x;
          if (lane == 63) ((float*)(ws + WS_DEC))[(bh0 + h) * 64 + ch] = __expf(b63); }
      __syncthreads();
      constexpr int PV = 544;
      LAS unsigned char* Vt = lds; LAS unsigned char* Kt = lds + 64 * PV;
      const int g4 = lane >> 4, q4 = (lane >> 2) & 3, p4 = lane & 3, fr = lane & 15;
      const int wd = wave & 1, we = wave >> 1;
      const bf16* QKB = (const bf16*)(ws + WS_QKB);
      for (int h = 0; h < 4; ++h) {
          { const int sr = tid >> 3, seg = tid & 7; const float wv_ = wsc[h * 64 + sr];
            const v4u* vs = (const v4u*)(Z + (size_t)(m0 + sr) * ZW + 5120 + h * 256 + 32 * seg); const v4u* ks = (const v4u*)(QKB + (size_t)(m0 + sr) * 2048 + 1024 + h * 256 + 32 * seg);
#pragma unroll
            for (int j = 0; j < 4; ++j) { *(LAS v4u*)(Vt + sr * PV + (32 * seg + 8 * j) * 2) = vs[j]; const v4u kk = ks[j];
                *(LAS v4u*)(Kt + sr * PV + (32 * seg + 8 * j) * 2) = (v4u){pk2(bflo(kk.x) * wv_, bfhi(kk.x) * wv_), pk2(bflo(kk.y) * wv_, bfhi(kk.y) * wv_), pk2(bflo(kk.z) * wv_, bfhi(kk.z) * wv_), pk2(bflo(kk.w) * wv_, bfhi(kk.w) * wv_)}; } }
          __syncthreads();
          if (tid < 256) { float sum = 0.f;
#pragma unroll 8
              for (int sr = 0; sr < 64; ++sr) sum += bf2f(*(const LAS bf16*)(Kt + sr * PV + tid * 2));
              ((float*)(ws + WS_DN))[((size_t)(bh0 + h) * 64 + ch) * 256 + tid] = sum; }
          f32x4 acc[8][4];
#pragma unroll
          for (int i = 0; i < 8; ++i)
#pragma unroll
              for (int j = 0; j < 4; ++j) acc[i][j] = (f32x4){0.f, 0.f, 0.f, 0.f};
#pragma unroll
          for (int ks2 = 0; ks2 < 2; ++ks2) {
              bf16x8 yf[4];
#pragma unroll
              for (int et = 0; et < 4; ++et) { const LAS unsigned char* p = Vt + (32 * ks2 + 8 * g4 + q4) * PV + (64 * we + 16 * et + 4 * p4) * 2;
                  const v2u lo = tr_read(p), hi = tr_read(p + 4 * PV); yf[et] = __builtin_bit_cast(bf16x8, (v4u){lo.x, lo.y, hi.x, hi.y}); }
#pragma unroll
              for (int dt = 0; dt < 8; ++dt) { const LAS unsigned char* p = Kt + (32 * ks2 + 8 * g4 + q4) * PV + (128 * wd + 16 * dt + 4 * p4) * 2;
                  const v2u lo = tr_read(p), hi = tr_read(p + 4 * PV); const bf16x8 xf = __builtin_bit_cast(bf16x8, (v4u){lo.x, lo.y, hi.x, hi.y});
#pragma unroll
                  for (int et = 0; et < 4; ++et) acc[dt][et] = __builtin_amdgcn_mfma_f32_16x16x32_bf16(xf, yf[et], acc[dt][et], 0, 0, 0); } }
          { bf16* DC = (bf16*)(ws + WS_DC) + ((size_t)(bh0 + h) * 64 + ch) * 65536;
#pragma unroll
            for (int et = 0; et < 4; ++et)
#pragma unroll
                for (int dt = 0; dt < 8; ++dt) { const f32x4 v = acc[dt][et];
                    *(v2u*)(DC + (size_t)(64 * we + 16 * et + fr) * 256 + 128 * wd + 16 * dt + 4 * g4) = (v2u){pk2(v.x, v.y), pk2(v.z, v.w)}; } }
          __syncthreads();
      }
    }
}

constexpr int AT_PITCH = 272;
constexpr int AT_BUF = 2 * 64 * AT_PITCH;
constexpr int AT_KM_OFF = 2 * AT_BUF, AT_GATE_OFF = AT_KM_OFF + 16 * 128 * 4, AT_SEL_OFF = AT_GATE_OFF + 256 * 16 * 4, AT_TL_OFF = AT_SEL_OFF + 256 * 4, AT_END = AT_TL_OFF + 80 * 4;
static_assert(AT_END <= RING_BYTES, "attention LDS map");

__device__ __forceinline__ void attn_unit(const int wv, LAS unsigned char* lds, int b, int h, int qb) {
    const ArgsP a = get_args();
#ifdef NO_ATTN
    return;
#endif
    OPAQUE_TID(); const int lane = tid & 63, wave = wv, fr = lane & 15, fq = lane >> 4, q4 = (lane >> 2) & 3, p4 = lane & 3;
    unsigned char* ws = a->ws;
    const bf16* Z = (const bf16*)(ws + WS_Z);
    const int q0 = 256 * qb;
    LAS float* km = (LAS float*)(lds + AT_KM_OFF); LAS float* gate = (LAS float*)(lds + AT_GATE_OFF);
    LAS unsigned* sel = (LAS unsigned*)(lds + AT_SEL_OFF); LAS int* tl = (LAS int*)(lds + AT_TL_OFF);
    if (tid == 0) tl[72] = 0;
    for (int i = tid; i < qb * 128; i += NTHR) { const int n = i >> 7, d = i & 127; const float* kp = (const float*)(ws + WS_KPART) + ((size_t)((b * 8 + h) * 64 + 4 * n)) * 128 + d;
        km[i] = (kp[0] + kp[128] + kp[256] + kp[384]) * (1.f / 256.f); }
    __syncthreads();
    if (qb > 3) { const int ql = tid >> 1, part = tid & 1; const v4u* qp = (const v4u*)(Z + (size_t)(b * SEQ + q0 + ql) * ZW + h * 128);
        float g[8] = {0, 0, 0, 0, 0, 0, 0, 0};
        for (int c = 0; c < 16; ++c) { const v4u w = qp[c]; const float qv[8] = {bflo(w.x), bfhi(w.x), bflo(w.y), bfhi(w.y), bflo(w.z), bfhi(w.z), bflo(w.w), bfhi(w.w)};
#pragma unroll
            for (int jj = 0; jj < 8; ++jj) { const int n = part + 2 * jj; if (n < qb) { const LAS float* kk = km + n * 128 + c * 8;
#pragma unroll
                for (int i = 0; i < 8; ++i) g[jj] += qv[i] * kk[i]; } } }
#pragma unroll
        for (int jj = 0; jj < 8; ++jj) { const int n = part + 2 * jj; if (n < qb) gate[ql * 16 + n] = g[jj]; }
    }
    __syncthreads();
    if (tid < 256) { unsigned m = 0;
        if (qb <= 3) m = (1u << qb) - 1u;
        else { for (int r = 0; r < 3; ++r) { float best = -3.0e38f; int bi = 0; for (int n = 0; n < qb; ++n) { const float g = gate[tid * 16 + n]; if (!((m >> n) & 1u) && g > best) { best = g; bi = n; } } m |= 1u << bi; } }
        sel[tid] = m;
        unsigned wm = m;
#pragma unroll
        for (int o = 1; o < 64; o <<= 1) wm |= __shfl_xor(wm, o);
        if (lane == 0) atomicOr((unsigned*)&tl[72], wm); }
    __syncthreads();
    if (tid == 0) { const unsigned um = (unsigned)tl[72];
        int nt = 0;
        for (int j = 0; j < 4; ++j) tl[1 + nt++] = (4 * qb + j) | (1 << 16);
        for (int n = 0; n < qb; ++n) if ((um >> n) & 1u) for (int j = 0; j < 4; ++j) tl[1 + nt++] = 4 * n + j;
        tl[0] = nt; }
    __syncthreads();
    const int ntile = tl[0];
    const unsigned mysel0 = sel[32 * wave + fr], mysel1 = sel[32 * wave + 16 + fr];
    unsigned wsel = mysel0 | mysel1;
#pragma unroll
    for (int o = 1; o < 16; o <<= 1) wsel |= __shfl_xor(wsel, o);
    bf16x8 qf[2][4];
#pragma unroll
    for (int t = 0; t < 2; ++t) { const v4u* qp = (const v4u*)(Z + (size_t)(b * SEQ + q0 + 32 * wave + 16 * t + fr) * ZW + h * 128);
#pragma unroll
        for (int kc = 0; kc < 4; ++kc) qf[t][kc] = __builtin_bit_cast(bf16x8, qp[kc * 4 + fq]); }
    f32x4 o[2][8];
#pragma unroll
    for (int t = 0; t < 2; ++t)
#pragma unroll
        for (int i = 0; i < 8; ++i) o[t][i] = (f32x4){0.f, 0.f, 0.f, 0.f};
    float mrun[2] = {-INFINITY, -INFINITY}, lrun[2] = {0.f, 0.f};
    const float sc = 0.08838834764831845f * 1.4426950408889634f;
    v4u kr0[2], vr0[2], kr1[2], vr1[2];
    auto gload = [&](int ti, v4u (&kr)[2], v4u (&vr)[2]) { const int key0 = 64 * (tl[1 + ti] & 0xffff);
        const v4u* kp = (const v4u*)(Z + (size_t)(b * SEQ + key0 + (tid >> 3)) * ZW + 1024 + h * 128) + (tid & 7) * 2; kr[0] = kp[0]; kr[1] = kp[1]; vr[0] = kp[128]; vr[1] = kp[129]; };
    auto lstore = [&](int bufi, const v4u (&kr)[2], const v4u (&vr)[2]) { LAS v4u* kd = (LAS v4u*)(lds + bufi * AT_BUF + (tid >> 3) * AT_PITCH + (tid & 7) * 32); kd[0] = kr[0]; kd[1] = kr[1];
        LAS v4u* vd = (LAS v4u*)(lds + bufi * AT_BUF + 64 * AT_PITCH + (tid >> 3) * AT_PITCH + (tid & 7) * 32); vd[0] = vr[0]; vd[1] = vr[1]; };
    gload(0, kr0, vr0); gload(1, kr1, vr1); lstore(0, kr0, vr0); __syncthreads();
    auto tile = [&](const int ti, v4u (&ldk)[2], v4u (&ldv)[2], const v4u (&stk)[2], const v4u (&stv)[2]) {
        const int ent = __builtin_amdgcn_readfirstlane(tl[1 + ti]); const int kt64 = ent & 0xffff; const bool own = (ent >> 16) & 1; const int key0 = 64 * kt64;
        if (ti + 2 < ntile) gload(ti + 2, ldk, ldv);
        const LAS unsigned char* Kt = lds + (ti & 1) * AT_BUF; const LAS unsigned char* Vt = Kt + 64 * AT_PITCH;
        const bool wave_active = own ? (key0 <= q0 + 32 * wave + 31) : (((wsel >> (kt64 >> 2)) & 1u) != 0u);
        if (wave_active) {
            f32x4 s[2][4];
            { bf16x8 kfa[2][4], kfb[2][4];
#pragma unroll
              for (int kt = 0; kt < 2; ++kt)
#pragma unroll
                  for (int kc = 0; kc < 4; ++kc) kfa[kt][kc] = *(const LAS bf16x8*)(Kt + (16 * kt + fr) * AT_PITCH + (kc * 32 + fq * 8) * 2);
#pragma unroll
              for (int kt = 0; kt < 2; ++kt)
#pragma unroll
                  for (int kc = 0; kc < 4; ++kc) kfb[kt][kc] = *(const LAS bf16x8*)(Kt + (16 * (kt + 2) + fr) * AT_PITCH + (kc * 32 + fq * 8) * 2);
              __builtin_amdgcn_sched_barrier(0);
#pragma unroll
              for (int kt = 0; kt < 2; ++kt) { s[0][kt] = (f32x4){0.f, 0.f, 0.f, 0.f}; s[1][kt] = (f32x4){0.f, 0.f, 0.f, 0.f};
#pragma unroll
                  for (int kc = 0; kc < 4; ++kc) { s[0][kt] = __builtin_amdgcn_mfma_f32_16x16x32_bf16(kfa[kt][kc], qf[0][kc], s[0][kt], 0, 0, 0); s[1][kt] = __builtin_amdgcn_mfma_f32_16x16x32_bf16(kfa[kt][kc], qf[1][kc], s[1][kt], 0, 0, 0); } }
              __builtin_amdgcn_sched_barrier(0);
#pragma unroll
              for (int kt = 0; kt < 2; ++kt) { s[0][kt + 2] = (f32x4){0.f, 0.f, 0.f, 0.f}; s[1][kt + 2] = (f32x4){0.f, 0.f, 0.f, 0.f};
#pragma unroll
                  for (int kc = 0; kc < 4; ++kc) { s[0][kt + 2] = __builtin_amdgcn_mfma_f32_16x16x32_bf16(kfb[kt][kc], qf[0][kc], s[0][kt + 2], 0, 0, 0); s[1][kt + 2] = __builtin_amdgcn_mfma_f32_16x16x32_bf16(kfb[kt][kc], qf[1][kc], s[1][kt + 2], 0, 0, 0); } }
            }
            bf16x8 vfa[4][2];
#pragma unroll
            for (int dt = 0; dt < 4; ++dt)
#pragma unroll
                for (int j = 0; j < 2; ++j) { const LAS unsigned char* vp = Vt + (32 * j + 4 * fq + q4) * AT_PITCH + (16 * dt + 4 * p4) * 2;
                    const v2u lo = tr_read(vp), hi = tr_read(vp + 16 * AT_PITCH); vfa[dt][j] = __builtin_bit_cast(bf16x8, (v4u){lo.x, lo.y, hi.x, hi.y}); }
            __builtin_amdgcn_sched_barrier(0);
            bf16x8 pf[2][2];
            const bool diag = own && (key0 + 63 > q0 + 32 * wave);
#pragma unroll
            for (int t = 0; t < 2; ++t) { const int qabs = q0 + 32 * wave + 16 * t + fr; const unsigned ms = t ? mysel1 : mysel0;
                const bool qsel = own || ((ms >> (kt64 >> 2)) & 1u);
                if (diag) {
#pragma unroll
                    for (int kt = 0; kt < 4; ++kt)
#pragma unroll
                        for (int e = 0; e < 4; ++e) { const int kabs = key0 + 16 * kt + 4 * fq + e; if (kabs > qabs) s[t][kt][e] = -INFINITY; } }
                float mx = s[t][0][0];
#pragma unroll
                for (int kt = 0; kt < 4; ++kt)
#pragma unroll
                    for (int e = 0; e < 4; ++e) mx = fmaxf(mx, s[t][kt][e]);
                mx = qsel ? mx * sc : -INFINITY;
                mx = fmaxf(mx, __shfl_xor(mx, 16)); mx = fmaxf(mx, __shfl_xor(mx, 32));
                const bool need = mx > mrun[t] + 8.f;
                if (__builtin_amdgcn_ballot_w64(need) != 0ull) {
                    const float mnew = need ? mx : mrun[t];
                    const float alpha = need ? __builtin_amdgcn_exp2f(mrun[t] - mnew) : 1.f;
                    lrun[t] *= alpha; mrun[t] = mnew;
#pragma unroll
                    for (int i = 0; i < 8; ++i) o[t][i] *= alpha; }
                const float scl = qsel ? sc : 0.f, nbias = qsel ? -mrun[t] : -1.0e30f;
                float psum = 0.f;
#pragma unroll
                for (int kt = 0; kt < 4; ++kt)
#pragma unroll
                    for (int e = 0; e < 4; ++e) { const float p = __builtin_amdgcn_exp2f(fmaf(s[t][kt][e], scl, nbias)); s[t][kt][e] = p; psum += p; }
                lrun[t] += psum;
#pragma unroll
                for (int j = 0; j < 2; ++j) { const v4u w = {pk2(s[t][2 * j][0], s[t][2 * j][1]), pk2(s[t][2 * j][2], s[t][2 * j][3]), pk2(s[t][2 * j + 1][0], s[t][2 * j + 1][1]), pk2(s[t][2 * j + 1][2], s[t][2 * j + 1][3])};
                    pf[t][j] = __builtin_bit_cast(bf16x8, w); } }
            { bf16x8 vfb[4][2];
              __builtin_amdgcn_sched_barrier(0);
#pragma unroll
              for (int dt = 0; dt < 4; ++dt)
#pragma unroll
                  for (int j = 0; j < 2; ++j) { const LAS unsigned char* vp = Vt + (32 * j + 4 * fq + q4) * AT_PITCH + (16 * (dt + 4) + 4 * p4) * 2;
                      const v2u lo = tr_read(vp), hi = tr_read(vp + 16 * AT_PITCH); vfb[dt][j] = __builtin_bit_cast(bf16x8, (v4u){lo.x, lo.y, hi.x, hi.y}); }
              __builtin_amdgcn_sched_barrier(0);
#pragma unroll
              for (int dt = 0; dt < 4; ++dt)
#pragma unroll
                  for (int j = 0; j < 2; ++j) { o[0][dt] = __builtin_amdgcn_mfma_f32_16x16x32_bf16(vfa[dt][j], pf[0][j], o[0][dt], 0, 0, 0); o[1][dt] = __builtin_amdgcn_mfma_f32_16x16x32_bf16(vfa[dt][j], pf[1][j], o[1][dt], 0, 0, 0); }
              __builtin_amdgcn_sched_barrier(0);
#pragma unroll
              for (int dt = 0; dt < 4; ++dt)
#pragma unroll
                  for (int j = 0; j < 2; ++j) { o[0][dt + 4] = __builtin_amdgcn_mfma_f32_16x16x32_bf16(vfb[dt][j], pf[0][j], o[0][dt + 4], 0, 0, 0); o[1][dt + 4] = __builtin_amdgcn_mfma_f32_16x16x32_bf16(vfb[dt][j], pf[1][j], o[1][dt + 4], 0, 0, 0); }
            }
        }
        if (ti + 1 < ntile) lstore((ti + 1) & 1, stk, stv);
        __syncthreads();
    };
    for (int ti = 0; ti < ntile; ti += 2) { tile(ti, kr0, vr0, kr1, vr1); if (ti + 1 < ntile) tile(ti + 1, kr1, vr1, kr0, vr0); }
#pragma unroll
    for (int t = 0; t < 2; ++t) { float lt = lrun[t]; lt += __shfl_xor(lt, 16); lt += __shfl_xor(lt, 32);
        const float inv = 1.f / lt;
        bf16* Y = (bf16*)(ws + WS_YE) + (size_t)(b * SEQ + q0 + 32 * wave + 16 * t + fr) * 2048 + h * 128;
#pragma unroll
        for (int dt = 0; dt < 8; ++dt) { v2u w; w.x = pk2(o[t][dt][0] * inv, o[t][dt][1] * inv); w.y = pk2(o[t][dt][2] * inv, o[t][dt][3] * inv); *(v2u*)(Y + 16 * dt + 4 * fq) = w; } }
    __syncthreads();
}

__device__ __forceinline__ void mlstm_scan(const int wv) {
    const ArgsP a = get_args();
    OPAQUE_TID();
    unsigned char* ws = a->ws;
    const int gt = blockIdx.x * NTHR + tid, NGT = gridDim.x * NTHR;
    for (int idx = gt; idx < 16 * 256 * 32; idx += NGT) { const int bh = idx >> 13, rem = idx & 8191;
        const bf16* DC = (const bf16*)(ws + WS_DC) + (size_t)bh * 64 * 65536 + rem * 8; bf16* CP = (bf16*)(ws + WS_CP) + (size_t)bh * 64 * 65536 + rem * 8;
        const float* dec = (const float*)(ws + WS_DEC) + bh * 64;
        float C[8] = {0, 0, 0, 0, 0, 0, 0, 0};
        for (int c0 = 0; c0 < 64; c0 += 16) { v4u in[16];
#pragma unroll
            for (int j = 0; j < 16; ++j) in[j] = __builtin_nontemporal_load((const v4u*)(DC + (size_t)(c0 + j) * 65536));
#pragma unroll
            for (int j = 0; j < 16; ++j) { const float dc = dec[c0 + j];
                *(v4u*)(CP + (size_t)(c0 + j) * 65536) = (v4u){pk2(C[0], C[1]), pk2(C[2], C[3]), pk2(C[4], C[5]), pk2(C[6], C[7])};
                C[0] = fmaf(dc, C[0], bflo(in[j].x)); C[1] = fmaf(dc, C[1], bfhi(in[j].x)); C[2] = fmaf(dc, C[2], bflo(in[j].y)); C[3] = fmaf(dc, C[3], bfhi(in[j].y));
                C[4] = fmaf(dc, C[4], bflo(in[j].z)); C[5] = fmaf(dc, C[5], bfhi(in[j].z)); C[6] = fmaf(dc, C[6], bflo(in[j].w)); C[7] = fmaf(dc, C[7], bfhi(in[j].w)); } }
    }
    for (int idx = gt; idx < 16 * 256; idx += NGT) { const int bh = idx >> 8, d = idx & 255; const float* DN = (const float*)(ws + WS_DN) + (size_t)bh * 64 * 256 + d; float* NP = (float*)(ws + WS_NP) + (size_t)bh * 64 * 256 + d;
        const float* dec = (const float*)(ws + WS_DEC) + bh * 64; float n = 0.f;
        for (int c = 0; c < 64; ++c) { NP[c * 256] = n; n = fmaf(dec[c], n, DN[c * 256]); } }
}

constexpr int M3_PQ = 528, M3_PVv = 544, M3_PP = 144;
constexpr int M3_Q = 0, M3_K = 64 * M3_PQ, M3_V = 2 * 64 * M3_PQ, M3_P = M3_V + 64 * M3_PVv, M3_F = M3_P + 64 * M3_PP;
__device__ __forceinline__ void mlstm_out_unit(const int wv, LAS unsigned char* lds, int e_, int b, int h, int c) {
    const ArgsP a = get_args();
    OPAQUE_TID(); const int lane = tid & 63, wave = wv, fr = lane & 15, fq = lane >> 4, q4 = (lane >> 2) & 3, p4 = lane & 3;
    unsigned char* ws = a->ws;
    const int bh = b * 4 + h, m0 = b * SEQ + 64 * c;
    const bf16* QKB = (const bf16*)(ws + WS_QKB); const bf16* Z = (const bf16*)(ws + WS_Z);
    LAS unsigned char* Qt = lds + M3_Q; LAS unsigned char* Kt = lds + M3_K; LAS unsigned char* Vt = lds + M3_V; LAS unsigned char* Pm = lds + M3_P;
    LAS float* F = (LAS float*)(lds + M3_F); LAS float* bt = F; LAS float* itv = F + 64; LAS float* ebt = F + 128; LAS float* den = F + 192; LAS float* rstd = F + 256; LAS float* np = F + 320; LAS float* rsp = F + 576;
    { const int sr = tid >> 3, seg = tid & 7;
      const v4u* qs = (const v4u*)(QKB + (size_t)(m0 + sr) * 2048 + h * 256 + 32 * seg); const v4u* ks = (const v4u*)(QKB + (size_t)(m0 + sr) * 2048 + 1024 + h * 256 + 32 * seg);
      const v4u* vs = (const v4u*)(Z + (size_t)(m0 + sr) * ZW + 5120 + h * 256 + 32 * seg);
#pragma unroll
      for (int j = 0; j < 4; ++j) { *(LAS v4u*)(Qt + sr * M3_PQ + (32 * seg + 8 * j) * 2) = qs[j]; *(LAS v4u*)(Kt + sr * M3_PQ + (32 * seg + 8 * j) * 2) = ks[j]; *(LAS v4u*)(Vt + sr * M3_PVv + (32 * seg + 8 * j) * 2) = vs[j]; }
      if (tid < 64) { const float bb = ((const float*)(ws + WS_BC))[(size_t)bh * SEQ + 64 * c + tid]; bt[tid] = bb; ebt[tid] = __expf(bb); itv[tid] = ((const float*)(ws + WS_IG))[(size_t)bh * SEQ + 64 * c + tid]; }
      else if (tid < 320) np[tid - 64] = ((const float*)(ws + WS_NP))[((size_t)bh * 64 + c) * 256 + tid - 64]; }
    v4u cf[8][2];
    { const bf16* CP = (const bf16*)(ws + WS_CP) + ((size_t)bh * 64 + c) * 65536 + (size_t)(32 * wave + fr) * 256 + 8 * fq;
#pragma unroll
      for (int kk = 0; kk < 8; ++kk)
#pragma unroll
          for (int et = 0; et < 2; ++et) cf[kk][et] = *(const v4u*)(CP + et * 16 * 256 + 32 * kk); }
    __syncthreads();
    { const int ss = wave >> 1;
#pragma unroll
      for (int ti = 0; ti < 2; ++ti) { const int tt = 2 * (wave & 1) + ti; f32x4 sacc = {0.f, 0.f, 0.f, 0.f};
#pragma unroll
          for (int kk = 0; kk < 8; ++kk) { const bf16x8 kf = *(const LAS bf16x8*)(Kt + (16 * ss + fr) * M3_PQ + (32 * kk + 8 * fq) * 2), qf = *(const LAS bf16x8*)(Qt + (16 * tt + fr) * M3_PQ + (32 * kk + 8 * fq) * 2);
              sacc = __builtin_amdgcn_mfma_f32_16x16x32_bf16(kf, qf, sacc, 0, 0, 0); }
          const int t = 16 * tt + fr; const float btv = bt[t]; float pv[4];
#pragma unroll
          for (int r = 0; r < 4; ++r) { const int s_ = 16 * ss + 4 * fq + r; pv[r] = (s_ <= t) ? sacc[r] * __expf(btv - bt[s_] + itv[s_]) * 0.0625f : 0.f; }
          *(LAS v2u*)(Pm + t * M3_PP + (16 * ss + 4 * fq) * 2) = (v2u){pk2(pv[0], pv[1]), pk2(pv[2], pv[3])}; } }
    float qn;
    { const int t = tid >> 3, part = tid & 7; float sacc = 0.f;
#pragma unroll
      for (int j = 0; j < 4; ++j) { const v4u w = *(const LAS v4u*)(Qt + t * M3_PQ + (32 * part + 8 * j) * 2); const LAS float* nn = np + 32 * part + 8 * j;
          sacc += bflo(w.x) * nn[0] + bfhi(w.x) * nn[1] + bflo(w.y) * nn[2] + bfhi(w.y) * nn[3] + bflo(w.z) * nn[4] + bfhi(w.z) * nn[5] + bflo(w.w) * nn[6] + bfhi(w.w) * nn[7]; }
      sacc += dppf<0xB1>(sacc); sacc += dppf<0x4E>(sacc); sacc += dppf<0x141>(sacc); qn = sacc; }
    __syncthreads();
    { const int t = tid >> 3, part = tid & 7; const v4u w = *(const LAS v4u*)(Pm + t * M3_PP + part * 16);
      float ps = bflo(w.x) + bfhi(w.x) + bflo(w.y) + bfhi(w.y) + bflo(w.z) + bfhi(w.z) + bflo(w.w) + bfhi(w.w);
      ps += dppf<0xB1>(ps); ps += dppf<0x4E>(ps); ps += dppf<0x141>(ps);
      if (part == 0) den[t] = ebt[t] * qn + ps; }
    f32x4 acc[4][2];
#pragma unroll
    for (int tt = 0; tt < 4; ++tt) { acc[tt][0] = (f32x4){0.f, 0.f, 0.f, 0.f}; acc[tt][1] = (f32x4){0.f, 0.f, 0.f, 0.f}; }
#pragma unroll
    for (int kk = 0; kk < 8; ++kk)
#pragma unroll
        for (int tt = 0; tt < 4; ++tt) { const bf16x8 qf = *(const LAS bf16x8*)(Qt + (16 * tt + fr) * M3_PQ + (32 * kk + 8 * fq) * 2);
            acc[tt][0] = __builtin_amdgcn_mfma_f32_16x16x32_bf16(qf, __builtin_bit_cast(bf16x8, cf[kk][0]), acc[tt][0], 0, 0, 0);
            acc[tt][1] = __builtin_amdgcn_mfma_f32_16x16x32_bf16(qf, __builtin_bit_cast(bf16x8, cf[kk][1]), acc[tt][1], 0, 0, 0); }
#pragma unroll
    for (int tt = 0; tt < 4; ++tt) { const f32x4 eb = *(const LAS f32x4*)(ebt + 16 * tt + 4 * fq); acc[tt][0] *= eb; acc[tt][1] *= eb; }
#pragma unroll
    for (int j = 0; j < 2; ++j) { bf16x8 vf[2];
#pragma unroll
        for (int et = 0; et < 2; ++et) { const LAS unsigned char* p = Vt + (32 * j + 8 * fq + q4) * M3_PVv + (32 * wave + 16 * et + 4 * p4) * 2;
            const v2u lo = tr_read(p), hi = tr_read(p + 4 * M3_PVv); vf[et] = __builtin_bit_cast(bf16x8, (v4u){lo.x, lo.y, hi.x, hi.y}); }
#pragma unroll
        for (int tt = 0; tt < 4; ++tt) { const bf16x8 pf = *(const LAS bf16x8*)(Pm + (16 * tt + fr) * M3_PP + (32 * j + 8 * fq) * 2);
            acc[tt][0] = __builtin_amdgcn_mfma_f32_16x16x32_bf16(pf, vf[0], acc[tt][0], 0, 0, 0); acc[tt][1] = __builtin_amdgcn_mfma_f32_16x16x32_bf16(pf, vf[1], acc[tt][1], 0, 0, 0); } }
    __syncthreads();
    LAS unsigned char* Ht = Qt;
#pragma unroll
    for (int tt = 0; tt < 4; ++tt) { const f32x4 dn = *(const LAS f32x4*)(den + 16 * tt + 4 * fq); float ssq[4];
#pragma unroll
        for (int r = 0; r < 4; ++r) { const float dv = __builtin_amdgcn_rcpf(fmaxf(fabsf(dn[r]), 1.f)); const float h0 = acc[tt][0][r] * dv, h1 = acc[tt][1][r] * dv; ssq[r] = red16(h0 * h0 + h1 * h1);
            const int t = 16 * tt + 4 * fq + r;
            *(LAS bf16*)(Ht + t * M3_PQ + (32 * wave + fr) * 2) = (bf16)f2bf(h0); *(LAS bf16*)(Ht + t * M3_PQ + (32 * wave + 16 + fr) * 2) = (bf16)f2bf(h1); }
        if (fr == 0) *(LAS f32x4*)(rsp + wave * 64 + 16 * tt + 4 * fq) = (f32x4){ssq[0], ssq[1], ssq[2], ssq[3]}; }
    __syncthreads();
    if (tid < 64) { float tot = 0.f;
#pragma unroll
        for (int w = 0; w < 8; ++w) tot += rsp[w * 64 + tid];
        rstd[tid] = 1.f / sqrtf(tot * (1.f / 256.f) + 1e-6f); }
    __syncthreads();
    { const int t = tid >> 3, seg = tid & 7; const float rs = rstd[t]; const float* hg = a->in[5] + (size_t)e_ * 1024 + h * 256 + 32 * seg;
      const v4u* os = (const v4u*)(Z + (size_t)(m0 + t) * ZW + 6144 + h * 256 + 32 * seg); v4u* yd = (v4u*)((bf16*)(ws + WS_YE) + (size_t)(m0 + t) * 2048 + 1024 + h * 256 + 32 * seg);
#pragma unroll
      for (int j = 0; j < 4; ++j) { const v4u hw = *(const LAS v4u*)(Ht + t * M3_PQ + (32 * seg + 8 * j) * 2), ow = os[j]; const f32x4 g0 = *(const f32x4*)(hg + 8 * j), g1 = *(const f32x4*)(hg + 8 * j + 4);
          yd[j] = (v4u){pk2(bflo(hw.x) * rs * g0.x * sigmoidf_(bflo(ow.x)), bfhi(hw.x) * rs * g0.y * sigmoidf_(bfhi(ow.x))), pk2(bflo(hw.y) * rs * g0.z * sigmoidf_(bflo(ow.y)), bfhi(hw.y) * rs * g0.w * sigmoidf_(bfhi(ow.y))),
                        pk2(bflo(hw.z) * rs * g1.x * sigmoidf_(bflo(ow.z)), bfhi(hw.z) * rs * g1.y * sigmoidf_(bfhi(ow.z))), pk2(bflo(hw.w) * rs * g1.z * sigmoidf_(bflo(ow.w)), bfhi(hw.w) * rs * g1.w * sigmoidf_(bfhi(ow.w)))}; } }
    __syncthreads();
}

__device__ __forceinline__ void odd_prep(const int wv, int o) {
    const ArgsP a = get_args();
#ifdef NO_OPREP
    return;
#endif
    OPAQUE_TID(); const int lane = tid & 63, wave = tid >> 6;
    unsigned char* ws = a->ws;
    const float* mu = a->in[7] + (size_t)o * 6 * 2048;
    bf16* XR = (bf16*)(ws + WS_XRKV); bf16* XK = XR + (size_t)T_ * 2048; bf16* XV = XK + (size_t)T_ * 2048; bf16* XC = (bf16*)(ws + WS_XC);
    const int gw = blockIdx.x * NWAVES + wave, NGW = gridDim.x * NWAVES;
    for (int m = gw; m < T_; m += NGW) { const bool first = (m % SEQ) == 0;
        const f32x4* xr = (const f32x4*)(a->out + (size_t)m * D_) + lane; const f32x4* xp = (const f32x4*)(a->out + (size_t)(m - 1) * D_) + lane;
#pragma unroll
        for (int j = 0; j < 8; ++j) { const f32x4 x = xr[64 * j]; f32x4 p = {0.f, 0.f, 0.f, 0.f}; if (!first) p = xp[64 * j]; const f32x4 dx = p - x;
            const f32x4 m0 = ((const f32x4*)mu)[lane + 64 * j], m2 = ((const f32x4*)(mu + 2 * 2048))[lane + 64 * j], m3 = ((const f32x4*)(mu + 3 * 2048))[lane + 64 * j];
            const f32x4 r = x + dx * m0, k = x + dx * m2, v = x + dx * m3; const size_t off = (size_t)m * 2048 + 4 * (lane + 64 * j);
            *(v2u*)(XR + off) = (v2u){pk2(r.x, r.y), pk2(r.z, r.w)}; *(v2u*)(XK + off) = (v2u){pk2(k.x, k.y), pk2(k.z, k.w)}; *(v2u*)(XV + off) = (v2u){pk2(v.x, v.y), pk2(v.z, v.w)};
            const size_t offc = (size_t)m * 4096 + 4 * (lane + 64 * j);
            *(v2u*)(XC + offc) = (v2u){pk2(x.x, x.y), pk2(x.z, x.w)}; *(v2u*)(XC + offc + 2048) = (v2u){pk2(dx.x, dx.y), pk2(dx.z, dx.w)}; }
    }
}

constexpr int RK_KQ = 0, RK_RQ = 4096, RK_TAB = 8192, RK_XU = 9216, RK_W4 = 17408, RK_VB = 19456, RK_CBUF = 27648;
constexpr int RK_PB0 = 3 * RK_CBUF, RK_PG = 0, RK_PV = 4096, RK_PBON = 8192, RK_PBSZ = 8320;
constexpr int RK_Y0 = RK_PB0 + 4 * RK_PBSZ, RK_YSZ = 64 * 36 * 4;
constexpr int RK_XS = RK_Y0 + 2 * RK_YSZ;
constexpr int RK_ZERO = RK_XS + 16384;
static_assert(RK_ZERO + 8192 <= RING_BYTES, "rwkv LDS map");
__device__ __forceinline__ float dot16(const f32x4 x, const f32x4 y) { return red16(x.x * y.x + x.y * y.y + x.z * y.z + x.w * y.w); }
__device__ __forceinline__ v2u pk4(const f32x4 v) { return (v2u){pk2(v.x, v.y), pk2(v.z, v.w)}; }
__device__ __forceinline__ f32x4 unpk4(const v2u w) { return (f32x4){bflo(w.x), bfhi(w.x), bflo(w.y), bfhi(w.y)}; }

template <bool DRY = false> __device__ __forceinline__ void rwkv_unit(const int wv, LAS unsigned char* lds, int o, int b, int h) {
    const ArgsP a = get_args();
#ifdef NO_RWKV
    return;
#endif
    OPAQUE_TID(); const int lane = tid & 63, fr = lane & 15, fq = lane >> 4;
    unsigned char* ws = a->ws;
    constexpr int NCH = SEQ / 32;
    for (int i = tid; i < 8192 / 16; i += NTHR) *(LAS v4u*)(lds + RK_ZERO + 16 * i) = (v4u){0u, 0u, 0u, 0u};
    if (wv < 4) {
        f32x4 S[4];
#pragma unroll
        for (int kt = 0; kt < 4; ++kt) S[kt] = (f32x4){0.f, 0.f, 0.f, 0.f};
        const int row = 16 * wv + fr;
        const bool f0 = fq == 0;
        struct Ops { v2u kq[4], rq[4]; f32x4 tab[8], vv, w4[4]; v4u xu[4]; };
        auto load_ops = [&](const LAS unsigned char* B, const LAS unsigned char* xb, int bk, Ops& o) {
            const LAS unsigned char* kp = B + RK_KQ + bk * 512 + (fr & 3) * 128 + 8 * fq; const LAS unsigned char* rp = kp + (RK_RQ - RK_KQ);
#pragma unroll
            for (int ks = 0; ks < 2; ++ks) { o.kq[2 * ks] = *(const LAS v2u*)(kp + 64 * ks); o.kq[2 * ks + 1] = *(const LAS v2u*)(kp + 64 * ks + 32); o.rq[2 * ks] = *(const LAS v2u*)(rp + 64 * ks); o.rq[2 * ks + 1] = *(const LAS v2u*)(rp + 64 * ks + 32); }
#pragma unroll
            for (int i = 0; i < 8; ++i) o.tab[i] = *(const LAS f32x4*)(B + RK_TAB + bk * 128 + 16 * i);
            o.vv = *(const LAS f32x4*)(B + RK_VB + bk * 1024 + row * 16);
#pragma unroll
            for (int kt = 0; kt < 4; ++kt) { o.w4[kt] = *(const LAS f32x4*)(B + RK_W4 + bk * 256 + (16 * kt + 4 * fq) * 4); o.xu[kt] = *(const LAS v4u*)(xb + bk * 1024 + (16 * kt + fr) * 16); } };
        auto step = [&](const Ops& o, f32x4& yout) {
            bf16x8 ys[2];
#pragma unroll
            for (int ks = 0; ks < 2; ++ks) { const v4u w = {pk2(S[2 * ks][0], S[2 * ks][1]), pk2(S[2 * ks][2], S[2 * ks][3]), pk2(S[2 * ks + 1][0], S[2 * ks + 1][1]), pk2(S[2 * ks + 1][2], S[2 * ks + 1][3])}; ys[ks] = __builtin_bit_cast(bf16x8, w); }
            f32x4 du = {0.f, 0.f, 0.f, 0.f}, dy = {0.f, 0.f, 0.f, 0.f};
#pragma unroll
            for (int ks = 0; ks < 2; ++ks) {
                du = __builtin_amdgcn_mfma_f32_16x16x32_bf16(__builtin_bit_cast(bf16x8, (v4u){o.kq[2 * ks].x, o.kq[2 * ks].y, o.kq[2 * ks + 1].x, o.kq[2 * ks + 1].y}), ys[ks], du, 0, 0, 0);
                dy = __builtin_amdgcn_mfma_f32_16x16x32_bf16(__builtin_bit_cast(bf16x8, (v4u){o.rq[2 * ks].x, o.rq[2 * ks].y, o.rq[2 * ks + 1].x, o.rq[2 * ks + 1].y}), ys[ks], dy, 0, 0, 0); }
            const f32x4 t0 = o.tab[0], t1 = o.tab[1], t2 = o.tab[2], t3 = o.tab[3], t4 = o.tab[4], t5 = o.tab[5], t6 = o.tab[6], t7 = o.tab[7]; const f32x4 vv = o.vv;
#define FMA_(a, b, c) ([](float x_, float y_, float z_) { float r_; asm("v_fma_f32 %0, %1, %2, %3" : "=v"(r_) : "v"(x_), "v"(y_), "v"(z_)); return r_; }((a), (b), (c)))
#define FNMA_(a, b, c) ([](float x_, float y_, float z_) { float r_; asm("v_fma_f32 %0, -%1, %2, %3" : "=v"(r_) : "v"(x_), "v"(y_), "v"(z_)); return r_; }((a), (b), (c)))
            const float u0 = du[0] + 0.f * vv.x;
            float a1_ = fmaf(vv.x, t0.x, du[1]);
            float a2_ = FMA_(vv.y, t0.w, fmaf(vv.x, t0.z, du[2]));
            float a3_ = FMA_(vv.z, t2.x, FMA_(vv.y, t1.w, fmaf(vv.x, t1.z, du[3])));
            float b0_ = fmaf(vv.x, t3.x, dy[0]);
            float b1_ = FMA_(vv.y, t3.w, fmaf(vv.x, t3.z, dy[1]));
            float b2_ = FMA_(vv.z, t5.x, FMA_(vv.y, t4.w, fmaf(vv.x, t4.z, dy[2])));
            float b3_ = FMA_(vv.w, t6.w, FMA_(vv.z, t6.z, FMA_(vv.y, t6.y, fmaf(vv.x, t6.x, dy[3]))));
            const float u1 = FNMA_(u0, t0.y, a1_);
            a2_ = FNMA_(u0, t1.x, a2_); a3_ = FNMA_(u0, t2.y, a3_); b0_ = FNMA_(u0, t3.y, b0_); b1_ = FNMA_(u0, t4.x, b1_); b2_ = FNMA_(u0, t5.y, b2_); b3_ = FNMA_(u0, t7.x, b3_);
            const float u2 = FNMA_(u1, t1.y, a2_);
            a3_ = FNMA_(u1, t2.z, a3_); b1_ = FNMA_(u1, t4.y, b1_); b2_ = FNMA_(u1, t5.z, b2_); b3_ = FNMA_(u1, t7.y, b3_);
            const float u3 = FNMA_(u2, t2.w, a3_);
            b2_ = FNMA_(u2, t5.w, b2_); b3_ = FNMA_(u2, t7.z, b3_);
            b3_ = FNMA_(u3, t7.w, b3_);
            yout.x = b0_; yout.y = b1_; yout.z = b2_; yout.w = b3_;
#undef FMA_
#undef FNMA_
            const bf16x8 yop = __builtin_bit_cast(bf16x8, (v4u){pk2(vv.x, vv.y), pk2(vv.z, vv.w), pk2(u0, u1), pk2(u2, u3)});
#pragma unroll
            for (int kt = 0; kt < 4; ++kt) S[kt] = __builtin_amdgcn_mfma_f32_16x16x32_bf16(__builtin_bit_cast(bf16x8, o.xu[kt]), yop, S[kt] * o.w4[kt], 0, 0, 0); };
        __syncthreads();
        __builtin_amdgcn_s_setprio(3);
#ifdef PROBE_RWKV
        float pacc_iter = 0.f, pacc_comp = 0.f;
#endif
        for (int c = 0; c < NCH; ++c) {
            const LAS unsigned char* B = lds + (c % 3) * RK_CBUF; LAS float* yb = (LAS float*)(lds + RK_Y0 + (c & 1) * RK_YSZ) + row * 36;
            const LAS unsigned char* xb = f0 ? B + RK_XU : (const LAS unsigned char*)(lds + RK_ZERO);
            Ops oa, ob; f32x4 yk[8];
#ifdef PROBE_RWKV
            const unsigned long long pt0 = __builtin_amdgcn_s_memtime();
#endif
            load_ops(B, xb, 0, oa);
#pragma unroll
            for (int bp = 0; bp < 4; ++bp) { load_ops(B, xb, 2 * bp + 1, ob); step(oa, yk[2 * bp]); if (bp < 3) load_ops(B, xb, 2 * bp + 2, oa); step(ob, yk[2 * bp + 1]); }
            if (f0) {
#pragma unroll
                for (int bk = 0; bk < 8; ++bk) *(LAS f32x4*)(yb + 4 * bk) = yk[bk]; }
#ifdef PROBE_RWKV
            const unsigned long long pt1 = __builtin_amdgcn_s_memtime();
#endif
            __syncthreads();
#ifdef PROBE_RWKV
            { const unsigned long long pt2 = __builtin_amdgcn_s_memtime();
              if (c >= 8) { pacc_iter += (float)(pt2 - pt0); pacc_comp += (float)(pt1 - pt0); }
              if (c == NCH - 1 && o == 1 && blockIdx.x == 0 && wv == 0 && lane == 0) { float* pw = (float*)(ws + WS_CTL) + 200000;
                  pw[0] = __expf(rintf(__logf(pacc_iter * (1.f / 120.f)) * 20.f) * 0.05f); pw[1] = __expf(rintf(__logf(pacc_comp * (1.f / 120.f)) * 20.f) * 0.05f); } }
#endif
        }
        __builtin_amdgcn_s_setprio(0);
    } else {
        const int pr = (wv - 4) >> 1, w2 = (wv - 4) & 1, ptid = w2 * 64 + lane, g8 = ptid >> 4, kq = ptid & 15;
        const size_t ub = ((size_t)b * SEQ * 2048 + h * 64) * 2;
        const char* Rs = (const char*)(ws + WS_RKV) + ub; const char* Ks = Rs + (size_t)T_ * 2048 * 2; const char* Vs = Ks + (size_t)T_ * 2048 * 2;
        const char* Gs = (const char*)(ws + WS_G) + ub; const char* WDs = (const char*)(ws + WS_WD) + ub; const char* AAs = (const char*)(ws + WS_AA) + ub;
        const unsigned lvo = (unsigned)(4 * kq + 4 * g8 * 2048) * 2u;
        const int pc = h * 64 + 4 * kq;
        const f32x4 p_kk = *(const f32x4*)(a->in[20] + (size_t)o * 2048 + pc), p_ka = *(const f32x4*)(a->in[21] + (size_t)o * 2048 + pc), p_rk = *(const f32x4*)(a->in[22] + (size_t)o * 2048 + pc);
        v2u gk[4], ga[4], gw[4], gr[4], gv[4], gg[4];
        auto gload = [&](int c) {
            const size_t co = (size_t)c * (32 * 2048 * 2);
            typedef const __attribute__((address_space(1))) char* gptr; typedef const __attribute__((address_space(1))) v2u* gv2;
            gptr k_ = (gptr)(Ks + co); gptr a_ = (gptr)(AAs + co); gptr w_ = (gptr)(WDs + co); gptr r_ = (gptr)(Rs + co); gptr v_ = (gptr)(Vs + co); gptr g_ = (gptr)(Gs + co);
            asm volatile("" : "+s"(k_), "+s"(a_), "+s"(w_), "+s"(r_), "+s"(v_), "+s"(g_));
#pragma unroll
            for (int j = 0; j < 4; ++j) { const unsigned off = lvo + (unsigned)j * 4096u;
                gk[j] = *(gv2)(k_ + off); ga[j] = *(gv2)(a_ + off); gw[j] = *(gv2)(w_ + off); gr[j] = *(gv2)(r_ + off); gv[j] = *(gv2)(v_ + off); gg[j] = *(gv2)(g_ + off); } };
        f32x4 kh3, bb3, hh0, hh1, hh2, hh3, bh0, bh1, bh2, bh3, W4;
        auto partA = [&](int c) {
            LAS unsigned char* B = lds + (c % 3) * RK_CBUF; LAS unsigned char* P = lds + RK_PB0 + (c & 3) * RK_PBSZ;
            f32x4 kk[4], bbv[4], kh[4], w[4], r[4], v[4];
#pragma unroll
            for (int j = 0; j < 4; ++j) { const f32x4 k = unpk4(gk[j]), aa = unpk4(ga[j]), wd = unpk4(gw[j]); r[j] = unpk4(gr[j]); v[j] = unpk4(gv[j]);
                const f32x4 kx = k * p_kk; const float inv = __builtin_amdgcn_rsqf(fmaxf(dot16(kx, kx), 1e-24f)); kk[j] = kx * inv; bbv[j] = kk[j] * aa; kh[j] = k * (1.f + (aa - 1.f) * p_ka);
                w[j] = (f32x4){__expf(wd.x), __expf(wd.y), __expf(wd.z), __expf(wd.w)};
                const float bon = dot16(r[j] * kh[j], p_rk);
                *(LAS v2u*)(P + RK_PG + ((4 * g8 + j) * 64 + 4 * kq) * 2) = gg[j];
                if (kq == 0) *(LAS float*)(P + RK_PBON + (4 * g8 + j) * 4) = bon; }
            const f32x4 W1 = w[0], W2 = w[0] * w[1], W3 = W2 * w[2]; W4 = W3 * w[3];
            const f32x4 i1 = {__builtin_amdgcn_rcpf(W1.x), __builtin_amdgcn_rcpf(W1.y), __builtin_amdgcn_rcpf(W1.z), __builtin_amdgcn_rcpf(W1.w)}, i2 = {__builtin_amdgcn_rcpf(W2.x), __builtin_amdgcn_rcpf(W2.y), __builtin_amdgcn_rcpf(W2.z), __builtin_amdgcn_rcpf(W2.w)},
                        i3 = {__builtin_amdgcn_rcpf(W3.x), __builtin_amdgcn_rcpf(W3.y), __builtin_amdgcn_rcpf(W3.z), __builtin_amdgcn_rcpf(W3.w)}, i4 = {__builtin_amdgcn_rcpf(W4.x), __builtin_amdgcn_rcpf(W4.y), __builtin_amdgcn_rcpf(W4.z), __builtin_amdgcn_rcpf(W4.w)};
            hh0 = kh[0] * i1; hh1 = kh[1] * i2; hh2 = kh[2] * i3; hh3 = kh[3] * i4; bh0 = bbv[0] * i1; bh1 = bbv[1] * i2; bh2 = bbv[2] * i3; bh3 = bbv[3] * i4; kh3 = kh[3]; bb3 = bbv[3];
            *(LAS v2u*)(B + RK_KQ + g8 * 512 + 0 * 128 + 8 * kq) = pk4(kk[0]);      *(LAS v2u*)(B + RK_RQ + g8 * 512 + 0 * 128 + 8 * kq) = pk4(r[0] * W1);
            *(LAS v2u*)(B + RK_KQ + g8 * 512 + 1 * 128 + 8 * kq) = pk4(kk[1] * W1); *(LAS v2u*)(B + RK_RQ + g8 * 512 + 1 * 128 + 8 * kq) = pk4(r[1] * W2);
            *(LAS v2u*)(B + RK_KQ + g8 * 512 + 2 * 128 + 8 * kq) = pk4(kk[2] * W2); *(LAS v2u*)(B + RK_RQ + g8 * 512 + 2 * 128 + 8 * kq) = pk4(r[2] * W3);
            *(LAS v2u*)(B + RK_KQ + g8 * 512 + 3 * 128 + 8 * kq) = pk4(kk[3] * W3); *(LAS v2u*)(B + RK_RQ + g8 * 512 + 3 * 128 + 8 * kq) = pk4(r[3] * W4);
            *(LAS f32x4*)(B + RK_W4 + g8 * 256 + 16 * kq) = W4;
#pragma unroll
            for (int j = 0; j < 4; ++j) *(LAS v2u*)(P + RK_PV + ((4 * g8 + j) * 64 + 4 * kq) * 2) = gv[j];
#pragma unroll
            for (int i = 0; i < 4; ++i) *(LAS f32x4*)(B + RK_VB + g8 * 1024 + (4 * kq + i) * 16) = (f32x4){v[0][i], v[1][i], v[2][i], v[3][i]};
        };
        auto partB = [&](int c) {
            LAS unsigned char* B = lds + (c % 3) * RK_CBUF;
            { LAS unsigned char* xs = lds + RK_XS + (wv - 4) * 4096 + (lane >> 4) * 1024 + 8 * kq;
              *(LAS v2u*)(xs + 0 * 128) = pk4(hh0); *(LAS v2u*)(xs + 1 * 128) = pk4(hh1); *(LAS v2u*)(xs + 2 * 128) = pk4(hh2); *(LAS v2u*)(xs + 3 * 128) = pk4(hh3);
              *(LAS v2u*)(xs + 4 * 128) = pk4(bh0); *(LAS v2u*)(xs + 5 * 128) = pk4(bh1); *(LAS v2u*)(xs + 6 * 128) = pk4(bh2); *(LAS v2u*)(xs + 7 * 128) = pk4(bh3); }
            { const f32x4 hw0 = hh0 * W4, hw1 = hh1 * W4, hw2 = hh2 * W4, hw3 = kh3, bw0 = bh0 * W4, bw1 = bh1 * W4, bw2 = bh2 * W4, bw3 = bb3;
#pragma unroll
              for (int i = 0; i < 4; ++i) *(LAS v4u*)(B + RK_XU + g8 * 1024 + (4 * kq + i) * 16) = (v4u){pk2(hw0[i], hw1[i]), pk2(hw2[i], hw3[i]), pk2(-bw0[i], -bw1[i]), pk2(-bw2[i], -bw3[i])};
            }
            asm volatile("s_waitcnt lgkmcnt(0)" ::: "memory");
#pragma unroll
            for (int p = 0; p < 2; ++p) { const int grp = 2 * p + (fr >> 3), rw = fr & 7, blk = 4 * w2 + grp;
                const LAS unsigned char* xp = lds + RK_XS + (wv - 4) * 4096 + grp * 1024 + rw * 128 + 16 * fq;
                const LAS unsigned char* yp = B + ((rw < 4) ? RK_KQ + blk * 512 + rw * 128 : RK_RQ + blk * 512 + (rw - 4) * 128) + 16 * fq;
                f32x4 d = {0.f, 0.f, 0.f, 0.f};
                d = __builtin_amdgcn_mfma_f32_16x16x32_bf16(*(const LAS bf16x8*)xp, *(const LAS bf16x8*)yp, d, 0, 0, 0);
                d = __builtin_amdgcn_mfma_f32_16x16x32_bf16(*(const LAS bf16x8*)(xp + 64), *(const LAS bf16x8*)(yp + 64), d, 0, 0, 0);
                if ((fr >> 3) == (fq >> 1) && rw >= 1) { const int cnt = (rw < 4) ? rw : rw - 3; const int base = (rw == 1) ? 0 : (rw == 2) ? 2 : (rw == 3) ? 6 : (rw == 4) ? 12 : (rw == 5) ? 14 : (rw == 6) ? 18 : 24;
                    LAS float* tp = (LAS float*)(B + RK_TAB + blk * 128) + base + (fq & 1) * cnt;
                    tp[0] = d[0]; if (cnt > 1) tp[1] = d[1]; if (cnt > 2) tp[2] = d[2]; if (cnt > 3) tp[3] = d[3]; } }
            asm volatile("" ::: "memory");
        };
        const int st = ptid >> 2, rq = ptid & 3;
        bf16* Yb = (bf16*)(ws + WS_YO) + (size_t)b * SEQ * 2048 + h * 64 + 16 * rq;
        const float* lg = a->in[23] + (size_t)o * 2048 + h * 64 + 16 * rq; const float* lb = a->in[24] + (size_t)o * 2048 + h * 64 + 16 * rq;
        auto post = [&](int c) {
            const LAS float* yb = (const LAS float*)(lds + RK_Y0 + (c & 1) * RK_YSZ); const LAS unsigned char* P = lds + RK_PB0 + (c & 3) * RK_PBSZ;
            float y[16]; float s1 = 0.f;
#pragma unroll
            for (int i = 0; i < 16; ++i) { y[i] = yb[(16 * rq + i) * 36 + st]; s1 += y[i]; }
            s1 += dppf<0xB1>(s1); s1 += dppf<0x4E>(s1); const float mean = s1 * (1.f / 64.f); float s2 = 0.f;
#pragma unroll
            for (int i = 0; i < 16; ++i) { y[i] -= mean; s2 += y[i] * y[i]; }
            s2 += dppf<0xB1>(s2); s2 += dppf<0x4E>(s2); const float rstd = __builtin_amdgcn_rsqf(s2 * (1.f / 64.f) + 64e-5f);
            const float bon = *(const LAS float*)(P + RK_PBON + st * 4);
            unsigned ow[8];
#pragma unroll
            for (int i4 = 0; i4 < 4; ++i4) { const f32x4 g = unpk4(*(const LAS v2u*)(P + RK_PG + (st * 64 + 16 * rq + 4 * i4) * 2)), vq = unpk4(*(const LAS v2u*)(P + RK_PV + (st * 64 + 16 * rq + 4 * i4) * 2));
                const f32x4 lgv = *(const f32x4*)(lg + 4 * i4), lbv = *(const f32x4*)(lb + 4 * i4); float o4[4];
#pragma unroll
                for (int i = 0; i < 4; ++i) o4[i] = (y[4 * i4 + i] * rstd * lgv[i] + lbv[i] + bon * vq[i]) * g[i];
                ow[2 * i4] = pk2(o4[0], o4[1]); ow[2 * i4 + 1] = pk2(o4[2], o4[3]); }
            v4u* dst = (v4u*)(Yb + (size_t)(32 * c + st) * 2048); dst[0] = (v4u){ow[0], ow[1], ow[2], ow[3]}; dst[1] = (v4u){ow[4], ow[5], ow[6], ow[7]};
        };
        if (!DRY) { gload(pr); partA(pr); gload(pr + 2); partB(pr); }
        __syncthreads();
        for (int c = 0; c < NCH; ++c) {
            if (!DRY) {
            if ((c & 1) == pr) { if (c + 2 < NCH) { partA(c + 2); if (c + 4 < NCH) gload(c + 4); } }
            else { if (c >= 1 && c + 1 < NCH) partB(c + 1); if (c >= 1) post(c - 1); } }
            __syncthreads();
        }
        if (!DRY && pr == 0) post(NCH - 1);
    }
    __syncthreads();
}

template <bool DRY = false> __device__ __forceinline__ void ln_router(const int wv, int l) {
    const ArgsP a = get_args();
#ifdef NO_ROUTER
    return;
#endif
    OPAQUE_TID(); const int lane = tid & 63, wave = tid >> 6;
    unsigned char* ws = a->ws;
    const float* lg = a->in[28] + (size_t)l * 2048; const float* lb = a->in[29] + (size_t)l * 2048;
    const float* bg = a->in[33] + l * 4; const float* be = a->in[35] + l * 32;
    const f32x4* RW = (const f32x4*)(ws + WS_RW) + (size_t)l * 9 * 2048;
    unsigned* cnt = (unsigned*)(ws + WS_CTL) + CW_CNT + (size_t)l * 32 * 64;
    int* TOKE = (int*)(ws + WS_TOKE); int* TOKR = (int*)(ws + WS_TOKR); float* TOKG = (float*)(ws + WS_TOKG);
    const int gw = blockIdx.x * NWAVES + wave, NGW = gridDim.x * NWAVES;
    const unsigned lo = (unsigned)lane * 16u;
    typedef const __attribute__((address_space(1))) char* gcp; typedef const __attribute__((address_space(1))) f32x4* gf4;
    v2u xnx[8];
    { const v2u* xr0 = (const v2u*)((const bf16*)(ws + WS_XSUM) + (size_t)gw * D_) + lane;
#pragma unroll
      for (int j = 0; j < 8; ++j) xnx[j] = (gw < T_) ? xr0[64 * j] : (v2u){0u, 0u}; }
#pragma unroll 1
    for (int m = gw; m < T_; m += NGW) {
        f32x4 v[8]; float s = 0.f;
#pragma unroll
        for (int j = 0; j < 8; ++j) { const v2u w_ = xnx[j]; v[j] = (f32x4){bflo(w_.x), bfhi(w_.x), bflo(w_.y), bfhi(w_.y)}; s += (v[j].x + v[j].y) + (v[j].z + v[j].w); }
        if (m + NGW < T_) { const v2u* xr = (const v2u*)((const bf16*)(ws + WS_XSUM) + (size_t)(m + NGW) * D_) + lane;
#pragma unroll
            for (int j = 0; j < 8; ++j) xnx[j] = xr[64 * j]; }
        const float mean = wave_sum(s) * (1.f / D_); float s2 = 0.f;
#pragma unroll
        for (int j = 0; j < 8; ++j) { v[j] = v[j] - mean; s2 += (v[j].x * v[j].x + v[j].y * v[j].y) + (v[j].z * v[j].z + v[j].w * v[j].w); }
        const float rstd = 1.f / sqrtf(wave_sum(s2) * (1.f / D_) + LN_EPS);
        float ag[4] = {0, 0, 0, 0};
#pragma unroll
        for (int j = 0; j < 8; ++j) { const f32x4 g = ((const f32x4*)lg)[lane + 64 * j], bb = ((const f32x4*)lb)[lane + 64 * j]; v[j] = v[j] * rstd * g + bb;
            ((v2u*)XIN(a, l))[(size_t)m * 512 + lane + 64 * j] = (v2u){pk2(v[j].x, v[j].y), pk2(v[j].z, v[j].w)};
            gcp wp = (gcp)((const char*)RW + j * 4096); asm volatile("" : "+s"(wp));
#pragma unroll
            for (int i = 0; i < 4; ++i) { const f32x4 w = *(gf4)(wp + i * 1024 + lo); const float x = v[j][i]; ag[0] += x * w.x; ag[1] += x * w.y; ag[2] += x * w.z; ag[3] += x * w.w; } }
#pragma unroll
        for (int i = 0; i < 4; ++i) ag[i] = wave_sum(ag[i]) + bg[i];
        int gi = 0; float gm = ag[0];
#pragma unroll
        for (int i = 1; i < 4; ++i) if (ag[i] > gm) { gm = ag[i]; gi = i; }
        float gs = 0.f;
#pragma unroll
        for (int i = 0; i < 4; ++i) gs += __expf(ag[i] - gm);
        const float gp = 1.f / gs;
        float ae[8] = {0, 0, 0, 0, 0, 0, 0, 0};
        const int gis = __builtin_amdgcn_readfirstlane(gi);
#pragma unroll
        for (int j = 0; j < 8; ++j) {
            gcp we0 = (gcp)((const char*)RW + (size_t)(1 + 2 * gis) * 32768 + j * 4096); asm volatile("" : "+s"(we0)); gcp we1 = we0 + 32768; asm volatile("" : "+s"(we1));
#pragma unroll
            for (int i = 0; i < 4; ++i) { const f32x4 w0 = *(gf4)(we0 + i * 1024 + lo), w1 = *(gf4)(we1 + i * 1024 + lo); const float x = v[j][i];
                ae[0] += x * w0.x; ae[1] += x * w0.y; ae[2] += x * w0.z; ae[3] += x * w0.w; ae[4] += x * w1.x; ae[5] += x * w1.y; ae[6] += x * w1.z; ae[7] += x * w1.w; } }
#pragma unroll
        for (int i = 0; i < 8; ++i) ae[i] = wave_sum(ae[i]) + be[8 * gi + i];
        int e1 = 0; float m1 = ae[0];
#pragma unroll
        for (int i = 1; i < 8; ++i) if (ae[i] > m1) { m1 = ae[i]; e1 = i; }
        int e2 = -1; float m2 = -3.0e38f;
#pragma unroll
        for (int i = 0; i < 8; ++i) if (i != e1 && ae[i] > m2) { m2 = ae[i]; e2 = i; }
        const float p2 = __expf(m2 - m1), den = 1.f / (1.f + p2);
        if (!DRY && lane == 0) { const int x1 = 8 * gi + e1, x2 = 8 * gi + e2;
            const unsigned r1 = __hip_atomic_fetch_add(cnt + x1 * 64, 1u, __ATOMIC_RELAXED, __HIP_MEMORY_SCOPE_AGENT);
            const unsigned r2 = __hip_atomic_fetch_add(cnt + x2 * 64, 1u, __ATOMIC_RELAXED, __HIP_MEMORY_SCOPE_AGENT);
            { int* LIST = (int*)(ws + WS_LIST); LIST[x1 * 16384 + (int)r1] = m; LIST[x2 * 16384 + (int)r2] = m; }
            TOKE[2 * m] = x1; TOKE[2 * m + 1] = x2; TOKR[2 * m] = (int)r1; TOKR[2 * m + 1] = (int)r2; TOKG[2 * m] = gp * den; TOKG[2 * m + 1] = gp * p2 * den; }
    }
}

struct MoeTab { LAS int* start; LAS int* tileE; LAS int* ntiles; LAS int* cntv; };
__device__ __forceinline__ MoeTab moe_tables(const int wv, int l, LAS unsigned char* lds) {
    const ArgsP a = get_args();
    MoeTab t; t.start = (LAS int*)(lds + MISC_OFF + 256); t.tileE = t.start + 40; t.ntiles = t.tileE + 168; t.cntv = t.ntiles + 8;
    OPAQUE_TID();
    if (wv == 0) { unsigned* cnt = (unsigned*)(a->ws + WS_CTL) + CW_CNT + (size_t)l * 32 * 64; const int e = tid & 31;
        const int c = (int)__hip_atomic_load(cnt + e * 64, __ATOMIC_RELAXED, __HIP_MEMORY_SCOPE_AGENT); const int pad = (c + 255) & ~255;
        int inc = pad;
#pragma unroll
        for (int d = 1; d < 32; d <<= 1) { const int v = __shfl_up(inc, d, 32); if (e >= d) inc += v; }
        if ((tid & 63) < 32) { const int st = inc - pad; t.start[e] = st; t.cntv[e] = c;
            int q1 = inc >> 8; if (q1 > MOE_TILES) q1 = MOE_TILES;
            for (int q = st >> 8; q < q1; ++q) t.tileE[q] = e;
            if (e == 31) *t.ntiles = q1; } }
    __syncthreads();
    return t;
}
__device__ __forceinline__ void moe_gather(const int wv, const MoeTab& tb) {
    const ArgsP a = get_args();
#ifdef NO_GATHER
    return;
#endif
    OPAQUE_TID(); const int lane = tid & 63, wave = tid >> 6;
    unsigned char* ws = a->ws;
    const int* TOKE = (const int*)(ws + WS_TOKE); const int* TOKR = (const int*)(ws + WS_TOKR); int* SLOT = (int*)(ws + WS_SLOT);
    const int gw = blockIdx.x * NWAVES + wave, NGW = gridDim.x * NWAVES;
    for (int it = gw; it < 2 * T_; it += NGW) { const int m = it >> 1; const int dest = tb.start[TOKE[it]] + TOKR[it];
        if (lane == 0) SLOT[it] = dest;
        const v4u* src = (const v4u*)(ws + WS_XB) + (size_t)m * 256 + lane; v4u* dst = (v4u*)(ws + WS_XS) + (size_t)dest * 256 + lane;
#pragma unroll
        for (int j = 0; j < 4; ++j) dst[64 * j] = src[64 * j]; }
}
template <int NJ> struct MoeOrder {
    LAS int* tileE; int nunits, G, c;
    __device__ bool next(int i, pg8::Unit& u) const {
        const int nt = nunits / NJ, x = c & 7, r = c >> 3, nx = G >> 3;
        const int t0 = (x * nt) >> 3, t1 = ((x + 1) * nt) >> 3, q = i * nx + r;
        if (q >= (t1 - t0) * NJ) return false;
        u.pm = t0 + q / NJ; u.pn = tileE[u.pm] * NJ + (q % NJ); u.aoff = 0; return true; }
    __device__ __forceinline__ void a_ready(const pg8::Unit&) const {}
    __device__ __forceinline__ void done(const pg8::Unit&) const {}
};
template <int NJ> struct MoeOrderG {
    LAS int* tileE; LAS int* start; LAS int* cntv; const int* list; int nunits, G, c; int ilo, ihi;
    __device__ bool next(int i_, pg8::Unit& u) const {
        const int i = i_ + ilo; if (i >= ihi) return false;
        const int nt = nunits / NJ, x = c & 7, r = c >> 3, nx = G >> 3;
        const int t0 = (x * nt) >> 3, t1 = ((x + 1) * nt) >> 3, q = i * nx + r;
        if (q >= (t1 - t0) * NJ) return false;
        u.pm = t0 + q / NJ; u.pn = tileE[u.pm] * NJ + (q % NJ); u.aoff = 0; return true; }
    __device__ __forceinline__ void gather_voff(const pg8::Unit& u, int R0, int C0, int R1, int C1, int lda, unsigned (&v)[2][2]) const {
        const int e = tileE[u.pm], roff = u.pm * 256 - start[e], cnt = cntv[e]; const int* le = list + e * 16384;
#pragma unroll
        for (int hh = 0; hh < 2; ++hh) { const int r0 = roff + 128 * hh + R0, r1 = roff + 128 * hh + R1;
            const int t0 = (r0 < cnt) ? le[r0] : 0, t1 = (r1 < cnt) ? le[r1] : 0;
            v[hh][0] = (unsigned)(t0 * lda + C0) * 2u; v[hh][1] = (unsigned)(t1 * lda + C1) * 2u; } }
    __device__ __forceinline__ void a_ready(const pg8::Unit&) const {}
    __device__ __forceinline__ void done(const pg8::Unit&) const {}
};
struct MoeOrderDn {
    LAS int* tileE; int ntiles, G, c, mode, KB;
    __device__ __forceinline__ void split(int& t0, int& ntx, int& busy, int& nB) const {
        const int x = c & 7, nx = G >> 3; t0 = (x * ntiles) >> 3; ntx = (((x + 1) * ntiles) >> 3) - t0;
        busy = ntx * 4 - 2 * nx; busy = busy < 0 ? 0 : (busy > nx ? nx : busy);
        const int cA = ntx < (nx >> 1) ? ntx : (nx >> 1);
        nB = KB * (nx - busy); if (nB > cA * 8) nB = cA * 8; }
    __device__ bool third_round() const { int t0, ntx, busy, nB; split(t0, ntx, busy, nB); return (c >> 3) < busy; }
    __device__ bool next(int i, pg8::Unit& u) const {
        int t0, ntx, busy, nB; split(t0, ntx, busy, nB); const int r = c >> 3, nx = G >> 3; int idx;
        if (mode == 0) { if (r < busy || i >= KB) return false; idx = i * (nx - busy) + (r - busy); if (idx >= nB) return false; }
        else { idx = nB + i * nx + r; if (idx >= ntx * 8) return false; }
        u.pm = t0 + (idx >> 3); u.pn = tileE[u.pm] * 8 + (idx & 7); u.aoff = 0; return true; }
    __device__ __forceinline__ void a_ready(const pg8::Unit&) const {}
    __device__ __forceinline__ void done(const pg8::Unit&) const {}
};
template <bool FUSE_ODD> __device__ __forceinline__ void moe_combine_ln(const int wv, int l) {
    const ArgsP a = get_args();
#ifdef NO_COMBINE
    return;
#endif
    OPAQUE_TID(); const int lane = tid & 63, wave = tid >> 6;
    unsigned char* ws = a->ws;
    const float* lg = a->in[30] + (size_t)l * 2048; const float* lb = a->in[31] + (size_t)l * 2048;
    const int* TOKE = (const int*)(ws + WS_TOKE); const int* TOKR = (const int*)(ws + WS_TOKR); const float* TOKG = (const float*)(ws + WS_TOKG); const bf16* YS = (const bf16*)(ws + WS_YS);
    const int gw = blockIdx.x * NWAVES + wave, NGW = gridDim.x * NWAVES;
    int mystart = 0;
    { unsigned* cnt = (unsigned*)(ws + WS_CTL) + CW_CNT + (size_t)l * 32 * 64; const int e = lane & 31;
      const int c = (int)__hip_atomic_load(cnt + e * 64, __ATOMIC_RELAXED, __HIP_MEMORY_SCOPE_AGENT); const int pad = (c + 255) & ~255;
      int inc = pad;
#pragma unroll
      for (int d = 1; d < 32; d <<= 1) { const int v = __shfl_up(inc, d, 32); if (e >= d) inc += v; }
      mystart = inc - pad; }
    const float* mu = FUSE_ODD ? a->in[7] + (size_t)((l + 1) >> 1) * 6 * 2048 : nullptr;
    bf16* XR = (bf16*)(ws + WS_XRKV); bf16* XK = XR + (size_t)T_ * 2048; bf16* XV = XK + (size_t)T_ * 2048; bf16* XC = (bf16*)(ws + WS_XC);
    const int nrows = FUSE_ODD ? 9 : 1;
    for (int base = FUSE_ODD ? gw * 8 : gw; base < T_; base += FUSE_ODD ? NGW * 8 : NGW) {
        f32x4 prev[8];
#pragma unroll 1
        for (int rr = 0; rr < nrows; ++rr) {
            const int m = FUSE_ODD ? base - 1 + rr : base;
            const bool halo = FUSE_ODD && rr == 0;
            if (halo && (base % SEQ) == 0) {
#pragma unroll
                for (int j = 0; j < 8; ++j) prev[j] = (f32x4){0.f, 0.f, 0.f, 0.f};
                continue; }
            const v2u* xr = (const v2u*)(XIN(a, l) + (size_t)m * D_) + lane; f32x4 v[8]; float s = 0.f;
            const int e0 = TOKE[2 * m], e1 = TOKE[2 * m + 1];
            const int s0 = __shfl(mystart, e0) + TOKR[2 * m], s1 = __shfl(mystart, e1) + TOKR[2 * m + 1]; const float g0 = TOKG[2 * m], g1 = TOKG[2 * m + 1];
            const v2u* y0 = (const v2u*)(YS + (size_t)s0 * 2048) + lane; const v2u* y1 = (const v2u*)(YS + (size_t)s1 * 2048) + lane;
#pragma unroll
            for (int j = 0; j < 8; ++j) { const v2u xw_ = xr[64 * j]; const f32x4 x = {bflo(xw_.x), bfhi(xw_.x), bflo(xw_.y), bfhi(xw_.y)}; const v2u a0 = y0[64 * j], a1 = y1[64 * j];
                v[j].x = DN_ALPHA * x.x + g0 * bflo(a0.x) + g1 * bflo(a1.x); v[j].y = DN_ALPHA * x.y + g0 * bfhi(a0.x) + g1 * bfhi(a1.x);
                v[j].z = DN_ALPHA * x.z + g0 * bflo(a0.y) + g1 * bflo(a1.y); v[j].w = DN_ALPHA * x.w + g0 * bfhi(a0.y) + g1 * bfhi(a1.y);
                s += (v[j].x + v[j].y) + (v[j].z + v[j].w); }
            const float mean = wave_sum(s) * (1.f / D_); float s2 = 0.f;
#pragma unroll
            for (int j = 0; j < 8; ++j) { v[j] = v[j] - mean; s2 += (v[j].x * v[j].x + v[j].y * v[j].y) + (v[j].z * v[j].z + v[j].w * v[j].w); }
            const float rstd = 1.f / sqrtf(wave_sum(s2) * (1.f / D_) + LN_EPS);
#pragma unroll
            for (int j = 0; j < 8; ++j) { const f32x4 g = ((const f32x4*)lg)[lane + 64 * j], bb = ((const f32x4*)lb)[lane + 64 * j]; v[j] = v[j] * rstd * g + bb;
                if (!halo) { if (l == 3) ((f32x4*)(a->out + (size_t)m * D_))[lane + 64 * j] = v[j]; else ((v2u*)XOUT(a, l))[(size_t)m * 512 + lane + 64 * j] = (v2u){pk2(v[j].x, v[j].y), pk2(v[j].z, v[j].w)}; }
                if (FUSE_ODD) {
                    if (!halo) { const f32x4 x = v[j], dx = prev[j] - x;
                        const f32x4 m0 = ((const f32x4*)mu)[lane + 64 * j], m2 = ((const f32x4*)(mu + 2 * 2048))[lane + 64 * j], m3 = ((const f32x4*)(mu + 3 * 2048))[lane + 64 * j];
                        const f32x4 r = x + dx * m0, k = x + dx * m2, vv = x + dx * m3; const size_t off = (size_t)m * 2048 + 4 * (lane + 64 * j);
                        *(v2u*)(XR + off) = (v2u){pk2(r.x, r.y), pk2(r.z, r.w)}; *(v2u*)(XK + off) = (v2u){pk2(k.x, k.y), pk2(k.z, k.w)}; *(v2u*)(XV + off) = (v2u){pk2(vv.x, vv.y), pk2(vv.z, vv.w)};
                        *(v2u*)(XC + off) = (v2u){pk2(dx.x, dx.y), pk2(dx.z, dx.w)}; }
                    prev[j] = v[j]; } }
        }
    }
}

struct RkvOrder {
    pg8::StaticOrder in; int lo, n, G, c;
    __device__ bool next(int i, pg8::Unit& u) const { const long L = (long)lo + (long)i * G + c; if (L >= lo + n) return false; const int g = (int)(L / 512);
        in.at(L % 512, u); u.pm += 64 * g; u.pn += 8 * g; return true; }
    __device__ __forceinline__ void a_ready(const pg8::Unit&) const {}
    __device__ __forceinline__ void done(const pg8::Unit&) const {}
};
struct MergedOrder {
    pg8::StaticOrder in; const char *A0, *B0, *A1a, *A1b, *B1a, *B1b; int G, c;
    __device__ bool next(int i, pg8::Unit& u) const {
        int idx;
        if (G == 256) { if (c < 128) { if (i == 0) idx = -1 - c; else idx = (i - 1) * 128 + c; if (i > 5) return false; } else { idx = 640 + i * 128 + (c - 128); if (i > 6) return false; } }
        else { const int L = i * G + c; if (L >= 1664) return false; idx = (L < 128) ? -1 - L : L - 128; }
        if (idx < 0) { const int q = -1 - idx; u.pm = q & 63; u.pn = q >> 6; u.aoff = 1; return true; }
        const int g = idx / 512; in.at(idx % 512, u); u.pm += 64 * g; u.pn += 8 * g; u.aoff = 0; return true; }
    __device__ __forceinline__ void ptrs(const pg8::Unit& u, const char*& a, const char*& a2, const char*& b, const char*& b2, int& nt) const {
        const size_t ts = (size_t)256 * 2048 * 2;
        if (u.aoff == 0) { a = A0 + (size_t)u.pm * ts; b = B0 + (size_t)u.pn * ts; a2 = a; b2 = b; nt = 32; }
        else { a = A1a + (size_t)u.pm * ts; a2 = A1b + (size_t)u.pm * ts; b = B1a + (size_t)u.pn * ts; b2 = B1b + (size_t)u.pn * ts; nt = 64; } }
    __device__ __forceinline__ void a_ready(const pg8::Unit&) const {}
    __device__ __forceinline__ void done(const pg8::Unit&) const {}
};
struct L2Order {
    int nunits, G, c;
    __device__ bool next(int i, pg8::Unit& u) const { const int L = i * G + c; if (L >= nunits) return false; u.pn = L >> 6; u.pm = L & 63; u.aoff = (u.pn >= 8) ? 512 : 0; return true; }
    __device__ __forceinline__ void a_ready(const pg8::Unit&) const {}
    __device__ __forceinline__ void done(const pg8::Unit&) const {}
};


#ifndef REP_PROL
#define REP_PROL 1
#endif
#ifndef REP_INPROJ
#define REP_INPROJ 1
#endif
#ifndef REP_ATTN
#define REP_ATTN 1
#endif
#ifndef REP_MLSTM
#define REP_MLSTM 1
#endif
#ifndef REP_HNORM
#define REP_HNORM 1
#endif
#ifndef REP_OPREP
#define REP_OPREP 1
#endif
#ifndef REP_RKV
#define REP_RKV 1
#endif
#ifndef REP_RWKV
#define REP_RWKV 1
#endif
#ifndef REP_GATHER
#define REP_GATHER 1
#endif
#ifndef REP_GU
#define REP_GU 1
#endif
#ifndef REP_DN
#define REP_DN 1
#endif
#define REPX_1(...) __VA_ARGS__
#define REPX_2(...) __VA_ARGS__ __VA_ARGS__
#define REPX_3(...) __VA_ARGS__ __VA_ARGS__ __VA_ARGS__
#define REPX_(n, ...) REPX_##n(__VA_ARGS__)
#define REPX(n, ...) REPX_(n, __VA_ARGS__)

struct RangeOrder { pg8::StaticOrder S; int i0, cnt;
    __device__ bool next(int i, pg8::Unit& u) const { if (i >= cnt) return false; return S.next(i + i0, u); }
    __device__ __forceinline__ void a_ready(const pg8::Unit&) const {}
    __device__ __forceinline__ void done(const pg8::Unit&) const {}
};
constexpr int N_PHASES = 41;

__global__ void __launch_bounds__(NTHR, 2) fwd(Args args) {
    extern __shared__ __attribute__((aligned(16))) unsigned char lds_raw[];
    LAS unsigned char* lds = (LAS unsigned char*)lds_raw;
    const int wv = __builtin_amdgcn_readfirstlane((int)threadIdx.x >> 6);
    OPAQUE_TID();
    const ArgsP ap0 = get_args();
    if (tid < 16) ((LAS unsigned*)(lds + MISC_OFF))[tid] = 0u;
    __syncthreads();
#if ONE_LAUNCH
    XcdBarrier bar = xcd_barrier_post((unsigned*)(ap0->ws + WS_CTL) + CW_BAR, (volatile LAS unsigned*)(lds + MISC_OFF), tid == 0);
#define SEAM(k) do { if ((k) + 1 < hi) xcd_barrier(bar, tid == 0); } while (0)
#define SEAMR() xcd_barrier(bar, tid == 0)
#else
#define SEAM(k) do { } while (0)
#define SEAMR() do { } while (0)
#endif
    const int lo = ap0->ph_lo, hi = ap0->ph_hi;
#define IN(k) (lo <= (k) && (k) < hi)
    const int G = gridDim.x, cb = blockIdx.x;

    if (IN(0)) { REPX(REP_PROL, { prologue(wv, lds, 0); SEAMR(); }) }
#ifdef PROBE_BAR
    for (int pb_i = 0; pb_i < 20; ++pb_i) SEAMR();
#endif

    auto layer = [&](auto lc) __attribute__((always_inline)) { constexpr int l = decltype(lc)::value;
        const int pb = 1 + 10 * l, eo = l >> 1;
        if ((l & 1) == 0) {
            if (IN(pb + 0)) {
                const ArgsP ap = get_args(); unsigned char* ws = ap->ws;
                pg8::Gemm g{XIN(ap, l), (const bf16*)(ws + WS_WIN) + (size_t)eo * ZW * 2048, 2048, 2048, 2048};
                pg8::StaticOrder S; S.init(T_, ZW, G, cb);
                pg8::EpiBf16 E{(bf16*)(ws + WS_Z), ZW, 0, 0, 0, nullptr};
                if constexpr (l == 0) {
                    const int n0 = 2 * (cb & 3);
                    RangeOrder S0{S, 0, n0}, S1{S, n0, 1 << 20};
                    if (n0 > 0) { pg8::gemm_phase<pg8::EpiBf16, RangeOrder, true, false>(wv, lds, g, S0, E); __syncthreads(); }
                    prologue(wv, lds, 1); __syncthreads();
                    pg8::gemm_phase<pg8::EpiBf16, RangeOrder, true, false>(wv, lds, g, S1, E); SEAMR();
                } else {
                REPX(REP_INPROJ, { pg8::gemm_phase<pg8::EpiBf16, pg8::StaticOrder, true, false>(wv, lds, g, S, E); SEAMR(); }) }
#if defined(PROBE_NULLEPI)
                { pg8::EpiNull EN; pg8::gemm_phase<pg8::EpiNull, pg8::StaticOrder, true, false>(wv, lds, g, S, EN); SEAMR(); }
#endif
#if defined(PROBE_FULLREP)
                pg8::gemm_phase<pg8::EpiBf16, pg8::StaticOrder, true, false>(wv, lds, g, S, E); SEAMR();
#endif
#if defined(REP_EPAIR)
                for (int u = cb; u < 256; u += G) even_prep(wv, eo, lds, u); SEAMR();
                pg8::gemm_phase<pg8::EpiBf16, pg8::StaticOrder, true, false>(wv, lds, g, S, E); SEAMR();
#endif
            }
            if (IN(pb + 1)) { for (int u = cb; u < 256; u += G) even_prep(wv, eo, lds, u); SEAM(pb + 1); }
            if (IN(pb + 2)) {
                if (cb & 1) { REPX(REP_MLSTM, { mlstm_scan(wv); }) }
                REPX(REP_ATTN, { for (int L = cb; L < 512; L += G) { const int i = L >> 8, c = L & 255; const int qbk = (i & 1) ? (c >> 5) : (15 - (c >> 5)); const int bh = c & 31;
                    attn_unit(wv, lds, bh >> 3, bh & 7, qbk); } })
                if (!(cb & 1)) { REPX(REP_MLSTM, { mlstm_scan(wv); }) }
                SEAM(pb + 2);
            }
            if (IN(pb + 3)) { REPX(REP_HNORM, { for (int u = cb; u < 1024; u += G) mlstm_out_unit(wv, lds, eo, u >> 8, (u >> 6) & 3, u & 63); SEAMR(); }) }
        } else {
            if (IN(pb + 1)) {
                const ArgsP ap = get_args(); unsigned char* ws = ap->ws;
                pg8::Gemm g{nullptr, nullptr, 2048, 2048, 2048};
                MergedOrder S; S.in.init(T_, 2048, 1, 0); S.G = G; S.c = cb;
                S.A0 = (const char*)(ws + WS_XRKV); S.B0 = (const char*)((const bf16*)(ws + WS_WRKV) + (size_t)eo * 3 * 2048 * 2048);
                S.A1a = (const char*)XIN(ap, l); S.A1b = (const char*)(ws + WS_XC);
                S.B1a = (const char*)((const bf16*)(ws + WS_WL1) + (size_t)eo * 2 * 512 * 2048); S.B1b = S.B1a + (size_t)512 * 2048 * 2;
                pg8::EpiBf16 E{(bf16*)(ws + WS_RKV), 2048, 64, 8, (size_t)T_ * 2048, (eo == 0) ? (bf16*)(ws + WS_VF) : nullptr};
                pg8::EpiL1 E1{(bf16*)(ws + WS_L1)};
                REPX(REP_RKV, { pg8::gemm_phase_m<pg8::EpiBf16, pg8::EpiL1, MergedOrder, true, false>(wv, lds, g, S, E, E1); __syncthreads(); })
                SEAM(pb + 1);
            }
            if (IN(pb + 2)) {
                const ArgsP ap = get_args(); unsigned char* ws = ap->ws;
                pg8::Gemm g{(const bf16*)(ws + WS_L1), (const bf16*)(ws + WS_WL2) + (size_t)eo * 8192 * 256, 256, 512, 256};
                L2Order S{(eo == 0 ? 24 : 32) * 64, G, cb};
                pg8::EpiL2 E{(bf16*)(ws + WS_G), (bf16*)(ws + WS_WD), (bf16*)(ws + WS_AA), (bf16*)(ws + WS_RKV) + (size_t)2 * T_ * 2048, (const bf16*)(ws + WS_VF),
                             ap->in[12] + (size_t)eo * 2048, ap->in[15] + (size_t)eo * 2048, ap->in[25]};
                pg8::gemm_phase<pg8::EpiL2, L2Order, true, false>(wv, lds, g, S, E);
#if defined(REP_L2A)
                if (eo == 0) { SEAMR(); pg8::gemm_phase<pg8::EpiL2, L2Order, true, false>(wv, lds, g, S, E); }
#endif
                SEAM(pb + 2);
            }
            if (IN(pb + 3)) { REPX(REP_RWKV, { for (int u = cb; u < 128; u += G) rwkv_unit(wv, lds, eo, u >> 5, u & 31);
#ifdef PROBE_DRY
                for (int u = cb; u < 128; u += G) rwkv_unit<true>(wv, lds, eo, u >> 5, u & 31);
#endif
                if (MOE_PROLOGUE_LAYERS >= 4) { } else if (G > 128 && cb >= 128) moe_convert(wv, lds, (l == 1) ? 32 : 96, (l == 1) ? 96 : 128, cb - 128, G - 128);
                else if (G <= 128) moe_convert(wv, lds, (l == 1) ? 32 : 96, (l == 1) ? 96 : 128, cb, G);
                SEAMR(); }) }
        }
        if (IN(pb + 4)) {
            const bool ev = (l & 1) == 0; const ArgsP ap = get_args(); unsigned char* ws = ap->ws;
            pg8::Gemm g{(const bf16*)(ws + (ev ? WS_YE : WS_YO)), (const bf16*)(ws + (ev ? WS_WOUT : WS_WO)) + (size_t)eo * 2048 * 2048, 2048, 2048, 2048};
            pg8::StaticOrder S; S.init(T_, 2048, G, cb);
            pg8::EpiResid E{XIN(ap, l), (bf16*)(ws + WS_XSUM), 2048, DN_ALPHA};
            pg8::gemm_phase<pg8::EpiResid, pg8::StaticOrder, true, false>(wv, lds, g, S, E);
#if defined(REP_OUT)
            SEAMR(); pg8::gemm_phase<pg8::EpiResid, pg8::StaticOrder, true, false>(wv, lds, g, S, E);
#endif
            SEAM(pb + 4);
        }
        if (IN(pb + 5)) { ln_router(wv, l);
#ifdef PROBE_ROUTER
            SEAMR(); ln_router<true>(wv, l);
#endif
            SEAM(pb + 5); }
        if (IN(pb + 7)) { const MoeTab tb = moe_tables(wv, l, lds); const ArgsP ap = get_args(); unsigned char* ws = ap->ws;
            pg8::Gemm g{XIN(ap, l), (const bf16*)(ws + WS_WGU) + (size_t)l * 32 * 1024 * 2048, 2048, 2048, 2048};
            pg8::EpiSilu E{(bf16*)(ws + WS_HID)};
            { MoeOrderG<4> S{tb.tileE, tb.start, tb.cntv, (const int*)(ws + WS_LIST), *tb.ntiles * 4, G, cb, 0, 2};
              pg8::gemm_phase_g<pg8::EpiSilu, MoeOrderG<4>, true, false>(wv, lds, g, S, E); SEAMR(); }
            { pg8::Gemm gd{(const bf16*)(ws + WS_HID), (const bf16*)(ws + WS_WDN) + (size_t)l * 32 * 2048 * 512, 512, 512, 512};
              MoeOrderDn SD{tb.tileE, *tb.ntiles, G, cb, 0, 4};
              if (SD.third_round()) { MoeOrderG<4> S{tb.tileE, tb.start, tb.cntv, (const int*)(ws + WS_LIST), *tb.ntiles * 4, G, cb, 2, 1 << 20};
                  pg8::gemm_phase_g<pg8::EpiSilu, MoeOrderG<4>, true, false>(wv, lds, g, S, E); }
              else { pg8::EpiBf16 ED{(bf16*)(ws + WS_YS), 2048, 0, 8, 0, nullptr};
                  pg8::gemm_phase<pg8::EpiBf16, MoeOrderDn, true, false>(wv, lds, gd, SD, ED); }
              SEAMR(); }
        }
        if (IN(pb + 8)) { const MoeTab tb = moe_tables(wv, l, lds); const ArgsP ap = get_args(); unsigned char* ws = ap->ws;
            pg8::Gemm g{(const bf16*)(ws + WS_HID), (const bf16*)(ws + WS_WDN) + (size_t)l * 32 * 2048 * 512, 512, 512, 512};
            MoeOrderDn S{tb.tileE, *tb.ntiles, G, cb, 1, 4};
            pg8::EpiBf16 E{(bf16*)(ws + WS_YS), 2048, 0, 8, 0, nullptr};
            pg8::gemm_phase<pg8::EpiBf16, MoeOrderDn, true, false>(wv, lds, g, S, E); SEAMR();
        }
        if (IN(pb + 9)) { moe_combine_ln<(l & 1) == 0>(wv, l);
#if defined(REP_COMB)
            if ((l & 1) == 0) { SEAMR(); moe_combine_ln<(l & 1) == 0>(wv, l); }
#endif
            SEAM(pb + 9); }
#ifdef PROBE_RWKV
        if (l == 3 && IN(pb + 9) && cb == 0) { __syncthreads(); const ArgsP ap = get_args(); if (tid == 0) { asm volatile("s_waitcnt vmcnt(0)" ::: "memory"); const float* pw = (const float*)(ap->ws + WS_CTL) + 200000; ap->out[0] = pw[0]; ap->out[1] = pw[1]; } }
#endif
        };
    layer(std::integral_constant<int, 0>{}); layer(std::integral_constant<int, 1>{}); layer(std::integral_constant<int, 2>{}); layer(std::integral_constant<int, 3>{});
#undef IN
#undef SEAM
}

extern "C" void kernel_launch(void* const* d_in, const int* in_sizes, int n_in, void* d_out, int out_size, void* d_ws, size_t ws_size, hipStream_t stream) {
    static int grid = 0;
    if (grid == 0) {
        if (n_in != 39 || in_sizes[0] != T_ * D_ || out_size != T_ * D_ || ws_size < WS_END) {
            fprintf(stderr, "kernel_launch: unexpected problem: n_in %d in0 %d out %d ws %zu (need %zu)\n", n_in, n_in > 0 ? in_sizes[0] : -1, out_size, ws_size, (size_t)WS_END); grid = -1; return; }
        int dev = 0, cus = 0, per_cu = 0;
        if (hipGetDevice(&dev) != hipSuccess || hipDeviceGetAttribute(&cus, hipDeviceAttributeMultiprocessorCount, dev) != hipSuccess) { fprintf(stderr, "kernel_launch: device query failed\n"); grid = -1; return; }
        if (hipFuncSetAttribute((const void*)fwd, hipFuncAttributeMaxDynamicSharedMemorySize, LDS_BYTES) != hipSuccess) { fprintf(stderr, "kernel_launch: hipFuncSetAttribute failed\n"); grid = -1; return; }
        if (hipOccupancyMaxActiveBlocksPerMultiprocessor(&per_cu, (const void*)fwd, NTHR, LDS_BYTES) != hipSuccess || per_cu < 1)
            fprintf(stderr, "kernel_launch: note: occupancy query reports %d workgroups per CU\n", per_cu);
        (void)hipGetLastError();
        grid = cus;
    }
    if (grid < 0) return;
    if (hipMemsetAsync((char*)d_ws + WS_CTL, 0, CTL_ZERO_BYTES, stream) != hipSuccess) { fprintf(stderr, "kernel_launch: memset failed\n"); return; }
    Args a{};
    for (int i = 0; i < 39; ++i) a.in[i] = (const float*)d_in[i];
    a.out = (float*)d_out; a.ws = (unsigned char*)d_ws;
#if ONE_LAUNCH
    a.ph_lo = 0; a.ph_hi = N_PHASES;
    hipLaunchKernelGGL(fwd, dim3(grid), dim3(NTHR), LDS_BYTES, stream, a);
#else
    for (int p = 0; p < N_PHASES; ++p) { a.ph_lo = p; a.ph_hi = p + 1; hipLaunchKernelGGL(fwd, dim3(grid), dim3(NTHR), LDS_BYTES, stream, a); }
#endif
    const hipError_t le = hipPeekAtLastError();
    if (le != hipSuccess) fprintf(stderr, "kernel_launch: launch failed: %s\n", hipGetErrorName(le));
}
```

```cpp
#include <hip/hip_runtime.h>
#include <cstdio>
#include <cstdint>
#include <type_traits>

#ifndef ONE_LAUNCH
#define ONE_LAUNCH 1
#endif

#define LAS __attribute__((address_space(3)))
typedef unsigned short bf16;
typedef unsigned v4u __attribute__((ext_vector_type(4)));
typedef unsigned v2u __attribute__((ext_vector_type(2)));
typedef float f32x4 __attribute__((ext_vector_type(4)));
typedef float f32x2 __attribute__((ext_vector_type(2)));
typedef short bf16x8 __attribute__((ext_vector_type(8)));

__device__ __forceinline__ unsigned f2bf(float f) { unsigned u = __builtin_bit_cast(unsigned, f); return (u + 0x7fffu + ((u >> 16) & 1u)) >> 16; }
typedef __bf16 bf16x2_t __attribute__((ext_vector_type(2)));
__device__ __forceinline__ unsigned pk2(float lo, float hi) { const f32x2 v = {lo, hi}; return __builtin_bit_cast(unsigned, __builtin_convertvector(v, bf16x2_t)); }
__device__ __forceinline__ float bflo(unsigned w) { return __builtin_bit_cast(float, w << 16); }
__device__ __forceinline__ float bfhi(unsigned w) { return __builtin_bit_cast(float, w & 0xffff0000u); }
__device__ __forceinline__ float bf2f(bf16 h) { return __builtin_bit_cast(float, (unsigned)h << 16); }
__device__ __forceinline__ float sigmoidf_(float x) { return __builtin_amdgcn_rcpf(1.f + __expf(-x)); }
__device__ __forceinline__ float wave_sum(float v) {
#pragma unroll
    for (int o = 1; o < 64; o <<= 1) v += __shfl_xor(v, o);
    return v;
}
template <int CTRL> __device__ __forceinline__ float dppf(float x) { return __builtin_bit_cast(float, __builtin_amdgcn_mov_dpp(__builtin_bit_cast(int, x), CTRL, 0xf, 0xf, true)); }
__device__ __forceinline__ float red16(float x) { x += dppf<0xB1>(x); x += dppf<0x4E>(x); x += dppf<0x141>(x); x += dppf<0x128>(x); return x; }
__device__ __forceinline__ float max16(float x) { x = fmaxf(x, dppf<0xB1>(x)); x = fmaxf(x, dppf<0x4E>(x)); x = fmaxf(x, dppf<0x141>(x)); x = fmaxf(x, dppf<0x128>(x)); return x; }

__device__ __forceinline__ int lane_id_asm() { int l; asm volatile("v_mbcnt_lo_u32_b32 %0, -1, 0\n\tv_mbcnt_hi_u32_b32 %0, -1, %0" : "=v"(l)); return l; }
#define OPAQUE_TID() const int tid = wv * 64 + lane_id_asm()
typedef short v4i16_t __attribute__((ext_vector_type(4)));
__device__ __forceinline__ v2u tr_read(const LAS unsigned char* p) { return __builtin_bit_cast(v2u, __builtin_amdgcn_ds_read_tr16_b64_v4i16((LAS v4i16_t*)p)); }
#define LDS_WAIT() asm volatile("s_waitcnt lgkmcnt(0)" ::: "memory")
#define VM_WAIT() asm volatile("s_waitcnt vmcnt(0)" ::: "memory")

namespace pg8 {
#define PG8_LAS __attribute__((address_space(3)))
typedef unsigned short bf16_t;
typedef short bf16x8 __attribute__((ext_vector_type(8)));
typedef float f32x4 __attribute__((ext_vector_type(4)));
typedef unsigned u32x4 __attribute__((ext_vector_type(4)));
constexpr int BM = 256, BK = 64, HALF = 128, HTB = HALF * BK * 2  , STAGE_BYTES = 8 * HTB, NXCD = 8, WGM = 8;

__host__ __device__ __forceinline__ int lds_byte(int r, int c) { const int st = (r >> 4) * 2 + (c >> 5), rr = r & 15, cc = c & 31, ob = rr * 64 + cc * 2; return st * 1024 + (ob ^ (((ob >> 9) & 1) << 5)); }
__host__ __device__ __forceinline__ void stage_rc(int b, int& R, int& C) { const int st = b / 1024, sb = b % 1024, swz = sb ^ (((sb >> 9) & 1) << 5); R = (st >> 1) * 16 + swz / 64; C = (st & 1) * 32 + (swz % 64) / 2; }
__host__ __device__ __forceinline__ int perm32(int rho) { const int n = rho >> 4, i = rho & 15; return 8 * (i >> 2) + 4 * n + (i & 3); }

struct Unit { int pm, pn, aoff; };
struct Gemm { const bf16_t* A; const bf16_t* Bt; int K, lda, ldb; };

struct StaticOrder {
    int nM, nN, nwg, G, c;
    __device__ void init(int M, int N, int G_, int c_) { nM = M / BM; nN = N / BM; nwg = nM * nN; G = G_; c = c_; }
    __device__ bool next(int i, Unit& u) const { return at((long)i * G + c, u); }
    __device__ bool at(long L, Unit& u) const {
        if (L >= nwg) return false;
        int wgid = (int)L; { const int q = nwg / NXCD, r = nwg % NXCD, xcd = wgid % NXCD, off = wgid / NXCD; wgid = (xcd < r ? xcd * (q + 1) : r * (q + 1) + (xcd - r) * q) + off; }
        const int nig = WGM * nN, gid = wgid / nig, fm = gid * WGM, gsz = (nM - fm) < WGM ? (nM - fm) : WGM;
        u.pm = fm + ((wgid % nig) % gsz); u.pn = (wgid % nig) / gsz; u.aoff = 0; return true;
    }
    __device__ __forceinline__ void a_ready(const Unit&) const {}
    __device__ __forceinline__ void done(const Unit&) const {}
};

__device__ __forceinline__ unsigned cvt_pk_bf16(float lo, float hi) { return ::pk2(lo, hi); }

struct EpiNull {
    static constexpr bool PERM = true, AFTER_DRAIN = false;
    __device__ __forceinline__ void operator()(const f32x4 (&acc)[2][2][4][2], const Unit&, int, int, int, int) const {
#pragma unroll
        for (int a = 0; a < 2; ++a)
#pragma unroll
            for (int b = 0; b < 2; ++b)
#pragma unroll
                for (int m = 0; m < 4; ++m)
#pragma unroll
                    for (int n = 0; n < 2; ++n) asm volatile("" :: "v"(acc[a][b][m][n]));
    }
};
struct EpiBf16 {
    static constexpr bool PERM = true, AFTER_DRAIN = false;
    bf16_t* O; int ldc; int pm_mod, pn_mod; size_t gstride; bf16_t* O2;
    __device__ __forceinline__ void operator()(const f32x4 (&acc)[2][2][4][2], const Unit& u, int wr, int wc, int fr, int fq) const {
        const int g = pm_mod ? u.pm / pm_mod : 0;
        const int row0 = (u.pm - g * pm_mod) * BM + wr * 64 + fr;
        const int col0 = (pn_mod ? (u.pn % pn_mod) : u.pn) * BM + wc * 32 + 8 * fq;
        bf16_t* base = O + (size_t)g * gstride;
        bf16_t* base2 = (O2 && g == 2) ? O2 : nullptr;
#pragma unroll
        for (int ai = 0; ai < 2; ++ai)
#pragma unroll
            for (int m = 0; m < 4; ++m) { const size_t ro = (size_t)(row0 + ai * HALF + m * 16) * ldc + col0;
#pragma unroll
                for (int bj = 0; bj < 2; ++bj) { const f32x4 v0 = acc[ai][bj][m][0], v1 = acc[ai][bj][m][1];
                    u32x4 w; w.x = cvt_pk_bf16(v0[0], v0[1]); w.y = cvt_pk_bf16(v0[2], v0[3]); w.z = cvt_pk_bf16(v1[0], v1[1]); w.w = cvt_pk_bf16(v1[2], v1[3]);
                    *(u32x4*)(base + ro + bj * HALF) = w; if (base2) *(u32x4*)(base2 + ro + bj * HALF) = w; } }
    }
};
struct EpiResid {
    static constexpr bool PERM = true, AFTER_DRAIN = false;
    const bf16_t* X; bf16_t* S; int ldc; float alpha;
    __device__ __forceinline__ void operator()(const f32x4 (&acc)[2][2][4][2], const Unit& u, int wr, int wc, int fr, int fq) const {
        const int row0 = u.pm * BM + wr * 64 + fr, col0 = u.pn * BM + wc * 32 + 8 * fq;
#pragma unroll
        for (int ai = 0; ai < 2; ++ai)
#pragma unroll
            for (int m = 0; m < 4; ++m) { const size_t ro = (size_t)(row0 + ai * HALF + m * 16) * ldc + col0;
#pragma unroll
                for (int bj = 0; bj < 2; ++bj) { const u32x4 xw = *(const u32x4*)(X + ro + bj * HALF);
                    const f32x4 x0 = {__builtin_bit_cast(float, xw.x << 16), __builtin_bit_cast(float, xw.x & 0xffff0000u), __builtin_bit_cast(float, xw.y << 16), __builtin_bit_cast(float, xw.y & 0xffff0000u)};
                    const f32x4 x1 = {__builtin_bit_cast(float, xw.z << 16), __builtin_bit_cast(float, xw.z & 0xffff0000u), __builtin_bit_cast(float, xw.w << 16), __builtin_bit_cast(float, xw.w & 0xffff0000u)};
                    const f32x4 s0 = x0 * alpha + acc[ai][bj][m][0], s1 = x1 * alpha + acc[ai][bj][m][1];
                    u32x4 w; w.x = cvt_pk_bf16(s0[0], s0[1]); w.y = cvt_pk_bf16(s0[2], s0[3]); w.z = cvt_pk_bf16(s1[0], s1[1]); w.w = cvt_pk_bf16(s1[2], s1[3]);
                    *(u32x4*)(S + ro + bj * HALF) = w; } }
    }
};
struct EpiSilu {
    static constexpr bool PERM = true, AFTER_DRAIN = false;
    bf16_t* O;
    __device__ __forceinline__ void operator()(const f32x4 (&acc)[2][2][4][2], const Unit& u, int wr, int wc, int fr, int fq) const {
        const int row0 = u.pm * BM + wr * 64 + fr, col0 = (u.pn & 3) * 128 + wc * 32 + 8 * fq;
#pragma unroll
        for (int ai = 0; ai < 2; ++ai)
#pragma unroll
            for (int m = 0; m < 4; ++m) { bf16_t* rowp = O + (size_t)(row0 + ai * HALF + m * 16) * 512 + col0;
                float h[8];
#pragma unroll
                for (int n = 0; n < 2; ++n)
#pragma unroll
                    for (int e = 0; e < 4; ++e) { const float gt = acc[ai][0][m][n][e], up = acc[ai][1][m][n][e]; h[n * 4 + e] = gt * __builtin_amdgcn_rcpf(1.f + __expf(-gt)) * up; }
                u32x4 w; w.x = cvt_pk_bf16(h[0], h[1]); w.y = cvt_pk_bf16(h[2], h[3]); w.z = cvt_pk_bf16(h[4], h[5]); w.w = cvt_pk_bf16(h[6], h[7]);
                *(u32x4*)rowp = w; }
    }
};
struct EpiL1 {
    static constexpr bool PERM = true, AFTER_DRAIN = false;
    bf16_t* O;
    __device__ __forceinline__ void operator()(const f32x4 (&acc)[2][2][4][2], const Unit& u, int wr, int wc, int fr, int fq) const {
        const int row0 = u.pm * BM + wr * 64 + fr, col0 = u.pn * BM + wc * 32 + 8 * fq;
#pragma unroll
        for (int ai = 0; ai < 2; ++ai)
#pragma unroll
            for (int m = 0; m < 4; ++m) { bf16_t* rowp = O + (size_t)(row0 + ai * HALF + m * 16) * 512 + col0;
#pragma unroll
                for (int bj = 0; bj < 2; ++bj) { const int c = col0 + bj * HALF; float h[8];
#pragma unroll
                    for (int n = 0; n < 2; ++n)
#pragma unroll
                        for (int e = 0; e < 4; ++e) { const float v = acc[ai][bj][m][n][e];
                            h[n * 4 + e] = (c < 256) ? __builtin_amdgcn_rcpf(1.f + __expf(-v)) : ((c < 352) ? (1.f - 2.f * __builtin_amdgcn_rcpf(1.f + __expf(2.f * v))) : v); }
                    u32x4 w; w.x = cvt_pk_bf16(h[0], h[1]); w.y = cvt_pk_bf16(h[2], h[3]); w.z = cvt_pk_bf16(h[4], h[5]); w.w = cvt_pk_bf16(h[6], h[7]);
                    *(u32x4*)(rowp + bj * HALF) = w; } }
    }
};
template <int KIND> __device__ __forceinline__ void epi_l2(const f32x4 (&acc)[2][2][4][2], bf16_t* O, const bf16_t* VF, const float* pv, int row0, int col0) {
    float pr[2][8];
#pragma unroll
    for (int bj = 0; bj < 2; ++bj)
#pragma unroll
        for (int j = 0; j < 8; ++j) pr[bj][j] = (KIND == 0) ? 0.f : pv[col0 + bj * HALF + j];
#pragma unroll
    for (int ai = 0; ai < 2; ++ai)
#pragma unroll
        for (int m = 0; m < 4; ++m) { const size_t ro = (size_t)(row0 + ai * HALF + m * 16) * 2048 + col0;
#pragma unroll
            for (int bj = 0; bj < 2; ++bj) { float h[8];
#pragma unroll
                for (int n = 0; n < 2; ++n)
#pragma unroll
                    for (int e = 0; e < 4; ++e) h[n * 4 + e] = acc[ai][bj][m][n][e] + pr[bj][n * 4 + e];
                if (KIND == 1) {
#pragma unroll
                    for (int j = 0; j < 8; ++j) h[j] = -0.60653065971263342f * __builtin_amdgcn_rcpf(1.f + __expf(-h[j]));
                } else if (KIND == 2) {
#pragma unroll
                    for (int j = 0; j < 8; ++j) h[j] = __builtin_amdgcn_rcpf(1.f + __expf(-h[j]));
                } else if (KIND == 3) {
                    const u32x4 vv = *(const u32x4*)(O + ro + bj * HALF), vf = *(const u32x4*)(VF + ro + bj * HALF);
#pragma unroll
                    for (int j = 0; j < 4; ++j) { const unsigned a = vv[j], b = vf[j];
                        const float v0_ = __builtin_bit_cast(float, a << 16), v1_ = __builtin_bit_cast(float, a & 0xffff0000u);
                        const float f0_ = __builtin_bit_cast(float, b << 16), f1_ = __builtin_bit_cast(float, b & 0xffff0000u);
                        h[2 * j] = v0_ + (f0_ - v0_) * __builtin_amdgcn_rcpf(1.f + __expf(-h[2 * j])); h[2 * j + 1] = v1_ + (f1_ - v1_) * __builtin_amdgcn_rcpf(1.f + __expf(-h[2 * j + 1])); }
                }
                u32x4 w; w.x = cvt_pk_bf16(h[0], h[1]); w.y = cvt_pk_bf16(h[2], h[3]); w.z = cvt_pk_bf16(h[4], h[5]); w.w = cvt_pk_bf16(h[6], h[7]);
                *(u32x4*)(O + ro + bj * HALF) = w; } }
}
struct EpiL2 {
    static constexpr bool PERM = true, AFTER_DRAIN = false;
    bf16_t *G, *WD, *AA, *V; const bf16_t* VF; const float *w0, *a0, *v0;
    __device__ __forceinline__ void operator()(const f32x4 (&acc)[2][2][4][2], const Unit& u, int wr, int wc, int fr, int fq) const {
        const int kind = u.pn >> 3;
        const int row0 = u.pm * BM + wr * 64 + fr, col0 = (u.pn & 7) * BM + wc * 32 + 8 * fq;
        if (kind == 0) epi_l2<0>(acc, G, nullptr, nullptr, row0, col0);
        else if (kind == 1) epi_l2<1>(acc, WD, nullptr, w0, row0, col0);
        else if (kind == 2) epi_l2<2>(acc, AA, nullptr, a0, row0, col0);
        else epi_l2<3>(acc, V, VF, v0, row0, col0);
    }
};

template <class Epi, class Sched, bool ALIGN_EPI = false, bool SP2 = false>
__device__ __forceinline__ void gemm_phase(const int wv, PG8_LAS unsigned char* lds, const Gemm g, const Sched& S, const Epi& E) {
#ifdef NO_GEMM
    return;
#endif
    const int tid_o = wv * 64 + lane_id_asm();
    const int tid = tid_o, wid = __builtin_amdgcn_readfirstlane(tid >> 6), lane = tid & 63, wr = wid >> 2, wc = wid & 3, fr = lane & 15, fq = lane >> 4;
    const int K = g.K, nt = K / BK;
    unsigned voffA[2], voffB[2];
#pragma unroll
    for (int i = 0; i < 2; ++i) { int R, C; stage_rc(tid * 16 + i * 8192, R, C); const int Rb = Epi::PERM ? ((R & ~31) + perm32(R & 31)) : R;
        voffA[i] = (unsigned)(R * g.lda + C) * 2u; voffB[i] = (unsigned)(Rb * g.ldb + C) * 2u; }
    const size_t kstep = (size_t)(BK * 2);
    const size_t hstepA = (size_t)HALF * g.lda * 2, hstepB = (size_t)HALF * g.ldb * 2;
    const size_t tstepA = 2 * hstepA, tstepB = 2 * hstepB;
    const unsigned ldsw = (unsigned)wid * 1024u;
    const int aoff = lds_byte(wr * 64 + fr, fq * 8), boff = lds_byte(wc * 32 + fr, fq * 8);
#define PG8_SA(b, h) (((b) * 2 + (h)) * HTB)
#define PG8_SB(b, h) ((4 + (b) * 2 + (h)) * HTB)
#define PG8_STAGE(bufoff, gbase, voff) do { _Pragma("unroll") for (int _i = 0; _i < 2; ++_i) \
        __builtin_amdgcn_global_load_lds((const unsigned*)((const char*)(gbase) + (voff)[_i]), (PG8_LAS unsigned*)(lds + (bufoff) + ldsw + _i * 8192), 16, 0, 0); } while (0)
#define PG8_LDA(dst, b, h) do { _Pragma("unroll") for (int m = 0; m < 4; ++m) _Pragma("unroll") for (int k = 0; k < 2; ++k) dst[m][k] = *(const PG8_LAS bf16x8*)(lds + PG8_SA(b, h) + aoff + m * 2048 + k * 1024); } while (0)
#define PG8_LDB(dst, b, h) do { _Pragma("unroll") for (int n = 0; n < 2; ++n) _Pragma("unroll") for (int k = 0; k < 2; ++k) dst[n][k] = *(const PG8_LAS bf16x8*)(lds + PG8_SB(b, h) + boff + n * 2048 + k * 1024); } while (0)
#define PG8_MMA(ai, bj, At, Bt) do { __builtin_amdgcn_s_setprio(1); _Pragma("unroll") for (int m = 0; m < 4; ++m) _Pragma("unroll") for (int n = 0; n < 2; ++n) _Pragma("unroll") for (int k = 0; k < 2; ++k) \
        acc[ai][bj][m][n] = __builtin_amdgcn_mfma_f32_16x16x32_bf16(Bt[n][k], At[m][k], acc[ai][bj][m][n], 0, 0, 0); __builtin_amdgcn_s_setprio(0); } while (0)
#define PG8_WAIT_V(n) asm volatile("s_waitcnt vmcnt(" #n ")" ::: "memory")
#define PG8_WAIT_L(n) asm volatile("s_waitcnt lgkmcnt(" #n ")" ::: "memory")
#define PG8_BAR __builtin_amdgcn_s_barrier()
#define PG8_SCHED __builtin_amdgcn_sched_barrier(0)
    Unit cur, nxt; int ui = 0;
    if (!S.next(0, cur)) return;
    f32x4 acc[2][2][4][2];
#pragma unroll
    for (int a = 0; a < 2; ++a)
#pragma unroll
        for (int b = 0; b < 2; ++b)
#pragma unroll
            for (int m = 0; m < 4; ++m)
#pragma unroll
                for (int n = 0; n < 2; ++n) acc[a][b][m][n] = (f32x4){0.f, 0.f, 0.f, 0.f};
    bf16x8 At[4][2], B0[2][2], B1[2][2];
    const char* cA = (const char*)g.A + (size_t)cur.pm * tstepA + cur.aoff; const char* cB = (const char*)g.Bt + (size_t)cur.pn * tstepB;
    S.a_ready(cur);
    if constexpr (SP2) {
        PG8_STAGE(PG8_SB(0, 0), cB, voffB); PG8_STAGE(PG8_SB(0, 1), cB + hstepB, voffB); PG8_STAGE(PG8_SA(0, 0), cA, voffA); PG8_STAGE(PG8_SA(0, 1), cA + hstepA, voffA);
        if (wr == 1) PG8_BAR;
        PG8_WAIT_V(2); PG8_BAR;
        PG8_STAGE(PG8_SB(1, 0), cB + kstep, voffB); PG8_STAGE(PG8_SA(1, 0), cA + kstep, voffA); PG8_STAGE(PG8_SB(1, 1), cB + hstepB + kstep, voffB);
        PG8_WAIT_V(6); PG8_BAR;
    } else {
        PG8_STAGE(PG8_SB(0, 0), cB, voffB); PG8_STAGE(PG8_SA(0, 0), cA, voffA); PG8_STAGE(PG8_SB(0, 1), cB + hstepB, voffB); PG8_STAGE(PG8_SA(0, 1), cA + hstepA, voffA);
        if (wr == 1) PG8_BAR;
        PG8_WAIT_V(4); PG8_BAR;
        PG8_STAGE(PG8_SB(1, 0), cB + kstep, voffB); PG8_STAGE(PG8_SA(1, 0), cA + kstep, voffA); PG8_STAGE(PG8_SB(1, 1), cB + hstepB + kstep, voffB);
        PG8_WAIT_V(6); PG8_BAR;
    }
    for (;;) {
        const bool has_next = S.next(ui + 1, nxt);
        const char* nA = has_next ? (const char*)g.A + (size_t)nxt.pm * tstepA + nxt.aoff : cA; const char* nB = has_next ? (const char*)g.Bt + (size_t)nxt.pn * tstepB : cB;
        for (int t = 0; t < nt; t += 2) {
            const bool last = (t == nt - 2);
            const char* a1 = cA + (size_t)(t + 1) * kstep;
            const char* a2 = last ? nA : cA + (size_t)(t + 2) * kstep; const char* b2 = last ? nB : cB + (size_t)(t + 2) * kstep;
            const char* a3 = a2 + kstep; const char* b3 = b2 + kstep;
            if (last && has_next) S.a_ready(nxt);
            if constexpr (SP2) {
            PG8_LDB(B0, 0, 0); PG8_LDB(B1, 0, 1); PG8_SCHED; PG8_LDA(At, 0, 0); PG8_STAGE(PG8_SA(1, 1), a1 + hstepA, voffA);
            PG8_WAIT_V(8); PG8_WAIT_L(0); PG8_BAR; PG8_MMA(0, 0, At, B0); PG8_MMA(0, 1, At, B1); PG8_BAR; PG8_SCHED;
            PG8_LDA(At, 0, 1); PG8_STAGE(PG8_SB(0, 0), b2, voffB); PG8_STAGE(PG8_SB(0, 1), b2 + hstepB, voffB); PG8_STAGE(PG8_SA(0, 0), a2, voffA);
            PG8_WAIT_V(8); PG8_WAIT_L(0); PG8_BAR; PG8_MMA(1, 0, At, B0); PG8_MMA(1, 1, At, B1); PG8_BAR; PG8_SCHED;
            PG8_LDB(B0, 1, 0); PG8_LDB(B1, 1, 1); PG8_SCHED; PG8_LDA(At, 1, 0); PG8_STAGE(PG8_SA(0, 1), a2 + hstepA, voffA);
            PG8_WAIT_V(8); PG8_WAIT_L(0); PG8_BAR; PG8_MMA(0, 0, At, B0); PG8_MMA(0, 1, At, B1); PG8_BAR; PG8_SCHED;
            PG8_LDA(At, 1, 1); PG8_STAGE(PG8_SB(1, 0), b3, voffB); PG8_STAGE(PG8_SB(1, 1), b3 + hstepB, voffB); PG8_STAGE(PG8_SA(1, 0), a3, voffA);
            PG8_WAIT_V(8); PG8_WAIT_L(0); PG8_BAR; PG8_MMA(1, 0, At, B0); PG8_MMA(1, 1, At, B1); PG8_BAR; PG8_SCHED;
            } else {
            PG8_LDB(B0, 0, 0); PG8_SCHED; PG8_LDA(At, 0, 0); PG8_STAGE(PG8_SA(1, 1), a1 + hstepA, voffA);
            PG8_WAIT_L(8); PG8_BAR; PG8_WAIT_L(0); PG8_MMA(0, 0, At, B0); PG8_BAR; PG8_SCHED;
            PG8_LDB(B1, 0, 1); PG8_STAGE(PG8_SB(0, 0), b2, voffB);
            PG8_BAR; PG8_WAIT_L(0); PG8_MMA(0, 1, At, B1); PG8_BAR;
            PG8_LDA(At, 0, 1); PG8_STAGE(PG8_SA(0, 0), a2, voffA);
            PG8_BAR; PG8_WAIT_L(0); PG8_MMA(1, 0, At, B0); PG8_BAR; PG8_SCHED;
            PG8_STAGE(PG8_SB(0, 1), b2 + hstepB, voffB);
            PG8_WAIT_V(6); PG8_BAR; PG8_MMA(1, 1, At, B1); PG8_BAR;
            PG8_LDB(B0, 1, 0); PG8_SCHED; PG8_LDA(At, 1, 0); PG8_STAGE(PG8_SA(0, 1), a2 + hstepA, voffA);
            PG8_WAIT_L(8); PG8_BAR; PG8_WAIT_L(0); PG8_MMA(0, 0, At, B0); PG8_BAR; PG8_SCHED;
            PG8_LDB(B1, 1, 1); PG8_STAGE(PG8_SB(1, 0), b3, voffB);
            PG8_BAR; PG8_WAIT_L(0); PG8_MMA(0, 1, At, B1); PG8_BAR;
            PG8_LDA(At, 1, 1); PG8_STAGE(PG8_SA(1, 0), a3, voffA);
            PG8_BAR; PG8_WAIT_L(0); PG8_MMA(1, 0, At, B0); PG8_BAR; PG8_SCHED;
            PG8_STAGE(PG8_SB(1, 1), b3 + hstepB, voffB);
            PG8_WAIT_V(6); PG8_BAR; PG8_MMA(1, 1, At, B1); PG8_BAR;
            }
        }
        if constexpr (ALIGN_EPI) { if (wr == 0) PG8_BAR; }
        if constexpr (!Epi::AFTER_DRAIN) { E(acc, cur, wr, wc, fr, fq); S.done(cur); }
        if (!has_next) break;
#pragma unroll
        for (int a = 0; a < 2; ++a)
#pragma unroll
            for (int b = 0; b < 2; ++b)
#pragma unroll
                for (int m = 0; m < 4; ++m)
#pragma unroll
                    for (int n = 0; n < 2; ++n) acc[a][b][m][n] = (f32x4){0.f, 0.f, 0.f, 0.f};
        cur = nxt; cA = nA; cB = nB; ++ui;
        if constexpr (ALIGN_EPI) { if (wr == 1) PG8_BAR; }
    }
    PG8_WAIT_V(0);
    if constexpr (!ALIGN_EPI) { if (wr == 0) PG8_BAR; }
    PG8_BAR;
    if constexpr (Epi::AFTER_DRAIN) { E.fused(acc, cur, wr, wc, fr, fq, lds, wid, lane); S.done(cur); }
#undef PG8_SA
#undef PG8_SB
#undef PG8_STAGE
#undef PG8_LDA
#undef PG8_LDB
#undef PG8_MMA
#undef PG8_WAIT_V
#undef PG8_WAIT_L
#undef PG8_BAR
#undef PG8_SCHED
}
template <class Epi, class Sched, bool ALIGN_EPI = false, bool SP2 = false>
__device__ __forceinline__ void gemm_phase_g(const int wv, PG8_LAS unsigned char* lds, const Gemm g, const Sched& S, const Epi& E) {
#ifdef NO_GEMM
    return;
#endif
    const int tid_o = wv * 64 + lane_id_asm();
    const int tid = tid_o, wid = __builtin_amdgcn_readfirstlane(tid >> 6), lane = tid & 63, wr = wid >> 2, wc = wid & 3, fr = lane & 15, fq = lane >> 4;
    const int K = g.K, nt = K / BK;
    unsigned voffA[2], voffB[2];
#pragma unroll
    for (int i = 0; i < 2; ++i) { int R, C; stage_rc(tid * 16 + i * 8192, R, C); const int Rb = Epi::PERM ? ((R & ~31) + perm32(R & 31)) : R;
        voffA[i] = (unsigned)(R * g.lda + C) * 2u; voffB[i] = (unsigned)(Rb * g.ldb + C) * 2u; }
    const size_t kstep = (size_t)(BK * 2);
    const size_t hstepA = (size_t)HALF * g.lda * 2, hstepB = (size_t)HALF * g.ldb * 2;
    const size_t tstepA = 2 * hstepA, tstepB = 2 * hstepB;
    const unsigned ldsw = (unsigned)wid * 1024u;
    const int aoff = lds_byte(wr * 64 + fr, fq * 8), boff = lds_byte(wc * 32 + fr, fq * 8);
#define PG8_SA(b, h) (((b) * 2 + (h)) * HTB)
#define PG8_SB(b, h) ((4 + (b) * 2 + (h)) * HTB)
#define PG8_STAGE(bufoff, gbase, voff) do { _Pragma("unroll") for (int _i = 0; _i < 2; ++_i) \
        __builtin_amdgcn_global_load_lds((const unsigned*)((const char*)(gbase) + (voff)[_i]), (PG8_LAS unsigned*)(lds + (bufoff) + ldsw + _i * 8192), 16, 0, 0); } while (0)
#define PG8_LDA(dst, b, h) do { _Pragma("unroll") for (int m = 0; m < 4; ++m) _Pragma("unroll") for (int k = 0; k < 2; ++k) dst[m][k] = *(const PG8_LAS bf16x8*)(lds + PG8_SA(b, h) + aoff + m * 2048 + k * 1024); } while (0)
#define PG8_LDB(dst, b, h) do { _Pragma("unroll") for (int n = 0; n < 2; ++n) _Pragma("unroll") for (int k = 0; k < 2; ++k) dst[n][k] = *(const PG8_LAS bf16x8*)(lds + PG8_SB(b, h) + boff + n * 2048 + k * 1024); } while (0)
#define PG8_MMA(ai, bj, At, Bt) do { __builtin_amdgcn_s_setprio(1); _Pragma("unroll") for (int m = 0; m < 4; ++m) _Pragma("unroll") for (int n = 0; n < 2; ++n) _Pragma("unroll") for (int k = 0; k < 2; ++k) \
        acc[ai][bj][m][n] = __builtin_amdgcn_mfma_f32_16x16x32_bf16(Bt[n][k], At[m][k], acc[ai][bj][m][n], 0, 0, 0); __builtin_amdgcn_s_setprio(0); } while (0)
#define PG8_WAIT_V(n) asm volatile("s_waitcnt vmcnt(" #n ")" ::: "memory")
#define PG8_WAIT_L(n) asm volatile("s_waitcnt lgkmcnt(" #n ")" ::: "memory")
#define PG8_BAR __builtin_amdgcn_s_barrier()
#define PG8_SCHED __builtin_amdgcn_sched_barrier(0)
    Unit cur, nxt; int ui = 0;
    if (!S.next(0, cur)) return;
    unsigned vc[2][2], vn[2][2];
    { int R0, C0, R1, C1; stage_rc(tid * 16, R0, C0); stage_rc(tid * 16 + 8192, R1, C1); S.gather_voff(cur, R0, C0, R1, C1, g.lda, vc); }
    f32x4 acc[2][2][4][2];
#pragma unroll
    for (int a = 0; a < 2; ++a)
#pragma unroll
        for (int b = 0; b < 2; ++b)
#pragma unroll
            for (int m = 0; m < 4; ++m)
#pragma unroll
                for (int n = 0; n < 2; ++n) acc[a][b][m][n] = (f32x4){0.f, 0.f, 0.f, 0.f};
    bf16x8 At[4][2], B0[2][2], B1[2][2];
    const char* const cA = (const char*)g.A; const char* cB = (const char*)g.Bt + (size_t)cur.pn * tstepB;
    S.a_ready(cur);
    if constexpr (SP2) {
        PG8_STAGE(PG8_SB(0, 0), cB, voffB); PG8_STAGE(PG8_SB(0, 1), cB + hstepB, voffB); PG8_STAGE(PG8_SA(0, 0), cA, voffA); PG8_STAGE(PG8_SA(0, 1), cA + hstepA, voffA);
        if (wr == 1) PG8_BAR;
        PG8_WAIT_V(2); PG8_BAR;
        PG8_STAGE(PG8_SB(1, 0), cB + kstep, voffB); PG8_STAGE(PG8_SA(1, 0), cA + kstep, voffA); PG8_STAGE(PG8_SB(1, 1), cB + hstepB + kstep, voffB);
        PG8_WAIT_V(6); PG8_BAR;
    } else {
        PG8_STAGE(PG8_SB(0, 0), cB, voffB); PG8_STAGE(PG8_SA(0, 0), cA, vc[0]); PG8_STAGE(PG8_SB(0, 1), cB + hstepB, voffB); PG8_STAGE(PG8_SA(0, 1), cA, vc[1]);
        if (wr == 1) PG8_BAR;
        PG8_WAIT_V(4); PG8_BAR;
        PG8_STAGE(PG8_SB(1, 0), cB + kstep, voffB); PG8_STAGE(PG8_SA(1, 0), cA + kstep, vc[0]); PG8_STAGE(PG8_SB(1, 1), cB + hstepB + kstep, voffB);
        PG8_WAIT_V(6); PG8_BAR;
    }
    for (;;) {
        const bool has_next = S.next(ui + 1, nxt);
        const char* nB = has_next ? (const char*)g.Bt + (size_t)nxt.pn * tstepB : cB;
        if (has_next) { int R0, C0, R1, C1; stage_rc(tid * 16, R0, C0); stage_rc(tid * 16 + 8192, R1, C1); S.gather_voff(nxt, R0, C0, R1, C1, g.lda, vn); }
        else { vn[0][0] = vc[0][0]; vn[0][1] = vc[0][1]; vn[1][0] = vc[1][0]; vn[1][1] = vc[1][1]; }
        for (int t = 0; t < nt; t += 2) {
            const bool last = (t == nt - 2);
            const char* a1 = cA + (size_t)(t + 1) * kstep;
            const char* a2 = last ? cA : cA + (size_t)(t + 2) * kstep; const char* b2 = last ? nB : cB + (size_t)(t + 2) * kstep;
            unsigned vs[2][2]; vs[0][0] = last ? vn[0][0] : vc[0][0]; vs[0][1] = last ? vn[0][1] : vc[0][1]; vs[1][0] = last ? vn[1][0] : vc[1][0]; vs[1][1] = last ? vn[1][1] : vc[1][1];
            const char* a3 = a2 + kstep; const char* b3 = b2 + kstep;
            if (last && has_next) S.a_ready(nxt);
            if constexpr (SP2) {
            PG8_LDB(B0, 0, 0); PG8_LDB(B1, 0, 1); PG8_SCHED; PG8_LDA(At, 0, 0); PG8_STAGE(PG8_SA(1, 1), a1 + hstepA, voffA);
            PG8_WAIT_V(8); PG8_WAIT_L(0); PG8_BAR; PG8_MMA(0, 0, At, B0); PG8_MMA(0, 1, At, B1); PG8_BAR; PG8_SCHED;
            PG8_LDA(At, 0, 1); PG8_STAGE(PG8_SB(0, 0), b2, voffB); PG8_STAGE(PG8_SB(0, 1), b2 + hstepB, voffB); PG8_STAGE(PG8_SA(0, 0), a2, voffA);
            PG8_WAIT_V(8); PG8_WAIT_L(0); PG8_BAR; PG8_MMA(1, 0, At, B0); PG8_MMA(1, 1, At, B1); PG8_BAR; PG8_SCHED;
            PG8_LDB(B0, 1, 0); PG8_LDB(B1, 1, 1); PG8_SCHED; PG8_LDA(At, 1, 0); PG8_STAGE(PG8_SA(0, 1), a2 + hstepA, voffA);
            PG8_WAIT_V(8); PG8_WAIT_L(0); PG8_BAR; PG8_MMA(0, 0, At, B0); PG8_MMA(0, 1, At, B1); PG8_BAR; PG8_SCHED;
            PG8_LDA(At, 1, 1); PG8_STAGE(PG8_SB(1, 0), b3, voffB); PG8_STAGE(PG8_SB(1, 1), b3 + hstepB, voffB); PG8_STAGE(PG8_SA(1, 0), a3, voffA);
            PG8_WAIT_V(8); PG8_WAIT_L(0); PG8_BAR; PG8_MMA(1, 0, At, B0); PG8_MMA(1, 1, At, B1); PG8_BAR; PG8_SCHED;
            } else {
            PG8_LDB(B0, 0, 0); PG8_SCHED; PG8_LDA(At, 0, 0); PG8_STAGE(PG8_SA(1, 1), a1, vc[1]);
            PG8_WAIT_L(8); PG8_BAR; PG8_WAIT_L(0); PG8_MMA(0, 0, At, B0); PG8_BAR; PG8_SCHED;
            PG8_LDB(B1, 0, 1); PG8_STAGE(PG8_SB(0, 0), b2, voffB);
            PG8_BAR; PG8_WAIT_L(0); PG8_MMA(0, 1, At, B1); PG8_BAR;
            PG8_LDA(At, 0, 1); PG8_STAGE(PG8_SA(0, 0), a2, vs[0]);
            PG8_BAR; PG8_WAIT_L(0); PG8_MMA(1, 0, At, B0); PG8_BAR; PG8_SCHED;
            PG8_STAGE(PG8_SB(0, 1), b2 + hstepB, voffB);
            PG8_WAIT_V(6); PG8_BAR; PG8_MMA(1, 1, At, B1); PG8_BAR;
            PG8_LDB(B0, 1, 0); PG8_SCHED; PG8_LDA(At, 1, 0); PG8_STAGE(PG8_SA(0, 1), a2, vs[1]);
            PG8_WAIT_L(8); PG8_BAR; PG8_WAIT_L(0); PG8_MMA(0, 0, At, B0); PG8_BAR; PG8_SCHED;
            PG8_LDB(B1, 1, 1); PG8_STAGE(PG8_SB(1, 0), b3, voffB);
            PG8_BAR; PG8_WAIT_L(0); PG8_MMA(0, 1, At, B1); PG8_BAR;
            PG8_LDA(At, 1, 1); PG8_STAGE(PG8_SA(1, 0), a3, vs[0]);
            PG8_BAR; PG8_WAIT_L(0); PG8_MMA(1, 0, At, B0); PG8_BAR; PG8_SCHED;
            PG8_STAGE(PG8_SB(1, 1), b3 + hstepB, voffB);
            PG8_WAIT_V(6); PG8_BAR; PG8_MMA(1, 1, At, B1); PG8_BAR;
            }
        }
        if constexpr (ALIGN_EPI) { if (wr == 0) PG8_BAR; }
        if constexpr (!Epi::AFTER_DRAIN) { E(acc, cur, wr, wc, fr, fq); S.done(cur); }
        if (!has_next) break;
#pragma unroll
        for (int a = 0; a < 2; ++a)
#pragma unroll
            for (int b = 0; b < 2; ++b)
#pragma unroll
                for (int m = 0; m < 4; ++m)
#pragma unroll
                    for (int n = 0; n < 2; ++n) acc[a][b][m][n] = (f32x4){0.f, 0.f, 0.f, 0.f};
        cur = nxt; cB = nB; ++ui; vc[0][0] = vn[0][0]; vc[0][1] = vn[0][1]; vc[1][0] = vn[1][0]; vc[1][1] = vn[1][1];
        if constexpr (ALIGN_EPI) { if (wr == 1) PG8_BAR; }
    }
    PG8_WAIT_V(0);
    if constexpr (!ALIGN_EPI) { if (wr == 0) PG8_BAR; }
    PG8_BAR;
    if constexpr (Epi::AFTER_DRAIN) { E.fused(acc, cur, wr, wc, fr, fq, lds, wid, lane); S.done(cur); }
#undef PG8_SA
#undef PG8_SB
#undef PG8_STAGE
#undef PG8_LDA
#undef PG8_LDB
#undef PG8_MMA
#undef PG8_WAIT_V
#undef PG8_WAIT_L
#undef PG8_BAR
#undef PG8_SCHED
}

template <class Epi, class Epi1, class Sched, bool ALIGN_EPI = false, bool SP2 = false>
__device__ __forceinline__ void gemm_phase_m(const int wv, PG8_LAS unsigned char* lds, const Gemm g, const Sched& S, const Epi& E, const Epi1& E1) {
#ifdef NO_GEMM
    return;
#endif
    const int tid_o = wv * 64 + lane_id_asm();
    const int tid = tid_o, wid = __builtin_amdgcn_readfirstlane(tid >> 6), lane = tid & 63, wr = wid >> 2, wc = wid & 3, fr = lane & 15, fq = lane >> 4;
    int nt;
    unsigned voffA[2], voffB[2];
#pragma unroll
    for (int i = 0; i < 2; ++i) { int R, C; stage_rc(tid * 16 + i * 8192, R, C); const int Rb = Epi::PERM ? ((R & ~31) + perm32(R & 31)) : R;
        voffA[i] = (unsigned)(R * g.lda + C) * 2u; voffB[i] = (unsigned)(Rb * g.ldb + C) * 2u; }
    const size_t kstep = (size_t)(BK * 2);
    const size_t hstepA = (size_t)HALF * g.lda * 2, hstepB = (size_t)HALF * g.ldb * 2;
    const size_t tstepA = 2 * hstepA, tstepB = 2 * hstepB;
    const unsigned ldsw = (unsigned)wid * 1024u;
    const int aoff = lds_byte(wr * 64 + fr, fq * 8), boff = lds_byte(wc * 32 + fr, fq * 8);
#define PG8_SA(b, h) (((b) * 2 + (h)) * HTB)
#define PG8_SB(b, h) ((4 + (b) * 2 + (h)) * HTB)
#define PG8_STAGE(bufoff, gbase, voff) do { _Pragma("unroll") for (int _i = 0; _i < 2; ++_i) \
        __builtin_amdgcn_global_load_lds((const unsigned*)((const char*)(gbase) + (voff)[_i]), (PG8_LAS unsigned*)(lds + (bufoff) + ldsw + _i * 8192), 16, 0, 0); } while (0)
#define PG8_LDA(dst, b, h) do { _Pragma("unroll") for (int m = 0; m < 4; ++m) _Pragma("unroll") for (int k = 0; k < 2; ++k) dst[m][k] = *(const PG8_LAS bf16x8*)(lds + PG8_SA(b, h) + aoff + m * 2048 + k * 1024); } while (0)
#define PG8_LDB(dst, b, h) do { _Pragma("unroll") for (int n = 0; n < 2; ++n) _Pragma("unroll") for (int k = 0; k < 2; ++k) dst[n][k] = *(const PG8_LAS bf16x8*)(lds + PG8_SB(b, h) + boff + n * 2048 + k * 1024); } while (0)
#define PG8_MMA(ai, bj, At, Bt) do { __builtin_amdgcn_s_setprio(1); _Pragma("unroll") for (int m = 0; m < 4; ++m) _Pragma("unroll") for (int n = 0; n < 2; ++n) _Pragma("unroll") for (int k = 0; k < 2; ++k) \
        acc[ai][bj][m][n] = __builtin_amdgcn_mfma_f32_16x16x32_bf16(Bt[n][k], At[m][k], acc[ai][bj][m][n], 0, 0, 0); __builtin_amdgcn_s_setprio(0); } while (0)
#define PG8_WAIT_V(n) asm volatile("s_waitcnt vmcnt(" #n ")" ::: "memory")
#define PG8_WAIT_L(n) asm volatile("s_waitcnt lgkmcnt(" #n ")" ::: "memory")
#define PG8_BAR __builtin_amdgcn_s_barrier()
#define PG8_SCHED __builtin_amdgcn_sched_barrier(0)
    Unit cur, nxt; int ui = 0;
    if (!S.next(0, cur)) return;
    f32x4 acc[2][2][4][2];
#pragma unroll
    for (int a = 0; a < 2; ++a)
#pragma unroll
        for (int b = 0; b < 2; ++b)
#pragma unroll
            for (int m = 0; m < 4; ++m)
#pragma unroll
                for (int n = 0; n < 2; ++n) acc[a][b][m][n] = (f32x4){0.f, 0.f, 0.f, 0.f};
    bf16x8 At[4][2], B0[2][2], B1[2][2];
    const char *cA, *cA2, *cB, *cB2; S.ptrs(cur, cA, cA2, cB, cB2, nt);
    S.a_ready(cur);
    if constexpr (SP2) {
        PG8_STAGE(PG8_SB(0, 0), cB, voffB); PG8_STAGE(PG8_SB(0, 1), cB + hstepB, voffB); PG8_STAGE(PG8_SA(0, 0), cA, voffA); PG8_STAGE(PG8_SA(0, 1), cA + hstepA, voffA);
        if (wr == 1) PG8_BAR;
        PG8_WAIT_V(2); PG8_BAR;
        PG8_STAGE(PG8_SB(1, 0), cB + kstep, voffB); PG8_STAGE(PG8_SA(1, 0), cA + kstep, voffA); PG8_STAGE(PG8_SB(1, 1), cB + hstepB + kstep, voffB);
        PG8_WAIT_V(6); PG8_BAR;
    } else {
        PG8_STAGE(PG8_SB(0, 0), cB, voffB); PG8_STAGE(PG8_SA(0, 0), cA, voffA); PG8_STAGE(PG8_SB(0, 1), cB + hstepB, voffB); PG8_STAGE(PG8_SA(0, 1), cA + hstepA, voffA);
        if (wr == 1) PG8_BAR;
        PG8_WAIT_V(4); PG8_BAR;
        PG8_STAGE(PG8_SB(1, 0), cB + kstep, voffB); PG8_STAGE(PG8_SA(1, 0), cA + kstep, voffA); PG8_STAGE(PG8_SB(1, 1), cB + hstepB + kstep, voffB);
        PG8_WAIT_V(6); PG8_BAR;
    }
    for (;;) {
        const bool has_next = S.next(ui + 1, nxt);
        const char *nA = cA, *nA2 = cA2, *nB = cB, *nB2 = cB2; int nnt = nt; if (has_next) S.ptrs(nxt, nA, nA2, nB, nB2, nnt);
        for (int t = 0; t < nt; t += 2) {
            const bool last = (t == nt - 2);
            const char* a1 = (t + 1 < 32) ? cA + (size_t)(t + 1) * kstep : cA2 + (size_t)(t + 1 - 32) * kstep;
            const char* a2 = last ? nA : ((t + 2 < 32) ? cA + (size_t)(t + 2) * kstep : cA2 + (size_t)(t + 2 - 32) * kstep);
            const char* b2 = last ? nB : ((t + 2 < 32) ? cB + (size_t)(t + 2) * kstep : cB2 + (size_t)(t + 2 - 32) * kstep);
            const char* a3 = a2 + kstep; const char* b3 = b2 + kstep;
            if (last && has_next) S.a_ready(nxt);
            if constexpr (SP2) {
            PG8_LDB(B0, 0, 0); PG8_LDB(B1, 0, 1); PG8_SCHED; PG8_LDA(At, 0, 0); PG8_STAGE(PG8_SA(1, 1), a1 + hstepA, voffA);
            PG8_WAIT_V(8); PG8_WAIT_L(0); PG8_BAR; PG8_MMA(0, 0, At, B0); PG8_MMA(0, 1, At, B1); PG8_BAR; PG8_SCHED;
            PG8_LDA(At, 0, 1); PG8_STAGE(PG8_SB(0, 0), b2, voffB); PG8_STAGE(PG8_SB(0, 1), b2 + hstepB, voffB); PG8_STAGE(PG8_SA(0, 0), a2, voffA);
            PG8_WAIT_V(8); PG8_WAIT_L(0); PG8_BAR; PG8_MMA(1, 0, At, B0); PG8_MMA(1, 1, At, B1); PG8_BAR; PG8_SCHED;
            PG8_LDB(B0, 1, 0); PG8_LDB(B1, 1, 1); PG8_SCHED; PG8_LDA(At, 1, 0); PG8_STAGE(PG8_SA(0, 1), a2 + hstepA, voffA);
            PG8_WAIT_V(8); PG8_WAIT_L(0); PG8_BAR; PG8_MMA(0, 0, At, B0); PG8_MMA(0, 1, At, B1); PG8_BAR; PG8_SCHED;
            PG8_LDA(At, 1, 1); PG8_STAGE(PG8_SB(1, 0), b3, voffB); PG8_STAGE(PG8_SB(1, 1), b3 + hstepB, voffB); PG8_STAGE(PG8_SA(1, 0), a3, voffA);
            PG8_WAIT_V(8); PG8_WAIT_L(0); PG8_BAR; PG8_MMA(1, 0, At, B0); PG8_MMA(1, 1, At, B1); PG8_BAR; PG8_SCHED;
            } else {
            PG8_LDB(B0, 0, 0); PG8_SCHED; PG8_LDA(At, 0, 0); PG8_STAGE(PG8_SA(1, 1), a1 + hstepA, voffA);
            PG8_WAIT_L(8); PG8_BAR; PG8_WAIT_L(0); PG8_MMA(0, 0, At, B0); PG8_BAR; PG8_SCHED;
            PG8_LDB(B1, 0, 1); PG8_STAGE(PG8_SB(0, 0), b2, voffB);
            PG8_BAR; PG8_WAIT_L(0); PG8_MMA(0, 1, At, B1); PG8_BAR;
            PG8_LDA(At, 0, 1); PG8_STAGE(PG8_SA(0, 0), a2, voffA);
            PG8_BAR; PG8_WAIT_L(0); PG8_MMA(1, 0, At, B0); PG8_BAR; PG8_SCHED;
            PG8_STAGE(PG8_SB(0, 1), b2 + hstepB, voffB);
            PG8_WAIT_V(6); PG8_BAR; PG8_MMA(1, 1, At, B1); PG8_BAR;
            PG8_LDB(B0, 1, 0); PG8_SCHED; PG8_LDA(At, 1, 0); PG8_STAGE(PG8_SA(0, 1), a2 + hstepA, voffA);
            PG8_WAIT_L(8); PG8_BAR; PG8_WAIT_L(0); PG8_MMA(0, 0, At, B0); PG8_BAR; PG8_SCHED;
            PG8_LDB(B1, 1, 1); PG8_STAGE(PG8_SB(1, 0), b3, voffB);
            PG8_BAR; PG8_WAIT_L(0); PG8_MMA(0, 1, At, B1); PG8_BAR;
            PG8_LDA(At, 1, 1); PG8_STAGE(PG8_SA(1, 0), a3, voffA);
            PG8_BAR; PG8_WAIT_L(0); PG8_MMA(1, 0, At, B0); PG8_BAR; PG8_SCHED;
            PG8_STAGE(PG8_SB(1, 1), b3 + hstepB, voffB);
            PG8_WAIT_V(6); PG8_BAR; PG8_MMA(1, 1, At, B1); PG8_BAR;
            }
        }
        if constexpr (ALIGN_EPI) { if (wr == 0) PG8_BAR; }
        if (cur.aoff == 0) E(acc, cur, wr, wc, fr, fq); else E1(acc, cur, wr, wc, fr, fq);
        if (!has_next) break;
#pragma unroll
        for (int a = 0; a < 2; ++a)
#pragma unroll
            for (int b = 0; b < 2; ++b)
#pragma unroll
                for (int m = 0; m < 4; ++m)
#pragma unroll
                    for (int n = 0; n < 2; ++n) acc[a][b][m][n] = (f32x4){0.f, 0.f, 0.f, 0.f};
        cur = nxt; cA = nA; cA2 = nA2; cB = nB; cB2 = nB2; nt = nnt; ++ui;
        if constexpr (ALIGN_EPI) { if (wr == 1) PG8_BAR; }
    }
    PG8_WAIT_V(0);
    if constexpr (!ALIGN_EPI) { if (wr == 0) PG8_BAR; }
    PG8_BAR;
#undef PG8_SA
#undef PG8_SB
#undef PG8_STAGE
#undef PG8_LDA
#undef PG8_LDB
#undef PG8_MMA
#undef PG8_WAIT_V
#undef PG8_WAIT_L
#undef PG8_BAR
#undef PG8_SCHED
}


}

#define XB_TMO      128
#define XB_XCNT(j)  (256  + 64 * (j))
#define XB_XSUB(j)  (1280 + 64 * (j))
#define XB_XGEN(j)  (2304 + 64 * (j))
#define XB_TOP      3328
#define XB_TOPGEN   3392
#define XCD_BAR_WORDS 3456
#define XB_SPIN_CAP (1u << 18)

__device__ __forceinline__ unsigned xb_ld(unsigned* p)              { return __hip_atomic_load(p, __ATOMIC_RELAXED, __HIP_MEMORY_SCOPE_AGENT); }
__device__ __forceinline__ unsigned xb_add(unsigned* p, unsigned v) { return __hip_atomic_fetch_add(p, v, __ATOMIC_RELAXED, __HIP_MEMORY_SCOPE_AGENT); }
__device__ __forceinline__ unsigned xb_xcc_id() { return (unsigned)__builtin_amdgcn_s_getreg((3 << 11) | 20) & 0xFu; }
#define XB_SPIN(cond, bar) do { unsigned _sp = 0; while (cond) { __builtin_amdgcn_s_sleep(1); \
    if ((++_sp & 255u) == 0u) { if (xb_ld(&(bar)[XB_TMO])) break; if (_sp > XB_SPIN_CAP) { atomicAdd(&(bar)[XB_TMO], 1u); break; } } } } while (0)

struct XcdBarrier {
    unsigned* bar; unsigned x;
    volatile LAS unsigned* st;
};

__device__ __forceinline__ XcdBarrier xcd_barrier_post(unsigned* bar, volatile LAS unsigned* st, const bool t0) {
    XcdBarrier b; b.bar = bar; b.x = xb_xcc_id(); b.st = st;
    if (t0) (void)xb_add(&bar[XB_XCNT(b.x)], 1u);
    return b;
}
__device__ __forceinline__ void xcd_barrier_complete(unsigned* bar, unsigned x, unsigned& nloc, unsigned& nx) {
    const unsigned G = gridDim.x * gridDim.y * gridDim.z;
    unsigned sum, cnt, mine, sp = 0u;
    for (;;) {
        sum = 0u; cnt = 0u; mine = 0u;
#pragma unroll
        for (unsigned j = 0; j < 16; ++j) { const unsigned c = xb_ld(&bar[XB_XCNT(j)]); sum += c; cnt += (c > 0u) ? 1u : 0u; mine = (j == x) ? c : mine; }
        if (sum == G) break;
        __builtin_amdgcn_s_sleep(1);
        if ((++sp & 255u) == 0u) { if (xb_ld(&bar[XB_TMO])) break; if (sp > XB_SPIN_CAP) { atomicAdd(&bar[XB_TMO], 1u); break; } }
    }
    nloc = mine > 0u ? mine : 1u; nx = cnt > 0u ? cnt : 1u;
}

__device__ __forceinline__ void xcd_barrier(const XcdBarrier& b, const bool t0) {
    asm volatile("s_waitcnt vmcnt(0)" ::: "memory");
    __syncthreads();
    if (t0) {
        unsigned* bar = b.bar;
        __builtin_amdgcn_s_waitcnt(0);
        unsigned nloc = b.st[0], nx = b.st[1];
        if (nloc == 0u) { xcd_barrier_complete(bar, b.x, nloc, nx); b.st[0] = nloc; b.st[1] = nx; }
        const unsigned old = xb_add(&bar[XB_XSUB(b.x)], 1u);
        const unsigned gen = old / nloc;
        if (old + 1u == (gen + 1u) * nloc) {
            __builtin_amdgcn_fence(__ATOMIC_RELEASE, "agent");
            asm volatile("s_waitcnt vmcnt(0)" ::: "memory");
            const unsigned og = xb_add(&bar[XB_TOP], 1u);
            const unsigned tg = og / nx;
            if (og + 1u == (tg + 1u) * nx) xb_add(&bar[XB_TOPGEN], 1u);
            else XB_SPIN(xb_ld(&bar[XB_TOPGEN]) == tg, bar);
            __builtin_amdgcn_fence(__ATOMIC_ACQUIRE, "agent");
            xb_add(&bar[XB_XGEN(b.x)], 1u);
            asm volatile("s_waitcnt vmcnt(0)" ::: "memory");
        } else {
            XB_SPIN(xb_ld(&bar[XB_XGEN(b.x)]) == gen, bar);
            __builtin_amdgcn_fence(__ATOMIC_ACQUIRE, "agent");
            asm volatile("s_waitcnt vmcnt(0)" ::: "memory");
        }
    }
    __syncthreads();
}

constexpr int NWAVES = 8, NTHR = 512;
constexpr int NB = 4, SEQ = 4096, T_ = NB * SEQ, D_ = 2048;
constexpr int EVEN_IN = 7176, ZW = 7168;
constexpr float DN_ALPHA = 1.6817928305074290f;
constexpr float LN_EPS = 1e-5f;
constexpr int MOE_ROWS = 40960, MOE_TILES = MOE_ROWS / 256;

constexpr size_t MiB = 1u << 20;
constexpr size_t WS_CTL = 0, CTL_ZERO_BYTES = 1 * MiB;
constexpr size_t WS_IG = 1 * MiB, WS_FG = WS_IG + 256 * 1024, WS_KPART = 2 * MiB;
constexpr size_t WS_TOKE = 3 * MiB, WS_TOKR = WS_TOKE + 128 * 1024, WS_TOKG = WS_TOKR + 128 * 1024, WS_SLOT = WS_TOKG + 128 * 1024;
constexpr size_t WS_DN = 4 * MiB, WS_NP = 5 * MiB, WS_DEC = 6 * MiB, WS_BC = 6 * MiB + 65536;
constexpr size_t WS_LIST = 8 * MiB;
constexpr size_t WS_RW = 12 * MiB;
constexpr size_t WS_WIN = 16 * MiB;
constexpr size_t WS_WOUT = 72 * MiB;
constexpr size_t WS_WRKV = 88 * MiB;
constexpr size_t WS_WO = 136 * MiB;
constexpr size_t WS_WL1 = 152 * MiB;
constexpr size_t WS_WL2 = 160 * MiB;
constexpr size_t WS_WGU = 168 * MiB;
constexpr size_t WS_WDN = 680 * MiB;
constexpr size_t WS_XB = 936 * MiB;
constexpr size_t WS_VF = 1000 * MiB;
constexpr size_t WS_R = 1064 * MiB;
constexpr size_t WS_Z = WS_R;
constexpr size_t WS_QKB = WS_R + 224 * MiB;
constexpr size_t WS_VAT = WS_R + 288 * MiB;
constexpr size_t WS_YE = WS_R + 320 * MiB;
constexpr size_t WS_DC = WS_R + 384 * MiB;
constexpr size_t WS_CP = WS_R + 512 * MiB;
constexpr size_t WS_XRKV = WS_R;
constexpr size_t WS_XC = WS_R + 192 * MiB;
constexpr size_t WS_RKV = WS_R + 320 * MiB;
constexpr size_t WS_L1 = WS_R + 512 * MiB;
constexpr size_t WS_G = WS_R + 528 * MiB;
constexpr size_t WS_WD = WS_R + 592 * MiB;
constexpr size_t WS_AA = WS_R + 656 * MiB;
constexpr size_t WS_YO = WS_R + 720 * MiB;
constexpr size_t WS_XS = WS_R;
constexpr size_t WS_HID = WS_R + 160 * MiB;
constexpr size_t WS_YS = WS_R + 400 * MiB;
constexpr size_t WS_X2 = WS_R + 784 * MiB;
constexpr size_t WS_VG = WS_X2 + 64 * MiB;
constexpr size_t WS_XSUM = WS_X2 + 64 * MiB;
constexpr size_t WS_END = WS_X2 + 128 * MiB;

constexpr int CW_BAR = 4096;
constexpr int CW_CNT = 16384;

constexpr int LDS_BYTES = 163840;
constexpr int MISC_OFF = LDS_BYTES - 4096;
constexpr int RING_BYTES = MISC_OFF;

typedef unsigned gu32;

#ifndef MOE_PROLOGUE_LAYERS
#define MOE_PROLOGUE_LAYERS 1
#endif
struct Args { const float* in[39]; float* out; unsigned char* ws; int ph_lo, ph_hi; };
#define CAS __attribute__((address_space(4)))
typedef const CAS Args* ArgsP;
#define XIN(a, l) ((bf16*)((a)->ws + (((l) == 0 || (l) == 3) ? WS_XB : WS_X2)))
#define XOUT(a, l) ((bf16*)((a)->ws + (((l) <= 1) ? WS_X2 : WS_XB)))
__device__ __forceinline__ ArgsP get_args() { ArgsP p = (ArgsP)__builtin_amdgcn_kernarg_segment_ptr(); asm volatile("" : "+s"(p)); return p; }

template <int NH> __device__ __forceinline__ void tr_item_n(const float* W, int ldw, int k0, int n0, bf16* WT, int ldt, int drow0, int dcol0, LAS float* scr, int lane, const float* kscale) {
    const int r = lane >> 3, c4 = lane & 7;
    f32x4 v[NH][8];
#pragma unroll
    for (int hh = 0; hh < NH; ++hh)
#pragma unroll
        for (int i = 0; i < 8; ++i) v[hh][i] = __builtin_nontemporal_load((const f32x4*)(W + (size_t)(k0 + 64 * hh + 8 * i + r) * ldw + n0 + 4 * c4));
#pragma unroll
    for (int hh = 0; hh < NH; ++hh) {
        if (kscale) {
#pragma unroll
            for (int i = 0; i < 8; ++i) v[hh][i] = v[hh][i] * kscale[k0 + 64 * hh + 8 * i + r]; }
#pragma unroll
        for (int i = 0; i < 8; ++i) { LAS float* d = scr + (8 * i + r) * 33 + 4 * c4; d[0] = v[hh][i].x; d[1] = v[hh][i].y; d[2] = v[hh][i].z; d[3] = v[hh][i].w; }
        LDS_WAIT(); asm volatile("" ::: "memory");
        const int c = lane & 7;
#pragma unroll
        for (int j = 0; j < 4; ++j) { const int n = (lane >> 3) + 8 * j; const LAS float* s = scr + (8 * c) * 33 + n;
            v4u o; o.x = pk2(s[0 * 33], s[1 * 33]); o.y = pk2(s[2 * 33], s[3 * 33]); o.z = pk2(s[4 * 33], s[5 * 33]); o.w = pk2(s[6 * 33], s[7 * 33]);
            *(v4u*)(WT + (size_t)(drow0 + n) * ldt + dcol0 + 64 * hh + 8 * c) = o; }
        LDS_WAIT(); asm volatile("" ::: "memory");
    }
}
__device__ __forceinline__ void tr_item(const float* W, int ldw, int k0, int n0, bf16* WT, int ldt, int drow0, int dcol0, LAS float* scr, int lane, const float* kscale) {
    tr_item_n<1>(W, ldw, k0, n0, WT, ldt, drow0, dcol0, scr, lane, kscale); }

__device__ __forceinline__ void moe_convert(const int wv, LAS unsigned char* lds, int le_lo, int le_hi, int vb, int nvb) {
    const ArgsP a = get_args();
    OPAQUE_TID(); const int lane = tid & 63, wave = tid >> 6;
    unsigned char* ws = a->ws;
    LAS float* scr = (LAS float*)(lds + wave * 16384);
    const int n = (le_hi - le_lo) * 768;
    for (int it = vb * NWAVES + wave; it < n; it += nvb * NWAVES) {
        const int le = le_lo + it / 768, rr = it % 768, mat = rr / 256, q = rr % 256;
        if (mat < 2) { const int kb = q / 16, nb = q % 16, n0 = 32 * nb;
            tr_item_n<2>((mat == 0 ? a->in[36] : a->in[37]) + (size_t)le * 2048 * 512, 512, 128 * kb, n0, (bf16*)(ws + WS_WGU) + (size_t)le * 1024 * 2048, 2048,
                    (n0 / 128) * 256 + (n0 % 128) + (mat == 1 ? 128 : 0), 128 * kb, scr, lane, nullptr); }
        else { const int kb = q / 64, nb = q % 64;
            tr_item_n<2>(a->in[38] + (size_t)le * 512 * 2048, 2048, 128 * kb, 32 * nb, (bf16*)(ws + WS_WDN) + (size_t)le * 2048 * 512, 512, 32 * nb, 128 * kb, scr, lane, nullptr); }
    }
}

__device__ __forceinline__ void prologue(const int wv, LAS unsigned char* lds, const int part) {
    const ArgsP a = get_args();
#ifdef NO_PROL
    return;
#endif
    OPAQUE_TID(); const int lane = tid & 63, wave = tid >> 6;
    unsigned char* ws = a->ws;
    LAS float* scr = (LAS float*)(lds + wave * 16384);
    const int gw = blockIdx.x * NWAVES + wave, NGW = gridDim.x * NWAVES;
    constexpr int I0 = 2 * 3584, I1 = 2 * 1024, I2 = 2 * 4 * 1024,     I3 = 2 * 32 * 16, I4 = MOE_PROLOGUE_LAYERS * 32 * 768;
    constexpr int NITEMS = I0 + I1 + I2 + I3 + I4;
    for (int it = (part == 0 ? 0 : 3584) + gw; it < (part == 0 ? 3584 : NITEMS); it += NGW) {
        int r = it;
        if (r < I0) { const int e = r / 3584, rr = r % 3584, kb = rr / 224, nb = rr % 224;
            tr_item_n<2>(a->in[1] + (size_t)e * 2048 * EVEN_IN, EVEN_IN, 128 * kb, 32 * nb, (bf16*)(ws + WS_WIN) + (size_t)e * ZW * 2048, 2048, 32 * nb, 128 * kb, scr, lane, nullptr); continue; } r -= I0;
        if (r < I1) { const int e = r / 1024, rr = r % 1024, kb = rr / 64, nb = rr % 64;
            tr_item_n<2>(a->in[6] + (size_t)e * 2048 * 2048, 2048, 128 * kb, 32 * nb, (bf16*)(ws + WS_WOUT) + (size_t)e * 2048 * 2048, 2048, 32 * nb, 128 * kb, scr, lane, nullptr); continue; } r -= I1;
        if (r < I2) { const int o = r / 4096, rr = r % 4096, mat = rr / 1024, q = rr % 1024, kb = q / 64, nb = q % 64;
            const float* src = (mat == 0 ? a->in[8] : mat == 1 ? a->in[9] : mat == 2 ? a->in[10] : a->in[11]) + (size_t)o * 2048 * 2048;
            bf16* dst = (mat < 3) ? (bf16*)(ws + WS_WRKV) + (size_t)o * 3 * 2048 * 2048 + (size_t)mat * 2048 * 2048 : (bf16*)(ws + WS_WO) + (size_t)o * 2048 * 2048;
            tr_item_n<2>(src, 2048, 128 * kb, 32 * nb, dst, 2048, 32 * nb, 128 * kb, scr, lane, nullptr); continue; } r -= I2;
        if (r < I3) { const int o = r / 512, rr = r % 512, kb = rr / 16, nb = rr % 16;
            const float* src; int ldw, n0, drow0, mu;
            if (nb < 8) { src = a->in[18] + (size_t)o * 2048 * 256; ldw = 256; n0 = 32 * nb; drow0 = 32 * nb; mu = 5; }
            else if (nb < 11) { src = a->in[13] + (size_t)o * 2048 * 96; ldw = 96; n0 = 32 * (nb - 8); drow0 = 256 + n0; mu = 1; }
            else if (nb < 14) { src = a->in[16] + (size_t)o * 2048 * 96; ldw = 96; n0 = 32 * (nb - 11); drow0 = 352 + n0; mu = 4; }
            else { if (o == 0) continue; src = a->in[26]; ldw = 64; n0 = 32 * (nb - 14); drow0 = 448 + n0; mu = 3; }
            bf16* dst = (bf16*)(ws + WS_WL1) + (size_t)o * 2 * 512 * 2048;
            tr_item(src, ldw, 64 * kb, n0, dst, 2048, drow0, 64 * kb, scr, lane, nullptr);
            tr_item(src, ldw, 64 * kb, n0, dst + (size_t)512 * 2048, 2048, drow0, 64 * kb, scr, lane, a->in[7] + (size_t)(o * 6 + mu) * 2048);
            continue; } r -= I3;
        { const int le = r / 768, rr = r % 768, mat = rr / 256, q = rr % 256;
            if (mat < 2) { const int kb = q / 16, nb = q % 16, n0 = 32 * nb;
                tr_item_n<2>((mat == 0 ? a->in[36] : a->in[37]) + (size_t)le * 2048 * 512, 512, 128 * kb, n0, (bf16*)(ws + WS_WGU) + (size_t)le * 1024 * 2048, 2048,
                        (n0 / 128) * 256 + (n0 % 128) + (mat == 1 ? 128 : 0), 128 * kb, scr, lane, nullptr); }
            else { const int kb = q / 64, nb = q % 64;
                tr_item_n<2>(a->in[38] + (size_t)le * 512 * 2048, 2048, 128 * kb, 32 * nb, (bf16*)(ws + WS_WDN) + (size_t)le * 2048 * 512, 512, 32 * nb, 128 * kb, scr, lane, nullptr); }
        }
    }
    const int gt = blockIdx.x * NTHR + tid, NGT = gridDim.x * NTHR;
    for (int idx = gt; part == 1 && idx < 2 * 32 * 8192; idx += NGT) {
        const int o = idx / (32 * 8192), rem = idx % (32 * 8192), kg = rem / 8192, n = rem % 8192, mat = n / 2048, nn = n % 2048;
        float v[8];
#pragma unroll
        for (int j = 0; j < 8; ++j) { const int k = 8 * kg + j; float x = 0.f;
            if (mat == 0) x = a->in[19][((size_t)o * 256 + k) * 2048 + nn];
            else if (mat == 1) { if (k < 96) x = a->in[14][((size_t)o * 96 + k) * 2048 + nn]; }
            else if (mat == 2) { if (k >= 96 && k < 192) x = a->in[17][((size_t)o * 96 + (k - 96)) * 2048 + nn]; }
            else { if (o == 1 && k >= 192) x = a->in[27][(size_t)(k - 192) * 2048 + nn]; }
            v[j] = x; }
        v4u w; w.x = pk2(v[0], v[1]); w.y = pk2(v[2], v[3]); w.z = pk2(v[4], v[5]); w.w = pk2(v[6], v[7]);
        *(v4u*)((bf16*)(ws + WS_WL2) + ((size_t)o * 8192 + n) * 256 + 8 * kg) = w;
    }
    for (int idx = gt; part == 0 && idx < 4 * 2048 * 9; idx += NGT) { const int l = idx / (2048 * 9), rem = idx % (2048 * 9), k = rem / 9, q = rem % 9;
        const f32x4 v = (q == 0) ? *(const f32x4*)(a->in[32] + ((size_t)l * 2048 + k) * 4) : *(const f32x4*)(a->in[34] + ((size_t)l * 2048 + k) * 32 + 4 * (q - 1));
        ((f32x4*)(ws + WS_RW))[(size_t)l * 9 * 2048 + q * 2048 + ((k >> 8) * 4 + (k & 3)) * 64 + ((k >> 2) & 63)] = v; }
    for (int i0 = gt; part == 0 && i0 < T_ * D_ / 4; i0 += 8 * NGT) { f32x4 v[8];
#pragma unroll
        for (int k = 0; k < 8; ++k) { const int i = i0 + k * NGT; v[k] = (i < T_ * D_ / 4) ? __builtin_nontemporal_load((const f32x4*)a->in[0] + i) : (f32x4){0.f, 0.f, 0.f, 0.f}; }
#pragma unroll
        for (int k = 0; k < 8; ++k) { const int i = i0 + k * NGT; if (i < T_ * D_ / 4) { v2u w; w.x = pk2(v[k].x, v[k].y); w.y = pk2(v[k].z, v[k].w); ((v2u*)(ws + WS_XB))[i] = w; } } }
}

__device__ __forceinline__ void even_prep(const int wv, int e, LAS unsigned char* lds, int u) {
    const ArgsP a = get_args();
#ifdef NO_EPREP
    return;
#endif
    OPAQUE_TID(); const int lane = tid & 63, wave = tid >> 6;
    unsigned char* ws = a->ws;
    bf16* Z = (bf16*)(ws + WS_Z);
    const int m0 = 64 * u, b = u >> 6, ch = u & 63, t0 = ch * 64;
    { LAS float* cst = (LAS float*)lds; LAS float* snt = cst + 1024;
#pragma unroll 1
      for (int q = tid; q < 1024; q += NTHR) { const int r = q >> 4, i = q & 15; const float inv = exp2f(-(float)i * (18.931568569324174f / 16.f));
          float sn_, cs_; sincosf((float)(t0 + r) * inv, &sn_, &cs_); cst[q] = cs_; snt[q] = sn_; }
      __syncthreads();
      const int row = tid >> 3, head = tid & 7;
      float cs[16], sn[16];
#pragma unroll
      for (int i = 0; i < 4; ++i) { const f32x4 c4 = *(const LAS f32x4*)(cst + row * 16 + 4 * i), s4 = *(const LAS f32x4*)(snt + row * 16 + 4 * i);
          cs[4 * i] = c4.x; cs[4 * i + 1] = c4.y; cs[4 * i + 2] = c4.z; cs[4 * i + 3] = c4.w; sn[4 * i] = s4.x; sn[4 * i + 1] = s4.y; sn[4 * i + 2] = s4.z; sn[4 * i + 3] = s4.w; }
#pragma unroll 1
      for (int qk = 0; qk < 2; ++qk) { v4u* p = (v4u*)(Z + (size_t)(m0 + row) * ZW + qk * 1024 + head * 128);
        v4u w0 = p[0], w1 = p[1], w2 = p[2], w3 = p[3]; unsigned x1[8] = {w0.x, w0.y, w0.z, w0.w, w1.x, w1.y, w1.z, w1.w}, x2[8] = {w2.x, w2.y, w2.z, w2.w, w3.x, w3.y, w3.z, w3.w};
        unsigned o1[8], o2[8];
#pragma unroll
        for (int j = 0; j < 8; ++j) { const float a0 = bflo(x1[j]), a1 = bfhi(x1[j]), b0 = bflo(x2[j]), b1 = bfhi(x2[j]);
            o1[j] = pk2(a0 * cs[2 * j] - b0 * sn[2 * j], a1 * cs[2 * j + 1] - b1 * sn[2 * j + 1]);
            o2[j] = pk2(b0 * cs[2 * j] + a0 * sn[2 * j], b1 * cs[2 * j + 1] + a1 * sn[2 * j + 1]); }
        p[0] = (v4u){o1[0], o1[1], o1[2], o1[3]}; p[1] = (v4u){o1[4], o1[5], o1[6], o1[7]}; p[2] = (v4u){o2[0], o2[1], o2[2], o2[3]}; p[3] = (v4u){o2[4], o2[5], o2[6], o2[7]}; }
    }
    VM_WAIT(); __syncthreads();
    { LAS float* red = (LAS float*)lds;
      const int cg = tid & 127, rq = tid >> 7; float s[8] = {0, 0, 0, 0, 0, 0, 0, 0};
      for (int r = 0; r < 16; ++r) { const v4u w = *(const v4u*)(Z + (size_t)(m0 + rq * 16 + r) * ZW + 1024 + cg * 8);
          s[0] += bflo(w.x); s[1] += bfhi(w.x); s[2] += bflo(w.y); s[3] += bfhi(w.y); s[4] += bflo(w.z); s[5] += bfhi(w.z); s[6] += bflo(w.w); s[7] += bfhi(w.w); }
#pragma unroll
      for (int j = 0; j < 8; ++j) red[rq * 1024 + cg * 8 + j] = s[j];
      __syncthreads();
      if (tid < 256) { f32x4 t = {0, 0, 0, 0};
#pragma unroll
          for (int q = 0; q < 4; ++q) { const f32x4 v = *(const LAS f32x4*)(red + q * 1024 + tid * 4); t += v; }
          const int c = tid * 4, h = c >> 7, d = c & 127;
          *(f32x4*)((float*)(ws + WS_KPART) + ((size_t)((b * 8 + h) * 64 + ch)) * 128 + d) = t; }
      __syncthreads();
    }
    { const int cg = tid & 255, rh = tid >> 8; const int c0 = 8 * cg;
      const float* cw = a->in[3] + (size_t)e * 4 * 2048; const float* cb = a->in[4] + (size_t)e * 2048;
      float w[4][8], bias[8];
#pragma unroll
      for (int j = 0; j < 4; ++j)
#pragma unroll
          for (int i = 0; i < 8; ++i) w[j][i] = cw[j * 2048 + c0 + i];
#pragma unroll
      for (int i = 0; i < 8; ++i) bias[i] = cb[c0 + i];
      float win[3][8];
#pragma unroll
      for (int j = 0; j < 3; ++j) { const int tt = t0 + 32 * rh - 3 + j;
          v4u x = {0, 0, 0, 0}; if (tt >= 0) x = *(const v4u*)(Z + (size_t)(b * SEQ + tt) * ZW + 3072 + c0);
          win[j][0] = bflo(x.x); win[j][1] = bfhi(x.x); win[j][2] = bflo(x.y); win[j][3] = bfhi(x.y); win[j][4] = bflo(x.z); win[j][5] = bfhi(x.z); win[j][6] = bflo(x.w); win[j][7] = bfhi(x.w); }
      bf16* QKB = (bf16*)(ws + WS_QKB);
      for (int r = 0; r < 32; ++r) { const int m = m0 + 32 * rh + r;
          const v4u x = *(const v4u*)(Z + (size_t)m * ZW + 3072 + c0);
          float cur[8] = {bflo(x.x), bfhi(x.x), bflo(x.y), bfhi(x.y), bflo(x.z), bfhi(x.z), bflo(x.w), bfhi(x.w)}; float o[8];
#pragma unroll
          for (int i = 0; i < 8; ++i) { const float v = bias[i] + w[0][i] * win[0][i] + w[1][i] * win[1][i] + w[2][i] * win[2][i] + w[3][i] * cur[i]; o[i] = v * __builtin_amdgcn_rcpf(1.f + __expf(-v));
              win[0][i] = win[1][i]; win[1][i] = win[2][i]; win[2][i] = cur[i]; }
          *(v4u*)(QKB + (size_t)m * 2048 + c0) = (v4u){pk2(o[0], o[1]), pk2(o[2], o[3]), pk2(o[4], o[5]), pk2(o[6], o[7])}; }
    }
    { LAS float* wg = (LAS float*)lds;
      const float* Win = a->in[1] + (size_t)e * 2048 * EVEN_IN;
      for (int i = tid; i < 2048 * 2; i += NTHR) { const int k = i >> 1, hf = i & 1;
          *(LAS f32x4*)(wg + ((((k >> 8) * 4 + (k & 3)) * 2 + hf) * 64 + ((k >> 2) & 63)) * 4) = *(const f32x4*)(Win + (size_t)k * EVEN_IN + ZW + hf * 4); }
      __syncthreads();
      const float* gb = a->in[2] + e * 8;
      for (int rr = 0; rr < 8; ++rr) { const int row = wave * 8 + rr, m = m0 + row; const v2u* xr = (const v2u*)(XIN(a, 2 * e) + (size_t)m * D_) + lane;
          float acc[8] = {0, 0, 0, 0, 0, 0, 0, 0};
#pragma unroll 2
          for (int j = 0; j < 8; ++j) { const v2u xw = xr[64 * j]; const f32x4 xv = {bflo(xw.x), bfhi(xw.x), bflo(xw.y), bfhi(xw.y)};
#pragma unroll
              for (int i = 0; i < 4; ++i) { const f32x4 wa = *(const LAS f32x4*)(wg + (((4 * j + i) * 2) * 64 + lane) * 4), wb = *(const LAS f32x4*)(wg + (((4 * j + i) * 2 + 1) * 64 + lane) * 4); const float xx = xv[i];
                  acc[0] += xx * wa.x; acc[1] += xx * wa.y; acc[2] += xx * wa.z; acc[3] += xx * wa.w; acc[4] += xx * wb.x; acc[5] += xx * wb.y; acc[6] += xx * wb.z; acc[7] += xx * wb.w; } }
#pragma unroll
          for (int j = 0; j < 8; ++j) acc[j] = wave_sum(acc[j]);
          if (lane < 4) { const int h = lane; float ip = 0.f, fp = 0.f;
#pragma unroll
              for (int j = 0; j < 4; ++j) { if (j == h) { ip = acc[j]; fp = acc[4 + j]; } }
              ip += gb[h]; fp += gb[4 + h];
              const float lf = -(fmaxf(-fp, 0.f) + __logf(1.f + __expf(-fabsf(fp))));
              ((float*)(ws + WS_IG))[(size_t)(b * 4 + h) * SEQ + t0 + row] = ip;
              ((LAS float*)(lds + 73728))[h * 64 + row] = ip; ((LAS float*)(lds + 73728 + 1024))[h * 64 + row] = lf; } }
      __syncthreads();
    }
    { LAS float* gi = (LAS float*)(lds + 73728); LAS float* gf = gi + 256; LAS float* wsc = gi + 512;
      const int bh0 = b * 4;
      if (wave < 4) { const int h = wave; float x = gf[h * 64 + lane];
#pragma unroll
          for (int o = 1; o < 64; o <<= 1) { const float t = __shfl_up(x, o); if (lane >= o) x += t; }
          const float b63 = __shfl(x, 63);
          wsc[h * 64 + lane] = __expf(b63 - x + gi[h * 64 + lane]) * 0.0625f;
          ((float*)(ws + WS_BC))[(size_t)(bh0 + h) * SEQ + t0 + lane] = x;
          if (lane == 63) ((float*)(ws + WS_DEC))[(bh0 + h) * 64 + ch] = __expf(b63); }
      __syncthreads();
      constexpr int PV = 544;
      LAS unsigned char* Vt = lds; LAS unsigned char* Kt = lds + 64 * PV;
      const int g4 = lane >> 4, q4 = (lane >> 2) & 3, p4 = lane & 3, fr = lane & 15;
      const int wd = wave & 1, we = wave >> 1;
      const bf16* QKB = (const bf16*)(ws + WS_QKB);
      for (int h = 0; h < 4; ++h) {
          { const int sr = tid >> 3, seg = tid & 7; const float wv_ = wsc[h * 64 + sr];
            const v4u* vs = (const v4u*)(Z + (size_t)(m0 + sr) * ZW + 5120 + h * 256 + 32 * seg); const v4u* ks = (const v4u*)(QKB + (size_t)(m0 + sr) * 2048 + 1024 + h * 256 + 32 * seg);
#pragma unroll
            for (int j = 0; j < 4; ++j) { *(LAS v4u*)(Vt + sr * PV + (32 * seg + 8 * j) * 2) = vs[j]; const v4u kk = ks[j];
                *(LAS v4u*)(Kt + sr * PV + (32 * seg + 8 * j) * 2) = (v4u){pk2(bflo(kk.x) * wv_, bfhi(kk.x) * wv_), pk2(bflo(kk.y) * wv_, bfhi(kk.y) * wv_), pk2(bflo(kk.z) * wv_, bfhi(kk.z) * wv_), pk2(bflo(kk.w) * wv_, bfhi(kk.w) * wv_)}; } }
          __syncthreads();
          if (tid < 256) { float sum = 0.f;
#pragma unroll 8
              for (int sr = 0; sr < 64; ++sr) sum += bf2f(*(const LAS bf16*)(Kt + sr * PV + tid * 2));
              ((float*)(ws + WS_DN))[((size_t)(bh0 + h) * 64 + ch) * 256 + tid] = sum; }
          f32x4 acc[8][4];
#pragma unroll
          for (int i = 0; i < 8; ++i)
#pragma unroll
              for (int j = 0; j < 4; ++j) acc[i][j] = (f32x4){0.f, 0.f, 0.f, 0.f};
#pragma unroll
          for (int ks2 = 0; ks2 < 2; ++ks2) {
              bf16x8 yf[4];
#pragma unroll
              for (int et = 0; et < 4; ++et) { const LAS unsigned char* p = Vt + (32 * ks2 + 8 * g4 + q4) * PV + (64 * we + 16 * et + 4 * p4) * 2;
                  const v2u lo = tr_read(p), hi = tr_read(p + 4 * PV); yf[et] = __builtin_bit_cast(bf16x8, (v4u){lo.x, lo.y, hi.x, hi.y}); }
#pragma unroll
              for (int dt = 0; dt < 8; ++dt) { const LAS unsigned char* p = Kt + (32 * ks2 + 8 * g4 + q4) * PV + (128 * wd + 16 * dt + 4 * p4) * 2;
                  const v2u lo = tr_read(p), hi = tr_read(p + 4 * PV); const bf16x8 xf = __builtin_bit_cast(bf16x8, (v4u){lo.x, lo.y, hi.x, hi.y});
#pragma unroll
                  for (int et = 0; et < 4; ++et) acc[dt][et] = __builtin_amdgcn_mfma_f32_16x16x32_bf16(xf, yf[et], acc[dt][et], 0, 0, 0); } }
          { bf16* DC = (bf16*)(ws + WS_DC) + ((size_t)(bh0 + h) * 64 + ch) * 65536;
#pragma unroll
            for (int et = 0; et < 4; ++et)
#pragma unroll
                for (int dt = 0; dt < 8; ++dt) { const f32x4 v = acc[dt][et];
                    *(v2u*)(DC + (size_t)(64 * we + 16 * et + fr) * 256 + 128 * wd + 16 * dt + 4 * g4) = (v2u){pk2(v.x, v.y), pk2(v.z, v.w)}; } }
          __syncthreads();
      }
    }
}

constexpr int AT_PITCH = 272;
constexpr int AT_BUF = 2 * 64 * AT_PITCH;
constexpr int AT_KM_OFF = 2 * AT_BUF, AT_GATE_OFF = AT_KM_OFF + 16 * 128 * 4, AT_SEL_OFF = AT_GATE_OFF + 256 * 16 * 4, AT_TL_OFF = AT_SEL_OFF + 256 * 4, AT_END = AT_TL_OFF + 80 * 4;
static_assert(AT_END <= RING_BYTES, "attention LDS map");

__device__ __forceinline__ void attn_unit(const int wv, LAS unsigned char* lds, int b, int h, int qb) {
    const ArgsP a = get_args();
#ifdef NO_ATTN
    return;
#endif
    OPAQUE_TID(); const int lane = tid & 63, wave = wv, fr = lane & 15, fq = lane >> 4, q4 = (lane >> 2) & 3, p4 = lane & 3;
    unsigned char* ws = a->ws;
    const bf16* Z = (const bf16*)(ws + WS_Z);
    const int q0 = 256 * qb;
    LAS float* km = (LAS float*)(lds + AT_KM_OFF); LAS float* gate = (LAS float*)(lds + AT_GATE_OFF);
    LAS unsigned* sel = (LAS unsigned*)(lds + AT_SEL_OFF); LAS int* tl = (LAS int*)(lds + AT_TL_OFF);
    if (tid == 0) tl[72] = 0;
    for (int i = tid; i < qb * 128; i += NTHR) { const int n = i >> 7, d = i & 127; const float* kp = (const float*)(ws + WS_KPART) + ((size_t)((b * 8 + h) * 64 + 4 * n)) * 128 + d;
        km[i] = (kp[0] + kp[128] + kp[256] + kp[384]) * (1.f / 256.f); }
    __syncthreads();
    if (qb > 3) { const int ql = tid >> 1, part = tid & 1; const v4u* qp = (const v4u*)(Z + (size_t)(b * SEQ + q0 + ql) * ZW + h * 128);
        float g[8] = {0, 0, 0, 0, 0, 0, 0, 0};
        for (int c = 0; c < 16; ++c) { const v4u w = qp[c]; const float qv[8] = {bflo(w.x), bfhi(w.x), bflo(w.y), bfhi(w.y), bflo(w.z), bfhi(w.z), bflo(w.w), bfhi(w.w)};
#pragma unroll
            for (int jj = 0; jj < 8; ++jj) { const int n = part + 2 * jj; if (n < qb) { const LAS float* kk = km + n * 128 + c * 8;
#pragma unroll
                for (int i = 0; i < 8; ++i) g[jj] += qv[i] * kk[i]; } } }
#pragma unroll
        for (int jj = 0; jj < 8; ++jj) { const int n = part + 2 * jj; if (n < qb) gate[ql * 16 + n] = g[jj]; }
    }
    __syncthreads();
    if (tid < 256) { unsigned m = 0;
        if (qb <= 3) m = (1u << qb) - 1u;
        else { for (int r = 0; r < 3; ++r) { float best = -3.0e38f; int bi = 0; for (int n = 0; n < qb; ++n) { const float g = gate[tid * 16 + n]; if (!((m >> n) & 1u) && g > best) { best = g; bi = n; } } m |= 1u << bi; } }
        sel[tid] = m;
        unsigned wm = m;
#pragma unroll
        for (int o = 1; o < 64; o <<= 1) wm |= __shfl_xor(wm, o);
        if (lane == 0) atomicOr((unsigned*)&tl[72], wm); }
    __syncthreads();
    if (tid == 0) { const unsigned um = (unsigned)tl[72];
        int nt = 0;
        for (int j = 0; j < 4; ++j) tl[1 + nt++] = (4 * qb + j) | (1 << 16);
        for (int n = 0; n < qb; ++n) if ((um >> n) & 1u) for (int j = 0; j < 4; ++j) tl[1 + nt++] = 4 * n + j;
        tl[0] = nt; }
    __syncthreads();
    const int ntile = tl[0];
    const unsigned mysel0 = sel[32 * wave + fr], mysel1 = sel[32 * wave + 16 + fr];
    unsigned wsel = mysel0 | mysel1;
#pragma unroll
    for (int o = 1; o < 16; o <<= 1) wsel |= __shfl_xor(wsel, o);
    bf16x8 qf[2][4];
#pragma unroll
    for (int t = 0; t < 2; ++t) { const v4u* qp = (const v4u*)(Z + (size_t)(b * SEQ + q0 + 32 * wave + 16 * t + fr) * ZW + h * 128);
#pragma unroll
        for (int kc = 0; kc < 4; ++kc) qf[t][kc] = __builtin_bit_cast(bf16x8, qp[kc * 4 + fq]); }
    f32x4 o[2][8];
#pragma unroll
    for (int t = 0; t < 2; ++t)
#pragma unroll
        for (int i = 0; i < 8; ++i) o[t][i] = (f32x4){0.f, 0.f, 0.f, 0.f};
    float mrun[2] = {-INFINITY, -INFINITY}, lrun[2] = {0.f, 0.f};
    const float sc = 0.08838834764831845f * 1.4426950408889634f;
    v4u kr0[2], vr0[2], kr1[2], vr1[2];
    auto gload = [&](int ti, v4u (&kr)[2], v4u (&vr)[2]) { const int key0 = 64 * (tl[1 + ti] & 0xffff);
        const v4u* kp = (const v4u*)(Z + (size_t)(b * SEQ + key0 + (tid >> 3)) * ZW + 1024 + h * 128) + (tid & 7) * 2; kr[0] = kp[0]; kr[1] = kp[1]; vr[0] = kp[128]; vr[1] = kp[129]; };
    auto lstore = [&](int bufi, const v4u (&kr)[2], const v4u (&vr)[2]) { LAS v4u* kd = (LAS v4u*)(lds + bufi * AT_BUF + (tid >> 3) * AT_PITCH + (tid & 7) * 32); kd[0] = kr[0]; kd[1] = kr[1];
        LAS v4u* vd = (LAS v4u*)(lds + bufi * AT_BUF + 64 * AT_PITCH + (tid >> 3) * AT_PITCH + (tid & 7) * 32); vd[0] = vr[0]; vd[1] = vr[1]; };
    gload(0, kr0, vr0); gload(1, kr1, vr1); lstore(0, kr0, vr0); __syncthreads();
    auto tile = [&](const int ti, v4u (&ldk)[2], v4u (&ldv)[2], const v4u (&stk)[2], const v4u (&stv)[2]) {
        const int ent = __builtin_amdgcn_readfirstlane(tl[1 + ti]); const int kt64 = ent & 0xffff; const bool own = (ent >> 16) & 1; const int key0 = 64 * kt64;
        if (ti + 2 < ntile) gload(ti + 2, ldk, ldv);
        const LAS unsigned char* Kt = lds + (ti & 1) * AT_BUF; const LAS unsigned char* Vt = Kt + 64 * AT_PITCH;
        const bool wave_active = own ? (key0 <= q0 + 32 * wave + 31) : (((wsel >> (kt64 >> 2)) & 1u) != 0u);
        if (wave_active) {
            f32x4 s[2][4];
            { bf16x8 kfa[2][4], kfb[2][4];
#pragma unroll
              for (int kt = 0; kt < 2; ++kt)
#pragma unroll
                  for (int kc = 0; kc < 4; ++kc) kfa[kt][kc] = *(const LAS bf16x8*)(Kt + (16 * kt + fr) * AT_PITCH + (kc * 32 + fq * 8) * 2);
#pragma unroll
              for (int kt = 0; kt < 2; ++kt)
#pragma unroll
                  for (int kc = 0; kc < 4; ++kc) kfb[kt][kc] = *(const LAS bf16x8*)(Kt + (16 * (kt + 2) + fr) * AT_PITCH + (kc * 32 + fq * 8) * 2);
              __builtin_amdgcn_sched_barrier(0);
#pragma unroll
              for (int kt = 0; kt < 2; ++kt) { s[0][kt] = (f32x4){0.f, 0.f, 0.f, 0.f}; s[1][kt] = (f32x4){0.f, 0.f, 0.f, 0.f};
#pragma unroll
                  for (int kc = 0; kc < 4; ++kc) { s[0][kt] = __builtin_amdgcn_mfma_f32_16x16x32_bf16(kfa[kt][kc], qf[0][kc], s[0][kt], 0, 0, 0); s[1][kt] = __builtin_amdgcn_mfma_f32_16x16x32_bf16(kfa[kt][kc], qf[1][kc], s[1][kt], 0, 0, 0); } }
              __builtin_amdgcn_sched_barrier(0);
#pragma unroll
              for (int kt = 0; kt < 2; ++kt) { s[0][kt + 2] = (f32x4){0.f, 0.f, 0.f, 0.f}; s[1][kt + 2] = (f32x4){0.f, 0.f, 0.f, 0.f};
#pragma unroll
                  for (int kc = 0; kc < 4; ++kc) { s[0][kt + 2] = __builtin_amdgcn_mfma_f32_16x16x32_bf16(kfb[kt][kc], qf[0][kc], s[0][kt + 2], 0, 0, 0); s[1][kt + 2] = __builtin_amdgcn_mfma_f32_16x16x32_bf16(kfb[kt][kc], qf[1][kc], s[1][kt + 2], 0, 0, 0); } }
            }
            bf16x8 vfa[4][2];
#pragma unroll
            for (int dt = 0; dt < 4; ++dt)
#pragma unroll
                for (int j = 0; j < 2; ++j) { const LAS unsigned char* vp = Vt + (32 * j + 4 * fq + q4) * AT_PITCH + (16 * dt + 4 * p4) * 2;
                    const v2u lo = tr_read(vp), hi = tr_read(vp + 16 * AT_PITCH); vfa[dt][j] = __builtin_bit_cast(bf16x8, (v4u){lo.x, lo.y, hi.x, hi.y}); }
            __builtin_amdgcn_sched_barrier(0);
            bf16x8 pf[2][2];
            const bool diag = own && (key0 + 63 > q0 + 32 * wave);
#pragma unroll
            for (int t = 0; t < 2; ++t) { const int qabs = q0 + 32 * wave + 16 * t + fr; const unsigned ms = t ? mysel1 : mysel0;
                const bool qsel = own || ((ms >> (kt64 >> 2)) & 1u);
                if (diag) {
#pragma unroll
                    for (int kt = 0; kt < 4; ++kt)
#pragma unroll
                        for (int e = 0; e < 4; ++e) { const int kabs = key0 + 16 * kt + 4 * fq + e; if (kabs > qabs) s[t][kt][e] = -INFINITY; } }
                float mx = s[t][0][0];
#pragma unroll
                for (int kt = 0; kt < 4; ++kt)
#pragma unroll
                    for (int e = 0; e < 4; ++e) mx = fmaxf(mx, s[t][kt][e]);
                mx = qsel ? mx * sc : -INFINITY;
                mx = fmaxf(mx, __shfl_xor(mx, 16)); mx = fmaxf(mx, __shfl_xor(mx, 32));
                const bool need = mx > mrun[t] + 8.f;
                if (__builtin_amdgcn_ballot_w64(need) != 0ull) {
                    const float mnew = need ? mx : mrun[t];
                    const float alpha = need ? __builtin_amdgcn_exp2f(mrun[t] - mnew) : 1.f;
                    lrun[t] *= alpha; mrun[t] = mnew;
#pragma unroll
                    for (int i = 0; i < 8; ++i) o[t][i] *= alpha; }
                const float scl = qsel ? sc : 0.f, nbias = qsel ? -mrun[t] : -1.0e30f;
                float psum = 0.f;
#pragma unroll
                for (int kt = 0; kt < 4; ++kt)
#pragma unroll
                    for (int e = 0; e < 4; ++e) { const float p = __builtin_amdgcn_exp2f(fmaf(s[t][kt][e], scl, nbias)); s[t][kt][e] = p; psum += p; }
                lrun[t] += psum;
#pragma unroll
                for (int j = 0; j < 2; ++j) { const v4u w = {pk2(s[t][2 * j][0], s[t][2 * j][1]), pk2(s[t][2 * j][2], s[t][2 * j][3]), pk2(s[t][2 * j + 1][0], s[t][2 * j + 1][1]), pk2(s[t][2 * j + 1][2], s[t][2 * j + 1][3])};
                    pf[t][j] = __builtin_bit_cast(bf16x8, w); } }
            { bf16x8 vfb[4][2];
              __builtin_amdgcn_sched_barrier(0);
#pragma unroll
              for (int dt = 0; dt < 4; ++dt)
#pragma unroll
                  for (int j = 0; j < 2; ++j) { const LAS unsigned char* vp = Vt + (32 * j + 4 * fq + q4) * AT_PITCH + (16 * (dt + 4) + 4 * p4) * 2;
                      const v2u lo = tr_read(vp), hi = tr_read(vp + 16 * AT_PITCH); vfb[dt][j] = __builtin_bit_cast(bf16x8, (v4u){lo.x, lo.y, hi.x, hi.y}); }
              __builtin_amdgcn_sched_barrier(0);
#pragma unroll
              for (int dt = 0; dt < 4; ++dt)
#pragma unroll
                  for (int j = 0; j < 2; ++j) { o[0][dt] = __builtin_amdgcn_mfma_f32_16x16x32_bf16(vfa[dt][j], pf[0][j], o[0][dt], 0, 0, 0); o[1][dt] = __builtin_amdgcn_mfma_f32_16x16x32_bf16(vfa[dt][j], pf[1][j], o[1][dt], 0, 0, 0); }
              __builtin_amdgcn_sched_barrier(0);
#pragma unroll
              for (int dt = 0; dt < 4; ++dt)
#pragma unroll
                  for (int j = 0; j < 2; ++j) { o[0][dt + 4] = __builtin_amdgcn_mfma_f32_16x16x32_bf16(vfb[dt][j], pf[0][j], o[0][dt + 4], 0, 0, 0); o[1][dt + 4] = __builtin_amdgcn_mfma_f32_16x16x32_bf16(vfb[dt][j], pf[1][j], o[1][dt + 4], 0, 0, 0); }
            }
        }
        if (ti + 1 < ntile) lstore((ti + 1) & 1, stk, stv);
        __syncthreads();
    };
    for (int ti = 0; ti < ntile; ti += 2) { tile(ti, kr0, vr0, kr1, vr1); if (ti + 1 < ntile) tile(ti + 1, kr1, vr1, kr0, vr0); }
#pragma unroll
    for (int t = 0; t < 2; ++t) { float lt = lrun[t]; lt += __shfl_xor(lt, 16); lt += __shfl_xor(lt, 32);
        const float inv = 1.f / lt;
        bf16* Y = (bf16*)(ws + WS_YE) + (size_t)(b * SEQ + q0 + 32 * wave + 16 * t + fr) * 2048 + h * 128;
#pragma unroll
        for (int dt = 0; dt < 8; ++dt) { v2u w; w.x = pk2(o[t][dt][0] * inv, o[t][dt][1] * inv); w.y = pk2(o[t][dt][2] * inv, o[t][dt][3] * inv); *(v2u*)(Y + 16 * dt + 4 * fq) = w; } }
    __syncthreads();
}

__device__ __forceinline__ void mlstm_scan(const int wv) {
    const ArgsP a = get_args();
    OPAQUE_TID();
    unsigned char* ws = a->ws;
    const int gt = blockIdx.x * NTHR + tid, NGT = gridDim.x * NTHR;
    for (int idx = gt; idx < 16 * 256 * 32; idx += NGT) { const int bh = idx >> 13, rem = idx & 8191;
        const bf16* DC = (const bf16*)(ws + WS_DC) + (size_t)bh * 64 * 65536 + rem * 8; bf16* CP = (bf16*)(ws + WS_CP) + (size_t)bh * 64 * 65536 + rem * 8;
        const float* dec = (const float*)(ws + WS_DEC) + bh * 64;
        float C[8] = {0, 0, 0, 0, 0, 0, 0, 0};
        for (int c0 = 0; c0 < 64; c0 += 16) { v4u in[16];
#pragma unroll
            for (int j = 0; j < 16; ++j) in[j] = __builtin_nontemporal_load((const v4u*)(DC + (size_t)(c0 + j) * 65536));
#pragma unroll
            for (int j = 0; j < 16; ++j) { const float dc = dec[c0 + j];
                *(v4u*)(CP + (size_t)(c0 + j) * 65536) = (v4u){pk2(C[0], C[1]), pk2(C[2], C[3]), pk2(C[4], C[5]), pk2(C[6], C[7])};
                C[0] = fmaf(dc, C[0], bflo(in[j].x)); C[1] = fmaf(dc, C[1], bfhi(in[j].x)); C[2] = fmaf(dc, C[2], bflo(in[j].y)); C[3] = fmaf(dc, C[3], bfhi(in[j].y));
                C[4] = fmaf(dc, C[4], bflo(in[j].z)); C[5] = fmaf(dc, C[5], bfhi(in[j].z)); C[6] = fmaf(dc, C[6], bflo(in[j].w)); C[7] = fmaf(dc, C[7], bfhi(in[j].w)); } }
    }
    for (int idx = gt; idx < 16 * 256; idx += NGT) { const int bh = idx >> 8, d = idx & 255; const float* DN = (const float*)(ws + WS_DN) + (size_t)bh * 64 * 256 + d; float* NP = (float*)(ws + WS_NP) + (size_t)bh * 64 * 256 + d;
        const float* dec = (const float*)(ws + WS_DEC) + bh * 64; float n = 0.f;
        for (int c = 0; c < 64; ++c) { NP[c * 256] = n; n = fmaf(dec[c], n, DN[c * 256]); } }
}

constexpr int M3_PQ = 528, M3_PVv = 544, M3_PP = 144;
constexpr int M3_Q = 0, M3_K = 64 * M3_PQ, M3_V = 2 * 64 * M3_PQ, M3_P = M3_V + 64 * M3_PVv, M3_F = M3_P + 64 * M3_PP;
__device__ __forceinline__ void mlstm_out_unit(const int wv, LAS unsigned char* lds, int e_, int b, int h, int c) {
    const ArgsP a = get_args();
    OPAQUE_TID(); const int lane = tid & 63, wave = wv, fr = lane & 15, fq = lane >> 4, q4 = (lane >> 2) & 3, p4 = lane & 3;
    unsigned char* ws = a->ws;
    const int bh = b * 4 + h, m0 = b * SEQ + 64 * c;
    const bf16* QKB = (const bf16*)(ws + WS_QKB); const bf16* Z = (const bf16*)(ws + WS_Z);
    LAS unsigned char* Qt = lds + M3_Q; LAS unsigned char* Kt = lds + M3_K; LAS unsigned char* Vt = lds + M3_V; LAS unsigned char* Pm = lds + M3_P;
    LAS float* F = (LAS float*)(lds + M3_F); LAS float* bt = F; LAS float* itv = F + 64; LAS float* ebt = F + 128; LAS float* den = F + 192; LAS float* rstd = F + 256; LAS float* np = F + 320; LAS float* rsp = F + 576;
    { const int sr = tid >> 3, seg = tid & 7;
      const v4u* qs = (const v4u*)(QKB + (size_t)(m0 + sr) * 2048 + h * 256 + 32 * seg); const v4u* ks = (const v4u*)(QKB + (size_t)(m0 + sr) * 2048 + 1024 + h * 256 + 32 * seg);
      const v4u* vs = (const v4u*)(Z + (size_t)(m0 + sr) * ZW + 5120 + h * 256 + 32 * seg);
#pragma unroll
      for (int j = 0; j < 4; ++j) { *(LAS v4u*)(Qt + sr * M3_PQ + (32 * seg + 8 * j) * 2) = qs[j]; *(LAS v4u*)(Kt + sr * M3_PQ + (32 * seg + 8 * j) * 2) = ks[j]; *(LAS v4u*)(Vt + sr * M3_PVv + (32 * seg + 8 * j) * 2) = vs[j]; }
      if (tid < 64) { const float bb = ((const float*)(ws + WS_BC))[(size_t)bh * SEQ + 64 * c + tid]; bt[tid] = bb; ebt[tid] = __expf(bb); itv[tid] = ((const float*)(ws + WS_IG))[(size_t)bh * SEQ + 64 * c + tid]; }
      else if (tid < 320) np[tid - 64] = ((const float*)(ws + WS_NP))[((size_t)bh * 64 + c) * 256 + tid - 64]; }
    v4u cf[8][2];
    { const bf16* CP = (const bf16*)(ws + WS_CP) + ((size_t)bh * 64 + c) * 65536 + (size_t)(32 * wave + fr) * 256 + 8 * fq;
#pragma unroll
      for (int kk = 0; kk < 8; ++kk)
#pragma unroll
          for (int et = 0; et < 2; ++et) cf[kk][et] = *(const v4u*)(CP + et * 16 * 256 + 32 * kk); }
    __syncthreads();
    { const int ss = wave >> 1;
#pragma unroll
      for (int ti = 0; ti < 2; ++ti) { const int tt = 2 * (wave & 1) + ti; f32x4 sacc = {0.f, 0.f, 0.f, 0.f};
#pragma unroll
          for (int kk = 0; kk < 8; ++kk) { const bf16x8 kf = *(const LAS bf16x8*)(Kt + (16 * ss + fr) * M3_PQ + (32 * kk + 8 * fq) * 2), qf = *(const LAS bf16x8*)(Qt + (16 * tt + fr) * M3_PQ + (32 * kk + 8 * fq) * 2);
              sacc = __builtin_amdgcn_mfma_f32_16x16x32_bf16(kf, qf, sacc, 0, 0, 0); }
          const int t = 16 * tt + fr; const float btv = bt[t]; float pv[4];
#pragma unroll
          for (int r = 0; r < 4; ++r) { const int s_ = 16 * ss + 4 * fq + r; pv[r] = (s_ <= t) ? sacc[r] * __expf(btv - bt[s_] + itv[s_]) * 0.0625f : 0.f; }
          *(LAS v2u*)(Pm + t * M3_PP + (16 * ss + 4 * fq) * 2) = (v2u){pk2(pv[0], pv[1]), pk2(pv[2], pv[3])}; } }
    float qn;
    { const int t = tid >> 3, part = tid & 7; float sacc = 0.f;
#pragma unroll
      for (int j = 0; j < 4; ++j) { const v4u w = *(const LAS v4u*)(Qt + t * M3_PQ + (32 * part + 8 * j) * 2); const LAS float* nn = np + 32 * part + 8 * j;
          sacc += bflo(w.x) * nn[0] + bfhi(w.x) * nn[1] + bflo(w.y) * nn[2] + bfhi(w.y) * nn[3] + bflo(w.z) * nn[4] + bfhi(w.z) * nn[5] + bflo(w.w) * nn[6] + bfhi(w.w) * nn[7]; }
      sacc += dppf<0xB1>(sacc); sacc += dppf<0x4E>(sacc); sacc += dppf<0x141>(sacc); qn = sacc; }
    __syncthreads();
    { const int t = tid >> 3, part = tid & 7; const v4u w = *(const LAS v4u*)(Pm + t * M3_PP + part * 16);
      float ps = bflo(w.x) + bfhi(w.x) + bflo(w.y) + bfhi(w.y) + bflo(w.z) + bfhi(w.z) + bflo(w.w) + bfhi(w.w);
      ps += dppf<0xB1>(ps); ps += dppf<0x4E>(ps); ps += dppf<0x141>(ps);
      if (part == 0) den[t] = ebt[t] * qn + ps; }
    f32x4 acc[4][2];
#pragma unroll
    for (int tt = 0; tt < 4; ++tt) { acc[tt][0] = (f32x4){0.f, 0.f, 0.f, 0.f}; acc[tt][1] = (f32x4){0.f, 0.f, 0.f, 0.f}; }
#pragma unroll
    for (int kk = 0; kk < 8; ++kk)
#pragma unroll
        for (int tt = 0; tt < 4; ++tt) { const bf16x8 qf = *(const LAS bf16x8*)(Qt + (16 * tt + fr) * M3_PQ + (32 * kk + 8 * fq) * 2);
            acc[tt][0] = __builtin_amdgcn_mfma_f32_16x16x32_bf16(qf, __builtin_bit_cast(bf16x8, cf[kk][0]), acc[tt][0], 0, 0, 0);
            acc[tt][1] = __builtin_amdgcn_mfma_f32_16x16x32_bf16(qf, __builtin_bit_cast(bf16x8, cf[kk][1]), acc[tt][1], 0, 0, 0); }
#pragma unroll
    for (int tt = 0; tt < 4; ++tt) { const f32x4 eb = *(const LAS f32x4*)(ebt + 16 * tt + 4 * fq); acc[tt][0] *= eb; acc[tt][1] *= eb; }
#pragma unroll
    for (int j = 0; j < 2; ++j) { bf16x8 vf[2];
#pragma unroll
        for (int et = 0; et < 2; ++et) { const LAS unsigned char* p = Vt + (32 * j + 8 * fq + q4) * M3_PVv + (32 * wave + 16 * et + 4 * p4) * 2;
            const v2u lo = tr_read(p), hi = tr_read(p + 4 * M3_PVv); vf[et] = __builtin_bit_cast(bf16x8, (v4u){lo.x, lo.y, hi.x, hi.y}); }
#pragma unroll
        for (int tt = 0; tt < 4; ++tt) { const bf16x8 pf = *(const LAS bf16x8*)(Pm + (16 * tt + fr) * M3_PP + (32 * j + 8 * fq) * 2);
            acc[tt][0] = __builtin_amdgcn_mfma_f32_16x16x32_bf16(pf, vf[0], acc[tt][0], 0, 0, 0); acc[tt][1] = __builtin_amdgcn_mfma_f32_16x16x32_bf16(pf, vf[1], acc[tt][1], 0, 0, 0); } }
    __syncthreads();
    LAS unsigned char* Ht = Qt;
#pragma unroll
    for (int tt = 0; tt < 4; ++tt) { const f32x4 dn = *(const LAS f32x4*)(den + 16 * tt + 4 * fq); float ssq[4];
#pragma unroll
        for (int r = 0; r < 4; ++r) { const float dv = __builtin_amdgcn_rcpf(fmaxf(fabsf(dn[r]), 1.f)); const float h0 = acc[tt][0][r] * dv, h1 = acc[tt][1][r] * dv; ssq[r] = red16(h0 * h0 + h1 * h1);
            const int t = 16 * tt + 4 * fq + r;
            *(LAS bf16*)(Ht + t * M3_PQ + (32 * wave + fr) * 2) = (bf16)f2bf(h0); *(LAS bf16*)(Ht + t * M3_PQ + (32 * wave + 16 + fr) * 2) = (bf16)f2bf(h1); }
        if (fr == 0) *(LAS f32x4*)(rsp + wave * 64 + 16 * tt + 4 * fq) = (f32x4){ssq[0], ssq[1], ssq[2], ssq[3]}; }
    __syncthreads();
    if (tid < 64) { float tot = 0.f;
#pragma unroll
        for (int w = 0; w < 8; ++w) tot += rsp[w * 64 + tid];
        rstd[tid] = 1.f / sqrtf(tot * (1.f / 256.f) + 1e-6f); }
    __syncthreads();
    { const int t = tid >> 3, seg = tid & 7; const float rs = rstd[t]; const float* hg = a->in[5] + (size_t)e_ * 1024 + h * 256 + 32 * seg;
      const v4u* os = (const v4u*)(Z + (size_t)(m0 + t) * ZW + 6144 + h * 256 + 32 * seg); v4u* yd = (v4u*)((bf16*)(ws + WS_YE) + (size_t)(m0 + t) * 2048 + 1024 + h * 256 + 32 * seg);
#pragma unroll
      for (int j = 0; j < 4; ++j) { const v4u hw = *(const LAS v4u*)(Ht + t * M3_PQ + (32 * seg + 8 * j) * 2), ow = os[j]; const f32x4 g0 = *(const f32x4*)(hg + 8 * j), g1 = *(const f32x4*)(hg + 8 * j + 4);
          yd[j] = (v4u){pk2(bflo(hw.x) * rs * g0.x * sigmoidf_(bflo(ow.x)), bfhi(hw.x) * rs * g0.y * sigmoidf_(bfhi(ow.x))), pk2(bflo(hw.y) * rs * g0.z * sigmoidf_(bflo(ow.y)), bfhi(hw.y) * rs * g0.w * sigmoidf_(bfhi(ow.y))),
                        pk2(bflo(hw.z) * rs * g1.x * sigmoidf_(bflo(ow.z)), bfhi(hw.z) * rs * g1.y * sigmoidf_(bfhi(ow.z))), pk2(bflo(hw.w) * rs * g1.z * sigmoidf_(bflo(ow.w)), bfhi(hw.w) * rs * g1.w * sigmoidf_(bfhi(ow.w)))}; } }
    __syncthreads();
}

__device__ __forceinline__ void odd_prep(const int wv, int o) {
    const ArgsP a = get_args();
#ifdef NO_OPREP
    return;
#endif
    OPAQUE_TID(); const int lane = tid & 63, wave = tid >> 6;
    unsigned char* ws = a->ws;
    const float* mu = a->in[7] + (size_t)o * 6 * 2048;
    bf16* XR = (bf16*)(ws + WS_XRKV); bf16* XK = XR + (size_t)T_ * 2048; bf16* XV = XK + (size_t)T_ * 2048; bf16* XC = (bf16*)(ws + WS_XC);
    const int gw = blockIdx.x * NWAVES + wave, NGW = gridDim.x * NWAVES;
    for (int m = gw; m < T_; m += NGW) { const bool first = (m % SEQ) == 0;
        const f32x4* xr = (const f32x4*)(a->out + (size_t)m * D_) + lane; const f32x4* xp = (const f32x4*)(a->out + (size_t)(m - 1) * D_) + lane;
#pragma unroll
        for (int j = 0; j < 8; ++j) { const f32x4 x = xr[64 * j]; f32x4 p = {0.f, 0.f, 0.f, 0.f}; if (!first) p = xp[64 * j]; const f32x4 dx = p - x;
            const f32x4 m0 = ((const f32x4*)mu)[lane + 64 * j], m2 = ((const f32x4*)(mu + 2 * 2048))[lane + 64 * j], m3 = ((const f32x4*)(mu + 3 * 2048))[lane + 64 * j];
            const f32x4 r = x + dx * m0, k = x + dx * m2, v = x + dx * m3; const size_t off = (size_t)m * 2048 + 4 * (lane + 64 * j);
            *(v2u*)(XR + off) = (v2u){pk2(r.x, r.y), pk2(r.z, r.w)}; *(v2u*)(XK + off) = (v2u){pk2(k.x, k.y), pk2(k.z, k.w)}; *(v2u*)(XV + off) = (v2u){pk2(v.x, v.y), pk2(v.z, v.w)};
            const size_t offc = (size_t)m * 4096 + 4 * (lane + 64 * j);
            *(v2u*)(XC + offc) = (v2u){pk2(x.x, x.y), pk2(x.z, x.w)}; *(v2u*)(XC + offc + 2048) = (v2u){pk2(dx.x, dx.y), pk2(dx.z, dx.w)}; }
    }
}

constexpr int RK_KQ = 0, RK_RQ = 4096, RK_TAB = 8192, RK_XU = 9216, RK_W4 = 17408, RK_VB = 19456, RK_CBUF = 27648;
constexpr int RK_PB0 = 3 * RK_CBUF, RK_PG = 0, RK_PV = 4096, RK_PBON = 8192, RK_PBSZ = 8320;
constexpr int RK_Y0 = RK_PB0 + 4 * RK_PBSZ, RK_YSZ = 64 * 36 * 4;
constexpr int RK_XS = RK_Y0 + 2 * RK_YSZ;
constexpr int RK_ZERO = RK_XS + 16384;
static_assert(RK_ZERO + 8192 <= RING_BYTES, "rwkv LDS map");
__device__ __forceinline__ float dot16(const f32x4 x, const f32x4 y) { return red16(x.x * y.x + x.y * y.y + x.z * y.z + x.w * y.w); }
__device__ __forceinline__ v2u pk4(const f32x4 v) { return (v2u){pk2(v.x, v.y), pk2(v.z, v.w)}; }
__device__ __forceinline__ f32x4 unpk4(const v2u w) { return (f32x4){bflo(w.x), bfhi(w.x), bflo(w.y), bfhi(w.y)}; }

template <bool DRY = false> __device__ __forceinline__ void rwkv_unit(const int wv, LAS unsigned char* lds, int o, int b, int h) {
    const ArgsP a = get_args();
#ifdef NO_RWKV
    return;
#endif
    OPAQUE_TID(); const int lane = tid & 63, fr = lane & 15, fq = lane >> 4;
    unsigned char* ws = a->ws;
    constexpr int NCH = SEQ / 32;
    for (int i = tid; i < 8192 / 16; i += NTHR) *(LAS v4u*)(lds + RK_ZERO + 16 * i) = (v4u){0u, 0u, 0u, 0u};
    if (wv < 4) {
        f32x4 S[4];
#pragma unroll
        for (int kt = 0; kt < 4; ++kt) S[kt] = (f32x4){0.f, 0.f, 0.f, 0.f};
        const int row = 16 * wv + fr;
        const bool f0 = fq == 0;
        struct Ops { v2u kq[4], rq[4]; f32x4 tab[8], vv, w4[4]; v4u xu[4]; };
        auto load_ops = [&](const LAS unsigned char* B, const LAS unsigned char* xb, int bk, Ops& o) {
            const LAS unsigned char* kp = B + RK_KQ + bk * 512 + (fr & 3) * 128 + 8 * fq; const LAS unsigned char* rp = kp + (RK_RQ - RK_KQ);
#pragma unroll
            for (int ks = 0; ks < 2; ++ks) { o.kq[2 * ks] = *(const LAS v2u*)(kp + 64 * ks); o.kq[2 * ks + 1] = *(const LAS v2u*)(kp + 64 * ks + 32); o.rq[2 * ks] = *(const LAS v2u*)(rp + 64 * ks); o.rq[2 * ks + 1] = *(const LAS v2u*)(rp + 64 * ks + 32); }
#pragma unroll
            for (int i = 0; i < 8; ++i) o.tab[i] = *(const LAS f32x4*)(B + RK_TAB + bk * 128 + 16 * i);
            o.vv = *(const LAS f32x4*)(B + RK_VB + bk * 1024 + row * 16);
#pragma unroll
            for (int kt = 0; kt < 4; ++kt) { o.w4[kt] = *(const LAS f32x4*)(B + RK_W4 + bk * 256 + (16 * kt + 4 * fq) * 4); o.xu[kt] = *(const LAS v4u*)(xb + bk * 1024 + (16 * kt + fr) * 16); } };
        auto step = [&](const Ops& o, f32x4& yout) {
            bf16x8 ys[2];
#pragma unroll
            for (int ks = 0; ks < 2; ++ks) { const v4u w = {pk2(S[2 * ks][0], S[2 * ks][1]), pk2(S[2 * ks][2], S[2 * ks][3]), pk2(S[2 * ks + 1][0], S[2 * ks + 1][1]), pk2(S[2 * ks + 1][2], S[2 * ks + 1][3])}; ys[ks] = __builtin_bit_cast(bf16x8, w); }
            f32x4 du = {0.f, 0.f, 0.f, 0.f}, dy = {0.f, 0.f, 0.f, 0.f};
#pragma unroll
            for (int ks = 0; ks < 2; ++ks) {
                du = __builtin_amdgcn_mfma_f32_16x16x32_bf16(__builtin_bit_cast(bf16x8, (v4u){o.kq[2 * ks].x, o.kq[2 * ks].y, o.kq[2 * ks + 1].x, o.kq[2 * ks + 1].y}), ys[ks], du, 0, 0, 0);
                dy = __builtin_amdgcn_mfma_f32_16x16x32_bf16(__builtin_bit_cast(bf16x8, (v4u){o.rq[2 * ks].x, o.rq[2 * ks].y, o.rq[2 * ks + 1].x, o.rq[2 * ks + 1].y}), ys[ks], dy, 0, 0, 0); }
            const f32x4 t0 = o.tab[0], t1 = o.tab[1], t2 = o.tab[2], t3 = o.tab[3], t4 = o.tab[4], t5 = o.tab[5], t6 = o.tab[6], t7 = o.tab[7]; const f32x4 vv = o.vv;
#define FMA_(a, b, c) ([](float x_, float y_, float z_) { float r_; asm("v_fma_f32 %0, %1, %2, %3" : "=v"(r_) : "v"(x_), "v"(y_), "v"(z_)); return r_; }((a), (b), (c)))
#define FNMA_(a, b, c) ([](float x_, float y_, float z_) { float r_; asm("v_fma_f32 %0, -%1, %2, %3" : "=v"(r_) : "v"(x_), "v"(y_), "v"(z_)); return r_; }((a), (b), (c)))
            const float u0 = du[0] + 0.f * vv.x;
            float a1_ = fmaf(vv.x, t0.x, du[1]);
            float a2_ = FMA_(vv.y, t0.w, fmaf(vv.x, t0.z, du[2]));
            float a3_ = FMA_(vv.z, t2.x, FMA_(vv.y, t1.w, fmaf(vv.x, t1.z, du[3])));
            float b0_ = fmaf(vv.x, t3.x, dy[0]);
            float b1_ = FMA_(vv.y, t3.w, fmaf(vv.x, t3.z, dy[1]));
            float b2_ = FMA_(vv.z, t5.x, FMA_(vv.y, t4.w, fmaf(vv.x, t4.z, dy[2])));
            float b3_ = FMA_(vv.w, t6.w, FMA_(vv.z, t6.z, FMA_(vv.y, t6.y, fmaf(vv.x, t6.x, dy[3]))));
            const float u1 = FNMA_(u0, t0.y, a1_);
            a2_ = FNMA_(u0, t1.x, a2_); a3_ = FNMA_(u0, t2.y, a3_); b0_ = FNMA_(u0, t3.y, b0_); b1_ = FNMA_(u0, t4.x, b1_); b2_ = FNMA_(u0, t5.y, b2_); b3_ = FNMA_(u0, t7.x, b3_);
            const float u2 = FNMA_(u1, t1.y, a2_);
            a3_ = FNMA_(u1, t2.z, a3_); b1_ = FNMA_(u1, t4.y, b1_); b2_ = FNMA_(u1, t5.z, b2_); b3_ = FNMA_(u1, t7.y, b3_);
            const float u3 = FNMA_(u2, t2.w, a3_);
            b2_ = FNMA_(u2, t5.w, b2_); b3_ = FNMA_(u2, t7.z, b3_);
            b3_ = FNMA_(u3, t7.w, b3_);
            yout.x = b0_; yout.y = b1_; yout.z = b2_; yout.w = b3_;
#undef FMA_
#undef FNMA_
            const bf16x8 yop = __builtin_bit_cast(bf16x8, (v4u){pk2(vv.x, vv.y), pk2(vv.z, vv.w), pk2(u0, u1), pk2(u2, u3)});
#pragma unroll
            for (int kt = 0; kt < 4; ++kt) S[kt] = __builtin_amdgcn_mfma_f32_16x16x32_bf16(__builtin_bit_cast(bf16x8, o.xu[kt]), yop, S[kt] * o.w4[kt], 0, 0, 0); };
        __syncthreads();
        __builtin_amdgcn_s_setprio(3);
#ifdef PROBE_RWKV
        float pacc_iter = 0.f, pacc_comp = 0.f;
#endif
        for (int c = 0; c < NCH; ++c) {
            const LAS unsigned char* B = lds + (c % 3) * RK_CBUF; LAS float* yb = (LAS float*)(lds + RK_Y0 + (c & 1) * RK_YSZ) + row * 36;
            const LAS unsigned char* xb = f0 ? B + RK_XU : (const LAS unsigned char*)(lds + RK_ZERO);
            Ops oa, ob; f32x4 yk[8];
#ifdef PROBE_RWKV
            const unsigned long long pt0 = __builtin_amdgcn_s_memtime();
#endif
            load_ops(B, xb, 0, oa);
#pragma unroll
            for (int bp = 0; bp < 4; ++bp) { load_ops(B, xb, 2 * bp + 1, ob); step(oa, yk[2 * bp]); if (bp < 3) load_ops(B, xb, 2 * bp + 2, oa); step(ob, yk[2 * bp + 1]); }
            if (f0) {
#pragma unroll
                for (int bk = 0; bk < 8; ++bk) *(LAS f32x4*)(yb + 4 * bk) = yk[bk]; }
#ifdef PROBE_RWKV
            const unsigned long long pt1 = __builtin_amdgcn_s_memtime();
#endif
            __syncthreads();
#ifdef PROBE_RWKV
            { const unsigned long long pt2 = __builtin_amdgcn_s_memtime();
              if (c >= 8) { pacc_iter += (float)(pt2 - pt0); pacc_comp += (float)(pt1 - pt0); }
              if (c == NCH - 1 && o == 1 && blockIdx.x == 0 && wv == 0 && lane == 0) { float* pw = (float*)(ws + WS_CTL) + 200000;
                  pw[0] = __expf(rintf(__logf(pacc_iter * (1.f / 120.f)) * 20.f) * 0.05f); pw[1] = __expf(rintf(__logf(pacc_comp * (1.f / 120.f)) * 20.f) * 0.05f); } }
#endif
        }
        __builtin_amdgcn_s_setprio(0);
    } else {
        const int pr = (wv - 4) >> 1, w2 = (wv - 4) & 1, ptid = w2 * 64 + lane, g8 = ptid >> 4, kq = ptid & 15;
        const size_t ub = ((size_t)b * SEQ * 2048 + h * 64) * 2;
        const char* Rs = (const char*)(ws + WS_RKV) + ub; const char* Ks = Rs + (size_t)T_ * 2048 * 2; const char* Vs = Ks + (size_t)T_ * 2048 * 2;
        const char* Gs = (const char*)(ws + WS_G) + ub; const char* WDs = (const char*)(ws + WS_WD) + ub; const char* AAs = (const char*)(ws + WS_AA) + ub;
        const unsigned lvo = (unsigned)(4 * kq + 4 * g8 * 2048) * 2u;
        const int pc = h * 64 + 4 * kq;
        const f32x4 p_kk = *(const f32x4*)(a->in[20] + (size_t)o * 2048 + pc), p_ka = *(const f32x4*)(a->in[21] + (size_t)o * 2048 + pc), p_rk = *(const f32x4*)(a->in[22] + (size_t)o * 2048 + pc);
        v2u gk[4], ga[4], gw[4], gr[4], gv[4], gg[4];
        auto gload = [&](int c) {
            const size_t co = (size_t)c * (32 * 2048 * 2);
            typedef const __attribute__((address_space(1))) char* gptr; typedef const __attribute__((address_space(1))) v2u* gv2;
            gptr k_ = (gptr)(Ks + co); gptr a_ = (gptr)(AAs + co); gptr w_ = (gptr)(WDs + co); gptr r_ = (gptr)(Rs + co); gptr v_ = (gptr)(Vs + co); gptr g_ = (gptr)(Gs + co);
            asm volatile("" : "+s"(k_), "+s"(a_), "+s"(w_), "+s"(r_), "+s"(v_), "+s"(g_));
#pragma unroll
            for (int j = 0; j < 4; ++j) { const unsigned off = lvo + (unsigned)j * 4096u;
                gk[j] = *(gv2)(k_ + off); ga[j] = *(gv2)(a_ + off); gw[j] = *(gv2)(w_ + off); gr[j] = *(gv2)(r_ + off); gv[j] = *(gv2)(v_ + off); gg[j] = *(gv2)(g_ + off); } };
        f32x4 kh3, bb3, hh0, hh1, hh2, hh3, bh0, bh1, bh2, bh3, W4;
        auto partA = [&](int c) {
            LAS unsigned char* B = lds + (c % 3) * RK_CBUF; LAS unsigned char* P = lds + RK_PB0 + (c & 3) * RK_PBSZ;
            f32x4 kk[4], bbv[4], kh[4], w[4], r[4], v[4];
#pragma unroll
            for (int j = 0; j < 4; ++j) { const f32x4 k = unpk4(gk[j]), aa = unpk4(ga[j]), wd = unpk4(gw[j]); r[j] = unpk4(gr[j]); v[j] = unpk4(gv[j]);
                const f32x4 kx = k * p_kk; const float inv = __builtin_amdgcn_rsqf(fmaxf(dot16(kx, kx), 1e-24f)); kk[j] = kx * inv; bbv[j] = kk[j] * aa; kh[j] = k * (1.f + (aa - 1.f) * p_ka);
                w[j] = (f32x4){__expf(wd.x), __expf(wd.y), __expf(wd.z), __expf(wd.w)};
                const float bon = dot16(r[j] * kh[j], p_rk);
                *(LAS v2u*)(P + RK_PG + ((4 * g8 + j) * 64 + 4 * kq) * 2) = gg[j];
                if (kq == 0) *(LAS float*)(P + RK_PBON + (4 * g8 + j) * 4) = bon; }
            const f32x4 W1 = w[0], W2 = w[0] * w[1], W3 = W2 * w[2]; W4 = W3 * w[3];
            const f32x4 i1 = {__builtin_amdgcn_rcpf(W1.x), __builtin_amdgcn_rcpf(W1.y), __builtin_amdgcn_rcpf(W1.z), __builtin_amdgcn_rcpf(W1.w)}, i2 = {__builtin_amdgcn_rcpf(W2.x), __builtin_amdgcn_rcpf(W2.y), __builtin_amdgcn_rcpf(W2.z), __builtin_amdgcn_rcpf(W2.w)},
                        i3 = {__builtin_amdgcn_rcpf(W3.x), __builtin_amdgcn_rcpf(W3.y), __builtin_amdgcn_rcpf(W3.z), __builtin_amdgcn_rcpf(W3.w)}, i4 = {__builtin_amdgcn_rcpf(W4.x), __builtin_amdgcn_rcpf(W4.y), __builtin_amdgcn_rcpf(W4.z), __builtin_amdgcn_rcpf(W4.w)};
            hh0 = kh[0] * i1; hh1 = kh[1] * i2; hh2 = kh[2] * i3; hh3 = kh[3] * i4; bh0 = bbv[0] * i1; bh1 = bbv[1] * i2; bh2 = bbv[2] * i3; bh3 = bbv[3] * i4; kh3 = kh[3]; bb3 = bbv[3];
            *(LAS v2u*)(B + RK_KQ + g8 * 512 + 0 * 128 + 8 * kq) = pk4(kk[0]);      *(LAS v2u*)(B + RK_RQ + g8 * 512 + 0 * 128 + 8 * kq) = pk4(r[0] * W1);
            *(LAS v2u*)(B + RK_KQ + g8 * 512 + 1 * 128 + 8 * kq) = pk4(kk[1] * W1); *(LAS v2u*)(B + RK_RQ + g8 * 512 + 1 * 128 + 8 * kq) = pk4(r[1] * W2);
            *(LAS v2u*)(B + RK_KQ + g8 * 512 + 2 * 128 + 8 * kq) = pk4(kk[2] * W2); *(LAS v2u*)(B + RK_RQ + g8 * 512 + 2 * 128 + 8 * kq) = pk4(r[2] * W3);
            *(LAS v2u*)(B + RK_KQ + g8 * 512 + 3 * 128 + 8 * kq) = pk4(kk[3] * W3); *(LAS v2u*)(B + RK_RQ + g8 * 512 + 3 * 128 + 8 * kq) = pk4(r[3] * W4);
            *(LAS f32x4*)(B + RK_W4 + g8 * 256 + 16 * kq) = W4;
#pragma unroll
            for (int j = 0; j < 4; ++j) *(LAS v2u*)(P + RK_PV + ((4 * g8 + j) * 64 + 4 * kq) * 2) = gv[j];
#pragma unroll
            for (int i = 0; i < 4; ++i) *(LAS f32x4*)(B + RK_VB + g8 * 1024 + (4 * kq + i) * 16) = (f32x4){v[0][i], v[1][i], v[2][i], v[3][i]};
        };
        auto partB = [&](int c) {
            LAS unsigned char* B = lds + (c % 3) * RK_CBUF;
            { LAS unsigned char* xs = lds + RK_XS + (wv - 4) * 4096 + (lane >> 4) * 1024 + 8 * kq;
              *(LAS v2u*)(xs + 0 * 128) = pk4(hh0); *(LAS v2u*)(xs + 1 * 128) = pk4(hh1); *(LAS v2u*)(xs + 2 * 128) = pk4(hh2); *(LAS v2u*)(xs + 3 * 128) = pk4(hh3);
              *(LAS v2u*)(xs + 4 * 128) = pk4(bh0); *(LAS v2u*)(xs + 5 * 128) = pk4(bh1); *(LAS v2u*)(xs + 6 * 128) = pk4(bh2); *(LAS v2u*)(xs + 7 * 128) = pk4(bh3); }
            { const f32x4 hw0 = hh0 * W4, hw1 = hh1 * W4, hw2 = hh2 * W4, hw3 = kh3, bw0 = bh0 * W4, bw1 = bh1 * W4, bw2 = bh2 * W4, bw3 = bb3;
#pragma unroll
              for (int i = 0; i < 4; ++i) *(LAS v4u*)(B + RK_XU + g8 * 1024 + (4 * kq + i) * 16) = (v4u){pk2(hw0[i], hw1[i]), pk2(hw2[i], hw3[i]), pk2(-bw0[i], -bw1[i]), pk2(-bw2[i], -bw3[i])};
            }
            asm volatile("s_waitcnt lgkmcnt(0)" ::: "memory");
#pragma unroll
            for (int p = 0; p < 2; ++p) { const int grp = 2 * p + (fr >> 3), rw = fr & 7, blk = 4 * w2 + grp;
                const LAS unsigned char* xp = lds + RK_XS + (wv - 4) * 4096 + grp * 1024 + rw * 128 + 16 * fq;
                const LAS unsigned char* yp = B + ((rw < 4) ? RK_KQ + blk * 512 + rw * 128 : RK_RQ + blk * 512 + (rw - 4) * 128) + 16 * fq;
                f32x4 d = {0.f, 0.f, 0.f, 0.f};
                d = __builtin_amdgcn_mfma_f32_16x16x32_bf16(*(const LAS bf16x8*)xp, *(const LAS bf16x8*)yp, d, 0, 0, 0);
                d = __builtin_amdgcn_mfma_f32_16x16x32_bf16(*(const LAS bf16x8*)(xp + 64), *(const LAS bf16x8*)(yp + 64), d, 0, 0, 0);
                if ((fr >> 3) == (fq >> 1) && rw >= 1) { const int cnt = (rw < 4) ? rw : rw - 3; const int base = (rw == 1) ? 0 : (rw == 2) ? 2 : (rw == 3) ? 6 : (rw == 4) ? 12 : (rw == 5) ? 14 : (rw == 6) ? 18 : 24;
                    LAS float* tp = (LAS float*)(B + RK_TAB + blk * 128) + base + (fq & 1) * cnt;
                    tp[0] = d[0]; if (cnt > 1) tp[1] = d[1]; if (cnt > 2) tp[2] = d[2]; if (cnt > 3) tp[3] = d[3]; } }
            asm volatile("" ::: "memory");
        };
        const int st = ptid >> 2, rq = ptid & 3;
        bf16* Yb = (bf16*)(ws + WS_YO) + (size_t)b * SEQ * 2048 + h * 64 + 16 * rq;
        const float* lg = a->in[23] + (size_t)o * 2048 + h * 64 + 16 * rq; const float* lb = a->in[24] + (size_t)o * 2048 + h * 64 + 16 * rq;
        auto post = [&](int c) {
            const LAS float* yb = (const LAS float*)(lds + RK_Y0 + (c & 1) * RK_YSZ); const LAS unsigned char* P = lds + RK_PB0 + (c & 3) * RK_PBSZ;
            float y[16]; float s1 = 0.f;
#pragma unroll
            for (int i = 0; i < 16; ++i) { y[i] = yb[(16 * rq + i) * 36 + st]; s1 += y[i]; }
            s1 += dppf<0xB1>(s1); s1 += dppf<0x4E>(s1); const float mean = s1 * (1.f / 64.f); float s2 = 0.f;
#pragma unroll
            for (int i = 0; i < 16; ++i) { y[i] -= mean; s2 += y[i] * y[i]; }
            s2 += dppf<0xB1>(s2); s2 += dppf<0x4E>(s2); const float rstd = __builtin_amdgcn_rsqf(s2 * (1.f / 64.f) + 64e-5f);
            const float bon = *(const LAS float*)(P + RK_PBON + st * 4);
            unsigned ow[8];
#pragma unroll
            for (int i4 = 0; i4 < 4; ++i4) { const f32x4 g = unpk4(*(const LAS v2u*)(P + RK_PG + (st * 64 + 16 * rq + 4 * i4) * 2)), vq = unpk4(*(const LAS v2u*)(P + RK_PV + (st * 64 + 16 * rq + 4 * i4) * 2));
                const f32x4 lgv = *(const f32x4*)(lg + 4 * i4), lbv = *(const f32x4*)(lb + 4 * i4); float o4[4];
#pragma unroll
                for (int i = 0; i < 4; ++i) o4[i] = (y[4 * i4 + i] * rstd * lgv[i] + lbv[i] + bon * vq[i]) * g[i];
                ow[2 * i4] = pk2(o4[0], o4[1]); ow[2 * i4 + 1] = pk2(o4[2], o4[3]); }
            v4u* dst = (v4u*)(Yb + (size_t)(32 * c + st) * 2048); dst[0] = (v4u){ow[0], ow[1], ow[2], ow[3]}; dst[1] = (v4u){ow[4], ow[5], ow[6], ow[7]};
        };
        if (!DRY) { gload(pr); partA(pr); gload(pr + 2); partB(pr); }
        __syncthreads();
        for (int c = 0; c < NCH; ++c) {
            if (!DRY) {
            if ((c & 1) == pr) { if (c + 2 < NCH) { partA(c + 2); if (c + 4 < NCH) gload(c + 4); } }
            else { if (c >= 1 && c + 1 < NCH) partB(c + 1); if (c >= 1) post(c - 1); } }
            __syncthreads();
        }
        if (!DRY && pr == 0) post(NCH - 1);
    }
    __syncthreads();
}

template <bool DRY = false> __device__ __forceinline__ void ln_router(const int wv, int l) {
    const ArgsP a = get_args();
#ifdef NO_ROUTER
    return;
#endif
    OPAQUE_TID(); const int lane = tid & 63, wave = tid >> 6;
    unsigned char* ws = a->ws;
    const float* lg = a->in[28] + (size_t)l * 2048; const float* lb = a->in[29] + (size_t)l * 2048;
    const float* bg = a->in[33] + l * 4; const float* be = a->in[35] + l * 32;
    const f32x4* RW = (const f32x4*)(ws + WS_RW) + (size_t)l * 9 * 2048;
    unsigned* cnt = (unsigned*)(ws + WS_CTL) + CW_CNT + (size_t)l * 32 * 64;
    int* TOKE = (int*)(ws + WS_TOKE); int* TOKR = (int*)(ws + WS_TOKR); float* TOKG = (float*)(ws + WS_TOKG);
    const int gw = blockIdx.x * NWAVES + wave, NGW = gridDim.x * NWAVES;
    const unsigned lo = (unsigned)lane * 16u;
    typedef const __attribute__((address_space(1))) char* gcp; typedef const __attribute__((address_space(1))) f32x4* gf4;
    v2u xnx[8];
    { const v2u* xr0 = (const v2u*)((const bf16*)(ws + WS_XSUM) + (size_t)gw * D_) + lane;
#pragma unroll
      for (int j = 0; j < 8; ++j) xnx[j] = (gw < T_) ? xr0[64 * j] : (v2u){0u, 0u}; }
#pragma unroll 1
    for (int m = gw; m < T_; m += NGW) {
        f32x4 v[8]; float s = 0.f;
#pragma unroll
        for (int j = 0; j < 8; ++j) { const v2u w_ = xnx[j]; v[j] = (f32x4){bflo(w_.x), bfhi(w_.x), bflo(w_.y), bfhi(w_.y)}; s += (v[j].x + v[j].y) + (v[j].z + v[j].w); }
        if (m + NGW < T_) { const v2u* xr = (const v2u*)((const bf16*)(ws + WS_XSUM) + (size_t)(m + NGW) * D_) + lane;
#pragma unroll
            for (int j = 0; j < 8; ++j) xnx[j] = xr[64 * j]; }
        const float mean = wave_sum(s) * (1.f / D_); float s2 = 0.f;
#pragma unroll
        for (int j = 0; j < 8; ++j) { v[j] = v[j] - mean; s2 += (v[j].x * v[j].x + v[j].y * v[j].y) + (v[j].z * v[j].z + v[j].w * v[j].w); }
        const float rstd = 1.f / sqrtf(wave_sum(s2) * (1.f / D_) + LN_EPS);
        float ag[4] = {0, 0, 0, 0};
#pragma unroll
        for (int j = 0; j < 8; ++j) { const f32x4 g = ((const f32x4*)lg)[lane + 64 * j], bb = ((const f32x4*)lb)[lane + 64 * j]; v[j] = v[j] * rstd * g + bb;
            ((v2u*)XIN(a, l))[(size_t)m * 512 + lane + 64 * j] = (v2u){pk2(v[j].x, v[j].y), pk2(v[j].z, v[j].w)};
            gcp wp = (gcp)((const char*)RW + j * 4096); asm volatile("" : "+s"(wp));
#pragma unroll
            for (int i = 0; i < 4; ++i) { const f32x4 w = *(gf4)(wp + i * 1024 + lo); const float x = v[j][i]; ag[0] += x * w.x; ag[1] += x * w.y; ag[2] += x * w.z; ag[3] += x * w.w; } }
#pragma unroll
        for (int i = 0; i < 4; ++i) ag[i] = wave_sum(ag[i]) + bg[i];
        int gi = 0; float gm = ag[0];
#pragma unroll
        for (int i = 1; i < 4; ++i) if (ag[i] > gm) { gm = ag[i]; gi = i; }
        float gs = 0.f;
#pragma unroll
        for (int i = 0; i < 4; ++i) gs += __expf(ag[i] - gm);
        const float gp = 1.f / gs;
        float ae[8] = {0, 0, 0, 0, 0, 0, 0, 0};
        const int gis = __builtin_amdgcn_readfirstlane(gi);
#pragma unroll
        for (int j = 0; j < 8; ++j) {
            gcp we0 = (gcp)((const char*)RW + (size_t)(1 + 2 * gis) * 32768 + j * 4096); asm volatile("" : "+s"(we0)); gcp we1 = we0 + 32768; asm volatile("" : "+s"(we1));
#pragma unroll
            for (int i = 0; i < 4; ++i) { const f32x4 w0 = *(gf4)(we0 + i * 1024 + lo), w1 = *(gf4)(we1 + i * 1024 + lo); const float x = v[j][i];
                ae[0] += x * w0.x; ae[1] += x * w0.y; ae[2] += x * w0.z; ae[3] += x * w0.w; ae[4] += x * w1.x; ae[5] += x * w1.y; ae[6] += x * w1.z; ae[7] += x * w1.w; } }
#pragma unroll
        for (int i = 0; i < 8; ++i) ae[i] = wave_sum(ae[i]) + be[8 * gi + i];
        int e1 = 0; float m1 = ae[0];
#pragma unroll
        for (int i = 1; i < 8; ++i) if (ae[i] > m1) { m1 = ae[i]; e1 = i; }
        int e2 = -1; float m2 = -3.0e38f;
#pragma unroll
        for (int i = 0; i < 8; ++i) if (i != e1 && ae[i] > m2) { m2 = ae[i]; e2 = i; }
        const float p2 = __expf(m2 - m1), den = 1.f / (1.f + p2);
        if (!DRY && lane == 0) { const int x1 = 8 * gi + e1, x2 = 8 * gi + e2;
            const unsigned r1 = __hip_atomic_fetch_add(cnt + x1 * 64, 1u, __ATOMIC_RELAXED, __HIP_MEMORY_SCOPE_AGENT);
            const unsigned r2 = __hip_atomic_fetch_add(cnt + x2 * 64, 1u, __ATOMIC_RELAXED, __HIP_MEMORY_SCOPE_AGENT);
            { int* LIST = (int*)(ws + WS_LIST); LIST[x1 * 16384 + (int)r1] = m; LIST[x2 * 16384 + (int)r2] = m; }
            TOKE[2 * m] = x1; TOKE[2 * m + 1] = x2; TOKR[2 * m] = (int)r1; TOKR[2 * m + 1] = (int)r2; TOKG[2 * m] = gp * den; TOKG[2 * m + 1] = gp * p2 * den; }
    }
}

struct MoeTab { LAS int* start; LAS int* tileE; LAS int* ntiles; LAS int* cntv; };
__device__ __forceinline__ MoeTab moe_tables(const int wv, int l, LAS unsigned char* lds) {
    const ArgsP a = get_args();
    MoeTab t; t.start = (LAS int*)(lds + MISC_OFF + 256); t.tileE = t.start + 40; t.ntiles = t.tileE + 168; t.cntv = t.ntiles + 8;
    OPAQUE_TID();
    if (wv == 0) { unsigned* cnt = (unsigned*)(a->ws + WS_CTL) + CW_CNT + (size_t)l * 32 * 64; const int e = tid & 31;
        const int c = (int)__hip_atomic_load(cnt + e * 64, __ATOMIC_RELAXED, __HIP_MEMORY_SCOPE_AGENT); const int pad = (c + 255) & ~255;
        int inc = pad;
#pragma unroll
        for (int d = 1; d < 32; d <<= 1) { const int v = __shfl_up(inc, d, 32); if (e >= d) inc += v; }
        if ((tid & 63) < 32) { const int st = inc - pad; t.start[e] = st; t.cntv[e] = c;
            int q1 = inc >> 8; if (q1 > MOE_TILES) q1 = MOE_TILES;
            for (int q = st >> 8; q < q1; ++q) t.tileE[q] = e;
            if (e == 31) *t.ntiles = q1; } }
    __syncthreads();
    return t;
}
__device__ __forceinline__ void moe_gather(const int wv, const MoeTab& tb) {
    const ArgsP a = get_args();
#ifdef NO_GATHER
    return;
#endif
    OPAQUE_TID(); const int lane = tid & 63, wave = tid >> 6;
    unsigned char* ws = a->ws;
    const int* TOKE = (const int*)(ws + WS_TOKE); const int* TOKR = (const int*)(ws + WS_TOKR); int* SLOT = (int*)(ws + WS_SLOT);
    const int gw = blockIdx.x * NWAVES + wave, NGW = gridDim.x * NWAVES;
    for (int it = gw; it < 2 * T_; it += NGW) { const int m = it >> 1; const int dest = tb.start[TOKE[it]] + TOKR[it];
        if (lane == 0) SLOT[it] = dest;
        const v4u* src = (const v4u*)(ws + WS_XB) + (size_t)m * 256 + lane; v4u* dst = (v4u*)(ws + WS_XS) + (size_t)dest * 256 + lane;
#pragma unroll
        for (int j = 0; j < 4; ++j) dst[64 * j] = src[64 * j]; }
}
template <int NJ> struct MoeOrder {
    LAS int* tileE; int nunits, G, c;
    __device__ bool next(int i, pg8::Unit& u) const {
        const int nt = nunits / NJ, x = c & 7, r = c >> 3, nx = G >> 3;
        const int t0 = (x * nt) >> 3, t1 = ((x + 1) * nt) >> 3, q = i * nx + r;
        if (q >= (t1 - t0) * NJ) return false;
        u.pm = t0 + q / NJ; u.pn = tileE[u.pm] * NJ + (q % NJ); u.aoff = 0; return true; }
    __device__ __forceinline__ void a_ready(const pg8::Unit&) const {}
    __device__ __forceinline__ void done(const pg8::Unit&) const {}
};
template <int NJ> struct MoeOrderG {
    LAS int* tileE; LAS int* start; LAS int* cntv; const int* list; int nunits, G, c; int ilo, ihi;
    __device__ bool next(int i_, pg8::Unit& u) const {
        const int i = i_ + ilo; if (i >= ihi) return false;
        const int nt = nunits / NJ, x = c & 7, r = c >> 3, nx = G >> 3;
        const int t0 = (x * nt) >> 3, t1 = ((x + 1) * nt) >> 3, q = i * nx + r;
        if (q >= (t1 - t0) * NJ) return false;
        u.pm = t0 + q / NJ; u.pn = tileE[u.pm] * NJ + (q % NJ); u.aoff = 0; return true; }
    __device__ __forceinline__ void gather_voff(const pg8::Unit& u, int R0, int C0, int R1, int C1, int lda, unsigned (&v)[2][2]) const {
        const int e = tileE[u.pm], roff = u.pm * 256 - start[e], cnt = cntv[e]; const int* le = list + e * 16384;
#pragma unroll
        for (int hh = 0; hh < 2; ++hh) { const int r0 = roff + 128 * hh + R0, r1 = roff + 128 * hh + R1;
            const int t0 = (r0 < cnt) ? le[r0] : 0, t1 = (r1 < cnt) ? le[r1] : 0;
            v[hh][0] = (unsigned)(t0 * lda + C0) * 2u; v[hh][1] = (unsigned)(t1 * lda + C1) * 2u; } }
    __device__ __forceinline__ void a_ready(const pg8::Unit&) const {}
    __device__ __forceinline__ void done(const pg8::Unit&) const {}
};
struct MoeOrderDn {
    LAS int* tileE; int ntiles, G, c, mode, KB;
    __device__ __forceinline__ void split(int& t0, int& ntx, int& busy, int& nB) const {
        const int x = c & 7, nx = G >> 3; t0 = (x * ntiles) >> 3; ntx = (((x + 1) * ntiles) >> 3) - t0;
        busy = ntx * 4 - 2 * nx; busy = busy < 0 ? 0 : (busy > nx ? nx : busy);
        const int cA = ntx < (nx >> 1) ? ntx : (nx >> 1);
        nB = KB * (nx - busy); if (nB > cA * 8) nB = cA * 8; }
    __device__ bool third_round() const { int t0, ntx, busy, nB; split(t0, ntx, busy, nB); return (c >> 3) < busy; }
    __device__ bool next(int i, pg8::Unit& u) const {
        int t0, ntx, busy, nB; split(t0, ntx, busy, nB); const int r = c >> 3, nx = G >> 3; int idx;
        if (mode == 0) { if (r < busy || i >= KB) return false; idx = i * (nx - busy) + (r - busy); if (idx >= nB) return false; }
        else { idx = nB + i * nx + r; if (idx >= ntx * 8) return false; }
        u.pm = t0 + (idx >> 3); u.pn = tileE[u.pm] * 8 + (idx & 7); u.aoff = 0; return true; }
    __device__ __forceinline__ void a_ready(const pg8::Unit&) const {}
    __device__ __forceinline__ void done(const pg8::Unit&) const {}
};
template <bool FUSE_ODD> __device__ __forceinline__ void moe_combine_ln(const int wv, int l) {
    const ArgsP a = get_args();
#ifdef NO_COMBINE
    return;
#endif
    OPAQUE_TID(); const int lane = tid & 63, wave = tid >> 6;
    unsigned char* ws = a->ws;
    const float* lg = a->in[30] + (size_t)l * 2048; const float* lb = a->in[31] + (size_t)l * 2048;
    const int* TOKE = (const int*)(ws + WS_TOKE); const int* TOKR = (const int*)(ws + WS_TOKR); const float* TOKG = (const float*)(ws + WS_TOKG); const bf16* YS = (const bf16*)(ws + WS_YS);
    const int gw = blockIdx.x * NWAVES + wave, NGW = gridDim.x * NWAVES;
    int mystart = 0;
    { unsigned* cnt = (unsigned*)(ws + WS_CTL) + CW_CNT + (size_t)l * 32 * 64; const int e = lane & 31;
      const int c = (int)__hip_atomic_load(cnt + e * 64, __ATOMIC_RELAXED, __HIP_MEMORY_SCOPE_AGENT); const int pad = (c + 255) & ~255;
      int inc = pad;
#pragma unroll
      for (int d = 1; d < 32; d <<= 1) { const int v = __shfl_up(inc, d, 32); if (e >= d) inc += v; }
      mystart = inc - pad; }
    const float* mu = FUSE_ODD ? a->in[7] + (size_t)((l + 1) >> 1) * 6 * 2048 : nullptr;
    bf16* XR = (bf16*)(ws + WS_XRKV); bf16* XK = XR + (size_t)T_ * 2048; bf16* XV = XK + (size_t)T_ * 2048; bf16* XC = (bf16*)(ws + WS_XC);
    const int nrows = FUSE_ODD ? 9 : 1;
    for (int base = FUSE_ODD ? gw * 8 : gw; base < T_; base += FUSE_ODD ? NGW * 8 : NGW) {
        f32x4 prev[8];
#pragma unroll 1
        for (int rr = 0; rr < nrows; ++rr) {
            const int m = FUSE_ODD ? base - 1 + rr : base;
            const bool halo = FUSE_ODD && rr == 0;
            if (halo && (base % SEQ) == 0) {
#pragma unroll
                for (int j = 0; j < 8; ++j) prev[j] = (f32x4){0.f, 0.f, 0.f, 0.f};
                continue; }
            const v2u* xr = (const v2u*)(XIN(a, l) + (size_t)m * D_) + lane; f32x4 v[8]; float s = 0.f;
            const int e0 = TOKE[2 * m], e1 = TOKE[2 * m + 1];
            const int s0 = __shfl(mystart, e0) + TOKR[2 * m], s1 = __shfl(mystart, e1) + TOKR[2 * m + 1]; const float g0 = TOKG[2 * m], g1 = TOKG[2 * m + 1];
            const v2u* y0 = (const v2u*)(YS + (size_t)s0 * 2048) + lane; const v2u* y1 = (const v2u*)(YS + (size_t)s1 * 2048) + lane;
#pragma unroll
            for (int j = 0; j < 8; ++j) { const v2u xw_ = xr[64 * j]; const f32x4 x = {bflo(xw_.x), bfhi(xw_.x), bflo(xw_.y), bfhi(xw_.y)}; const v2u a0 = y0[64 * j], a1 = y1[64 * j];
                v[j].x = DN_ALPHA * x.x + g0 * bflo(a0.x) + g1 * bflo(a1.x); v[j].y = DN_ALPHA * x.y + g0 * bfhi(a0.x) + g1 * bfhi(a1.x);
                v[j].z = DN_ALPHA * x.z + g0 * bflo(a0.y) + g1 * bflo(a1.y); v[j].w = DN_ALPHA * x.w + g0 * bfhi(a0.y) + g1 * bfhi(a1.y);
                s += (v[j].x + v[j].y) + (v[j].z + v[j].w); }
            const float mean = wave_sum(s) * (1.f / D_); float s2 = 0.f;
#pragma unroll
            for (int j = 0; j < 8; ++j) { v[j] = v[j] - mean; s2 += (v[j].x * v[j].x + v[j].y * v[j].y) + (v[j].z * v[j].z + v[j].w * v[j].w); }
            const float rstd = 1.f / sqrtf(wave_sum(s2) * (1.f / D_) + LN_EPS);
#pragma unroll
            for (int j = 0; j < 8; ++j) { const f32x4 g = ((const f32x4*)lg)[lane + 64 * j], bb = ((const f32x4*)lb)[lane + 64 * j]; v[j] = v[j] * rstd * g + bb;
                if (!halo) { if (l == 3) ((f32x4*)(a->out + (size_t)m * D_))[lane + 64 * j] = v[j]; else ((v2u*)XOUT(a, l))[(size_t)m * 512 + lane + 64 * j] = (v2u){pk2(v[j].x, v[j].y), pk2(v[j].z, v[j].w)}; }
                if (FUSE_ODD) {
                    if (!halo) { const f32x4 x = v[j], dx = prev[j] - x;
                        const f32x4 m0 = ((const f32x4*)mu)[lane + 64 * j], m2 = ((const f32x4*)(mu + 2 * 2048))[lane + 64 * j], m3 = ((const f32x4*)(mu + 3 * 2048))[lane + 64 * j];
                        const f32x4 r = x + dx * m0, k = x + dx * m2, vv = x + dx * m3; const size_t off = (size_t)m * 2048 + 4 * (lane + 64 * j);
                        *(v2u*)(XR + off) = (v2u){pk2(r.x, r.y), pk2(r.z, r.w)}; *(v2u*)(XK + off) = (v2u){pk2(k.x, k.y), pk2(k.z, k.w)}; *(v2u*)(XV + off) = (v2u){pk2(vv.x, vv.y), pk2(vv.z, vv.w)};
                        *(v2u*)(XC + off) = (v2u){pk2(dx.x, dx.y), pk2(dx.z, dx.w)}; }
                    prev[j] = v[j]; } }
        }
    }
}

struct RkvOrder {
    pg8::StaticOrder in; int lo, n, G, c;
    __device__ bool next(int i, pg8::Unit& u) const { const long L = (long)lo + (long)i * G + c; if (L >= lo + n) return false; const int g = (int)(L / 512);
        in.at(L % 512, u); u.pm += 64 * g; u.pn += 8 * g; return true; }
    __device__ __forceinline__ void a_ready(const pg8::Unit&) const {}
    __device__ __forceinline__ void done(const pg8::Unit&) const {}
};
struct MergedOrder {
    pg8::StaticOrder in; const char *A0, *B0, *A1a, *A1b, *B1a, *B1b; int G, c;
    __device__ bool next(int i, pg8::Unit& u) const {
        int idx;
        if (G == 256) { if (c < 128) { if (i == 0) idx = -1 - c; else idx = (i - 1) * 128 + c; if (i > 5) return false; } else { idx = 640 + i * 128 + (c - 128); if (i > 6) return false; } }
        else { const int L = i * G + c; if (L >= 1664) return false; idx = (L < 128) ? -1 - L : L - 128; }
        if (idx < 0) { const int q = -1 - idx; u.pm = q & 63; u.pn = q >> 6; u.aoff = 1; return true; }
        const int g = idx / 512; in.at(idx % 512, u); u.pm += 64 * g; u.pn += 8 * g; u.aoff = 0; return true; }
    __device__ __forceinline__ void ptrs(const pg8::Unit& u, const char*& a, const char*& a2, const char*& b, const char*& b2, int& nt) const {
        const size_t ts = (size_t)256 * 2048 * 2;
        if (u.aoff == 0) { a = A0 + (size_t)u.pm * ts; b = B0 + (size_t)u.pn * ts; a2 = a; b2 = b; nt = 32; }
        else { a = A1a + (size_t)u.pm * ts; a2 = A1b + (size_t)u.pm * ts; b = B1a + (size_t)u.pn * ts; b2 = B1b + (size_t)u.pn * ts; nt = 64; } }
    __device__ __forceinline__ void a_ready(const pg8::Unit&) const {}
    __device__ __forceinline__ void done(const pg8::Unit&) const {}
};
struct L2Order {
    int nunits, G, c;
    __device__ bool next(int i, pg8::Unit& u) const { const int L = i * G + c; if (L >= nunits) return false; u.pn = L >> 6; u.pm = L & 63; u.aoff = (u.pn >= 8) ? 512 : 0; return true; }
    __device__ __forceinline__ void a_ready(const pg8::Unit&) const {}
    __device__ __forceinline__ void done(const pg8::Unit&) const {}
};


#ifndef REP_PROL
#define REP_PROL 1
#endif
#ifndef REP_INPROJ
#define REP_INPROJ 1
#endif
#ifndef REP_ATTN
#define REP_ATTN 1
#endif
#ifndef REP_MLSTM
#define REP_MLSTM 1
#endif
#ifndef REP_HNORM
#define REP_HNORM 1
#endif
#ifndef REP_OPREP
#define REP_OPREP 1
#endif
#ifndef REP_RKV
#define REP_RKV 1
#endif
#ifndef REP_RWKV
#define REP_RWKV 1
#endif
#ifndef REP_GATHER
#define REP_GATHER 1
#endif
#ifndef REP_GU
#define REP_GU 1
#endif
#ifndef REP_DN
#define REP_DN 1
#endif
#define REPX_1(...) __VA_ARGS__
#define REPX_2(...) __VA_ARGS__ __VA_ARGS__
#define REPX_3(...) __VA_ARGS__ __VA_ARGS__ __VA_ARGS__
#define REPX_(n, ...) REPX_##n(__VA_ARGS__)
#define REPX(n, ...) REPX_(n, __VA_ARGS__)

struct RangeOrder { pg8::StaticOrder S; int i0, cnt;
    __device__ bool next(int i, pg8::Unit& u) const { if (i >= cnt) return false; return S.next(i + i0, u); }
    __device__ __forceinline__ void a_ready(const pg8::Unit&) const {}
    __device__ __forceinline__ void done(const pg8::Unit&) const {}
};
constexpr int N_PHASES = 41;

__global__ void __launch_bounds__(NTHR, 2) fwd(Args args) {
    extern __shared__ __attribute__((aligned(16))) unsigned char lds_raw[];
    LAS unsigned char* lds = (LAS unsigned char*)lds_raw;
    const int wv = __builtin_amdgcn_readfirstlane((int)threadIdx.x >> 6);
    OPAQUE_TID();
    const ArgsP ap0 = get_args();
    if (tid < 16) ((LAS unsigned*)(lds + MISC_OFF))[tid] = 0u;
    __syncthreads();
#if ONE_LAUNCH
    XcdBarrier bar = xcd_barrier_post((unsigned*)(ap0->ws + WS_CTL) + CW_BAR, (volatile LAS unsigned*)(lds + MISC_OFF), tid == 0);
#define SEAM(k) do { if ((k) + 1 < hi) xcd_barrier(bar, tid == 0); } while (0)
#define SEAMR() xcd_barrier(bar, tid == 0)
#else
#define SEAM(k) do { } while (0)
#define SEAMR() do { } while (0)
#endif
    const int lo = ap0->ph_lo, hi = ap0->ph_hi;
#define IN(k) (lo <= (k) && (k) < hi)
    const int G = gridDim.x, cb = blockIdx.x;

    if (IN(0)) { REPX(REP_PROL, { prologue(wv, lds, 0); SEAMR(); }) }
#ifdef PROBE_BAR
    for (int pb_i = 0; pb_i < 20; ++pb_i) SEAMR();
#endif

    auto layer = [&](auto lc) __attribute__((always_inline)) { constexpr int l = decltype(lc)::value;
        const int pb = 1 + 10 * l, eo = l >> 1;
        if ((l & 1) == 0) {
            if (IN(pb + 0)) {
                const ArgsP ap = get_args(); unsigned char* ws = ap->ws;
                pg8::Gemm g{XIN(ap, l), (const bf16*)(ws + WS_WIN) + (size_t)eo * ZW * 2048, 2048, 2048, 2048};
                pg8::StaticOrder S; S.init(T_, ZW, G, cb);
                pg8::EpiBf16 E{(bf16*)(ws + WS_Z), ZW, 0, 0, 0, nullptr};
                if constexpr (l == 0) {
                    const int n0 = 2 * (cb & 3);
                    RangeOrder S0{S, 0, n0}, S1{S, n0, 1 << 20};
                    if (n0 > 0) { pg8::gemm_phase<pg8::EpiBf16, RangeOrder, true, false>(wv, lds, g, S0, E); __syncthreads(); }
                    prologue(wv, lds, 1); __syncthreads();
                    pg8::gemm_phase<pg8::EpiBf16, RangeOrder, true, false>(wv, lds, g, S1, E); SEAMR();
                } else {
                REPX(REP_INPROJ, { pg8::gemm_phase<pg8::EpiBf16, pg8::StaticOrder, true, false>(wv, lds, g, S, E); SEAMR(); }) }
#if defined(PROBE_NULLEPI)
                { pg8::EpiNull EN; pg8::gemm_phase<pg8::EpiNull, pg8::StaticOrder, true, false>(wv, lds, g, S, EN); SEAMR(); }
#endif
#if defined(PROBE_FULLREP)
                pg8::gemm_phase<pg8::EpiBf16, pg8::StaticOrder, true, false>(wv, lds, g, S, E); SEAMR();
#endif
#if defined(REP_EPAIR)
                for (int u = cb; u < 256; u += G) even_prep(wv, eo, lds, u); SEAMR();
                pg8::gemm_phase<pg8::EpiBf16, pg8::StaticOrder, true, false>(wv, lds, g, S, E); SEAMR();
#endif
            }
            if (IN(pb + 1)) { for (int u = cb; u < 256; u += G) even_prep(wv, eo, lds, u); SEAM(pb + 1); }
            if (IN(pb + 2)) {
                if (cb & 1) { REPX(REP_MLSTM, { mlstm_scan(wv); }) }
                REPX(REP_ATTN, { for (int L = cb; L < 512; L += G) { const int i = L >> 8, c = L & 255; const int qbk = (i & 1) ? (c >> 5) : (15 - (c >> 5)); const int bh = c & 31;
                    attn_unit(wv, lds, bh >> 3, bh & 7, qbk); } })
                if (!(cb & 1)) { REPX(REP_MLSTM, { mlstm_scan(wv); }) }
                SEAM(pb + 2);
            }
            if (IN(pb + 3)) { REPX(REP_HNORM, { for (int u = cb; u < 1024; u += G) mlstm_out_unit(wv, lds, eo, u >> 8, (u >> 6) & 3, u & 63); SEAMR(); }) }
        } else {
            if (IN(pb + 1)) {
                const ArgsP ap = get_args(); unsigned char* ws = ap->ws;
                pg8::Gemm g{nullptr, nullptr, 2048, 2048, 2048};
                MergedOrder S; S.in.init(T_, 2048, 1, 0); S.G = G; S.c = cb;
                S.A0 = (const char*)(ws + WS_XRKV); S.B0 = (const char*)((const bf16*)(ws + WS_WRKV) + (size_t)eo * 3 * 2048 * 2048);
                S.A1a = (const char*)XIN(ap, l); S.A1b = (const char*)(ws + WS_XC);
                S.B1a = (const char*)((const bf16*)(ws + WS_WL1) + (size_t)eo * 2 * 512 * 2048); S.B1b = S.B1a + (size_t)512 * 2048 * 2;
                pg8::EpiBf16 E{(bf16*)(ws + WS_RKV), 2048, 64, 8, (size_t)T_ * 2048, (eo == 0) ? (bf16*)(ws + WS_VF) : nullptr};
                pg8::EpiL1 E1{(bf16*)(ws + WS_L1)};
                REPX(REP_RKV, { pg8::gemm_phase_m<pg8::EpiBf16, pg8::EpiL1, MergedOrder, true, false>(wv, lds, g, S, E, E1); __syncthreads(); })
                SEAM(pb + 1);
            }
            if (IN(pb + 2)) {
                const ArgsP ap = get_args(); unsigned char* ws = ap->ws;
                pg8::Gemm g{(const bf16*)(ws + WS_L1), (const bf16*)(ws + WS_WL2) + (size_t)eo * 8192 * 256, 256, 512, 256};
                L2Order S{(eo == 0 ? 24 : 32) * 64, G, cb};
                pg8::EpiL2 E{(bf16*)(ws + WS_G), (bf16*)(ws + WS_WD), (bf16*)(ws + WS_AA), (bf16*)(ws + WS_RKV) + (size_t)2 * T_ * 2048, (const bf16*)(ws + WS_VF),
                             ap->in[12] + (size_t)eo * 2048, ap->in[15] + (size_t)eo * 2048, ap->in[25]};
                pg8::gemm_phase<pg8::EpiL2, L2Order, true, false>(wv, lds, g, S, E);
#if defined(REP_L2A)
                if (eo == 0) { SEAMR(); pg8::gemm_phase<pg8::EpiL2, L2Order, true, false>(wv, lds, g, S, E); }
#endif
                SEAM(pb + 2);
            }
            if (IN(pb + 3)) { REPX(REP_RWKV, { for (int u = cb; u < 128; u += G) rwkv_unit(wv, lds, eo, u >> 5, u & 31);
#ifdef PROBE_DRY
                for (int u = cb; u < 128; u += G) rwkv_unit<true>(wv, lds, eo, u >> 5, u & 31);
#endif
                if (MOE_PROLOGUE_LAYERS >= 4) { } else if (G > 128 && cb >= 128) moe_convert(wv, lds, (l == 1) ? 32 : 96, (l == 1) ? 96 : 128, cb - 128, G - 128);
                else if (G <= 128) moe_convert(wv, lds, (l == 1) ? 32 : 96, (l == 1) ? 96 : 128, cb, G);
                SEAMR(); }) }
        }
        if (IN(pb + 4)) {
            const bool ev = (l & 1) == 0; const ArgsP ap = get_args(); unsigned char* ws = ap->ws;
            pg8::Gemm g{(const bf16*)(ws + (ev ? WS_YE : WS_YO)), (const bf16*)(ws + (ev ? WS_WOUT : WS_WO)) + (size_t)eo * 2048 * 2048, 2048, 2048, 2048};
            pg8::StaticOrder S; S.init(T_, 2048, G, cb);
            pg8::EpiResid E{XIN(ap, l), (bf16*)(ws + WS_XSUM), 2048, DN_ALPHA};
            pg8::gemm_phase<pg8::EpiResid, pg8::StaticOrder, true, false>(wv, lds, g, S, E);
#if defined(REP_OUT)
            SEAMR(); pg8::gemm_phase<pg8::EpiResid, pg8::StaticOrder, true, false>(wv, lds, g, S, E);
#endif
            SEAM(pb + 4);
        }
        if (IN(pb + 5)) { ln_router(wv, l);
#ifdef PROBE_ROUTER
            SEAMR(); ln_router<true>(wv, l);
#endif
            SEAM(pb + 5); }
        if (IN(pb + 7)) { const MoeTab tb = moe_tables(wv, l, lds); const ArgsP ap = get_args(); unsigned char* ws = ap->ws;
            pg8::Gemm g{XIN(ap, l), (const bf16*)(ws + WS_WGU) + (size_t)l * 32 * 1024 * 2048, 2048, 2048, 2048};
            pg8::EpiSilu E{(bf16*)(ws + WS_HID)};
            { MoeOrderG<4> S{tb.tileE, tb.start, tb.cntv, (const int*)(ws + WS_LIST), *tb.ntiles * 4, G, cb, 0, 2};
              pg8::gemm_phase_g<pg8::EpiSilu, MoeOrderG<4>, true, false>(wv, lds, g, S, E); SEAMR(); }
            { pg8::Gemm gd{(const bf16*)(ws + WS_HID), (const bf16*)(ws + WS_WDN) + (size_t)l * 32 * 2048 * 512, 512, 512, 512};
              MoeOrderDn SD{tb.tileE, *tb.ntiles, G, cb, 0, 4};
              if (SD.third_round()) { MoeOrderG<4> S{tb.tileE, tb.start, tb.cntv, (const int*)(ws + WS_LIST), *tb.ntiles * 4, G, cb, 2, 1 << 20};
                  pg8::gemm_phase_g<pg8::EpiSilu, MoeOrderG<4>, true, false>(wv, lds, g, S, E); }
              else { pg8::EpiBf16 ED{(bf16*)(ws + WS_YS), 2048, 0, 8, 0, nullptr};
                  pg8::gemm_phase<pg8::EpiBf16, MoeOrderDn, true, false>(wv, lds, gd, SD, ED); }
              SEAMR(); }
        }
        if (IN(pb + 8)) { const MoeTab tb = moe_tables(wv, l, lds); const ArgsP ap = get_args(); unsigned char* ws = ap->ws;
            pg8::Gemm g{(const bf16*)(ws + WS_HID), (const bf16*)(ws + WS_WDN) + (size_t)l * 32 * 2048 * 512, 512, 512, 512};
            MoeOrderDn S{tb.tileE, *tb.ntiles, G, cb, 1, 4};
            pg8::EpiBf16 E{(bf16*)(ws + WS_YS), 2048, 0, 8, 0, nullptr};
            pg8::gemm_phase<pg8::EpiBf16, MoeOrderDn, true, false>(wv, lds, g, S, E); SEAMR();
        }
        if (IN(pb + 9)) { moe_combine_ln<(l & 1) == 0>(wv, l);
#if defined(REP_COMB)
            if ((l & 1) == 0) { SEAMR(); moe_combine_ln<(l & 1) == 0>(wv, l); }
#endif
            SEAM(pb + 9); }
#ifdef PROBE_RWKV
        if (l == 3 && IN(pb + 9) && cb == 0) { __syncthreads(); const ArgsP ap = get_args(); if (tid == 0) { asm volatile("s_waitcnt vmcnt(0)" ::: "memory"); const float* pw = (const float*)(ap->ws + WS_CTL) + 200000; ap->out[0] = pw[0]; ap->out[1] = pw[1]; } }
#endif
        };
    layer(std::integral_constant<int, 0>{}); layer(std::integral_constant<int, 1>{}); layer(std::integral_constant<int, 2>{}); layer(std::integral_constant<int, 3>{});
#undef IN
#undef SEAM
}

extern "C" void kernel_launch(void* const* d_in, const int* in_sizes, int n_in, void* d_out, int out_size, void* d_ws, size_t ws_size, hipStream_t stream) {
    static int grid = 0;
    if (grid == 0) {
        if (n_in != 39 || in_sizes[0] != T_ * D_ || out_size != T_ * D_ || ws_size < WS_END) {
            fprintf(stderr, "kernel_launch: unexpected problem: n_in %d in0 %d out %d ws %zu (need %zu)\n", n_in, n_in > 0 ? in_sizes[0] : -1, out_size, ws_size, (size_t)WS_END); grid = -1; return; }
        int dev = 0, cus = 0, per_cu = 0;
        if (hipGetDevice(&dev) != hipSuccess || hipDeviceGetAttribute(&cus, hipDeviceAttributeMultiprocessorCount, dev) != hipSuccess) { fprintf(stderr, "kernel_launch: device query failed\n"); grid = -1; return; }
        if (hipFuncSetAttribute((const void*)fwd, hipFuncAttributeMaxDynamicSharedMemorySize, LDS_BYTES) != hipSuccess) { fprintf(stderr, "kernel_launch: hipFuncSetAttribute failed\n"); grid = -1; return; }
        if (hipOccupancyMaxActiveBlocksPerMultiprocessor(&per_cu, (const void*)fwd, NTHR, LDS_BYTES) != hipSuccess || per_cu < 1)
            fprintf(stderr, "kernel_launch: note: occupancy query reports %d workgroups per CU\n", per_cu);
        (void)hipGetLastError();
        grid = cus;
    }
    if (grid < 0) return;
    if (hipMemsetAsync((char*)d_ws + WS_CTL, 0, CTL_ZERO_BYTES, stream) != hipSuccess) { fprintf(stderr, "kernel_launch: memset failed\n"); return; }
    Args a{};
    for (int i = 0; i < 39; ++i) a.in[i] = (const float*)d_in[i];
    a.out = (float*)d_out; a.ws = (unsigned char*)d_ws;
#if ONE_LAUNCH
    a.ph_lo = 0; a.ph_hi = N_PHASES;
    hipLaunchKernelGGL(fwd, dim3(grid), dim3(NTHR), LDS_BYTES, stream, a);
#else
    for (int p = 0; p < N_PHASES; ++p) { a.ph_lo = p; a.ph_hi = p + 1; hipLaunchKernelGGL(fwd, dim3(grid), dim3(NTHR), LDS_BYTES, stream, a); }
#endif
    const hipError_t le = hipPeekAtLastError();
    if (le != hipSuccess) fprintf(stderr, "kernel_launch: launch failed: %s\n", hipGetErrorName(le));
}
```

```cpp
#include <hip/hip_runtime.h>
#include <cstdio>
#include <cstdint>
#include <type_traits>

#ifndef ONE_LAUNCH
#define ONE_LAUNCH 1
#endif

#define LAS __attribute__((address_space(3)))
typedef unsigned short bf16;
typedef unsigned v4u __attribute__((ext_vector_type(4)));
typedef unsigned v2u __attribute__((ext_vector_type(2)));
typedef float f32x4 __attribute__((ext_vector_type(4)));
typedef float f32x2 __attribute__((ext_vector_type(2)));
typedef short bf16x8 __attribute__((ext_vector_type(8)));

__device__ __forceinline__ unsigned f2bf(float f) { unsigned u = __builtin_bit_cast(unsigned, f); return (u + 0x7fffu + ((u >> 16) & 1u)) >> 16; }
typedef __bf16 bf16x2_t __attribute__((ext_vector_type(2)));
__device__ __forceinline__ unsigned pk2(float lo, float hi) { const f32x2 v = {lo, hi}; return __builtin_bit_cast(unsigned, __builtin_convertvector(v, bf16x2_t)); }
__device__ __forceinline__ float bflo(unsigned w) { return __builtin_bit_cast(float, w << 16); }
__device__ __forceinline__ float bfhi(unsigned w) { return __builtin_bit_cast(float, w & 0xffff0000u); }
__device__ __forceinline__ float bf2f(bf16 h) { return __builtin_bit_cast(float, (unsigned)h << 16); }
__device__ __forceinline__ float sigmoidf_(float x) { return __builtin_amdgcn_rcpf(1.f + __expf(-x)); }
__device__ __forceinline__ float wave_sum(float v) {
#pragma unroll
    for (int o = 1; o < 64; o <<= 1) v += __shfl_xor(v, o);
    return v;
}
template <int CTRL> __device__ __forceinline__ float dppf(float x) { return __builtin_bit_cast(float, __builtin_amdgcn_mov_dpp(__builtin_bit_cast(int, x), CTRL, 0xf, 0xf, true)); }
__device__ __forceinline__ float red16(float x) { x += dppf<0xB1>(x); x += dppf<0x4E>(x); x += dppf<0x141>(x); x += dppf<0x128>(x); return x; }
__device__ __forceinline__ float max16(float x) { x = fmaxf(x, dppf<0xB1>(x)); x = fmaxf(x, dppf<0x4E>(x)); x = fmaxf(x, dppf<0x141>(x)); x = fmaxf(x, dppf<0x128>(x)); return x; }

__device__ __forceinline__ int lane_id_asm() { int l; asm volatile("v_mbcnt_lo_u32_b32 %0, -1, 0\n\tv_mbcnt_hi_u32_b32 %0, -1, %0" : "=v"(l)); return l; }
#define OPAQUE_TID() const int tid = wv * 64 + lane_id_asm()
typedef short v4i16_t __attribute__((ext_vector_type(4)));
__device__ __forceinline__ v2u tr_read(const LAS unsigned char* p) { return __builtin_bit_cast(v2u, __builtin_amdgcn_ds_read_tr16_b64_v4i16((LAS v4i16_t*)p)); }
#define LDS_WAIT() asm volatile("s_waitcnt lgkmcnt(0)" ::: "memory")
#define VM_WAIT() asm volatile("s_waitcnt vmcnt(0)" ::: "memory")

namespace pg8 {
#define PG8_LAS __attribute__((address_space(3)))
typedef unsigned short bf16_t;
typedef short bf16x8 __attribute__((ext_vector_type(8)));
typedef float f32x4 __attribute__((ext_vector_type(4)));
typedef unsigned u32x4 __attribute__((ext_vector_type(4)));
constexpr int BM = 256, BK = 64, HALF = 128, HTB = HALF * BK * 2  , STAGE_BYTES = 8 * HTB, NXCD = 8, WGM = 8;

__host__ __device__ __forceinline__ int lds_byte(int r, int c) { const int st = (r >> 4) * 2 + (c >> 5), rr = r & 15, cc = c & 31, ob = rr * 64 + cc * 2; return st * 1024 + (ob ^ (((ob >> 9) & 1) << 5)); }
__host__ __device__ __forceinline__ void stage_rc(int b, int& R, int& C) { const int st = b / 1024, sb = b % 1024, swz = sb ^ (((sb >> 9) & 1) << 5); R = (st >> 1) * 16 + swz / 64; C = (st & 1) * 32 + (swz % 64) / 2; }
__host__ __device__ __forceinline__ int perm32(int rho) { const int n = rho >> 4, i = rho & 15; return 8 * (i >> 2) + 4 * n + (i & 3); }

struct Unit { int pm, pn, aoff; };
struct Gemm { const bf16_t* A; const bf16_t* Bt; int K, lda, ldb; };

struct StaticOrder {
    int nM, nN, nwg, G, c;
    __device__ void init(int M, int N, int G_, int c_) { nM = M / BM; nN = N / BM; nwg = nM * nN; G = G_; c = c_; }
    __device__ bool next(int i, Unit& u) const { return at((long)i * G + c, u); }
    __device__ bool at(long L, Unit& u) const {
        if (L >= nwg) return false;
        int wgid = (int)L; { const int q = nwg / NXCD, r = nwg % NXCD, xcd = wgid % NXCD, off = wgid / NXCD; wgid = (xcd < r ? xcd * (q + 1) : r * (q + 1) + (xcd - r) * q) + off; }
        const int nig = WGM * nN, gid = wgid / nig, fm = gid * WGM, gsz = (nM - fm) < WGM ? (nM - fm) : WGM;
        u.pm = fm + ((wgid % nig) % gsz); u.pn = (wgid % nig) / gsz; u.aoff = 0; return true;
    }
    __device__ __forceinline__ void a_ready(const Unit&) const {}
    __device__ __forceinline__ void done(const Unit&) const {}
};

__device__ __forceinline__ unsigned cvt_pk_bf16(float lo, float hi) { return ::pk2(lo, hi); }

struct EpiNull {
    static constexpr bool PERM = true, AFTER_DRAIN = false;
    __device__ __forceinline__ void operator()(const f32x4 (&acc)[2][2][4][2], const Unit&, int, int, int, int) const {
#pragma unroll
        for (int a = 0; a < 2; ++a)
#pragma unroll
            for (int b = 0; b < 2; ++b)
#pragma unroll
                for (int m = 0; m < 4; ++m)
#pragma unroll
                    for (int n = 0; n < 2; ++n) asm volatile("" :: "v"(acc[a][b][m][n]));
    }
};
struct EpiBf16 {
    static constexpr bool PERM = true, AFTER_DRAIN = false;
    bf16_t* O; int ldc; int pm_mod, pn_mod; size_t gstride; bf16_t* O2;
    __device__ __forceinline__ void operator()(const f32x4 (&acc)[2][2][4][2], const Unit& u, int wr, int wc, int fr, int fq) const {
        const int g = pm_mod ? u.pm / pm_mod : 0;
        const int row0 = (u.pm - g * pm_mod) * BM + wr * 64 + fr;
        const int col0 = (pn_mod ? (u.pn % pn_mod) : u.pn) * BM + wc * 32 + 8 * fq;
        bf16_t* base = O + (size_t)g * gstride;
        bf16_t* base2 = (O2 && g == 2) ? O2 : nullptr;
#pragma unroll
        for (int ai = 0; ai < 2; ++ai)
#pragma unroll
            for (int m = 0; m < 4; ++m) { const size_t ro = (size_t)(row0 + ai * HALF + m * 16) * ldc + col0;
#pragma unroll
                for (int bj = 0; bj < 2; ++bj) { const f32x4 v0 = acc[ai][bj][m][0], v1 = acc[ai][bj][m][1];
                    u32x4 w; w.x = cvt_pk_bf16(v0[0], v0[1]); w.y = cvt_pk_bf16(v0[2], v0[3]); w.z = cvt_pk_bf16(v1[0], v1[1]); w.w = cvt_pk_bf16(v1[2], v1[3]);
                    *(u32x4*)(base + ro + bj * HALF) = w; if (base2) *(u32x4*)(base2 + ro + bj * HALF) = w; } }
    }
};
struct EpiResid {
    static constexpr bool PERM = true, AFTER_DRAIN = false;
    const bf16_t* X; bf16_t* S; int ldc; float alpha;
    __device__ __forceinline__ void operator()(const f32x4 (&acc)[2][2][4][2], const Unit& u, int wr, int wc, int fr, int fq) const {
        const int row0 = u.pm * BM + wr * 64 + fr, col0 = u.pn * BM + wc * 32 + 8 * fq;
#pragma unroll
        for (int ai = 0; ai < 2; ++ai)
#pragma unroll
            for (int m = 0; m < 4; ++m) { const size_t ro = (size_t)(row0 + ai * HALF + m * 16) * ldc + col0;
#pragma unroll
                for (int bj = 0; bj < 2; ++bj) { const u32x4 xw = *(const u32x4*)(X + ro + bj * HALF);
                    const f32x4 x0 = {__builtin_bit_cast(float, xw.x << 16), __builtin_bit_cast(float, xw.x & 0xffff0000u), __builtin_bit_cast(float, xw.y << 16), __builtin_bit_cast(float, xw.y & 0xffff0000u)};
                    const f32x4 x1 = {__builtin_bit_cast(float, xw.z << 16), __builtin_bit_cast(float, xw.z & 0xffff0000u), __builtin_bit_cast(float, xw.w << 16), __builtin_bit_cast(float, xw.w & 0xffff0000u)};
                    const f32x4 s0 = x0 * alpha + acc[ai][bj][m][0], s1 = x1 * alpha + acc[ai][bj][m][1];
                    u32x4 w; w.x = cvt_pk_bf16(s0[0], s0[1]); w.y = cvt_pk_bf16(s0[2], s0[3]); w.z = cvt_pk_bf16(s1[0], s1[1]); w.w = cvt_pk_bf16(s1[2], s1[3]);
                    *(u32x4*)(S + ro + bj * HALF) = w; } }
    }
};
struct EpiSilu {
    static constexpr bool PERM = true, AFTER_DRAIN = false;
    bf16_t* O;
    __device__ __forceinline__ void operator()(const f32x4 (&acc)[2][2][4][2], const Unit& u, int wr, int wc, int fr, int fq) const {
        const int row0 = u.pm * BM + wr * 64 + fr, col0 = (u.pn & 3) * 128 + wc * 32 + 8 * fq;
#pragma unroll
        for (int ai = 0; ai < 2; ++ai)
#pragma unroll
            for (int m = 0; m < 4; ++m) { bf16_t* rowp = O + (size_t)(row0 + ai * HALF + m * 16) * 512 + col0;
                float h[8];
#pragma unroll
                for (int n = 0; n < 2; ++n)
#pragma unroll
                    for (int e = 0; e < 4; ++e) { const float gt = acc[ai][0][m][n][e], up = acc[ai][1][m][n][e]; h[n * 4 + e] = gt * __builtin_amdgcn_rcpf(1.f + __expf(-gt)) * up; }
                u32x4 w; w.x = cvt_pk_bf16(h[0], h[1]); w.y = cvt_pk_bf16(h[2], h[3]); w.z = cvt_pk_bf16(h[4], h[5]); w.w = cvt_pk_bf16(h[6], h[7]);
                *(u32x4*)rowp = w; }
    }
};
struct EpiL1 {
    static constexpr bool PERM = true, AFTER_DRAIN = false;
    bf16_t* O;
    __device__ __forceinline__ void operator()(const f32x4 (&acc)[2][2][4][2], const Unit& u, int wr, int wc, int fr, int fq) const {
        const int row0 = u.pm * BM + wr * 64 + fr, col0 = u.pn * BM + wc * 32 + 8 * fq;
#pragma unroll
        for (int ai = 0; ai < 2; ++ai)
#pragma unroll
            for (int m = 0; m < 4; ++m) { bf16_t* rowp = O + (size_t)(row0 + ai * HALF + m * 16) * 512 + col0;
#pragma unroll
                for (int bj = 0; bj < 2; ++bj) { const int c = col0 + bj * HALF; float h[8];
#pragma unroll
                    for (int n = 0; n < 2; ++n)
#pragma unroll
                        for (int e = 0; e < 4; ++e) { const float v = acc[ai][bj][m][n][e];
                            h[n * 4 + e] = (c < 256) ? __builtin_amdgcn_rcpf(1.f + __expf(-v)) : ((c < 352) ? (1.f - 2.f * __builtin_amdgcn_rcpf(1.f + __expf(2.f * v))) : v); }
                    u32x4 w; w.x = cvt_pk_bf16(h[0], h[1]); w.y = cvt_pk_bf16(h[2], h[3]); w.z = cvt_pk_bf16(h[4], h[5]); w.w = cvt_pk_bf16(h[6], h[7]);
                    *(u32x4*)(rowp + bj * HALF) = w; } }
    }
};
template <int KIND> __device__ __forceinline__ void epi_l2(const f32x4 (&acc)[2][2][4][2], bf16_t* O, const bf16_t* VF, const float* pv, int row0, int col0) {
    float pr[2][8];
#pragma unroll
    for (int bj = 0; bj < 2; ++bj)
#pragma unroll
        for (int j = 0; j < 8; ++j) pr[bj][j] = (KIND == 0) ? 0.f : pv[col0 + bj * HALF + j];
#pragma unroll
    for (int ai = 0; ai < 2; ++ai)
#pragma unroll
        for (int m = 0; m < 4; ++m) { const size_t ro = (size_t)(row0 + ai * HALF + m * 16) * 2048 + col0;
#pragma unroll
            for (int bj = 0; bj < 2; ++bj) { float h[8];
#pragma unroll
                for (int n = 0; n < 2; ++n)
#pragma unroll
                    for (int e = 0; e < 4; ++e) h[n * 4 + e] = acc[ai][bj][m][n][e] + pr[bj][n * 4 + e];
                if (KIND == 1) {
#pragma unroll
                    for (int j = 0; j < 8; ++j) h[j] = -0.60653065971263342f * __builtin_amdgcn_rcpf(1.f + __expf(-h[j]));
                } else if (KIND == 2) {
#pragma unroll
                    for (int j = 0; j < 8; ++j) h[j] = __builtin_amdgcn_rcpf(1.f + __expf(-h[j]));
                } else if (KIND == 3) {
                    const u32x4 vv = *(const u32x4*)(O + ro + bj * HALF), vf = *(const u32x4*)(VF + ro + bj * HALF);
#pragma unroll
                    for (int j = 0; j < 4; ++j) { const unsigned a = vv[j], b = vf[j];
                        const float v0_ = __builtin_bit_cast(float, a << 16), v1_ = __builtin_bit_cast(float, a & 0xffff0000u);
                        const float f0_ = __builtin_bit_cast(float, b << 16), f1_ = __builtin_bit_cast(float, b & 0xffff0000u);
                        h[2 * j] = v0_ + (f0_ - v0_) * __builtin_amdgcn_rcpf(1.f + __expf(-h[2 * j])); h[2 * j + 1] = v1_ + (f1_ - v1_) * __builtin_amdgcn_rcpf(1.f + __expf(-h[2 * j + 1])); }
                }
                u32x4 w; w.x = cvt_pk_bf16(h[0], h[1]); w.y = cvt_pk_bf16(h[2], h[3]); w.z = cvt_pk_bf16(h[4], h[5]); w.w = cvt_pk_bf16(h[6], h[7]);
                *(u32x4*)(O + ro + bj * HALF) = w; } }
}
struct EpiL2 {
    static constexpr bool PERM = true, AFTER_DRAIN = false;
    bf16_t *G, *WD, *AA, *V; const bf16_t* VF; const float *w0, *a0, *v0;
    __device__ __forceinline__ void operator()(const f32x4 (&acc)[2][2][4][2], const Unit& u, int wr, int wc, int fr, int fq) const {
        const int kind = u.pn >> 3;
        const int row0 = u.pm * BM + wr * 64 + fr, col0 = (u.pn & 7) * BM + wc * 32 + 8 * fq;
        if (kind == 0) epi_l2<0>(acc, G, nullptr, nullptr, row0, col0);
        else if (kind == 1) epi_l2<1>(acc, WD, nullptr, w0, row0, col0);
        else if (kind == 2) epi_l2<2>(acc, AA, nullptr, a0, row0, col0);
        else epi_l2<3>(acc, V, VF, v0, row0, col0);
    }
};

template <class Epi, class Sched, bool ALIGN_EPI = false, bool SP2 = false>
__device__ __forceinline__ void gemm_phase(const int wv, PG8_LAS unsigned char* lds, const Gemm g, const Sched& S, const Epi& E) {
#ifdef NO_GEMM
    return;
#endif
    const int tid_o = wv * 64 + lane_id_asm();
    const int tid = tid_o, wid = __builtin_amdgcn_readfirstlane(tid >> 6), lane = tid & 63, wr = wid >> 2, wc = wid & 3, fr = lane & 15, fq = lane >> 4;
    const int K = g.K, nt = K / BK;
    unsigned voffA[2], voffB[2];
#pragma unroll
    for (int i = 0; i < 2; ++i) { int R, C; stage_rc(tid * 16 + i * 8192, R, C); const int Rb = Epi::PERM ? ((R & ~31) + perm32(R & 31)) : R;
        voffA[i] = (unsigned)(R * g.lda + C) * 2u; voffB[i] = (unsigned)(Rb * g.ldb + C) * 2u; }
    const size_t kstep = (size_t)(BK * 2);
    const size_t hstepA = (size_t)HALF * g.lda * 2, hstepB = (size_t)HALF * g.ldb * 2;
    const size_t tstepA = 2 * hstepA, tstepB = 2 * hstepB;
    const unsigned ldsw = (unsigned)wid * 1024u;
    const int aoff = lds_byte(wr * 64 + fr, fq * 8), boff = lds_byte(wc * 32 + fr, fq * 8);
#define PG8_SA(b, h) (((b) * 2 + (h)) * HTB)
#define PG8_SB(b, h) ((4 + (b) * 2 + (h)) * HTB)
#define PG8_STAGE(bufoff, gbase, voff) do { _Pragma("unroll") for (int _i = 0; _i < 2; ++_i) \
        __builtin_amdgcn_global_load_lds((const unsigned*)((const char*)(gbase) + (voff)[_i]), (PG8_LAS unsigned*)(lds + (bufoff) + ldsw + _i * 8192), 16, 0, 0); } while (0)
#define PG8_LDA(dst, b, h) do { _Pragma("unroll") for (int m = 0; m < 4; ++m) _Pragma("unroll") for (int k = 0; k < 2; ++k) dst[m][k] = *(const PG8_LAS bf16x8*)(lds + PG8_SA(b, h) + aoff + m * 2048 + k * 1024); } while (0)
#define PG8_LDB(dst, b, h) do { _Pragma("unroll") for (int n = 0; n < 2; ++n) _Pragma("unroll") for (int k = 0; k < 2; ++k) dst[n][k] = *(const PG8_LAS bf16x8*)(lds + PG8_SB(b, h) + boff + n * 2048 + k * 1024); } while (0)
#define PG8_MMA(ai, bj, At, Bt) do { __builtin_amdgcn_s_setprio(1); _Pragma("unroll") for (int m = 0; m < 4; ++m) _Pragma("unroll") for (int n = 0; n < 2; ++n) _Pragma("unroll") for (int k = 0; k < 2; ++k) \
        acc[ai][bj][m][n] = __builtin_amdgcn_mfma_f32_16x16x32_bf16(Bt[n][k], At[m][k], acc[ai][bj][m][n], 0, 0, 0); __builtin_amdgcn_s_setprio(0); } while (0)
#define PG8_WAIT_V(n) asm volatile("s_waitcnt vmcnt(" #n ")" ::: "memory")
#define PG8_WAIT_L(n) asm volatile("s_waitcnt lgkmcnt(" #n ")" ::: "memory")
#define PG8_BAR __builtin_amdgcn_s_barrier()
#define PG8_SCHED __builtin_amdgcn_sched_barrier(0)
    Unit cur, nxt; int ui = 0;
    if (!S.next(0, cur)) return;
    f32x4 acc[2][2][4][2];
#pragma unroll
    for (int a = 0; a < 2; ++a)
#pragma unroll
        for (int b = 0; b < 2; ++b)
#pragma unroll
            for (int m = 0; m < 4; ++m)
#pragma unroll
                for (int n = 0; n < 2; ++n) acc[a][b][m][n] = (f32x4){0.f, 0.f, 0.f, 0.f};
    bf16x8 At[4][2], B0[2][2], B1[2][2];
    const char* cA = (const char*)g.A + (size_t)cur.pm * tstepA + cur.aoff; const char* cB = (const char*)g.Bt + (size_t)cur.pn * tstepB;
    S.a_ready(cur);
    if constexpr (SP2) {
        PG8_STAGE(PG8_SB(0, 0), cB, voffB); PG8_STAGE(PG8_SB(0, 1), cB + hstepB, voffB); PG8_STAGE(PG8_SA(0, 0), cA, voffA); PG8_STAGE(PG8_SA(0, 1), cA + hstepA, voffA);
        if (wr == 1) PG8_BAR;
        PG8_WAIT_V(2); PG8_BAR;
        PG8_STAGE(PG8_SB(1, 0), cB + kstep, voffB); PG8_STAGE(PG8_SA(1, 0), cA + kstep, voffA); PG8_STAGE(PG8_SB(1, 1), cB + hstepB + kstep, voffB);
        PG8_WAIT_V(6); PG8_BAR;
    } else {
        PG8_STAGE(PG8_SB(0, 0), cB, voffB); PG8_STAGE(PG8_SA(0, 0), cA, voffA); PG8_STAGE(PG8_SB(0, 1), cB + hstepB, voffB); PG8_STAGE(PG8_SA(0, 1), cA + hstepA, voffA);
        if (wr == 1) PG8_BAR;
        PG8_WAIT_V(4); PG8_BAR;
        PG8_STAGE(PG8_SB(1, 0), cB + kstep, voffB); PG8_STAGE(PG8_SA(1, 0), cA + kstep, voffA); PG8_STAGE(PG8_SB(1, 1), cB + hstepB + kstep, voffB);
        PG8_WAIT_V(6); PG8_BAR;
    }
    for (;;) {
        const bool has_next = S.next(ui + 1, nxt);
        const char* nA = has_next ? (const char*)g.A + (size_t)nxt.pm * tstepA + nxt.aoff : cA; const char* nB = has_next ? (const char*)g.Bt + (size_t)nxt.pn * tstepB : cB;
        for (int t = 0; t < nt; t += 2) {
            const bool last = (t == nt - 2);
            const char* a1 = cA + (size_t)(t + 1) * kstep;
            const char* a2 = last ? nA : cA + (size_t)(t + 2) * kstep; const char* b2 = last ? nB : cB + (size_t)(t + 2) * kstep;
            const char* a3 = a2 + kstep; const char* b3 = b2 + kstep;
            if (last && has_next) S.a_ready(nxt);
            if constexpr (SP2) {
            PG8_LDB(B0, 0, 0); PG8_LDB(B1, 0, 1); PG8_SCHED; PG8_LDA(At, 0, 0); PG8_STAGE(PG8_SA(1, 1), a1 + hstepA, voffA);
            PG8_WAIT_V(8); PG8_WAIT_L(0); PG8_BAR; PG8_MMA(0, 0, At, B0); PG8_MMA(0, 1, At, B1); PG8_BAR; PG8_SCHED;
            PG8_LDA(At, 0, 1); PG8_STAGE(PG8_SB(0, 0), b2, voffB); PG8_STAGE(PG8_SB(0, 1), b2 + hstepB, voffB); PG8_STAGE(PG8_SA(0, 0), a2, voffA);
            PG8_WAIT_V(8); PG8_WAIT_L(0); PG8_BAR; PG8_MMA(1, 0, At, B0); PG8_MMA(1, 1, At, B1); PG8_BAR; PG8_SCHED;
            PG8_LDB(B0, 1, 0); PG8_LDB(B1, 1, 1); PG8_SCHED; PG8_LDA(At, 1, 0); PG8_STAGE(PG8_SA(0, 1), a2 + hstepA, voffA);
            PG8_WAIT_V(8); PG8_WAIT_L(0); PG8_BAR; PG8_MMA(0, 0, At, B0); PG8_MMA(0, 1, At, B1); PG8_BAR; PG8_SCHED;
            PG8_LDA(At, 1, 1); PG8_STAGE(PG8_SB(1, 0), b3, voffB); PG8_STAGE(PG8_SB(1, 1), b3 + hstepB, voffB); PG8_STAGE(PG8_SA(1, 0), a3, voffA);
            PG8_WAIT_V(8); PG8_WAIT_L(0); PG8_BAR; PG8_MMA(1, 0, At, B0); PG8_MMA(1, 1, At, B1); PG8_BAR; PG8_SCHED;
            } else {
            PG8_LDB(B0, 0, 0); PG8_SCHED; PG8_LDA(At, 0, 0); PG8_STAGE(PG8_SA(1, 1), a1 + hstepA, voffA);
            PG8_WAIT_L(8); PG8_BAR; PG8_WAIT_L(0); PG8_MMA(0, 0, At, B0); PG8_BAR; PG8_SCHED;
            PG8_LDB(B1, 0, 1); PG8_STAGE(PG8_SB(0, 0), b2, voffB);
            PG8_BAR; PG8_WAIT_L(0); PG8_MMA(0, 1, At, B1); PG8_BAR;
            PG8_LDA(At, 0, 1); PG8_STAGE(PG8_SA(0, 0), a2, voffA);
            PG8_BAR; PG8_WAIT_L(0); PG8_MMA(1, 0, At, B0); PG8_BAR; PG8_SCHED;
            PG8_STAGE(PG8_SB(0, 1), b2 + hstepB, voffB);
            PG8_WAIT_V(6); PG8_BAR; PG8_MMA(1, 1, At, B1); PG8_BAR;
            PG8_LDB(B0, 1, 0); PG8_SCHED; PG8_LDA(At, 1, 0); PG8_STAGE(PG8_SA(0, 1), a2 + hstepA, voffA);
            PG8_WAIT_L(8); PG8_BAR; PG8_WAIT_L(0); PG8_MMA(0, 0, At, B0); PG8_BAR; PG8_SCHED;
            PG8_LDB(B1, 1, 1); PG8_STAGE(PG8_SB(1, 0), b3, voffB);
            PG8_BAR; PG8_WAIT_L(0); PG8_MMA(0, 1, At, B1); PG8_BAR;
            PG8_LDA(At, 1, 1); PG8_STAGE(PG8_SA(1, 0), a3, voffA);
            PG8_BAR; PG8_WAIT_L(0); PG8_MMA(1, 0, At, B0); PG8_BAR; PG8_SCHED;
            PG8_STAGE(PG8_SB(1, 1), b3 + hstepB, voffB);
            PG8_WAIT_V(6); PG8_BAR; PG8_MMA(1, 1, At, B1); PG8_BAR;
            }
        }
        if constexpr (ALIGN_EPI) { if (wr == 0) PG8_BAR; }
        if constexpr (!Epi::AFTER_DRAIN) { E(acc, cur, wr, wc, fr, fq); S.done(cur); }
        if (!has_next) break;
#pragma unroll
        for (int a = 0; a < 2; ++a)
#pragma unroll
            for (int b = 0; b < 2; ++b)
#pragma unroll
                for (int m = 0; m < 4; ++m)
#pragma unroll
                    for (int n = 0; n < 2; ++n) acc[a][b][m][n] = (f32x4){0.f, 0.f, 0.f, 0.f};
        cur = nxt; cA = nA; cB = nB; ++ui;
        if constexpr (ALIGN_EPI) { if (wr == 1) PG8_BAR; }
    }
    PG8_WAIT_V(0);
    if constexpr (!ALIGN_EPI) { if (wr == 0) PG8_BAR; }
    PG8_BAR;
    if constexpr (Epi::AFTER_DRAIN) { E.fused(acc, cur, wr, wc, fr, fq, lds, wid, lane); S.done(cur); }
#undef PG8_SA
#undef PG8_SB
#undef PG8_STAGE
#undef PG8_LDA
#undef PG8_LDB
#undef PG8_MMA
#undef PG8_WAIT_V
#undef PG8_WAIT_L
#undef PG8_BAR
#undef PG8_SCHED
}
template <class Epi, class Sched, bool ALIGN_EPI = false, bool SP2 = false>
__device__ __forceinline__ void gemm_phase_g(const int wv, PG8_LAS unsigned char* lds, const Gemm g, const Sched& S, const Epi& E) {
#ifdef NO_GEMM
    return;
#endif
    const int tid_o = wv * 64 + lane_id_asm();
    const int tid = tid_o, wid = __builtin_amdgcn_readfirstlane(tid >> 6), lane = tid & 63, wr = wid >> 2, wc = wid & 3, fr = lane & 15, fq = lane >> 4;
    const int K = g.K, nt = K / BK;
    unsigned voffA[2], voffB[2];
#pragma unroll
    for (int i = 0; i < 2; ++i) { int R, C; stage_rc(tid * 16 + i * 8192, R, C); const int Rb = Epi::PERM ? ((R & ~31) + perm32(R & 31)) : R;
        voffA[i] = (unsigned)(R * g.lda + C) * 2u; voffB[i] = (unsigned)(Rb * g.ldb + C) * 2u; }
    const size_t kstep = (size_t)(BK * 2);
    const size_t hstepA = (size_t)HALF * g.lda * 2, hstepB = (size_t)HALF * g.ldb * 2;
    const size_t tstepA = 2 * hstepA, tstepB = 2 * hstepB;
    const unsigned ldsw = (unsigned)wid * 1024u;
    const int aoff = lds_byte(wr * 64 + fr, fq * 8), boff = lds_byte(wc * 32 + fr, fq * 8);
#define PG8_SA(b, h) (((b) * 2 + (h)) * HTB)
#define PG8_SB(b, h) ((4 + (b) * 2 + (h)) * HTB)
#define PG8_STAGE(bufoff, gbase, voff) do { _Pragma("unroll") for (int _i = 0; _i < 2; ++_i) \
        __builtin_amdgcn_global_load_lds((const unsigned*)((const char*)(gbase) + (voff)[_i]), (PG8_LAS unsigned*)(lds + (bufoff) + ldsw + _i * 8192), 16, 0, 0); } while (0)
#define PG8_LDA(dst, b, h) do { _Pragma("unroll") for (int m = 0; m < 4; ++m) _Pragma("unroll") for (int k = 0; k < 2; ++k) dst[m][k] = *(const PG8_LAS bf16x8*)(lds + PG8_SA(b, h) + aoff + m * 2048 + k * 1024); } while (0)
#define PG8_LDB(dst, b, h) do { _Pragma("unroll") for (int n = 0; n < 2; ++n) _Pragma("unroll") for (int k = 0; k < 2; ++k) dst[n][k] = *(const PG8_LAS bf16x8*)(lds + PG8_SB(b, h) + boff + n * 2048 + k * 1024); } while (0)
#define PG8_MMA(ai, bj, At, Bt) do { __builtin_amdgcn_s_setprio(1); _Pragma("unroll") for (int m = 0; m < 4; ++m) _Pragma("unroll") for (int n = 0; n < 2; ++n) _Pragma("unroll") for (int k = 0; k < 2; ++k) \
        acc[ai][bj][m][n] = __builtin_amdgcn_mfma_f32_16x16x32_bf16(Bt[n][k], At[m][k], acc[ai][bj][m][n], 0, 0, 0); __builtin_amdgcn_s_setprio(0); } while (0)
#define PG8_WAIT_V(n) asm volatile("s_waitcnt vmcnt(" #n ")" ::: "memory")
#define PG8_WAIT_L(n) asm volatile("s_waitcnt lgkmcnt(" #n ")" ::: "memory")
#define PG8_BAR __builtin_amdgcn_s_barrier()
#define PG8_SCHED __builtin_amdgcn_sched_barrier(0)
    Unit cur, nxt; int ui = 0;
    if (!S.next(0, cur)) return;
    unsigned vc[2][2], vn[2][2];
    { int R0, C0, R1, C1; stage_rc(tid * 16, R0, C0); stage_rc(tid * 16 + 8192, R1, C1); S.gather_voff(cur, R0, C0, R1, C1, g.lda, vc); }
    f32x4 acc[2][2][4][2];
#pragma unroll
    for (int a = 0; a < 2; ++a)
#pragma unroll
        for (int b = 0; b < 2; ++b)
#pragma unroll
            for (int m = 0; m < 4; ++m)
#pragma unroll
                for (int n = 0; n < 2; ++n) acc[a][b][m][n] = (f32x4){0.f, 0.f, 0.f, 0.f};
    bf16x8 At[4][2], B0[2][2], B1[2][2];
    const char* const cA = (const char*)g.A; const char* cB = (const char*)g.Bt + (size_t)cur.pn * tstepB;
    S.a_ready(cur);
    if constexpr (SP2) {
        PG8_STAGE(PG8_SB(0, 0), cB, voffB); PG8_STAGE(PG8_SB(0, 1), cB + hstepB, voffB); PG8_STAGE(PG8_SA(0, 0), cA, voffA); PG8_STAGE(PG8_SA(0, 1), cA + hstepA, voffA);
        if (wr == 1) PG8_BAR;
        PG8_WAIT_V(2); PG8_BAR;
        PG8_STAGE(PG8_SB(1, 0), cB + kstep, voffB); PG8_STAGE(PG8_SA(1, 0), cA + kstep, voffA); PG8_STAGE(PG8_SB(1, 1), cB + hstepB + kstep, voffB);
        PG8_WAIT_V(6); PG8_BAR;
    } else {
        PG8_STAGE(PG8_SB(0, 0), cB, voffB); PG8_STAGE(PG8_SA(0, 0), cA, vc[0]); PG8_STAGE(PG8_SB(0, 1), cB + hstepB, voffB); PG8_STAGE(PG8_SA(0, 1), cA, vc[1]);
        if (wr == 1) PG8_BAR;
        PG8_WAIT_V(4); PG8_BAR;
        PG8_STAGE(PG8_SB(1, 0), cB + kstep, voffB); PG8_STAGE(PG8_SA(1, 0), cA + kstep, vc[0]); PG8_STAGE(PG8_SB(1, 1), cB + hstepB + kstep, voffB);
        PG8_WAIT_V(6); PG8_BAR;
    }
    for (;;) {
        const bool has_next = S.next(ui + 1, nxt);
        const char* nB = has_next ? (const char*)g.Bt + (size_t)nxt.pn * tstepB : cB;
        if (has_next) { int R0, C0, R1, C1; stage_rc(tid * 16, R0, C0); stage_rc(tid * 16 + 8192, R1, C1); S.gather_voff(nxt, R0, C0, R1, C1, g.lda, vn); }
        else { vn[0][0] = vc[0][0]; vn[0][1] = vc[0][1]; vn[1][0] = vc[1][0]; vn[1][1] = vc[1][1]; }
        for (int t = 0; t < nt; t += 2) {
            const bool last = (t == nt - 2);
            const char* a1 = cA + (size_t)(t + 1) * kstep;
            const char* a2 = last ? cA : cA + (size_t)(t + 2) * kstep; const char* b2 = last ? nB : cB + (size_t)(t + 2) * kstep;
            unsigned vs[2][2]; vs[0][0] = last ? vn[0][0] : vc[0][0]; vs[0][1] = last ? vn[0][1] : vc[0][1]; vs[1][0] = last ? vn[1][0] : vc[1][0]; vs[1][1] = last ? vn[1][1] : vc[1][1];
            const char* a3 = a2 + kstep; const char* b3 = b2 + kstep;
            if (last && has_next) S.a_ready(nxt);
            if constexpr (SP2) {
            PG8_LDB(B0, 0, 0); PG8_LDB(B1, 0, 1); PG8_SCHED; PG8_LDA(At, 0, 0); PG8_STAGE(PG8_SA(1, 1), a1 + hstepA, voffA);
            PG8_WAIT_V(8); PG8_WAIT_L(0); PG8_BAR; PG8_MMA(0, 0, At, B0); PG8_MMA(0, 1, At, B1); PG8_BAR; PG8_SCHED;
            PG8_LDA(At, 0, 1); PG8_STAGE(PG8_SB(0, 0), b2, voffB); PG8_STAGE(PG8_SB(0, 1), b2 + hstepB, voffB); PG8_STAGE(PG8_SA(0, 0), a2, voffA);
            PG8_WAIT_V(8); PG8_WAIT_L(0); PG8_BAR; PG8_MMA(1, 0, At, B0); PG8_MMA(1, 1, At, B1); PG8_BAR; PG8_SCHED;
            PG8_LDB(B0, 1, 0); PG8_LDB(B1, 1, 1); PG8_SCHED; PG8_LDA(At, 1, 0); PG8_STAGE(PG8_SA(0, 1), a2 + hstepA, voffA);
            PG8_WAIT_V(8); PG8_WAIT_L(0); PG8_BAR; PG8_MMA(0, 0, At, B0); PG8_MMA(0, 1, At, B1); PG8_BAR; PG8_SCHED;
            PG8_LDA(At, 1, 1); PG8_STAGE(PG8_SB(1, 0), b3, voffB); PG8_STAGE(PG8_SB(1, 1), b3 + hstepB, voffB); PG8_STAGE(PG8_SA(1, 0), a3, voffA);
            PG8_WAIT_V(8); PG8_WAIT_L(0); PG8_BAR; PG8_MMA(1, 0, At, B0); PG8_MMA(1, 1, At, B1); PG8_BAR; PG8_SCHED;
            } else {
            PG8_LDB(B0, 0, 0); PG8_SCHED; PG8_LDA(At, 0, 0); PG8_STAGE(PG8_SA(1, 1), a1, vc[1]);
            PG8_WAIT_L(8); PG8_BAR; PG8_WAIT_L(0); PG8_MMA(0, 0, At, B0); PG8_BAR; PG8_SCHED;
            PG8_LDB(B1, 0, 1); PG8_STAGE(PG8_SB(0, 0), b2, voffB);
            PG8_BAR; PG8_WAIT_L(0); PG8_MMA(0, 1, At, B1); PG8_BAR;
            PG8_LDA(At, 0, 1); PG8_STAGE(PG8_SA(0, 0), a2, vs[0]);
            PG8_BAR; PG8_WAIT_L(0); PG8_MMA(1, 0, At, B0); PG8_BAR; PG8_SCHED;
            PG8_STAGE(PG8_SB(0, 1), b2 + hstepB, voffB);
            PG8_WAIT_V(6); PG8_BAR; PG8_MMA(1, 1, At, B1); PG8_BAR;
            PG8_LDB(B0, 1, 0); PG8_SCHED; PG8_LDA(At, 1, 0); PG8_STAGE(PG8_SA(0, 1), a2, vs[1]);
            PG8_WAIT_L(8); PG8_BAR; PG8_WAIT_L(0); PG8_MMA(0, 0, At, B0); PG8_BAR; PG8_SCHED;
            PG8_LDB(B1, 1, 1); PG8_STAGE(PG8_SB(1, 0), b3, voffB);
            PG8_BAR; PG8_WAIT_L(0); PG8_MMA(0, 1, At, B1); PG8_BAR;
            PG8_LDA(At, 1, 1); PG8_STAGE(PG8_SA(1, 0), a3, vs[0]);
            PG8_BAR; PG8_WAIT_L(0); PG8_MMA(1, 0, At, B0); PG8_BAR; PG8_SCHED;
            PG8_STAGE(PG8_SB(1, 1), b3 + hstepB, voffB);
            PG8_WAIT_V(6); PG8_BAR; PG8_MMA(1, 1, At, B1); PG8_BAR;
            }
        }
        if constexpr (ALIGN_EPI) { if (wr == 0) PG8_BAR; }
        if constexpr (!Epi::AFTER_DRAIN) { E(acc, cur, wr, wc, fr, fq); S.done(cur); }
        if (!has_next) break;
#pragma unroll
        for (int a = 0; a < 2; ++a)
#pragma unroll
            for (int b = 0; b < 2; ++b)
#pragma unroll
                for (int m = 0; m < 4; ++m)
#pragma unroll
                    for (int n = 0; n < 2; ++n) acc[a][b][m][n] = (f32x4){0.f, 0.f, 0.f, 0.f};
        cur = nxt; cB = nB; ++ui; vc[0][0] = vn[0][0]; vc[0][1] = vn[0][1]; vc[1][0] = vn[1][0]; vc[1][1] = vn[1][1];
        if constexpr (ALIGN_EPI) { if (wr == 1) PG8_BAR; }
    }
    PG8_WAIT_V(0);
    if constexpr (!ALIGN_EPI) { if (wr == 0) PG8_BAR; }
    PG8_BAR;
    if constexpr (Epi::AFTER_DRAIN) { E.fused(acc, cur, wr, wc, fr, fq, lds, wid, lane); S.done(cur); }
#undef PG8_SA
#undef PG8_SB
#undef PG8_STAGE
#undef PG8_LDA
#undef PG8_LDB
#undef PG8_MMA
#undef PG8_WAIT_V
#undef PG8_WAIT_L
#undef PG8_BAR
#undef PG8_SCHED
}

template <class Epi, class Epi1, class Sched, bool ALIGN_EPI = false, bool SP2 = false>
__device__ __forceinline__ void gemm_phase_m(const int wv, PG8_LAS unsigned char* lds, const Gemm g, const Sched& S, const Epi& E, const Epi1& E1) {
#ifdef NO_GEMM
    return;
#endif
    const int tid_o = wv * 64 + lane_id_asm();
    const int tid = tid_o, wid = __builtin_amdgcn_readfirstlane(tid >> 6), lane = tid & 63, wr = wid >> 2, wc = wid & 3, fr = lane & 15, fq = lane >> 4;
    int nt;
    unsigned voffA[2], voffB[2];
#pragma unroll
    for (int i = 0; i < 2; ++i) { int R, C; stage_rc(tid * 16 + i * 8192, R, C); const int Rb = Epi::PERM ? ((R & ~31) + perm32(R & 31)) : R;
        voffA[i] = (unsigned)(R * g.lda + C) * 2u; voffB[i] = (unsigned)(Rb * g.ldb + C) * 2u; }
    const size_t kstep = (size_t)(BK * 2);
    const size_t hstepA = (size_t)HALF * g.lda * 2, hstepB = (size_t)HALF * g.ldb * 2;
    const size_t tstepA = 2 * hstepA, tstepB = 2 * hstepB;
    const unsigned ldsw = (unsigned)wid * 1024u;
    const int aoff = lds_byte(wr * 64 + fr, fq * 8), boff = lds_byte(wc * 32 + fr, fq * 8);
#define PG8_SA(b, h) (((b) * 2 + (h)) * HTB)
#define PG8_SB(b, h) ((4 + (b) * 2 + (h)) * HTB)
#define PG8_STAGE(bufoff, gbase, voff) do { _Pragma("unroll") for (int _i = 0; _i < 2; ++_i) \
        __builtin_amdgcn_global_load_lds((const unsigned*)((const char*)(gbase) + (voff)[_i]), (PG8_LAS unsigned*)(lds + (bufoff) + ldsw + _i * 8192), 16, 0, 0); } while (0)
#define PG8_LDA(dst, b, h) do { _Pragma("unroll") for (int m = 0; m < 4; ++m) _Pragma("unroll") for (int k = 0; k < 2; ++k) dst[m][k] = *(const PG8_LAS bf16x8*)(lds + PG8_SA(b, h) + aoff + m * 2048 + k * 1024); } while (0)
#define PG8_LDB(dst, b, h) do { _Pragma("unroll") for (int n = 0; n < 2; ++n) _Pragma("unroll") for (int k = 0; k < 2; ++k) dst[n][k] = *(const PG8_LAS bf16x8*)(lds + PG8_SB(b, h) + boff + n * 2048 + k * 1024); } while (0)
#define PG8_MMA(ai, bj, At, Bt) do { __builtin_amdgcn_s_setprio(1); _Pragma("unroll") for (int m = 0; m < 4; ++m) _Pragma("unroll") for (int n = 0; n < 2; ++n) _Pragma("unroll") for (int k = 0; k < 2; ++k) \
        acc[ai][bj][m][n] = __builtin_amdgcn_mfma_f32_16x16x32_bf16(Bt[n][k], At[m][k], acc[ai][bj][m][n], 0, 0, 0); __builtin_amdgcn_s_setprio(0); } while (0)
#define PG8_WAIT_V(n) asm volatile("s_waitcnt vmcnt(" #n ")" ::: "memory")
#define PG8_WAIT_L(n) asm volatile("s_waitcnt lgkmcnt(" #n ")" ::: "memory")
#define PG8_BAR __builtin_amdgcn_s_barrier()
#define PG8_SCHED __builtin_amdgcn_sched_barrier(0)
    Unit cur, nxt; int ui = 0;
    if (!S.next(0, cur)) return;
    f32x4 acc[2][2][4][2];
#pragma unroll
    for (int a = 0; a < 2; ++a)
#pragma unroll
        for (int b = 0; b < 2; ++b)
#pragma unroll
            for (int m = 0; m < 4; ++m)
#pragma unroll
                for (int n = 0; n < 2; ++n) acc[a][b][m][n] = (f32x4){0.f, 0.f, 0.f, 0.f};
    bf16x8 At[4][2], B0[2][2], B1[2][2];
    const char *cA, *cA2, *cB, *cB2; S.ptrs(cur, cA, cA2, cB, cB2, nt);
    S.a_ready(cur);
    if constexpr (SP2) {
        PG8_STAGE(PG8_SB(0, 0), cB, voffB); PG8_STAGE(PG8_SB(0, 1), cB + hstepB, voffB); PG8_STAGE(PG8_SA(0, 0), cA, voffA); PG8_STAGE(PG8_SA(0, 1), cA + hstepA, voffA);
        if (wr == 1) PG8_BAR;
        PG8_WAIT_V(2); PG8_BAR;
        PG8_STAGE(PG8_SB(1, 0), cB + kstep, voffB); PG8_STAGE(PG8_SA(1, 0), cA + kstep, voffA); PG8_STAGE(PG8_SB(1, 1), cB + hstepB + kstep, voffB);
        PG8_WAIT_V(6); PG8_BAR;
    } else {
        PG8_STAGE(PG8_SB(0, 0), cB, voffB); PG8_STAGE(PG8_SA(0, 0), cA, voffA); PG8_STAGE(PG8_SB(0, 1), cB + hstepB, voffB); PG8_STAGE(PG8_SA(0, 1), cA + hstepA, voffA);
        if (wr == 1) PG8_BAR;
        PG8_WAIT_V(4); PG8_BAR;
        PG8_STAGE(PG8_SB(1, 0), cB + kstep, voffB); PG8_STAGE(PG8_SA(1, 0), cA + kstep, voffA); PG8_STAGE(PG8_SB(1, 1), cB + hstepB + kstep, voffB);
        PG8_WAIT_V(6); PG8_BAR;
    }
    for (;;) {
        const bool has_next = S.next(ui + 1, nxt);
        const char *nA = cA, *nA2 = cA2, *nB = cB, *nB2 = cB2; int nnt = nt; if (has_next) S.ptrs(nxt, nA, nA2, nB, nB2, nnt);
        for (int t = 0; t < nt; t += 2) {
            const bool last = (t == nt - 2);
            const char* a1 = (t + 1 < 32) ? cA + (size_t)(t + 1) * kstep : cA2 + (size_t)(t + 1 - 32) * kstep;
            const char* a2 = last ? nA : ((t + 2 < 32) ? cA + (size_t)(t + 2) * kstep : cA2 + (size_t)(t + 2 - 32) * kstep);
            const char* b2 = last ? nB : ((t + 2 < 32) ? cB + (size_t)(t + 2) * kstep : cB2 + (size_t)(t + 2 - 32) * kstep);
            const char* a3 = a2 + kstep; const char* b3 = b2 + kstep;
            if (last && has_next) S.a_ready(nxt);
            if constexpr (SP2) {
            PG8_LDB(B0, 0, 0); PG8_LDB(B1, 0, 1); PG8_SCHED; PG8_LDA(At, 0, 0); PG8_STAGE(PG8_SA(1, 1), a1 + hstepA, voffA);
            PG8_WAIT_V(8); PG8_WAIT_L(0); PG8_BAR; PG8_MMA(0, 0, At, B0); PG8_MMA(0, 1, At, B1); PG8_BAR; PG8_SCHED;
            PG8_LDA(At, 0, 1); PG8_STAGE(PG8_SB(0, 0), b2, voffB); PG8_STAGE(PG8_SB(0, 1), b2 + hstepB, voffB); PG8_STAGE(PG8_SA(0, 0), a2, voffA);
            PG8_WAIT_V(8); PG8_WAIT_L(0); PG8_BAR; PG8_MMA(1, 0, At, B0); PG8_MMA(1, 1, At, B1); PG8_BAR; PG8_SCHED;
            PG8_LDB(B0, 1, 0); PG8_LDB(B1, 1, 1); PG8_SCHED; PG8_LDA(At, 1, 0); PG8_STAGE(PG8_SA(0, 1), a2 + hstepA, voffA);
            PG8_WAIT_V(8); PG8_WAIT_L(0); PG8_BAR; PG8_MMA(0, 0, At, B0); PG8_MMA(0, 1, At, B1); PG8_BAR; PG8_SCHED;
            PG8_LDA(At, 1, 1); PG8_STAGE(PG8_SB(1, 0), b3, voffB); PG8_STAGE(PG8_SB(1, 1), b3 + hstepB, voffB); PG8_STAGE(PG8_SA(1, 0), a3, voffA);
            PG8_WAIT_V(8); PG8_WAIT_L(0); PG8_BAR; PG8_MMA(1, 0, At, B0); PG8_MMA(1, 1, At, B1); PG8_BAR; PG8_SCHED;
            } else {
            PG8_LDB(B0, 0, 0); PG8_SCHED; PG8_LDA(At, 0, 0); PG8_STAGE(PG8_SA(1, 1), a1 + hstepA, voffA);
            PG8_WAIT_L(8); PG8_BAR; PG8_WAIT_L(0); PG8_MMA(0, 0, At, B0); PG8_BAR; PG8_SCHED;
            PG8_LDB(B1, 0, 1); PG8_STAGE(PG8_SB(0, 0), b2, voffB);
            PG8_BAR; PG8_WAIT_L(0); PG8_MMA(0, 1, At, B1); PG8_BAR;
            PG8_LDA(At, 0, 1); PG8_STAGE(PG8_SA(0, 0), a2, voffA);
            PG8_BAR; PG8_WAIT_L(0); PG8_MMA(1, 0, At, B0); PG8_BAR; PG8_SCHED;
            PG8_STAGE(PG8_SB(0, 1), b2 + hstepB, voffB);
            PG8_WAIT_V(6); PG8_BAR; PG8_MMA(1, 1, At, B1); PG8_BAR;
            PG8_LDB(B0, 1, 0); PG8_SCHED; PG8_LDA(At, 1, 0); PG8_STAGE(PG8_SA(0, 1), a2 + hstepA, voffA);
            PG8_WAIT_L(8); PG8_BAR; PG8_WAIT_L(0); PG8_MMA(0, 0, At, B0); PG8_BAR; PG8_SCHED;
            PG8_LDB(B1, 1, 1); PG8_STAGE(PG8_SB(1, 0), b3, voffB);
            PG8_BAR; PG8_WAIT_L(0); PG8_MMA(0, 1, At, B1); PG8_BAR;
            PG8_LDA(At, 1, 1); PG8_STAGE(PG8_SA(1, 0), a3, voffA);
            PG8_BAR; PG8_WAIT_L(0); PG8_MMA(1, 0, At, B0); PG8_BAR; PG8_SCHED;
            PG8_STAGE(PG8_SB(1, 1), b3 + hstepB, voffB);
            PG8_WAIT_V(6); PG8_BAR; PG8_MMA(1, 1, At, B1); PG8_BAR;
            }
        }
        if constexpr (ALIGN_EPI) { if (wr == 0) PG8_BAR; }
        if (cur.aoff == 0) E(acc, cur, wr, wc, fr, fq); else E1(acc, cur, wr, wc, fr, fq);
        if (!has_next) break;
#pragma unroll
        for (int a = 0; a < 2; ++a)
#pragma unroll
            for (int b = 0; b < 2; ++b)
#pragma unroll
                for (int m = 0; m < 4; ++m)
#pragma unroll
                    for (int n = 0; n < 2; ++n) acc[a][b][m][n] = (f32x4){0.f, 0.f, 0.f, 0.f};
        cur = nxt; cA = nA; cA2 = nA2; cB = nB; cB2 = nB2; nt = nnt; ++ui;
        if constexpr (ALIGN_EPI) { if (wr == 1) PG8_BAR; }
    }
    PG8_WAIT_V(0);
    if constexpr (!ALIGN_EPI) { if (wr == 0) PG8_BAR; }
    PG8_BAR;
#undef PG8_SA
#undef PG8_SB
#undef PG8_STAGE
#undef PG8_LDA
#undef PG8_LDB
#undef PG8_MMA
#undef PG8_WAIT_V
#undef PG8_WAIT_L
#undef PG8_BAR
#undef PG8_SCHED
}


}

#define XB_TMO      128
#define XB_XCNT(j)  (256  + 64 * (j))
#define XB_XSUB(j)  (1280 + 64 * (j))
#define XB_XGEN(j)  (2304 + 64 * (j))
#define XB_TOP      3328
#define XB_TOPGEN   3392
#define XCD_BAR_WORDS 3456
#define XB_SPIN_CAP (1u << 18)

__device__ __forceinline__ unsigned xb_ld(unsigned* p)              { return __hip_atomic_load(p, __ATOMIC_RELAXED, __HIP_MEMORY_SCOPE_AGENT); }
__device__ __forceinline__ unsigned xb_add(unsigned* p, unsigned v) { return __hip_atomic_fetch_add(p, v, __ATOMIC_RELAXED, __HIP_MEMORY_SCOPE_AGENT); }
__device__ __forceinline__ unsigned xb_xcc_id() { return (unsigned)__builtin_amdgcn_s_getreg((3 << 11) | 20) & 0xFu; }
#define XB_SPIN(cond, bar) do { unsigned _sp = 0; while (cond) { __builtin_amdgcn_s_sleep(1); \
    if ((++_sp & 255u) == 0u) { if (xb_ld(&(bar)[XB_TMO])) break; if (_sp > XB_SPIN_CAP) { atomicAdd(&(bar)[XB_TMO], 1u); break; } } } } while (0)

struct XcdBarrier {
    unsigned* bar; unsigned x;
    volatile LAS unsigned* st;
};

__device__ __forceinline__ XcdBarrier xcd_barrier_post(unsigned* bar, volatile LAS unsigned* st, const bool t0) {
    XcdBarrier b; b.bar = bar; b.x = xb_xcc_id(); b.st = st;
    if (t0) (void)xb_add(&bar[XB_XCNT(b.x)], 1u);
    return b;
}
__device__ __forceinline__ void xcd_barrier_complete(unsigned* bar, unsigned x, unsigned& nloc, unsigned& nx) {
    const unsigned G = gridDim.x * gridDim.y * gridDim.z;
    unsigned sum, cnt, mine, sp = 0u;
    for (;;) {
        sum = 0u; cnt = 0u; mine = 0u;
#pragma unroll
        for (unsigned j = 0; j < 16; ++j) { const unsigned c = xb_ld(&bar[XB_XCNT(j)]); sum += c; cnt += (c > 0u) ? 1u : 0u; mine = (j == x) ? c : mine; }
        if (sum == G) break;
        __builtin_amdgcn_s_sleep(1);
        if ((++sp & 255u) == 0u) { if (xb_ld(&bar[XB_TMO])) break; if (sp > XB_SPIN_CAP) { atomicAdd(&bar[XB_TMO], 1u); break; } }
    }
    nloc = mine > 0u ? mine : 1u; nx = cnt > 0u ? cnt : 1u;
}

__device__ __forceinline__ void xcd_barrier(const XcdBarrier& b, const bool t0) {
    asm volatile("s_waitcnt vmcnt(0)" ::: "memory");
    __syncthreads();
    if (t0) {
        unsigned* bar = b.bar;
        __builtin_amdgcn_s_waitcnt(0);
        unsigned nloc = b.st[0], nx = b.st[1];
        if (nloc == 0u) { xcd_barrier_complete(bar, b.x, nloc, nx); b.st[0] = nloc; b.st[1] = nx; }
        const unsigned old = xb_add(&bar[XB_XSUB(b.x)], 1u);
        const unsigned gen = old / nloc;
        if (old + 1u == (gen + 1u) * nloc) {
            __builtin_amdgcn_fence(__ATOMIC_RELEASE, "agent");
            asm volatile("s_waitcnt vmcnt(0)" ::: "memory");
            const unsigned og = xb_add(&bar[XB_TOP], 1u);
            const unsigned tg = og / nx;
            if (og + 1u == (tg + 1u) * nx) xb_add(&bar[XB_TOPGEN], 1u);
            else XB_SPIN(xb_ld(&bar[XB_TOPGEN]) == tg, bar);
            __builtin_amdgcn_fence(__ATOMIC_ACQUIRE, "agent");
            xb_add(&bar[XB_XGEN(b.x)], 1u);
            asm volatile("s_waitcnt vmcnt(0)" ::: "memory");
        } else {
            XB_SPIN(xb_ld(&bar[XB_XGEN(b.x)]) == gen, bar);
            __builtin_amdgcn_fence(__ATOMIC_ACQUIRE, "agent");
            asm volatile("s_waitcnt vmcnt(0)" ::: "memory");
        }
    }
    __syncthreads();
}

constexpr int NWAVES = 8, NTHR = 512;
constexpr int NB = 4, SEQ = 4096, T_ = NB * SEQ, D_ = 2048;
constexpr int EVEN_IN = 7176, ZW = 7168;
constexpr float DN_ALPHA = 1.6817928305074290f;
constexpr float LN_EPS = 1e-5f;
constexpr int MOE_ROWS = 40960, MOE_TILES = MOE_ROWS / 256;

constexpr size_t MiB = 1u << 20;
constexpr size_t WS_CTL = 0, CTL_ZERO_BYTES = 1 * MiB;
constexpr size_t WS_IG = 1 * MiB, WS_FG = WS_IG + 256 * 1024, WS_KPART = 2 * MiB;
constexpr size_t WS_TOKE = 3 * MiB, WS_TOKR = WS_TOKE + 128 * 1024, WS_TOKG = WS_TOKR + 128 * 1024, WS_SLOT = WS_TOKG + 128 * 1024;
constexpr size_t WS_DN = 4 * MiB, WS_NP = 5 * MiB, WS_DEC = 6 * MiB, WS_BC = 6 * MiB + 65536;
constexpr size_t WS_LIST = 8 * MiB;
constexpr size_t WS_RW = 12 * MiB;
constexpr size_t WS_WIN = 16 * MiB;
constexpr size_t WS_WOUT = 72 * MiB;
constexpr size_t WS_WRKV = 88 * MiB;
constexpr size_t WS_WO = 136 * MiB;
constexpr size_t WS_WL1 = 152 * MiB;
constexpr size_t WS_WL2 = 160 * MiB;
constexpr size_t WS_WGU = 168 * MiB;
constexpr size_t WS_WDN = 680 * MiB;
constexpr size_t WS_XB = 936 * MiB;
constexpr size_t WS_VF = 1000 * MiB;
constexpr size_t WS_R = 1064 * MiB;
constexpr size_t WS_Z = WS_R;
constexpr size_t WS_QKB = WS_R + 224 * MiB;
constexpr size_t WS_VAT = WS_R + 288 * MiB;
constexpr size_t WS_YE = WS_R + 320 * MiB;
constexpr size_t WS_DC = WS_R + 384 * MiB;
constexpr size_t WS_CP = WS_R + 512 * MiB;
constexpr size_t WS_XRKV = WS_R;
constexpr size_t WS_XC = WS_R + 192 * MiB;
constexpr size_t WS_RKV = WS_R + 320 * MiB;
constexpr size_t WS_L1 = WS_R + 512 * MiB;
constexpr size_t WS_G = WS_R + 528 * MiB;
constexpr size_t WS_WD = WS_R + 592 * MiB;
constexpr size_t WS_AA = WS_R + 656 * MiB;
constexpr size_t WS_YO = WS_R + 720 * MiB;
constexpr size_t WS_XS = WS_R;
constexpr size_t WS_HID = WS_R + 160 * MiB;
constexpr size_t WS_YS = WS_R + 400 * MiB;
constexpr size_t WS_X2 = WS_R + 784 * MiB;
constexpr size_t WS_VG = WS_X2 + 64 * MiB;
constexpr size_t WS_XSUM = WS_X2 + 64 * MiB;
constexpr size_t WS_END = WS_X2 + 128 * MiB;

constexpr int CW_BAR = 4096;
constexpr int CW_CNT = 16384;

constexpr int LDS_BYTES = 163840;
constexpr int MISC_OFF = LDS_BYTES - 4096;
constexpr int RING_BYTES = MISC_OFF;

typedef unsigned gu32;

#ifndef MOE_PROLOGUE_LAYERS
#define MOE_PROLOGUE_LAYERS 1
#endif
struct Args { const float* in[39]; float* out; unsigned char* ws; int ph_lo, ph_hi; };
#define CAS __attribute__((address_space(4)))
typedef const CAS Args* ArgsP;
#define XIN(a, l) ((bf16*)((a)->ws + (((l) == 0 || (l) == 3) ? WS_XB : WS_X2)))
#define XOUT(a, l) ((bf16*)((a)->ws + (((l) <= 1) ? WS_X2 : WS_XB)))
__device__ __forceinline__ ArgsP get_args() { ArgsP p = (ArgsP)__builtin_amdgcn_kernarg_segment_ptr(); asm volatile("" : "+s"(p)); return p; }

template <int NH> __device__ __forceinline__ void tr_item_n(const float* W, int ldw, int k0, int n0, bf16* WT, int ldt, int drow0, int dcol0, LAS float* scr, int lane, const float* kscale) {
    const int r = lane >> 3, c4 = lane & 7;
    f32x4 v[NH][8];
#pragma unroll
    for (int hh = 0; hh < NH; ++hh)
#pragma unroll
        for (int i = 0; i < 8; ++i) v[hh][i] = __builtin_nontemporal_load((const f32x4*)(W + (size_t)(k0 + 64 * hh + 8 * i + r) * ldw + n0 + 4 * c4));
#pragma unroll
    for (int hh = 0; hh < NH; ++hh) {
        if (kscale) {
#pragma unroll
            for (int i = 0; i < 8; ++i) v[hh][i] = v[hh][i] * kscale[k0 + 64 * hh + 8 * i + r]; }
#pragma unroll
        for (int i = 0; i < 8; ++i) { LAS float* d = scr + (8 * i + r) * 33 + 4 * c4; d[0] = v[hh][i].x; d[1] = v[hh][i].y; d[2] = v[hh][i].z; d[3] = v[hh][i].w; }
        LDS_WAIT(); asm volatile("" ::: "memory");
        const int c = lane & 7;
#pragma unroll
        for (int j = 0; j < 4; ++j) { const int n = (lane >> 3) + 8 * j; const LAS float* s = scr + (8 * c) * 33 + n;
            v4u o; o.x = pk2(s[0 * 33], s[1 * 33]); o.y = pk2(s[2 * 33], s[3 * 33]); o.z = pk2(s[4 * 33], s[5 * 33]); o.w = pk2(s[6 * 33], s[7 * 33]);
            *(v4u*)(WT + (size_t)(drow0 + n) * ldt + dcol0 + 64 * hh + 8 * c) = o; }
        LDS_WAIT(); asm volatile("" ::: "memory");
    }
}
__device__ __forceinline__ void tr_item(const float* W, int ldw, int k0, int n0, bf16* WT, int ldt, int drow0, int dcol0, LAS float* scr, int lane, const float* kscale) {
    tr_item_n<1>(W, ldw, k0, n0, WT, ldt, drow0, dcol0, scr, lane, kscale); }

__device__ __forceinline__ void moe_convert(const int wv, LAS unsigned char* lds, int le_lo, int le_hi, int vb, int nvb) {
    const ArgsP a = get_args();
    OPAQUE_TID(); const int lane = tid & 63, wave = tid >> 6;
    unsigned char* ws = a->ws;
    LAS float* scr = (LAS float*)(lds + wave * 16384);
    const int n = (le_hi - le_lo) * 768;
    for (int it = vb * NWAVES + wave; it < n; it += nvb * NWAVES) {
        const int le = le_lo + it / 768, rr = it % 768, mat = rr / 256, q = rr % 256;
        if (mat < 2) { const int kb = q / 16, nb = q % 16, n0 = 32 * nb;
            tr_item_n<2>((mat == 0 ? a->in[36] : a->in[37]) + (size_t)le * 2048 * 512, 512, 128 * kb, n0, (bf16*)(ws + WS_WGU) + (size_t)le * 1024 * 2048, 2048,
                    (n0 / 128) * 256 + (n0 % 128) + (mat == 1 ? 128 : 0), 128 * kb, scr, lane, nullptr); }
        else { const int kb = q / 64, nb = q % 64;
            tr_item_n<2>(a->in[38] + (size_t)le * 512 * 2048, 2048, 128 * kb, 32 * nb, (bf16*)(ws + WS_WDN) + (size_t)le * 2048 * 512, 512, 32 * nb, 128 * kb, scr, lane, nullptr); }
    }
}

__device__ __forceinline__ void prologue(const int wv, LAS unsigned char* lds, const int part) {
    const ArgsP a = get_args();
#ifdef NO_PROL
    return;
#endif
    OPAQUE_TID(); const int lane = tid & 63, wave = tid >> 6;
    unsigned char* ws = a->ws;
    LAS float* scr = (LAS float*)(lds + wave * 16384);
    const int gw = blockIdx.x * NWAVES + wave, NGW = gridDim.x * NWAVES;
    constexpr int I0 = 2 * 3584, I1 = 2 * 1024, I2 = 2 * 4 * 1024,     I3 = 2 * 32 * 16, I4 = MOE_PROLOGUE_LAYERS * 32 * 768;
    constexpr int NITEMS = I0 + I1 + I2 + I3 + I4;
    for (int it = (part == 0 ? 0 : 3584) + gw; it < (part == 0 ? 3584 : NITEMS); it += NGW) {
        int r = it;
        if (r < I0) { const int e = r / 3584, rr = r % 3584, kb = rr / 224, nb = rr % 224;
            tr_item_n<2>(a->in[1] + (size_t)e * 2048 * EVEN_IN, EVEN_IN, 128 * kb, 32 * nb, (bf16*)(ws + WS_WIN) + (size_t)e * ZW * 2048, 2048, 32 * nb, 128 * kb, scr, lane, nullptr); continue; } r -= I0;
        if (r < I1) { const int e = r / 1024, rr = r % 1024, kb = rr / 64, nb = rr % 64;
            tr_item_n<2>(a->in[6] + (size_t)e * 2048 * 2048, 2048, 128 * kb, 32 * nb, (bf16*)(ws + WS_WOUT) + (size_t)e * 2048 * 2048, 2048, 32 * nb, 128 * kb, scr, lane, nullptr); continue; } r -= I1;
        if (r < I2) { const int o = r / 4096, rr = r % 4096, mat = rr / 1024, q = rr % 1024, kb = q / 64, nb = q % 64;
            const float* src = (mat == 0 ? a->in[8] : mat == 1 ? a->in[9] : mat == 2 ? a->in[10] : a->in[11]) + (size_t)o * 2048 * 2048;
            bf16* dst = (mat < 3) ? (bf16*)(ws + WS_WRKV) + (size_t)o * 3 * 2048 * 2048 + (size_t)mat * 2048 * 2048 : (bf16*)(ws + WS_WO) + (size_t)o * 2048 * 2048;
            tr_item_n<2>(src, 2048, 128 * kb, 32 * nb, dst, 2048, 32 * nb, 128 * kb, scr, lane, nullptr); continue; } r -= I2;
        if (r < I3) { const int o = r / 512, rr = r % 512, kb = rr / 16, nb = rr % 16;
            const float* src; int ldw, n0, drow0, mu;
            if (nb < 8) { src = a->in[18] + (size_t)o * 2048 * 256; ldw = 256; n0 = 32 * nb; drow0 = 32 * nb; mu = 5; }
            else if (nb < 11) { src = a->in[13] + (size_t)o * 2048 * 96; ldw = 96; n0 = 32 * (nb - 8); drow0 = 256 + n0; mu = 1; }
            else if (nb < 14) { src = a->in[16] + (size_t)o * 2048 * 96; ldw = 96; n0 = 32 * (nb - 11); drow0 = 352 + n0; mu = 4; }
            else { if (o == 0) continue; src = a->in[26]; ldw = 64; n0 = 32 * (nb - 14); drow0 = 448 + n0; mu = 3; }
            bf16* dst = (bf16*)(ws + WS_WL1) + (size_t)o * 2 * 512 * 2048;
            tr_item(src, ldw, 64 * kb, n0, dst, 2048, drow0, 64 * kb, scr, lane, nullptr);
            tr_item(src, ldw, 64 * kb, n0, dst + (size_t)512 * 2048, 2048, drow0, 64 * kb, scr, lane, a->in[7] + (size_t)(o * 6 + mu) * 2048);
            continue; } r -= I3;
        { const int le = r / 768, rr = r % 768, mat = rr / 256, q = rr % 256;
            if (mat < 2) { const int kb = q / 16, nb = q % 16, n0 = 32 * nb;
                tr_item_n<2>((mat == 0 ? a->in[36] : a->in[37]) + (size_t)le * 2048 * 512, 512, 128 * kb, n0, (bf16*)(ws + WS_WGU) + (size_t)le * 1024 * 2048, 2048,
                        (n0 / 128) * 256 + (n0 % 128) + (mat == 1 ? 128 : 0), 128 * kb, scr, lane, nullptr); }
            else { const int kb = q / 64, nb = q % 64;
                tr_item_n<2>(a->in[38] + (size_t)le * 512 * 2048, 2048, 128 * kb, 32 * nb, (bf16*)(ws + WS_WDN) + (size_t)le * 2048 * 512, 512, 32 * nb, 128 * kb, scr, lane, nullptr); }
        }
    }
    const int gt = blockIdx.x * NTHR + tid, NGT = gridDim.x * NTHR;
    for (int idx = gt; part == 1 && idx < 2 * 32 * 8192; idx += NGT) {
        const int o = idx / (32 * 8192), rem = idx % (32 * 8192), kg = rem / 8192, n = rem % 8192, mat = n / 2048, nn = n % 2048;
        float v[8];
#pragma unroll
        for (int j = 0; j < 8; ++j) { const int k = 8 * kg + j; float x = 0.f;
            if (mat == 0) x = a->in[19][((size_t)o * 256 + k) * 2048 + nn];
            else if (mat == 1) { if (k < 96) x = a->in[14][((size_t)o * 96 + k) * 2048 + nn]; }
            else if (mat == 2) { if (k >= 96 && k < 192) x = a->in[17][((size_t)o * 96 + (k - 96)) * 2048 + nn]; }
            else { if (o == 1 && k >= 192) x = a->in[27][(size_t)(k - 192) * 2048 + nn]; }
            v[j] = x; }
        v4u w; w.x = pk2(v[0], v[1]); w.y = pk2(v[2], v[3]); w.z = pk2(v[4], v[5]); w.w = pk2(v[6], v[7]);
        *(v4u*)((bf16*)(ws + WS_WL2) + ((size_t)o * 8192 + n) * 256 + 8 * kg) = w;
    }
    for (int idx = gt; part == 0 && idx < 4 * 2048 * 9; idx += NGT) { const int l = idx / (2048 * 9), rem = idx % (2048 * 9), k = rem / 9, q = rem % 9;
        const f32x4 v = (q == 0) ? *(const f32x4*)(a->in[32] + ((size_t)l * 2048 + k) * 4) : *(const f32x4*)(a->in[34] + ((size_t)l * 2048 + k) * 32 + 4 * (q - 1));
        ((f32x4*)(ws + WS_RW))[(size_t)l * 9 * 2048 + q * 2048 + ((k >> 8) * 4 + (k & 3)) * 64 + ((k >> 2) & 63)] = v; }
    for (int i0 = gt; part == 0 && i0 < T_ * D_ / 4; i0 += 8 * NGT) { f32x4 v[8];
#pragma unroll
        for (int k = 0; k < 8; ++k) { const int i = i0 + k * NGT; v[k] = (i < T_ * D_ / 4) ? __builtin_nontemporal_load((const f32x4*)a->in[0] + i) : (f32x4){0.f, 0.f, 0.f, 0.f}; }
#pragma unroll
        for (int k = 0; k < 8; ++k) { const int i = i0 + k * NGT; if (i < T_ * D_ / 4) { v2u w; w.x = pk2(v[k].x, v[k].y); w.y = pk2(v[k].z, v[k].w); ((v2u*)(ws + WS_XB))[i] = w; } } }
}

__device__ __forceinline__ void even_prep(const int wv, int e, LAS unsigned char* lds, int u) {
    const ArgsP a = get_args();
#ifdef NO_EPREP
    return;
#endif
    OPAQUE_TID(); const int lane = tid & 63, wave = tid >> 6;
    unsigned char* ws = a->ws;
    bf16* Z = (bf16*)(ws + WS_Z);
    const int m0 = 64 * u, b = u >> 6, ch = u & 63, t0 = ch * 64;
    { LAS float* cst = (LAS float*)lds; LAS float* snt = cst + 1024;
#pragma unroll 1
      for (int q = tid; q < 1024; q += NTHR) { const int r = q >> 4, i = q & 15; const float inv = exp2f(-(float)i * (18.931568569324174f / 16.f));
          float sn_, cs_; sincosf((float)(t0 + r) * inv, &sn_, &cs_); cst[q] = cs_; snt[q] = sn_; }
      __syncthreads();
      const int row = tid >> 3, head = tid & 7;
      float cs[16], sn[16];
#pragma unroll
      for (int i = 0; i < 4; ++i) { const f32x4 c4 = *(const LAS f32x4*)(cst + row * 16 + 4 * i), s4 = *(const LAS f32x4*)(snt + row * 16 + 4 * i);
          cs[4 * i] = c4.x; cs[4 * i + 1] = c4.y; cs[4 * i + 2] = c4.z; cs[4 * i + 3] = c4.w; sn[4 * i] = s4.x; sn[4 * i + 1] = s4.y; sn[4 * i + 2] = s4.z; sn[4 * i + 3] = s4.w; }
      v4u rin[2][4];
#pragma unroll
      for (int qk = 0; qk < 2; ++qk) { const v4u* p = (const v4u*)(Z + (size_t)(m0 + row) * ZW + qk * 1024 + head * 128); rin[qk][0] = p[0]; rin[qk][1] = p[1]; rin[qk][2] = p[2]; rin[qk][3] = p[3]; }
#pragma unroll
      for (int qk = 0; qk < 2; ++qk) { v4u* p = (v4u*)(Z + (size_t)(m0 + row) * ZW + qk * 1024 + head * 128);
        const v4u w0 = rin[qk][0], w1 = rin[qk][1], w2 = rin[qk][2], w3 = rin[qk][3]; unsigned x1[8] = {w0.x, w0.y, w0.z, w0.w, w1.x, w1.y, w1.z, w1.w}, x2[8] = {w2.x, w2.y, w2.z, w2.w, w3.x, w3.y, w3.z, w3.w};
        unsigned o1[8], o2[8];
#pragma unroll
        for (int j = 0; j < 8; ++j) { const float a0 = bflo(x1[j]), a1 = bfhi(x1[j]), b0 = bflo(x2[j]), b1 = bfhi(x2[j]);
            o1[j] = pk2(a0 * cs[2 * j] - b0 * sn[2 * j], a1 * cs[2 * j + 1] - b1 * sn[2 * j + 1]);
            o2[j] = pk2(b0 * cs[2 * j] + a0 * sn[2 * j], b1 * cs[2 * j + 1] + a1 * sn[2 * j + 1]); }
        p[0] = (v4u){o1[0], o1[1], o1[2], o1[3]}; p[1] = (v4u){o1[4], o1[5], o1[6], o1[7]}; p[2] = (v4u){o2[0], o2[1], o2[2], o2[3]}; p[3] = (v4u){o2[4], o2[5], o2[6], o2[7]}; }
    }
    VM_WAIT(); __syncthreads();
    { LAS float* red = (LAS float*)lds;
      const int cg = tid & 127, rq = tid >> 7; float s[8] = {0, 0, 0, 0, 0, 0, 0, 0};
      v4u kin[16];
#pragma unroll
      for (int r = 0; r < 16; ++r) kin[r] = *(const v4u*)(Z + (size_t)(m0 + rq * 16 + r) * ZW + 1024 + cg * 8);
#pragma unroll
      for (int r = 0; r < 16; ++r) { const v4u w = kin[r];
          s[0] += bflo(w.x); s[1] += bfhi(w.x); s[2] += bflo(w.y); s[3] += bfhi(w.y); s[4] += bflo(w.z); s[5] += bfhi(w.z); s[6] += bflo(w.w); s[7] += bfhi(w.w); }
#pragma unroll
      for (int j = 0; j < 8; ++j) red[rq * 1024 + cg * 8 + j] = s[j];
      __syncthreads();
      if (tid < 256) { f32x4 t = {0, 0, 0, 0};
#pragma unroll
          for (int q = 0; q < 4; ++q) { const f32x4 v = *(const LAS f32x4*)(red + q * 1024 + tid * 4); t += v; }
          const int c = tid * 4, h = c >> 7, d = c & 127;
          *(f32x4*)((float*)(ws + WS_KPART) + ((size_t)((b * 8 + h) * 64 + ch)) * 128 + d) = t; }
      __syncthreads();
    }
    { const int cg = tid & 255, rh = tid >> 8; const int c0 = 8 * cg;
      const float* cw = a->in[3] + (size_t)e * 4 * 2048; const float* cb = a->in[4] + (size_t)e * 2048;
      float w[4][8], bias[8];
#pragma unroll
      for (int j = 0; j < 4; ++j)
#pragma unroll
          for (int i = 0; i < 8; ++i) w[j][i] = cw[j * 2048 + c0 + i];
#pragma unroll
      for (int i = 0; i < 8; ++i) bias[i] = cb[c0 + i];
      float win[3][8];
#pragma unroll
      for (int j = 0; j < 3; ++j) { const int tt = t0 + 32 * rh - 3 + j;
          v4u x = {0, 0, 0, 0}; if (tt >= 0) x = *(const v4u*)(Z + (size_t)(b * SEQ + tt) * ZW + 3072 + c0);
          win[j][0] = bflo(x.x); win[j][1] = bfhi(x.x); win[j][2] = bflo(x.y); win[j][3] = bfhi(x.y); win[j][4] = bflo(x.z); win[j][5] = bfhi(x.z); win[j][6] = bflo(x.w); win[j][7] = bfhi(x.w); }
      bf16* QKB = (bf16*)(ws + WS_QKB);
#pragma unroll 1
      for (int r0 = 0; r0 < 32; r0 += 16) { v4u cin[16];
#pragma unroll
        for (int k = 0; k < 16; ++k) cin[k] = *(const v4u*)(Z + (size_t)(m0 + 32 * rh + r0 + k) * ZW + 3072 + c0);
#pragma unroll
        for (int k = 0; k < 16; ++k) { const int m = m0 + 32 * rh + r0 + k;
          const v4u x = cin[k];
          float cur[8] = {bflo(x.x), bfhi(x.x), bflo(x.y), bfhi(x.y), bflo(x.z), bfhi(x.z), bflo(x.w), bfhi(x.w)}; float o[8];
#pragma unroll
          for (int i = 0; i < 8; ++i) { const float v = bias[i] + w[0][i] * win[0][i] + w[1][i] * win[1][i] + w[2][i] * win[2][i] + w[3][i] * cur[i]; o[i] = v * __builtin_amdgcn_rcpf(1.f + __expf(-v));
              win[0][i] = win[1][i]; win[1][i] = win[2][i]; win[2][i] = cur[i]; }
          *(v4u*)(QKB + (size_t)m * 2048 + c0) = (v4u){pk2(o[0], o[1]), pk2(o[2], o[3]), pk2(o[4], o[5]), pk2(o[6], o[7])}; } }
    }
    { LAS float* wg = (LAS float*)lds;
      const float* Win = a->in[1] + (size_t)e * 2048 * EVEN_IN;
      { f32x4 gin[8];
#pragma unroll
        for (int q = 0; q < 8; ++q) { const int i = tid + q * NTHR, k = i >> 1, hf = i & 1; gin[q] = *(const f32x4*)(Win + (size_t)k * EVEN_IN + ZW + hf * 4); }
#pragma unroll
        for (int q = 0; q < 8; ++q) { const int i = tid + q * NTHR, k = i >> 1, hf = i & 1; *(LAS f32x4*)(wg + ((((k >> 8) * 4 + (k & 3)) * 2 + hf) * 64 + ((k >> 2) & 63)) * 4) = gin[q]; } }
      __syncthreads();
      const float* gb = a->in[2] + e * 8;
      v2u xnext[8];
      { const v2u* xr0 = (const v2u*)(XIN(a, 2 * e) + (size_t)(m0 + wave * 8) * D_) + lane;
#pragma unroll
        for (int j = 0; j < 8; ++j) xnext[j] = xr0[64 * j]; }
#pragma unroll 1
      for (int rr = 0; rr < 8; ++rr) { const int row = wave * 8 + rr, m = m0 + row;
          v2u xcur[8];
#pragma unroll
          for (int j = 0; j < 8; ++j) xcur[j] = xnext[j];
          if (rr < 7) { const v2u* xr = (const v2u*)(XIN(a, 2 * e) + (size_t)(m + 1) * D_) + lane;
#pragma unroll
              for (int j = 0; j < 8; ++j) xnext[j] = xr[64 * j]; }
          float acc[8] = {0, 0, 0, 0, 0, 0, 0, 0};
#pragma unroll
          for (int j = 0; j < 8; ++j) { const v2u xw = xcur[j]; const f32x4 xv = {bflo(xw.x), bfhi(xw.x), bflo(xw.y), bfhi(xw.y)};
#pragma unroll
              for (int i = 0; i < 4; ++i) { const f32x4 wa = *(const LAS f32x4*)(wg + (((4 * j + i) * 2) * 64 + lane) * 4), wb = *(const LAS f32x4*)(wg + (((4 * j + i) * 2 + 1) * 64 + lane) * 4); const float xx = xv[i];
                  acc[0] += xx * wa.x; acc[1] += xx * wa.y; acc[2] += xx * wa.z; acc[3] += xx * wa.w; acc[4] += xx * wb.x; acc[5] += xx * wb.y; acc[6] += xx * wb.z; acc[7] += xx * wb.w; } }
#pragma unroll
          for (int j = 0; j < 8; ++j) acc[j] = wave_sum(acc[j]);
          if (lane < 4) { const int h = lane; float ip = 0.f, fp = 0.f;
#pragma unroll
              for (int j = 0; j < 4; ++j) { if (j == h) { ip = acc[j]; fp = acc[4 + j]; } }
              ip += gb[h]; fp += gb[4 + h];
              const float lf = -(fmaxf(-fp, 0.f) + __logf(1.f + __expf(-fabsf(fp))));
              ((float*)(ws + WS_IG))[(size_t)(b * 4 + h) * SEQ + t0 + row] = ip;
              ((LAS float*)(lds + 73728))[h * 64 + row] = ip; ((LAS float*)(lds + 73728 + 1024))[h * 64 + row] = lf; } }
      __syncthreads();
    }
    { LAS float* gi = (LAS float*)(lds + 73728); LAS float* gf = gi + 256; LAS float* wsc = gi + 512;
      const int bh0 = b * 4;
      if (wave < 4) { const int h = wave; float x = gf[h * 64 + lane];
#pragma unroll
          for (int o = 1; o < 64; o <<= 1) { const float t = __shfl_up(x, o); if (lane >= o) x += t; }
          const float b63 = __shfl(x, 63);
          wsc[h * 64 + lane] = __expf(b63 - x + gi[h * 64 + lane]) * 0.0625f;
          ((float*)(ws + WS_BC))[(size_t)(bh0 + h) * SEQ + t0 + lane] = x;
          if (lane == 63) ((float*)(ws + WS_DEC))[(bh0 + h) * 64 + ch] = __expf(b63); }
      __syncthreads();
      constexpr int PV = 544;
      LAS unsigned char* Vt = lds; LAS unsigned char* Kt = lds + 64 * PV;
      const int g4 = lane >> 4, q4 = (lane >> 2) & 3, p4 = lane & 3, fr = lane & 15;
      const int wd = wave & 1, we = wave >> 1;
      const bf16* QKB = (const bf16*)(ws + WS_QKB);
      for (int h = 0; h < 4; ++h) {
          { const int sr = tid >> 3, seg = tid & 7; const float wv_ = wsc[h * 64 + sr];
            const v4u* vs = (const v4u*)(Z + (size_t)(m0 + sr) * ZW + 5120 + h * 256 + 32 * seg); const v4u* ks = (const v4u*)(QKB + (size_t)(m0 + sr) * 2048 + 1024 + h * 256 + 32 * seg);
#pragma unroll
            for (int j = 0; j < 4; ++j) { *(LAS v4u*)(Vt + sr * PV + (32 * seg + 8 * j) * 2) = vs[j]; const v4u kk = ks[j];
                *(LAS v4u*)(Kt + sr * PV + (32 * seg + 8 * j) * 2) = (v4u){pk2(bflo(kk.x) * wv_, bfhi(kk.x) * wv_), pk2(bflo(kk.y) * wv_, bfhi(kk.y) * wv_), pk2(bflo(kk.z) * wv_, bfhi(kk.z) * wv_), pk2(bflo(kk.w) * wv_, bfhi(kk.w) * wv_)}; } }
          __syncthreads();
          if (tid < 256) { float sum = 0.f;
#pragma unroll 8
              for (int sr = 0; sr < 64; ++sr) sum += bf2f(*(const LAS bf16*)(Kt + sr * PV + tid * 2));
              ((float*)(ws + WS_DN))[((size_t)(bh0 + h) * 64 + ch) * 256 + tid] = sum; }
          f32x4 acc[8][4];
#pragma unroll
          for (int i = 0; i < 8; ++i)
#pragma unroll
              for (int j = 0; j < 4; ++j) acc[i][j] = (f32x4){0.f, 0.f, 0.f, 0.f};
#pragma unroll
          for (int ks2 = 0; ks2 < 2; ++ks2) {
              bf16x8 yf[4];
#pragma unroll
              for (int et = 0; et < 4; ++et) { const LAS unsigned char* p = Vt + (32 * ks2 + 8 * g4 + q4) * PV + (64 * we + 16 * et + 4 * p4) * 2;
                  const v2u lo = tr_read(p), hi = tr_read(p + 4 * PV); yf[et] = __builtin_bit_cast(bf16x8, (v4u){lo.x, lo.y, hi.x, hi.y}); }
#pragma unroll
              for (int dt = 0; dt < 8; ++dt) { const LAS unsigned char* p = Kt + (32 * ks2 + 8 * g4 + q4) * PV + (128 * wd + 16 * dt + 4 * p4) * 2;
                  const v2u lo = tr_read(p), hi = tr_read(p + 4 * PV); const bf16x8 xf = __builtin_bit_cast(bf16x8, (v4u){lo.x, lo.y, hi.x, hi.y});
#pragma unroll
                  for (int et = 0; et < 4; ++et) acc[dt][et] = __builtin_amdgcn_mfma_f32_16x16x32_bf16(xf, yf[et], acc[dt][et], 0, 0, 0); } }
          { bf16* DC = (bf16*)(ws + WS_DC) + ((size_t)(bh0 + h) * 64 + ch) * 65536;
#pragma unroll
            for (int et = 0; et < 4; ++et)
#pragma unroll
                for (int dt = 0; dt < 8; ++dt) { const f32x4 v = acc[dt][et];
                    *(v2u*)(DC + (size_t)(64 * we + 16 * et + fr) * 256 + 128 * wd + 16 * dt + 4 * g4) = (v2u){pk2(v.x, v.y), pk2(v.z, v.w)}; } }
          __syncthreads();
      }
    }
}

constexpr int AT_PITCH = 272;
constexpr int AT_BUF = 2 * 64 * AT_PITCH;
constexpr int AT_KM_OFF = 2 * AT_BUF, AT_GATE_OFF = AT_KM_OFF + 16 * 128 * 4, AT_SEL_OFF = AT_GATE_OFF + 256 * 16 * 4, AT_TL_OFF = AT_SEL_OFF + 256 * 4, AT_END = AT_TL_OFF + 80 * 4;
static_assert(AT_END <= RING_BYTES, "attention LDS map");

__device__ __forceinline__ void attn_unit(const int wv, LAS unsigned char* lds, int b, int h, int qb) {
    const ArgsP a = get_args();
#ifdef NO_ATTN
    return;
#endif
    OPAQUE_TID(); const int lane = tid & 63, wave = wv, fr = lane & 15, fq = lane >> 4, q4 = (lane >> 2) & 3, p4 = lane & 3;
    unsigned char* ws = a->ws;
    const bf16* Z = (const bf16*)(ws + WS_Z);
    const int q0 = 256 * qb;
    LAS float* km = (LAS float*)(lds + AT_KM_OFF); LAS float* gate = (LAS float*)(lds + AT_GATE_OFF);
    LAS unsigned* sel = (LAS unsigned*)(lds + AT_SEL_OFF); LAS int* tl = (LAS int*)(lds + AT_TL_OFF);
    if (tid == 0) tl[72] = 0;
    for (int i = tid; i < qb * 128; i += NTHR) { const int n = i >> 7, d = i & 127; const float* kp = (const float*)(ws + WS_KPART) + ((size_t)((b * 8 + h) * 64 + 4 * n)) * 128 + d;
        km[i] = (kp[0] + kp[128] + kp[256] + kp[384]) * (1.f / 256.f); }
    __syncthreads();
    if (qb > 3) { const int ql = tid >> 1, part = tid & 1; const v4u* qp = (const v4u*)(Z + (size_t)(b * SEQ + q0 + ql) * ZW + h * 128);
        float g[8] = {0, 0, 0, 0, 0, 0, 0, 0};
        for (int c = 0; c < 16; ++c) { const v4u w = qp[c]; const float qv[8] = {bflo(w.x), bfhi(w.x), bflo(w.y), bfhi(w.y), bflo(w.z), bfhi(w.z), bflo(w.w), bfhi(w.w)};
#pragma unroll
            for (int jj = 0; jj < 8; ++jj) { const int n = part + 2 * jj; if (n < qb) { const LAS float* kk = km + n * 128 + c * 8;
#pragma unroll
                for (int i = 0; i < 8; ++i) g[jj] += qv[i] * kk[i]; } } }
#pragma unroll
        for (int jj = 0; jj < 8; ++jj) { const int n = part + 2 * jj; if (n < qb) gate[ql * 16 + n] = g[jj]; }
    }
    __syncthreads();
    if (tid < 256) { unsigned m = 0;
        if (qb <= 3) m = (1u << qb) - 1u;
        else { for (int r = 0; r < 3; ++r) { float best = -3.0e38f; int bi = 0; for (int n = 0; n < qb; ++n) { const float g = gate[tid * 16 + n]; if (!((m >> n) & 1u) && g > best) { best = g; bi = n; } } m |= 1u << bi; } }
        sel[tid] = m;
        unsigned wm = m;
#pragma unroll
        for (int o = 1; o < 64; o <<= 1) wm |= __shfl_xor(wm, o);
        if (lane == 0) atomicOr((unsigned*)&tl[72], wm); }
    __syncthreads();
    if (tid == 0) { const unsigned um = (unsigned)tl[72];
        int nt = 0;
        for (int j = 0; j < 4; ++j) tl[1 + nt++] = (4 * qb + j) | (1 << 16);
        for (int n = 0; n < qb; ++n) if ((um >> n) & 1u) for (int j = 0; j < 4; ++j) tl[1 + nt++] = 4 * n + j;
        tl[0] = nt; }
    __syncthreads();
    const int ntile = tl[0];
    const unsigned mysel0 = sel[32 * wave + fr], mysel1 = sel[32 * wave + 16 + fr];
    unsigned wsel = mysel0 | mysel1;
#pragma unroll
    for (int o = 1; o < 16; o <<= 1) wsel |= __shfl_xor(wsel, o);
    bf16x8 qf[2][4];
#pragma unroll
    for (int t = 0; t < 2; ++t) { const v4u* qp = (const v4u*)(Z + (size_t)(b * SEQ + q0 + 32 * wave + 16 * t + fr) * ZW + h * 128);
#pragma unroll
        for (int kc = 0; kc < 4; ++kc) qf[t][kc] = __builtin_bit_cast(bf16x8, qp[kc * 4 + fq]); }
    f32x4 o[2][8];
#pragma unroll
    for (int t = 0; t < 2; ++t)
#pragma unroll
        for (int i = 0; i < 8; ++i) o[t][i] = (f32x4){0.f, 0.f, 0.f, 0.f};
    float mrun[2] = {-INFINITY, -INFINITY}, lrun[2] = {0.f, 0.f};
    const float sc = 0.08838834764831845f * 1.4426950408889634f;
    v4u kr0[2], vr0[2], kr1[2], vr1[2];
    auto gload = [&](int ti, v4u (&kr)[2], v4u (&vr)[2]) { const int key0 = 64 * (tl[1 + ti] & 0xffff);
        const v4u* kp = (const v4u*)(Z + (size_t)(b * SEQ + key0 + (tid >> 3)) * ZW + 1024 + h * 128) + (tid & 7) * 2; kr[0] = kp[0]; kr[1] = kp[1]; vr[0] = kp[128]; vr[1] = kp[129]; };
    auto lstore = [&](int bufi, const v4u (&kr)[2], const v4u (&vr)[2]) { LAS v4u* kd = (LAS v4u*)(lds + bufi * AT_BUF + (tid >> 3) * AT_PITCH + (tid & 7) * 32); kd[0] = kr[0]; kd[1] = kr[1];
        LAS v4u* vd = (LAS v4u*)(lds + bufi * AT_BUF + 64 * AT_PITCH + (tid >> 3) * AT_PITCH + (tid & 7) * 32); vd[0] = vr[0]; vd[1] = vr[1]; };
    gload(0, kr0, vr0); gload(1, kr1, vr1); lstore(0, kr0, vr0); __syncthreads();
    auto tile = [&](const int ti, v4u (&ldk)[2], v4u (&ldv)[2], const v4u (&stk)[2], const v4u (&stv)[2]) {
        const int ent = __builtin_amdgcn_readfirstlane(tl[1 + ti]); const int kt64 = ent & 0xffff; const bool own = (ent >> 16) & 1; const int key0 = 64 * kt64;
        if (ti + 2 < ntile) gload(ti + 2, ldk, ldv);
        const LAS unsigned char* Kt = lds + (ti & 1) * AT_BUF; const LAS unsigned char* Vt = Kt + 64 * AT_PITCH;
        const bool wave_active = own ? (key0 <= q0 + 32 * wave + 31) : (((wsel >> (kt64 >> 2)) & 1u) != 0u);
        if (wave_active) {
            f32x4 s[2][4];
            { bf16x8 kfa[2][4], kfb[2][4];
#pragma unroll
              for (int kt = 0; kt < 2; ++kt)
#pragma unroll
                  for (int kc = 0; kc < 4; ++kc) kfa[kt][kc] = *(const LAS bf16x8*)(Kt + (16 * kt + fr) * AT_PITCH + (kc * 32 + fq * 8) * 2);
#pragma unroll
              for (int kt = 0; kt < 2; ++kt)
#pragma unroll
                  for (int kc = 0; kc < 4; ++kc) kfb[kt][kc] = *(const LAS bf16x8*)(Kt + (16 * (kt + 2) + fr) * AT_PITCH + (kc * 32 + fq * 8) * 2);
              __builtin_amdgcn_sched_barrier(0);
#pragma unroll
              for (int kt = 0; kt < 2; ++kt) { s[0][kt] = (f32x4){0.f, 0.f, 0.f, 0.f}; s[1][kt] = (f32x4){0.f, 0.f, 0.f, 0.f};
#pragma unroll
                  for (int kc = 0; kc < 4; ++kc) { s[0][kt] = __builtin_amdgcn_mfma_f32_16x16x32_bf16(kfa[kt][kc], qf[0][kc], s[0][kt], 0, 0, 0); s[1][kt] = __builtin_amdgcn_mfma_f32_16x16x32_bf16(kfa[kt][kc], qf[1][kc], s[1][kt], 0, 0, 0); } }
              __builtin_amdgcn_sched_barrier(0);
#pragma unroll
              for (int kt = 0; kt < 2; ++kt) { s[0][kt + 2] = (f32x4){0.f, 0.f, 0.f, 0.f}; s[1][kt + 2] = (f32x4){0.f, 0.f, 0.f, 0.f};
#pragma unroll
                  for (int kc = 0; kc < 4; ++kc) { s[0][kt + 2] = __builtin_amdgcn_mfma_f32_16x16x32_bf16(kfb[kt][kc], qf[0][kc], s[0][kt + 2], 0, 0, 0); s[1][kt + 2] = __builtin_amdgcn_mfma_f32_16x16x32_bf16(kfb[kt][kc], qf[1][kc], s[1][kt + 2], 0, 0, 0); } }
            }
            bf16x8 vfa[4][2];
#pragma unroll
            for (int dt = 0; dt < 4; ++dt)
#pragma unroll
                for (int j = 0; j < 2; ++j) { const LAS unsigned char* vp = Vt + (32 * j + 4 * fq + q4) * AT_PITCH + (16 * dt + 4 * p4) * 2;
                    const v2u lo = tr_read(vp), hi = tr_read(vp + 16 * AT_PITCH); vfa[dt][j] = __builtin_bit_cast(bf16x8, (v4u){lo.x, lo.y, hi.x, hi.y}); }
            __builtin_amdgcn_sched_barrier(0);
            bf16x8 pf[2][2];
            const bool diag = own && (key0 + 63 > q0 + 32 * wave);
#pragma unroll
            for (int t = 0; t < 2; ++t) { const int qabs = q0 + 32 * wave + 16 * t + fr; const unsigned ms = t ? mysel1 : mysel0;
                const bool qsel = own || ((ms >> (kt64 >> 2)) & 1u);
                if (diag) {
#pragma unroll
                    for (int kt = 0; kt < 4; ++kt)
#pragma unroll
                        for (int e = 0; e < 4; ++e) { const int kabs = key0 + 16 * kt + 4 * fq + e; if (kabs > qabs) s[t][kt][e] = -INFINITY; } }
                float mx = s[t][0][0];
#pragma unroll
                for (int kt = 0; kt < 4; ++kt)
#pragma unroll
                    for (int e = 0; e < 4; ++e) mx = fmaxf(mx, s[t][kt][e]);
                mx = qsel ? mx * sc : -INFINITY;
                mx = fmaxf(mx, __shfl_xor(mx, 16)); mx = fmaxf(mx, __shfl_xor(mx, 32));
                const bool need = mx > mrun[t] + 8.f;
                if (__builtin_amdgcn_ballot_w64(need) != 0ull) {
                    const float mnew = need ? mx : mrun[t];
                    const float alpha = need ? __builtin_amdgcn_exp2f(mrun[t] - mnew) : 1.f;
                    lrun[t] *= alpha; mrun[t] = mnew;
#pragma unroll
                    for (int i = 0; i < 8; ++i) o[t][i] *= alpha; }
                const float scl = qsel ? sc : 0.f, nbias = qsel ? -mrun[t] : -1.0e30f;
                float psum = 0.f;
#pragma unroll
                for (int kt = 0; kt < 4; ++kt)
#pragma unroll
                    for (int e = 0; e < 4; ++e) { const float p = __builtin_amdgcn_exp2f(fmaf(s[t][kt][e], scl, nbias)); s[t][kt][e] = p; psum += p; }
                lrun[t] += psum;
#pragma unroll
                for (int j = 0; j < 2; ++j) { const v4u w = {pk2(s[t][2 * j][0], s[t][2 * j][1]), pk2(s[t][2 * j][2], s[t][2 * j][3]), pk2(s[t][2 * j + 1][0], s[t][2 * j + 1][1]), pk2(s[t][2 * j + 1][2], s[t][2 * j + 1][3])};
                    pf[t][j] = __builtin_bit_cast(bf16x8, w); } }
            { bf16x8 vfb[4][2];
              __builtin_amdgcn_sched_barrier(0);
#pragma unroll
              for (int dt = 0; dt < 4; ++dt)
#pragma unroll
                  for (int j = 0; j < 2; ++j) { const LAS unsigned char* vp = Vt + (32 * j + 4 * fq + q4) * AT_PITCH + (16 * (dt + 4) + 4 * p4) * 2;
                      const v2u lo = tr_read(vp), hi = tr_read(vp + 16 * AT_PITCH); vfb[dt][j] = __builtin_bit_cast(bf16x8, (v4u){lo.x, lo.y, hi.x, hi.y}); }
              __builtin_amdgcn_sched_barrier(0);
#pragma unroll
              for (int dt = 0; dt < 4; ++dt)
#pragma unroll
                  for (int j = 0; j < 2; ++j) { o[0][dt] = __builtin_amdgcn_mfma_f32_16x16x32_bf16(vfa[dt][j], pf[0][j], o[0][dt], 0, 0, 0); o[1][dt] = __builtin_amdgcn_mfma_f32_16x16x32_bf16(vfa[dt][j], pf[1][j], o[1][dt], 0, 0, 0); }
              __builtin_amdgcn_sched_barrier(0);
#pragma unroll
              for (int dt = 0; dt < 4; ++dt)
#pragma unroll
                  for (int j = 0; j < 2; ++j) { o[0][dt + 4] = __builtin_amdgcn_mfma_f32_16x16x32_bf16(vfb[dt][j], pf[0][j], o[0][dt + 4], 0, 0, 0); o[1][dt + 4] = __builtin_amdgcn_mfma_f32_16x16x32_bf16(vfb[dt][j], pf[1][j], o[1][dt + 4], 0, 0, 0); }
            }
        }
        if (ti + 1 < ntile) lstore((ti + 1) & 1, stk, stv);
        __syncthreads();
    };
    for (int ti = 0; ti < ntile; ti += 2) { tile(ti, kr0, vr0, kr1, vr1); if (ti + 1 < ntile) tile(ti + 1, kr1, vr1, kr0, vr0); }
#pragma unroll
    for (int t = 0; t < 2; ++t) { float lt = lrun[t]; lt += __shfl_xor(lt, 16); lt += __shfl_xor(lt, 32);
        const float inv = 1.f / lt;
        bf16* Y = (bf16*)(ws + WS_YE) + (size_t)(b * SEQ + q0 + 32 * wave + 16 * t + fr) * 2048 + h * 128;
#pragma unroll
        for (int dt = 0; dt < 8; ++dt) { v2u w; w.x = pk2(o[t][dt][0] * inv, o[t][dt][1] * inv); w.y = pk2(o[t][dt][2] * inv, o[t][dt][3] * inv); *(v2u*)(Y + 16 * dt + 4 * fq) = w; } }
    __syncthreads();
}

__device__ __forceinline__ void mlstm_scan(const int wv) {
    const ArgsP a = get_args();
    OPAQUE_TID();
    unsigned char* ws = a->ws;
    const int gt = blockIdx.x * NTHR + tid, NGT = gridDim.x * NTHR;
    for (int idx = gt; idx < 16 * 256 * 32; idx += NGT) { const int bh = idx >> 13, rem = idx & 8191;
        const bf16* DC = (const bf16*)(ws + WS_DC) + (size_t)bh * 64 * 65536 + rem * 8; bf16* CP = (bf16*)(ws + WS_CP) + (size_t)bh * 64 * 65536 + rem * 8;
        const float* dec = (const float*)(ws + WS_DEC) + bh * 64;
        float C[8] = {0, 0, 0, 0, 0, 0, 0, 0};
        for (int c0 = 0; c0 < 64; c0 += 16) { v4u in[16];
#pragma unroll
            for (int j = 0; j < 16; ++j) in[j] = __builtin_nontemporal_load((const v4u*)(DC + (size_t)(c0 + j) * 65536));
#pragma unroll
            for (int j = 0; j < 16; ++j) { const float dc = dec[c0 + j];
                *(v4u*)(CP + (size_t)(c0 + j) * 65536) = (v4u){pk2(C[0], C[1]), pk2(C[2], C[3]), pk2(C[4], C[5]), pk2(C[6], C[7])};
                C[0] = fmaf(dc, C[0], bflo(in[j].x)); C[1] = fmaf(dc, C[1], bfhi(in[j].x)); C[2] = fmaf(dc, C[2], bflo(in[j].y)); C[3] = fmaf(dc, C[3], bfhi(in[j].y));
                C[4] = fmaf(dc, C[4], bflo(in[j].z)); C[5] = fmaf(dc, C[5], bfhi(in[j].z)); C[6] = fmaf(dc, C[6], bflo(in[j].w)); C[7] = fmaf(dc, C[7], bfhi(in[j].w)); } }
    }
    for (int idx = gt; idx < 16 * 256; idx += NGT) { const int bh = idx >> 8, d = idx & 255; const float* DN = (const float*)(ws + WS_DN) + (size_t)bh * 64 * 256 + d; float* NP = (float*)(ws + WS_NP) + (size_t)bh * 64 * 256 + d;
        const float* dec = (const float*)(ws + WS_DEC) + bh * 64; float n = 0.f;
        for (int c = 0; c < 64; ++c) { NP[c * 256] = n; n = fmaf(dec[c], n, DN[c * 256]); } }
}

constexpr int M3_PQ = 528, M3_PVv = 544, M3_PP = 144;
constexpr int M3_Q = 0, M3_K = 64 * M3_PQ, M3_V = 2 * 64 * M3_PQ, M3_P = M3_V + 64 * M3_PVv, M3_F = M3_P + 64 * M3_PP;
__device__ __forceinline__ void mlstm_out_unit(const int wv, LAS unsigned char* lds, int e_, int b, int h, int c) {
    const ArgsP a = get_args();
    OPAQUE_TID(); const int lane = tid & 63, wave = wv, fr = lane & 15, fq = lane >> 4, q4 = (lane >> 2) & 3, p4 = lane & 3;
    unsigned char* ws = a->ws;
    const int bh = b * 4 + h, m0 = b * SEQ + 64 * c;
    const bf16* QKB = (const bf16*)(ws + WS_QKB); const bf16* Z = (const bf16*)(ws + WS_Z);
    LAS unsigned char* Qt = lds + M3_Q; LAS unsigned char* Kt = lds + M3_K; LAS unsigned char* Vt = lds + M3_V; LAS unsigned char* Pm = lds + M3_P;
    LAS float* F = (LAS float*)(lds + M3_F); LAS float* bt = F; LAS float* itv = F + 64; LAS float* ebt = F + 128; LAS float* den = F + 192; LAS float* rstd = F + 256; LAS float* np = F + 320; LAS float* rsp = F + 576;
    { const int sr = tid >> 3, seg = tid & 7;
      const v4u* qs = (const v4u*)(QKB + (size_t)(m0 + sr) * 2048 + h * 256 + 32 * seg); const v4u* ks = (const v4u*)(QKB + (size_t)(m0 + sr) * 2048 + 1024 + h * 256 + 32 * seg);
      const v4u* vs = (const v4u*)(Z + (size_t)(m0 + sr) * ZW + 5120 + h * 256 + 32 * seg);
#pragma unroll
      for (int j = 0; j < 4; ++j) { *(LAS v4u*)(Qt + sr * M3_PQ + (32 * seg + 8 * j) * 2) = qs[j]; *(LAS v4u*)(Kt + sr * M3_PQ + (32 * seg + 8 * j) * 2) = ks[j]; *(LAS v4u*)(Vt + sr * M3_PVv + (32 * seg + 8 * j) * 2) = vs[j]; }
      if (tid < 64) { const float bb = ((const float*)(ws + WS_BC))[(size_t)bh * SEQ + 64 * c + tid]; bt[tid] = bb; ebt[tid] = __expf(bb); itv[tid] = ((const float*)(ws + WS_IG))[(size_t)bh * SEQ + 64 * c + tid]; }
      else if (tid < 320) np[tid - 64] = ((const float*)(ws + WS_NP))[((size_t)bh * 64 + c) * 256 + tid - 64]; }
    v4u cf[8][2];
    { const bf16* CP = (const bf16*)(ws + WS_CP) + ((size_t)bh * 64 + c) * 65536 + (size_t)(32 * wave + fr) * 256 + 8 * fq;
#pragma unroll
      for (int kk = 0; kk < 8; ++kk)
#pragma unroll
          for (int et = 0; et < 2; ++et) cf[kk][et] = *(const v4u*)(CP + et * 16 * 256 + 32 * kk); }
    __syncthreads();
    { const int ss = wave >> 1;
#pragma unroll
      for (int ti = 0; ti < 2; ++ti) { const int tt = 2 * (wave & 1) + ti; f32x4 sacc = {0.f, 0.f, 0.f, 0.f};
#pragma unroll
          for (int kk = 0; kk < 8; ++kk) { const bf16x8 kf = *(const LAS bf16x8*)(Kt + (16 * ss + fr) * M3_PQ + (32 * kk + 8 * fq) * 2), qf = *(const LAS bf16x8*)(Qt + (16 * tt + fr) * M3_PQ + (32 * kk + 8 * fq) * 2);
              sacc = __builtin_amdgcn_mfma_f32_16x16x32_bf16(kf, qf, sacc, 0, 0, 0); }
          const int t = 16 * tt + fr; const float btv = bt[t]; float pv[4];
#pragma unroll
          for (int r = 0; r < 4; ++r) { const int s_ = 16 * ss + 4 * fq + r; pv[r] = (s_ <= t) ? sacc[r] * __expf(btv - bt[s_] + itv[s_]) * 0.0625f : 0.f; }
          *(LAS v2u*)(Pm + t * M3_PP + (16 * ss + 4 * fq) * 2) = (v2u){pk2(pv[0], pv[1]), pk2(pv[2], pv[3])}; } }
    float qn;
    { const int t = tid >> 3, part = tid & 7; float sacc = 0.f;
#pragma unroll
      for (int j = 0; j < 4; ++j) { const v4u w = *(const LAS v4u*)(Qt + t * M3_PQ + (32 * part + 8 * j) * 2); const LAS float* nn = np + 32 * part + 8 * j;
          sacc += bflo(w.x) * nn[0] + bfhi(w.x) * nn[1] + bflo(w.y) * nn[2] + bfhi(w.y) * nn[3] + bflo(w.z) * nn[4] + bfhi(w.z) * nn[5] + bflo(w.w) * nn[6] + bfhi(w.w) * nn[7]; }
      sacc += dppf<0xB1>(sacc); sacc += dppf<0x4E>(sacc); sacc += dppf<0x141>(sacc); qn = sacc; }
    __syncthreads();
    { const int t = tid >> 3, part = tid & 7; const v4u w = *(const LAS v4u*)(Pm + t * M3_PP + part * 16);
      float ps = bflo(w.x) + bfhi(w.x) + bflo(w.y) + bfhi(w.y) + bflo(w.z) + bfhi(w.z) + bflo(w.w) + bfhi(w.w);
      ps += dppf<0xB1>(ps); ps += dppf<0x4E>(ps); ps += dppf<0x141>(ps);
      if (part == 0) den[t] = ebt[t] * qn + ps; }
    f32x4 acc[4][2];
#pragma unroll
    for (int tt = 0; tt < 4; ++tt) { acc[tt][0] = (f32x4){0.f, 0.f, 0.f, 0.f}; acc[tt][1] = (f32x4){0.f, 0.f, 0.f, 0.f}; }
#pragma unroll
    for (int kk = 0; kk < 8; ++kk)
#pragma unroll
        for (int tt = 0; tt < 4; ++tt) { const bf16x8 qf = *(const LAS bf16x8*)(Qt + (16 * tt + fr) * M3_PQ + (32 * kk + 8 * fq) * 2);
            acc[tt][0] = __builtin_amdgcn_mfma_f32_16x16x32_bf16(qf, __builtin_bit_cast(bf16x8, cf[kk][0]), acc[tt][0], 0, 0, 0);
            acc[tt][1] = __builtin_amdgcn_mfma_f32_16x16x32_bf16(qf, __builtin_bit_cast(bf16x8, cf[kk][1]), acc[tt][1], 0, 0, 0); }
#pragma unroll
    for (int tt = 0; tt < 4; ++tt) { const f32x4 eb = *(const LAS f32x4*)(ebt + 16 * tt + 4 * fq); acc[tt][0] *= eb; acc[tt][1] *= eb; }
#pragma unroll
    for (int j = 0; j < 2; ++j) { bf16x8 vf[2];
#pragma unroll
        for (int et = 0; et < 2; ++et) { const LAS unsigned char* p = Vt + (32 * j + 8 * fq + q4) * M3_PVv + (32 * wave + 16 * et + 4 * p4) * 2;
            const v2u lo = tr_read(p), hi = tr_read(p + 4 * M3_PVv); vf[et] = __builtin_bit_cast(bf16x8, (v4u){lo.x, lo.y, hi.x, hi.y}); }
#pragma unroll
        for (int tt = 0; tt < 4; ++tt) { const bf16x8 pf = *(const LAS bf16x8*)(Pm + (16 * tt + fr) * M3_PP + (32 * j + 8 * fq) * 2);
            acc[tt][0] = __builtin_amdgcn_mfma_f32_16x16x32_bf16(pf, vf[0], acc[tt][0], 0, 0, 0); acc[tt][1] = __builtin_amdgcn_mfma_f32_16x16x32_bf16(pf, vf[1], acc[tt][1], 0, 0, 0); } }
    __syncthreads();
    LAS unsigned char* Ht = Qt;
#pragma unroll
    for (int tt = 0; tt < 4; ++tt) { const f32x4 dn = *(const LAS f32x4*)(den + 16 * tt + 4 * fq); float ssq[4];
#pragma unroll
        for (int r = 0; r < 4; ++r) { const float dv = __builtin_amdgcn_rcpf(fmaxf(fabsf(dn[r]), 1.f)); const float h0 = acc[tt][0][r] * dv, h1 = acc[tt][1][r] * dv; ssq[r] = red16(h0 * h0 + h1 * h1);
            const int t = 16 * tt + 4 * fq + r;
            *(LAS bf16*)(Ht + t * M3_PQ + (32 * wave + fr) * 2) = (bf16)f2bf(h0); *(LAS bf16*)(Ht + t * M3_PQ + (32 * wave + 16 + fr) * 2) = (bf16)f2bf(h1); }
        if (fr == 0) *(LAS f32x4*)(rsp + wave * 64 + 16 * tt + 4 * fq) = (f32x4){ssq[0], ssq[1], ssq[2], ssq[3]}; }
    __syncthreads();
    if (tid < 64) { float tot = 0.f;
#pragma unroll
        for (int w = 0; w < 8; ++w) tot += rsp[w * 64 + tid];
        rstd[tid] = 1.f / sqrtf(tot * (1.f / 256.f) + 1e-6f); }
    __syncthreads();
    { const int t = tid >> 3, seg = tid & 7; const float rs = rstd[t]; const float* hg = a->in[5] + (size_t)e_ * 1024 + h * 256 + 32 * seg;
      const v4u* os = (const v4u*)(Z + (size_t)(m0 + t) * ZW + 6144 + h * 256 + 32 * seg); v4u* yd = (v4u*)((bf16*)(ws + WS_YE) + (size_t)(m0 + t) * 2048 + 1024 + h * 256 + 32 * seg);
#pragma unroll
      for (int j = 0; j < 4; ++j) { const v4u hw = *(const LAS v4u*)(Ht + t * M3_PQ + (32 * seg + 8 * j) * 2), ow = os[j]; const f32x4 g0 = *(const f32x4*)(hg + 8 * j), g1 = *(const f32x4*)(hg + 8 * j + 4);
          yd[j] = (v4u){pk2(bflo(hw.x) * rs * g0.x * sigmoidf_(bflo(ow.x)), bfhi(hw.x) * rs * g0.y * sigmoidf_(bfhi(ow.x))), pk2(bflo(hw.y) * rs * g0.z * sigmoidf_(bflo(ow.y)), bfhi(hw.y) * rs * g0.w * sigmoidf_(bfhi(ow.y))),
                        pk2(bflo(hw.z) * rs * g1.x * sigmoidf_(bflo(ow.z)), bfhi(hw.z) * rs * g1.y * sigmoidf_(bfhi(ow.z))), pk2(bflo(hw.w) * rs * g1.z * sigmoidf_(bflo(ow.w)), bfhi(hw.w) * rs * g1.w * sigmoidf_(bfhi(ow.w)))}; } }
    __syncthreads();
}

__device__ __forceinline__ void odd_prep(const int wv, int o) {
    const ArgsP a = get_args();
#ifdef NO_OPREP
    return;
#endif
    OPAQUE_TID(); const int lane = tid & 63, wave = tid >> 6;
    unsigned char* ws = a->ws;
    const float* mu = a->in[7] + (size_t)o * 6 * 2048;
    bf16* XR = (bf16*)(ws + WS_XRKV); bf16* XK = XR + (size_t)T_ * 2048; bf16* XV = XK + (size_t)T_ * 2048; bf16* XC = (bf16*)(ws + WS_XC);
    const int gw = blockIdx.x * NWAVES + wave, NGW = gridDim.x * NWAVES;
    for (int m = gw; m < T_; m += NGW) { const bool first = (m % SEQ) == 0;
        const f32x4* xr = (const f32x4*)(a->out + (size_t)m * D_) + lane; const f32x4* xp = (const f32x4*)(a->out + (size_t)(m - 1) * D_) + lane;
#pragma unroll
        for (int j = 0; j < 8; ++j) { const f32x4 x = xr[64 * j]; f32x4 p = {0.f, 0.f, 0.f, 0.f}; if (!first) p = xp[64 * j]; const f32x4 dx = p - x;
            const f32x4 m0 = ((const f32x4*)mu)[lane + 64 * j], m2 = ((const f32x4*)(mu + 2 * 2048))[lane + 64 * j], m3 = ((const f32x4*)(mu + 3 * 2048))[lane + 64 * j];
            const f32x4 r = x + dx * m0, k = x + dx * m2, v = x + dx * m3; const size_t off = (size_t)m * 2048 + 4 * (lane + 64 * j);
            *(v2u*)(XR + off) = (v2u){pk2(r.x, r.y), pk2(r.z, r.w)}; *(v2u*)(XK + off) = (v2u){pk2(k.x, k.y), pk2(k.z, k.w)}; *(v2u*)(XV + off) = (v2u){pk2(v.x, v.y), pk2(v.z, v.w)};
            const size_t offc = (size_t)m * 4096 + 4 * (lane + 64 * j);
            *(v2u*)(XC + offc) = (v2u){pk2(x.x, x.y), pk2(x.z, x.w)}; *(v2u*)(XC + offc + 2048) = (v2u){pk2(dx.x, dx.y), pk2(dx.z, dx.w)}; }
    }
}

constexpr int RK_KQ = 0, RK_RQ = 4096, RK_TAB = 8192, RK_XU = 9216, RK_W4 = 17408, RK_VB = 19456, RK_CBUF = 27648;
constexpr int RK_PB0 = 3 * RK_CBUF, RK_PG = 0, RK_PV = 4096, RK_PBON = 8192, RK_PBSZ = 8320;
constexpr int RK_Y0 = RK_PB0 + 4 * RK_PBSZ, RK_YSZ = 64 * 36 * 4;
constexpr int RK_XS = RK_Y0 + 2 * RK_YSZ;
constexpr int RK_ZERO = RK_XS + 16384;
static_assert(RK_ZERO + 8192 <= RING_BYTES, "rwkv LDS map");
__device__ __forceinline__ float dot16(const f32x4 x, const f32x4 y) { return red16(x.x * y.x + x.y * y.y + x.z * y.z + x.w * y.w); }
__device__ __forceinline__ v2u pk4(const f32x4 v) { return (v2u){pk2(v.x, v.y), pk2(v.z, v.w)}; }
__device__ __forceinline__ f32x4 unpk4(const v2u w) { return (f32x4){bflo(w.x), bfhi(w.x), bflo(w.y), bfhi(w.y)}; }

template <bool DRY = false> __device__ __forceinline__ void rwkv_unit(const int wv, LAS unsigned char* lds, int o, int b, int h) {
    const ArgsP a = get_args();
#ifdef NO_RWKV
    return;
#endif
    OPAQUE_TID(); const int lane = tid & 63, fr = lane & 15, fq = lane >> 4;
    unsigned char* ws = a->ws;
    constexpr int NCH = SEQ / 32;
    for (int i = tid; i < 8192 / 16; i += NTHR) *(LAS v4u*)(lds + RK_ZERO + 16 * i) = (v4u){0u, 0u, 0u, 0u};
    if (wv < 4) {
        f32x4 S[4];
#pragma unroll
        for (int kt = 0; kt < 4; ++kt) S[kt] = (f32x4){0.f, 0.f, 0.f, 0.f};
        const int row = 16 * wv + fr;
        const bool f0 = fq == 0;
        struct Ops { v2u kq[4], rq[4]; f32x4 tab[8], vv, w4[4]; v4u xu[4]; };
        auto load_ops = [&](const LAS unsigned char* B, const LAS unsigned char* xb, int bk, Ops& o) {
            const LAS unsigned char* kp = B + RK_KQ + bk * 512 + (fr & 3) * 128 + 8 * fq; const LAS unsigned char* rp = kp + (RK_RQ - RK_KQ);
#pragma unroll
            for (int ks = 0; ks < 2; ++ks) { o.kq[2 * ks] = *(const LAS v2u*)(kp + 64 * ks); o.kq[2 * ks + 1] = *(const LAS v2u*)(kp + 64 * ks + 32); o.rq[2 * ks] = *(const LAS v2u*)(rp + 64 * ks); o.rq[2 * ks + 1] = *(const LAS v2u*)(rp + 64 * ks + 32); }
#pragma unroll
            for (int i = 0; i < 8; ++i) o.tab[i] = *(const LAS f32x4*)(B + RK_TAB + bk * 128 + 16 * i);
            o.vv = *(const LAS f32x4*)(B + RK_VB + bk * 1024 + row * 16);
#pragma unroll
            for (int kt = 0; kt < 4; ++kt) { o.w4[kt] = *(const LAS f32x4*)(B + RK_W4 + bk * 256 + (16 * kt + 4 * fq) * 4); o.xu[kt] = *(const LAS v4u*)(xb + bk * 1024 + (16 * kt + fr) * 16); } };
        auto step = [&](const Ops& o, f32x4& yout) {
            bf16x8 ys[2];
#pragma unroll
            for (int ks = 0; ks < 2; ++ks) { const v4u w = {pk2(S[2 * ks][0], S[2 * ks][1]), pk2(S[2 * ks][2], S[2 * ks][3]), pk2(S[2 * ks + 1][0], S[2 * ks + 1][1]), pk2(S[2 * ks + 1][2], S[2 * ks + 1][3])}; ys[ks] = __builtin_bit_cast(bf16x8, w); }
            f32x4 du = {0.f, 0.f, 0.f, 0.f}, dy = {0.f, 0.f, 0.f, 0.f};
#pragma unroll
            for (int ks = 0; ks < 2; ++ks) {
                du = __builtin_amdgcn_mfma_f32_16x16x32_bf16(__builtin_bit_cast(bf16x8, (v4u){o.kq[2 * ks].x, o.kq[2 * ks].y, o.kq[2 * ks + 1].x, o.kq[2 * ks + 1].y}), ys[ks], du, 0, 0, 0);
                dy = __builtin_amdgcn_mfma_f32_16x16x32_bf16(__builtin_bit_cast(bf16x8, (v4u){o.rq[2 * ks].x, o.rq[2 * ks].y, o.rq[2 * ks + 1].x, o.rq[2 * ks + 1].y}), ys[ks], dy, 0, 0, 0); }
            const f32x4 t0 = o.tab[0], t1 = o.tab[1], t2 = o.tab[2], t3 = o.tab[3], t4 = o.tab[4], t5 = o.tab[5], t6 = o.tab[6], t7 = o.tab[7]; const f32x4 vv = o.vv;
#define FMA_(a, b, c) ([](float x_, float y_, float z_) { float r_; asm("v_fma_f32 %0, %1, %2, %3" : "=v"(r_) : "v"(x_), "v"(y_), "v"(z_)); return r_; }((a), (b), (c)))
#define FNMA_(a, b, c) ([](float x_, float y_, float z_) { float r_; asm("v_fma_f32 %0, -%1, %2, %3" : "=v"(r_) : "v"(x_), "v"(y_), "v"(z_)); return r_; }((a), (b), (c)))
            const float u0 = du[0] + 0.f * vv.x;
            float a1_ = fmaf(vv.x, t0.x, du[1]);
            float a2_ = FMA_(vv.y, t0.w, fmaf(vv.x, t0.z, du[2]));
            float a3_ = FMA_(vv.z, t2.x, FMA_(vv.y, t1.w, fmaf(vv.x, t1.z, du[3])));
            float b0_ = fmaf(vv.x, t3.x, dy[0]);
            float b1_ = FMA_(vv.y, t3.w, fmaf(vv.x, t3.z, dy[1]));
            float b2_ = FMA_(vv.z, t5.x, FMA_(vv.y, t4.w, fmaf(vv.x, t4.z, dy[2])));
            float b3_ = FMA_(vv.w, t6.w, FMA_(vv.z, t6.z, FMA_(vv.y, t6.y, fmaf(vv.x, t6.x, dy[3]))));
            const float u1 = FNMA_(u0, t0.y, a1_);
            a2_ = FNMA_(u0, t1.x, a2_); a3_ = FNMA_(u0, t2.y, a3_); b0_ = FNMA_(u0, t3.y, b0_); b1_ = FNMA_(u0, t4.x, b1_); b2_ = FNMA_(u0, t5.y, b2_); b3_ = FNMA_(u0, t7.x, b3_);
            const float u2 = FNMA_(u1, t1.y, a2_);
            a3_ = FNMA_(u1, t2.z, a3_); b1_ = FNMA_(u1, t4.y, b1_); b2_ = FNMA_(u1, t5.z, b2_); b3_ = FNMA_(u1, t7.y, b3_);
            const float u3 = FNMA_(u2, t2.w, a3_);
            b2_ = FNMA_(u2, t5.w, b2_); b3_ = FNMA_(u2, t7.z, b3_);
            b3_ = FNMA_(u3, t7.w, b3_);
            yout.x = b0_; yout.y = b1_; yout.z = b2_; yout.w = b3_;
#undef FMA_
#undef FNMA_
            const bf16x8 yop = __builtin_bit_cast(bf16x8, (v4u){pk2(vv.x, vv.y), pk2(vv.z, vv.w), pk2(u0, u1), pk2(u2, u3)});
#pragma unroll
            for (int kt = 0; kt < 4; ++kt) S[kt] = __builtin_amdgcn_mfma_f32_16x16x32_bf16(__builtin_bit_cast(bf16x8, o.xu[kt]), yop, S[kt] * o.w4[kt], 0, 0, 0); };
        __syncthreads();
        __builtin_amdgcn_s_setprio(3);
#ifdef PROBE_RWKV
        float pacc_iter = 0.f, pacc_comp = 0.f;
#endif
        for (int c = 0; c < NCH; ++c) {
            const LAS unsigned char* B = lds + (c % 3) * RK_CBUF; LAS float* yb = (LAS float*)(lds + RK_Y0 + (c & 1) * RK_YSZ) + row * 36;
            const LAS unsigned char* xb = f0 ? B + RK_XU : (const LAS unsigned char*)(lds + RK_ZERO);
            Ops oa, ob; f32x4 yk[8];
#ifdef PROBE_RWKV
            const unsigned long long pt0 = __builtin_amdgcn_s_memtime();
#endif
            load_ops(B, xb, 0, oa);
#pragma unroll
            for (int bp = 0; bp < 4; ++bp) { load_ops(B, xb, 2 * bp + 1, ob); step(oa, yk[2 * bp]); if (bp < 3) load_ops(B, xb, 2 * bp + 2, oa); step(ob, yk[2 * bp + 1]); }
            if (f0) {
#pragma unroll
                for (int bk = 0; bk < 8; ++bk) *(LAS f32x4*)(yb + 4 * bk) = yk[bk]; }
#ifdef PROBE_RWKV
            const unsigned long long pt1 = __builtin_amdgcn_s_memtime();
#endif
            __syncthreads();
#ifdef PROBE_RWKV
            { const unsigned long long pt2 = __builtin_amdgcn_s_memtime();
              if (c >= 8) { pacc_iter += (float)(pt2 - pt0); pacc_comp += (float)(pt1 - pt0); }
              if (c == NCH - 1 && o == 1 && blockIdx.x == 0 && wv == 0 && lane == 0) { float* pw = (float*)(ws + WS_CTL) + 200000;
                  pw[0] = __expf(rintf(__logf(pacc_iter * (1.f / 120.f)) * 20.f) * 0.05f); pw[1] = __expf(rintf(__logf(pacc_comp * (1.f / 120.f)) * 20.f) * 0.05f); } }
#endif
        }
        __builtin_amdgcn_s_setprio(0);
    } else {
        const int pr = (wv - 4) >> 1, w2 = (wv - 4) & 1, ptid = w2 * 64 + lane, g8 = ptid >> 4, kq = ptid & 15;
        const size_t ub = ((size_t)b * SEQ * 2048 + h * 64) * 2;
        const char* Rs = (const char*)(ws + WS_RKV) + ub; const char* Ks = Rs + (size_t)T_ * 2048 * 2; const char* Vs = Ks + (size_t)T_ * 2048 * 2;
        const char* Gs = (const char*)(ws + WS_G) + ub; const char* WDs = (const char*)(ws + WS_WD) + ub; const char* AAs = (const char*)(ws + WS_AA) + ub;
        const unsigned lvo = (unsigned)(4 * kq + 4 * g8 * 2048) * 2u;
        const int pc = h * 64 + 4 * kq;
        const f32x4 p_kk = *(const f32x4*)(a->in[20] + (size_t)o * 2048 + pc), p_ka = *(const f32x4*)(a->in[21] + (size_t)o * 2048 + pc), p_rk = *(const f32x4*)(a->in[22] + (size_t)o * 2048 + pc);
        v2u gk[4], ga[4], gw[4], gr[4], gv[4], gg[4];
        auto gload = [&](int c) {
            const size_t co = (size_t)c * (32 * 2048 * 2);
            typedef const __attribute__((address_space(1))) char* gptr; typedef const __attribute__((address_space(1))) v2u* gv2;
            gptr k_ = (gptr)(Ks + co); gptr a_ = (gptr)(AAs + co); gptr w_ = (gptr)(WDs + co); gptr r_ = (gptr)(Rs + co); gptr v_ = (gptr)(Vs + co); gptr g_ = (gptr)(Gs + co);
            asm volatile("" : "+s"(k_), "+s"(a_), "+s"(w_), "+s"(r_), "+s"(v_), "+s"(g_));
#pragma unroll
            for (int j = 0; j < 4; ++j) { const unsigned off = lvo + (unsigned)j * 4096u;
                gk[j] = *(gv2)(k_ + off); ga[j] = *(gv2)(a_ + off); gw[j] = *(gv2)(w_ + off); gr[j] = *(gv2)(r_ + off); gv[j] = *(gv2)(v_ + off); gg[j] = *(gv2)(g_ + off); } };
        f32x4 kh3, bb3, hh0, hh1, hh2, hh3, bh0, bh1, bh2, bh3, W4;
        auto partA = [&](int c) {
            LAS unsigned char* B = lds + (c % 3) * RK_CBUF; LAS unsigned char* P = lds + RK_PB0 + (c & 3) * RK_PBSZ;
            f32x4 kk[4], bbv[4], kh[4], w[4], r[4], v[4];
#pragma unroll
            for (int j = 0; j < 4; ++j) { const f32x4 k = unpk4(gk[j]), aa = unpk4(ga[j]), wd = unpk4(gw[j]); r[j] = unpk4(gr[j]); v[j] = unpk4(gv[j]);
                const f32x4 kx = k * p_kk; const float inv = __builtin_amdgcn_rsqf(fmaxf(dot16(kx, kx), 1e-24f)); kk[j] = kx * inv; bbv[j] = kk[j] * aa; kh[j] = k * (1.f + (aa - 1.f) * p_ka);
                w[j] = (f32x4){__expf(wd.x), __expf(wd.y), __expf(wd.z), __expf(wd.w)};
                const float bon = dot16(r[j] * kh[j], p_rk);
                *(LAS v2u*)(P + RK_PG + ((4 * g8 + j) * 64 + 4 * kq) * 2) = gg[j];
                if (kq == 0) *(LAS float*)(P + RK_PBON + (4 * g8 + j) * 4) = bon; }
            const f32x4 W1 = w[0], W2 = w[0] * w[1], W3 = W2 * w[2]; W4 = W3 * w[3];
            const f32x4 i1 = {__builtin_amdgcn_rcpf(W1.x), __builtin_amdgcn_rcpf(W1.y), __builtin_amdgcn_rcpf(W1.z), __builtin_amdgcn_rcpf(W1.w)}, i2 = {__builtin_amdgcn_rcpf(W2.x), __builtin_amdgcn_rcpf(W2.y), __builtin_amdgcn_rcpf(W2.z), __builtin_amdgcn_rcpf(W2.w)},
                        i3 = {__builtin_amdgcn_rcpf(W3.x), __builtin_amdgcn_rcpf(W3.y), __builtin_amdgcn_rcpf(W3.z), __builtin_amdgcn_rcpf(W3.w)}, i4 = {__builtin_amdgcn_rcpf(W4.x), __builtin_amdgcn_rcpf(W4.y), __builtin_amdgcn_rcpf(W4.z), __builtin_amdgcn_rcpf(W4.w)};
            hh0 = kh[0] * i1; hh1 = kh[1] * i2; hh2 = kh[2] * i3; hh3 = kh[3] * i4; bh0 = bbv[0] * i1; bh1 = bbv[1] * i2; bh2 = bbv[2] * i3; bh3 = bbv[3] * i4; kh3 = kh[3]; bb3 = bbv[3];
            *(LAS v2u*)(B + RK_KQ + g8 * 512 + 0 * 128 + 8 * kq) = pk4(kk[0]);      *(LAS v2u*)(B + RK_RQ + g8 * 512 + 0 * 128 + 8 * kq) = pk4(r[0] * W1);
            *(LAS v2u*)(B + RK_KQ + g8 * 512 + 1 * 128 + 8 * kq) = pk4(kk[1] * W1); *(LAS v2u*)(B + RK_RQ + g8 * 512 + 1 * 128 + 8 * kq) = pk4(r[1] * W2);
            *(LAS v2u*)(B + RK_KQ + g8 * 512 + 2 * 128 + 8 * kq) = pk4(kk[2] * W2); *(LAS v2u*)(B + RK_RQ + g8 * 512 + 2 * 128 + 8 * kq) = pk4(r[2] * W3);
            *(LAS v2u*)(B + RK_KQ + g8 * 512 + 3 * 128 + 8 * kq) = pk4(kk[3] * W3); *(LAS v2u*)(B + RK_RQ + g8 * 512 + 3 * 128 + 8 * kq) = pk4(r[3] * W4);
            *(LAS f32x4*)(B + RK_W4 + g8 * 256 + 16 * kq) = W4;
#pragma unroll
            for (int j = 0; j < 4; ++j) *(LAS v2u*)(P + RK_PV + ((4 * g8 + j) * 64 + 4 * kq) * 2) = gv[j];
#pragma unroll
            for (int i = 0; i < 4; ++i) *(LAS f32x4*)(B + RK_VB + g8 * 1024 + (4 * kq + i) * 16) = (f32x4){v[0][i], v[1][i], v[2][i], v[3][i]};
        };
        auto partB = [&](int c) {
            LAS unsigned char* B = lds + (c % 3) * RK_CBUF;
            { LAS unsigned char* xs = lds + RK_XS + (wv - 4) * 4096 + (lane >> 4) * 1024 + 8 * kq;
              *(LAS v2u*)(xs + 0 * 128) = pk4(hh0); *(LAS v2u*)(xs + 1 * 128) = pk4(hh1); *(LAS v2u*)(xs + 2 * 128) = pk4(hh2); *(LAS v2u*)(xs + 3 * 128) = pk4(hh3);
              *(LAS v2u*)(xs + 4 * 128) = pk4(bh0); *(LAS v2u*)(xs + 5 * 128) = pk4(bh1); *(LAS v2u*)(xs + 6 * 128) = pk4(bh2); *(LAS v2u*)(xs + 7 * 128) = pk4(bh3); }
            { const f32x4 hw0 = hh0 * W4, hw1 = hh1 * W4, hw2 = hh2 * W4, hw3 = kh3, bw0 = bh0 * W4, bw1 = bh1 * W4, bw2 = bh2 * W4, bw3 = bb3;
#pragma unroll
              for (int i = 0; i < 4; ++i) *(LAS v4u*)(B + RK_XU + g8 * 1024 + (4 * kq + i) * 16) = (v4u){pk2(hw0[i], hw1[i]), pk2(hw2[i], hw3[i]), pk2(-bw0[i], -bw1[i]), pk2(-bw2[i], -bw3[i])};
            }
            asm volatile("s_waitcnt lgkmcnt(0)" ::: "memory");
#pragma unroll
            for (int p = 0; p < 2; ++p) { const int grp = 2 * p + (fr >> 3), rw = fr & 7, blk = 4 * w2 + grp;
                const LAS unsigned char* xp = lds + RK_XS + (wv - 4) * 4096 + grp * 1024 + rw * 128 + 16 * fq;
                const LAS unsigned char* yp = B + ((rw < 4) ? RK_KQ + blk * 512 + rw * 128 : RK_RQ + blk * 512 + (rw - 4) * 128) + 16 * fq;
                f32x4 d = {0.f, 0.f, 0.f, 0.f};
                d = __builtin_amdgcn_mfma_f32_16x16x32_bf16(*(const LAS bf16x8*)xp, *(const LAS bf16x8*)yp, d, 0, 0, 0);
                d = __builtin_amdgcn_mfma_f32_16x16x32_bf16(*(const LAS bf16x8*)(xp + 64), *(const LAS bf16x8*)(yp + 64), d, 0, 0, 0);
                if ((fr >> 3) == (fq >> 1) && rw >= 1) { const int cnt = (rw < 4) ? rw : rw - 3; const int base = (rw == 1) ? 0 : (rw == 2) ? 2 : (rw == 3) ? 6 : (rw == 4) ? 12 : (rw == 5) ? 14 : (rw == 6) ? 18 : 24;
                    LAS float* tp = (LAS float*)(B + RK_TAB + blk * 128) + base + (fq & 1) * cnt;
                    tp[0] = d[0]; if (cnt > 1) tp[1] = d[1]; if (cnt > 2) tp[2] = d[2]; if (cnt > 3) tp[3] = d[3]; } }
            asm volatile("" ::: "memory");
        };
        const int st = ptid >> 2, rq = ptid & 3;
        bf16* Yb = (bf16*)(ws + WS_YO) + (size_t)b * SEQ * 2048 + h * 64 + 16 * rq;
        const float* lg = a->in[23] + (size_t)o * 2048 + h * 64 + 16 * rq; const float* lb = a->in[24] + (size_t)o * 2048 + h * 64 + 16 * rq;
        auto post = [&](int c) {
            const LAS float* yb = (const LAS float*)(lds + RK_Y0 + (c & 1) * RK_YSZ); const LAS unsigned char* P = lds + RK_PB0 + (c & 3) * RK_PBSZ;
            float y[16]; float s1 = 0.f;
#pragma unroll
            for (int i = 0; i < 16; ++i) { y[i] = yb[(16 * rq + i) * 36 + st]; s1 += y[i]; }
            s1 += dppf<0xB1>(s1); s1 += dppf<0x4E>(s1); const float mean = s1 * (1.f / 64.f); float s2 = 0.f;
#pragma unroll
            for (int i = 0; i < 16; ++i) { y[i] -= mean; s2 += y[i] * y[i]; }
            s2 += dppf<0xB1>(s2); s2 += dppf<0x4E>(s2); const float rstd = __builtin_amdgcn_rsqf(s2 * (1.f / 64.f) + 64e-5f);
            const float bon = *(const LAS float*)(P + RK_PBON + st * 4);
            unsigned ow[8];
#pragma unroll
            for (int i4 = 0; i4 < 4; ++i4) { const f32x4 g = unpk4(*(const LAS v2u*)(P + RK_PG + (st * 64 + 16 * rq + 4 * i4) * 2)), vq = unpk4(*(const LAS v2u*)(P + RK_PV + (st * 64 + 16 * rq + 4 * i4) * 2));
                const f32x4 lgv = *(const f32x4*)(lg + 4 * i4), lbv = *(const f32x4*)(lb + 4 * i4); float o4[4];
#pragma unroll
                for (int i = 0; i < 4; ++i) o4[i] = (y[4 * i4 + i] * rstd * lgv[i] + lbv[i] + bon * vq[i]) * g[i];
                ow[2 * i4] = pk2(o4[0], o4[1]); ow[2 * i4 + 1] = pk2(o4[2], o4[3]); }
            v4u* dst = (v4u*)(Yb + (size_t)(32 * c + st) * 2048); dst[0] = (v4u){ow[0], ow[1], ow[2], ow[3]}; dst[1] = (v4u){ow[4], ow[5], ow[6], ow[7]};
        };
        if (!DRY) { gload(pr); partA(pr); gload(pr + 2); partB(pr); }
        __syncthreads();
        for (int c = 0; c < NCH; ++c) {
            if (!DRY) {
            if ((c & 1) == pr) { if (c + 2 < NCH) { partA(c + 2); if (c + 4 < NCH) gload(c + 4); } }
            else { if (c >= 1 && c + 1 < NCH) partB(c + 1); if (c >= 1) post(c - 1); } }
            __syncthreads();
        }
        if (!DRY && pr == 0) post(NCH - 1);
    }
    __syncthreads();
}

template <bool DRY = false> __device__ __forceinline__ void ln_router(const int wv, int l) {
    const ArgsP a = get_args();
#ifdef NO_ROUTER
    return;
#endif
    OPAQUE_TID(); const int lane = tid & 63, wave = tid >> 6;
    unsigned char* ws = a->ws;
    const float* lg = a->in[28] + (size_t)l * 2048; const float* lb = a->in[29] + (size_t)l * 2048;
    const float* bg = a->in[33] + l * 4; const float* be = a->in[35] + l * 32;
    const f32x4* RW = (const f32x4*)(ws + WS_RW) + (size_t)l * 9 * 2048;
    unsigned* cnt = (unsigned*)(ws + WS_CTL) + CW_CNT + (size_t)l * 32 * 64;
    int* TOKE = (int*)(ws + WS_TOKE); int* TOKR = (int*)(ws + WS_TOKR); float* TOKG = (float*)(ws + WS_TOKG);
    const int gw = blockIdx.x * NWAVES + wave, NGW = gridDim.x * NWAVES;
    const unsigned lo = (unsigned)lane * 16u;
    typedef const __attribute__((address_space(1))) char* gcp; typedef const __attribute__((address_space(1))) f32x4* gf4;
    v2u xnx[8];
    { const v2u* xr0 = (const v2u*)((const bf16*)(ws + WS_XSUM) + (size_t)gw * D_) + lane;
#pragma unroll
      for (int j = 0; j < 8; ++j) xnx[j] = (gw < T_) ? xr0[64 * j] : (v2u){0u, 0u}; }
#pragma unroll 1
    for (int m = gw; m < T_; m += NGW) {
        f32x4 v[8]; float s = 0.f;
#pragma unroll
        for (int j = 0; j < 8; ++j) { const v2u w_ = xnx[j]; v[j] = (f32x4){bflo(w_.x), bfhi(w_.x), bflo(w_.y), bfhi(w_.y)}; s += (v[j].x + v[j].y) + (v[j].z + v[j].w); }
        if (m + NGW < T_) { const v2u* xr = (const v2u*)((const bf16*)(ws + WS_XSUM) + (size_t)(m + NGW) * D_) + lane;
#pragma unroll
            for (int j = 0; j < 8; ++j) xnx[j] = xr[64 * j]; }
        const float mean = wave_sum(s) * (1.f / D_); float s2 = 0.f;
#pragma unroll
        for (int j = 0; j < 8; ++j) { v[j] = v[j] - mean; s2 += (v[j].x * v[j].x + v[j].y * v[j].y) + (v[j].z * v[j].z + v[j].w * v[j].w); }
        const float rstd = 1.f / sqrtf(wave_sum(s2) * (1.f / D_) + LN_EPS);
        float ag[4] = {0, 0, 0, 0};
#pragma unroll
        for (int j = 0; j < 8; ++j) { const f32x4 g = ((const f32x4*)lg)[lane + 64 * j], bb = ((const f32x4*)lb)[lane + 64 * j]; v[j] = v[j] * rstd * g + bb;
            ((v2u*)XIN(a, l))[(size_t)m * 512 + lane + 64 * j] = (v2u){pk2(v[j].x, v[j].y), pk2(v[j].z, v[j].w)};
            gcp wp = (gcp)((const char*)RW + j * 4096); asm volatile("" : "+s"(wp));
#pragma unroll
            for (int i = 0; i < 4; ++i) { const f32x4 w = *(gf4)(wp + i * 1024 + lo); const float x = v[j][i]; ag[0] += x * w.x; ag[1] += x * w.y; ag[2] += x * w.z; ag[3] += x * w.w; } }
#pragma unroll
        for (int i = 0; i < 4; ++i) ag[i] = wave_sum(ag[i]) + bg[i];
        int gi = 0; float gm = ag[0];
#pragma unroll
        for (int i = 1; i < 4; ++i) if (ag[i] > gm) { gm = ag[i]; gi = i; }
        float gs = 0.f;
#pragma unroll
        for (int i = 0; i < 4; ++i) gs += __expf(ag[i] - gm);
        const float gp = 1.f / gs;
        float ae[8] = {0, 0, 0, 0, 0, 0, 0, 0};
        const int gis = __builtin_amdgcn_readfirstlane(gi);
#pragma unroll
        for (int j = 0; j < 8; ++j) {
            gcp we0 = (gcp)((const char*)RW + (size_t)(1 + 2 * gis) * 32768 + j * 4096); asm volatile("" : "+s"(we0)); gcp we1 = we0 + 32768; asm volatile("" : "+s"(we1));
#pragma unroll
            for (int i = 0; i < 4; ++i) { const f32x4 w0 = *(gf4)(we0 + i * 1024 + lo), w1 = *(gf4)(we1 + i * 1024 + lo); const float x = v[j][i];
                ae[0] += x * w0.x; ae[1] += x * w0.y; ae[2] += x * w0.z; ae[3] += x * w0.w; ae[4] += x * w1.x; ae[5] += x * w1.y; ae[6] += x * w1.z; ae[7] += x * w1.w; } }
#pragma unroll
        for (int i = 0; i < 8; ++i) ae[i] = wave_sum(ae[i]) + be[8 * gi + i];
        int e1 = 0; float m1 = ae[0];
#pragma unroll
        for (int i = 1; i < 8; ++i) if (ae[i] > m1) { m1 = ae[i]; e1 = i; }
        int e2 = -1; float m2 = -3.0e38f;
#pragma unroll
        for (int i = 0; i < 8; ++i) if (i != e1 && ae[i] > m2) { m2 = ae[i]; e2 = i; }
        const float p2 = __expf(m2 - m1), den = 1.f / (1.f + p2);
        if (!DRY && lane == 0) { const int x1 = 8 * gi + e1, x2 = 8 * gi + e2;
            const unsigned r1 = __hip_atomic_fetch_add(cnt + x1 * 64, 1u, __ATOMIC_RELAXED, __HIP_MEMORY_SCOPE_AGENT);
            const unsigned r2 = __hip_atomic_fetch_add(cnt + x2 * 64, 1u, __ATOMIC_RELAXED, __HIP_MEMORY_SCOPE_AGENT);
            { int* LIST = (int*)(ws + WS_LIST); LIST[x1 * 16384 + (int)r1] = m; LIST[x2 * 16384 + (int)r2] = m; }
            TOKE[2 * m] = x1; TOKE[2 * m + 1] = x2; TOKR[2 * m] = (int)r1; TOKR[2 * m + 1] = (int)r2; TOKG[2 * m] = gp * den; TOKG[2 * m + 1] = gp * p2 * den; }
    }
}

struct MoeTab { LAS int* start; LAS int* tileE; LAS int* ntiles; LAS int* cntv; };
__device__ __forceinline__ MoeTab moe_tables(const int wv, int l, LAS unsigned char* lds) {
    const ArgsP a = get_args();
    MoeTab t; t.start = (LAS int*)(lds + MISC_OFF + 256); t.tileE = t.start + 40; t.ntiles = t.tileE + 168; t.cntv = t.ntiles + 8;
    OPAQUE_TID();
    if (wv == 0) { unsigned* cnt = (unsigned*)(a->ws + WS_CTL) + CW_CNT + (size_t)l * 32 * 64; const int e = tid & 31;
        const int c = (int)__hip_atomic_load(cnt + e * 64, __ATOMIC_RELAXED, __HIP_MEMORY_SCOPE_AGENT); const int pad = (c + 255) & ~255;
        int inc = pad;
#pragma unroll
        for (int d = 1; d < 32; d <<= 1) { const int v = __shfl_up(inc, d, 32); if (e >= d) inc += v; }
        if ((tid & 63) < 32) { const int st = inc - pad; t.start[e] = st; t.cntv[e] = c;
            int q1 = inc >> 8; if (q1 > MOE_TILES) q1 = MOE_TILES;
            for (int q = st >> 8; q < q1; ++q) t.tileE[q] = e;
            if (e == 31) *t.ntiles = q1; } }
    __syncthreads();
    return t;
}
__device__ __forceinline__ void moe_gather(const int wv, const MoeTab& tb) {
    const ArgsP a = get_args();
#ifdef NO_GATHER
    return;
#endif
    OPAQUE_TID(); const int lane = tid & 63, wave = tid >> 6;
    unsigned char* ws = a->ws;
    const int* TOKE = (const int*)(ws + WS_TOKE); const int* TOKR = (const int*)(ws + WS_TOKR); int* SLOT = (int*)(ws + WS_SLOT);
    const int gw = blockIdx.x * NWAVES + wave, NGW = gridDim.x * NWAVES;
    for (int it = gw; it < 2 * T_; it += NGW) { const int m = it >> 1; const int dest = tb.start[TOKE[it]] + TOKR[it];
        if (lane == 0) SLOT[it] = dest;
        const v4u* src = (const v4u*)(ws + WS_XB) + (size_t)m * 256 + lane; v4u* dst = (v4u*)(ws + WS_XS) + (size_t)dest * 256 + lane;
#pragma unroll
        for (int j = 0; j < 4; ++j) dst[64 * j] = src[64 * j]; }
}
template <int NJ> struct MoeOrder {
    LAS int* tileE; int nunits, G, c;
    __device__ bool next(int i, pg8::Unit& u) const {
        const int nt = nunits / NJ, x = c & 7, r = c >> 3, nx = G >> 3;
        const int t0 = (x * nt) >> 3, t1 = ((x + 1) * nt) >> 3, q = i * nx + r;
        if (q >= (t1 - t0) * NJ) return false;
        u.pm = t0 + q / NJ; u.pn = tileE[u.pm] * NJ + (q % NJ); u.aoff = 0; return true; }
    __device__ __forceinline__ void a_ready(const pg8::Unit&) const {}
    __device__ __forceinline__ void done(const pg8::Unit&) const {}
};
template <int NJ> struct MoeOrderG {
    LAS int* tileE; LAS int* start; LAS int* cntv; const int* list; int nunits, G, c; int ilo, ihi;
    __device__ bool next(int i_, pg8::Unit& u) const {
        const int i = i_ + ilo; if (i >= ihi) return false;
        const int nt = nunits / NJ, x = c & 7, r = c >> 3, nx = G >> 3;
        const int t0 = (x * nt) >> 3, t1 = ((x + 1) * nt) >> 3, q = i * nx + r;
        if (q >= (t1 - t0) * NJ) return false;
        u.pm = t0 + q / NJ; u.pn = tileE[u.pm] * NJ + (q % NJ); u.aoff = 0; return true; }
    __device__ __forceinline__ void gather_voff(const pg8::Unit& u, int R0, int C0, int R1, int C1, int lda, unsigned (&v)[2][2]) const {
        const int e = tileE[u.pm], roff = u.pm * 256 - start[e], cnt = cntv[e]; const int* le = list + e * 16384;
#pragma unroll
        for (int hh = 0; hh < 2; ++hh) { const int r0 = roff + 128 * hh + R0, r1 = roff + 128 * hh + R1;
            const int t0 = (r0 < cnt) ? le[r0] : 0, t1 = (r1 < cnt) ? le[r1] : 0;
            v[hh][0] = (unsigned)(t0 * lda + C0) * 2u; v[hh][1] = (unsigned)(t1 * lda + C1) * 2u; } }
    __device__ __forceinline__ void a_ready(const pg8::Unit&) const {}
    __device__ __forceinline__ void done(const pg8::Unit&) const {}
};
struct MoeOrderDn {
    LAS int* tileE; int ntiles, G, c, mode, KB;
    __device__ __forceinline__ void split(int& t0, int& ntx, int& busy, int& nB) const {
        const int x = c & 7, nx = G >> 3; t0 = (x * ntiles) >> 3; ntx = (((x + 1) * ntiles) >> 3) - t0;
        busy = ntx * 4 - 2 * nx; busy = busy < 0 ? 0 : (busy > nx ? nx : busy);
        const int cA = ntx < (nx >> 1) ? ntx : (nx >> 1);
        nB = KB * (nx - busy); if (nB > cA * 8) nB = cA * 8; }
    __device__ bool third_round() const { int t0, ntx, busy, nB; split(t0, ntx, busy, nB); return (c >> 3) < busy; }
    __device__ bool next(int i, pg8::Unit& u) const {
        int t0, ntx, busy, nB; split(t0, ntx, busy, nB); const int r = c >> 3, nx = G >> 3; int idx;
        if (mode == 0) { if (r < busy || i >= KB) return false; idx = i * (nx - busy) + (r - busy); if (idx >= nB) return false; }
        else { idx = nB + i * nx + r; if (idx >= ntx * 8) return false; }
        u.pm = t0 + (idx >> 3); u.pn = tileE[u.pm] * 8 + (idx & 7); u.aoff = 0; return true; }
    __device__ __forceinline__ void a_ready(const pg8::Unit&) const {}
    __device__ __forceinline__ void done(const pg8::Unit&) const {}
};
template <bool FUSE_ODD> __device__ __forceinline__ void moe_combine_ln(const int wv, int l) {
    const ArgsP a = get_args();
#ifdef NO_COMBINE
    return;
#endif
    OPAQUE_TID(); const int lane = tid & 63, wave = tid >> 6;
    unsigned char* ws = a->ws;
    const float* lg = a->in[30] + (size_t)l * 2048; const float* lb = a->in[31] + (size_t)l * 2048;
    const int* TOKE = (const int*)(ws + WS_TOKE); const int* TOKR = (const int*)(ws + WS_TOKR); const float* TOKG = (const float*)(ws + WS_TOKG); const bf16* YS = (const bf16*)(ws + WS_YS);
    const int gw = blockIdx.x * NWAVES + wave, NGW = gridDim.x * NWAVES;
    int mystart = 0;
    { unsigned* cnt = (unsigned*)(ws + WS_CTL) + CW_CNT + (size_t)l * 32 * 64; const int e = lane & 31;
      const int c = (int)__hip_atomic_load(cnt + e * 64, __ATOMIC_RELAXED, __HIP_MEMORY_SCOPE_AGENT); const int pad = (c + 255) & ~255;
      int inc = pad;
#pragma unroll
      for (int d = 1; d < 32; d <<= 1) { const int v = __shfl_up(inc, d, 32); if (e >= d) inc += v; }
      mystart = inc - pad; }
    const float* mu = FUSE_ODD ? a->in[7] + (size_t)((l + 1) >> 1) * 6 * 2048 : nullptr;
    bf16* XR = (bf16*)(ws + WS_XRKV); bf16* XK = XR + (size_t)T_ * 2048; bf16* XV = XK + (size_t)T_ * 2048; bf16* XC = (bf16*)(ws + WS_XC);
    const int nrows = FUSE_ODD ? 9 : 1;
    for (int base = FUSE_ODD ? gw * 8 : gw; base < T_; base += FUSE_ODD ? NGW * 8 : NGW) {
        f32x4 prev[8];
#pragma unroll 1
        for (int rr = 0; rr < nrows; ++rr) {
            const int m = FUSE_ODD ? base - 1 + rr : base;
            const bool halo = FUSE_ODD && rr == 0;
            if (halo && (base % SEQ) == 0) {
#pragma unroll
                for (int j = 0; j < 8; ++j) prev[j] = (f32x4){0.f, 0.f, 0.f, 0.f};
                continue; }
            const v2u* xr = (const v2u*)(XIN(a, l) + (size_t)m * D_) + lane; f32x4 v[8]; float s = 0.f;
            const int e0 = TOKE[2 * m], e1 = TOKE[2 * m + 1];
            const int s0 = __shfl(mystart, e0) + TOKR[2 * m], s1 = __shfl(mystart, e1) + TOKR[2 * m + 1]; const float g0 = TOKG[2 * m], g1 = TOKG[2 * m + 1];
            const v2u* y0 = (const v2u*)(YS + (size_t)s0 * 2048) + lane; const v2u* y1 = (const v2u*)(YS + (size_t)s1 * 2048) + lane;
#pragma unroll
            for (int j = 0; j < 8; ++j) { const v2u xw_ = xr[64 * j]; const f32x4 x = {bflo(xw_.x), bfhi(xw_.x), bflo(xw_.y), bfhi(xw_.y)}; const v2u a0 = y0[64 * j], a1 = y1[64 * j];
                v[j].x = DN_ALPHA * x.x + g0 * bflo(a0.x) + g1 * bflo(a1.x); v[j].y = DN_ALPHA * x.y + g0 * bfhi(a0.x) + g1 * bfhi(a1.x);
                v[j].z = DN_ALPHA * x.z + g0 * bflo(a0.y) + g1 * bflo(a1.y); v[j].w = DN_ALPHA * x.w + g0 * bfhi(a0.y) + g1 * bfhi(a1.y);
                s += (v[j].x + v[j].y) + (v[j].z + v[j].w); }
            const float mean = wave_sum(s) * (1.f / D_); float s2 = 0.f;
#pragma unroll
            for (int j = 0; j < 8; ++j) { v[j] = v[j] - mean; s2 += (v[j].x * v[j].x + v[j].y * v[j].y) + (v[j].z * v[j].z + v[j].w * v[j].w); }
            const float rstd = 1.f / sqrtf(wave_sum(s2) * (1.f / D_) + LN_EPS);
#pragma unroll
            for (int j = 0; j < 8; ++j) { const f32x4 g = ((const f32x4*)lg)[lane + 64 * j], bb = ((const f32x4*)lb)[lane + 64 * j]; v[j] = v[j] * rstd * g + bb;
                if (!halo) { if (l == 3) ((f32x4*)(a->out + (size_t)m * D_))[lane + 64 * j] = v[j]; else ((v2u*)XOUT(a, l))[(size_t)m * 512 + lane + 64 * j] = (v2u){pk2(v[j].x, v[j].y), pk2(v[j].z, v[j].w)}; }
                if (FUSE_ODD) {
                    if (!halo) { const f32x4 x = v[j], dx = prev[j] - x;
                        const f32x4 m0 = ((const f32x4*)mu)[lane + 64 * j], m2 = ((const f32x4*)(mu + 2 * 2048))[lane + 64 * j], m3 = ((const f32x4*)(mu + 3 * 2048))[lane + 64 * j];
                        const f32x4 r = x + dx * m0, k = x + dx * m2, vv = x + dx * m3; const size_t off = (size_t)m * 2048 + 4 * (lane + 64 * j);
                        *(v2u*)(XR + off) = (v2u){pk2(r.x, r.y), pk2(r.z, r.w)}; *(v2u*)(XK + off) = (v2u){pk2(k.x, k.y), pk2(k.z, k.w)}; *(v2u*)(XV + off) = (v2u){pk2(vv.x, vv.y), pk2(vv.z, vv.w)};
                        *(v2u*)(XC + off) = (v2u){pk2(dx.x, dx.y), pk2(dx.z, dx.w)}; }
                    prev[j] = v[j]; } }
        }
    }
}

struct RkvOrder {
    pg8::StaticOrder in; int lo, n, G, c;
    __device__ bool next(int i, pg8::Unit& u) const { const long L = (long)lo + (long)i * G + c; if (L >= lo + n) return false; const int g = (int)(L / 512);
        in.at(L % 512, u); u.pm += 64 * g; u.pn += 8 * g; return true; }
    __device__ __forceinline__ void a_ready(const pg8::Unit&) const {}
    __device__ __forceinline__ void done(const pg8::Unit&) const {}
};
struct MergedOrder {
    pg8::StaticOrder in; const char *A0, *B0, *A1a, *A1b, *B1a, *B1b; int G, c;
    __device__ bool next(int i, pg8::Unit& u) const {
        int idx;
        if (G == 256) { if (c < 128) { if (i == 0) idx = -1 - c; else idx = (i - 1) * 128 + c; if (i > 5) return false; } else { idx = 640 + i * 128 + (c - 128); if (i > 6) return false; } }
        else { const int L = i * G + c; if (L >= 1664) return false; idx = (L < 128) ? -1 - L : L - 128; }
        if (idx < 0) { const int q = -1 - idx; u.pm = q & 63; u.pn = q >> 6; u.aoff = 1; return true; }
        const int g = idx / 512; in.at(idx % 512, u); u.pm += 64 * g; u.pn += 8 * g; u.aoff = 0; return true; }
    __device__ __forceinline__ void ptrs(const pg8::Unit& u, const char*& a, const char*& a2, const char*& b, const char*& b2, int& nt) const {
        const size_t ts = (size_t)256 * 2048 * 2;
        if (u.aoff == 0) { a = A0 + (size_t)u.pm * ts; b = B0 + (size_t)u.pn * ts; a2 = a; b2 = b; nt = 32; }
        else { a = A1a + (size_t)u.pm * ts; a2 = A1b + (size_t)u.pm * ts; b = B1a + (size_t)u.pn * ts; b2 = B1b + (size_t)u.pn * ts; nt = 64; } }
    __device__ __forceinline__ void a_ready(const pg8::Unit&) const {}
    __device__ __forceinline__ void done(const pg8::Unit&) const {}
};
struct L2Order {
    int nunits, G, c;
    __device__ bool next(int i, pg8::Unit& u) const { const int L = i * G + c; if (L >= nunits) return false; u.pn = L >> 6; u.pm = L & 63; u.aoff = (u.pn >= 8) ? 512 : 0; return true; }
    __device__ __forceinline__ void a_ready(const pg8::Unit&) const {}
    __device__ __forceinline__ void done(const pg8::Unit&) const {}
};


#ifndef REP_PROL
#define REP_PROL 1
#endif
#ifndef REP_INPROJ
#define REP_INPROJ 1
#endif
#ifndef REP_ATTN
#define REP_ATTN 1
#endif
#ifndef REP_MLSTM
#define REP_MLSTM 1
#endif
#ifndef REP_HNORM
#define REP_HNORM 1
#endif
#ifndef REP_OPREP
#define REP_OPREP 1
#endif
#ifndef REP_RKV
#define REP_RKV 1
#endif
#ifndef REP_RWKV
#define REP_RWKV 1
#endif
#ifndef REP_GATHER
#define REP_GATHER 1
#endif
#ifndef REP_GU
#define REP_GU 1
#endif
#ifndef REP_DN
#define REP_DN 1
#endif
#define REPX_1(...) __VA_ARGS__
#define REPX_2(...) __VA_ARGS__ __VA_ARGS__
#define REPX_3(...) __VA_ARGS__ __VA_ARGS__ __VA_ARGS__
#define REPX_(n, ...) REPX_##n(__VA_ARGS__)
#define REPX(n, ...) REPX_(n, __VA_ARGS__)

struct RangeOrder { pg8::StaticOrder S; int i0, cnt;
    __device__ bool next(int i, pg8::Unit& u) const { if (i >= cnt) return false; return S.next(i + i0, u); }
    __device__ __forceinline__ void a_ready(const pg8::Unit&) const {}
    __device__ __forceinline__ void done(const pg8::Unit&) const {}
};
constexpr int N_PHASES = 41;

__global__ void __launch_bounds__(NTHR, 2) fwd(Args args) {
    extern __shared__ __attribute__((aligned(16))) unsigned char lds_raw[];
    LAS unsigned char* lds = (LAS unsigned char*)lds_raw;
    const int wv = __builtin_amdgcn_readfirstlane((int)threadIdx.x >> 6);
    OPAQUE_TID();
    const ArgsP ap0 = get_args();
    if (tid < 16) ((LAS unsigned*)(lds + MISC_OFF))[tid] = 0u;
    __syncthreads();
#if ONE_LAUNCH
    XcdBarrier bar = xcd_barrier_post((unsigned*)(ap0->ws + WS_CTL) + CW_BAR, (volatile LAS unsigned*)(lds + MISC_OFF), tid == 0);
#define SEAM(k) do { if ((k) + 1 < hi) xcd_barrier(bar, tid == 0); } while (0)
#define SEAMR() xcd_barrier(bar, tid == 0)
#else
#define SEAM(k) do { } while (0)
#define SEAMR() do { } while (0)
#endif
    const int lo = ap0->ph_lo, hi = ap0->ph_hi;
#define IN(k) (lo <= (k) && (k) < hi)
    const int G = gridDim.x, cb = blockIdx.x;

    if (IN(0)) { REPX(REP_PROL, { prologue(wv, lds, 0); SEAMR(); }) }
#ifdef PROBE_BAR
    for (int pb_i = 0; pb_i < 20; ++pb_i) SEAMR();
#endif

    auto layer = [&](auto lc) __attribute__((always_inline)) { constexpr int l = decltype(lc)::value;
        const int pb = 1 + 10 * l, eo = l >> 1;
        if ((l & 1) == 0) {
            if (IN(pb + 0)) {
                const ArgsP ap = get_args(); unsigned char* ws = ap->ws;
                pg8::Gemm g{XIN(ap, l), (const bf16*)(ws + WS_WIN) + (size_t)eo * ZW * 2048, 2048, 2048, 2048};
                pg8::StaticOrder S; S.init(T_, ZW, G, cb);
                pg8::EpiBf16 E{(bf16*)(ws + WS_Z), ZW, 0, 0, 0, nullptr};
                if constexpr (l == 0) {
                    const int n0 = 2 * (cb & 3);
                    RangeOrder S0{S, 0, n0}, S1{S, n0, 1 << 20};
                    if (n0 > 0) { pg8::gemm_phase<pg8::EpiBf16, RangeOrder, true, false>(wv, lds, g, S0, E); __syncthreads(); }
                    prologue(wv, lds, 1); __syncthreads();
                    pg8::gemm_phase<pg8::EpiBf16, RangeOrder, true, false>(wv, lds, g, S1, E); SEAMR();
                } else {
                REPX(REP_INPROJ, { pg8::gemm_phase<pg8::EpiBf16, pg8::StaticOrder, true, false>(wv, lds, g, S, E); SEAMR(); }) }
#if defined(PROBE_NULLEPI)
                { pg8::EpiNull EN; pg8::gemm_phase<pg8::EpiNull, pg8::StaticOrder, true, false>(wv, lds, g, S, EN); SEAMR(); }
#endif
#if defined(PROBE_FULLREP)
                pg8::gemm_phase<pg8::EpiBf16, pg8::StaticOrder, true, false>(wv, lds, g, S, E); SEAMR();
#endif
#if defined(REP_EPAIR)
                for (int u = cb; u < 256; u += G) even_prep(wv, eo, lds, u); SEAMR();
                pg8::gemm_phase<pg8::EpiBf16, pg8::StaticOrder, true, false>(wv, lds, g, S, E); SEAMR();
#endif
            }
            if (IN(pb + 1)) { for (int u = cb; u < 256; u += G) even_prep(wv, eo, lds, u); SEAM(pb + 1); }
            if (IN(pb + 2)) {
                if (cb & 1) { REPX(REP_MLSTM, { mlstm_scan(wv); }) }
                REPX(REP_ATTN, { for (int L = cb; L < 512; L += G) { const int i = L >> 8, c = L & 255; const int qbk = (i & 1) ? (c >> 5) : (15 - (c >> 5)); const int bh = c & 31;
                    attn_unit(wv, lds, bh >> 3, bh & 7, qbk); } })
                if (!(cb & 1)) { REPX(REP_MLSTM, { mlstm_scan(wv); }) }
                SEAM(pb + 2);
            }
            if (IN(pb + 3)) { REPX(REP_HNORM, { for (int u = cb; u < 1024; u += G) mlstm_out_unit(wv, lds, eo, u >> 8, (u >> 6) & 3, u & 63); SEAMR(); }) }
        } else {
            if (IN(pb + 1)) {
                const ArgsP ap = get_args(); unsigned char* ws = ap->ws;
                pg8::Gemm g{nullptr, nullptr, 2048, 2048, 2048};
                MergedOrder S; S.in.init(T_, 2048, 1, 0); S.G = G; S.c = cb;
                S.A0 = (const char*)(ws + WS_XRKV); S.B0 = (const char*)((const bf16*)(ws + WS_WRKV) + (size_t)eo * 3 * 2048 * 2048);
                S.A1a = (const char*)XIN(ap, l); S.A1b = (const char*)(ws + WS_XC);
                S.B1a = (const char*)((const bf16*)(ws + WS_WL1) + (size_t)eo * 2 * 512 * 2048); S.B1b = S.B1a + (size_t)512 * 2048 * 2;
                pg8::EpiBf16 E{(bf16*)(ws + WS_RKV), 2048, 64, 8, (size_t)T_ * 2048, (eo == 0) ? (bf16*)(ws + WS_VF) : nullptr};
                pg8::EpiL1 E1{(bf16*)(ws + WS_L1)};
                REPX(REP_RKV, { pg8::gemm_phase_m<pg8::EpiBf16, pg8::EpiL1, MergedOrder, true, false>(wv, lds, g, S, E, E1); __syncthreads(); })
                SEAM(pb + 1);
            }
            if (IN(pb + 2)) {
                const ArgsP ap = get_args(); unsigned char* ws = ap->ws;
                pg8::Gemm g{(const bf16*)(ws + WS_L1), (const bf16*)(ws + WS_WL2) + (size_t)eo * 8192 * 256, 256, 512, 256};
                L2Order S{(eo == 0 ? 24 : 32) * 64, G, cb};
                pg8::EpiL2 E{(bf16*)(ws + WS_G), (bf16*)(ws + WS_WD), (bf16*)(ws + WS_AA), (bf16*)(ws + WS_RKV) + (size_t)2 * T_ * 2048, (const bf16*)(ws + WS_VF),
                             ap->in[12] + (size_t)eo * 2048, ap->in[15] + (size_t)eo * 2048, ap->in[25]};
                pg8::gemm_phase<pg8::EpiL2, L2Order, true, false>(wv, lds, g, S, E);
#if defined(REP_L2A)
                if (eo == 0) { SEAMR(); pg8::gemm_phase<pg8::EpiL2, L2Order, true, false>(wv, lds, g, S, E); }
#endif
                SEAM(pb + 2);
            }
            if (IN(pb + 3)) { REPX(REP_RWKV, { for (int u = cb; u < 128; u += G) rwkv_unit(wv, lds, eo, u >> 5, u & 31);
#ifdef PROBE_DRY
                for (int u = cb; u < 128; u += G) rwkv_unit<true>(wv, lds, eo, u >> 5, u & 31);
#endif
                if (MOE_PROLOGUE_LAYERS >= 4) { } else if (G > 128 && cb >= 128) moe_convert(wv, lds, (l == 1) ? 32 : 96, (l == 1) ? 96 : 128, cb - 128, G - 128);
                else if (G <= 128) moe_convert(wv, lds, (l == 1) ? 32 : 96, (l == 1) ? 96 : 128, cb, G);
                SEAMR(); }) }
        }
        if (IN(pb + 4)) {
            const bool ev = (l & 1) == 0; const ArgsP ap = get_args(); unsigned char* ws = ap->ws;
            pg8::Gemm g{(const bf16*)(ws + (ev ? WS_YE : WS_YO)), (const bf16*)(ws + (ev ? WS_WOUT : WS_WO)) + (size_t)eo * 2048 * 2048, 2048, 2048, 2048};
            pg8::StaticOrder S; S.init(T_, 2048, G, cb);
            pg8::EpiResid E{XIN(ap, l), (bf16*)(ws + WS_XSUM), 2048, DN_ALPHA};
            pg8::gemm_phase<pg8::EpiResid, pg8::StaticOrder, true, false>(wv, lds, g, S, E);
#if defined(REP_OUT)
            SEAMR(); pg8::gemm_phase<pg8::EpiResid, pg8::StaticOrder, true, false>(wv, lds, g, S, E);
#endif
            SEAM(pb + 4);
        }
        if (IN(pb + 5)) { ln_router(wv, l);
#ifdef PROBE_ROUTER
            SEAMR(); ln_router<true>(wv, l);
#endif
            SEAM(pb + 5); }
        if (IN(pb + 7)) { const MoeTab tb = moe_tables(wv, l, lds); const ArgsP ap = get_args(); unsigned char* ws = ap->ws;
            pg8::Gemm g{XIN(ap, l), (const bf16*)(ws + WS_WGU) + (size_t)l * 32 * 1024 * 2048, 2048, 2048, 2048};
            pg8::EpiSilu E{(bf16*)(ws + WS_HID)};
            { MoeOrderG<4> S{tb.tileE, tb.start, tb.cntv, (const int*)(ws + WS_LIST), *tb.ntiles * 4, G, cb, 0, 2};
              pg8::gemm_phase_g<pg8::EpiSilu, MoeOrderG<4>, true, false>(wv, lds, g, S, E); SEAMR(); }
            { pg8::Gemm gd{(const bf16*)(ws + WS_HID), (const bf16*)(ws + WS_WDN) + (size_t)l * 32 * 2048 * 512, 512, 512, 512};
              MoeOrderDn SD{tb.tileE, *tb.ntiles, G, cb, 0, 4};
              if (SD.third_round()) { MoeOrderG<4> S{tb.tileE, tb.start, tb.cntv, (const int*)(ws + WS_LIST), *tb.ntiles * 4, G, cb, 2, 1 << 20};
                  pg8::gemm_phase_g<pg8::EpiSilu, MoeOrderG<4>, true, false>(wv, lds, g, S, E); }
              else { pg8::EpiBf16 ED{(bf16*)(ws + WS_YS), 2048, 0, 8, 0, nullptr};
                  pg8::gemm_phase<pg8::EpiBf16, MoeOrderDn, true, false>(wv, lds, gd, SD, ED); }
              SEAMR(); }
        }
        if (IN(pb + 8)) { const MoeTab tb = moe_tables(wv, l, lds); const ArgsP ap = get_args(); unsigned char* ws = ap->ws;
            pg8::Gemm g{(const bf16*)(ws + WS_HID), (const bf16*)(ws + WS_WDN) + (size_t)l * 32 * 2048 * 512, 512, 512, 512};
            MoeOrderDn S{tb.tileE, *tb.ntiles, G, cb, 1, 4};
            pg8::EpiBf16 E{(bf16*)(ws + WS_YS), 2048, 0, 8, 0, nullptr};
            pg8::gemm_phase<pg8::EpiBf16, MoeOrderDn, true, false>(wv, lds, g, S, E); SEAMR();
        }
        if (IN(pb + 9)) { moe_combine_ln<(l & 1) == 0>(wv, l);
#if defined(REP_COMB)
            if ((l & 1) == 0) { SEAMR(); moe_combine_ln<(l & 1) == 0>(wv, l); }
#endif
            SEAM(pb + 9); }
#ifdef PROBE_RWKV
        if (l == 3 && IN(pb + 9) && cb == 0) { __syncthreads(); const ArgsP ap = get_args(); if (tid == 0) { asm volatile("s_waitcnt vmcnt(0)" ::: "memory"); const float* pw = (const float*)(ap->ws + WS_CTL) + 200000; ap->out[0] = pw[0]; ap->out[1] = pw[1]; } }
#endif
        };
    layer(std::integral_constant<int, 0>{}); layer(std::integral_constant<int, 1>{}); layer(std::integral_constant<int, 2>{}); layer(std::integral_constant<int, 3>{});
#undef IN
#undef SEAM
}

extern "C" void kernel_launch(void* const* d_in, const int* in_sizes, int n_in, void* d_out, int out_size, void* d_ws, size_t ws_size, hipStream_t stream) {
    static int grid = 0;
    if (grid == 0) {
        if (n_in != 39 || in_sizes[0] != T_ * D_ || out_size != T_ * D_ || ws_size < WS_END) {
            fprintf(stderr, "kernel_launch: unexpected problem: n_in %d in0 %d out %d ws %zu (need %zu)\n", n_in, n_in > 0 ? in_sizes[0] : -1, out_size, ws_size, (size_t)WS_END); grid = -1; return; }
        int dev = 0, cus = 0, per_cu = 0;
        if (hipGetDevice(&dev) != hipSuccess || hipDeviceGetAttribute(&cus, hipDeviceAttributeMultiprocessorCount, dev) != hipSuccess) { fprintf(stderr, "kernel_launch: device query failed\n"); grid = -1; return; }
        if (hipFuncSetAttribute((const void*)fwd, hipFuncAttributeMaxDynamicSharedMemorySize, LDS_BYTES) != hipSuccess) { fprintf(stderr, "kernel_launch: hipFuncSetAttribute failed\n"); grid = -1; return; }
        if (hipOccupancyMaxActiveBlocksPerMultiprocessor(&per_cu, (const void*)fwd, NTHR, LDS_BYTES) != hipSuccess || per_cu < 1)
            fprintf(stderr, "kernel_launch: note: occupancy query reports %d workgroups per CU\n", per_cu);
        (void)hipGetLastError();
        grid = cus;
    }
    if (grid < 0) return;
    if (hipMemsetAsync((char*)d_ws + WS_CTL, 0, CTL_ZERO_BYTES, stream) != hipSuccess) { fprintf(stderr, "kernel_launch: memset failed\n"); return; }
    Args a{};
    for (int i = 0; i < 39; ++i) a.in[i] = (const float*)d_in[i];
    a.out = (float*)d_out; a.ws = (unsigned char*)d_ws;
#if ONE_LAUNCH
    a.ph_lo = 0; a.ph_hi = N_PHASES;
    hipLaunchKernelGGL(fwd, dim3(grid), dim3(NTHR), LDS_BYTES, stream, a);
#else
    for (int p = 0; p < N_PHASES; ++p) { a.ph_lo = p; a.ph_hi = p + 1; hipLaunchKernelGGL(fwd, dim3(grid), dim3(NTHR), LDS_BYTES, stream, a); }
#endif
    const hipError_t le = hipPeekAtLastError();
    if (le != hipSuccess) fprintf(stderr, "kernel_launch: launch failed: %s\n", hipGetErrorName(le));
}
```
